# Optimizing an MI355X kernel written in HIP

```python
import math
import jax, jax.numpy as jnp
from jax import lax
import numpy as np

D_MODEL = 1024
BATCH = 4
SEQ = 8192
DEPTH = 1
DEC_BATCH = 32
DEC_SEQ = 4
PAST_LEN = 16384
PAGE_SIZE = 128

DN_HEADS = 4
DN_DK = 128
DN_DV = 128
CONV_W = 4
DN_CHUNK = 64
DN_QK = DN_HEADS * DN_DK
DN_V = DN_HEADS * DN_DV
CONV_DIM = 2 * DN_QK + DN_V
SW_GROUPS = ((128, 1), (512, 4), (2048, 16))
SW_HEADS = 4
SW_DH = 64
SW_W = SW_HEADS * SW_DH
SW_BLOCK = 128
IN_SIZES = (DN_QK, DN_QK, DN_V, DN_HEADS, DN_HEADS, DN_V) + (SW_W,) * (3 * len(SW_GROUPS))
IN_DIM = sum(IN_SIZES)
MIX_OUT = DN_V + SW_W
MEM_LEN = 256
MEM_HEADS = 4
MEM_DH = D_MODEL // MEM_HEADS
PEER_HEADS = 8
PEER_NKEYS = 128
PEER_N = PEER_NKEYS * PEER_NKEYS
PEER_DQ = 256
PEER_DHALF = PEER_DQ // 2
PEER_TOPK = 16
PEER_BLOCK = 128
NORM_EPS = 1e-6

kernel_name = 'hymba_deltanet_dilated_peer_step'

F32 = jnp.float32


def rmsnorm(x, g):
    xf = x.astype(F32)
    y = xf * lax.rsqrt(jnp.mean(xf * xf, axis=-1, keepdims=True) + NORM_EPS)
    return (y * g.astype(F32)).astype(x.dtype)


def l2norm(x):
    xf = x.astype(F32)
    return xf * lax.rsqrt(jnp.sum(xf * xf, axis=-1, keepdims=True) + NORM_EPS)


def short_conv(x, buf, w):
    t = x.shape[1]
    xp = jnp.concatenate([buf.astype(x.dtype), x], axis=1)
    y = xp[:, 0:t] * w[0]
    for j in range(1, CONV_W):
        y = y + xp[:, j:j + t] * w[j]
    return jax.nn.silu(y), xp[:, t:]


def gated_delta_rule(q, k, v, g, beta, s0):
    bn, t, nh, dk = q.shape
    dv = v.shape[-1]
    c = DN_CHUNK
    pad = (-t) % c
    nc = (t + pad) // c

    def prep(a):
        a = jnp.pad(a, [(0, 0), (0, pad)] + [(0, 0)] * (a.ndim - 2))
        a = a.reshape((bn, nc, c) + a.shape[2:])
        return jnp.moveaxis(a, 3, 2)

    q, k, v, g, beta = prep(q), prep(k), prep(v), prep(g), prep(beta)
    gc = jnp.cumsum(g, axis=-1)
    idx = jnp.arange(c)
    causal = idx[:, None] >= idx[None, :]
    strict = idx[:, None] > idx[None, :]
    gam = jnp.exp(jnp.where(causal, gc[..., :, None] - gc[..., None, :], -jnp.inf))
    kb = k * beta[..., None]
    lmat = jnp.where(strict, jnp.einsum('bnhik,bnhjk->bnhij', kb, k) * gam, 0.0)
    eye = jnp.broadcast_to(jnp.eye(c, dtype=F32), lmat.shape)
    rhs = jnp.concatenate([v * beta[..., None], kb * jnp.exp(gc)[..., None]], axis=-1)
    sol = lax.linalg.triangular_solve(eye + lmat, rhs, left_side=True, lower=True, unit_diagonal=True)
    u0, wk = sol[..., :dv], sol[..., dv:]
    aqk = jnp.where(causal, jnp.einsum('bnhik,bnhjk->bnhij', q, k) * gam, 0.0)
    qg = q * jnp.exp(gc)[..., None]
    kd = k * jnp.exp(gc[..., -1:] - gc)[..., None]
    dlast = jnp.exp(gc[..., -1])

    def step(s, xs):
        u0_c, w_c, aqk_c, qg_c, kd_c, dl_c = xs
        u = u0_c - jnp.einsum('bhck,bhkv->bhcv', w_c, s)
        o = jnp.einsum('bhck,bhkv->bhcv', qg_c, s) + jnp.einsum('bhij,bhjv->bhiv', aqk_c, u)
        s = s * dl_c[..., None, None] + jnp.einsum('bhck,bhcv->bhkv', kd_c, u)
        return s, o

    xs = (jnp.moveaxis(u0, 1, 0), jnp.moveaxis(wk, 1, 0), jnp.moveaxis(aqk, 1, 0),
          jnp.moveaxis(qg, 1, 0), jnp.moveaxis(kd, 1, 0), jnp.moveaxis(dlast, 1, 0))
    s_fin, o = lax.scan(step, s0, xs)
    o = jnp.moveaxis(o, 0, 1)
    o = jnp.moveaxis(o, 2, 3).reshape(bn, nc * c, nh, dv)[:, :t]
    return o, s_fin


def deltanet_group(qa, ka, va, ag, bg, z, conv_buf, s0, conv_w, a_log, dt_bias, g_onorm):
    bn, t, _ = qa.shape
    act, conv_new = short_conv(jnp.concatenate([qa, ka, va], axis=-1), conv_buf, conv_w)
    q, k, v = jnp.split(act, [DN_QK, 2 * DN_QK], axis=-1)
    q = l2norm(q.reshape(bn, t, DN_HEADS, DN_DK)) * (DN_DK ** -0.5)
    k = l2norm(k.reshape(bn, t, DN_HEADS, DN_DK))
    v = v.reshape(bn, t, DN_HEADS, DN_DV).astype(F32)
    beta = jax.nn.sigmoid(bg.astype(F32))
    g = -jnp.exp(a_log.astype(F32)) * jax.nn.softplus(ag.astype(F32) + dt_bias.astype(F32))
    o, s_new = gated_delta_rule(q, k, v, g, beta, s0.astype(F32))
    o = rmsnorm(o, g_onorm) * jax.nn.silu(z.reshape(bn, t, DN_HEADS, DN_DV).astype(F32))
    return o.reshape(bn, t, DN_V).astype(qa.dtype), conv_new, s_new.astype(qa.dtype)


def dilated_prompt(q, k, v, window, dil):
    bn, t, nh, dh = q.shape
    ln = t // dil
    nb = -(-ln // SW_BLOCK)
    lp = nb * SW_BLOCK
    span = window // dil

    def sub(a):
        a = a.reshape(bn, ln, dil, nh, dh).transpose(0, 2, 1, 3, 4)
        a = jnp.pad(a, ((0, 0), (0, 0), (0, lp - ln), (0, 0), (0, 0)))
        return a.reshape(bn, dil, nb, SW_BLOCK, nh, dh)

    def band(a):
        prev = jnp.pad(a, ((0, 0), (0, 0), (1, 0), (0, 0), (0, 0), (0, 0)))[:, :, :-1]
        return jnp.concatenate([prev, a], axis=3)

    qs = sub(q)
    kk, vv = band(sub(k)), band(sub(v))
    s = jnp.einsum('brnqhc,brnkhc->brnhqk', qs, kk, preferred_element_type=F32) * (dh ** -0.5)
    qi = jnp.arange(SW_BLOCK)[:, None]
    ki = jnp.arange(2 * SW_BLOCK)[None, :]
    dist = SW_BLOCK + qi - ki
    kpos = (jnp.arange(nb)[:, None, None] - 1) * SW_BLOCK + ki[None]
    mask = (dist >= 0) & (dist <= span) & (kpos >= 0)
    s = jnp.where(mask[None, None, :, None], s, -jnp.inf)
    lse = jax.nn.logsumexp(s, axis=-1)
    p = jnp.exp(s - lse[..., None])
    o = jnp.einsum('brnhqk,brnkhc->brnqhc', p, vv.astype(F32))
    o = o.reshape(bn, dil, lp, nh, dh)[:, :, :ln].transpose(0, 2, 1, 3, 4).reshape(bn, t, nh, dh)
    lse = lse.transpose(0, 1, 2, 4, 3).reshape(bn, dil, lp, nh)[:, :, :ln]
    lse = lse.transpose(0, 2, 1, 3).reshape(bn, t, nh)
    return o, lse


def dilated_sample(q, k, v, buf, window, dil):
    bn, tn, nh, dh = q.shape
    wb = buf.shape[1]
    kc = jnp.concatenate([buf[:, :, 0].astype(k.dtype), k], axis=1)
    vc = jnp.concatenate([buf[:, :, 1].astype(v.dtype), v], axis=1)
    m = jnp.arange(window // dil + 1)
    j = wb + jnp.arange(tn)[:, None] - m[None, :] * dil
    valid = j >= 0
    jc = jnp.clip(j, 0)
    kg = kc[:, jc]
    vg = vc[:, jc]
    s = jnp.einsum('bthc,btmhc->bhtm', q, kg, preferred_element_type=F32) * (dh ** -0.5)
    s = jnp.where(valid[None, None], s, -jnp.inf)
    lse = jax.nn.logsumexp(s, axis=-1)
    p = jnp.exp(s - lse[..., None])
    o = jnp.einsum('bhtm,btmhc->bthc', p, vg.astype(F32))
    new_buf = jnp.stack([kc, vc], axis=2)[:, -min(window, wb + tn):]
    return o, lse.transpose(0, 2, 1), new_buf


def token_mixer(a, conv_buf, s0, wins, w_in, conv_w, a_log, dt_bias, g_onorm, w_out):
    bn, t, _ = a.shape
    proj = a @ w_in
    parts = jnp.split(proj, [int(o) for o in np.cumsum(IN_SIZES)[:-1]], axis=-1)
    qa, ka, va, ag, bg, z = parts[:6]
    sw = parts[6:]
    if conv_buf is None:
        conv_buf = jnp.zeros((bn, CONV_W - 1, CONV_DIM), a.dtype)
    if s0 is None:
        s0 = jnp.zeros((bn, DN_HEADS, DN_DK, DN_DV), F32)
    o_dn, conv_new, s_new = deltanet_group(qa, ka, va, ag, bg, z, conv_buf, s0,
                                           conv_w, a_log, dt_bias, g_onorm)
    outs, lses, wins_new = [], [], []
    for gi, (win, dil) in enumerate(SW_GROUPS):
        q, k, v = [p.reshape(bn, t, SW_HEADS, SW_DH) for p in sw[3 * gi:3 * gi + 3]]
        if wins is None:
            o, l = dilated_prompt(q, k, v, win, dil)
            nbuf = jnp.stack([k, v], axis=2)[:, -min(win, t):]
        else:
            o, l, nbuf = dilated_sample(q, k, v, wins[gi], win, dil)
        outs.append(o)
        lses.append(l)
        wins_new.append(nbuf)
    wgt = jax.nn.softmax(jnp.stack(lses, axis=0), axis=0)
    o_sw = jnp.sum(wgt[..., None] * jnp.stack(outs, axis=0), axis=0).reshape(bn, t, SW_W)
    y = jnp.concatenate([o_dn, o_sw.astype(a.dtype)], axis=-1) @ w_out
    return y, conv_new, s_new, wins_new


def memory_kv(mem, g_memkv, w_mkv):
    bn = mem.shape[0]
    return (rmsnorm(mem, g_memkv) @ w_mkv).reshape(bn, MEM_LEN, 2, MEM_HEADS, MEM_DH)


def mem_attend(c, kv, w_mq, w_mo):
    bn, t, _ = c.shape
    q = (c @ w_mq).reshape(bn, t, MEM_HEADS, MEM_DH)
    s = jnp.einsum('bthc,bmhc->bhtm', q, kv[:, :, 0], preferred_element_type=F32) * (MEM_DH ** -0.5)
    p = jax.nn.softmax(s, axis=-1)
    o = jnp.einsum('bhtm,bmhc->bthc', p, kv[:, :, 1].astype(F32))
    return o.reshape(bn, t, MEM_HEADS * MEM_DH).astype(c.dtype) @ w_mo


def peer(f, w_pq, sub_keys, expert_u, expert_v):
    bn, t, d = f.shape
    n = bn * t
    pad = (-n) % PEER_BLOCK
    flat = jnp.pad(f.reshape(n, d), ((0, pad), (0, 0))).reshape(-1, PEER_BLOCK, d)

    def block(xb):
        q = (xb @ w_pq).reshape(PEER_BLOCK, PEER_HEADS, 2, PEER_DHALF)
        s = jnp.einsum('thpc,hpnc->thpn', q, sub_keys, preferred_element_type=F32)
        sv, si = lax.top_k(s, PEER_TOPK)
        cand = sv[:, :, 0, :, None] + sv[:, :, 1, None, :]
        cv, ci = lax.top_k(cand.reshape(PEER_BLOCK, PEER_HEADS, PEER_TOPK * PEER_TOPK), PEER_TOPK)
        i1 = jnp.take_along_axis(si[:, :, 0], ci // PEER_TOPK, axis=-1)
        i2 = jnp.take_along_axis(si[:, :, 1], ci % PEER_TOPK, axis=-1)
        eid = i1 * PEER_NKEYS + i2
        gate = jax.nn.softmax(cv, axis=-1)
        hid = jax.nn.gelu(jnp.einsum('thkd,td->thk', expert_u[eid], xb, preferred_element_type=F32))
        out = jnp.einsum('thk,thkd->td', gate * hid, expert_v[eid].astype(F32))
        return out.astype(f.dtype)

    out = lax.map(block, flat)
    return out.reshape(-1, d)[:n].reshape(bn, t, d)


def layer(h, conv_buf, s0, wins, kv, g_mix, w_in, conv_w, a_log, dt_bias, g_onorm, w_out,
          g_memq, w_mq, w_mo, g_ffn, w_pq, sub_keys, expert_u, expert_v):
    mix, conv_new, s_new, wins_new = token_mixer(rmsnorm(h, g_mix), conv_buf, s0, wins, w_in,
                                                 conv_w, a_log, dt_bias, g_onorm, w_out)
    h = h + mix
    h = h + mem_attend(rmsnorm(h, g_memq), kv, w_mq, w_mo)
    h = h + peer(rmsnorm(h, g_ffn), w_pq, sub_keys, expert_u, expert_v)
    return h, conv_new, s_new, wins_new


def setup_inputs(seed: int = 0) -> dict:
    key = jax.random.key(seed)
    ks = iter(jax.random.split(key, 40))

    def nrm(shape, scale):
        return jax.random.normal(next(ks), shape, F32) * scale

    def gain(shape):
        return 1.0 + nrm(shape, 0.02)

    wb = [min(w, PAST_LEN) for w, _ in SW_GROUPS]
    a_log = jnp.log(jax.random.uniform(next(ks), (DEPTH, DN_HEADS), F32, 1.0, 16.0))
    dt = jnp.exp(jax.random.uniform(next(ks), (DEPTH, DN_HEADS), F32, math.log(1e-3), math.log(1e-1)))
    dt_bias = dt + jnp.log(-jnp.expm1(-dt))
    return {
        'x_prompt': nrm((BATCH, SEQ, D_MODEL), 1.0),
        'x_sample': nrm((DEC_BATCH, DEC_SEQ, D_MODEL), 1.0),
        'state_delta': nrm((DEPTH, DEC_BATCH, DN_HEADS, DN_DK, DN_DV), 0.1),
        'state_conv': nrm((DEPTH, DEC_BATCH, CONV_W - 1, CONV_DIM), 1.0),
        'cache_win1': nrm((DEPTH, DEC_BATCH, wb[0], 2, SW_HEADS, SW_DH), 1.0),
        'cache_win2': nrm((DEPTH, DEC_BATCH, wb[1], 2, SW_HEADS, SW_DH), 1.0),
        'cache_win3': nrm((DEPTH, DEC_BATCH, wb[2], 2, SW_HEADS, SW_DH), 1.0),
        'cache_mem_kv': nrm((DEPTH, DEC_BATCH, MEM_LEN, 2, MEM_HEADS, MEM_DH), 1.0),
        'mem_prompt': nrm((BATCH, MEM_LEN, D_MODEL), 1.0),
        'g_mix': gain((DEPTH, D_MODEL)),
        'w_in': nrm((DEPTH, D_MODEL, IN_DIM), D_MODEL ** -0.5),
        'conv_w': nrm((DEPTH, CONV_W, CONV_DIM), CONV_W ** -0.5),
        'a_log': a_log,
        'dt_bias': dt_bias,
        'g_onorm': gain((DEPTH, DN_DV)),
        'w_out': nrm((DEPTH, MIX_OUT, D_MODEL), MIX_OUT ** -0.5),
        'g_memq': gain((DEPTH, D_MODEL)),
        'g_memkv': gain((DEPTH, D_MODEL)),
        'w_mq': nrm((DEPTH, D_MODEL, MEM_HEADS * MEM_DH), D_MODEL ** -0.5),
        'w_mkv': nrm((DEPTH, D_MODEL, 2 * MEM_HEADS * MEM_DH), D_MODEL ** -0.5),
        'w_mo': nrm((DEPTH, MEM_HEADS * MEM_DH, D_MODEL), (MEM_HEADS * MEM_DH) ** -0.5),
        'g_ffn': gain((DEPTH, D_MODEL)),
        'w_pq': nrm((DEPTH, D_MODEL, PEER_HEADS * PEER_DQ), D_MODEL ** -0.5),
        'sub_keys': nrm((DEPTH, PEER_HEADS, 2, PEER_NKEYS, PEER_DHALF), PEER_DHALF ** -0.5),
        'expert_u': nrm((DEPTH, PEER_N, D_MODEL), D_MODEL ** -0.5),
        'expert_v': nrm((DEPTH, PEER_N, D_MODEL), 0.5 * PEER_HEADS ** -0.5),
        'g_final': gain((D_MODEL,)),
    }


def reference(x_prompt, x_sample, state_delta, state_conv, cache_win1, cache_win2, cache_win3,
              cache_mem_kv, mem_prompt, g_mix, w_in, conv_w, a_log, dt_bias, g_onorm, w_out,
              g_memq, g_memkv, w_mq, w_mkv, w_mo, g_ffn, w_pq, sub_keys, expert_u, expert_v,
              g_final):
    per_layer = (g_mix, w_in, conv_w, a_log, dt_bias, g_onorm, w_out, g_memq, w_mq, w_mo,
                 g_ffn, w_pq, sub_keys, expert_u, expert_v)
    h = x_prompt
    p_conv, p_delta, p_win, p_mem = [], [], [], []
    for l in range(DEPTH):
        kv = memory_kv(mem_prompt, g_memkv[l], w_mkv[l])
        h, c_new, s_new, w_new = layer(h, None, None, None, kv, *[p[l] for p in per_layer])
        p_conv.append(c_new)
        p_delta.append(s_new)
        p_win.append(w_new)
        p_mem.append(kv)
    y_prompt = rmsnorm(h, g_final)
    h = x_sample
    s_conv, s_delta, s_win = [], [], []
    for l in range(DEPTH):
        wins = (cache_win1[l], cache_win2[l], cache_win3[l])
        h, c_new, s_new, w_new = layer(h, state_conv[l], state_delta[l], wins, cache_mem_kv[l],
                                       *[p[l] for p in per_layer])
        s_conv.append(c_new)
        s_delta.append(s_new)
        s_win.append(w_new)
    y_sample = rmsnorm(h, g_final)
    return (y_prompt, y_sample,
            jnp.stack(p_delta), jnp.stack(p_conv),
            jnp.stack([w[0] for w in p_win]), jnp.stack([w[1] for w in p_win]),
            jnp.stack([w[2] for w in p_win]), jnp.stack(p_mem),
            jnp.stack(s_delta), jnp.stack(s_conv),
            jnp.stack([w[0] for w in s_win]), jnp.stack([w[1] for w in s_win]),
            jnp.stack([w[2] for w in s_win]))
```

```cpp
#include <hip/hip_runtime.h>
#include <hip/hip_cooperative_groups.h>
#include <cstdio>
namespace cg = cooperative_groups;

typedef unsigned short u16;
typedef __attribute__((ext_vector_type(8))) short bf16x8;
typedef __attribute__((ext_vector_type(4))) float f32x4;
typedef __attribute__((ext_vector_type(2))) __bf16 bf2_t;

#define DI __device__ __forceinline__
#define MFMA(a, b, c) __builtin_amdgcn_mfma_f32_16x16x32_bf16((a), (b), (c), 0, 0, 0)

constexpr int MP = 32768, MS = 128, MT = 32896;
constexpr int NP = 4352;
constexpr int SEQ = 8192;
constexpr float EPS = 1e-6f;
constexpr size_t DN_ITEM = 73728;

constexpr size_t O_YP = 0, O_YS = 33554432, O_PDELTA = 33685504, O_PCONV = 33947648, O_PW1 = 33966080,
                 O_PW2 = 34228224, O_PW3 = 35276800, O_PMEM = 39471104, O_SDELTA = 41568256, O_SCONV = 43665408,
                 O_SW1 = 43812864, O_SW2 = 45910016, O_SW3 = 54298624;

struct Params {
  const float *x_prompt, *x_sample, *state_delta, *state_conv, *cw1, *cw2, *cw3, *cache_mem, *mem_prompt;
  const float *g_mix, *w_in, *conv_w, *a_log, *dt_bias, *g_onorm, *w_out, *g_memq, *g_memkv, *w_mq, *w_mkv, *w_mo;
  const float *g_ffn, *w_pq, *sub_keys, *expert_u, *expert_v, *g_final;
  float* out;
  u16 *WtIn, *WtOut, *WtMq, *WtMkv, *WtMo, *WtPq, *subkb, *EU, *EV, *Amem;
  float *gb, *ssq1, *ssq2, *dl;
  u16 *Kb, *VTf;
  u16* proj;
  float *h1, *h2;
  u16* pq;
  char* dnops;
  u16 *A0, *A1, *qb, *attn, *A2;
  int* eid;
  float* gate;
  u16 *vT, *osw, *odn, *Amix;
  float* lse;
};

DI u16 f2bf(float x) { unsigned u = __float_as_uint(x); u += 0x7fffu + ((u >> 16) & 1u); return (u16)(u >> 16); }
DI float bf2f(u16 h) { return __uint_as_float(((unsigned)h) << 16); }
DI unsigned pack2(float a, float b) { return (unsigned)f2bf(a) | ((unsigned)f2bf(b) << 16); }
DI float bflo(unsigned d) { return __uint_as_float(d << 16); }
DI float bfhi(unsigned d) { return __uint_as_float(d & 0xffff0000u); }
DI bf16x8 pack8(f32x4 a, f32x4 b) {
  uint4 r; r.x = pack2(a[0], a[1]); r.y = pack2(a[2], a[3]); r.z = pack2(b[0], b[1]); r.w = pack2(b[2], b[3]);
  return __builtin_bit_cast(bf16x8, r);
}
DI float wave_sum(float v) {
#pragma unroll
  for (int o = 32; o > 0; o >>= 1) v += __shfl_xor(v, o);
  return v;
}
DI float wave_max(float v) {
#pragma unroll
  for (int o = 32; o > 0; o >>= 1) v = fmaxf(v, __shfl_xor(v, o));
  return v;
}
DI float siluf(float x) { return x / (1.f + __expf(-x)); }
DI float geluf(float x) { return 0.5f * x * (1.f + tanhf(0.7978845608028654f * (x + 0.044715f * x * x * x))); }
DI int permk(int kg, int j) { return (j < 4) ? (kg * 4 + j) : (16 + kg * 4 + (j - 4)); }
DI void cvt8(const float* __restrict__ s, u16* __restrict__ d) {
  float4 a = *(const float4*)s, b = *(const float4*)(s + 4);
  uint4 r; r.x = pack2(a.x, a.y); r.y = pack2(a.z, a.w); r.z = pack2(b.x, b.y); r.w = pack2(b.z, b.w);
  *(uint4*)d = r;
}
DI unsigned ordf(float f) { unsigned u = __float_as_uint(f); return (u & 0x80000000u) ? ~u : (u | 0x80000000u); }
DI float unordf(unsigned k) { unsigned u = (k & 0x80000000u) ? (k & 0x7fffffffu) : ~k; return __uint_as_float(u); }
DI unsigned umax(unsigned a, unsigned b) { return a > b ? a : b; }
template <typename T> DI T sel4(int L, T a, T b, T c, T d) { return L == 0 ? a : (L == 1 ? b : (L == 2 ? c : d)); }

template <int MODE>
DI void gemm_tile(const Params& p, const u16* __restrict__ A, int lda, const u16* __restrict__ Bt, int K, int tm, int tn,
                          char* smem) {
  u16* sA = (u16*)smem;
  u16* sB = sA + 128 * 72;
  const int tid = threadIdx.x, lane = tid & 63, w = tid >> 6;
  const int wm = w >> 1, wn = w & 1, r = lane & 15, kg = lane >> 4;
  f32x4 acc[4][4];
#pragma unroll
  for (int i = 0; i < 4; ++i)
#pragma unroll
    for (int j = 0; j < 4; ++j) acc[i][j] = (f32x4){0.f, 0.f, 0.f, 0.f};
  const int lrow = tid >> 1, lcol = (tid & 1) * 32;
  const u16* gA = A + (size_t)(tm * 128 + lrow) * lda + lcol;
  const u16* gB = Bt + (size_t)(tn * 128 + lrow) * K + lcol;
  bf16x8 ra[4], rb[4];
#pragma unroll
  for (int i = 0; i < 4; ++i) { ra[i] = *(const bf16x8*)(gA + i * 8); rb[i] = *(const bf16x8*)(gB + i * 8); }
  for (int k0 = 0; k0 < K; k0 += 64) {
    __syncthreads();
#pragma unroll
    for (int i = 0; i < 4; ++i) {
      *(bf16x8*)&sA[lrow * 72 + lcol + i * 8] = ra[i];
      *(bf16x8*)&sB[lrow * 72 + lcol + i * 8] = rb[i];
    }
    __syncthreads();
    if (k0 + 64 < K) {
#pragma unroll
      for (int i = 0; i < 4; ++i) { ra[i] = *(const bf16x8*)(gA + k0 + 64 + i * 8); rb[i] = *(const bf16x8*)(gB + k0 + 64 + i * 8); }
    }
#pragma unroll
    for (int ks = 0; ks < 2; ++ks) {
      bf16x8 af[4], bfr[4];
#pragma unroll
      for (int i = 0; i < 4; ++i) {
        af[i] = *(const bf16x8*)&sA[(wm * 64 + i * 16 + r) * 72 + ks * 32 + kg * 8];
        bfr[i] = *(const bf16x8*)&sB[(wn * 64 + i * 16 + r) * 72 + ks * 32 + kg * 8];
      }
#pragma unroll
      for (int mt = 0; mt < 4; ++mt)
#pragma unroll
        for (int nt = 0; nt < 4; ++nt) acc[mt][nt] = MFMA(bfr[nt], af[mt], acc[mt][nt]);
    }
  }
#pragma unroll
  for (int mt = 0; mt < 4; ++mt) {
    const int row = tm * 128 + wm * 64 + mt * 16 + r;
    float rs = 1.f, ssq = 0.f;
    if (MODE == 3) rs = rsqrtf(p.ssq1[row] * (1.f / 1024.f) + EPS);
    if (MODE == 5) rs = rsqrtf(p.ssq2[row] * (1.f / 1024.f) + EPS);
#pragma unroll
    for (int nt = 0; nt < 4; ++nt) {
      const int col = tn * 128 + wn * 64 + nt * 16 + kg * 4;
      f32x4 v = acc[mt][nt];
      if (MODE == 0) {
        uint2 o; o.x = pack2(v[0], v[1]); o.y = pack2(v[2], v[3]);
        *(uint2*)&p.proj[(size_t)row * NP + col] = o;
      } else if (MODE == 1) {
        *(float4*)&p.out[O_PMEM + (size_t)row * 2048 + col] = make_float4(v[0], v[1], v[2], v[3]);
      } else if (MODE == 2 || MODE == 4) {
        float4 rsd;
        const float* gn;
        if (MODE == 2) {
          rsd = (row < MP) ? *(const float4*)&p.x_prompt[(size_t)row * 1024 + col] : *(const float4*)&p.x_sample[(size_t)(row - MP) * 1024 + col];
          gn = p.g_memq;
        } else {
          rsd = *(const float4*)&p.h1[(size_t)row * 1024 + col];
          gn = p.g_ffn;
        }
        float4 h = make_float4(rsd.x + v[0], rsd.y + v[1], rsd.z + v[2], rsd.w + v[3]);
        float4 g4 = *(const float4*)&gn[col];
        ssq += h.x * h.x + h.y * h.y + h.z * h.z + h.w * h.w;
        uint2 o; o.x = pack2(h.x * g4.x, h.y * g4.y); o.y = pack2(h.z * g4.z, h.w * g4.w);
        if (MODE == 2) { *(float4*)&p.h1[(size_t)row * 1024 + col] = h; *(uint2*)&p.A1[(size_t)row * 1024 + col] = o; }
        else { *(float4*)&p.h2[(size_t)row * 1024 + col] = h; *(uint2*)&p.A2[(size_t)row * 1024 + col] = o; }
      } else if (MODE == 3) {
        uint2 o; o.x = pack2(v[0] * rs, v[1] * rs); o.y = pack2(v[2] * rs, v[3] * rs);
        *(uint2*)&p.qb[(size_t)row * 1024 + col] = o;
      } else {
        uint2 o; o.x = pack2(v[0] * rs, v[1] * rs); o.y = pack2(v[2] * rs, v[3] * rs);
        *(uint2*)&p.pq[(size_t)row * 2048 + col] = o;
      }
    }
    if (MODE == 2 || MODE == 4) {
      ssq += __shfl_xor(ssq, 16);
      ssq += __shfl_xor(ssq, 32);
      if (kg == 0) atomicAdd((MODE == 2) ? &p.ssq1[row] : &p.ssq2[row], ssq);
    }
  }
}

DI void tr_tile(const float* __restrict__ W, int ldw, int nsrc0, u16* __restrict__ Wt, int K, int k0, int n0, float* tile) {
  const int tid = threadIdx.x;
  const int n = tid & 63, kq = tid >> 6;
  __syncthreads();
#pragma unroll
  for (int i = 0; i < 16; ++i) { int kk = kq + 4 * i; tile[kk * 65 + n] = W[(size_t)(k0 + kk) * ldw + nsrc0 + n]; }
  __syncthreads();
  const int nn = tid >> 2, ks = (tid & 3) * 16;
  unsigned o[8];
#pragma unroll
  for (int i = 0; i < 8; ++i) o[i] = pack2(tile[(ks + 2 * i) * 65 + nn], tile[(ks + 2 * i + 1) * 65 + nn]);
  u16* d = Wt + (size_t)(n0 + nn) * K + k0 + ks;
  *(uint4*)d = make_uint4(o[0], o[1], o[2], o[3]);
  *(uint4*)(d + 8) = make_uint4(o[4], o[5], o[6], o[7]);
}

DI void phase0(const Params& p, char* smem) {
  const int tid = threadIdx.x, lane = tid & 63, w = tid >> 6;
  const size_t gtid = (size_t)blockIdx.x * 256 + tid, gsz = (size_t)gridDim.x * 256;
  for (size_t i = gtid; i < (size_t)16384 * 1024 / 8; i += gsz) { cvt8(p.expert_u + i * 8, p.EU + i * 8); cvt8(p.expert_v + i * 8, p.EV + i * 8); }
  for (size_t i = gtid; i < 262144 / 8; i += gsz) cvt8(p.sub_keys + i * 8, p.subkb + i * 8);
  for (size_t i = gtid; i < MT; i += gsz) { p.ssq1[i] = 0.f; p.ssq2[i] = 0.f; }
  for (int row = blockIdx.x * 4 + w; row < MT + 1024; row += gridDim.x * 4) {
    const float* src; const float* g; u16* dst;
    if (row < MP) { src = p.x_prompt + (size_t)row * 1024; g = p.g_mix; dst = p.A0 + (size_t)row * 1024; }
    else if (row < MT) { src = p.x_sample + (size_t)(row - MP) * 1024; g = p.g_mix; dst = p.A0 + (size_t)row * 1024; }
    else { src = p.mem_prompt + (size_t)(row - MT) * 1024; g = p.g_memkv; dst = p.Amem + (size_t)(row - MT) * 1024; }
    float4 v[4];
    float ss = 0.f;
#pragma unroll
    for (int i = 0; i < 4; ++i) { v[i] = *(const float4*)&src[lane * 4 + i * 256]; ss += v[i].x * v[i].x + v[i].y * v[i].y + v[i].z * v[i].z + v[i].w * v[i].w; }
    ss = wave_sum(ss);
    const float rs = rsqrtf(ss * (1.f / 1024.f) + EPS);
    float d8[8] = {0.f, 0.f, 0.f, 0.f, 0.f, 0.f, 0.f, 0.f};
#pragma unroll
    for (int i = 0; i < 4; ++i) {
      float4 g4 = *(const float4*)&g[lane * 4 + i * 256];
      float y[4] = {v[i].x * rs * g4.x, v[i].y * rs * g4.y, v[i].z * rs * g4.z, v[i].w * rs * g4.w};
      uint2 o; o.x = pack2(y[0], y[1]); o.y = pack2(y[2], y[3]);
      *(uint2*)&dst[lane * 4 + i * 256] = o;
      if (row < MT) {
#pragma unroll
        for (int e = 0; e < 4; ++e) {
          const float* wr = p.w_in + (size_t)(lane * 4 + i * 256 + e) * 4360 + 1536;
          float4 wa = *(const float4*)wr, wb = *(const float4*)(wr + 4);
          d8[0] += y[e] * wa.x; d8[1] += y[e] * wa.y; d8[2] += y[e] * wa.z; d8[3] += y[e] * wa.w;
          d8[4] += y[e] * wb.x; d8[5] += y[e] * wb.y; d8[6] += y[e] * wb.z; d8[7] += y[e] * wb.w;
        }
      }
    }
    if (row < MT) {
#pragma unroll
      for (int j = 0; j < 8; ++j) d8[j] = wave_sum(d8[j]);
      if (lane < 4) {
        float ag = sel4(lane, d8[0], d8[1], d8[2], d8[3]);
        float bg = sel4(lane, d8[4], d8[5], d8[6], d8[7]);
        float xs = ag + p.dt_bias[lane];
        float sp = (xs > 20.f) ? xs : log1pf(expf(xs));
        p.gb[(size_t)row * 8 + lane] = -expf(p.a_log[lane]) * sp;
        p.gb[(size_t)row * 8 + 4 + lane] = 1.f / (1.f + expf(-bg));
      }
    }
  }
  float* tile = (float*)smem;
  for (int j = blockIdx.x; j < 2816; j += gridDim.x) {
    int t = j;
    if (t < 1088) { int kt = t / 68, nt = t % 68; int n0 = nt * 64; tr_tile(p.w_in, 4360, n0 + (n0 >= 1536 ? 8 : 0), p.WtIn, 1024, kt * 64, n0, tile); continue; }
    t -= 1088;
    if (t < 192) { int kt = t / 16, nt = t % 16; tr_tile(p.w_out, 1024, nt * 64, p.WtOut, 768, kt * 64, nt * 64, tile); continue; }
    t -= 192;
    if (t < 256) { int kt = t / 16, nt = t % 16; tr_tile(p.w_mq, 1024, nt * 64, p.WtMq, 1024, kt * 64, nt * 64, tile); continue; }
    t -= 256;
    if (t < 512) { int kt = t / 32, nt = t % 32; tr_tile(p.w_mkv, 2048, nt * 64, p.WtMkv, 1024, kt * 64, nt * 64, tile); continue; }
    t -= 512;
    if (t < 256) { int kt = t / 16, nt = t % 16; tr_tile(p.w_mo, 1024, nt * 64, p.WtMo, 1024, kt * 64, nt * 64, tile); continue; }
    t -= 256;
    { int kt = t / 32, nt = t % 32; tr_tile(p.w_pq, 2048, nt * 64, p.WtPq, 1024, kt * 64, nt * 64, tile); }
  }
}

DI void dn_prep(const Params& p, int item, char* smem) {
  u16* qs = (u16*)smem;
  u16* ksm = qs + 64 * 136;
  float* sL = (float*)(ksm + 64 * 136);
  float* sgc = sL + 64 * 64;
  float* sbeta = sgc + 64;
  u16* sU = (u16*)sL;
  u16* sW = qs;
  const int tid = threadIdx.x, lane = tid & 63, w = tid >> 6, r = lane & 15, kg = lane >> 4;
  const int bh = item >> 7, n = item & 127, b = bh >> 2, h = bh & 3;
  const int t0 = n * 64;
  const size_t rowbase = (size_t)b * SEQ;
  char* ops = p.dnops + (size_t)item * DN_ITEM;
  __syncthreads();
  if (tid < 64) {
    float gv = p.gb[(rowbase + t0 + tid) * 8 + h];
    float bv = p.gb[(rowbase + t0 + tid) * 8 + 4 + h];
#pragma unroll
    for (int o = 1; o < 64; o <<= 1) { float t = __shfl_up(gv, o); if (lane >= o) gv += t; }
    sgc[tid] = gv; sbeta[tid] = bv;
    if (tid == 63) p.dl[item] = __expf(gv);
  }
#pragma unroll 1
  for (int ps = 0; ps < 8; ++ps) {
    const int combo = ps * 16 + (tid >> 4);
    const int tt = combo & 63, part = combo >> 6, sub = tid & 15;
    const int col = part * 512 + h * 128 + sub * 8;
    float y[8] = {0.f, 0.f, 0.f, 0.f, 0.f, 0.f, 0.f, 0.f};
#pragma unroll
    for (int j = 0; j < 4; ++j) {
      const int t = t0 + tt - 3 + j;
      if (t >= 0) {
        uint4 xv = *(const uint4*)&p.proj[(rowbase + t) * NP + col];
        float4 wa = *(const float4*)&p.conv_w[j * 1536 + col], wb = *(const float4*)&p.conv_w[j * 1536 + col + 4];
        y[0] += bflo(xv.x) * wa.x; y[1] += bfhi(xv.x) * wa.y; y[2] += bflo(xv.y) * wa.z; y[3] += bfhi(xv.y) * wa.w;
        y[4] += bflo(xv.z) * wb.x; y[5] += bfhi(xv.z) * wb.y; y[6] += bflo(xv.w) * wb.z; y[7] += bfhi(xv.w) * wb.w;
      }
    }
    float ss = 0.f;
#pragma unroll
    for (int e = 0; e < 8; ++e) { y[e] = siluf(y[e]); ss += y[e] * y[e]; }
    ss += __shfl_xor(ss, 1); ss += __shfl_xor(ss, 2); ss += __shfl_xor(ss, 4); ss += __shfl_xor(ss, 8);
    float sc = rsqrtf(ss + EPS) * (part == 0 ? 0.08838834764831845f : 1.f);
    uint4 o; o.x = pack2(y[0] * sc, y[1] * sc); o.y = pack2(y[2] * sc, y[3] * sc); o.z = pack2(y[4] * sc, y[5] * sc); o.w = pack2(y[6] * sc, y[7] * sc);
    *(uint4*)&((part == 0 ? qs : ksm)[tt * 136 + sub * 8]) = o;
  }
  __syncthreads();
  const float gcl = sgc[63];
  {
    f32x4 aL[4], aA[4];
#pragma unroll
    for (int i = 0; i < 4; ++i) { aL[i] = (f32x4){0.f, 0.f, 0.f, 0.f}; aA[i] = (f32x4){0.f, 0.f, 0.f, 0.f}; }
#pragma unroll
    for (int ks = 0; ks < 4; ++ks) {
      bf16x8 kI = *(const bf16x8*)&ksm[(w * 16 + r) * 136 + ks * 32 + kg * 8];
      bf16x8 qI = *(const bf16x8*)&qs[(w * 16 + r) * 136 + ks * 32 + kg * 8];
#pragma unroll
      for (int nt = 0; nt < 4; ++nt) {
        bf16x8 kJ = *(const bf16x8*)&ksm[(nt * 16 + r) * 136 + ks * 32 + kg * 8];
        aL[nt] = MFMA(kJ, kI, aL[nt]);
        aA[nt] = MFMA(kJ, qI, aA[nt]);
      }
    }
    const int i = w * 16 + r;
    const float gci = sgc[i], bi = sbeta[i];
    u16* aq = (u16*)(ops + 49152);
#pragma unroll
    for (int nt = 0; nt < 4; ++nt) {
      float lv[4], av[4];
#pragma unroll
      for (int jj = 0; jj < 4; ++jj) {
        const int j = nt * 16 + kg * 4 + jj;
        const float gam = (i >= j) ? __expf(gci - sgc[j]) : 0.f;
        lv[jj] = (i > j) ? aL[nt][jj] * bi * gam : 0.f;
        av[jj] = aA[nt][jj] * gam;
      }
      *(float4*)&sL[i * 64 + nt * 16 + kg * 4] = make_float4(lv[0], lv[1], lv[2], lv[3]);
      uint2 o; o.x = pack2(av[0], av[1]); o.y = pack2(av[2], av[3]);
      *(uint2*)&aq[((w * 2 + (nt >> 1)) * 64 + lane) * 8 + (nt & 1) * 4] = o;
    }
  }
  {
    u16* qg = (u16*)(ops + 16384);
    u16* kdT = (u16*)(ops + 32768);
#pragma unroll 1
    for (int i = 0; i < 4; ++i) {
      const int f = tid + 256 * i;
      const int mtks = f >> 6, l = f & 63, rr = l & 15, kgg = l >> 4;
      {
        const int mt = mtks >> 2, ks = mtks & 3, row = mt * 16 + rr;
        const float e = __expf(sgc[row]);
        uint2 a = *(const uint2*)&qs[row * 136 + ks * 32 + kgg * 4];
        uint2 c = *(const uint2*)&qs[row * 136 + ks * 32 + 16 + kgg * 4];
        uint4 o;
        o.x = pack2(bflo(a.x) * e, bfhi(a.x) * e); o.y = pack2(bflo(a.y) * e, bfhi(a.y) * e);
        o.z = pack2(bflo(c.x) * e, bfhi(c.x) * e); o.w = pack2(bflo(c.y) * e, bfhi(c.y) * e);
        *(uint4*)&qg[(size_t)f * 8] = o;
      }
      {
        const int mt = mtks >> 1, ks = mtks & 1, kdim = mt * 16 + rr;
        float v[8];
#pragma unroll
        for (int j = 0; j < 8; ++j) {
          const int c = ks * 32 + permk(kgg, j);
          v[j] = bf2f(ksm[c * 136 + kdim]) * __expf(gcl - sgc[c]);
        }
        uint4 o; o.x = pack2(v[0], v[1]); o.y = pack2(v[2], v[3]); o.z = pack2(v[4], v[5]); o.w = pack2(v[6], v[7]);
        *(uint4*)&kdT[(size_t)f * 8] = o;
      }
    }
  }
  __syncthreads();
  float x[64];
  if (tid < 128) {
    const int col = 1024 + h * 128 + tid;
    const float w0 = p.conv_w[col], w1 = p.conv_w[1536 + col], w2 = p.conv_w[3072 + col], w3 = p.conv_w[4608 + col];
    float xm3 = 0.f, xm2 = 0.f, xm1 = 0.f;
    if (t0 > 0) {
      xm3 = bf2f(p.proj[(rowbase + t0 - 3) * NP + col]);
      xm2 = bf2f(p.proj[(rowbase + t0 - 2) * NP + col]);
      xm1 = bf2f(p.proj[(rowbase + t0 - 1) * NP + col]);
    }
#pragma unroll
    for (int t = 0; t < 64; ++t) {
      float xc = bf2f(p.proj[(rowbase + t0 + t) * NP + col]);
      float yv = w0 * xm3 + w1 * xm2 + w2 * xm1 + w3 * xc;
      x[t] = siluf(yv) * sbeta[t];
      xm3 = xm2; xm2 = xm1; xm1 = xc;
    }
  } else {
    const int kc = tid - 128;
#pragma unroll
    for (int t = 0; t < 64; ++t) x[t] = bf2f(ksm[t * 136 + kc]) * sbeta[t] * __expf(sgc[t]);
  }
#pragma unroll
  for (int i = 1; i < 64; ++i) {
    float s = x[i];
#pragma unroll
    for (int j4 = 0; j4 < (i + 3) / 4; ++j4) {
      float4 l = *(const float4*)&sL[i * 64 + j4 * 4];
      s -= l.x * x[j4 * 4];
      if (j4 * 4 + 1 < i) s -= l.y * x[j4 * 4 + 1];
      if (j4 * 4 + 2 < i) s -= l.z * x[j4 * 4 + 2];
      if (j4 * 4 + 3 < i) s -= l.w * x[j4 * 4 + 3];
    }
    x[i] = s;
  }
  __syncthreads();
  if (tid < 128) {
#pragma unroll
    for (int t = 0; t < 64; ++t) sU[t * 128 + tid] = f2bf(x[t]);
  } else {
    const int kc = tid - 128;
#pragma unroll
    for (int t = 0; t < 64; ++t) sW[t * 136 + kc] = f2bf(-x[t]);
  }
  __syncthreads();
  {
    u16* nW = (u16*)ops;
    u16* u0 = (u16*)(ops + 57344);
#pragma unroll 1
    for (int i = 0; i < 4; ++i) {
      const int f = tid + 256 * i;
      const int mtks = f >> 6, l = f & 63, rr = l & 15, kgg = l >> 4;
      const int mt = mtks >> 2, ks = mtks & 3, row = mt * 16 + rr;
      uint2 a = *(const uint2*)&sW[row * 136 + ks * 32 + kgg * 4];
      uint2 c = *(const uint2*)&sW[row * 136 + ks * 32 + 16 + kgg * 4];
      *(uint4*)&nW[(size_t)f * 8] = make_uint4(a.x, a.y, c.x, c.y);
    }
#pragma unroll 1
    for (int i = 0; i < 8; ++i) {
      const int f = tid + 256 * i;
      const int smt = f >> 6, l = f & 63, rr = l & 15, kgg = l >> 4;
      const int s = smt >> 2, mt = smt & 3;
      u16 v0 = sU[(mt * 16 + kgg * 4 + 0) * 128 + s * 16 + rr];
      u16 v1 = sU[(mt * 16 + kgg * 4 + 1) * 128 + s * 16 + rr];
      u16 v2 = sU[(mt * 16 + kgg * 4 + 2) * 128 + s * 16 + rr];
      u16 v3 = sU[(mt * 16 + kgg * 4 + 3) * 128 + s * 16 + rr];
      *(uint2*)&u0[(size_t)f * 4] = make_uint2((unsigned)v0 | ((unsigned)v1 << 16), (unsigned)v2 | ((unsigned)v3 << 16));
    }
  }
}

DI void vt_tile(const Params& p, int item, char* smem) {
  u16* tile = (u16*)smem;
  const int tid = threadIdx.x;
  const int ptile = item & 127, gbh = item >> 7;
  const int h = gbh & 3, b = (gbh >> 2) & 3, g = gbh >> 4;
  const int dsh = g * 2, ln = SEQ >> dsh;
  const int pos0 = ptile * 64;
  const int rres = pos0 / ln, i0 = pos0 % ln;
  __syncthreads();
  {
    const int pr = tid >> 2, seg = (tid & 3) * 16;
    const int token = ((i0 + pr) << dsh) + rres;
    const u16* src = &p.proj[((size_t)b * SEQ + token) * NP + 2048 + g * 768 + 512 + h * 64 + seg];
    uint4 a = *(const uint4*)src, c = *(const uint4*)(src + 8);
    unsigned d[8] = {a.x, a.y, a.z, a.w, c.x, c.y, c.z, c.w};
#pragma unroll
    for (int e = 0; e < 8; ++e) *(unsigned*)&tile[pr * 66 + seg + e * 2] = d[e];
  }
  __syncthreads();
  {
    const int dh = tid >> 2, seg = (tid & 3) * 16;
    unsigned o[8];
#pragma unroll
    for (int e = 0; e < 8; ++e) o[e] = (unsigned)tile[(seg + 2 * e) * 66 + dh] | ((unsigned)tile[(seg + 2 * e + 1) * 66 + dh] << 16);
    u16* d = &p.vT[((size_t)gbh * 64 + dh) * SEQ + pos0 + seg];
    *(uint4*)d = make_uint4(o[0], o[1], o[2], o[3]);
    *(uint4*)(d + 8) = make_uint4(o[4], o[5], o[6], o[7]);
  }
}

DI void dn_sample(const Params& p, int item, char* smem) {
  float* sq = (float*)smem;
  float* sk = sq + 512;
  float* sv = sk + 512;
  float* red = sv + 512;
  const int tid = threadIdx.x, lane = tid & 63, w = tid >> 6;
  const int b = item >> 2, h = item & 3;
  __syncthreads();
  for (int c = tid; c < 384; c += 256) {
    const int part = c >> 7, cc = c & 127;
    const int col = part * 512 + h * 128 + cc;
    float xp[7];
#pragma unroll
    for (int j = 0; j < 3; ++j) xp[j] = p.state_conv[((size_t)b * 3 + j) * 1536 + col];
#pragma unroll
    for (int j = 0; j < 4; ++j) xp[3 + j] = bf2f(p.proj[((size_t)MP + b * 4 + j) * NP + col]);
    const float w0 = p.conv_w[col], w1 = p.conv_w[1536 + col], w2 = p.conv_w[3072 + col], w3 = p.conv_w[4608 + col];
    float* dst = part == 0 ? sq : (part == 1 ? sk : sv);
#pragma unroll
    for (int t = 0; t < 4; ++t) dst[t * 128 + cc] = siluf(w0 * xp[t] + w1 * xp[t + 1] + w2 * xp[t + 2] + w3 * xp[t + 3]);
  }
  __syncthreads();
  {
    float a0 = sq[w * 128 + lane], a1 = sq[w * 128 + 64 + lane];
    float s = wave_sum(a0 * a0 + a1 * a1);
    float sc = rsqrtf(s + EPS) * 0.08838834764831845f;
    sq[w * 128 + lane] = a0 * sc; sq[w * 128 + 64 + lane] = a1 * sc;
    float b0 = sk[w * 128 + lane], b1 = sk[w * 128 + 64 + lane];
    s = wave_sum(b0 * b0 + b1 * b1);
    sc = rsqrtf(s + EPS);
    sk[w * 128 + lane] = b0 * sc; sk[w * 128 + 64 + lane] = b1 * sc;
  }
  __syncthreads();
  const int v = tid & 127, half = tid >> 7;
  float S[64];
  const float* s0 = p.state_delta + (((size_t)b * 4 + h) * 128 + half * 64) * 128 + v;
#pragma unroll
  for (int i = 0; i < 64; ++i) S[i] = s0[(size_t)i * 128];
#pragma unroll 1
  for (int t = 0; t < 4; ++t) {
    const size_t row = (size_t)MP + b * 4 + t;
    const float a = __expf(p.gb[row * 8 + h]);
    const float beta = p.gb[row * 8 + 4 + h];
    float part = 0.f;
#pragma unroll
    for (int i = 0; i < 64; ++i) part += S[i] * sk[t * 128 + half * 64 + i];
    red[half * 128 + v] = part;
    __syncthreads();
    const float kS = red[v] + red[128 + v];
    const float u = beta * (sv[t * 128 + v] - a * kS);
    float po = 0.f;
#pragma unroll
    for (int i = 0; i < 64; ++i) { S[i] = a * S[i] + sk[t * 128 + half * 64 + i] * u; po += S[i] * sq[t * 128 + half * 64 + i]; }
    __syncthreads();
    red[half * 128 + v] = po;
    __syncthreads();
    if (half == 0) p.odn[row * 512 + h * 128 + v] = f2bf(red[v] + red[128 + v]);
    __syncthreads();
  }
  float* d = p.out + O_SDELTA + (((size_t)b * 4 + h) * 128 + half * 64) * 128 + v;
#pragma unroll
  for (int i = 0; i < 64; ++i) d[(size_t)i * 128] = S[i];
}

DI void phase2(const Params& p, char* smem) {
  const size_t gtid = (size_t)blockIdx.x * 256 + threadIdx.x, gsz = (size_t)gridDim.x * 256;
  for (int j = blockIdx.x; j < 2048 + 128 + 6144; j += gridDim.x) {
    if (j < 2048) dn_prep(p, j, smem);
    else if (j < 2048 + 128) dn_sample(p, j - 2048, smem);
    else vt_tile(p, j - 2176, smem);
  }
  for (size_t f = gtid; f < (size_t)16 * 8192; f += gsz) {
    {
      const size_t e0 = f * 8;
      const int bh = (int)(e0 >> 16), key = (int)((e0 >> 8) & 255), dh = (int)(e0 & 255);
      const int b = bh >> 2, h = bh & 3;
      cvt8(p.out + O_PMEM + (((size_t)b * 256 + key) * 2 + 0) * 1024 + h * 256 + dh, p.Kb + e0);
    }
    {
      const int l = (int)(f & 63), ks = (int)((f >> 6) & 7), nt = (int)((f >> 9) & 15), bh = (int)(f >> 13);
      const int b = bh >> 2, h = bh & 3, rr = l & 15, kgg = l >> 4;
      float v[8];
#pragma unroll
      for (int j = 0; j < 8; ++j) {
        const int key = ks * 32 + permk(kgg, j);
        v[j] = p.out[O_PMEM + (((size_t)b * 256 + key) * 2 + 1) * 1024 + h * 256 + nt * 16 + rr];
      }
      *(uint4*)&p.VTf[f * 8] = make_uint4(pack2(v[0], v[1]), pack2(v[2], v[3]), pack2(v[4], v[5]), pack2(v[6], v[7]));
    }
  }
  for (size_t i = gtid; i < 18432; i += gsz) {
    const int c = (int)(i % 1536), j = (int)((i / 1536) % 3), b = (int)(i / 4608);
    p.out[O_PCONV + i] = bf2f(p.proj[((size_t)b * SEQ + SEQ - 3 + j) * NP + c]);
  }
  for (int g = 0; g < 3; ++g) {
    const int W = 128 << (2 * g);
    const size_t off = (g == 0) ? O_PW1 : (g == 1 ? O_PW2 : O_PW3);
    const size_t n4 = (size_t)4 * W * 512 / 4;
    for (size_t i = gtid; i < n4; i += gsz) {
      const size_t e0 = i * 4;
      const int e = (int)(e0 & 511), ii = (int)((e0 >> 9) % W), b = (int)((e0 >> 9) / W);
      uint2 v = *(const uint2*)&p.proj[((size_t)b * SEQ + SEQ - W + ii) * NP + 2048 + g * 768 + 256 + e];
      *(float4*)&p.out[off + e0] = make_float4(bflo(v.x), bfhi(v.x), bflo(v.y), bfhi(v.y));
    }
  }
}

DI void dn_scan_wave(const Params& p, int widx) {
  const int lane = threadIdx.x & 63, r = lane & 15, kg = lane >> 4;
  const int bh = widx >> 3, s = widx & 7, b = bh >> 2, h = bh & 3;
  f32x4 S[8];
#pragma unroll
  for (int i = 0; i < 8; ++i) S[i] = (f32x4){0.f, 0.f, 0.f, 0.f};
#pragma unroll 1
  for (int n = 0; n < 128; ++n) {
    const char* base = p.dnops + (size_t)(bh * 128 + n) * DN_ITEM;
    const bf16x8* negW = (const bf16x8*)base;
    const bf16x8* qg = (const bf16x8*)(base + 16384);
    const bf16x8* kdT = (const bf16x8*)(base + 32768);
    const bf16x8* aqk = (const bf16x8*)(base + 49152);
    const uint2* u0 = (const uint2*)(base + 57344);
    const float dl = p.dl[bh * 128 + n];
    bf16x8 Sb[4];
#pragma unroll
    for (int ks = 0; ks < 4; ++ks) Sb[ks] = pack8(S[2 * ks], S[2 * ks + 1]);
    f32x4 u[4];
#pragma unroll
    for (int mt = 0; mt < 4; ++mt) {
      uint2 t = u0[(s * 4 + mt) * 64 + lane];
      u[mt] = (f32x4){bflo(t.x), bfhi(t.x), bflo(t.y), bfhi(t.y)};
#pragma unroll
      for (int ks = 0; ks < 4; ++ks) u[mt] = MFMA(negW[(mt * 4 + ks) * 64 + lane], Sb[ks], u[mt]);
    }
    bf16x8 ub[2];
    ub[0] = pack8(u[0], u[1]); ub[1] = pack8(u[2], u[3]);
#pragma unroll
    for (int mt = 0; mt < 4; ++mt) {
      f32x4 o = (f32x4){0.f, 0.f, 0.f, 0.f};
#pragma unroll
      for (int ks = 0; ks < 4; ++ks) o = MFMA(qg[(mt * 4 + ks) * 64 + lane], Sb[ks], o);
#pragma unroll
      for (int k2 = 0; k2 < 2; ++k2) o = MFMA(aqk[(mt * 2 + k2) * 64 + lane], ub[k2], o);
#pragma unroll
      for (int j = 0; j < 4; ++j) {
        const size_t token = (size_t)b * SEQ + n * 64 + mt * 16 + kg * 4 + j;
        p.odn[token * 512 + h * 128 + s * 16 + r] = f2bf(o[j]);
      }
    }
#pragma unroll
    for (int m8 = 0; m8 < 8; ++m8) {
      S[m8] = S[m8] * dl;
#pragma unroll
      for (int k2 = 0; k2 < 2; ++k2) S[m8] = MFMA(kdT[(m8 * 2 + k2) * 64 + lane], ub[k2], S[m8]);
    }
  }
#pragma unroll
  for (int m8 = 0; m8 < 8; ++m8)
#pragma unroll
    for (int j = 0; j < 4; ++j)
      p.out[O_PDELTA + ((size_t)bh * 128 + m8 * 16 + kg * 4 + j) * 128 + s * 16 + r] = S[m8][j];
}

DI void sw_prompt_wave(const Params& p, int item) {
  const int lane = threadIdx.x & 63, r = lane & 15, kg = lane >> 4;
  const int qt = item & 511, gbh = item >> 9;
  const int h = gbh & 3, b = (gbh >> 2) & 3, g = gbh >> 4;
  const int dsh = 2 * g, ln = SEQ >> dsh;
  const int pos0 = qt * 16, rres = pos0 / ln, i0 = pos0 % ln;
  const int kbase = i0 - 144;
  const size_t rb = (size_t)b * SEQ;
  const int qoff = 2048 + g * 768 + h * 64, koff = qoff + 256;
  bf16x8 qf[2];
  {
    const size_t tok = rb + ((size_t)(i0 + r) << dsh) + rres;
#pragma unroll
    for (int ks = 0; ks < 2; ++ks) qf[ks] = *(const bf16x8*)&p.proj[tok * NP + qoff + ks * 32 + kg * 8];
  }
  f32x4 st[10];
#pragma unroll
  for (int mt = 0; mt < 10; ++mt) {
    int ki = kbase + mt * 16 + r; ki = ki < 0 ? 0 : ki;
    const size_t tok = rb + ((size_t)ki << dsh) + rres;
    f32x4 a = (f32x4){0.f, 0.f, 0.f, 0.f};
#pragma unroll
    for (int ks = 0; ks < 2; ++ks) {
      bf16x8 kf = *(const bf16x8*)&p.proj[tok * NP + koff + ks * 32 + kg * 8];
      a = MFMA(kf, qf[ks], a);
    }
    st[mt] = a;
  }
  const int qi = i0 + r;
  float mx = -3.0e38f;
#pragma unroll
  for (int mt = 0; mt < 10; ++mt)
#pragma unroll
    for (int j = 0; j < 4; ++j) {
      const int ki = kbase + mt * 16 + kg * 4 + j;
      const int d = qi - ki;
      const bool valid = (ki >= 0) && (d >= 0) && (d <= 128);
      const float sv = valid ? st[mt][j] * 0.125f : -3.0e38f;
      st[mt][j] = sv;
      mx = fmaxf(mx, sv);
    }
  mx = fmaxf(mx, __shfl_xor(mx, 16));
  mx = fmaxf(mx, __shfl_xor(mx, 32));
  float sum = 0.f;
#pragma unroll
  for (int mt = 0; mt < 10; ++mt)
#pragma unroll
    for (int j = 0; j < 4; ++j) {
      const float pv = (st[mt][j] > -1.0e38f) ? __expf(st[mt][j] - mx) : 0.f;
      st[mt][j] = pv;
      sum += pv;
    }
  sum += __shfl_xor(sum, 16);
  sum += __shfl_xor(sum, 32);
  const float inv = 1.f / sum;
  bf16x8 pf[5];
#pragma unroll
  for (int k2 = 0; k2 < 5; ++k2) pf[k2] = pack8(st[2 * k2], st[2 * k2 + 1]);
  const size_t qrow = rb + ((size_t)qi << dsh) + rres;
#pragma unroll
  for (int nt = 0; nt < 4; ++nt) {
    f32x4 o = (f32x4){0.f, 0.f, 0.f, 0.f};
    const u16* vrow = &p.vT[((size_t)gbh * 64 + nt * 16 + r) * SEQ + (size_t)rres * ln];
#pragma unroll
    for (int k2 = 0; k2 < 5; ++k2) {
      int ka = kbase + k2 * 32 + kg * 4, kc = ka + 16;
      ka = ka < 0 ? 0 : ka; kc = kc < 0 ? 0 : kc;
      uint2 va = *(const uint2*)&vrow[ka];
      uint2 vc = *(const uint2*)&vrow[kc];
      bf16x8 vf = __builtin_bit_cast(bf16x8, make_uint4(va.x, va.y, vc.x, vc.y));
      o = MFMA(vf, pf[k2], o);
    }
    uint2 ov; ov.x = pack2(o[0] * inv, o[1] * inv); ov.y = pack2(o[2] * inv, o[3] * inv);
    *(uint2*)&p.osw[((size_t)g * MT + qrow) * 256 + h * 64 + nt * 16 + kg * 4] = ov;
  }
  if (kg == 0) p.lse[((size_t)g * MT + qrow) * 4 + h] = mx + __logf(sum);
}

DI void sw_sample_wave(const Params& p, int item) {
  const int lane = threadIdx.x & 63;
  const int t = item & 3, h = (item >> 2) & 3, b = (item >> 4) & 31, g = item >> 9;
  const int dil = 1 << (2 * g), W = 128 << (2 * g);
  const float* cache = (g == 0) ? p.cw1 : (g == 1 ? p.cw2 : p.cw3);
  const int qoff = 2048 + g * 768 + h * 64;
  const size_t qrow = (size_t)MP + b * 4 + t;
  float q[64];
#pragma unroll
  for (int c = 0; c < 64; c += 8) {
    uint4 v = *(const uint4*)&p.proj[qrow * NP + qoff + c];
    q[c] = bflo(v.x); q[c + 1] = bfhi(v.x); q[c + 2] = bflo(v.y); q[c + 3] = bfhi(v.y);
    q[c + 4] = bflo(v.z); q[c + 5] = bfhi(v.z); q[c + 6] = bflo(v.w); q[c + 7] = bfhi(v.w);
  }
  float sc[3];
#pragma unroll
  for (int mi = 0; mi < 3; ++mi) {
    const int m = lane + 64 * mi;
    float s = -3.0e38f;
    if (m <= 128) {
      const int j = W + t - m * dil;
      float d = 0.f;
      if (j >= W) {
        const u16* kr = &p.proj[((size_t)MP + b * 4 + (j - W)) * NP + qoff + 256];
#pragma unroll
        for (int c = 0; c < 64; c += 8) {
          uint4 v = *(const uint4*)&kr[c];
          d += q[c] * bflo(v.x) + q[c + 1] * bfhi(v.x) + q[c + 2] * bflo(v.y) + q[c + 3] * bfhi(v.y) + q[c + 4] * bflo(v.z) +
               q[c + 5] * bfhi(v.z) + q[c + 6] * bflo(v.w) + q[c + 7] * bfhi(v.w);
        }
      } else {
        const float* kr = &cache[(((size_t)b * W + j) * 2 + 0) * 256 + h * 64];
#pragma unroll
        for (int c = 0; c < 64; c += 4) {
          float4 v = *(const float4*)&kr[c];
          d += q[c] * v.x + q[c + 1] * v.y + q[c + 2] * v.z + q[c + 3] * v.w;
        }
      }
      s = d * 0.125f;
    }
    sc[mi] = s;
  }
  float mx = wave_max(fmaxf(fmaxf(sc[0], sc[1]), sc[2]));
  float sum = 0.f;
#pragma unroll
  for (int mi = 0; mi < 3; ++mi) { sc[mi] = (sc[mi] > -1.0e38f) ? __expf(sc[mi] - mx) : 0.f; sum += sc[mi]; }
  sum = wave_sum(sum);
  float o = 0.f;
#pragma unroll 1
  for (int m = 0; m <= 128; ++m) {
    const float pv = (m < 64) ? __shfl(sc[0], m) : ((m < 128) ? __shfl(sc[1], m - 64) : __shfl(sc[2], 0));
    const int j = W + t - m * dil;
    float vv;
    if (j >= W) vv = bf2f(p.proj[((size_t)MP + b * 4 + (j - W)) * NP + qoff + 512 + lane]);
    else vv = cache[(((size_t)b * W + j) * 2 + 1) * 256 + h * 64 + lane];
    o += pv * vv;
  }
  p.osw[((size_t)g * MT + qrow) * 256 + h * 64 + lane] = f2bf(o / sum);
  if (lane == 0) p.lse[((size_t)g * MT + qrow) * 4 + h] = mx + __logf(sum);
}

DI void phase3(const Params& p) {
  const int w = threadIdx.x >> 6;
  if (blockIdx.x < 32) {
    dn_scan_wave(p, blockIdx.x * 4 + w);
  } else {
    const int gw = (blockIdx.x - 32) * 4 + w, nw = (gridDim.x - 32) * 4;
    for (int it = gw; it < 24576 + 1536; it += nw) {
      if (it < 24576) sw_prompt_wave(p, it);
      else sw_sample_wave(p, it - 24576);
    }
  }
}

DI void phase4(const Params& p) {
  const int lane = threadIdx.x & 63, w = threadIdx.x >> 6;
  for (int row = blockIdx.x * 4 + w; row < MT; row += gridDim.x * 4) {
    u16* dst = p.Amix + (size_t)row * 768;
#pragma unroll
    for (int h = 0; h < 4; ++h) {
      unsigned ov = *(const unsigned*)&p.odn[(size_t)row * 512 + h * 128 + lane * 2];
      unsigned zv = *(const unsigned*)&p.proj[(size_t)row * NP + 1536 + h * 128 + lane * 2];
      float o0 = bflo(ov), o1 = bfhi(ov);
      float ss = wave_sum(o0 * o0 + o1 * o1);
      float rs = rsqrtf(ss * (1.f / 128.f) + EPS);
      float2 gn = *(const float2*)&p.g_onorm[lane * 2];
      float y0 = o0 * rs * gn.x * siluf(bflo(zv)), y1 = o1 * rs * gn.y * siluf(bfhi(zv));
      *(unsigned*)&dst[h * 128 + lane * 2] = pack2(y0, y1);
    }
    {
      const int h = lane >> 4;
      float l0 = p.lse[((size_t)0 * MT + row) * 4 + h], l1 = p.lse[((size_t)1 * MT + row) * 4 + h], l2 = p.lse[((size_t)2 * MT + row) * 4 + h];
      float m = fmaxf(l0, fmaxf(l1, l2));
      float e0 = __expf(l0 - m), e1 = __expf(l1 - m), e2 = __expf(l2 - m);
      float inv = 1.f / (e0 + e1 + e2);
      uint2 a = *(const uint2*)&p.osw[((size_t)0 * MT + row) * 256 + lane * 4];
      uint2 c = *(const uint2*)&p.osw[((size_t)1 * MT + row) * 256 + lane * 4];
      uint2 d = *(const uint2*)&p.osw[((size_t)2 * MT + row) * 256 + lane * 4];
      e0 *= inv; e1 *= inv; e2 *= inv;
      float y0 = e0 * bflo(a.x) + e1 * bflo(c.x) + e2 * bflo(d.x);
      float y1 = e0 * bfhi(a.x) + e1 * bfhi(c.x) + e2 * bfhi(d.x);
      float y2 = e0 * bflo(a.y) + e1 * bflo(c.y) + e2 * bflo(d.y);
      float y3 = e0 * bfhi(a.y) + e1 * bfhi(c.y) + e2 * bfhi(d.y);
      *(uint2*)&dst[512 + lane * 4] = make_uint2(pack2(y0, y1), pack2(y2, y3));
    }
  }
}

DI void sample_state_copy(const Params& p) {
  const size_t gtid = (size_t)blockIdx.x * 256 + threadIdx.x, gsz = (size_t)gridDim.x * 256;
  for (size_t i = gtid; i < 147456; i += gsz) {
    const int c = (int)(i % 1536), j = (int)((i / 1536) % 3), b = (int)(i / 4608);
    p.out[O_SCONV + i] = bf2f(p.proj[((size_t)MP + b * 4 + j + 1) * NP + c]);
  }
  for (int g = 0; g < 3; ++g) {
    const int W = 128 << (2 * g);
    const float* cache = (g == 0) ? p.cw1 : (g == 1 ? p.cw2 : p.cw3);
    const size_t off = (g == 0) ? O_SW1 : (g == 1 ? O_SW2 : O_SW3);
    const size_t n4 = (size_t)32 * W * 512 / 4;
    for (size_t i = gtid; i < n4; i += gsz) {
      const size_t e0 = i * 4;
      const int e = (int)(e0 & 511), ii = (int)((e0 >> 9) % W), b = (int)((e0 >> 9) / W);
      float4 o;
      if (ii < W - 4) o = *(const float4*)&cache[((size_t)b * W + ii + 4) * 512 + e];
      else {
        uint2 v = *(const uint2*)&p.proj[((size_t)MP + b * 4 + (ii - (W - 4))) * NP + 2048 + g * 768 + 256 + e];
        o = make_float4(bflo(v.x), bfhi(v.x), bflo(v.y), bfhi(v.y));
      }
      *(float4*)&p.out[off + e0] = o;
    }
  }
}

DI void mem_attn_prompt_wave(const Params& p, int item) {
  const int lane = threadIdx.x & 63, r = lane & 15, kg = lane >> 4;
  const int h = item & 3, qt = item >> 2;
  const int row0 = qt * 16, b = row0 >> 13;
  const int bh = b * 4 + h;
  bf16x8 qf[8];
#pragma unroll
  for (int ks = 0; ks < 8; ++ks) qf[ks] = *(const bf16x8*)&p.qb[(size_t)(row0 + r) * 1024 + h * 256 + ks * 32 + kg * 8];
  f32x4 st[16];
  const u16* kbp = p.Kb + (size_t)bh * 65536;
#pragma unroll
  for (int mt = 0; mt < 16; ++mt) {
    f32x4 a = (f32x4){0.f, 0.f, 0.f, 0.f};
#pragma unroll
    for (int ks = 0; ks < 8; ++ks) {
      bf16x8 kf = *(const bf16x8*)&kbp[(mt * 16 + r) * 256 + ks * 32 + kg * 8];
      a = MFMA(kf, qf[ks], a);
    }
    st[mt] = a;
  }
  float mx = -3.0e38f;
#pragma unroll
  for (int mt = 0; mt < 16; ++mt)
#pragma unroll
    for (int j = 0; j < 4; ++j) { st[mt][j] *= 0.0625f; mx = fmaxf(mx, st[mt][j]); }
  mx = fmaxf(mx, __shfl_xor(mx, 16));
  mx = fmaxf(mx, __shfl_xor(mx, 32));
  float sum = 0.f;
#pragma unroll
  for (int mt = 0; mt < 16; ++mt)
#pragma unroll
    for (int j = 0; j < 4; ++j) { st[mt][j] = __expf(st[mt][j] - mx); sum += st[mt][j]; }
  sum += __shfl_xor(sum, 16);
  sum += __shfl_xor(sum, 32);
  const float inv = 1.f / sum;
  bf16x8 pf[8];
#pragma unroll
  for (int k2 = 0; k2 < 8; ++k2) pf[k2] = pack8(st[2 * k2], st[2 * k2 + 1]);
  const bf16x8* vt = (const bf16x8*)(p.VTf + (size_t)bh * 65536);
#pragma unroll 4
  for (int nt = 0; nt < 16; ++nt) {
    f32x4 o = (f32x4){0.f, 0.f, 0.f, 0.f};
#pragma unroll
    for (int k2 = 0; k2 < 8; ++k2) o = MFMA(vt[(nt * 8 + k2) * 64 + lane], pf[k2], o);
    uint2 ov; ov.x = pack2(o[0] * inv, o[1] * inv); ov.y = pack2(o[2] * inv, o[3] * inv);
    *(uint2*)&p.attn[(size_t)(row0 + r) * 1024 + h * 256 + nt * 16 + kg * 4] = ov;
  }
}

DI void mem_attn_sample_wave(const Params& p, int item, float* lds) {
  const int lane = threadIdx.x & 63;
  const int b = item >> 2, h = item & 3;
  float* sq = lds;
#pragma unroll
  for (int t = 0; t < 4; ++t) {
    uint2 v = *(const uint2*)&p.qb[((size_t)MP + b * 4 + t) * 1024 + h * 256 + lane * 4];
    *(float4*)&sq[t * 256 + lane * 4] = make_float4(bflo(v.x), bfhi(v.x), bflo(v.y), bfhi(v.y));
  }
  __builtin_amdgcn_s_waitcnt(0);
  __builtin_amdgcn_wave_barrier();
  float sc[4][4];
#pragma unroll
  for (int mi = 0; mi < 4; ++mi) {
    const int m = lane + 64 * mi;
    const float* kr = &p.cache_mem[(((size_t)b * 256 + m) * 2 + 0) * 1024 + h * 256];
    float d0 = 0.f, d1 = 0.f, d2 = 0.f, d3 = 0.f;
#pragma unroll 8
    for (int c = 0; c < 256; c += 4) {
      float4 kv = *(const float4*)&kr[c];
      float4 q0 = *(const float4*)&sq[c], q1 = *(const float4*)&sq[256 + c], q2 = *(const float4*)&sq[512 + c], q3 = *(const float4*)&sq[768 + c];
      d0 += kv.x * q0.x + kv.y * q0.y + kv.z * q0.z + kv.w * q0.w;
      d1 += kv.x * q1.x + kv.y * q1.y + kv.z * q1.z + kv.w * q1.w;
      d2 += kv.x * q2.x + kv.y * q2.y + kv.z * q2.z + kv.w * q2.w;
      d3 += kv.x * q3.x + kv.y * q3.y + kv.z * q3.z + kv.w * q3.w;
    }
    sc[0][mi] = d0 * 0.0625f; sc[1][mi] = d1 * 0.0625f; sc[2][mi] = d2 * 0.0625f; sc[3][mi] = d3 * 0.0625f;
  }
  float inv[4];
  __builtin_amdgcn_wave_barrier();
#pragma unroll
  for (int t = 0; t < 4; ++t) {
    float mx = wave_max(fmaxf(fmaxf(sc[t][0], sc[t][1]), fmaxf(sc[t][2], sc[t][3])));
    float sum = 0.f;
#pragma unroll
    for (int mi = 0; mi < 4; ++mi) { sc[t][mi] = __expf(sc[t][mi] - mx); sum += sc[t][mi]; }
    sum = wave_sum(sum);
    inv[t] = 1.f / sum;
#pragma unroll
    for (int mi = 0; mi < 4; ++mi) sq[t * 256 + lane + 64 * mi] = sc[t][mi];
  }
  __builtin_amdgcn_s_waitcnt(0);
  __builtin_amdgcn_wave_barrier();
  float4 o[4];
#pragma unroll
  for (int t = 0; t < 4; ++t) o[t] = make_float4(0.f, 0.f, 0.f, 0.f);
#pragma unroll 4
  for (int m = 0; m < 256; ++m) {
    float4 vv = *(const float4*)&p.cache_mem[(((size_t)b * 256 + m) * 2 + 1) * 1024 + h * 256 + lane * 4];
#pragma unroll
    for (int t = 0; t < 4; ++t) {
      const float pv = sq[t * 256 + m];
      o[t].x += pv * vv.x; o[t].y += pv * vv.y; o[t].z += pv * vv.z; o[t].w += pv * vv.w;
    }
  }
#pragma unroll
  for (int t = 0; t < 4; ++t) {
    uint2 ov; ov.x = pack2(o[t].x * inv[t], o[t].y * inv[t]); ov.y = pack2(o[t].z * inv[t], o[t].w * inv[t]);
    *(uint2*)&p.attn[((size_t)MP + b * 4 + t) * 1024 + h * 256 + lane * 4] = ov;
  }
  __builtin_amdgcn_wave_barrier();
}

DI void phase7(const Params& p, char* smem) {
  const int w = threadIdx.x >> 6;
  const int gw = blockIdx.x * 4 + w, nw = gridDim.x * 4;
  float* lds = (float*)smem + w * 1280;
  for (int it = gw; it < 128 + 8192; it += nw) {
    if (it < 128) mem_attn_sample_wave(p, it, lds);
    else mem_attn_prompt_wave(p, it - 128);
  }
}

DI void peer_topk_wave(const Params& p, int item, unsigned* lds  ) {
  const int lane = threadIdx.x & 63, r = lane & 15, kg = lane >> 4;
  const int h = item & 7, row0 = (item >> 3) * 16;
  unsigned win[2][16];
#pragma unroll
  for (int pp = 0; pp < 2; ++pp) {
    bf16x8 qf[4];
#pragma unroll
    for (int ks = 0; ks < 4; ++ks) qf[ks] = *(const bf16x8*)&p.pq[(size_t)(row0 + r) * 2048 + h * 256 + pp * 128 + ks * 32 + kg * 8];
    unsigned kk[32];
    const u16* sk = p.subkb + (size_t)(h * 2 + pp) * 16384;
#pragma unroll
    for (int mt = 0; mt < 8; ++mt) {
      f32x4 a = (f32x4){0.f, 0.f, 0.f, 0.f};
#pragma unroll
      for (int ks = 0; ks < 4; ++ks) {
        bf16x8 kf = *(const bf16x8*)&sk[(mt * 16 + r) * 128 + ks * 32 + kg * 8];
        a = MFMA(kf, qf[ks], a);
      }
#pragma unroll
      for (int j = 0; j < 4; ++j) kk[mt * 4 + j] = (ordf(a[j]) & ~127u) | (unsigned)(mt * 16 + kg * 4 + j);
    }
#pragma unroll
    for (int rr = 0; rr < 16; ++rr) {
      unsigned m = 0;
#pragma unroll
      for (int i = 0; i < 32; ++i) m = umax(m, kk[i]);
      m = umax(m, (unsigned)__shfl_xor((int)m, 16));
      m = umax(m, (unsigned)__shfl_xor((int)m, 32));
      win[pp][rr] = m;
#pragma unroll
      for (int i = 0; i < 32; ++i) kk[i] = (kk[i] == m) ? 0u : kk[i];
    }
  }
  float f0[16], f1[16];
#pragma unroll
  for (int i = 0; i < 16; ++i) { f0[i] = unordf(win[0][i] & ~127u); f1[i] = unordf(win[1][i] & ~127u); }
  unsigned cand[13];
#define CAND(s, a0, b0, a1, b1, a2, b2, a3, b3)                                                         \
  {                                                                                                     \
    float va = sel4(kg, f0[a0], f0[a1], f0[a2], f0[(a3) < 0 ? 0 : (a3)]);                                \
    float vb = sel4(kg, f1[b0], f1[b1], f1[b2], f1[(b3) < 0 ? 0 : (b3)]);                                \
    unsigned id = sel4(kg, (unsigned)((a0) * 16 + (b0)), (unsigned)((a1) * 16 + (b1)), (unsigned)((a2) * 16 + (b2)), (unsigned)(((a3) < 0 ? 0 : (a3)) * 16 + ((b3) < 0 ? 0 : (b3)))); \
    unsigned key = (ordf(va + vb) & ~255u) | id;                                                        \
    if ((a3) < 0) key = (kg == 3) ? 0u : key;                                                           \
    cand[s] = key;                                                                                      \
  }
  CAND(0, 0, 0, 0, 13, 2, 0, 6, 1)
  CAND(1, 0, 1, 0, 14, 2, 1, 7, 0)
  CAND(2, 0, 2, 0, 15, 2, 2, 7, 1)
  CAND(3, 0, 3, 1, 0, 2, 3, 8, 0)
  CAND(4, 0, 4, 1, 1, 2, 4, 9, 0)
  CAND(5, 0, 5, 1, 2, 3, 0, 10, 0)
  CAND(6, 0, 6, 1, 3, 3, 1, 11, 0)
  CAND(7, 0, 7, 1, 4, 3, 2, 12, 0)
  CAND(8, 0, 8, 1, 5, 3, 3, 13, 0)
  CAND(9, 0, 9, 1, 6, 4, 2, 14, 0)
  CAND(10, 0, 10, 1, 7, 5, 0, 15, 0)
  CAND(11, 0, 11, 4, 0, 5, 1, -1, -1)
  CAND(12, 0, 12, 4, 1, 6, 0, -1, -1)
#undef CAND
  unsigned w2[16];
#pragma unroll
  for (int rr = 0; rr < 16; ++rr) {
    unsigned m = 0;
#pragma unroll
    for (int i = 0; i < 13; ++i) m = umax(m, cand[i]);
    m = umax(m, (unsigned)__shfl_xor((int)m, 16));
    m = umax(m, (unsigned)__shfl_xor((int)m, 32));
    w2[rr] = m;
#pragma unroll
    for (int i = 0; i < 13; ++i) cand[i] = (cand[i] == m) ? 0u : cand[i];
  }
  if (kg == 0) {
#pragma unroll
    for (int i = 0; i < 16; ++i) { lds[r * 32 + i] = win[0][i] & 127u; lds[r * 32 + 16 + i] = win[1][i] & 127u; }
  }
  __builtin_amdgcn_s_waitcnt(0);
  __builtin_amdgcn_wave_barrier();
  const float cv0 = unordf(w2[0] & ~255u);
  float sum = 0.f;
#pragma unroll
  for (int rr = 0; rr < 16; ++rr) sum += __expf(unordf(w2[rr] & ~255u) - cv0);
  const float inv = 1.f / sum;
  const size_t ob = ((size_t)(row0 + r) * 8 + h) * 16;
#pragma unroll
  for (int q = 0; q < 4; ++q) {
    const unsigned wk = sel4(kg, w2[q], w2[4 + q], w2[8 + q], w2[12 + q]);
    const int a = (wk >> 4) & 15, bb = wk & 15;
    const int i1 = (int)lds[r * 32 + a], i2 = (int)lds[r * 32 + 16 + bb];
    p.eid[ob + kg * 4 + q] = i1 * 128 + i2;
    p.gate[ob + kg * 4 + q] = __expf(unordf(wk & ~255u) - cv0) * inv;
  }
  __builtin_amdgcn_wave_barrier();
}

DI float dot8(uint4 a, uint4 b, float c) {
  c = __builtin_amdgcn_fdot2_f32_bf16(__builtin_bit_cast(bf2_t, a.x), __builtin_bit_cast(bf2_t, b.x), c, false);
  c = __builtin_amdgcn_fdot2_f32_bf16(__builtin_bit_cast(bf2_t, a.y), __builtin_bit_cast(bf2_t, b.y), c, false);
  c = __builtin_amdgcn_fdot2_f32_bf16(__builtin_bit_cast(bf2_t, a.z), __builtin_bit_cast(bf2_t, b.z), c, false);
  c = __builtin_amdgcn_fdot2_f32_bf16(__builtin_bit_cast(bf2_t, a.w), __builtin_bit_cast(bf2_t, b.w), c, false);
  return c;
}
DI void axpy8(float* o, float w, uint4 v) {
  o[0] += w * bflo(v.x); o[1] += w * bfhi(v.x); o[2] += w * bflo(v.y); o[3] += w * bfhi(v.y);
  o[4] += w * bflo(v.z); o[5] += w * bfhi(v.z); o[6] += w * bflo(v.w); o[7] += w * bfhi(v.w);
}

DI void peer_expert_wave(const Params& p, int row) {
  const int lane = threadIdx.x & 63;
  const uint4 x0 = *(const uint4*)&p.A2[(size_t)row * 1024 + lane * 8];
  const uint4 x1 = *(const uint4*)&p.A2[(size_t)row * 1024 + 512 + lane * 8];
  const float r2 = rsqrtf(p.ssq2[row] * (1.f / 1024.f) + EPS);
  float out[16];
#pragma unroll
  for (int i = 0; i < 16; ++i) out[i] = 0.f;
#pragma unroll 1
  for (int bt = 0; bt < 2; ++bt) {
    const int eidv = p.eid[(size_t)row * 128 + bt * 64 + lane];
    const float gv = p.gate[(size_t)row * 128 + bt * 64 + lane];
    float part[64];
#pragma unroll
    for (int e = 0; e < 64; ++e) {
      const int id = __builtin_amdgcn_readlane(eidv, e);
      const u16* ur = p.EU + (size_t)id * 1024 + lane * 8;
      uint4 u0 = *(const uint4*)ur, u1 = *(const uint4*)(ur + 512);
      part[e] = dot8(u1, x1, dot8(u0, x0, 0.f));
    }
#pragma unroll
    for (int off = 32; off > 0; off >>= 1) {
      const bool up = (lane & off) != 0;
#pragma unroll
      for (int i = 0; i < off; ++i) {
        const float a = part[i], bq = part[i + off];
        const float send = up ? a : bq, keep = up ? bq : a;
        part[i] = keep + __shfl_xor(send, off);
      }
    }
    const float wv = gv * geluf(part[0] * r2);
#pragma unroll 8
    for (int e = 0; e < 64; ++e) {
      const int id = __builtin_amdgcn_readlane(eidv, e);
      const float we = __int_as_float(__builtin_amdgcn_readlane(__float_as_int(wv), e));
      const u16* vr = p.EV + (size_t)id * 1024 + lane * 8;
      uint4 v0 = *(const uint4*)vr, v1 = *(const uint4*)(vr + 512);
      axpy8(out, we, v0);
      axpy8(out + 8, we, v1);
    }
  }
  const float* hr = p.h2 + (size_t)row * 1024;
  float4 ha = *(const float4*)&hr[lane * 8], hb = *(const float4*)&hr[lane * 8 + 4];
  float4 hc = *(const float4*)&hr[512 + lane * 8], hd = *(const float4*)&hr[512 + lane * 8 + 4];
  float hv[16] = {ha.x + out[0], ha.y + out[1], ha.z + out[2], ha.w + out[3], hb.x + out[4], hb.y + out[5], hb.z + out[6], hb.w + out[7],
                  hc.x + out[8], hc.y + out[9], hc.z + out[10], hc.w + out[11], hd.x + out[12], hd.y + out[13], hd.z + out[14], hd.w + out[15]};
  float ss = 0.f;
#pragma unroll
  for (int i = 0; i < 16; ++i) ss += hv[i] * hv[i];
  ss = wave_sum(ss);
  const float rs = rsqrtf(ss * (1.f / 1024.f) + EPS);
  float* y = (row < MP) ? (p.out + O_YP + (size_t)row * 1024) : (p.out + O_YS + (size_t)(row - MP) * 1024);
  float4 ga = *(const float4*)&p.g_final[lane * 8], gbb = *(const float4*)&p.g_final[lane * 8 + 4];
  float4 gc = *(const float4*)&p.g_final[512 + lane * 8], gd = *(const float4*)&p.g_final[512 + lane * 8 + 4];
  *(float4*)&y[lane * 8] = make_float4(hv[0] * rs * ga.x, hv[1] * rs * ga.y, hv[2] * rs * ga.z, hv[3] * rs * ga.w);
  *(float4*)&y[lane * 8 + 4] = make_float4(hv[4] * rs * gbb.x, hv[5] * rs * gbb.y, hv[6] * rs * gbb.z, hv[7] * rs * gbb.w);
  *(float4*)&y[512 + lane * 8] = make_float4(hv[8] * rs * gc.x, hv[9] * rs * gc.y, hv[10] * rs * gc.z, hv[11] * rs * gc.w);
  *(float4*)&y[512 + lane * 8 + 4] = make_float4(hv[12] * rs * gd.x, hv[13] * rs * gd.y, hv[14] * rs * gd.z, hv[15] * rs * gd.w);
}

__global__ void __launch_bounds__(256, 2) mega(Params pk) {
  __shared__ __attribute__((aligned(16))) char smem[53248];
  __shared__ Params sp;
  cg::grid_group grid = cg::this_grid();
  const int w = threadIdx.x >> 6;
  if (threadIdx.x == 0) sp = pk;
  __syncthreads();
  const Params& p = sp;
  phase0(p, smem);
  grid.sync();
  for (int t = blockIdx.x; t < 257 * 34 + 128; t += gridDim.x) {
    if (t < 257 * 34) gemm_tile<0>(p, p.A0, 1024, p.WtIn, 1024, t / 34, t % 34, smem);
    else { int u = t - 257 * 34; gemm_tile<1>(p, p.Amem, 1024, p.WtMkv, 1024, u / 16, u % 16, smem); }
  }
  grid.sync();
  phase2(p, smem);
  grid.sync();
  phase3(p);
  grid.sync();
  phase4(p);
  grid.sync();
  for (int t = blockIdx.x; t < 257 * 8; t += gridDim.x) gemm_tile<2>(p, p.Amix, 768, p.WtOut, 768, t / 8, t % 8, smem);
  grid.sync();
  for (int t = blockIdx.x; t < 257 * 8; t += gridDim.x) gemm_tile<3>(p, p.A1, 1024, p.WtMq, 1024, t / 8, t % 8, smem);
  sample_state_copy(p);
  grid.sync();
  phase7(p, smem);
  grid.sync();
  for (int t = blockIdx.x; t < 257 * 8; t += gridDim.x) gemm_tile<4>(p, p.attn, 1024, p.WtMo, 1024, t / 8, t % 8, smem);
  grid.sync();
  for (int t = blockIdx.x; t < 257 * 16; t += gridDim.x) gemm_tile<5>(p, p.A2, 1024, p.WtPq, 1024, t / 16, t % 16, smem);
  grid.sync();
  {
    unsigned* lds = (unsigned*)smem + w * 512;
    for (int it = blockIdx.x * 4 + w; it < 2056 * 8; it += gridDim.x * 4) peer_topk_wave(p, it, lds);
  }
  grid.sync();
  for (int row = blockIdx.x * 4 + w; row < MT; row += gridDim.x * 4) peer_expert_wave(p, row);
}

extern "C" void kernel_launch(void* const* d_in, const int* in_sizes, int n_in, void* d_out, int out_size, void* d_ws, size_t ws_size,
                              hipStream_t stream) {
  static int grid_blocks = 0;
  if (!grid_blocks) {
    int dev = 0, cus = 0, per_cu = 0;
    (void)hipGetDevice(&dev);
    (void)hipDeviceGetAttribute(&cus, hipDeviceAttributeMultiprocessorCount, dev);
    (void)hipOccupancyMaxActiveBlocksPerMultiprocessor(&per_cu, mega, 256, 0);
    if (per_cu > 2) per_cu = 2;
    if (per_cu < 1) per_cu = 1;
    grid_blocks = cus * per_cu;
  }
  Params p{};
  const float* const* in = (const float* const*)d_in;
  p.x_prompt = in[0]; p.x_sample = in[1]; p.state_delta = in[2]; p.state_conv = in[3]; p.cw1 = in[4]; p.cw2 = in[5]; p.cw3 = in[6];
  p.cache_mem = in[7]; p.mem_prompt = in[8]; p.g_mix = in[9]; p.w_in = in[10]; p.conv_w = in[11]; p.a_log = in[12]; p.dt_bias = in[13];
  p.g_onorm = in[14]; p.w_out = in[15]; p.g_memq = in[16]; p.g_memkv = in[17]; p.w_mq = in[18]; p.w_mkv = in[19]; p.w_mo = in[20];
  p.g_ffn = in[21]; p.w_pq = in[22]; p.sub_keys = in[23]; p.expert_u = in[24]; p.expert_v = in[25]; p.g_final = in[26];
  p.out = (float*)d_out;
  char* ws = (char*)d_ws;
  size_t off = 0;
  auto take = [&](size_t bytes) { char* r = ws + off; off += (bytes + 255) & ~(size_t)255; return r; };
  p.WtIn = (u16*)take((size_t)NP * 1024 * 2);
  p.WtOut = (u16*)take((size_t)1024 * 768 * 2);
  p.WtMq = (u16*)take((size_t)1024 * 1024 * 2);
  p.WtMkv = (u16*)take((size_t)2048 * 1024 * 2);
  p.WtMo = (u16*)take((size_t)1024 * 1024 * 2);
  p.WtPq = (u16*)take((size_t)2048 * 1024 * 2);
  p.subkb = (u16*)take((size_t)262144 * 2);
  p.EU = (u16*)take((size_t)16384 * 1024 * 2);
  p.EV = (u16*)take((size_t)16384 * 1024 * 2);
  p.Amem = (u16*)take((size_t)1024 * 1024 * 2);
  p.gb = (float*)take((size_t)MT * 8 * 4);
  p.ssq1 = (float*)take((size_t)MT * 4);
  p.ssq2 = (float*)take((size_t)MT * 4);
  p.dl = (float*)take(2048 * 4);
  p.Kb = (u16*)take((size_t)16 * 65536 * 2);
  p.VTf = (u16*)take((size_t)16 * 65536 * 2);
  char* regA = take((size_t)MT * NP * 2);
  char* regB = take((size_t)2048 * DN_ITEM);
  p.proj = (u16*)regA;
  p.h1 = (float*)regA;
  p.h2 = (float*)(regA + (size_t)MT * 1024 * 4);
  p.pq = (u16*)regA;
  p.dnops = regB;
  p.A0 = (u16*)regB;
  p.A1 = (u16*)regB;
  p.qb = (u16*)(regB + (size_t)MT * 1024 * 2);
  p.attn = (u16*)regB;
  p.A2 = (u16*)(regB + (size_t)MT * 1024 * 2);
  p.eid = (int*)regB;
  p.gate = (float*)(regB + (size_t)MT * 128 * 4);
  char* ob = (char*)d_out;
  p.vT = (u16*)ob;
  p.osw = (u16*)(ob + (size_t)3 * MP * 256 * 2);
  p.lse = (float*)(ob + (size_t)3 * MP * 256 * 2 + (size_t)3 * MT * 256 * 2);
  char* sb = ob + O_SW3 * 4;
  p.odn = (u16*)sb;
  p.Amix = (u16*)(sb + (size_t)MT * 512 * 2);
  if (off > ws_size) { fprintf(stderr, "workspace too small: need %zu have %zu\n", off, ws_size); return; }
  void* args[] = {&p};
  hipError_t e = hipLaunchCooperativeKernel((void*)mega, dim3(grid_blocks), dim3(256), args, 0, stream);
  if (e != hipSuccess) fprintf(stderr, "coop launch failed: %s (grid %d)\n", hipGetErrorString(e), grid_blocks);
}
```

```cpp
#include <hip/hip_runtime.h>
#include <hip/hip_cooperative_groups.h>
#include <cstdio>
namespace cg = cooperative_groups;

typedef unsigned short u16;
typedef __attribute__((ext_vector_type(8))) short bf16x8;
typedef __attribute__((ext_vector_type(4))) float f32x4;
typedef __attribute__((ext_vector_type(2))) __bf16 bf2_t;

#define DI __device__ __forceinline__
#define MFMA(a, b, c) __builtin_amdgcn_mfma_f32_16x16x32_bf16((a), (b), (c), 0, 0, 0)

constexpr int MP = 32768, MS = 128, MT = 32896;
constexpr int NP = 4352;
constexpr int SEQ = 8192;
constexpr float EPS = 1e-6f;
constexpr size_t DN_ITEM = 73728;

constexpr size_t O_YP = 0, O_YS = 33554432, O_PDELTA = 33685504, O_PCONV = 33947648, O_PW1 = 33966080,
                 O_PW2 = 34228224, O_PW3 = 35276800, O_PMEM = 39471104, O_SDELTA = 41568256, O_SCONV = 43665408,
                 O_SW1 = 43812864, O_SW2 = 45910016, O_SW3 = 54298624;

struct Params {
  const float *x_prompt, *x_sample, *state_delta, *state_conv, *cw1, *cw2, *cw3, *cache_mem, *mem_prompt;
  const float *g_mix, *w_in, *conv_w, *a_log, *dt_bias, *g_onorm, *w_out, *g_memq, *g_memkv, *w_mq, *w_mkv, *w_mo;
  const float *g_ffn, *w_pq, *sub_keys, *expert_u, *expert_v, *g_final;
  float* out;
  u16 *WtIn, *WtOut, *WtMq, *WtMkv, *WtMo, *WtPq, *subkb, *Amem;
  unsigned char* E8;
  float* rs;
  float *gb, *ssq1, *ssq2, *dl;
  u16 *Kb, *VTf;
  u16* proj;
  float *h1, *h2;
  u16* pq;
  char* dnops;
  u16 *A0, *A1, *qb, *attn, *A2;
  int* eid;
  float* gate;
  u16 *vT, *osw, *odn, *Amix;
  float* lse;
};

DI u16 f2bf(float x) { unsigned u = __float_as_uint(x); u += 0x7fffu + ((u >> 16) & 1u); return (u16)(u >> 16); }
DI float bf2f(u16 h) { return __uint_as_float(((unsigned)h) << 16); }
DI unsigned pack2(float a, float b) { return (unsigned)f2bf(a) | ((unsigned)f2bf(b) << 16); }
DI float bflo(unsigned d) { return __uint_as_float(d << 16); }
DI float bfhi(unsigned d) { return __uint_as_float(d & 0xffff0000u); }
DI bf16x8 pack8(f32x4 a, f32x4 b) {
  uint4 r; r.x = pack2(a[0], a[1]); r.y = pack2(a[2], a[3]); r.z = pack2(b[0], b[1]); r.w = pack2(b[2], b[3]);
  return __builtin_bit_cast(bf16x8, r);
}
DI float wave_sum(float v) {
#pragma unroll
  for (int o = 32; o > 0; o >>= 1) v += __shfl_xor(v, o);
  return v;
}
DI float wave_max(float v) {
#pragma unroll
  for (int o = 32; o > 0; o >>= 1) v = fmaxf(v, __shfl_xor(v, o));
  return v;
}
DI float siluf(float x) { return x / (1.f + __expf(-x)); }
DI float geluf(float x) { return 0.5f * x * (1.f + tanhf(0.7978845608028654f * (x + 0.044715f * x * x * x))); }
DI int permk(int kg, int j) { return (j < 4) ? (kg * 4 + j) : (16 + kg * 4 + (j - 4)); }
DI void cvt8(const float* __restrict__ s, u16* __restrict__ d) {
  float4 a = *(const float4*)s, b = *(const float4*)(s + 4);
  uint4 r; r.x = pack2(a.x, a.y); r.y = pack2(a.z, a.w); r.z = pack2(b.x, b.y); r.w = pack2(b.z, b.w);
  *(uint4*)d = r;
}
DI unsigned ordf(float f) { unsigned u = __float_as_uint(f); return (u & 0x80000000u) ? ~u : (u | 0x80000000u); }
DI float unordf(unsigned k) { unsigned u = (k & 0x80000000u) ? (k & 0x7fffffffu) : ~k; return __uint_as_float(u); }
DI unsigned umax(unsigned a, unsigned b) { return a > b ? a : b; }
template <typename T> DI T sel4(int L, T a, T b, T c, T d) { return L == 0 ? a : (L == 1 ? b : (L == 2 ? c : d)); }

template <int MODE>
DI void gemm_tile(const Params& p, const u16* __restrict__ A, int lda, const u16* __restrict__ Bt, int K, int tm, int tn,
                          char* smem) {
  u16* sA = (u16*)smem;
  u16* sB = sA + 128 * 72;
  const int tid = threadIdx.x, lane = tid & 63, w = tid >> 6;
  const int wm = w >> 1, wn = w & 1, r = lane & 15, kg = lane >> 4;
  f32x4 acc[4][4];
#pragma unroll
  for (int i = 0; i < 4; ++i)
#pragma unroll
    for (int j = 0; j < 4; ++j) acc[i][j] = (f32x4){0.f, 0.f, 0.f, 0.f};
  const int lrow = tid >> 1, lcol = (tid & 1) * 32;
  const u16* gA = A + (size_t)(tm * 128 + lrow) * lda + lcol;
  const u16* gB = Bt + (size_t)(tn * 128 + lrow) * K + lcol;
  bf16x8 ra[4], rb[4];
#pragma unroll
  for (int i = 0; i < 4; ++i) { ra[i] = *(const bf16x8*)(gA + i * 8); rb[i] = *(const bf16x8*)(gB + i * 8); }
  for (int k0 = 0; k0 < K; k0 += 64) {
    __syncthreads();
#pragma unroll
    for (int i = 0; i < 4; ++i) {
      *(bf16x8*)&sA[lrow * 72 + lcol + i * 8] = ra[i];
      *(bf16x8*)&sB[lrow * 72 + lcol + i * 8] = rb[i];
    }
    __syncthreads();
    if (k0 + 64 < K) {
#pragma unroll
      for (int i = 0; i < 4; ++i) { ra[i] = *(const bf16x8*)(gA + k0 + 64 + i * 8); rb[i] = *(const bf16x8*)(gB + k0 + 64 + i * 8); }
    }
#pragma unroll
    for (int ks = 0; ks < 2; ++ks) {
      bf16x8 af[4], bfr[4];
#pragma unroll
      for (int i = 0; i < 4; ++i) {
        af[i] = *(const bf16x8*)&sA[(wm * 64 + i * 16 + r) * 72 + ks * 32 + kg * 8];
        bfr[i] = *(const bf16x8*)&sB[(wn * 64 + i * 16 + r) * 72 + ks * 32 + kg * 8];
      }
#pragma unroll
      for (int mt = 0; mt < 4; ++mt)
#pragma unroll
        for (int nt = 0; nt < 4; ++nt) acc[mt][nt] = MFMA(bfr[nt], af[mt], acc[mt][nt]);
    }
  }
#pragma unroll
  for (int mt = 0; mt < 4; ++mt) {
    const int row = tm * 128 + wm * 64 + mt * 16 + r;
    float rs = 1.f, ssq = 0.f;
    if (MODE == 3) rs = rsqrtf(p.ssq1[row] * (1.f / 1024.f) + EPS);
    if (MODE == 5) rs = rsqrtf(p.ssq2[row] * (1.f / 1024.f) + EPS);
#pragma unroll
    for (int nt = 0; nt < 4; ++nt) {
      const int col = tn * 128 + wn * 64 + nt * 16 + kg * 4;
      f32x4 v = acc[mt][nt];
      if (MODE == 0) {
        uint2 o; o.x = pack2(v[0], v[1]); o.y = pack2(v[2], v[3]);
        *(uint2*)&p.proj[(size_t)row * NP + col] = o;
      } else if (MODE == 1) {
        *(float4*)&p.out[O_PMEM + (size_t)row * 2048 + col] = make_float4(v[0], v[1], v[2], v[3]);
      } else if (MODE == 2 || MODE == 4) {
        float4 rsd;
        const float* gn;
        if (MODE == 2) {
          rsd = (row < MP) ? *(const float4*)&p.x_prompt[(size_t)row * 1024 + col] : *(const float4*)&p.x_sample[(size_t)(row - MP) * 1024 + col];
          gn = p.g_memq;
        } else {
          rsd = *(const float4*)&p.h1[(size_t)row * 1024 + col];
          gn = p.g_ffn;
        }
        float4 h = make_float4(rsd.x + v[0], rsd.y + v[1], rsd.z + v[2], rsd.w + v[3]);
        float4 g4 = *(const float4*)&gn[col];
        ssq += h.x * h.x + h.y * h.y + h.z * h.z + h.w * h.w;
        uint2 o; o.x = pack2(h.x * g4.x, h.y * g4.y); o.y = pack2(h.z * g4.z, h.w * g4.w);
        if (MODE == 2) { *(float4*)&p.h1[(size_t)row * 1024 + col] = h; *(uint2*)&p.A1[(size_t)row * 1024 + col] = o; }
        else { *(float4*)&p.h2[(size_t)row * 1024 + col] = h; *(uint2*)&p.A2[(size_t)row * 1024 + col] = o; }
      } else if (MODE == 3) {
        uint2 o; o.x = pack2(v[0] * rs, v[1] * rs); o.y = pack2(v[2] * rs, v[3] * rs);
        *(uint2*)&p.qb[(size_t)row * 1024 + col] = o;
      } else {
        uint2 o; o.x = pack2(v[0] * rs, v[1] * rs); o.y = pack2(v[2] * rs, v[3] * rs);
        *(uint2*)&p.pq[(size_t)row * 2048 + col] = o;
      }
    }
    if (MODE == 2 || MODE == 4) {
      ssq += __shfl_xor(ssq, 16);
      ssq += __shfl_xor(ssq, 32);
      if (kg == 0) atomicAdd((MODE == 2) ? &p.ssq1[row] : &p.ssq2[row], ssq);
    }
  }
}

DI void tr_tile(const float* __restrict__ W, int ldw, int nsrc0, u16* __restrict__ Wt, int K, int k0, int n0, float* tile) {
  const int tid = threadIdx.x;
  const int n = tid & 63, kq = tid >> 6;
  __syncthreads();
#pragma unroll
  for (int i = 0; i < 16; ++i) { int kk = kq + 4 * i; tile[kk * 65 + n] = W[(size_t)(k0 + kk) * ldw + nsrc0 + n]; }
  __syncthreads();
  const int nn = tid >> 2, ks = (tid & 3) * 16;
  unsigned o[8];
#pragma unroll
  for (int i = 0; i < 8; ++i) o[i] = pack2(tile[(ks + 2 * i) * 65 + nn], tile[(ks + 2 * i + 1) * 65 + nn]);
  u16* d = Wt + (size_t)(n0 + nn) * K + k0 + ks;
  *(uint4*)d = make_uint4(o[0], o[1], o[2], o[3]);
  *(uint4*)(d + 8) = make_uint4(o[4], o[5], o[6], o[7]);
}

DI void phase0(const Params& p, char* smem) {
  const int tid = threadIdx.x, lane = tid & 63, w = tid >> 6;
  const size_t gtid = (size_t)blockIdx.x * 256 + tid, gsz = (size_t)gridDim.x * 256;
  {
    const float* eu = p.expert_u;
    const float* ev = p.expert_v;
    unsigned char* e8 = p.E8;
    float* rsp = p.rs;
    for (int er = blockIdx.x * 4 + w; er < 32768; er += gridDim.x * 4) {
      const float* src = (er < 16384) ? (eu + (size_t)er * 1024) : (ev + (size_t)(er - 16384) * 1024);
      float4 v[4];
      float am = 0.f;
#pragma unroll
      for (int i = 0; i < 4; ++i) {
        v[i] = *(const float4*)&src[lane * 16 + i * 4];
        am = fmaxf(am, fmaxf(fmaxf(fabsf(v[i].x), fabsf(v[i].y)), fmaxf(fabsf(v[i].z), fabsf(v[i].w))));
      }
      am = wave_max(am);
      const float sc = (am > 0.f) ? 224.f / am : 1.f;
      int o[4];
#pragma unroll
      for (int i = 0; i < 4; ++i) {
        int t = __builtin_amdgcn_cvt_pk_fp8_f32(v[i].x * sc, v[i].y * sc, 0, false);
        o[i] = __builtin_amdgcn_cvt_pk_fp8_f32(v[i].z * sc, v[i].w * sc, t, true);
      }
      *(uint4*)&e8[(size_t)er * 1024 + lane * 16] = make_uint4((unsigned)o[0], (unsigned)o[1], (unsigned)o[2], (unsigned)o[3]);
      if (lane == 0) rsp[er] = (am > 0.f) ? am * (1.f / 224.f) : 1.f;
    }
  }
  for (size_t i = gtid; i < 262144 / 8; i += gsz) cvt8(p.sub_keys + i * 8, p.subkb + i * 8);
  for (size_t i = gtid; i < MT; i += gsz) { p.ssq1[i] = 0.f; p.ssq2[i] = 0.f; }
  const float* xpp = p.x_prompt;
  const float* xsp = p.x_sample;
  const float* mpp = p.mem_prompt;
  const float* gmx = p.g_mix;
  const float* gmk = p.g_memkv;
  u16* a0p = p.A0;
  u16* amp = p.Amem;
  for (int row = blockIdx.x * 4 + w; row < MT + 1024; row += gridDim.x * 4) {
    const float* src; const float* g; u16* dst;
    if (row < MP) { src = xpp + (size_t)row * 1024; g = gmx; dst = a0p + (size_t)row * 1024; }
    else if (row < MT) { src = xsp + (size_t)(row - MP) * 1024; g = gmx; dst = a0p + (size_t)row * 1024; }
    else { src = mpp + (size_t)(row - MT) * 1024; g = gmk; dst = amp + (size_t)(row - MT) * 1024; }
    float4 v[4];
    float ss = 0.f;
#pragma unroll
    for (int i = 0; i < 4; ++i) { v[i] = *(const float4*)&src[lane * 4 + i * 256]; ss += v[i].x * v[i].x + v[i].y * v[i].y + v[i].z * v[i].z + v[i].w * v[i].w; }
    ss = wave_sum(ss);
    const float rs = rsqrtf(ss * (1.f / 1024.f) + EPS);
    float d8[8] = {0.f, 0.f, 0.f, 0.f, 0.f, 0.f, 0.f, 0.f};
#pragma unroll
    for (int i = 0; i < 4; ++i) {
      float4 g4 = *(const float4*)&g[lane * 4 + i * 256];
      float y[4] = {v[i].x * rs * g4.x, v[i].y * rs * g4.y, v[i].z * rs * g4.z, v[i].w * rs * g4.w};
      uint2 o; o.x = pack2(y[0], y[1]); o.y = pack2(y[2], y[3]);
      *(uint2*)&dst[lane * 4 + i * 256] = o;
      if (row < MT) {
#pragma unroll
        for (int e = 0; e < 4; ++e) {
          const float* wr = p.w_in + (size_t)(lane * 4 + i * 256 + e) * 4360 + 1536;
          float4 wa = *(const float4*)wr, wb = *(const float4*)(wr + 4);
          d8[0] += y[e] * wa.x; d8[1] += y[e] * wa.y; d8[2] += y[e] * wa.z; d8[3] += y[e] * wa.w;
          d8[4] += y[e] * wb.x; d8[5] += y[e] * wb.y; d8[6] += y[e] * wb.z; d8[7] += y[e] * wb.w;
        }
      }
    }
    if (row < MT) {
#pragma unroll
      for (int j = 0; j < 8; ++j) d8[j] = wave_sum(d8[j]);
      if (lane < 4) {
        float ag = sel4(lane, d8[0], d8[1], d8[2], d8[3]);
        float bg = sel4(lane, d8[4], d8[5], d8[6], d8[7]);
        float xs = ag + p.dt_bias[lane];
        float sp = (xs > 20.f) ? xs : log1pf(expf(xs));
        p.gb[(size_t)row * 8 + lane] = -expf(p.a_log[lane]) * sp;
        p.gb[(size_t)row * 8 + 4 + lane] = 1.f / (1.f + expf(-bg));
      }
    }
  }
  float* tile = (float*)smem;
  for (int j = blockIdx.x; j < 2816; j += gridDim.x) {
    int t = j;
    if (t < 1088) { int kt = t / 68, nt = t % 68; int n0 = nt * 64; tr_tile(p.w_in, 4360, n0 + (n0 >= 1536 ? 8 : 0), p.WtIn, 1024, kt * 64, n0, tile); continue; }
    t -= 1088;
    if (t < 192) { int kt = t / 16, nt = t % 16; tr_tile(p.w_out, 1024, nt * 64, p.WtOut, 768, kt * 64, nt * 64, tile); continue; }
    t -= 192;
    if (t < 256) { int kt = t / 16, nt = t % 16; tr_tile(p.w_mq, 1024, nt * 64, p.WtMq, 1024, kt * 64, nt * 64, tile); continue; }
    t -= 256;
    if (t < 512) { int kt = t / 32, nt = t % 32; tr_tile(p.w_mkv, 2048, nt * 64, p.WtMkv, 1024, kt * 64, nt * 64, tile); continue; }
    t -= 512;
    if (t < 256) { int kt = t / 16, nt = t % 16; tr_tile(p.w_mo, 1024, nt * 64, p.WtMo, 1024, kt * 64, nt * 64, tile); continue; }
    t -= 256;
    { int kt = t / 32, nt = t % 32; tr_tile(p.w_pq, 2048, nt * 64, p.WtPq, 1024, kt * 64, nt * 64, tile); }
  }
}

DI void dn_prep(const Params& p, int item, char* smem) {
  u16* qs = (u16*)smem;
  u16* ksm = qs + 64 * 136;
  float* sL = (float*)(ksm + 64 * 136);
  float* sgc = sL + 64 * 64;
  float* sbeta = sgc + 64;
  u16* sU = (u16*)sL;
  u16* sW = qs;
  const int tid = threadIdx.x, lane = tid & 63, w = tid >> 6, r = lane & 15, kg = lane >> 4;
  const int bh = item >> 7, n = item & 127, b = bh >> 2, h = bh & 3;
  const int t0 = n * 64;
  const size_t rowbase = (size_t)b * SEQ;
  char* ops = p.dnops + (size_t)item * DN_ITEM;
  __syncthreads();
  if (tid < 64) {
    float gv = p.gb[(rowbase + t0 + tid) * 8 + h];
    float bv = p.gb[(rowbase + t0 + tid) * 8 + 4 + h];
#pragma unroll
    for (int o = 1; o < 64; o <<= 1) { float t = __shfl_up(gv, o); if (lane >= o) gv += t; }
    sgc[tid] = gv; sbeta[tid] = bv;
    if (tid == 63) p.dl[item] = __expf(gv);
  }
#pragma unroll 1
  for (int ps = 0; ps < 8; ++ps) {
    const int combo = ps * 16 + (tid >> 4);
    const int tt = combo & 63, part = combo >> 6, sub = tid & 15;
    const int col = part * 512 + h * 128 + sub * 8;
    float y[8] = {0.f, 0.f, 0.f, 0.f, 0.f, 0.f, 0.f, 0.f};
#pragma unroll
    for (int j = 0; j < 4; ++j) {
      const int t = t0 + tt - 3 + j;
      if (t >= 0) {
        uint4 xv = *(const uint4*)&p.proj[(rowbase + t) * NP + col];
        float4 wa = *(const float4*)&p.conv_w[j * 1536 + col], wb = *(const float4*)&p.conv_w[j * 1536 + col + 4];
        y[0] += bflo(xv.x) * wa.x; y[1] += bfhi(xv.x) * wa.y; y[2] += bflo(xv.y) * wa.z; y[3] += bfhi(xv.y) * wa.w;
        y[4] += bflo(xv.z) * wb.x; y[5] += bfhi(xv.z) * wb.y; y[6] += bflo(xv.w) * wb.z; y[7] += bfhi(xv.w) * wb.w;
      }
    }
    float ss = 0.f;
#pragma unroll
    for (int e = 0; e < 8; ++e) { y[e] = siluf(y[e]); ss += y[e] * y[e]; }
    ss += __shfl_xor(ss, 1); ss += __shfl_xor(ss, 2); ss += __shfl_xor(ss, 4); ss += __shfl_xor(ss, 8);
    float sc = rsqrtf(ss + EPS) * (part == 0 ? 0.08838834764831845f : 1.f);
    uint4 o; o.x = pack2(y[0] * sc, y[1] * sc); o.y = pack2(y[2] * sc, y[3] * sc); o.z = pack2(y[4] * sc, y[5] * sc); o.w = pack2(y[6] * sc, y[7] * sc);
    *(uint4*)&((part == 0 ? qs : ksm)[tt * 136 + sub * 8]) = o;
  }
  __syncthreads();
  const float gcl = sgc[63];
  {
    f32x4 aL[4], aA[4];
#pragma unroll
    for (int i = 0; i < 4; ++i) { aL[i] = (f32x4){0.f, 0.f, 0.f, 0.f}; aA[i] = (f32x4){0.f, 0.f, 0.f, 0.f}; }
#pragma unroll
    for (int ks = 0; ks < 4; ++ks) {
      bf16x8 kI = *(const bf16x8*)&ksm[(w * 16 + r) * 136 + ks * 32 + kg * 8];
      bf16x8 qI = *(const bf16x8*)&qs[(w * 16 + r) * 136 + ks * 32 + kg * 8];
#pragma unroll
      for (int nt = 0; nt < 4; ++nt) {
        bf16x8 kJ = *(const bf16x8*)&ksm[(nt * 16 + r) * 136 + ks * 32 + kg * 8];
        aL[nt] = MFMA(kJ, kI, aL[nt]);
        aA[nt] = MFMA(kJ, qI, aA[nt]);
      }
    }
    const int i = w * 16 + r;
    const float gci = sgc[i], bi = sbeta[i];
    u16* aq = (u16*)(ops + 49152);
#pragma unroll
    for (int nt = 0; nt < 4; ++nt) {
      float lv[4], av[4];
#pragma unroll
      for (int jj = 0; jj < 4; ++jj) {
        const int j = nt * 16 + kg * 4 + jj;
        const float gam = (i >= j) ? __expf(gci - sgc[j]) : 0.f;
        lv[jj] = (i > j) ? aL[nt][jj] * bi * gam : 0.f;
        av[jj] = aA[nt][jj] * gam;
      }
      *(float4*)&sL[i * 64 + nt * 16 + kg * 4] = make_float4(lv[0], lv[1], lv[2], lv[3]);
      uint2 o; o.x = pack2(av[0], av[1]); o.y = pack2(av[2], av[3]);
      *(uint2*)&aq[((w * 2 + (nt >> 1)) * 64 + lane) * 8 + (nt & 1) * 4] = o;
    }
  }
  {
    u16* qg = (u16*)(ops + 16384);
    u16* kdT = (u16*)(ops + 32768);
#pragma unroll 1
    for (int i = 0; i < 4; ++i) {
      const int f = tid + 256 * i;
      const int mtks = f >> 6, l = f & 63, rr = l & 15, kgg = l >> 4;
      {
        const int mt = mtks >> 2, ks = mtks & 3, row = mt * 16 + rr;
        const float e = __expf(sgc[row]);
        uint2 a = *(const uint2*)&qs[row * 136 + ks * 32 + kgg * 4];
        uint2 c = *(const uint2*)&qs[row * 136 + ks * 32 + 16 + kgg * 4];
        uint4 o;
        o.x = pack2(bflo(a.x) * e, bfhi(a.x) * e); o.y = pack2(bflo(a.y) * e, bfhi(a.y) * e);
        o.z = pack2(bflo(c.x) * e, bfhi(c.x) * e); o.w = pack2(bflo(c.y) * e, bfhi(c.y) * e);
        *(uint4*)&qg[(size_t)f * 8] = o;
      }
      {
        const int mt = mtks >> 1, ks = mtks & 1, kdim = mt * 16 + rr;
        float v[8];
#pragma unroll
        for (int j = 0; j < 8; ++j) {
          const int c = ks * 32 + permk(kgg, j);
          v[j] = bf2f(ksm[c * 136 + kdim]) * __expf(gcl - sgc[c]);
        }
        uint4 o; o.x = pack2(v[0], v[1]); o.y = pack2(v[2], v[3]); o.z = pack2(v[4], v[5]); o.w = pack2(v[6], v[7]);
        *(uint4*)&kdT[(size_t)f * 8] = o;
      }
    }
  }
  __syncthreads();
  float x[64];
  if (tid < 128) {
    const int col = 1024 + h * 128 + tid;
    const float w0 = p.conv_w[col], w1 = p.conv_w[1536 + col], w2 = p.conv_w[3072 + col], w3 = p.conv_w[4608 + col];
    float xm3 = 0.f, xm2 = 0.f, xm1 = 0.f;
    if (t0 > 0) {
      xm3 = bf2f(p.proj[(rowbase + t0 - 3) * NP + col]);
      xm2 = bf2f(p.proj[(rowbase + t0 - 2) * NP + col]);
      xm1 = bf2f(p.proj[(rowbase + t0 - 1) * NP + col]);
    }
#pragma unroll
    for (int t = 0; t < 64; ++t) {
      float xc = bf2f(p.proj[(rowbase + t0 + t) * NP + col]);
      float yv = w0 * xm3 + w1 * xm2 + w2 * xm1 + w3 * xc;
      x[t] = siluf(yv) * sbeta[t];
      xm3 = xm2; xm2 = xm1; xm1 = xc;
    }
  } else {
    const int kc = tid - 128;
#pragma unroll
    for (int t = 0; t < 64; ++t) x[t] = bf2f(ksm[t * 136 + kc]) * sbeta[t] * __expf(sgc[t]);
  }
#pragma unroll
  for (int i = 1; i < 64; ++i) {
    float s = x[i];
#pragma unroll
    for (int j4 = 0; j4 < (i + 3) / 4; ++j4) {
      float4 l = *(const float4*)&sL[i * 64 + j4 * 4];
      s -= l.x * x[j4 * 4];
      if (j4 * 4 + 1 < i) s -= l.y * x[j4 * 4 + 1];
      if (j4 * 4 + 2 < i) s -= l.z * x[j4 * 4 + 2];
      if (j4 * 4 + 3 < i) s -= l.w * x[j4 * 4 + 3];
    }
    x[i] = s;
  }
  __syncthreads();
  if (tid < 128) {
#pragma unroll
    for (int t = 0; t < 64; ++t) sU[t * 128 + tid] = f2bf(x[t]);
  } else {
    const int kc = tid - 128;
#pragma unroll
    for (int t = 0; t < 64; ++t) sW[t * 136 + kc] = f2bf(-x[t]);
  }
  __syncthreads();
  {
    u16* nW = (u16*)ops;
    u16* u0 = (u16*)(ops + 57344);
#pragma unroll 1
    for (int i = 0; i < 4; ++i) {
      const int f = tid + 256 * i;
      const int mtks = f >> 6, l = f & 63, rr = l & 15, kgg = l >> 4;
      const int mt = mtks >> 2, ks = mtks & 3, row = mt * 16 + rr;
      uint2 a = *(const uint2*)&sW[row * 136 + ks * 32 + kgg * 4];
      uint2 c = *(const uint2*)&sW[row * 136 + ks * 32 + 16 + kgg * 4];
      *(uint4*)&nW[(size_t)f * 8] = make_uint4(a.x, a.y, c.x, c.y);
    }
#pragma unroll 1
    for (int i = 0; i < 8; ++i) {
      const int f = tid + 256 * i;
      const int smt = f >> 6, l = f & 63, rr = l & 15, kgg = l >> 4;
      const int s = smt >> 2, mt = smt & 3;
      u16 v0 = sU[(mt * 16 + kgg * 4 + 0) * 128 + s * 16 + rr];
      u16 v1 = sU[(mt * 16 + kgg * 4 + 1) * 128 + s * 16 + rr];
      u16 v2 = sU[(mt * 16 + kgg * 4 + 2) * 128 + s * 16 + rr];
      u16 v3 = sU[(mt * 16 + kgg * 4 + 3) * 128 + s * 16 + rr];
      *(uint2*)&u0[(size_t)f * 4] = make_uint2((unsigned)v0 | ((unsigned)v1 << 16), (unsigned)v2 | ((unsigned)v3 << 16));
    }
  }
}

DI void vt_tile(const Params& p, int item, char* smem) {
  u16* tile = (u16*)smem;
  const int tid = threadIdx.x;
  const int ptile = item & 127, gbh = item >> 7;
  const int h = gbh & 3, b = (gbh >> 2) & 3, g = gbh >> 4;
  const int dsh = g * 2, ln = SEQ >> dsh;
  const int pos0 = ptile * 64;
  const int rres = pos0 / ln, i0 = pos0 % ln;
  __syncthreads();
  {
    const int pr = tid >> 2, seg = (tid & 3) * 16;
    const int token = ((i0 + pr) << dsh) + rres;
    const u16* src = &p.proj[((size_t)b * SEQ + token) * NP + 2048 + g * 768 + 512 + h * 64 + seg];
    uint4 a = *(const uint4*)src, c = *(const uint4*)(src + 8);
    unsigned d[8] = {a.x, a.y, a.z, a.w, c.x, c.y, c.z, c.w};
#pragma unroll
    for (int e = 0; e < 8; ++e) *(unsigned*)&tile[pr * 66 + seg + e * 2] = d[e];
  }
  __syncthreads();
  {
    const int dh = tid >> 2, seg = (tid & 3) * 16;
    unsigned o[8];
#pragma unroll
    for (int e = 0; e < 8; ++e) o[e] = (unsigned)tile[(seg + 2 * e) * 66 + dh] | ((unsigned)tile[(seg + 2 * e + 1) * 66 + dh] << 16);
    u16* d = &p.vT[((size_t)gbh * 64 + dh) * SEQ + pos0 + seg];
    *(uint4*)d = make_uint4(o[0], o[1], o[2], o[3]);
    *(uint4*)(d + 8) = make_uint4(o[4], o[5], o[6], o[7]);
  }
}

DI void dn_sample(const Params& p, int item, char* smem) {
  float* sq = (float*)smem;
  float* sk = sq + 512;
  float* sv = sk + 512;
  float* red = sv + 512;
  const int tid = threadIdx.x, lane = tid & 63, w = tid >> 6;
  const int b = item >> 2, h = item & 3;
  __syncthreads();
  for (int c = tid; c < 384; c += 256) {
    const int part = c >> 7, cc = c & 127;
    const int col = part * 512 + h * 128 + cc;
    float xp[7];
#pragma unroll
    for (int j = 0; j < 3; ++j) xp[j] = p.state_conv[((size_t)b * 3 + j) * 1536 + col];
#pragma unroll
    for (int j = 0; j < 4; ++j) xp[3 + j] = bf2f(p.proj[((size_t)MP + b * 4 + j) * NP + col]);
    const float w0 = p.conv_w[col], w1 = p.conv_w[1536 + col], w2 = p.conv_w[3072 + col], w3 = p.conv_w[4608 + col];
    float* dst = part == 0 ? sq : (part == 1 ? sk : sv);
#pragma unroll
    for (int t = 0; t < 4; ++t) dst[t * 128 + cc] = siluf(w0 * xp[t] + w1 * xp[t + 1] + w2 * xp[t + 2] + w3 * xp[t + 3]);
  }
  __syncthreads();
  {
    float a0 = sq[w * 128 + lane], a1 = sq[w * 128 + 64 + lane];
    float s = wave_sum(a0 * a0 + a1 * a1);
    float sc = rsqrtf(s + EPS) * 0.08838834764831845f;
    sq[w * 128 + lane] = a0 * sc; sq[w * 128 + 64 + lane] = a1 * sc;
    float b0 = sk[w * 128 + lane], b1 = sk[w * 128 + 64 + lane];
    s = wave_sum(b0 * b0 + b1 * b1);
    sc = rsqrtf(s + EPS);
    sk[w * 128 + lane] = b0 * sc; sk[w * 128 + 64 + lane] = b1 * sc;
  }
  __syncthreads();
  const int v = tid & 127, half = tid >> 7;
  float S[64];
  const float* s0 = p.state_delta + (((size_t)b * 4 + h) * 128 + half * 64) * 128 + v;
#pragma unroll
  for (int i = 0; i < 64; ++i) S[i] = s0[(size_t)i * 128];
#pragma unroll 1
  for (int t = 0; t < 4; ++t) {
    const size_t row = (size_t)MP + b * 4 + t;
    const float a = __expf(p.gb[row * 8 + h]);
    const float beta = p.gb[row * 8 + 4 + h];
    float part = 0.f;
#pragma unroll
    for (int i = 0; i < 64; ++i) part += S[i] * sk[t * 128 + half * 64 + i];
    red[half * 128 + v] = part;
    __syncthreads();
    const float kS = red[v] + red[128 + v];
    const float u = beta * (sv[t * 128 + v] - a * kS);
    float po = 0.f;
#pragma unroll
    for (int i = 0; i < 64; ++i) { S[i] = a * S[i] + sk[t * 128 + half * 64 + i] * u; po += S[i] * sq[t * 128 + half * 64 + i]; }
    __syncthreads();
    red[half * 128 + v] = po;
    __syncthreads();
    if (half == 0) p.odn[row * 512 + h * 128 + v] = f2bf(red[v] + red[128 + v]);
    __syncthreads();
  }
  float* d = p.out + O_SDELTA + (((size_t)b * 4 + h) * 128 + half * 64) * 128 + v;
#pragma unroll
  for (int i = 0; i < 64; ++i) d[(size_t)i * 128] = S[i];
}

DI void phase2(const Params& p, char* smem) {
  const size_t gtid = (size_t)blockIdx.x * 256 + threadIdx.x, gsz = (size_t)gridDim.x * 256;
  for (int j = blockIdx.x; j < 2048 + 128 + 6144; j += gridDim.x) {
    if (j < 2048) dn_prep(p, j, smem);
    else if (j < 2048 + 128) dn_sample(p, j - 2048, smem);
    else vt_tile(p, j - 2176, smem);
  }
  for (size_t f = gtid; f < (size_t)16 * 8192; f += gsz) {
    {
      const size_t e0 = f * 8;
      const int bh = (int)(e0 >> 16), key = (int)((e0 >> 8) & 255), dh = (int)(e0 & 255);
      const int b = bh >> 2, h = bh & 3;
      cvt8(p.out + O_PMEM + (((size_t)b * 256 + key) * 2 + 0) * 1024 + h * 256 + dh, p.Kb + e0);
    }
    {
      const int l = (int)(f & 63), ks = (int)((f >> 6) & 7), nt = (int)((f >> 9) & 15), bh = (int)(f >> 13);
      const int b = bh >> 2, h = bh & 3, rr = l & 15, kgg = l >> 4;
      float v[8];
#pragma unroll
      for (int j = 0; j < 8; ++j) {
        const int key = ks * 32 + permk(kgg, j);
        v[j] = p.out[O_PMEM + (((size_t)b * 256 + key) * 2 + 1) * 1024 + h * 256 + nt * 16 + rr];
      }
      *(uint4*)&p.VTf[f * 8] = make_uint4(pack2(v[0], v[1]), pack2(v[2], v[3]), pack2(v[4], v[5]), pack2(v[6], v[7]));
    }
  }
  for (size_t i = gtid; i < 18432; i += gsz) {
    const int c = (int)(i % 1536), j = (int)((i / 1536) % 3), b = (int)(i / 4608);
    p.out[O_PCONV + i] = bf2f(p.proj[((size_t)b * SEQ + SEQ - 3 + j) * NP + c]);
  }
  for (int g = 0; g < 3; ++g) {
    const int W = 128 << (2 * g);
    const size_t off = (g == 0) ? O_PW1 : (g == 1 ? O_PW2 : O_PW3);
    const size_t n4 = (size_t)4 * W * 512 / 4;
    for (size_t i = gtid; i < n4; i += gsz) {
      const size_t e0 = i * 4;
      const int e = (int)(e0 & 511), ii = (int)((e0 >> 9) % W), b = (int)((e0 >> 9) / W);
      uint2 v = *(const uint2*)&p.proj[((size_t)b * SEQ + SEQ - W + ii) * NP + 2048 + g * 768 + 256 + e];
      *(float4*)&p.out[off + e0] = make_float4(bflo(v.x), bfhi(v.x), bflo(v.y), bfhi(v.y));
    }
  }
}

DI void dn_scan_wave(const Params& p, int widx) {
  const int lane = threadIdx.x & 63, r = lane & 15, kg = lane >> 4;
  const int bh = widx >> 3, s = widx & 7, b = bh >> 2, h = bh & 3;
  f32x4 S[8];
#pragma unroll
  for (int i = 0; i < 8; ++i) S[i] = (f32x4){0.f, 0.f, 0.f, 0.f};
#pragma unroll 1
  for (int n = 0; n < 128; ++n) {
    const char* base = p.dnops + (size_t)(bh * 128 + n) * DN_ITEM;
    const bf16x8* negW = (const bf16x8*)base;
    const bf16x8* qg = (const bf16x8*)(base + 16384);
    const bf16x8* kdT = (const bf16x8*)(base + 32768);
    const bf16x8* aqk = (const bf16x8*)(base + 49152);
    const uint2* u0 = (const uint2*)(base + 57344);
    const float dl = p.dl[bh * 128 + n];
    bf16x8 Sb[4];
#pragma unroll
    for (int ks = 0; ks < 4; ++ks) Sb[ks] = pack8(S[2 * ks], S[2 * ks + 1]);
    f32x4 u[4];
#pragma unroll
    for (int mt = 0; mt < 4; ++mt) {
      uint2 t = u0[(s * 4 + mt) * 64 + lane];
      u[mt] = (f32x4){bflo(t.x), bfhi(t.x), bflo(t.y), bfhi(t.y)};
#pragma unroll
      for (int ks = 0; ks < 4; ++ks) u[mt] = MFMA(negW[(mt * 4 + ks) * 64 + lane], Sb[ks], u[mt]);
    }
    bf16x8 ub[2];
    ub[0] = pack8(u[0], u[1]); ub[1] = pack8(u[2], u[3]);
#pragma unroll
    for (int mt = 0; mt < 4; ++mt) {
      f32x4 o = (f32x4){0.f, 0.f, 0.f, 0.f};
#pragma unroll
      for (int ks = 0; ks < 4; ++ks) o = MFMA(qg[(mt * 4 + ks) * 64 + lane], Sb[ks], o);
#pragma unroll
      for (int k2 = 0; k2 < 2; ++k2) o = MFMA(aqk[(mt * 2 + k2) * 64 + lane], ub[k2], o);
#pragma unroll
      for (int j = 0; j < 4; ++j) {
        const size_t token = (size_t)b * SEQ + n * 64 + mt * 16 + kg * 4 + j;
        p.odn[token * 512 + h * 128 + s * 16 + r] = f2bf(o[j]);
      }
    }
#pragma unroll
    for (int m8 = 0; m8 < 8; ++m8) {
      S[m8] = S[m8] * dl;
#pragma unroll
      for (int k2 = 0; k2 < 2; ++k2) S[m8] = MFMA(kdT[(m8 * 2 + k2) * 64 + lane], ub[k2], S[m8]);
    }
  }
#pragma unroll
  for (int m8 = 0; m8 < 8; ++m8)
#pragma unroll
    for (int j = 0; j < 4; ++j)
      p.out[O_PDELTA + ((size_t)bh * 128 + m8 * 16 + kg * 4 + j) * 128 + s * 16 + r] = S[m8][j];
}

DI void sw_prompt_wave(const Params& p, int item) {
  const int lane = threadIdx.x & 63, r = lane & 15, kg = lane >> 4;
  const int qt = item & 511, gbh = item >> 9;
  const int h = gbh & 3, b = (gbh >> 2) & 3, g = gbh >> 4;
  const int dsh = 2 * g, ln = SEQ >> dsh;
  const int pos0 = qt * 16, rres = pos0 / ln, i0 = pos0 % ln;
  const int kbase = i0 - 144;
  const size_t rb = (size_t)b * SEQ;
  const int qoff = 2048 + g * 768 + h * 64, koff = qoff + 256;
  bf16x8 qf[2];
  {
    const size_t tok = rb + ((size_t)(i0 + r) << dsh) + rres;
#pragma unroll
    for (int ks = 0; ks < 2; ++ks) qf[ks] = *(const bf16x8*)&p.proj[tok * NP + qoff + ks * 32 + kg * 8];
  }
  f32x4 st[10];
#pragma unroll
  for (int mt = 0; mt < 10; ++mt) {
    int ki = kbase + mt * 16 + r; ki = ki < 0 ? 0 : ki;
    const size_t tok = rb + ((size_t)ki << dsh) + rres;
    f32x4 a = (f32x4){0.f, 0.f, 0.f, 0.f};
#pragma unroll
    for (int ks = 0; ks < 2; ++ks) {
      bf16x8 kf = *(const bf16x8*)&p.proj[tok * NP + koff + ks * 32 + kg * 8];
      a = MFMA(kf, qf[ks], a);
    }
    st[mt] = a;
  }
  const int qi = i0 + r;
  float mx = -3.0e38f;
#pragma unroll
  for (int mt = 0; mt < 10; ++mt)
#pragma unroll
    for (int j = 0; j < 4; ++j) {
      const int ki = kbase + mt * 16 + kg * 4 + j;
      const int d = qi - ki;
      const bool valid = (ki >= 0) && (d >= 0) && (d <= 128);
      const float sv = valid ? st[mt][j] * 0.125f : -3.0e38f;
      st[mt][j] = sv;
      mx = fmaxf(mx, sv);
    }
  mx = fmaxf(mx, __shfl_xor(mx, 16));
  mx = fmaxf(mx, __shfl_xor(mx, 32));
  float sum = 0.f;
#pragma unroll
  for (int mt = 0; mt < 10; ++mt)
#pragma unroll
    for (int j = 0; j < 4; ++j) {
      const float pv = (st[mt][j] > -1.0e38f) ? __expf(st[mt][j] - mx) : 0.f;
      st[mt][j] = pv;
      sum += pv;
    }
  sum += __shfl_xor(sum, 16);
  sum += __shfl_xor(sum, 32);
  const float inv = 1.f / sum;
  bf16x8 pf[5];
#pragma unroll
  for (int k2 = 0; k2 < 5; ++k2) pf[k2] = pack8(st[2 * k2], st[2 * k2 + 1]);
  const size_t qrow = rb + ((size_t)qi << dsh) + rres;
#pragma unroll
  for (int nt = 0; nt < 4; ++nt) {
    f32x4 o = (f32x4){0.f, 0.f, 0.f, 0.f};
    const u16* vrow = &p.vT[((size_t)gbh * 64 + nt * 16 + r) * SEQ + (size_t)rres * ln];
#pragma unroll
    for (int k2 = 0; k2 < 5; ++k2) {
      int ka = kbase + k2 * 32 + kg * 4, kc = ka + 16;
      ka = ka < 0 ? 0 : ka; kc = kc < 0 ? 0 : kc;
      uint2 va = *(const uint2*)&vrow[ka];
      uint2 vc = *(const uint2*)&vrow[kc];
      bf16x8 vf = __builtin_bit_cast(bf16x8, make_uint4(va.x, va.y, vc.x, vc.y));
      o = MFMA(vf, pf[k2], o);
    }
    uint2 ov; ov.x = pack2(o[0] * inv, o[1] * inv); ov.y = pack2(o[2] * inv, o[3] * inv);
    *(uint2*)&p.osw[((size_t)g * MT + qrow) * 256 + h * 64 + nt * 16 + kg * 4] = ov;
  }
  if (kg == 0) p.lse[((size_t)g * MT + qrow) * 4 + h] = mx + __logf(sum);
}

DI void sw_sample_wave(const Params& p, int item) {
  const int lane = threadIdx.x & 63;
  const int t = item & 3, h = (item >> 2) & 3, b = (item >> 4) & 31, g = item >> 9;
  const int dil = 1 << (2 * g), W = 128 << (2 * g);
  const float* c1 = p.cw1;
  const float* c2 = p.cw2;
  const float* c3 = p.cw3;
  const float* cache = (g == 0) ? c1 : (g == 1 ? c2 : c3);
  const int qoff = 2048 + g * 768 + h * 64;
  const size_t qrow = (size_t)MP + b * 4 + t;
  float q[64];
#pragma unroll
  for (int c = 0; c < 64; c += 8) {
    uint4 v = *(const uint4*)&p.proj[qrow * NP + qoff + c];
    q[c] = bflo(v.x); q[c + 1] = bfhi(v.x); q[c + 2] = bflo(v.y); q[c + 3] = bfhi(v.y);
    q[c + 4] = bflo(v.z); q[c + 5] = bfhi(v.z); q[c + 6] = bflo(v.w); q[c + 7] = bfhi(v.w);
  }
  float sc[3];
#pragma unroll
  for (int mi = 0; mi < 3; ++mi) {
    const int m = lane + 64 * mi;
    float s = -3.0e38f;
    if (m <= 128) {
      const int j = W + t - m * dil;
      float d = 0.f;
      if (j >= W) {
        const u16* kr = &p.proj[((size_t)MP + b * 4 + (j - W)) * NP + qoff + 256];
#pragma unroll
        for (int c = 0; c < 64; c += 8) {
          uint4 v = *(const uint4*)&kr[c];
          d += q[c] * bflo(v.x) + q[c + 1] * bfhi(v.x) + q[c + 2] * bflo(v.y) + q[c + 3] * bfhi(v.y) + q[c + 4] * bflo(v.z) +
               q[c + 5] * bfhi(v.z) + q[c + 6] * bflo(v.w) + q[c + 7] * bfhi(v.w);
        }
      } else {
        const float* kr = &cache[(((size_t)b * W + j) * 2 + 0) * 256 + h * 64];
#pragma unroll
        for (int c = 0; c < 64; c += 4) {
          float4 v = *(const float4*)&kr[c];
          d += q[c] * v.x + q[c + 1] * v.y + q[c + 2] * v.z + q[c + 3] * v.w;
        }
      }
      s = d * 0.125f;
    }
    sc[mi] = s;
  }
  float mx = wave_max(fmaxf(fmaxf(sc[0], sc[1]), sc[2]));
  float sum = 0.f;
#pragma unroll
  for (int mi = 0; mi < 3; ++mi) { sc[mi] = (sc[mi] > -1.0e38f) ? __expf(sc[mi] - mx) : 0.f; sum += sc[mi]; }
  sum = wave_sum(sum);
  float o = 0.f;
#pragma unroll 1
  for (int m = 0; m <= 128; ++m) {
    const float pv = (m < 64) ? __shfl(sc[0], m) : ((m < 128) ? __shfl(sc[1], m - 64) : __shfl(sc[2], 0));
    const int j = W + t - m * dil;
    float vv;
    if (j >= W) vv = bf2f(p.proj[((size_t)MP + b * 4 + (j - W)) * NP + qoff + 512 + lane]);
    else vv = cache[(((size_t)b * W + j) * 2 + 1) * 256 + h * 64 + lane];
    o += pv * vv;
  }
  p.osw[((size_t)g * MT + qrow) * 256 + h * 64 + lane] = f2bf(o / sum);
  if (lane == 0) p.lse[((size_t)g * MT + qrow) * 4 + h] = mx + __logf(sum);
}

DI void phase3(const Params& p) {
  const int w = threadIdx.x >> 6;
  if (blockIdx.x < 32) {
    dn_scan_wave(p, blockIdx.x * 4 + w);
  } else {
    const int gw = (blockIdx.x - 32) * 4 + w, nw = (gridDim.x - 32) * 4;
    for (int it = gw; it < 24576 + 1536; it += nw) {
      if (it < 24576) sw_prompt_wave(p, it);
      else sw_sample_wave(p, it - 24576);
    }
  }
}

DI void phase4(const Params& p) {
  const int lane = threadIdx.x & 63, w = threadIdx.x >> 6;
  for (int row = blockIdx.x * 4 + w; row < MT; row += gridDim.x * 4) {
    u16* dst = p.Amix + (size_t)row * 768;
#pragma unroll
    for (int h = 0; h < 4; ++h) {
      unsigned ov = *(const unsigned*)&p.odn[(size_t)row * 512 + h * 128 + lane * 2];
      unsigned zv = *(const unsigned*)&p.proj[(size_t)row * NP + 1536 + h * 128 + lane * 2];
      float o0 = bflo(ov), o1 = bfhi(ov);
      float ss = wave_sum(o0 * o0 + o1 * o1);
      float rs = rsqrtf(ss * (1.f / 128.f) + EPS);
      float2 gn = *(const float2*)&p.g_onorm[lane * 2];
      float y0 = o0 * rs * gn.x * siluf(bflo(zv)), y1 = o1 * rs * gn.y * siluf(bfhi(zv));
      *(unsigned*)&dst[h * 128 + lane * 2] = pack2(y0, y1);
    }
    {
      const int h = lane >> 4;
      float l0 = p.lse[((size_t)0 * MT + row) * 4 + h], l1 = p.lse[((size_t)1 * MT + row) * 4 + h], l2 = p.lse[((size_t)2 * MT + row) * 4 + h];
      float m = fmaxf(l0, fmaxf(l1, l2));
      float e0 = __expf(l0 - m), e1 = __expf(l1 - m), e2 = __expf(l2 - m);
      float inv = 1.f / (e0 + e1 + e2);
      uint2 a = *(const uint2*)&p.osw[((size_t)0 * MT + row) * 256 + lane * 4];
      uint2 c = *(const uint2*)&p.osw[((size_t)1 * MT + row) * 256 + lane * 4];
      uint2 d = *(const uint2*)&p.osw[((size_t)2 * MT + row) * 256 + lane * 4];
      e0 *= inv; e1 *= inv; e2 *= inv;
      float y0 = e0 * bflo(a.x) + e1 * bflo(c.x) + e2 * bflo(d.x);
      float y1 = e0 * bfhi(a.x) + e1 * bfhi(c.x) + e2 * bfhi(d.x);
      float y2 = e0 * bflo(a.y) + e1 * bflo(c.y) + e2 * bflo(d.y);
      float y3 = e0 * bfhi(a.y) + e1 * bfhi(c.y) + e2 * bfhi(d.y);
      *(uint2*)&dst[512 + lane * 4] = make_uint2(pack2(y0, y1), pack2(y2, y3));
    }
  }
}

DI void sample_state_copy(const Params& p) {
  const size_t gtid = (size_t)blockIdx.x * 256 + threadIdx.x, gsz = (size_t)gridDim.x * 256;
  for (size_t i = gtid; i < 147456; i += gsz) {
    const int c = (int)(i % 1536), j = (int)((i / 1536) % 3), b = (int)(i / 4608);
    p.out[O_SCONV + i] = bf2f(p.proj[((size_t)MP + b * 4 + j + 1) * NP + c]);
  }
  const float* c1 = p.cw1;
  const float* c2 = p.cw2;
  const float* c3 = p.cw3;
  for (int g = 0; g < 3; ++g) {
    const int W = 128 << (2 * g);
    const float* cache = (g == 0) ? c1 : (g == 1 ? c2 : c3);
    const size_t off = (g == 0) ? O_SW1 : (g == 1 ? O_SW2 : O_SW3);
    const size_t n4 = (size_t)32 * W * 512 / 4;
    for (size_t i = gtid; i < n4; i += gsz) {
      const size_t e0 = i * 4;
      const int e = (int)(e0 & 511), ii = (int)((e0 >> 9) % W), b = (int)((e0 >> 9) / W);
      float4 o;
      if (ii < W - 4) o = *(const float4*)&cache[((size_t)b * W + ii + 4) * 512 + e];
      else {
        uint2 v = *(const uint2*)&p.proj[((size_t)MP + b * 4 + (ii - (W - 4))) * NP + 2048 + g * 768 + 256 + e];
        o = make_float4(bflo(v.x), bfhi(v.x), bflo(v.y), bfhi(v.y));
      }
      *(float4*)&p.out[off + e0] = o;
    }
  }
}

DI void mem_attn_prompt_wave(const Params& p, int item) {
  const int lane = threadIdx.x & 63, r = lane & 15, kg = lane >> 4;
  const int h = item & 3, qt = item >> 2;
  const int row0 = qt * 16, b = row0 >> 13;
  const int bh = b * 4 + h;
  bf16x8 qf[8];
#pragma unroll
  for (int ks = 0; ks < 8; ++ks) qf[ks] = *(const bf16x8*)&p.qb[(size_t)(row0 + r) * 1024 + h * 256 + ks * 32 + kg * 8];
  f32x4 st[16];
  const u16* kbp = p.Kb + (size_t)bh * 65536;
#pragma unroll
  for (int mt = 0; mt < 16; ++mt) {
    f32x4 a = (f32x4){0.f, 0.f, 0.f, 0.f};
#pragma unroll
    for (int ks = 0; ks < 8; ++ks) {
      bf16x8 kf = *(const bf16x8*)&kbp[(mt * 16 + r) * 256 + ks * 32 + kg * 8];
      a = MFMA(kf, qf[ks], a);
    }
    st[mt] = a;
  }
  float mx = -3.0e38f;
#pragma unroll
  for (int mt = 0; mt < 16; ++mt)
#pragma unroll
    for (int j = 0; j < 4; ++j) { st[mt][j] *= 0.0625f; mx = fmaxf(mx, st[mt][j]); }
  mx = fmaxf(mx, __shfl_xor(mx, 16));
  mx = fmaxf(mx, __shfl_xor(mx, 32));
  float sum = 0.f;
#pragma unroll
  for (int mt = 0; mt < 16; ++mt)
#pragma unroll
    for (int j = 0; j < 4; ++j) { st[mt][j] = __expf(st[mt][j] - mx); sum += st[mt][j]; }
  sum += __shfl_xor(sum, 16);
  sum += __shfl_xor(sum, 32);
  const float inv = 1.f / sum;
  bf16x8 pf[8];
#pragma unroll
  for (int k2 = 0; k2 < 8; ++k2) pf[k2] = pack8(st[2 * k2], st[2 * k2 + 1]);
  const bf16x8* vt = (const bf16x8*)(p.VTf + (size_t)bh * 65536);
#pragma unroll 2
  for (int nt = 0; nt < 16; ++nt) {
    f32x4 o = (f32x4){0.f, 0.f, 0.f, 0.f};
#pragma unroll
    for (int k2 = 0; k2 < 8; ++k2) o = MFMA(vt[(nt * 8 + k2) * 64 + lane], pf[k2], o);
    uint2 ov; ov.x = pack2(o[0] * inv, o[1] * inv); ov.y = pack2(o[2] * inv, o[3] * inv);
    *(uint2*)&p.attn[(size_t)(row0 + r) * 1024 + h * 256 + nt * 16 + kg * 4] = ov;
  }
}

DI void mem_attn_sample_wave(const Params& p, int item, float* lds) {
  const int lane = threadIdx.x & 63;
  const int b = item >> 2, h = item & 3;
  float* sq = lds;
#pragma unroll
  for (int t = 0; t < 4; ++t) {
    uint2 v = *(const uint2*)&p.qb[((size_t)MP + b * 4 + t) * 1024 + h * 256 + lane * 4];
    *(float4*)&sq[t * 256 + lane * 4] = make_float4(bflo(v.x), bfhi(v.x), bflo(v.y), bfhi(v.y));
  }
  __builtin_amdgcn_s_waitcnt(0);
  __builtin_amdgcn_wave_barrier();
  float sc[4][4];
#pragma unroll
  for (int mi = 0; mi < 4; ++mi) {
    const int m = lane + 64 * mi;
    const float* kr = &p.cache_mem[(((size_t)b * 256 + m) * 2 + 0) * 1024 + h * 256];
    float d0 = 0.f, d1 = 0.f, d2 = 0.f, d3 = 0.f;
#pragma unroll 2
    for (int c = 0; c < 256; c += 4) {
      float4 kv = *(const float4*)&kr[c];
      float4 q0 = *(const float4*)&sq[c], q1 = *(const float4*)&sq[256 + c], q2 = *(const float4*)&sq[512 + c], q3 = *(const float4*)&sq[768 + c];
      d0 += kv.x * q0.x + kv.y * q0.y + kv.z * q0.z + kv.w * q0.w;
      d1 += kv.x * q1.x + kv.y * q1.y + kv.z * q1.z + kv.w * q1.w;
      d2 += kv.x * q2.x + kv.y * q2.y + kv.z * q2.z + kv.w * q2.w;
      d3 += kv.x * q3.x + kv.y * q3.y + kv.z * q3.z + kv.w * q3.w;
    }
    sc[0][mi] = d0 * 0.0625f; sc[1][mi] = d1 * 0.0625f; sc[2][mi] = d2 * 0.0625f; sc[3][mi] = d3 * 0.0625f;
  }
  float inv[4];
  __builtin_amdgcn_wave_barrier();
#pragma unroll
  for (int t = 0; t < 4; ++t) {
    float mx = wave_max(fmaxf(fmaxf(sc[t][0], sc[t][1]), fmaxf(sc[t][2], sc[t][3])));
    float sum = 0.f;
#pragma unroll
    for (int mi = 0; mi < 4; ++mi) { sc[t][mi] = __expf(sc[t][mi] - mx); sum += sc[t][mi]; }
    sum = wave_sum(sum);
    inv[t] = 1.f / sum;
#pragma unroll
    for (int mi = 0; mi < 4; ++mi) sq[t * 256 + lane + 64 * mi] = sc[t][mi];
  }
  __builtin_amdgcn_s_waitcnt(0);
  __builtin_amdgcn_wave_barrier();
  float4 o[4];
#pragma unroll
  for (int t = 0; t < 4; ++t) o[t] = make_float4(0.f, 0.f, 0.f, 0.f);
#pragma unroll 4
  for (int m = 0; m < 256; ++m) {
    float4 vv = *(const float4*)&p.cache_mem[(((size_t)b * 256 + m) * 2 + 1) * 1024 + h * 256 + lane * 4];
#pragma unroll
    for (int t = 0; t < 4; ++t) {
      const float pv = sq[t * 256 + m];
      o[t].x += pv * vv.x; o[t].y += pv * vv.y; o[t].z += pv * vv.z; o[t].w += pv * vv.w;
    }
  }
#pragma unroll
  for (int t = 0; t < 4; ++t) {
    uint2 ov; ov.x = pack2(o[t].x * inv[t], o[t].y * inv[t]); ov.y = pack2(o[t].z * inv[t], o[t].w * inv[t]);
    *(uint2*)&p.attn[((size_t)MP + b * 4 + t) * 1024 + h * 256 + lane * 4] = ov;
  }
  __builtin_amdgcn_wave_barrier();
}

DI void phase7(const Params& p, char* smem) {
  const int w = threadIdx.x >> 6;
  const int gw = blockIdx.x * 4 + w, nw = gridDim.x * 4;
  float* lds = (float*)smem + w * 1280;
  for (int it = gw; it < 128 + 8192; it += nw) {
    if (it < 128) mem_attn_sample_wave(p, it, lds);
    else mem_attn_prompt_wave(p, it - 128);
  }
}

DI void peer_topk_wave(const Params& p, int item, unsigned* lds  ) {
  const int lane = threadIdx.x & 63, r = lane & 15, kg = lane >> 4;
  const int h = item & 7, row0 = (item >> 3) * 16;
  unsigned win[2][16];
#pragma unroll
  for (int pp = 0; pp < 2; ++pp) {
    bf16x8 qf[4];
#pragma unroll
    for (int ks = 0; ks < 4; ++ks) qf[ks] = *(const bf16x8*)&p.pq[(size_t)(row0 + r) * 2048 + h * 256 + pp * 128 + ks * 32 + kg * 8];
    unsigned kk[32];
    const u16* sk = p.subkb + (size_t)(h * 2 + pp) * 16384;
#pragma unroll
    for (int mt = 0; mt < 8; ++mt) {
      f32x4 a = (f32x4){0.f, 0.f, 0.f, 0.f};
#pragma unroll
      for (int ks = 0; ks < 4; ++ks) {
        bf16x8 kf = *(const bf16x8*)&sk[(mt * 16 + r) * 128 + ks * 32 + kg * 8];
        a = MFMA(kf, qf[ks], a);
      }
#pragma unroll
      for (int j = 0; j < 4; ++j) kk[mt * 4 + j] = (ordf(a[j]) & ~127u) | (unsigned)(mt * 16 + kg * 4 + j);
    }
#pragma unroll
    for (int rr = 0; rr < 16; ++rr) {
      unsigned m = 0;
#pragma unroll
      for (int i = 0; i < 32; ++i) m = umax(m, kk[i]);
      m = umax(m, (unsigned)__shfl_xor((int)m, 16));
      m = umax(m, (unsigned)__shfl_xor((int)m, 32));
      win[pp][rr] = m;
#pragma unroll
      for (int i = 0; i < 32; ++i) kk[i] = (kk[i] == m) ? 0u : kk[i];
    }
  }
  float f0[16], f1[16];
#pragma unroll
  for (int i = 0; i < 16; ++i) { f0[i] = unordf(win[0][i] & ~127u); f1[i] = unordf(win[1][i] & ~127u); }
  unsigned cand[13];
#define CAND(s, a0, b0, a1, b1, a2, b2, a3, b3)                                                         \
  {                                                                                                     \
    float va = sel4(kg, f0[a0], f0[a1], f0[a2], f0[(a3) < 0 ? 0 : (a3)]);                                \
    float vb = sel4(kg, f1[b0], f1[b1], f1[b2], f1[(b3) < 0 ? 0 : (b3)]);                                \
    unsigned id = sel4(kg, (unsigned)((a0) * 16 + (b0)), (unsigned)((a1) * 16 + (b1)), (unsigned)((a2) * 16 + (b2)), (unsigned)(((a3) < 0 ? 0 : (a3)) * 16 + ((b3) < 0 ? 0 : (b3)))); \
    unsigned key = (ordf(va + vb) & ~255u) | id;                                                        \
    if ((a3) < 0) key = (kg == 3) ? 0u : key;                                                           \
    cand[s] = key;                                                                                      \
  }
  CAND(0, 0, 0, 0, 13, 2, 0, 6, 1)
  CAND(1, 0, 1, 0, 14, 2, 1, 7, 0)
  CAND(2, 0, 2, 0, 15, 2, 2, 7, 1)
  CAND(3, 0, 3, 1, 0, 2, 3, 8, 0)
  CAND(4, 0, 4, 1, 1, 2, 4, 9, 0)
  CAND(5, 0, 5, 1, 2, 3, 0, 10, 0)
  CAND(6, 0, 6, 1, 3, 3, 1, 11, 0)
  CAND(7, 0, 7, 1, 4, 3, 2, 12, 0)
  CAND(8, 0, 8, 1, 5, 3, 3, 13, 0)
  CAND(9, 0, 9, 1, 6, 4, 2, 14, 0)
  CAND(10, 0, 10, 1, 7, 5, 0, 15, 0)
  CAND(11, 0, 11, 4, 0, 5, 1, -1, -1)
  CAND(12, 0, 12, 4, 1, 6, 0, -1, -1)
#undef CAND
  unsigned w2[16];
#pragma unroll
  for (int rr = 0; rr < 16; ++rr) {
    unsigned m = 0;
#pragma unroll
    for (int i = 0; i < 13; ++i) m = umax(m, cand[i]);
    m = umax(m, (unsigned)__shfl_xor((int)m, 16));
    m = umax(m, (unsigned)__shfl_xor((int)m, 32));
    w2[rr] = m;
#pragma unroll
    for (int i = 0; i < 13; ++i) cand[i] = (cand[i] == m) ? 0u : cand[i];
  }
  if (kg == 0) {
#pragma unroll
    for (int i = 0; i < 16; ++i) { lds[r * 32 + i] = win[0][i] & 127u; lds[r * 32 + 16 + i] = win[1][i] & 127u; }
  }
  __builtin_amdgcn_s_waitcnt(0);
  __builtin_amdgcn_wave_barrier();
  const float cv0 = unordf(w2[0] & ~255u);
  float sum = 0.f;
#pragma unroll
  for (int rr = 0; rr < 16; ++rr) sum += __expf(unordf(w2[rr] & ~255u) - cv0);
  const float inv = 1.f / sum;
  const size_t ob = ((size_t)(row0 + r) * 8 + h) * 16;
#pragma unroll
  for (int q = 0; q < 4; ++q) {
    const unsigned wk = sel4(kg, w2[q], w2[4 + q], w2[8 + q], w2[12 + q]);
    const int a = (wk >> 4) & 15, bb = wk & 15;
    const int i1 = (int)lds[r * 32 + a], i2 = (int)lds[r * 32 + 16 + bb];
    p.eid[ob + kg * 4 + q] = i1 * 128 + i2;
    p.gate[ob + kg * 4 + q] = __expf(unordf(wk & ~255u) - cv0) * inv;
  }
  __builtin_amdgcn_wave_barrier();
}

typedef __attribute__((ext_vector_type(2))) float f32x2;
DI float dot16_fp8(uint4 u, const float* x, float c) {
  const unsigned d[4] = {u.x, u.y, u.z, u.w};
#pragma unroll
  for (int i = 0; i < 4; ++i) {
    f32x2 a = __builtin_amdgcn_cvt_pk_f32_fp8((int)d[i], false);
    f32x2 b = __builtin_amdgcn_cvt_pk_f32_fp8((int)d[i], true);
    c += a[0] * x[4 * i] + a[1] * x[4 * i + 1] + b[0] * x[4 * i + 2] + b[1] * x[4 * i + 3];
  }
  return c;
}
DI void axpy16_fp8(float* o, float w, uint4 u) {
  const unsigned d[4] = {u.x, u.y, u.z, u.w};
#pragma unroll
  for (int i = 0; i < 4; ++i) {
    f32x2 a = __builtin_amdgcn_cvt_pk_f32_fp8((int)d[i], false);
    f32x2 b = __builtin_amdgcn_cvt_pk_f32_fp8((int)d[i], true);
    o[4 * i] += w * a[0]; o[4 * i + 1] += w * a[1]; o[4 * i + 2] += w * b[0]; o[4 * i + 3] += w * b[1];
  }
}

DI void peer_expert_wave(const Params& p, int row) {
  const int lane = threadIdx.x & 63;
  float xf[16];
  {
    const uint4 x0 = *(const uint4*)&p.A2[(size_t)row * 1024 + lane * 16];
    const uint4 x1 = *(const uint4*)&p.A2[(size_t)row * 1024 + lane * 16 + 8];
    xf[0] = bflo(x0.x); xf[1] = bfhi(x0.x); xf[2] = bflo(x0.y); xf[3] = bfhi(x0.y);
    xf[4] = bflo(x0.z); xf[5] = bfhi(x0.z); xf[6] = bflo(x0.w); xf[7] = bfhi(x0.w);
    xf[8] = bflo(x1.x); xf[9] = bfhi(x1.x); xf[10] = bflo(x1.y); xf[11] = bfhi(x1.y);
    xf[12] = bflo(x1.z); xf[13] = bfhi(x1.z); xf[14] = bflo(x1.w); xf[15] = bfhi(x1.w);
  }
  const float r2 = rsqrtf(p.ssq2[row] * (1.f / 1024.f) + EPS);
  const unsigned char* EU8 = p.E8;
  const unsigned char* EV8 = p.E8 + (size_t)16384 * 1024;
  float out[16];
#pragma unroll
  for (int i = 0; i < 16; ++i) out[i] = 0.f;
#pragma unroll 1
  for (int bt = 0; bt < 2; ++bt) {
    const int eidv = p.eid[(size_t)row * 128 + bt * 64 + lane];
    const float gv = p.gate[(size_t)row * 128 + bt * 64 + lane];
    const float rsu = p.rs[eidv], rsv = p.rs[16384 + eidv];
    float part[64];
#pragma unroll
    for (int e = 0; e < 64; ++e) {
      const int id = __builtin_amdgcn_readlane(eidv, e);
      const uint4 u = *(const uint4*)(EU8 + (size_t)id * 1024 + lane * 16);
      part[e] = dot16_fp8(u, xf, 0.f);
    }
#pragma unroll
    for (int off = 32; off > 0; off >>= 1) {
      const bool up = (lane & off) != 0;
#pragma unroll
      for (int i = 0; i < off; ++i) {
        const float a = part[i], bq = part[i + off];
        const float send = up ? a : bq, keep = up ? bq : a;
        part[i] = keep + __shfl_xor(send, off);
      }
    }
    const float wv = gv * geluf(part[0] * r2 * rsu) * rsv;
#pragma unroll 8
    for (int e = 0; e < 64; ++e) {
      const int id = __builtin_amdgcn_readlane(eidv, e);
      const float we = __int_as_float(__builtin_amdgcn_readlane(__float_as_int(wv), e));
      const uint4 v = *(const uint4*)(EV8 + (size_t)id * 1024 + lane * 16);
      axpy16_fp8(out, we, v);
    }
  }
  const float* hr = p.h2 + (size_t)row * 1024 + lane * 16;
  float hv[16];
  float ss = 0.f;
#pragma unroll
  for (int i = 0; i < 4; ++i) {
    float4 t = *(const float4*)&hr[i * 4];
    hv[4 * i] = t.x + out[4 * i]; hv[4 * i + 1] = t.y + out[4 * i + 1]; hv[4 * i + 2] = t.z + out[4 * i + 2]; hv[4 * i + 3] = t.w + out[4 * i + 3];
    ss += hv[4 * i] * hv[4 * i] + hv[4 * i + 1] * hv[4 * i + 1] + hv[4 * i + 2] * hv[4 * i + 2] + hv[4 * i + 3] * hv[4 * i + 3];
  }
  ss = wave_sum(ss);
  const float rsn = rsqrtf(ss * (1.f / 1024.f) + EPS);
  float* y = ((row < MP) ? (p.out + O_YP + (size_t)row * 1024) : (p.out + O_YS + (size_t)(row - MP) * 1024)) + lane * 16;
#pragma unroll
  for (int i = 0; i < 4; ++i) {
    float4 g4 = *(const float4*)&p.g_final[lane * 16 + i * 4];
    *(float4*)&y[i * 4] = make_float4(hv[4 * i] * rsn * g4.x, hv[4 * i + 1] * rsn * g4.y, hv[4 * i + 2] * rsn * g4.z, hv[4 * i + 3] * rsn * g4.w);
  }
}

__global__ void __launch_bounds__(256, 2) mega(Params pk) {
  __shared__ __attribute__((aligned(16))) char smem[53248];
  __shared__ Params sp;
  cg::grid_group grid = cg::this_grid();
  const int w = threadIdx.x >> 6;
  if (threadIdx.x == 0) sp = pk;
  __syncthreads();
  const Params& p = sp;
#ifndef DBL
#define DBL -1
#endif
#define REP(ph) for (int rp_ = 0; rp_ < ((DBL == (ph)) ? 2 : 1); ++rp_)
  REP(0) { phase0(p, smem); if (DBL == 0) grid.sync(); }
  grid.sync();
  REP(1) for (int t = blockIdx.x; t < 257 * 34 + 128; t += gridDim.x) {
    if (t < 257 * 34) gemm_tile<0>(p, p.A0, 1024, p.WtIn, 1024, t / 34, t % 34, smem);
    else { int u = t - 257 * 34; gemm_tile<1>(p, p.Amem, 1024, p.WtMkv, 1024, u / 16, u % 16, smem); }
  }
  grid.sync();
  REP(2) { phase2(p, smem); if (DBL == 2) grid.sync(); }
  grid.sync();
  REP(3) { phase3(p); if (DBL == 3) grid.sync(); }
  grid.sync();
  REP(4) phase4(p);
  grid.sync();
  for (int t = blockIdx.x; t < 257 * 8; t += gridDim.x) gemm_tile<2>(p, p.Amix, 768, p.WtOut, 768, t / 8, t % 8, smem);
  grid.sync();
  REP(6) for (int t = blockIdx.x; t < 257 * 8; t += gridDim.x) gemm_tile<3>(p, p.A1, 1024, p.WtMq, 1024, t / 8, t % 8, smem);
  sample_state_copy(p);
  grid.sync();
  REP(7) phase7(p, smem);
  grid.sync();
  for (int t = blockIdx.x; t < 257 * 8; t += gridDim.x) gemm_tile<4>(p, p.attn, 1024, p.WtMo, 1024, t / 8, t % 8, smem);
  grid.sync();
  REP(9) for (int t = blockIdx.x; t < 257 * 16; t += gridDim.x) gemm_tile<5>(p, p.A2, 1024, p.WtPq, 1024, t / 16, t % 16, smem);
  grid.sync();
  REP(10) {
    unsigned* lds = (unsigned*)smem + w * 512;
    for (int it = blockIdx.x * 4 + w; it < 2056 * 8; it += gridDim.x * 4) peer_topk_wave(p, it, lds);
  }
  grid.sync();
  REP(11) for (int row = blockIdx.x * 4 + w; row < MT; row += gridDim.x * 4) peer_expert_wave(p, row);
}

extern "C" void kernel_launch(void* const* d_in, const int* in_sizes, int n_in, void* d_out, int out_size, void* d_ws, size_t ws_size,
                              hipStream_t stream) {
  static int grid_blocks = 0;
  if (!grid_blocks) {
    int dev = 0, cus = 0, per_cu = 0;
    (void)hipGetDevice(&dev);
    (void)hipDeviceGetAttribute(&cus, hipDeviceAttributeMultiprocessorCount, dev);
    (void)hipOccupancyMaxActiveBlocksPerMultiprocessor(&per_cu, mega, 256, 0);
    if (per_cu > 2) per_cu = 2;
    if (per_cu < 1) per_cu = 1;
    grid_blocks = cus * per_cu;
  }
  Params p{};
  const float* const* in = (const float* const*)d_in;
  p.x_prompt = in[0]; p.x_sample = in[1]; p.state_delta = in[2]; p.state_conv = in[3]; p.cw1 = in[4]; p.cw2 = in[5]; p.cw3 = in[6];
  p.cache_mem = in[7]; p.mem_prompt = in[8]; p.g_mix = in[9]; p.w_in = in[10]; p.conv_w = in[11]; p.a_log = in[12]; p.dt_bias = in[13];
  p.g_onorm = in[14]; p.w_out = in[15]; p.g_memq = in[16]; p.g_memkv = in[17]; p.w_mq = in[18]; p.w_mkv = in[19]; p.w_mo = in[20];
  p.g_ffn = in[21]; p.w_pq = in[22]; p.sub_keys = in[23]; p.expert_u = in[24]; p.expert_v = in[25]; p.g_final = in[26];
  p.out = (float*)d_out;
  char* ws = (char*)d_ws;
  size_t off = 0;
  auto take = [&](size_t bytes) { char* r = ws + off; off += (bytes + 255) & ~(size_t)255; return r; };
  p.WtIn = (u16*)take((size_t)NP * 1024 * 2);
  p.WtOut = (u16*)take((size_t)1024 * 768 * 2);
  p.WtMq = (u16*)take((size_t)1024 * 1024 * 2);
  p.WtMkv = (u16*)take((size_t)2048 * 1024 * 2);
  p.WtMo = (u16*)take((size_t)1024 * 1024 * 2);
  p.WtPq = (u16*)take((size_t)2048 * 1024 * 2);
  p.subkb = (u16*)take((size_t)262144 * 2);
  p.E8 = (unsigned char*)take((size_t)32768 * 1024);
  p.rs = (float*)take((size_t)32768 * 4);
  p.Amem = (u16*)take((size_t)1024 * 1024 * 2);
  p.gb = (float*)take((size_t)MT * 8 * 4);
  p.ssq1 = (float*)take((size_t)MT * 4);
  p.ssq2 = (float*)take((size_t)MT * 4);
  p.dl = (float*)take(2048 * 4);
  p.Kb = (u16*)take((size_t)16 * 65536 * 2);
  p.VTf = (u16*)take((size_t)16 * 65536 * 2);
  char* regA = take((size_t)MT * NP * 2);
  char* regB = take((size_t)2048 * DN_ITEM);
  p.proj = (u16*)regA;
  p.h1 = (float*)regA;
  p.h2 = (float*)(regA + (size_t)MT * 1024 * 4);
  p.pq = (u16*)regA;
  p.dnops = regB;
  p.A0 = (u16*)regB;
  p.A1 = (u16*)regB;
  p.qb = (u16*)(regB + (size_t)MT * 1024 * 2);
  p.attn = (u16*)regB;
  p.A2 = (u16*)(regB + (size_t)MT * 1024 * 2);
  p.eid = (int*)regB;
  p.gate = (float*)(regB + (size_t)MT * 128 * 4);
  char* ob = (char*)d_out;
  p.vT = (u16*)ob;
  p.osw = (u16*)(ob + (size_t)3 * MP * 256 * 2);
  p.lse = (float*)(ob + (size_t)3 * MP * 256 * 2 + (size_t)3 * MT * 256 * 2);
  char* sb = ob + O_SW3 * 4;
  p.odn = (u16*)sb;
  p.Amix = (u16*)(sb + (size_t)MT * 512 * 2);
  if (off > ws_size) { fprintf(stderr, "workspace too small: need %zu have %zu\n", off, ws_size); return; }
  void* args[] = {&p};
  hipError_t e = hipLaunchCooperativeKernel((void*)mega, dim3(grid_blocks), dim3(256), args, 0, stream);
  if (e != hipSuccess) fprintf(stderr, "coop launch failed: %s (grid %d)\n", hipGetErrorString(e), grid_blocks);
}
```

```cpp
#include <hip/hip_runtime.h>
#include <hip/hip_cooperative_groups.h>
#include <cstdio>
namespace cg = cooperative_groups;

typedef unsigned short u16;
typedef __attribute__((ext_vector_type(8))) short bf16x8;
typedef __attribute__((ext_vector_type(4))) float f32x4;
typedef __attribute__((ext_vector_type(2))) __bf16 bf2_t;

#define DI __device__ __forceinline__
#define MFMA(a, b, c) __builtin_amdgcn_mfma_f32_16x16x32_bf16((a), (b), (c), 0, 0, 0)

constexpr int MP = 32768, MS = 128, MT = 32896;
constexpr int NP = 4352;
constexpr int SEQ = 8192;
constexpr float EPS = 1e-6f;
constexpr size_t DN_ITEM = 73728;

constexpr size_t O_YP = 0, O_YS = 33554432, O_PDELTA = 33685504, O_PCONV = 33947648, O_PW1 = 33966080,
                 O_PW2 = 34228224, O_PW3 = 35276800, O_PMEM = 39471104, O_SDELTA = 41568256, O_SCONV = 43665408,
                 O_SW1 = 43812864, O_SW2 = 45910016, O_SW3 = 54298624;

struct Params {
  const float *x_prompt, *x_sample, *state_delta, *state_conv, *cw1, *cw2, *cw3, *cache_mem, *mem_prompt;
  const float *g_mix, *w_in, *conv_w, *a_log, *dt_bias, *g_onorm, *w_out, *g_memq, *g_memkv, *w_mq, *w_mkv, *w_mo;
  const float *g_ffn, *w_pq, *sub_keys, *expert_u, *expert_v, *g_final;
  float* out;
  u16 *WtIn, *WtOut, *WtMq, *WtMkv, *WtMo, *WtPq, *subkb, *Amem;
  unsigned char* E8;
  float* rs;
  float *gb, *ssq1, *ssq2, *dl;
  u16 *Kb, *VTf;
  u16* proj;
  float *h1, *h2;
  u16* pq;
  char* dnops;
  u16 *A0, *A1, *qb, *attn, *A2;
  int* eid;
  float* gate;
  u16 *vT, *osw, *odn, *Amix;
  float* lse;
};

DI u16 f2bf(float x) { unsigned u = __float_as_uint(x); u += 0x7fffu + ((u >> 16) & 1u); return (u16)(u >> 16); }
DI float bf2f(u16 h) { return __uint_as_float(((unsigned)h) << 16); }
DI unsigned pack2(float a, float b) { return (unsigned)f2bf(a) | ((unsigned)f2bf(b) << 16); }
DI float bflo(unsigned d) { return __uint_as_float(d << 16); }
DI float bfhi(unsigned d) { return __uint_as_float(d & 0xffff0000u); }
DI bf16x8 pack8(f32x4 a, f32x4 b) {
  uint4 r; r.x = pack2(a[0], a[1]); r.y = pack2(a[2], a[3]); r.z = pack2(b[0], b[1]); r.w = pack2(b[2], b[3]);
  return __builtin_bit_cast(bf16x8, r);
}
DI float wave_sum(float v) {
#pragma unroll
  for (int o = 32; o > 0; o >>= 1) v += __shfl_xor(v, o);
  return v;
}
DI float wave_max(float v) {
#pragma unroll
  for (int o = 32; o > 0; o >>= 1) v = fmaxf(v, __shfl_xor(v, o));
  return v;
}
DI float siluf(float x) { return x / (1.f + __expf(-x)); }
DI float geluf(float x) { return 0.5f * x * (1.f + tanhf(0.7978845608028654f * (x + 0.044715f * x * x * x))); }
DI int permk(int kg, int j) { return (j < 4) ? (kg * 4 + j) : (16 + kg * 4 + (j - 4)); }
DI void cvt8(const float* __restrict__ s, u16* __restrict__ d) {
  float4 a = *(const float4*)s, b = *(const float4*)(s + 4);
  uint4 r; r.x = pack2(a.x, a.y); r.y = pack2(a.z, a.w); r.z = pack2(b.x, b.y); r.w = pack2(b.z, b.w);
  *(uint4*)d = r;
}
DI unsigned ordf(float f) { unsigned u = __float_as_uint(f); return (u & 0x80000000u) ? ~u : (u | 0x80000000u); }
DI float unordf(unsigned k) { unsigned u = (k & 0x80000000u) ? (k & 0x7fffffffu) : ~k; return __uint_as_float(u); }
DI unsigned umax(unsigned a, unsigned b) { return a > b ? a : b; }
template <typename T> DI T sel4(int L, T a, T b, T c, T d) { return L == 0 ? a : (L == 1 ? b : (L == 2 ? c : d)); }

template <int MODE>
DI void gemm_tile(const Params& p, const u16* __restrict__ A, int lda, const u16* __restrict__ Bt, int K, int tm, int tn,
                          char* smem) {
  u16* sA = (u16*)smem;
  u16* sB = sA + 128 * 72;
  const int tid = threadIdx.x, lane = tid & 63, w = tid >> 6;
  const int wm = w >> 1, wn = w & 1, r = lane & 15, kg = lane >> 4;
  f32x4 acc[4][4];
#pragma unroll
  for (int i = 0; i < 4; ++i)
#pragma unroll
    for (int j = 0; j < 4; ++j) acc[i][j] = (f32x4){0.f, 0.f, 0.f, 0.f};
  const int lrow = tid >> 1, lcol = (tid & 1) * 32;
  const u16* gA = A + (size_t)(tm * 128 + lrow) * lda + lcol;
  const u16* gB = Bt + (size_t)(tn * 128 + lrow) * K + lcol;
  bf16x8 ra[4], rb[4];
#pragma unroll
  for (int i = 0; i < 4; ++i) { ra[i] = *(const bf16x8*)(gA + i * 8); rb[i] = *(const bf16x8*)(gB + i * 8); }
  for (int k0 = 0; k0 < K; k0 += 64) {
    __syncthreads();
#pragma unroll
    for (int i = 0; i < 4; ++i) {
      *(bf16x8*)&sA[lrow * 72 + lcol + i * 8] = ra[i];
      *(bf16x8*)&sB[lrow * 72 + lcol + i * 8] = rb[i];
    }
    __syncthreads();
    if (k0 + 64 < K) {
#pragma unroll
      for (int i = 0; i < 4; ++i) { ra[i] = *(const bf16x8*)(gA + k0 + 64 + i * 8); rb[i] = *(const bf16x8*)(gB + k0 + 64 + i * 8); }
    }
#pragma unroll
    for (int ks = 0; ks < 2; ++ks) {
      bf16x8 af[4], bfr[4];
#pragma unroll
      for (int i = 0; i < 4; ++i) {
        af[i] = *(const bf16x8*)&sA[(wm * 64 + i * 16 + r) * 72 + ks * 32 + kg * 8];
        bfr[i] = *(const bf16x8*)&sB[(wn * 64 + i * 16 + r) * 72 + ks * 32 + kg * 8];
      }
#pragma unroll
      for (int mt = 0; mt < 4; ++mt)
#pragma unroll
        for (int nt = 0; nt < 4; ++nt) acc[mt][nt] = MFMA(bfr[nt], af[mt], acc[mt][nt]);
    }
  }
#pragma unroll
  for (int mt = 0; mt < 4; ++mt) {
    const int row = tm * 128 + wm * 64 + mt * 16 + r;
    float rs = 1.f, ssq = 0.f;
    if (MODE == 3) rs = rsqrtf(p.ssq1[row] * (1.f / 1024.f) + EPS);
    if (MODE == 5) rs = rsqrtf(p.ssq2[row] * (1.f / 1024.f) + EPS);
#pragma unroll
    for (int nt = 0; nt < 4; ++nt) {
      const int col = tn * 128 + wn * 64 + nt * 16 + kg * 4;
      f32x4 v = acc[mt][nt];
      if (MODE == 0) {
        uint2 o; o.x = pack2(v[0], v[1]); o.y = pack2(v[2], v[3]);
        *(uint2*)&p.proj[(size_t)row * NP + col] = o;
      } else if (MODE == 1) {
        *(float4*)&p.out[O_PMEM + (size_t)row * 2048 + col] = make_float4(v[0], v[1], v[2], v[3]);
      } else if (MODE == 2 || MODE == 4) {
        float4 rsd;
        const float* gn;
        if (MODE == 2) {
          rsd = (row < MP) ? *(const float4*)&p.x_prompt[(size_t)row * 1024 + col] : *(const float4*)&p.x_sample[(size_t)(row - MP) * 1024 + col];
          gn = p.g_memq;
        } else {
          rsd = *(const float4*)&p.h1[(size_t)row * 1024 + col];
          gn = p.g_ffn;
        }
        float4 h = make_float4(rsd.x + v[0], rsd.y + v[1], rsd.z + v[2], rsd.w + v[3]);
        float4 g4 = *(const float4*)&gn[col];
        ssq += h.x * h.x + h.y * h.y + h.z * h.z + h.w * h.w;
        uint2 o; o.x = pack2(h.x * g4.x, h.y * g4.y); o.y = pack2(h.z * g4.z, h.w * g4.w);
        if (MODE == 2) { *(float4*)&p.h1[(size_t)row * 1024 + col] = h; *(uint2*)&p.A1[(size_t)row * 1024 + col] = o; }
        else { *(float4*)&p.h2[(size_t)row * 1024 + col] = h; *(uint2*)&p.A2[(size_t)row * 1024 + col] = o; }
      } else if (MODE == 3) {
        uint2 o; o.x = pack2(v[0] * rs, v[1] * rs); o.y = pack2(v[2] * rs, v[3] * rs);
        *(uint2*)&p.qb[(size_t)row * 1024 + col] = o;
      } else {
        uint2 o; o.x = pack2(v[0] * rs, v[1] * rs); o.y = pack2(v[2] * rs, v[3] * rs);
        *(uint2*)&p.pq[(size_t)row * 2048 + col] = o;
      }
    }
    if (MODE == 2 || MODE == 4) {
      ssq += __shfl_xor(ssq, 16);
      ssq += __shfl_xor(ssq, 32);
      if (kg == 0) atomicAdd((MODE == 2) ? &p.ssq1[row] : &p.ssq2[row], ssq);
    }
  }
}

DI void tr_tile(const float* __restrict__ W, int ldw, int nsrc0, u16* __restrict__ Wt, int K, int k0, int n0, float* tile) {
  const int tid = threadIdx.x;
  const int n = tid & 63, kq = tid >> 6;
  __syncthreads();
#pragma unroll
  for (int i = 0; i < 16; ++i) { int kk = kq + 4 * i; tile[kk * 65 + n] = W[(size_t)(k0 + kk) * ldw + nsrc0 + n]; }
  __syncthreads();
  const int nn = tid >> 2, ks = (tid & 3) * 16;
  unsigned o[8];
#pragma unroll
  for (int i = 0; i < 8; ++i) o[i] = pack2(tile[(ks + 2 * i) * 65 + nn], tile[(ks + 2 * i + 1) * 65 + nn]);
  u16* d = Wt + (size_t)(n0 + nn) * K + k0 + ks;
  *(uint4*)d = make_uint4(o[0], o[1], o[2], o[3]);
  *(uint4*)(d + 8) = make_uint4(o[4], o[5], o[6], o[7]);
}

DI void phase0(const Params& p, char* smem) {
  const int tid = threadIdx.x, lane = tid & 63, w = tid >> 6;
  const size_t gtid = (size_t)blockIdx.x * 256 + tid, gsz = (size_t)gridDim.x * 256;
  {
    const float* eu = p.expert_u;
    const float* ev = p.expert_v;
    unsigned char* e8 = p.E8;
    float* rsp = p.rs;
    for (int er = blockIdx.x * 4 + w; er < 32768; er += gridDim.x * 4) {
      const float* src = (er < 16384) ? (eu + (size_t)er * 1024) : (ev + (size_t)(er - 16384) * 1024);
      float4 v[4];
      float am = 0.f;
#pragma unroll
      for (int i = 0; i < 4; ++i) {
        v[i] = *(const float4*)&src[lane * 16 + i * 4];
        am = fmaxf(am, fmaxf(fmaxf(fabsf(v[i].x), fabsf(v[i].y)), fmaxf(fabsf(v[i].z), fabsf(v[i].w))));
      }
      am = wave_max(am);
      const float sc = (am > 0.f) ? 224.f / am : 1.f;
      int o[4];
#pragma unroll
      for (int i = 0; i < 4; ++i) {
        int t = __builtin_amdgcn_cvt_pk_fp8_f32(v[i].x * sc, v[i].y * sc, 0, false);
        o[i] = __builtin_amdgcn_cvt_pk_fp8_f32(v[i].z * sc, v[i].w * sc, t, true);
      }
      *(uint4*)&e8[(size_t)er * 1024 + lane * 16] = make_uint4((unsigned)o[0], (unsigned)o[1], (unsigned)o[2], (unsigned)o[3]);
      if (lane == 0) rsp[er] = (am > 0.f) ? am * (1.f / 224.f) : 1.f;
    }
  }
  for (size_t i = gtid; i < 262144 / 8; i += gsz) cvt8(p.sub_keys + i * 8, p.subkb + i * 8);
  for (size_t i = gtid; i < MT; i += gsz) { p.ssq1[i] = 0.f; p.ssq2[i] = 0.f; }
  const float* xpp = p.x_prompt;
  const float* xsp = p.x_sample;
  const float* mpp = p.mem_prompt;
  const float* gmx = p.g_mix;
  const float* gmk = p.g_memkv;
  u16* a0p = p.A0;
  u16* amp = p.Amem;
  for (int row = blockIdx.x * 4 + w; row < MT + 1024; row += gridDim.x * 4) {
    const float* src; const float* g; u16* dst;
    if (row < MP) { src = xpp + (size_t)row * 1024; g = gmx; dst = a0p + (size_t)row * 1024; }
    else if (row < MT) { src = xsp + (size_t)(row - MP) * 1024; g = gmx; dst = a0p + (size_t)row * 1024; }
    else { src = mpp + (size_t)(row - MT) * 1024; g = gmk; dst = amp + (size_t)(row - MT) * 1024; }
    float4 v[4];
    float ss = 0.f;
#pragma unroll
    for (int i = 0; i < 4; ++i) { v[i] = *(const float4*)&src[lane * 4 + i * 256]; ss += v[i].x * v[i].x + v[i].y * v[i].y + v[i].z * v[i].z + v[i].w * v[i].w; }
    ss = wave_sum(ss);
    const float rs = rsqrtf(ss * (1.f / 1024.f) + EPS);
    float d8[8] = {0.f, 0.f, 0.f, 0.f, 0.f, 0.f, 0.f, 0.f};
#pragma unroll
    for (int i = 0; i < 4; ++i) {
      float4 g4 = *(const float4*)&g[lane * 4 + i * 256];
      float y[4] = {v[i].x * rs * g4.x, v[i].y * rs * g4.y, v[i].z * rs * g4.z, v[i].w * rs * g4.w};
      uint2 o; o.x = pack2(y[0], y[1]); o.y = pack2(y[2], y[3]);
      *(uint2*)&dst[lane * 4 + i * 256] = o;
      if (row < MT) {
#pragma unroll
        for (int e = 0; e < 4; ++e) {
          const float* wr = p.w_in + (size_t)(lane * 4 + i * 256 + e) * 4360 + 1536;
          float4 wa = *(const float4*)wr, wb = *(const float4*)(wr + 4);
          d8[0] += y[e] * wa.x; d8[1] += y[e] * wa.y; d8[2] += y[e] * wa.z; d8[3] += y[e] * wa.w;
          d8[4] += y[e] * wb.x; d8[5] += y[e] * wb.y; d8[6] += y[e] * wb.z; d8[7] += y[e] * wb.w;
        }
      }
    }
    if (row < MT) {
#pragma unroll
      for (int j = 0; j < 8; ++j) d8[j] = wave_sum(d8[j]);
      if (lane < 4) {
        float ag = sel4(lane, d8[0], d8[1], d8[2], d8[3]);
        float bg = sel4(lane, d8[4], d8[5], d8[6], d8[7]);
        float xs = ag + p.dt_bias[lane];
        float sp = (xs > 20.f) ? xs : log1pf(expf(xs));
        p.gb[(size_t)row * 8 + lane] = -expf(p.a_log[lane]) * sp;
        p.gb[(size_t)row * 8 + 4 + lane] = 1.f / (1.f + expf(-bg));
      }
    }
  }
  float* tile = (float*)smem;
  for (int j = blockIdx.x; j < 2816; j += gridDim.x) {
    int t = j;
    if (t < 1088) { int kt = t / 68, nt = t % 68; int n0 = nt * 64; tr_tile(p.w_in, 4360, n0 + (n0 >= 1536 ? 8 : 0), p.WtIn, 1024, kt * 64, n0, tile); continue; }
    t -= 1088;
    if (t < 192) { int kt = t / 16, nt = t % 16; tr_tile(p.w_out, 1024, nt * 64, p.WtOut, 768, kt * 64, nt * 64, tile); continue; }
    t -= 192;
    if (t < 256) { int kt = t / 16, nt = t % 16; tr_tile(p.w_mq, 1024, nt * 64, p.WtMq, 1024, kt * 64, nt * 64, tile); continue; }
    t -= 256;
    if (t < 512) { int kt = t / 32, nt = t % 32; tr_tile(p.w_mkv, 2048, nt * 64, p.WtMkv, 1024, kt * 64, nt * 64, tile); continue; }
    t -= 512;
    if (t < 256) { int kt = t / 16, nt = t % 16; tr_tile(p.w_mo, 1024, nt * 64, p.WtMo, 1024, kt * 64, nt * 64, tile); continue; }
    t -= 256;
    { int kt = t / 32, nt = t % 32; tr_tile(p.w_pq, 2048, nt * 64, p.WtPq, 1024, kt * 64, nt * 64, tile); }
  }
}

DI void dn_prep(const Params& p, int item, char* smem) {
  u16* qs = (u16*)smem;
  u16* ksm = qs + 64 * 136;
  float* sL = (float*)(ksm + 64 * 136);
  float* sgc = sL + 64 * 64;
  float* sbeta = sgc + 64;
  u16* sU = (u16*)sL;
  u16* sW = qs;
  const int tid = threadIdx.x, lane = tid & 63, w = tid >> 6, r = lane & 15, kg = lane >> 4;
  const int bh = item >> 7, n = item & 127, b = bh >> 2, h = bh & 3;
  const int t0 = n * 64;
  const size_t rowbase = (size_t)b * SEQ;
  char* ops = p.dnops + (size_t)item * DN_ITEM;
  __syncthreads();
  if (tid < 64) {
    float gv = p.gb[(rowbase + t0 + tid) * 8 + h];
    float bv = p.gb[(rowbase + t0 + tid) * 8 + 4 + h];
#pragma unroll
    for (int o = 1; o < 64; o <<= 1) { float t = __shfl_up(gv, o); if (lane >= o) gv += t; }
    sgc[tid] = gv; sbeta[tid] = bv;
    if (tid == 63) p.dl[item] = __expf(gv);
  }
#pragma unroll 1
  for (int ps = 0; ps < 8; ++ps) {
    const int combo = ps * 16 + (tid >> 4);
    const int tt = combo & 63, part = combo >> 6, sub = tid & 15;
    const int col = part * 512 + h * 128 + sub * 8;
    float y[8] = {0.f, 0.f, 0.f, 0.f, 0.f, 0.f, 0.f, 0.f};
#pragma unroll
    for (int j = 0; j < 4; ++j) {
      const int t = t0 + tt - 3 + j;
      if (t >= 0) {
        uint4 xv = *(const uint4*)&p.proj[(rowbase + t) * NP + col];
        float4 wa = *(const float4*)&p.conv_w[j * 1536 + col], wb = *(const float4*)&p.conv_w[j * 1536 + col + 4];
        y[0] += bflo(xv.x) * wa.x; y[1] += bfhi(xv.x) * wa.y; y[2] += bflo(xv.y) * wa.z; y[3] += bfhi(xv.y) * wa.w;
        y[4] += bflo(xv.z) * wb.x; y[5] += bfhi(xv.z) * wb.y; y[6] += bflo(xv.w) * wb.z; y[7] += bfhi(xv.w) * wb.w;
      }
    }
    float ss = 0.f;
#pragma unroll
    for (int e = 0; e < 8; ++e) { y[e] = siluf(y[e]); ss += y[e] * y[e]; }
    ss += __shfl_xor(ss, 1); ss += __shfl_xor(ss, 2); ss += __shfl_xor(ss, 4); ss += __shfl_xor(ss, 8);
    float sc = rsqrtf(ss + EPS) * (part == 0 ? 0.08838834764831845f : 1.f);
    uint4 o; o.x = pack2(y[0] * sc, y[1] * sc); o.y = pack2(y[2] * sc, y[3] * sc); o.z = pack2(y[4] * sc, y[5] * sc); o.w = pack2(y[6] * sc, y[7] * sc);
    *(uint4*)&((part == 0 ? qs : ksm)[tt * 136 + sub * 8]) = o;
  }
  __syncthreads();
  const float gcl = sgc[63];
  {
    f32x4 aL[4], aA[4];
#pragma unroll
    for (int i = 0; i < 4; ++i) { aL[i] = (f32x4){0.f, 0.f, 0.f, 0.f}; aA[i] = (f32x4){0.f, 0.f, 0.f, 0.f}; }
#pragma unroll
    for (int ks = 0; ks < 4; ++ks) {
      bf16x8 kI = *(const bf16x8*)&ksm[(w * 16 + r) * 136 + ks * 32 + kg * 8];
      bf16x8 qI = *(const bf16x8*)&qs[(w * 16 + r) * 136 + ks * 32 + kg * 8];
#pragma unroll
      for (int nt = 0; nt < 4; ++nt) {
        bf16x8 kJ = *(const bf16x8*)&ksm[(nt * 16 + r) * 136 + ks * 32 + kg * 8];
        aL[nt] = MFMA(kJ, kI, aL[nt]);
        aA[nt] = MFMA(kJ, qI, aA[nt]);
      }
    }
    const int i = w * 16 + r;
    const float gci = sgc[i], bi = sbeta[i];
    u16* aq = (u16*)(ops + 49152);
#pragma unroll
    for (int nt = 0; nt < 4; ++nt) {
      float lv[4], av[4];
#pragma unroll
      for (int jj = 0; jj < 4; ++jj) {
        const int j = nt * 16 + kg * 4 + jj;
        const float gam = (i >= j) ? __expf(gci - sgc[j]) : 0.f;
        lv[jj] = (i > j) ? aL[nt][jj] * bi * gam : 0.f;
        av[jj] = aA[nt][jj] * gam;
      }
      *(float4*)&sL[i * 64 + nt * 16 + kg * 4] = make_float4(lv[0], lv[1], lv[2], lv[3]);
      uint2 o; o.x = pack2(av[0], av[1]); o.y = pack2(av[2], av[3]);
      *(uint2*)&aq[((w * 2 + (nt >> 1)) * 64 + lane) * 8 + (nt & 1) * 4] = o;
    }
  }
  {
    u16* qg = (u16*)(ops + 16384);
    u16* kdT = (u16*)(ops + 32768);
#pragma unroll 1
    for (int i = 0; i < 4; ++i) {
      const int f = tid + 256 * i;
      const int mtks = f >> 6, l = f & 63, rr = l & 15, kgg = l >> 4;
      {
        const int mt = mtks >> 2, ks = mtks & 3, row = mt * 16 + rr;
        const float e = __expf(sgc[row]);
        uint2 a = *(const uint2*)&qs[row * 136 + ks * 32 + kgg * 4];
        uint2 c = *(const uint2*)&qs[row * 136 + ks * 32 + 16 + kgg * 4];
        uint4 o;
        o.x = pack2(bflo(a.x) * e, bfhi(a.x) * e); o.y = pack2(bflo(a.y) * e, bfhi(a.y) * e);
        o.z = pack2(bflo(c.x) * e, bfhi(c.x) * e); o.w = pack2(bflo(c.y) * e, bfhi(c.y) * e);
        *(uint4*)&qg[(size_t)f * 8] = o;
      }
      {
        const int mt = mtks >> 1, ks = mtks & 1, kdim = mt * 16 + rr;
        float v[8];
#pragma unroll
        for (int j = 0; j < 8; ++j) {
          const int c = ks * 32 + permk(kgg, j);
          v[j] = bf2f(ksm[c * 136 + kdim]) * __expf(gcl - sgc[c]);
        }
        uint4 o; o.x = pack2(v[0], v[1]); o.y = pack2(v[2], v[3]); o.z = pack2(v[4], v[5]); o.w = pack2(v[6], v[7]);
        *(uint4*)&kdT[(size_t)f * 8] = o;
      }
    }
  }
  __syncthreads();
  float x[64];
  if (tid < 128) {
    const int col = 1024 + h * 128 + tid;
    const float w0 = p.conv_w[col], w1 = p.conv_w[1536 + col], w2 = p.conv_w[3072 + col], w3 = p.conv_w[4608 + col];
    float xm3 = 0.f, xm2 = 0.f, xm1 = 0.f;
    if (t0 > 0) {
      xm3 = bf2f(p.proj[(rowbase + t0 - 3) * NP + col]);
      xm2 = bf2f(p.proj[(rowbase + t0 - 2) * NP + col]);
      xm1 = bf2f(p.proj[(rowbase + t0 - 1) * NP + col]);
    }
#pragma unroll
    for (int t = 0; t < 64; ++t) {
      float xc = bf2f(p.proj[(rowbase + t0 + t) * NP + col]);
      float yv = w0 * xm3 + w1 * xm2 + w2 * xm1 + w3 * xc;
      x[t] = siluf(yv) * sbeta[t];
      xm3 = xm2; xm2 = xm1; xm1 = xc;
    }
  } else {
    const int kc = tid - 128;
#pragma unroll
    for (int t = 0; t < 64; ++t) x[t] = bf2f(ksm[t * 136 + kc]) * sbeta[t] * __expf(sgc[t]);
  }
#pragma unroll
  for (int i = 1; i < 64; ++i) {
    float s = x[i];
#pragma unroll
    for (int j4 = 0; j4 < (i + 3) / 4; ++j4) {
      float4 l = *(const float4*)&sL[i * 64 + j4 * 4];
      s -= l.x * x[j4 * 4];
      if (j4 * 4 + 1 < i) s -= l.y * x[j4 * 4 + 1];
      if (j4 * 4 + 2 < i) s -= l.z * x[j4 * 4 + 2];
      if (j4 * 4 + 3 < i) s -= l.w * x[j4 * 4 + 3];
    }
    x[i] = s;
  }
  __syncthreads();
  if (tid < 128) {
#pragma unroll
    for (int t = 0; t < 64; ++t) sU[t * 128 + tid] = f2bf(x[t]);
  } else {
    const int kc = tid - 128;
#pragma unroll
    for (int t = 0; t < 64; ++t) sW[t * 136 + kc] = f2bf(-x[t]);
  }
  __syncthreads();
  {
    u16* nW = (u16*)ops;
    u16* u0 = (u16*)(ops + 57344);
#pragma unroll 1
    for (int i = 0; i < 4; ++i) {
      const int f = tid + 256 * i;
      const int mtks = f >> 6, l = f & 63, rr = l & 15, kgg = l >> 4;
      const int mt = mtks >> 2, ks = mtks & 3, row = mt * 16 + rr;
      uint2 a = *(const uint2*)&sW[row * 136 + ks * 32 + kgg * 4];
      uint2 c = *(const uint2*)&sW[row * 136 + ks * 32 + 16 + kgg * 4];
      *(uint4*)&nW[(size_t)f * 8] = make_uint4(a.x, a.y, c.x, c.y);
    }
#pragma unroll 1
    for (int i = 0; i < 8; ++i) {
      const int f = tid + 256 * i;
      const int smt = f >> 6, l = f & 63, rr = l & 15, kgg = l >> 4;
      const int s = smt >> 2, mt = smt & 3;
      u16 v0 = sU[(mt * 16 + kgg * 4 + 0) * 128 + s * 16 + rr];
      u16 v1 = sU[(mt * 16 + kgg * 4 + 1) * 128 + s * 16 + rr];
      u16 v2 = sU[(mt * 16 + kgg * 4 + 2) * 128 + s * 16 + rr];
      u16 v3 = sU[(mt * 16 + kgg * 4 + 3) * 128 + s * 16 + rr];
      *(uint2*)&u0[(size_t)f * 4] = make_uint2((unsigned)v0 | ((unsigned)v1 << 16), (unsigned)v2 | ((unsigned)v3 << 16));
    }
  }
}

DI void vt_tile(const Params& p, int item, char* smem) {
  u16* tile = (u16*)smem;
  const int tid = threadIdx.x;
  const int ptile = item & 127, gbh = item >> 7;
  const int h = gbh & 3, b = (gbh >> 2) & 3, g = gbh >> 4;
  const int dsh = g * 2, ln = SEQ >> dsh;
  const int pos0 = ptile * 64;
  const int rres = pos0 / ln, i0 = pos0 % ln;
  __syncthreads();
  {
    const int pr = tid >> 2, seg = (tid & 3) * 16;
    const int token = ((i0 + pr) << dsh) + rres;
    const u16* src = &p.proj[((size_t)b * SEQ + token) * NP + 2048 + g * 768 + 512 + h * 64 + seg];
    uint4 a = *(const uint4*)src, c = *(const uint4*)(src + 8);
    unsigned d[8] = {a.x, a.y, a.z, a.w, c.x, c.y, c.z, c.w};
#pragma unroll
    for (int e = 0; e < 8; ++e) *(unsigned*)&tile[pr * 66 + seg + e * 2] = d[e];
  }
  __syncthreads();
  {
    const int dh = tid >> 2, seg = (tid & 3) * 16;
    unsigned o[8];
#pragma unroll
    for (int e = 0; e < 8; ++e) o[e] = (unsigned)tile[(seg + 2 * e) * 66 + dh] | ((unsigned)tile[(seg + 2 * e + 1) * 66 + dh] << 16);
    u16* d = &p.vT[((size_t)gbh * 64 + dh) * SEQ + pos0 + seg];
    *(uint4*)d = make_uint4(o[0], o[1], o[2], o[3]);
    *(uint4*)(d + 8) = make_uint4(o[4], o[5], o[6], o[7]);
  }
}

DI void dn_sample(const Params& p, int item, char* smem) {
  float* sq = (float*)smem;
  float* sk = sq + 512;
  float* sv = sk + 512;
  float* red = sv + 512;
  const int tid = threadIdx.x, lane = tid & 63, w = tid >> 6;
  const int b = item >> 2, h = item & 3;
  __syncthreads();
  for (int c = tid; c < 384; c += 256) {
    const int part = c >> 7, cc = c & 127;
    const int col = part * 512 + h * 128 + cc;
    float xp[7];
#pragma unroll
    for (int j = 0; j < 3; ++j) xp[j] = p.state_conv[((size_t)b * 3 + j) * 1536 + col];
#pragma unroll
    for (int j = 0; j < 4; ++j) xp[3 + j] = bf2f(p.proj[((size_t)MP + b * 4 + j) * NP + col]);
    const float w0 = p.conv_w[col], w1 = p.conv_w[1536 + col], w2 = p.conv_w[3072 + col], w3 = p.conv_w[4608 + col];
    float* dst = part == 0 ? sq : (part == 1 ? sk : sv);
#pragma unroll
    for (int t = 0; t < 4; ++t) dst[t * 128 + cc] = siluf(w0 * xp[t] + w1 * xp[t + 1] + w2 * xp[t + 2] + w3 * xp[t + 3]);
  }
  __syncthreads();
  {
    float a0 = sq[w * 128 + lane], a1 = sq[w * 128 + 64 + lane];
    float s = wave_sum(a0 * a0 + a1 * a1);
    float sc = rsqrtf(s + EPS) * 0.08838834764831845f;
    sq[w * 128 + lane] = a0 * sc; sq[w * 128 + 64 + lane] = a1 * sc;
    float b0 = sk[w * 128 + lane], b1 = sk[w * 128 + 64 + lane];
    s = wave_sum(b0 * b0 + b1 * b1);
    sc = rsqrtf(s + EPS);
    sk[w * 128 + lane] = b0 * sc; sk[w * 128 + 64 + lane] = b1 * sc;
  }
  __syncthreads();
  const int v = tid & 127, half = tid >> 7;
  float S[64];
  const float* s0 = p.state_delta + (((size_t)b * 4 + h) * 128 + half * 64) * 128 + v;
#pragma unroll
  for (int i = 0; i < 64; ++i) S[i] = s0[(size_t)i * 128];
#pragma unroll 1
  for (int t = 0; t < 4; ++t) {
    const size_t row = (size_t)MP + b * 4 + t;
    const float a = __expf(p.gb[row * 8 + h]);
    const float beta = p.gb[row * 8 + 4 + h];
    float part = 0.f;
#pragma unroll
    for (int i = 0; i < 64; ++i) part += S[i] * sk[t * 128 + half * 64 + i];
    red[half * 128 + v] = part;
    __syncthreads();
    const float kS = red[v] + red[128 + v];
    const float u = beta * (sv[t * 128 + v] - a * kS);
    float po = 0.f;
#pragma unroll
    for (int i = 0; i < 64; ++i) { S[i] = a * S[i] + sk[t * 128 + half * 64 + i] * u; po += S[i] * sq[t * 128 + half * 64 + i]; }
    __syncthreads();
    red[half * 128 + v] = po;
    __syncthreads();
    if (half == 0) p.odn[row * 512 + h * 128 + v] = f2bf(red[v] + red[128 + v]);
    __syncthreads();
  }
  float* d = p.out + O_SDELTA + (((size_t)b * 4 + h) * 128 + half * 64) * 128 + v;
#pragma unroll
  for (int i = 0; i < 64; ++i) d[(size_t)i * 128] = S[i];
}

DI void phase2(const Params& p, char* smem) {
  const size_t gtid = (size_t)blockIdx.x * 256 + threadIdx.x, gsz = (size_t)gridDim.x * 256;
  for (int j = blockIdx.x; j < 2048 + 128 + 6144; j += gridDim.x) {
    if (j < 2048) dn_prep(p, j, smem);
    else if (j < 2048 + 128) dn_sample(p, j - 2048, smem);
    else vt_tile(p, j - 2176, smem);
  }
  for (size_t f = gtid; f < (size_t)16 * 8192; f += gsz) {
    {
      const size_t e0 = f * 8;
      const int bh = (int)(e0 >> 16), key = (int)((e0 >> 8) & 255), dh = (int)(e0 & 255);
      const int b = bh >> 2, h = bh & 3;
      cvt8(p.out + O_PMEM + (((size_t)b * 256 + key) * 2 + 0) * 1024 + h * 256 + dh, p.Kb + e0);
    }
    {
      const int l = (int)(f & 63), ks = (int)((f >> 6) & 7), nt = (int)((f >> 9) & 15), bh = (int)(f >> 13);
      const int b = bh >> 2, h = bh & 3, rr = l & 15, kgg = l >> 4;
      float v[8];
#pragma unroll
      for (int j = 0; j < 8; ++j) {
        const int key = ks * 32 + permk(kgg, j);
        v[j] = p.out[O_PMEM + (((size_t)b * 256 + key) * 2 + 1) * 1024 + h * 256 + nt * 16 + rr];
      }
      *(uint4*)&p.VTf[f * 8] = make_uint4(pack2(v[0], v[1]), pack2(v[2], v[3]), pack2(v[4], v[5]), pack2(v[6], v[7]));
    }
  }
  for (size_t i = gtid; i < 18432; i += gsz) {
    const int c = (int)(i % 1536), j = (int)((i / 1536) % 3), b = (int)(i / 4608);
    p.out[O_PCONV + i] = bf2f(p.proj[((size_t)b * SEQ + SEQ - 3 + j) * NP + c]);
  }
  for (int g = 0; g < 3; ++g) {
    const int W = 128 << (2 * g);
    const size_t off = (g == 0) ? O_PW1 : (g == 1 ? O_PW2 : O_PW3);
    const size_t n4 = (size_t)4 * W * 512 / 4;
    for (size_t i = gtid; i < n4; i += gsz) {
      const size_t e0 = i * 4;
      const int e = (int)(e0 & 511), ii = (int)((e0 >> 9) % W), b = (int)((e0 >> 9) / W);
      uint2 v = *(const uint2*)&p.proj[((size_t)b * SEQ + SEQ - W + ii) * NP + 2048 + g * 768 + 256 + e];
      *(float4*)&p.out[off + e0] = make_float4(bflo(v.x), bfhi(v.x), bflo(v.y), bfhi(v.y));
    }
  }
}

typedef __attribute__((ext_vector_type(2))) unsigned u32x2;
struct ScanOps { bf16x8 nW[4]; bf16x8 qg[4]; bf16x8 aq[2]; bf16x8 kd[4]; u32x2 u0; float dl; };

DI void scan_load(const Params& p, int bh, int s, int n, int j, int lane, ScanOps& o) {
  n = n > 127 ? 127 : n;
  const char* base = p.dnops + (size_t)(bh * 128 + n) * DN_ITEM;
  const bf16x8* negW = (const bf16x8*)base;
  const bf16x8* qg = (const bf16x8*)(base + 16384);
  const bf16x8* kdT = (const bf16x8*)(base + 32768);
  const bf16x8* aqk = (const bf16x8*)(base + 49152);
  const u32x2* u0 = (const u32x2*)(base + 57344);
#pragma unroll
  for (int ks = 0; ks < 4; ++ks) o.nW[ks] = negW[(j * 4 + ks) * 64 + lane];
#pragma unroll
  for (int ks = 0; ks < 4; ++ks) o.qg[ks] = qg[(j * 4 + ks) * 64 + lane];
#pragma unroll
  for (int k2 = 0; k2 < 2; ++k2) o.aq[k2] = aqk[(j * 2 + k2) * 64 + lane];
#pragma unroll
  for (int mm = 0; mm < 2; ++mm)
#pragma unroll
    for (int k2 = 0; k2 < 2; ++k2) o.kd[mm * 2 + k2] = kdT[((2 * j + mm) * 2 + k2) * 64 + lane];
  o.u0 = u0[(s * 4 + j) * 64 + lane];
  o.dl = p.dl[bh * 128 + n];
}

DI void scan_step(const Params& p, const ScanOps& ops, int n, int b, int h, int s, int j, int lane, f32x4& S0, f32x4& S1,
                  bf16x8* sSb, u32x2* sUb) {
  const int r = lane & 15, kg = lane >> 4;
  bf16x8 sb[4];
#pragma unroll
  for (int ks = 0; ks < 4; ++ks) sb[ks] = sSb[ks * 64 + lane];
  f32x4 u = (f32x4){bflo(ops.u0[0]), bfhi(ops.u0[0]), bflo(ops.u0[1]), bfhi(ops.u0[1])};
#pragma unroll
  for (int ks = 0; ks < 4; ++ks) u = MFMA(ops.nW[ks], sb[ks], u);
  {
    u32x2 t; t[0] = pack2(u[0], u[1]); t[1] = pack2(u[2], u[3]);
    sUb[((j >> 1) * 64 + lane) * 2 + (j & 1)] = t;
  }
  __syncthreads();
  bf16x8 ub[2];
#pragma unroll
  for (int k2 = 0; k2 < 2; ++k2) ub[k2] = *(const bf16x8*)&sUb[(k2 * 64 + lane) * 2];
  f32x4 o = (f32x4){0.f, 0.f, 0.f, 0.f};
#pragma unroll
  for (int ks = 0; ks < 4; ++ks) o = MFMA(ops.qg[ks], sb[ks], o);
#pragma unroll
  for (int k2 = 0; k2 < 2; ++k2) o = MFMA(ops.aq[k2], ub[k2], o);
  S0 = S0 * ops.dl; S1 = S1 * ops.dl;
#pragma unroll
  for (int k2 = 0; k2 < 2; ++k2) { S0 = MFMA(ops.kd[k2], ub[k2], S0); S1 = MFMA(ops.kd[2 + k2], ub[k2], S1); }
  sSb[j * 64 + lane] = pack8(S0, S1);
#pragma unroll
  for (int jj = 0; jj < 4; ++jj) {
    const size_t token = (size_t)b * SEQ + n * 64 + j * 16 + kg * 4 + jj;
    p.odn[token * 512 + h * 128 + s * 16 + r] = f2bf(o[jj]);
  }
  __syncthreads();
}

DI void dn_scan_block(const Params& p, int item, char* smem) {
  const int lane = threadIdx.x & 63, j = threadIdx.x >> 6, r = lane & 15, kg = lane >> 4;
  const int bh = item >> 3, s = item & 7, b = bh >> 2, h = bh & 3;
  bf16x8* sSb = (bf16x8*)smem;
  u32x2* sUb = (u32x2*)(smem + 4096);
  f32x4 S0 = (f32x4){0.f, 0.f, 0.f, 0.f}, S1 = (f32x4){0.f, 0.f, 0.f, 0.f};
  __syncthreads();
  sSb[j * 64 + lane] = pack8(S0, S1);
  ScanOps A, B;
  scan_load(p, bh, s, 0, j, lane, A);
  scan_load(p, bh, s, 1, j, lane, B);
  __syncthreads();
#pragma unroll 1
  for (int n0 = 0; n0 < 128; n0 += 2) {
    scan_step(p, A, n0, b, h, s, j, lane, S0, S1, sSb, sUb);
    scan_load(p, bh, s, n0 + 2, j, lane, A);
    scan_step(p, B, n0 + 1, b, h, s, j, lane, S0, S1, sSb, sUb);
    scan_load(p, bh, s, n0 + 3, j, lane, B);
  }
#pragma unroll
  for (int jj = 0; jj < 4; ++jj) {
    p.out[O_PDELTA + ((size_t)bh * 128 + 32 * j + kg * 4 + jj) * 128 + s * 16 + r] = S0[jj];
    p.out[O_PDELTA + ((size_t)bh * 128 + 32 * j + 16 + kg * 4 + jj) * 128 + s * 16 + r] = S1[jj];
  }
}

DI void sw_prompt_wave(const Params& p, int item) {
  const int lane = threadIdx.x & 63, r = lane & 15, kg = lane >> 4;
  const int qt = item & 511, gbh = item >> 9;
  const int h = gbh & 3, b = (gbh >> 2) & 3, g = gbh >> 4;
  const int dsh = 2 * g, ln = SEQ >> dsh;
  const int pos0 = qt * 16, rres = pos0 / ln, i0 = pos0 % ln;
  const int kbase = i0 - 144;
  const size_t rb = (size_t)b * SEQ;
  const int qoff = 2048 + g * 768 + h * 64, koff = qoff + 256;
  bf16x8 qf[2];
  {
    const size_t tok = rb + ((size_t)(i0 + r) << dsh) + rres;
#pragma unroll
    for (int ks = 0; ks < 2; ++ks) qf[ks] = *(const bf16x8*)&p.proj[tok * NP + qoff + ks * 32 + kg * 8];
  }
  f32x4 st[10];
#pragma unroll
  for (int mt = 0; mt < 10; ++mt) {
    int ki = kbase + mt * 16 + r; ki = ki < 0 ? 0 : ki;
    const size_t tok = rb + ((size_t)ki << dsh) + rres;
    f32x4 a = (f32x4){0.f, 0.f, 0.f, 0.f};
#pragma unroll
    for (int ks = 0; ks < 2; ++ks) {
      bf16x8 kf = *(const bf16x8*)&p.proj[tok * NP + koff + ks * 32 + kg * 8];
      a = MFMA(kf, qf[ks], a);
    }
    st[mt] = a;
  }
  const int qi = i0 + r;
  float mx = -3.0e38f;
#pragma unroll
  for (int mt = 0; mt < 10; ++mt)
#pragma unroll
    for (int j = 0; j < 4; ++j) {
      const int ki = kbase + mt * 16 + kg * 4 + j;
      const int d = qi - ki;
      const bool valid = (ki >= 0) && (d >= 0) && (d <= 128);
      const float sv = valid ? st[mt][j] * 0.125f : -3.0e38f;
      st[mt][j] = sv;
      mx = fmaxf(mx, sv);
    }
  mx = fmaxf(mx, __shfl_xor(mx, 16));
  mx = fmaxf(mx, __shfl_xor(mx, 32));
  float sum = 0.f;
#pragma unroll
  for (int mt = 0; mt < 10; ++mt)
#pragma unroll
    for (int j = 0; j < 4; ++j) {
      const float pv = (st[mt][j] > -1.0e38f) ? __expf(st[mt][j] - mx) : 0.f;
      st[mt][j] = pv;
      sum += pv;
    }
  sum += __shfl_xor(sum, 16);
  sum += __shfl_xor(sum, 32);
  const float inv = 1.f / sum;
  bf16x8 pf[5];
#pragma unroll
  for (int k2 = 0; k2 < 5; ++k2) pf[k2] = pack8(st[2 * k2], st[2 * k2 + 1]);
  const size_t qrow = rb + ((size_t)qi << dsh) + rres;
#pragma unroll
  for (int nt = 0; nt < 4; ++nt) {
    f32x4 o = (f32x4){0.f, 0.f, 0.f, 0.f};
    const u16* vrow = &p.vT[((size_t)gbh * 64 + nt * 16 + r) * SEQ + (size_t)rres * ln];
#pragma unroll
    for (int k2 = 0; k2 < 5; ++k2) {
      int ka = kbase + k2 * 32 + kg * 4, kc = ka + 16;
      ka = ka < 0 ? 0 : ka; kc = kc < 0 ? 0 : kc;
      uint2 va = *(const uint2*)&vrow[ka];
      uint2 vc = *(const uint2*)&vrow[kc];
      bf16x8 vf = __builtin_bit_cast(bf16x8, make_uint4(va.x, va.y, vc.x, vc.y));
      o = MFMA(vf, pf[k2], o);
    }
    uint2 ov; ov.x = pack2(o[0] * inv, o[1] * inv); ov.y = pack2(o[2] * inv, o[3] * inv);
    *(uint2*)&p.osw[((size_t)g * MT + qrow) * 256 + h * 64 + nt * 16 + kg * 4] = ov;
  }
  if (kg == 0) p.lse[((size_t)g * MT + qrow) * 4 + h] = mx + __logf(sum);
}

DI void sw_sample_wave(const Params& p, int item) {
  const int lane = threadIdx.x & 63;
  const int t = item & 3, h = (item >> 2) & 3, b = (item >> 4) & 31, g = item >> 9;
  const int dil = 1 << (2 * g), W = 128 << (2 * g);
  const float* c1 = p.cw1;
  const float* c2 = p.cw2;
  const float* c3 = p.cw3;
  const float* cache = (g == 0) ? c1 : (g == 1 ? c2 : c3);
  const int qoff = 2048 + g * 768 + h * 64;
  const size_t qrow = (size_t)MP + b * 4 + t;
  float q[64];
#pragma unroll
  for (int c = 0; c < 64; c += 8) {
    uint4 v = *(const uint4*)&p.proj[qrow * NP + qoff + c];
    q[c] = bflo(v.x); q[c + 1] = bfhi(v.x); q[c + 2] = bflo(v.y); q[c + 3] = bfhi(v.y);
    q[c + 4] = bflo(v.z); q[c + 5] = bfhi(v.z); q[c + 6] = bflo(v.w); q[c + 7] = bfhi(v.w);
  }
  float sc[3];
#pragma unroll
  for (int mi = 0; mi < 3; ++mi) {
    const int m = lane + 64 * mi;
    float s = -3.0e38f;
    if (m <= 128) {
      const int j = W + t - m * dil;
      float d = 0.f;
      if (j >= W) {
        const u16* kr = &p.proj[((size_t)MP + b * 4 + (j - W)) * NP + qoff + 256];
#pragma unroll
        for (int c = 0; c < 64; c += 8) {
          uint4 v = *(const uint4*)&kr[c];
          d += q[c] * bflo(v.x) + q[c + 1] * bfhi(v.x) + q[c + 2] * bflo(v.y) + q[c + 3] * bfhi(v.y) + q[c + 4] * bflo(v.z) +
               q[c + 5] * bfhi(v.z) + q[c + 6] * bflo(v.w) + q[c + 7] * bfhi(v.w);
        }
      } else {
        const float* kr = &cache[(((size_t)b * W + j) * 2 + 0) * 256 + h * 64];
#pragma unroll
        for (int c = 0; c < 64; c += 4) {
          float4 v = *(const float4*)&kr[c];
          d += q[c] * v.x + q[c + 1] * v.y + q[c + 2] * v.z + q[c + 3] * v.w;
        }
      }
      s = d * 0.125f;
    }
    sc[mi] = s;
  }
  float mx = wave_max(fmaxf(fmaxf(sc[0], sc[1]), sc[2]));
  float sum = 0.f;
#pragma unroll
  for (int mi = 0; mi < 3; ++mi) { sc[mi] = (sc[mi] > -1.0e38f) ? __expf(sc[mi] - mx) : 0.f; sum += sc[mi]; }
  sum = wave_sum(sum);
  float o = 0.f;
#pragma unroll
  for (int mi = 0; mi < 3; ++mi) {
#pragma unroll 8
    for (int mm = 0; mm < 64; ++mm) {
      const int m = mi * 64 + mm;
      if (m <= 128) {
        const float pv = __shfl(sc[mi], mm);
        const int j = W + t - m * dil;
        float vv;
        if (j >= W) vv = bf2f(p.proj[((size_t)MP + b * 4 + (j - W)) * NP + qoff + 512 + lane]);
        else vv = cache[(((size_t)b * W + j) * 2 + 1) * 256 + h * 64 + lane];
        o += pv * vv;
      }
    }
  }
  p.osw[((size_t)g * MT + qrow) * 256 + h * 64 + lane] = f2bf(o / sum);
  if (lane == 0) p.lse[((size_t)g * MT + qrow) * 4 + h] = mx + __logf(sum);
}

DI void phase3(const Params& p, char* smem) {
  const int w = threadIdx.x >> 6;
  if (blockIdx.x < 128) {
    dn_scan_block(p, blockIdx.x, smem);
  } else {
    const int gw = (blockIdx.x - 128) * 4 + w, nw = (gridDim.x - 128) * 4;
    for (int it = gw; it < 24576 + 1536; it += nw) {
      if (it < 24576) sw_prompt_wave(p, it);
      else sw_sample_wave(p, it - 24576);
    }
  }
}

DI void phase4(const Params& p) {
  const int lane = threadIdx.x & 63, w = threadIdx.x >> 6;
  for (int row = blockIdx.x * 4 + w; row < MT; row += gridDim.x * 4) {
    u16* dst = p.Amix + (size_t)row * 768;
#pragma unroll
    for (int h = 0; h < 4; ++h) {
      unsigned ov = *(const unsigned*)&p.odn[(size_t)row * 512 + h * 128 + lane * 2];
      unsigned zv = *(const unsigned*)&p.proj[(size_t)row * NP + 1536 + h * 128 + lane * 2];
      float o0 = bflo(ov), o1 = bfhi(ov);
      float ss = wave_sum(o0 * o0 + o1 * o1);
      float rs = rsqrtf(ss * (1.f / 128.f) + EPS);
      float2 gn = *(const float2*)&p.g_onorm[lane * 2];
      float y0 = o0 * rs * gn.x * siluf(bflo(zv)), y1 = o1 * rs * gn.y * siluf(bfhi(zv));
      *(unsigned*)&dst[h * 128 + lane * 2] = pack2(y0, y1);
    }
    {
      const int h = lane >> 4;
      float l0 = p.lse[((size_t)0 * MT + row) * 4 + h], l1 = p.lse[((size_t)1 * MT + row) * 4 + h], l2 = p.lse[((size_t)2 * MT + row) * 4 + h];
      float m = fmaxf(l0, fmaxf(l1, l2));
      float e0 = __expf(l0 - m), e1 = __expf(l1 - m), e2 = __expf(l2 - m);
      float inv = 1.f / (e0 + e1 + e2);
      uint2 a = *(const uint2*)&p.osw[((size_t)0 * MT + row) * 256 + lane * 4];
      uint2 c = *(const uint2*)&p.osw[((size_t)1 * MT + row) * 256 + lane * 4];
      uint2 d = *(const uint2*)&p.osw[((size_t)2 * MT + row) * 256 + lane * 4];
      e0 *= inv; e1 *= inv; e2 *= inv;
      float y0 = e0 * bflo(a.x) + e1 * bflo(c.x) + e2 * bflo(d.x);
      float y1 = e0 * bfhi(a.x) + e1 * bfhi(c.x) + e2 * bfhi(d.x);
      float y2 = e0 * bflo(a.y) + e1 * bflo(c.y) + e2 * bflo(d.y);
      float y3 = e0 * bfhi(a.y) + e1 * bfhi(c.y) + e2 * bfhi(d.y);
      *(uint2*)&dst[512 + lane * 4] = make_uint2(pack2(y0, y1), pack2(y2, y3));
    }
  }
}

DI void sample_state_copy(const Params& p) {
  const size_t gtid = (size_t)blockIdx.x * 256 + threadIdx.x, gsz = (size_t)gridDim.x * 256;
  for (size_t i = gtid; i < 147456; i += gsz) {
    const int c = (int)(i % 1536), j = (int)((i / 1536) % 3), b = (int)(i / 4608);
    p.out[O_SCONV + i] = bf2f(p.proj[((size_t)MP + b * 4 + j + 1) * NP + c]);
  }
  const float* c1 = p.cw1;
  const float* c2 = p.cw2;
  const float* c3 = p.cw3;
  for (int g = 0; g < 3; ++g) {
    const int W = 128 << (2 * g);
    const float* cache = (g == 0) ? c1 : (g == 1 ? c2 : c3);
    const size_t off = (g == 0) ? O_SW1 : (g == 1 ? O_SW2 : O_SW3);
    const size_t n4 = (size_t)32 * W * 512 / 4;
    for (size_t i = gtid; i < n4; i += gsz) {
      const size_t e0 = i * 4;
      const int e = (int)(e0 & 511), ii = (int)((e0 >> 9) % W), b = (int)((e0 >> 9) / W);
      float4 o;
      if (ii < W - 4) o = *(const float4*)&cache[((size_t)b * W + ii + 4) * 512 + e];
      else {
        uint2 v = *(const uint2*)&p.proj[((size_t)MP + b * 4 + (ii - (W - 4))) * NP + 2048 + g * 768 + 256 + e];
        o = make_float4(bflo(v.x), bfhi(v.x), bflo(v.y), bfhi(v.y));
      }
      *(float4*)&p.out[off + e0] = o;
    }
  }
}

DI void mem_attn_prompt_wave(const Params& p, int item) {
  const int lane = threadIdx.x & 63, r = lane & 15, kg = lane >> 4;
  const int h = item & 3, qt = item >> 2;
  const int row0 = qt * 16, b = row0 >> 13;
  const int bh = b * 4 + h;
  bf16x8 qf[8];
#pragma unroll
  for (int ks = 0; ks < 8; ++ks) qf[ks] = *(const bf16x8*)&p.qb[(size_t)(row0 + r) * 1024 + h * 256 + ks * 32 + kg * 8];
  f32x4 st[16];
  const u16* kbp = p.Kb + (size_t)bh * 65536;
#pragma unroll
  for (int mt = 0; mt < 16; ++mt) {
    f32x4 a = (f32x4){0.f, 0.f, 0.f, 0.f};
#pragma unroll
    for (int ks = 0; ks < 8; ++ks) {
      bf16x8 kf = *(const bf16x8*)&kbp[(mt * 16 + r) * 256 + ks * 32 + kg * 8];
      a = MFMA(kf, qf[ks], a);
    }
    st[mt] = a;
  }
  float mx = -3.0e38f;
#pragma unroll
  for (int mt = 0; mt < 16; ++mt)
#pragma unroll
    for (int j = 0; j < 4; ++j) { st[mt][j] *= 0.0625f; mx = fmaxf(mx, st[mt][j]); }
  mx = fmaxf(mx, __shfl_xor(mx, 16));
  mx = fmaxf(mx, __shfl_xor(mx, 32));
  float sum = 0.f;
#pragma unroll
  for (int mt = 0; mt < 16; ++mt)
#pragma unroll
    for (int j = 0; j < 4; ++j) { st[mt][j] = __expf(st[mt][j] - mx); sum += st[mt][j]; }
  sum += __shfl_xor(sum, 16);
  sum += __shfl_xor(sum, 32);
  const float inv = 1.f / sum;
  bf16x8 pf[8];
#pragma unroll
  for (int k2 = 0; k2 < 8; ++k2) pf[k2] = pack8(st[2 * k2], st[2 * k2 + 1]);
  const bf16x8* vt = (const bf16x8*)(p.VTf + (size_t)bh * 65536);
#pragma unroll 2
  for (int nt = 0; nt < 16; ++nt) {
    f32x4 o = (f32x4){0.f, 0.f, 0.f, 0.f};
#pragma unroll
    for (int k2 = 0; k2 < 8; ++k2) o = MFMA(vt[(nt * 8 + k2) * 64 + lane], pf[k2], o);
    uint2 ov; ov.x = pack2(o[0] * inv, o[1] * inv); ov.y = pack2(o[2] * inv, o[3] * inv);
    *(uint2*)&p.attn[(size_t)(row0 + r) * 1024 + h * 256 + nt * 16 + kg * 4] = ov;
  }
}

DI void mem_attn_sample_wave(const Params& p, int item, float* lds) {
  const int lane = threadIdx.x & 63;
  const int b = item >> 2, h = item & 3;
  float* sq = lds;
#pragma unroll
  for (int t = 0; t < 4; ++t) {
    uint2 v = *(const uint2*)&p.qb[((size_t)MP + b * 4 + t) * 1024 + h * 256 + lane * 4];
    *(float4*)&sq[t * 256 + lane * 4] = make_float4(bflo(v.x), bfhi(v.x), bflo(v.y), bfhi(v.y));
  }
  __builtin_amdgcn_s_waitcnt(0);
  __builtin_amdgcn_wave_barrier();
  float sc[4][4];
#pragma unroll
  for (int mi = 0; mi < 4; ++mi) {
    const int m = lane + 64 * mi;
    const float* kr = &p.cache_mem[(((size_t)b * 256 + m) * 2 + 0) * 1024 + h * 256];
    float d0 = 0.f, d1 = 0.f, d2 = 0.f, d3 = 0.f;
#pragma unroll 2
    for (int c = 0; c < 256; c += 4) {
      float4 kv = *(const float4*)&kr[c];
      float4 q0 = *(const float4*)&sq[c], q1 = *(const float4*)&sq[256 + c], q2 = *(const float4*)&sq[512 + c], q3 = *(const float4*)&sq[768 + c];
      d0 += kv.x * q0.x + kv.y * q0.y + kv.z * q0.z + kv.w * q0.w;
      d1 += kv.x * q1.x + kv.y * q1.y + kv.z * q1.z + kv.w * q1.w;
      d2 += kv.x * q2.x + kv.y * q2.y + kv.z * q2.z + kv.w * q2.w;
      d3 += kv.x * q3.x + kv.y * q3.y + kv.z * q3.z + kv.w * q3.w;
    }
    sc[0][mi] = d0 * 0.0625f; sc[1][mi] = d1 * 0.0625f; sc[2][mi] = d2 * 0.0625f; sc[3][mi] = d3 * 0.0625f;
  }
  float inv[4];
  __builtin_amdgcn_wave_barrier();
#pragma unroll
  for (int t = 0; t < 4; ++t) {
    float mx = wave_max(fmaxf(fmaxf(sc[t][0], sc[t][1]), fmaxf(sc[t][2], sc[t][3])));
    float sum = 0.f;
#pragma unroll
    for (int mi = 0; mi < 4; ++mi) { sc[t][mi] = __expf(sc[t][mi] - mx); sum += sc[t][mi]; }
    sum = wave_sum(sum);
    inv[t] = 1.f / sum;
#pragma unroll
    for (int mi = 0; mi < 4; ++mi) sq[t * 256 + lane + 64 * mi] = sc[t][mi];
  }
  __builtin_amdgcn_s_waitcnt(0);
  __builtin_amdgcn_wave_barrier();
  float4 o[4];
#pragma unroll
  for (int t = 0; t < 4; ++t) o[t] = make_float4(0.f, 0.f, 0.f, 0.f);
#pragma unroll 4
  for (int m = 0; m < 256; ++m) {
    float4 vv = *(const float4*)&p.cache_mem[(((size_t)b * 256 + m) * 2 + 1) * 1024 + h * 256 + lane * 4];
#pragma unroll
    for (int t = 0; t < 4; ++t) {
      const float pv = sq[t * 256 + m];
      o[t].x += pv * vv.x; o[t].y += pv * vv.y; o[t].z += pv * vv.z; o[t].w += pv * vv.w;
    }
  }
#pragma unroll
  for (int t = 0; t < 4; ++t) {
    uint2 ov; ov.x = pack2(o[t].x * inv[t], o[t].y * inv[t]); ov.y = pack2(o[t].z * inv[t], o[t].w * inv[t]);
    *(uint2*)&p.attn[((size_t)MP + b * 4 + t) * 1024 + h * 256 + lane * 4] = ov;
  }
  __builtin_amdgcn_wave_barrier();
}

DI void phase7(const Params& p, char* smem) {
  const int w = threadIdx.x >> 6;
  const int gw = blockIdx.x * 4 + w, nw = gridDim.x * 4;
  float* lds = (float*)smem + w * 1280;
  for (int it = gw; it < 128 + 8192; it += nw) {
    if (it < 128) mem_attn_sample_wave(p, it, lds);
    else mem_attn_prompt_wave(p, it - 128);
  }
}

DI void peer_topk_wave(const Params& p, int item, unsigned* lds  ) {
  const int lane = threadIdx.x & 63, r = lane & 15, kg = lane >> 4;
  const int h = item & 7, row0 = (item >> 3) * 16;
  unsigned win[2][16];
#pragma unroll
  for (int pp = 0; pp < 2; ++pp) {
    bf16x8 qf[4];
#pragma unroll
    for (int ks = 0; ks < 4; ++ks) qf[ks] = *(const bf16x8*)&p.pq[(size_t)(row0 + r) * 2048 + h * 256 + pp * 128 + ks * 32 + kg * 8];
    unsigned kk[32];
    const u16* sk = p.subkb + (size_t)(h * 2 + pp) * 16384;
#pragma unroll
    for (int mt = 0; mt < 8; ++mt) {
      f32x4 a = (f32x4){0.f, 0.f, 0.f, 0.f};
#pragma unroll
      for (int ks = 0; ks < 4; ++ks) {
        bf16x8 kf = *(const bf16x8*)&sk[(mt * 16 + r) * 128 + ks * 32 + kg * 8];
        a = MFMA(kf, qf[ks], a);
      }
#pragma unroll
      for (int j = 0; j < 4; ++j) kk[mt * 4 + j] = (ordf(a[j]) & ~127u) | (unsigned)(mt * 16 + kg * 4 + j);
    }
#pragma unroll
    for (int rr = 0; rr < 16; ++rr) {
      unsigned m = 0;
#pragma unroll
      for (int i = 0; i < 32; ++i) m = umax(m, kk[i]);
      m = umax(m, (unsigned)__shfl_xor((int)m, 16));
      m = umax(m, (unsigned)__shfl_xor((int)m, 32));
      win[pp][rr] = m;
#pragma unroll
      for (int i = 0; i < 32; ++i) kk[i] = (kk[i] == m) ? 0u : kk[i];
    }
  }
  float f0[16], f1[16];
#pragma unroll
  for (int i = 0; i < 16; ++i) { f0[i] = unordf(win[0][i] & ~127u); f1[i] = unordf(win[1][i] & ~127u); }
  unsigned cand[13];
#define CAND(s, a0, b0, a1, b1, a2, b2, a3, b3)                                                         \
  {                                                                                                     \
    float va = sel4(kg, f0[a0], f0[a1], f0[a2], f0[(a3) < 0 ? 0 : (a3)]);                                \
    float vb = sel4(kg, f1[b0], f1[b1], f1[b2], f1[(b3) < 0 ? 0 : (b3)]);                                \
    unsigned id = sel4(kg, (unsigned)((a0) * 16 + (b0)), (unsigned)((a1) * 16 + (b1)), (unsigned)((a2) * 16 + (b2)), (unsigned)(((a3) < 0 ? 0 : (a3)) * 16 + ((b3) < 0 ? 0 : (b3)))); \
    unsigned key = (ordf(va + vb) & ~255u) | id;                                                        \
    if ((a3) < 0) key = (kg == 3) ? 0u : key;                                                           \
    cand[s] = key;                                                                                      \
  }
  CAND(0, 0, 0, 0, 13, 2, 0, 6, 1)
  CAND(1, 0, 1, 0, 14, 2, 1, 7, 0)
  CAND(2, 0, 2, 0, 15, 2, 2, 7, 1)
  CAND(3, 0, 3, 1, 0, 2, 3, 8, 0)
  CAND(4, 0, 4, 1, 1, 2, 4, 9, 0)
  CAND(5, 0, 5, 1, 2, 3, 0, 10, 0)
  CAND(6, 0, 6, 1, 3, 3, 1, 11, 0)
  CAND(7, 0, 7, 1, 4, 3, 2, 12, 0)
  CAND(8, 0, 8, 1, 5, 3, 3, 13, 0)
  CAND(9, 0, 9, 1, 6, 4, 2, 14, 0)
  CAND(10, 0, 10, 1, 7, 5, 0, 15, 0)
  CAND(11, 0, 11, 4, 0, 5, 1, -1, -1)
  CAND(12, 0, 12, 4, 1, 6, 0, -1, -1)
#undef CAND
  unsigned w2[16];
#pragma unroll
  for (int rr = 0; rr < 16; ++rr) {
    unsigned m = 0;
#pragma unroll
    for (int i = 0; i < 13; ++i) m = umax(m, cand[i]);
    m = umax(m, (unsigned)__shfl_xor((int)m, 16));
    m = umax(m, (unsigned)__shfl_xor((int)m, 32));
    w2[rr] = m;
#pragma unroll
    for (int i = 0; i < 13; ++i) cand[i] = (cand[i] == m) ? 0u : cand[i];
  }
  if (kg == 0) {
#pragma unroll
    for (int i = 0; i < 16; ++i) { lds[r * 32 + i] = win[0][i] & 127u; lds[r * 32 + 16 + i] = win[1][i] & 127u; }
  }
  __builtin_amdgcn_s_waitcnt(0);
  __builtin_amdgcn_wave_barrier();
  const float cv0 = unordf(w2[0] & ~255u);
  float sum = 0.f;
#pragma unroll
  for (int rr = 0; rr < 16; ++rr) sum += __expf(unordf(w2[rr] & ~255u) - cv0);
  const float inv = 1.f / sum;
  const size_t ob = ((size_t)(row0 + r) * 8 + h) * 16;
#pragma unroll
  for (int q = 0; q < 4; ++q) {
    const unsigned wk = sel4(kg, w2[q], w2[4 + q], w2[8 + q], w2[12 + q]);
    const int a = (wk >> 4) & 15, bb = wk & 15;
    const int i1 = (int)lds[r * 32 + a], i2 = (int)lds[r * 32 + 16 + bb];
    p.eid[ob + kg * 4 + q] = i1 * 128 + i2;
    p.gate[ob + kg * 4 + q] = __expf(unordf(wk & ~255u) - cv0) * inv;
  }
  __builtin_amdgcn_wave_barrier();
}

typedef __attribute__((ext_vector_type(2))) float f32x2;
DI float dot16_fp8(uint4 u, const float* x, float c) {
  const unsigned d[4] = {u.x, u.y, u.z, u.w};
#pragma unroll
  for (int i = 0; i < 4; ++i) {
    f32x2 a = __builtin_amdgcn_cvt_pk_f32_fp8((int)d[i], false);
    f32x2 b = __builtin_amdgcn_cvt_pk_f32_fp8((int)d[i], true);
    c += a[0] * x[4 * i] + a[1] * x[4 * i + 1] + b[0] * x[4 * i + 2] + b[1] * x[4 * i + 3];
  }
  return c;
}
DI void axpy16_fp8(float* o, float w, uint4 u) {
  const unsigned d[4] = {u.x, u.y, u.z, u.w};
#pragma unroll
  for (int i = 0; i < 4; ++i) {
    f32x2 a = __builtin_amdgcn_cvt_pk_f32_fp8((int)d[i], false);
    f32x2 b = __builtin_amdgcn_cvt_pk_f32_fp8((int)d[i], true);
    o[4 * i] += w * a[0]; o[4 * i + 1] += w * a[1]; o[4 * i + 2] += w * b[0]; o[4 * i + 3] += w * b[1];
  }
}

DI void peer_expert_wave(const Params& p, int row) {
  const int lane = threadIdx.x & 63;
  float xf[16];
  {
    const uint4 x0 = *(const uint4*)&p.A2[(size_t)row * 1024 + lane * 16];
    const uint4 x1 = *(const uint4*)&p.A2[(size_t)row * 1024 + lane * 16 + 8];
    xf[0] = bflo(x0.x); xf[1] = bfhi(x0.x); xf[2] = bflo(x0.y); xf[3] = bfhi(x0.y);
    xf[4] = bflo(x0.z); xf[5] = bfhi(x0.z); xf[6] = bflo(x0.w); xf[7] = bfhi(x0.w);
    xf[8] = bflo(x1.x); xf[9] = bfhi(x1.x); xf[10] = bflo(x1.y); xf[11] = bfhi(x1.y);
    xf[12] = bflo(x1.z); xf[13] = bfhi(x1.z); xf[14] = bflo(x1.w); xf[15] = bfhi(x1.w);
  }
  const float r2 = rsqrtf(p.ssq2[row] * (1.f / 1024.f) + EPS);
  const unsigned char* EU8 = p.E8;
  const unsigned char* EV8 = p.E8 + (size_t)16384 * 1024;
  float out[16];
#pragma unroll
  for (int i = 0; i < 16; ++i) out[i] = 0.f;
#pragma unroll 1
  for (int bt = 0; bt < 2; ++bt) {
    const int eidv = p.eid[(size_t)row * 128 + bt * 64 + lane];
    const float gv = p.gate[(size_t)row * 128 + bt * 64 + lane];
    const float rsu = p.rs[eidv], rsv = p.rs[16384 + eidv];
    float part[64];
#pragma unroll
    for (int e = 0; e < 64; ++e) {
      const int id = __builtin_amdgcn_readlane(eidv, e);
      const uint4 u = *(const uint4*)(EU8 + (size_t)id * 1024 + lane * 16);
      part[e] = dot16_fp8(u, xf, 0.f);
    }
#pragma unroll
    for (int off = 32; off > 0; off >>= 1) {
      const bool up = (lane & off) != 0;
#pragma unroll
      for (int i = 0; i < off; ++i) {
        const float a = part[i], bq = part[i + off];
        const float send = up ? a : bq, keep = up ? bq : a;
        part[i] = keep + __shfl_xor(send, off);
      }
    }
    const float wv = gv * geluf(part[0] * r2 * rsu) * rsv;
#pragma unroll 8
    for (int e = 0; e < 64; ++e) {
      const int id = __builtin_amdgcn_readlane(eidv, e);
      const float we = __int_as_float(__builtin_amdgcn_readlane(__float_as_int(wv), e));
      const uint4 v = *(const uint4*)(EV8 + (size_t)id * 1024 + lane * 16);
      axpy16_fp8(out, we, v);
    }
  }
  const float* hr = p.h2 + (size_t)row * 1024 + lane * 16;
  float hv[16];
  float ss = 0.f;
#pragma unroll
  for (int i = 0; i < 4; ++i) {
    float4 t = *(const float4*)&hr[i * 4];
    hv[4 * i] = t.x + out[4 * i]; hv[4 * i + 1] = t.y + out[4 * i + 1]; hv[4 * i + 2] = t.z + out[4 * i + 2]; hv[4 * i + 3] = t.w + out[4 * i + 3];
    ss += hv[4 * i] * hv[4 * i] + hv[4 * i + 1] * hv[4 * i + 1] + hv[4 * i + 2] * hv[4 * i + 2] + hv[4 * i + 3] * hv[4 * i + 3];
  }
  ss = wave_sum(ss);
  const float rsn = rsqrtf(ss * (1.f / 1024.f) + EPS);
  float* y = ((row < MP) ? (p.out + O_YP + (size_t)row * 1024) : (p.out + O_YS + (size_t)(row - MP) * 1024)) + lane * 16;
#pragma unroll
  for (int i = 0; i < 4; ++i) {
    float4 g4 = *(const float4*)&p.g_final[lane * 16 + i * 4];
    *(float4*)&y[i * 4] = make_float4(hv[4 * i] * rsn * g4.x, hv[4 * i + 1] * rsn * g4.y, hv[4 * i + 2] * rsn * g4.z, hv[4 * i + 3] * rsn * g4.w);
  }
}

__global__ void __launch_bounds__(256, 2) mega(Params pk) {
  __shared__ __attribute__((aligned(16))) char smem[53248];
  __shared__ Params sp;
  cg::grid_group grid = cg::this_grid();
  const int w = threadIdx.x >> 6;
  if (threadIdx.x == 0) sp = pk;
  __syncthreads();
  const Params& p = sp;
#ifndef DBL
#define DBL -1
#endif
#define REP(ph) for (int rp_ = 0; rp_ < ((DBL == (ph)) ? 2 : 1); ++rp_)
  REP(0) { phase0(p, smem); if (DBL == 0) grid.sync(); }
  grid.sync();
  REP(1) for (int t = blockIdx.x; t < 257 * 34 + 128; t += gridDim.x) {
    if (t < 257 * 34) gemm_tile<0>(p, p.A0, 1024, p.WtIn, 1024, t / 34, t % 34, smem);
    else { int u = t - 257 * 34; gemm_tile<1>(p, p.Amem, 1024, p.WtMkv, 1024, u / 16, u % 16, smem); }
  }
  grid.sync();
  REP(2) { phase2(p, smem); if (DBL == 2) grid.sync(); }
  grid.sync();
  REP(3) { phase3(p, smem); if (DBL == 3) grid.sync(); }
  grid.sync();
  REP(4) phase4(p);
  grid.sync();
  for (int t = blockIdx.x; t < 257 * 8; t += gridDim.x) gemm_tile<2>(p, p.Amix, 768, p.WtOut, 768, t / 8, t % 8, smem);
  grid.sync();
  REP(6) for (int t = blockIdx.x; t < 257 * 8; t += gridDim.x) gemm_tile<3>(p, p.A1, 1024, p.WtMq, 1024, t / 8, t % 8, smem);
  sample_state_copy(p);
  grid.sync();
  REP(7) phase7(p, smem);
  grid.sync();
  for (int t = blockIdx.x; t < 257 * 8; t += gridDim.x) gemm_tile<4>(p, p.attn, 1024, p.WtMo, 1024, t / 8, t % 8, smem);
  grid.sync();
  REP(9) for (int t = blockIdx.x; t < 257 * 16; t += gridDim.x) gemm_tile<5>(p, p.A2, 1024, p.WtPq, 1024, t / 16, t % 16, smem);
  grid.sync();
  REP(10) {
    unsigned* lds = (unsigned*)smem + w * 512;
    for (int it = blockIdx.x * 4 + w; it < 2056 * 8; it += gridDim.x * 4) peer_topk_wave(p, it, lds);
  }
  grid.sync();
  REP(11) for (int row = blockIdx.x * 4 + w; row < MT; row += gridDim.x * 4) peer_expert_wave(p, row);
}

extern "C" void kernel_launch(void* const* d_in, const int* in_sizes, int n_in, void* d_out, int out_size, void* d_ws, size_t ws_size,
                              hipStream_t stream) {
  static int grid_blocks = 0;
  if (!grid_blocks) {
    int dev = 0, cus = 0, per_cu = 0;
    (void)hipGetDevice(&dev);
    (void)hipDeviceGetAttribute(&cus, hipDeviceAttributeMultiprocessorCount, dev);
    (void)hipOccupancyMaxActiveBlocksPerMultiprocessor(&per_cu, mega, 256, 0);
    if (per_cu > 2) per_cu = 2;
    if (per_cu < 1) per_cu = 1;
    grid_blocks = cus * per_cu;
  }
  Params p{};
  const float* const* in = (const float* const*)d_in;
  p.x_prompt = in[0]; p.x_sample = in[1]; p.state_delta = in[2]; p.state_conv = in[3]; p.cw1 = in[4]; p.cw2 = in[5]; p.cw3 = in[6];
  p.cache_mem = in[7]; p.mem_prompt = in[8]; p.g_mix = in[9]; p.w_in = in[10]; p.conv_w = in[11]; p.a_log = in[12]; p.dt_bias = in[13];
  p.g_onorm = in[14]; p.w_out = in[15]; p.g_memq = in[16]; p.g_memkv = in[17]; p.w_mq = in[18]; p.w_mkv = in[19]; p.w_mo = in[20];
  p.g_ffn = in[21]; p.w_pq = in[22]; p.sub_keys = in[23]; p.expert_u = in[24]; p.expert_v = in[25]; p.g_final = in[26];
  p.out = (float*)d_out;
  char* ws = (char*)d_ws;
  size_t off = 0;
  auto take = [&](size_t bytes) { char* r = ws + off; off += (bytes + 255) & ~(size_t)255; return r; };
  p.WtIn = (u16*)take((size_t)NP * 1024 * 2);
  p.WtOut = (u16*)take((size_t)1024 * 768 * 2);
  p.WtMq = (u16*)take((size_t)1024 * 1024 * 2);
  p.WtMkv = (u16*)take((size_t)2048 * 1024 * 2);
  p.WtMo = (u16*)take((size_t)1024 * 1024 * 2);
  p.WtPq = (u16*)take((size_t)2048 * 1024 * 2);
  p.subkb = (u16*)take((size_t)262144 * 2);
  p.E8 = (unsigned char*)take((size_t)32768 * 1024);
  p.rs = (float*)take((size_t)32768 * 4);
  p.Amem = (u16*)take((size_t)1024 * 1024 * 2);
  p.gb = (float*)take((size_t)MT * 8 * 4);
  p.ssq1 = (float*)take((size_t)MT * 4);
  p.ssq2 = (float*)take((size_t)MT * 4);
  p.dl = (float*)take(2048 * 4);
  p.Kb = (u16*)take((size_t)16 * 65536 * 2);
  p.VTf = (u16*)take((size_t)16 * 65536 * 2);
  char* regA = take((size_t)MT * NP * 2);
  char* regB = take((size_t)2048 * DN_ITEM);
  p.proj = (u16*)regA;
  p.h1 = (float*)regA;
  p.h2 = (float*)(regA + (size_t)MT * 1024 * 4);
  p.pq = (u16*)regA;
  p.dnops = regB;
  p.A0 = (u16*)regB;
  p.A1 = (u16*)regB;
  p.qb = (u16*)(regB + (size_t)MT * 1024 * 2);
  p.attn = (u16*)regB;
  p.A2 = (u16*)(regB + (size_t)MT * 1024 * 2);
  p.eid = (int*)regB;
  p.gate = (float*)(regB + (size_t)MT * 128 * 4);
  char* ob = (char*)d_out;
  p.vT = (u16*)ob;
  p.osw = (u16*)(ob + (size_t)3 * MP * 256 * 2);
  p.lse = (float*)(ob + (size_t)3 * MP * 256 * 2 + (size_t)3 * MT * 256 * 2);
  char* sb = ob + O_SW3 * 4;
  p.odn = (u16*)sb;
  p.Amix = (u16*)(sb + (size_t)MT * 512 * 2);
  if (off > ws_size) { fprintf(stderr, "workspace too small: need %zu have %zu\n", off, ws_size); return; }
  void* args[] = {&p};
  hipError_t e = hipLaunchCooperativeKernel((void*)mega, dim3(grid_blocks), dim3(256), args, 0, stream);
  if (e != hipSuccess) fprintf(stderr, "coop launch failed: %s (grid %d)\n", hipGetErrorString(e), grid_blocks);
}
```

```cpp
#include <hip/hip_runtime.h>
#include <hip/hip_cooperative_groups.h>
#include <cstdio>
namespace cg = cooperative_groups;

typedef unsigned short u16;
typedef __attribute__((ext_vector_type(8))) short bf16x8;
typedef __attribute__((ext_vector_type(4))) float f32x4;
typedef __attribute__((ext_vector_type(2))) __bf16 bf2_t;

#define DI __device__ __forceinline__
#define MFMA(a, b, c) __builtin_amdgcn_mfma_f32_16x16x32_bf16((a), (b), (c), 0, 0, 0)

constexpr int MP = 32768, MS = 128, MT = 32896;
constexpr int NP = 4352;
constexpr int SEQ = 8192;
constexpr float EPS = 1e-6f;
constexpr size_t DN_ITEM = 73728;

constexpr size_t O_YP = 0, O_YS = 33554432, O_PDELTA = 33685504, O_PCONV = 33947648, O_PW1 = 33966080,
                 O_PW2 = 34228224, O_PW3 = 35276800, O_PMEM = 39471104, O_SDELTA = 41568256, O_SCONV = 43665408,
                 O_SW1 = 43812864, O_SW2 = 45910016, O_SW3 = 54298624;

struct Params {
  const float *x_prompt, *x_sample, *state_delta, *state_conv, *cw1, *cw2, *cw3, *cache_mem, *mem_prompt;
  const float *g_mix, *w_in, *conv_w, *a_log, *dt_bias, *g_onorm, *w_out, *g_memq, *g_memkv, *w_mq, *w_mkv, *w_mo;
  const float *g_ffn, *w_pq, *sub_keys, *expert_u, *expert_v, *g_final;
  float* out;
  u16 *WtIn, *WtOut, *WtMq, *WtMkv, *WtMo, *WtPq, *subkb, *Amem;
  unsigned char* E8;
  float* rs;
  float *gb, *ssq1, *ssq2, *dl;
  u16 *Kb, *VTf;
  u16* proj;
  float *h1, *h2;
  u16* pq;
  char* dnops;
  u16 *A0, *A1, *qb, *attn, *A2;
  int* eid;
  float* gate;
  u16 *vT, *osw, *odn, *Amix;
  float* lse;
};

DI u16 f2bf(float x) { unsigned u = __float_as_uint(x); u += 0x7fffu + ((u >> 16) & 1u); return (u16)(u >> 16); }
DI float bf2f(u16 h) { return __uint_as_float(((unsigned)h) << 16); }
DI unsigned pack2(float a, float b) { return (unsigned)f2bf(a) | ((unsigned)f2bf(b) << 16); }
DI float bflo(unsigned d) { return __uint_as_float(d << 16); }
DI float bfhi(unsigned d) { return __uint_as_float(d & 0xffff0000u); }
DI bf16x8 pack8(f32x4 a, f32x4 b) {
  uint4 r; r.x = pack2(a[0], a[1]); r.y = pack2(a[2], a[3]); r.z = pack2(b[0], b[1]); r.w = pack2(b[2], b[3]);
  return __builtin_bit_cast(bf16x8, r);
}
DI float wave_sum(float v) {
#pragma unroll
  for (int o = 32; o > 0; o >>= 1) v += __shfl_xor(v, o);
  return v;
}
DI float wave_max(float v) {
#pragma unroll
  for (int o = 32; o > 0; o >>= 1) v = fmaxf(v, __shfl_xor(v, o));
  return v;
}
DI float siluf(float x) { return x / (1.f + __expf(-x)); }
DI float geluf(float x) { return 0.5f * x * (1.f + tanhf(0.7978845608028654f * (x + 0.044715f * x * x * x))); }
DI int permk(int kg, int j) { return (j < 4) ? (kg * 4 + j) : (16 + kg * 4 + (j - 4)); }
DI void cvt8(const float* __restrict__ s, u16* __restrict__ d) {
  float4 a = *(const float4*)s, b = *(const float4*)(s + 4);
  uint4 r; r.x = pack2(a.x, a.y); r.y = pack2(a.z, a.w); r.z = pack2(b.x, b.y); r.w = pack2(b.z, b.w);
  *(uint4*)d = r;
}
DI unsigned ordf(float f) { unsigned u = __float_as_uint(f); return (u & 0x80000000u) ? ~u : (u | 0x80000000u); }
DI float unordf(unsigned k) { unsigned u = (k & 0x80000000u) ? (k & 0x7fffffffu) : ~k; return __uint_as_float(u); }
DI unsigned umax(unsigned a, unsigned b) { return a > b ? a : b; }
template <typename T> DI T sel4(int L, T a, T b, T c, T d) { return L == 0 ? a : (L == 1 ? b : (L == 2 ? c : d)); }

template <int MODE>
DI void gemm_tile(const Params& p, const u16* __restrict__ A, int lda, const u16* __restrict__ Bt, int K, int tm, int tn,
                          char* smem) {
  u16* sA = (u16*)smem;
  u16* sB = sA + 128 * 72;
  const int tid = threadIdx.x, lane = tid & 63, w = tid >> 6;
  const int wm = w >> 1, wn = w & 1, r = lane & 15, kg = lane >> 4;
  f32x4 acc[4][4];
#pragma unroll
  for (int i = 0; i < 4; ++i)
#pragma unroll
    for (int j = 0; j < 4; ++j) acc[i][j] = (f32x4){0.f, 0.f, 0.f, 0.f};
  const int lrow = tid >> 1, lcol = (tid & 1) * 32;
  const u16* gA = A + (size_t)(tm * 128 + lrow) * lda + lcol;
  const u16* gB = Bt + (size_t)(tn * 128 + lrow) * K + lcol;
  bf16x8 ra[2][4], rb[2][4];
#pragma unroll
  for (int st = 0; st < 2; ++st)
#pragma unroll
    for (int i = 0; i < 4; ++i) { ra[st][i] = *(const bf16x8*)(gA + st * 64 + i * 8); rb[st][i] = *(const bf16x8*)(gB + st * 64 + i * 8); }
  for (int k0 = 0; k0 < K; k0 += 128) {
#pragma unroll
    for (int st = 0; st < 2; ++st) {
      __syncthreads();
#pragma unroll
      for (int i = 0; i < 4; ++i) {
        *(bf16x8*)&sA[lrow * 72 + lcol + i * 8] = ra[st][i];
        *(bf16x8*)&sB[lrow * 72 + lcol + i * 8] = rb[st][i];
      }
      __syncthreads();
      if (k0 + st * 64 + 128 < K) {
#pragma unroll
        for (int i = 0; i < 4; ++i) {
          ra[st][i] = *(const bf16x8*)(gA + k0 + st * 64 + 128 + i * 8);
          rb[st][i] = *(const bf16x8*)(gB + k0 + st * 64 + 128 + i * 8);
        }
      }
#pragma unroll
      for (int ks = 0; ks < 2; ++ks) {
        bf16x8 af[4], bfr[4];
#pragma unroll
        for (int i = 0; i < 4; ++i) {
          af[i] = *(const bf16x8*)&sA[(wm * 64 + i * 16 + r) * 72 + ks * 32 + kg * 8];
          bfr[i] = *(const bf16x8*)&sB[(wn * 64 + i * 16 + r) * 72 + ks * 32 + kg * 8];
        }
#pragma unroll
        for (int mt = 0; mt < 4; ++mt)
#pragma unroll
          for (int nt = 0; nt < 4; ++nt) acc[mt][nt] = MFMA(bfr[nt], af[mt], acc[mt][nt]);
      }
    }
  }
#pragma unroll
  for (int mt = 0; mt < 4; ++mt) {
    const int row = tm * 128 + wm * 64 + mt * 16 + r;
    float rs = 1.f, ssq = 0.f;
    if (MODE == 3) rs = rsqrtf(p.ssq1[row] * (1.f / 1024.f) + EPS);
    if (MODE == 5) rs = rsqrtf(p.ssq2[row] * (1.f / 1024.f) + EPS);
#pragma unroll
    for (int nt = 0; nt < 4; ++nt) {
      const int col = tn * 128 + wn * 64 + nt * 16 + kg * 4;
      f32x4 v = acc[mt][nt];
      if (MODE == 0) {
        uint2 o; o.x = pack2(v[0], v[1]); o.y = pack2(v[2], v[3]);
        *(uint2*)&p.proj[(size_t)row * NP + col] = o;
      } else if (MODE == 1) {
        *(float4*)&p.out[O_PMEM + (size_t)row * 2048 + col] = make_float4(v[0], v[1], v[2], v[3]);
      } else if (MODE == 2 || MODE == 4) {
        float4 rsd;
        const float* gn;
        if (MODE == 2) {
          rsd = (row < MP) ? *(const float4*)&p.x_prompt[(size_t)row * 1024 + col] : *(const float4*)&p.x_sample[(size_t)(row - MP) * 1024 + col];
          gn = p.g_memq;
        } else {
          rsd = *(const float4*)&p.h1[(size_t)row * 1024 + col];
          gn = p.g_ffn;
        }
        float4 h = make_float4(rsd.x + v[0], rsd.y + v[1], rsd.z + v[2], rsd.w + v[3]);
        float4 g4 = *(const float4*)&gn[col];
        ssq += h.x * h.x + h.y * h.y + h.z * h.z + h.w * h.w;
        uint2 o; o.x = pack2(h.x * g4.x, h.y * g4.y); o.y = pack2(h.z * g4.z, h.w * g4.w);
        if (MODE == 2) { *(float4*)&p.h1[(size_t)row * 1024 + col] = h; *(uint2*)&p.A1[(size_t)row * 1024 + col] = o; }
        else { *(float4*)&p.h2[(size_t)row * 1024 + col] = h; *(uint2*)&p.A2[(size_t)row * 1024 + col] = o; }
      } else if (MODE == 3) {
        uint2 o; o.x = pack2(v[0] * rs, v[1] * rs); o.y = pack2(v[2] * rs, v[3] * rs);
        *(uint2*)&p.qb[(size_t)row * 1024 + col] = o;
      } else {
        uint2 o; o.x = pack2(v[0] * rs, v[1] * rs); o.y = pack2(v[2] * rs, v[3] * rs);
        *(uint2*)&p.pq[(size_t)row * 2048 + col] = o;
      }
    }
    if (MODE == 2 || MODE == 4) {
      ssq += __shfl_xor(ssq, 16);
      ssq += __shfl_xor(ssq, 32);
      if (kg == 0) atomicAdd((MODE == 2) ? &p.ssq1[row] : &p.ssq2[row], ssq);
    }
  }
}

DI void tr_tile(const float* __restrict__ W, int ldw, int nsrc0, u16* __restrict__ Wt, int K, int k0, int n0, float* tile) {
  const int tid = threadIdx.x;
  const int n = tid & 63, kq = tid >> 6;
  __syncthreads();
#pragma unroll
  for (int i = 0; i < 16; ++i) { int kk = kq + 4 * i; tile[kk * 65 + n] = W[(size_t)(k0 + kk) * ldw + nsrc0 + n]; }
  __syncthreads();
  const int nn = tid >> 2, ks = (tid & 3) * 16;
  unsigned o[8];
#pragma unroll
  for (int i = 0; i < 8; ++i) o[i] = pack2(tile[(ks + 2 * i) * 65 + nn], tile[(ks + 2 * i + 1) * 65 + nn]);
  u16* d = Wt + (size_t)(n0 + nn) * K + k0 + ks;
  *(uint4*)d = make_uint4(o[0], o[1], o[2], o[3]);
  *(uint4*)(d + 8) = make_uint4(o[4], o[5], o[6], o[7]);
}

DI void phase0(const Params& p, char* smem) {
  const int tid = threadIdx.x, lane = tid & 63, w = tid >> 6;
  const size_t gtid = (size_t)blockIdx.x * 256 + tid, gsz = (size_t)gridDim.x * 256;
  {
    const float* eu = p.expert_u;
    const float* ev = p.expert_v;
    unsigned char* e8 = p.E8;
    float* rsp = p.rs;
    for (int er = blockIdx.x * 4 + w; er < 32768; er += gridDim.x * 4) {
      const float* src = (er < 16384) ? (eu + (size_t)er * 1024) : (ev + (size_t)(er - 16384) * 1024);
      float4 v[4];
      float am = 0.f;
#pragma unroll
      for (int i = 0; i < 4; ++i) {
        v[i] = *(const float4*)&src[lane * 16 + i * 4];
        am = fmaxf(am, fmaxf(fmaxf(fabsf(v[i].x), fabsf(v[i].y)), fmaxf(fabsf(v[i].z), fabsf(v[i].w))));
      }
      am = wave_max(am);
      const float sc = (am > 0.f) ? 224.f / am : 1.f;
      int o[4];
#pragma unroll
      for (int i = 0; i < 4; ++i) {
        int t = __builtin_amdgcn_cvt_pk_fp8_f32(v[i].x * sc, v[i].y * sc, 0, false);
        o[i] = __builtin_amdgcn_cvt_pk_fp8_f32(v[i].z * sc, v[i].w * sc, t, true);
      }
      *(uint4*)&e8[(size_t)er * 1024 + lane * 16] = make_uint4((unsigned)o[0], (unsigned)o[1], (unsigned)o[2], (unsigned)o[3]);
      if (lane == 0) rsp[er] = (am > 0.f) ? am * (1.f / 224.f) : 1.f;
    }
  }
  for (size_t i = gtid; i < 262144 / 8; i += gsz) cvt8(p.sub_keys + i * 8, p.subkb + i * 8);
  for (size_t i = gtid; i < MT; i += gsz) { p.ssq1[i] = 0.f; p.ssq2[i] = 0.f; }
  float* wl = (float*)smem;
  __syncthreads();
  for (int i = tid; i < 2048; i += 256) {
    const int k = i >> 1, hf = i & 1;
    float4 t = *(const float4*)&p.w_in[(size_t)k * 4360 + 1536 + hf * 4];
    wl[(hf * 4 + 0) * 1024 + k] = t.x; wl[(hf * 4 + 1) * 1024 + k] = t.y; wl[(hf * 4 + 2) * 1024 + k] = t.z; wl[(hf * 4 + 3) * 1024 + k] = t.w;
  }
  __syncthreads();
  const float* xpp = p.x_prompt;
  const float* xsp = p.x_sample;
  const float* mpp = p.mem_prompt;
  const float* gmx = p.g_mix;
  const float* gmk = p.g_memkv;
  u16* a0p = p.A0;
  u16* amp = p.Amem;
  for (int row = blockIdx.x * 4 + w; row < MT + 1024; row += gridDim.x * 4) {
    const float* src; const float* g; u16* dst;
    if (row < MP) { src = xpp + (size_t)row * 1024; g = gmx; dst = a0p + (size_t)row * 1024; }
    else if (row < MT) { src = xsp + (size_t)(row - MP) * 1024; g = gmx; dst = a0p + (size_t)row * 1024; }
    else { src = mpp + (size_t)(row - MT) * 1024; g = gmk; dst = amp + (size_t)(row - MT) * 1024; }
    float4 v[4];
    float ss = 0.f;
#pragma unroll
    for (int i = 0; i < 4; ++i) { v[i] = *(const float4*)&src[lane * 4 + i * 256]; ss += v[i].x * v[i].x + v[i].y * v[i].y + v[i].z * v[i].z + v[i].w * v[i].w; }
    ss = wave_sum(ss);
    const float rs = rsqrtf(ss * (1.f / 1024.f) + EPS);
    float d8[8] = {0.f, 0.f, 0.f, 0.f, 0.f, 0.f, 0.f, 0.f};
#pragma unroll
    for (int i = 0; i < 4; ++i) {
      float4 g4 = *(const float4*)&g[lane * 4 + i * 256];
      float y[4] = {v[i].x * rs * g4.x, v[i].y * rs * g4.y, v[i].z * rs * g4.z, v[i].w * rs * g4.w};
      uint2 o; o.x = pack2(y[0], y[1]); o.y = pack2(y[2], y[3]);
      *(uint2*)&dst[lane * 4 + i * 256] = o;
      if (row < MT) {
#pragma unroll
        for (int j = 0; j < 8; ++j) {
          float4 wv = *(const float4*)&wl[j * 1024 + i * 256 + lane * 4];
          d8[j] += y[0] * wv.x + y[1] * wv.y + y[2] * wv.z + y[3] * wv.w;
        }
      }
    }
    if (row < MT) {
#pragma unroll
      for (int j = 0; j < 8; ++j) d8[j] = wave_sum(d8[j]);
      if (lane < 4) {
        float ag = sel4(lane, d8[0], d8[1], d8[2], d8[3]);
        float bg = sel4(lane, d8[4], d8[5], d8[6], d8[7]);
        float xs = ag + p.dt_bias[lane];
        float sp = (xs > 20.f) ? xs : log1pf(expf(xs));
        p.gb[(size_t)row * 8 + lane] = -expf(p.a_log[lane]) * sp;
        p.gb[(size_t)row * 8 + 4 + lane] = 1.f / (1.f + expf(-bg));
      }
    }
  }
  __syncthreads();
  float* tile = (float*)smem;
  for (int j = blockIdx.x; j < 2816; j += gridDim.x) {
    int t = j;
    if (t < 1088) { int kt = t / 68, nt = t % 68; int n0 = nt * 64; tr_tile(p.w_in, 4360, n0 + (n0 >= 1536 ? 8 : 0), p.WtIn, 1024, kt * 64, n0, tile); continue; }
    t -= 1088;
    if (t < 192) { int kt = t / 16, nt = t % 16; tr_tile(p.w_out, 1024, nt * 64, p.WtOut, 768, kt * 64, nt * 64, tile); continue; }
    t -= 192;
    if (t < 256) { int kt = t / 16, nt = t % 16; tr_tile(p.w_mq, 1024, nt * 64, p.WtMq, 1024, kt * 64, nt * 64, tile); continue; }
    t -= 256;
    if (t < 512) { int kt = t / 32, nt = t % 32; tr_tile(p.w_mkv, 2048, nt * 64, p.WtMkv, 1024, kt * 64, nt * 64, tile); continue; }
    t -= 512;
    if (t < 256) { int kt = t / 16, nt = t % 16; tr_tile(p.w_mo, 1024, nt * 64, p.WtMo, 1024, kt * 64, nt * 64, tile); continue; }
    t -= 256;
    { int kt = t / 32, nt = t % 32; tr_tile(p.w_pq, 2048, nt * 64, p.WtPq, 1024, kt * 64, nt * 64, tile); }
  }
}

DI void dn_prep(const Params& p, int item, char* smem) {
  u16* qs = (u16*)smem;
  u16* ksm = qs + 64 * 136;
  float* sL = (float*)(ksm + 64 * 136);
  float* sgc = sL + 64 * 64;
  float* sbeta = sgc + 64;
  u16* sU = (u16*)sL;
  u16* sW = qs;
  const int tid = threadIdx.x, lane = tid & 63, w = tid >> 6, r = lane & 15, kg = lane >> 4;
  const int bh = item >> 7, n = item & 127, b = bh >> 2, h = bh & 3;
  const int t0 = n * 64;
  const size_t rowbase = (size_t)b * SEQ;
  char* ops = p.dnops + (size_t)item * DN_ITEM;
  __syncthreads();
  if (tid < 64) {
    float gv = p.gb[(rowbase + t0 + tid) * 8 + h];
    float bv = p.gb[(rowbase + t0 + tid) * 8 + 4 + h];
#pragma unroll
    for (int o = 1; o < 64; o <<= 1) { float t = __shfl_up(gv, o); if (lane >= o) gv += t; }
    sgc[tid] = gv; sbeta[tid] = bv;
    if (tid == 63) p.dl[item] = __expf(gv);
  }
#pragma unroll 4
  for (int ps = 0; ps < 8; ++ps) {
    const int combo = ps * 16 + (tid >> 4);
    const int tt = combo & 63, part = combo >> 6, sub = tid & 15;
    const int col = part * 512 + h * 128 + sub * 8;
    float y[8] = {0.f, 0.f, 0.f, 0.f, 0.f, 0.f, 0.f, 0.f};
#pragma unroll
    for (int j = 0; j < 4; ++j) {
      const int t = t0 + tt - 3 + j;
      if (t >= 0) {
        uint4 xv = *(const uint4*)&p.proj[(rowbase + t) * NP + col];
        float4 wa = *(const float4*)&p.conv_w[j * 1536 + col], wb = *(const float4*)&p.conv_w[j * 1536 + col + 4];
        y[0] += bflo(xv.x) * wa.x; y[1] += bfhi(xv.x) * wa.y; y[2] += bflo(xv.y) * wa.z; y[3] += bfhi(xv.y) * wa.w;
        y[4] += bflo(xv.z) * wb.x; y[5] += bfhi(xv.z) * wb.y; y[6] += bflo(xv.w) * wb.z; y[7] += bfhi(xv.w) * wb.w;
      }
    }
    float ss = 0.f;
#pragma unroll
    for (int e = 0; e < 8; ++e) { y[e] = siluf(y[e]); ss += y[e] * y[e]; }
    ss += __shfl_xor(ss, 1); ss += __shfl_xor(ss, 2); ss += __shfl_xor(ss, 4); ss += __shfl_xor(ss, 8);
    float sc = rsqrtf(ss + EPS) * (part == 0 ? 0.08838834764831845f : 1.f);
    uint4 o; o.x = pack2(y[0] * sc, y[1] * sc); o.y = pack2(y[2] * sc, y[3] * sc); o.z = pack2(y[4] * sc, y[5] * sc); o.w = pack2(y[6] * sc, y[7] * sc);
    *(uint4*)&((part == 0 ? qs : ksm)[tt * 136 + sub * 8]) = o;
  }
  __syncthreads();
  const float gcl = sgc[63];
  {
    f32x4 aL[4], aA[4];
#pragma unroll
    for (int i = 0; i < 4; ++i) { aL[i] = (f32x4){0.f, 0.f, 0.f, 0.f}; aA[i] = (f32x4){0.f, 0.f, 0.f, 0.f}; }
#pragma unroll
    for (int ks = 0; ks < 4; ++ks) {
      bf16x8 kI = *(const bf16x8*)&ksm[(w * 16 + r) * 136 + ks * 32 + kg * 8];
      bf16x8 qI = *(const bf16x8*)&qs[(w * 16 + r) * 136 + ks * 32 + kg * 8];
#pragma unroll
      for (int nt = 0; nt < 4; ++nt) {
        bf16x8 kJ = *(const bf16x8*)&ksm[(nt * 16 + r) * 136 + ks * 32 + kg * 8];
        aL[nt] = MFMA(kJ, kI, aL[nt]);
        aA[nt] = MFMA(kJ, qI, aA[nt]);
      }
    }
    const int i = w * 16 + r;
    const float gci = sgc[i], bi = sbeta[i];
    u16* aq = (u16*)(ops + 49152);
#pragma unroll
    for (int nt = 0; nt < 4; ++nt) {
      float lv[4], av[4];
#pragma unroll
      for (int jj = 0; jj < 4; ++jj) {
        const int j = nt * 16 + kg * 4 + jj;
        const float gam = (i >= j) ? __expf(gci - sgc[j]) : 0.f;
        lv[jj] = (i > j) ? aL[nt][jj] * bi * gam : 0.f;
        av[jj] = aA[nt][jj] * gam;
      }
      *(float4*)&sL[i * 64 + nt * 16 + kg * 4] = make_float4(lv[0], lv[1], lv[2], lv[3]);
      uint2 o; o.x = pack2(av[0], av[1]); o.y = pack2(av[2], av[3]);
      *(uint2*)&aq[((w * 2 + (nt >> 1)) * 64 + lane) * 8 + (nt & 1) * 4] = o;
    }
  }
  {
    u16* qg = (u16*)(ops + 16384);
    u16* kdT = (u16*)(ops + 32768);
#pragma unroll 1
    for (int i = 0; i < 4; ++i) {
      const int f = tid + 256 * i;
      const int mtks = f >> 6, l = f & 63, rr = l & 15, kgg = l >> 4;
      {
        const int mt = mtks >> 2, ks = mtks & 3, row = mt * 16 + rr;
        const float e = __expf(sgc[row]);
        uint2 a = *(const uint2*)&qs[row * 136 + ks * 32 + kgg * 4];
        uint2 c = *(const uint2*)&qs[row * 136 + ks * 32 + 16 + kgg * 4];
        uint4 o;
        o.x = pack2(bflo(a.x) * e, bfhi(a.x) * e); o.y = pack2(bflo(a.y) * e, bfhi(a.y) * e);
        o.z = pack2(bflo(c.x) * e, bfhi(c.x) * e); o.w = pack2(bflo(c.y) * e, bfhi(c.y) * e);
        *(uint4*)&qg[(size_t)f * 8] = o;
      }
      {
        const int mt = mtks >> 1, ks = mtks & 1, kdim = mt * 16 + rr;
        float v[8];
#pragma unroll
        for (int j = 0; j < 8; ++j) {
          const int c = ks * 32 + permk(kgg, j);
          v[j] = bf2f(ksm[c * 136 + kdim]) * __expf(gcl - sgc[c]);
        }
        uint4 o; o.x = pack2(v[0], v[1]); o.y = pack2(v[2], v[3]); o.z = pack2(v[4], v[5]); o.w = pack2(v[6], v[7]);
        *(uint4*)&kdT[(size_t)f * 8] = o;
      }
    }
  }
  __syncthreads();
  float x[64];
  if (tid < 128) {
    const int col = 1024 + h * 128 + tid;
    const float w0 = p.conv_w[col], w1 = p.conv_w[1536 + col], w2 = p.conv_w[3072 + col], w3 = p.conv_w[4608 + col];
    float xm3 = 0.f, xm2 = 0.f, xm1 = 0.f;
    if (t0 > 0) {
      xm3 = bf2f(p.proj[(rowbase + t0 - 3) * NP + col]);
      xm2 = bf2f(p.proj[(rowbase + t0 - 2) * NP + col]);
      xm1 = bf2f(p.proj[(rowbase + t0 - 1) * NP + col]);
    }
#pragma unroll
    for (int t = 0; t < 64; ++t) {
      float xc = bf2f(p.proj[(rowbase + t0 + t) * NP + col]);
      float yv = w0 * xm3 + w1 * xm2 + w2 * xm1 + w3 * xc;
      x[t] = siluf(yv) * sbeta[t];
      xm3 = xm2; xm2 = xm1; xm1 = xc;
    }
  } else {
    const int kc = tid - 128;
#pragma unroll
    for (int t = 0; t < 64; ++t) x[t] = bf2f(ksm[t * 136 + kc]) * sbeta[t] * __expf(sgc[t]);
  }
#pragma unroll
  for (int i = 1; i < 64; ++i) {
    float s = x[i];
#pragma unroll
    for (int j4 = 0; j4 < (i + 3) / 4; ++j4) {
      float4 l = *(const float4*)&sL[i * 64 + j4 * 4];
      s -= l.x * x[j4 * 4];
      if (j4 * 4 + 1 < i) s -= l.y * x[j4 * 4 + 1];
      if (j4 * 4 + 2 < i) s -= l.z * x[j4 * 4 + 2];
      if (j4 * 4 + 3 < i) s -= l.w * x[j4 * 4 + 3];
    }
    x[i] = s;
  }
  __syncthreads();
  if (tid < 128) {
#pragma unroll
    for (int t = 0; t < 64; ++t) sU[t * 128 + tid] = f2bf(x[t]);
  } else {
    const int kc = tid - 128;
#pragma unroll
    for (int t = 0; t < 64; ++t) sW[t * 136 + kc] = f2bf(-x[t]);
  }
  __syncthreads();
  {
    u16* nW = (u16*)ops;
    u16* u0 = (u16*)(ops + 57344);
#pragma unroll 1
    for (int i = 0; i < 4; ++i) {
      const int f = tid + 256 * i;
      const int mtks = f >> 6, l = f & 63, rr = l & 15, kgg = l >> 4;
      const int mt = mtks >> 2, ks = mtks & 3, row = mt * 16 + rr;
      uint2 a = *(const uint2*)&sW[row * 136 + ks * 32 + kgg * 4];
      uint2 c = *(const uint2*)&sW[row * 136 + ks * 32 + 16 + kgg * 4];
      *(uint4*)&nW[(size_t)f * 8] = make_uint4(a.x, a.y, c.x, c.y);
    }
#pragma unroll 1
    for (int i = 0; i < 8; ++i) {
      const int f = tid + 256 * i;
      const int smt = f >> 6, l = f & 63, rr = l & 15, kgg = l >> 4;
      const int s = smt >> 2, mt = smt & 3;
      u16 v0 = sU[(mt * 16 + kgg * 4 + 0) * 128 + s * 16 + rr];
      u16 v1 = sU[(mt * 16 + kgg * 4 + 1) * 128 + s * 16 + rr];
      u16 v2 = sU[(mt * 16 + kgg * 4 + 2) * 128 + s * 16 + rr];
      u16 v3 = sU[(mt * 16 + kgg * 4 + 3) * 128 + s * 16 + rr];
      *(uint2*)&u0[(size_t)f * 4] = make_uint2((unsigned)v0 | ((unsigned)v1 << 16), (unsigned)v2 | ((unsigned)v3 << 16));
    }
  }
}

DI void vt_tile(const Params& p, int item, char* smem) {
  u16* tile = (u16*)smem;
  const int tid = threadIdx.x;
  const int ptile = item & 127, gbh = item >> 7;
  const int h = gbh & 3, b = (gbh >> 2) & 3, g = gbh >> 4;
  const int dsh = g * 2, ln = SEQ >> dsh;
  const int pos0 = ptile * 64;
  const int rres = pos0 / ln, i0 = pos0 % ln;
  __syncthreads();
  {
    const int pr = tid >> 2, seg = (tid & 3) * 16;
    const int token = ((i0 + pr) << dsh) + rres;
    const u16* src = &p.proj[((size_t)b * SEQ + token) * NP + 2048 + g * 768 + 512 + h * 64 + seg];
    uint4 a = *(const uint4*)src, c = *(const uint4*)(src + 8);
    unsigned d[8] = {a.x, a.y, a.z, a.w, c.x, c.y, c.z, c.w};
#pragma unroll
    for (int e = 0; e < 8; ++e) *(unsigned*)&tile[pr * 66 + seg + e * 2] = d[e];
  }
  __syncthreads();
  {
    const int dh = tid >> 2, seg = (tid & 3) * 16;
    unsigned o[8];
#pragma unroll
    for (int e = 0; e < 8; ++e) o[e] = (unsigned)tile[(seg + 2 * e) * 66 + dh] | ((unsigned)tile[(seg + 2 * e + 1) * 66 + dh] << 16);
    u16* d = &p.vT[((size_t)gbh * 64 + dh) * SEQ + pos0 + seg];
    *(uint4*)d = make_uint4(o[0], o[1], o[2], o[3]);
    *(uint4*)(d + 8) = make_uint4(o[4], o[5], o[6], o[7]);
  }
}

DI void dn_sample(const Params& p, int item, char* smem) {
  float* sq = (float*)smem;
  float* sk = sq + 512;
  float* sv = sk + 512;
  float* red = sv + 512;
  const int tid = threadIdx.x, lane = tid & 63, w = tid >> 6;
  const int b = item >> 2, h = item & 3;
  __syncthreads();
  for (int c = tid; c < 384; c += 256) {
    const int part = c >> 7, cc = c & 127;
    const int col = part * 512 + h * 128 + cc;
    float xp[7];
#pragma unroll
    for (int j = 0; j < 3; ++j) xp[j] = p.state_conv[((size_t)b * 3 + j) * 1536 + col];
#pragma unroll
    for (int j = 0; j < 4; ++j) xp[3 + j] = bf2f(p.proj[((size_t)MP + b * 4 + j) * NP + col]);
    const float w0 = p.conv_w[col], w1 = p.conv_w[1536 + col], w2 = p.conv_w[3072 + col], w3 = p.conv_w[4608 + col];
    float* dst = part == 0 ? sq : (part == 1 ? sk : sv);
#pragma unroll
    for (int t = 0; t < 4; ++t) dst[t * 128 + cc] = siluf(w0 * xp[t] + w1 * xp[t + 1] + w2 * xp[t + 2] + w3 * xp[t + 3]);
  }
  __syncthreads();
  {
    float a0 = sq[w * 128 + lane], a1 = sq[w * 128 + 64 + lane];
    float s = wave_sum(a0 * a0 + a1 * a1);
    float sc = rsqrtf(s + EPS) * 0.08838834764831845f;
    sq[w * 128 + lane] = a0 * sc; sq[w * 128 + 64 + lane] = a1 * sc;
    float b0 = sk[w * 128 + lane], b1 = sk[w * 128 + 64 + lane];
    s = wave_sum(b0 * b0 + b1 * b1);
    sc = rsqrtf(s + EPS);
    sk[w * 128 + lane] = b0 * sc; sk[w * 128 + 64 + lane] = b1 * sc;
  }
  __syncthreads();
  const int v = tid & 127, half = tid >> 7;
  float S[64];
  const float* s0 = p.state_delta + (((size_t)b * 4 + h) * 128 + half * 64) * 128 + v;
#pragma unroll
  for (int i = 0; i < 64; ++i) S[i] = s0[(size_t)i * 128];
#pragma unroll 1
  for (int t = 0; t < 4; ++t) {
    const size_t row = (size_t)MP + b * 4 + t;
    const float a = __expf(p.gb[row * 8 + h]);
    const float beta = p.gb[row * 8 + 4 + h];
    float part = 0.f;
#pragma unroll
    for (int i = 0; i < 64; ++i) part += S[i] * sk[t * 128 + half * 64 + i];
    red[half * 128 + v] = part;
    __syncthreads();
    const float kS = red[v] + red[128 + v];
    const float u = beta * (sv[t * 128 + v] - a * kS);
    float po = 0.f;
#pragma unroll
    for (int i = 0; i < 64; ++i) { S[i] = a * S[i] + sk[t * 128 + half * 64 + i] * u; po += S[i] * sq[t * 128 + half * 64 + i]; }
    __syncthreads();
    red[half * 128 + v] = po;
    __syncthreads();
    if (half == 0) p.odn[row * 512 + h * 128 + v] = f2bf(red[v] + red[128 + v]);
    __syncthreads();
  }
  float* d = p.out + O_SDELTA + (((size_t)b * 4 + h) * 128 + half * 64) * 128 + v;
#pragma unroll
  for (int i = 0; i < 64; ++i) d[(size_t)i * 128] = S[i];
}

DI void phase2(const Params& p, char* smem) {
  const size_t gtid = (size_t)blockIdx.x * 256 + threadIdx.x, gsz = (size_t)gridDim.x * 256;
  for (int j = blockIdx.x; j < 2048 + 128 + 6144; j += gridDim.x) {
    if (j < 2048) dn_prep(p, j, smem);
    else if (j < 2048 + 128) dn_sample(p, j - 2048, smem);
    else vt_tile(p, j - 2176, smem);
  }
  for (size_t f = gtid; f < (size_t)16 * 8192; f += gsz) {
    {
      const size_t e0 = f * 8;
      const int bh = (int)(e0 >> 16), key = (int)((e0 >> 8) & 255), dh = (int)(e0 & 255);
      const int b = bh >> 2, h = bh & 3;
      cvt8(p.out + O_PMEM + (((size_t)b * 256 + key) * 2 + 0) * 1024 + h * 256 + dh, p.Kb + e0);
    }
    {
      const int l = (int)(f & 63), ks = (int)((f >> 6) & 7), nt = (int)((f >> 9) & 15), bh = (int)(f >> 13);
      const int b = bh >> 2, h = bh & 3, rr = l & 15, kgg = l >> 4;
      float v[8];
#pragma unroll
      for (int j = 0; j < 8; ++j) {
        const int key = ks * 32 + permk(kgg, j);
        v[j] = p.out[O_PMEM + (((size_t)b * 256 + key) * 2 + 1) * 1024 + h * 256 + nt * 16 + rr];
      }
      *(uint4*)&p.VTf[f * 8] = make_uint4(pack2(v[0], v[1]), pack2(v[2], v[3]), pack2(v[4], v[5]), pack2(v[6], v[7]));
    }
  }
  for (size_t i = gtid; i < 18432; i += gsz) {
    const int c = (int)(i % 1536), j = (int)((i / 1536) % 3), b = (int)(i / 4608);
    p.out[O_PCONV + i] = bf2f(p.proj[((size_t)b * SEQ + SEQ - 3 + j) * NP + c]);
  }
  for (int g = 0; g < 3; ++g) {
    const int W = 128 << (2 * g);
    const size_t off = (g == 0) ? O_PW1 : (g == 1 ? O_PW2 : O_PW3);
    const size_t n4 = (size_t)4 * W * 512 / 4;
    for (size_t i = gtid; i < n4; i += gsz) {
      const size_t e0 = i * 4;
      const int e = (int)(e0 & 511), ii = (int)((e0 >> 9) % W), b = (int)((e0 >> 9) / W);
      uint2 v = *(const uint2*)&p.proj[((size_t)b * SEQ + SEQ - W + ii) * NP + 2048 + g * 768 + 256 + e];
      *(float4*)&p.out[off + e0] = make_float4(bflo(v.x), bfhi(v.x), bflo(v.y), bfhi(v.y));
    }
  }
}

typedef __attribute__((ext_vector_type(2))) unsigned u32x2;
struct ScanOps { bf16x8 nW[4]; bf16x8 qg[4]; bf16x8 aq[2]; bf16x8 kd[4]; u32x2 u0; float dl; };

DI void scan_load(const Params& p, int bh, int s, int n, int j, int lane, ScanOps& o) {
  n = n > 127 ? 127 : n;
  const char* base = p.dnops + (size_t)(bh * 128 + n) * DN_ITEM;
  const bf16x8* negW = (const bf16x8*)base;
  const bf16x8* qg = (const bf16x8*)(base + 16384);
  const bf16x8* kdT = (const bf16x8*)(base + 32768);
  const bf16x8* aqk = (const bf16x8*)(base + 49152);
  const u32x2* u0 = (const u32x2*)(base + 57344);
#pragma unroll
  for (int ks = 0; ks < 4; ++ks) o.nW[ks] = negW[(j * 4 + ks) * 64 + lane];
#pragma unroll
  for (int ks = 0; ks < 4; ++ks) o.qg[ks] = qg[(j * 4 + ks) * 64 + lane];
#pragma unroll
  for (int k2 = 0; k2 < 2; ++k2) o.aq[k2] = aqk[(j * 2 + k2) * 64 + lane];
#pragma unroll
  for (int mm = 0; mm < 2; ++mm)
#pragma unroll
    for (int k2 = 0; k2 < 2; ++k2) o.kd[mm * 2 + k2] = kdT[((2 * j + mm) * 2 + k2) * 64 + lane];
  o.u0 = u0[(s * 4 + j) * 64 + lane];
  o.dl = p.dl[bh * 128 + n];
}

DI void scan_step(const Params& p, const ScanOps& ops, int n, int b, int h, int s, int j, int lane, f32x4& S0, f32x4& S1,
                  bf16x8* sSb, u32x2* sUb) {
  const int r = lane & 15, kg = lane >> 4;
  bf16x8 sb[4];
#pragma unroll
  for (int ks = 0; ks < 4; ++ks) sb[ks] = sSb[ks * 64 + lane];
  f32x4 u = (f32x4){bflo(ops.u0[0]), bfhi(ops.u0[0]), bflo(ops.u0[1]), bfhi(ops.u0[1])};
#pragma unroll
  for (int ks = 0; ks < 4; ++ks) u = MFMA(ops.nW[ks], sb[ks], u);
  {
    u32x2 t; t[0] = pack2(u[0], u[1]); t[1] = pack2(u[2], u[3]);
    sUb[((j >> 1) * 64 + lane) * 2 + (j & 1)] = t;
  }
  __syncthreads();
  bf16x8 ub[2];
#pragma unroll
  for (int k2 = 0; k2 < 2; ++k2) ub[k2] = *(const bf16x8*)&sUb[(k2 * 64 + lane) * 2];
  f32x4 o = (f32x4){0.f, 0.f, 0.f, 0.f};
#pragma unroll
  for (int ks = 0; ks < 4; ++ks) o = MFMA(ops.qg[ks], sb[ks], o);
#pragma unroll
  for (int k2 = 0; k2 < 2; ++k2) o = MFMA(ops.aq[k2], ub[k2], o);
  S0 = S0 * ops.dl; S1 = S1 * ops.dl;
#pragma unroll
  for (int k2 = 0; k2 < 2; ++k2) { S0 = MFMA(ops.kd[k2], ub[k2], S0); S1 = MFMA(ops.kd[2 + k2], ub[k2], S1); }
  sSb[j * 64 + lane] = pack8(S0, S1);
#pragma unroll
  for (int jj = 0; jj < 4; ++jj) {
    const size_t token = (size_t)b * SEQ + n * 64 + j * 16 + kg * 4 + jj;
    p.odn[token * 512 + h * 128 + s * 16 + r] = f2bf(o[jj]);
  }
  __syncthreads();
}

DI void dn_scan_block(const Params& p, int item, char* smem) {
  const int lane = threadIdx.x & 63, j = threadIdx.x >> 6, r = lane & 15, kg = lane >> 4;
  const int bh = item >> 3, s = item & 7, b = bh >> 2, h = bh & 3;
  bf16x8* sSb = (bf16x8*)smem;
  u32x2* sUb = (u32x2*)(smem + 4096);
  f32x4 S0 = (f32x4){0.f, 0.f, 0.f, 0.f}, S1 = (f32x4){0.f, 0.f, 0.f, 0.f};
  __syncthreads();
  sSb[j * 64 + lane] = pack8(S0, S1);
  ScanOps A, B;
  scan_load(p, bh, s, 0, j, lane, A);
  scan_load(p, bh, s, 1, j, lane, B);
  __syncthreads();
#pragma unroll 1
  for (int n0 = 0; n0 < 128; n0 += 2) {
    scan_step(p, A, n0, b, h, s, j, lane, S0, S1, sSb, sUb);
    scan_load(p, bh, s, n0 + 2, j, lane, A);
    scan_step(p, B, n0 + 1, b, h, s, j, lane, S0, S1, sSb, sUb);
    scan_load(p, bh, s, n0 + 3, j, lane, B);
  }
#pragma unroll
  for (int jj = 0; jj < 4; ++jj) {
    p.out[O_PDELTA + ((size_t)bh * 128 + 32 * j + kg * 4 + jj) * 128 + s * 16 + r] = S0[jj];
    p.out[O_PDELTA + ((size_t)bh * 128 + 32 * j + 16 + kg * 4 + jj) * 128 + s * 16 + r] = S1[jj];
  }
}

DI void sw_prompt_wave(const Params& p, int item) {
  const int lane = threadIdx.x & 63, r = lane & 15, kg = lane >> 4;
  const int qt = item & 511, gbh = item >> 9;
  const int h = gbh & 3, b = (gbh >> 2) & 3, g = gbh >> 4;
  const int dsh = 2 * g, ln = SEQ >> dsh;
  const int pos0 = qt * 16, rres = pos0 / ln, i0 = pos0 % ln;
  const int kbase = i0 - 144;
  const size_t rb = (size_t)b * SEQ;
  const int qoff = 2048 + g * 768 + h * 64, koff = qoff + 256;
  bf16x8 qf[2];
  {
    const size_t tok = rb + ((size_t)(i0 + r) << dsh) + rres;
#pragma unroll
    for (int ks = 0; ks < 2; ++ks) qf[ks] = *(const bf16x8*)&p.proj[tok * NP + qoff + ks * 32 + kg * 8];
  }
  f32x4 st[10];
#pragma unroll
  for (int mt = 0; mt < 10; ++mt) {
    int ki = kbase + mt * 16 + r; ki = ki < 0 ? 0 : ki;
    const size_t tok = rb + ((size_t)ki << dsh) + rres;
    f32x4 a = (f32x4){0.f, 0.f, 0.f, 0.f};
#pragma unroll
    for (int ks = 0; ks < 2; ++ks) {
      bf16x8 kf = *(const bf16x8*)&p.proj[tok * NP + koff + ks * 32 + kg * 8];
      a = MFMA(kf, qf[ks], a);
    }
    st[mt] = a;
  }
  const int qi = i0 + r;
  float mx = -3.0e38f;
#pragma unroll
  for (int mt = 0; mt < 10; ++mt)
#pragma unroll
    for (int j = 0; j < 4; ++j) {
      const int ki = kbase + mt * 16 + kg * 4 + j;
      const int d = qi - ki;
      const bool valid = (ki >= 0) && (d >= 0) && (d <= 128);
      const float sv = valid ? st[mt][j] * 0.125f : -3.0e38f;
      st[mt][j] = sv;
      mx = fmaxf(mx, sv);
    }
  mx = fmaxf(mx, __shfl_xor(mx, 16));
  mx = fmaxf(mx, __shfl_xor(mx, 32));
  float sum = 0.f;
#pragma unroll
  for (int mt = 0; mt < 10; ++mt)
#pragma unroll
    for (int j = 0; j < 4; ++j) {
      const float pv = (st[mt][j] > -1.0e38f) ? __expf(st[mt][j] - mx) : 0.f;
      st[mt][j] = pv;
      sum += pv;
    }
  sum += __shfl_xor(sum, 16);
  sum += __shfl_xor(sum, 32);
  const float inv = 1.f / sum;
  bf16x8 pf[5];
#pragma unroll
  for (int k2 = 0; k2 < 5; ++k2) pf[k2] = pack8(st[2 * k2], st[2 * k2 + 1]);
  const size_t qrow = rb + ((size_t)qi << dsh) + rres;
#pragma unroll
  for (int nt = 0; nt < 4; ++nt) {
    f32x4 o = (f32x4){0.f, 0.f, 0.f, 0.f};
    const u16* vrow = &p.vT[((size_t)gbh * 64 + nt * 16 + r) * SEQ + (size_t)rres * ln];
#pragma unroll
    for (int k2 = 0; k2 < 5; ++k2) {
      int ka = kbase + k2 * 32 + kg * 4, kc = ka + 16;
      ka = ka < 0 ? 0 : ka; kc = kc < 0 ? 0 : kc;
      uint2 va = *(const uint2*)&vrow[ka];
      uint2 vc = *(const uint2*)&vrow[kc];
      bf16x8 vf = __builtin_bit_cast(bf16x8, make_uint4(va.x, va.y, vc.x, vc.y));
      o = MFMA(vf, pf[k2], o);
    }
    uint2 ov; ov.x = pack2(o[0] * inv, o[1] * inv); ov.y = pack2(o[2] * inv, o[3] * inv);
    *(uint2*)&p.osw[((size_t)g * MT + qrow) * 256 + h * 64 + nt * 16 + kg * 4] = ov;
  }
  if (kg == 0) p.lse[((size_t)g * MT + qrow) * 4 + h] = mx + __logf(sum);
}

DI void sw_sample_wave(const Params& p, int item) {
  const int lane = threadIdx.x & 63;
  const int t = item & 3, h = (item >> 2) & 3, b = (item >> 4) & 31, g = item >> 9;
  const int dil = 1 << (2 * g), W = 128 << (2 * g);
  const float* c1 = p.cw1;
  const float* c2 = p.cw2;
  const float* c3 = p.cw3;
  const float* cache = (g == 0) ? c1 : (g == 1 ? c2 : c3);
  const int qoff = 2048 + g * 768 + h * 64;
  const size_t qrow = (size_t)MP + b * 4 + t;
  float q[64];
#pragma unroll
  for (int c = 0; c < 64; c += 8) {
    uint4 v = *(const uint4*)&p.proj[qrow * NP + qoff + c];
    q[c] = bflo(v.x); q[c + 1] = bfhi(v.x); q[c + 2] = bflo(v.y); q[c + 3] = bfhi(v.y);
    q[c + 4] = bflo(v.z); q[c + 5] = bfhi(v.z); q[c + 6] = bflo(v.w); q[c + 7] = bfhi(v.w);
  }
  float sc[3];
#pragma unroll
  for (int mi = 0; mi < 3; ++mi) {
    const int m = lane + 64 * mi;
    float s = -3.0e38f;
    if (m <= 128) {
      const int j = W + t - m * dil;
      float d = 0.f;
      if (j >= W) {
        const u16* kr = &p.proj[((size_t)MP + b * 4 + (j - W)) * NP + qoff + 256];
#pragma unroll
        for (int c = 0; c < 64; c += 8) {
          uint4 v = *(const uint4*)&kr[c];
          d += q[c] * bflo(v.x) + q[c + 1] * bfhi(v.x) + q[c + 2] * bflo(v.y) + q[c + 3] * bfhi(v.y) + q[c + 4] * bflo(v.z) +
               q[c + 5] * bfhi(v.z) + q[c + 6] * bflo(v.w) + q[c + 7] * bfhi(v.w);
        }
      } else {
        const float* kr = &cache[(((size_t)b * W + j) * 2 + 0) * 256 + h * 64];
#pragma unroll
        for (int c = 0; c < 64; c += 4) {
          float4 v = *(const float4*)&kr[c];
          d += q[c] * v.x + q[c + 1] * v.y + q[c + 2] * v.z + q[c + 3] * v.w;
        }
      }
      s = d * 0.125f;
    }
    sc[mi] = s;
  }
  float mx = wave_max(fmaxf(fmaxf(sc[0], sc[1]), sc[2]));
  float sum = 0.f;
#pragma unroll
  for (int mi = 0; mi < 3; ++mi) { sc[mi] = (sc[mi] > -1.0e38f) ? __expf(sc[mi] - mx) : 0.f; sum += sc[mi]; }
  sum = wave_sum(sum);
  float o = 0.f;
#pragma unroll
  for (int mi = 0; mi < 3; ++mi) {
#pragma unroll 8
    for (int mm = 0; mm < 64; ++mm) {
      const int m = mi * 64 + mm;
      if (m <= 128) {
        const float pv = __shfl(sc[mi], mm);
        const int j = W + t - m * dil;
        float vv;
        if (j >= W) vv = bf2f(p.proj[((size_t)MP + b * 4 + (j - W)) * NP + qoff + 512 + lane]);
        else vv = cache[(((size_t)b * W + j) * 2 + 1) * 256 + h * 64 + lane];
        o += pv * vv;
      }
    }
  }
  p.osw[((size_t)g * MT + qrow) * 256 + h * 64 + lane] = f2bf(o / sum);
  if (lane == 0) p.lse[((size_t)g * MT + qrow) * 4 + h] = mx + __logf(sum);
}

DI void phase3(const Params& p, char* smem) {
  const int w = threadIdx.x >> 6;
  if (blockIdx.x < 128) {
    dn_scan_block(p, blockIdx.x, smem);
  } else {
    const int gw = (blockIdx.x - 128) * 4 + w, nw = (gridDim.x - 128) * 4;
    for (int it = gw; it < 24576 + 1536; it += nw) {
      if (it < 24576) sw_prompt_wave(p, it);
      else sw_sample_wave(p, it - 24576);
    }
  }
}

DI void phase4(const Params& p) {
  const int lane = threadIdx.x & 63, w = threadIdx.x >> 6;
  for (int row = blockIdx.x * 4 + w; row < MT; row += gridDim.x * 4) {
    u16* dst = p.Amix + (size_t)row * 768;
#pragma unroll
    for (int h = 0; h < 4; ++h) {
      unsigned ov = *(const unsigned*)&p.odn[(size_t)row * 512 + h * 128 + lane * 2];
      unsigned zv = *(const unsigned*)&p.proj[(size_t)row * NP + 1536 + h * 128 + lane * 2];
      float o0 = bflo(ov), o1 = bfhi(ov);
      float ss = wave_sum(o0 * o0 + o1 * o1);
      float rs = rsqrtf(ss * (1.f / 128.f) + EPS);
      float2 gn = *(const float2*)&p.g_onorm[lane * 2];
      float y0 = o0 * rs * gn.x * siluf(bflo(zv)), y1 = o1 * rs * gn.y * siluf(bfhi(zv));
      *(unsigned*)&dst[h * 128 + lane * 2] = pack2(y0, y1);
    }
    {
      const int h = lane >> 4;
      float l0 = p.lse[((size_t)0 * MT + row) * 4 + h], l1 = p.lse[((size_t)1 * MT + row) * 4 + h], l2 = p.lse[((size_t)2 * MT + row) * 4 + h];
      float m = fmaxf(l0, fmaxf(l1, l2));
      float e0 = __expf(l0 - m), e1 = __expf(l1 - m), e2 = __expf(l2 - m);
      float inv = 1.f / (e0 + e1 + e2);
      uint2 a = *(const uint2*)&p.osw[((size_t)0 * MT + row) * 256 + lane * 4];
      uint2 c = *(const uint2*)&p.osw[((size_t)1 * MT + row) * 256 + lane * 4];
      uint2 d = *(const uint2*)&p.osw[((size_t)2 * MT + row) * 256 + lane * 4];
      e0 *= inv; e1 *= inv; e2 *= inv;
      float y0 = e0 * bflo(a.x) + e1 * bflo(c.x) + e2 * bflo(d.x);
      float y1 = e0 * bfhi(a.x) + e1 * bfhi(c.x) + e2 * bfhi(d.x);
      float y2 = e0 * bflo(a.y) + e1 * bflo(c.y) + e2 * bflo(d.y);
      float y3 = e0 * bfhi(a.y) + e1 * bfhi(c.y) + e2 * bfhi(d.y);
      *(uint2*)&dst[512 + lane * 4] = make_uint2(pack2(y0, y1), pack2(y2, y3));
    }
  }
}

DI void sample_state_copy(const Params& p) {
  const size_t gtid = (size_t)blockIdx.x * 256 + threadIdx.x, gsz = (size_t)gridDim.x * 256;
  for (size_t i = gtid; i < 147456; i += gsz) {
    const int c = (int)(i % 1536), j = (int)((i / 1536) % 3), b = (int)(i / 4608);
    p.out[O_SCONV + i] = bf2f(p.proj[((size_t)MP + b * 4 + j + 1) * NP + c]);
  }
  const float* c1 = p.cw1;
  const float* c2 = p.cw2;
  const float* c3 = p.cw3;
  for (int g = 0; g < 3; ++g) {
    const int W = 128 << (2 * g);
    const float* cache = (g == 0) ? c1 : (g == 1 ? c2 : c3);
    const size_t off = (g == 0) ? O_SW1 : (g == 1 ? O_SW2 : O_SW3);
    const size_t n4 = (size_t)32 * W * 512 / 4;
    for (size_t i = gtid; i < n4; i += gsz) {
      const size_t e0 = i * 4;
      const int e = (int)(e0 & 511), ii = (int)((e0 >> 9) % W), b = (int)((e0 >> 9) / W);
      float4 o;
      if (ii < W - 4) o = *(const float4*)&cache[((size_t)b * W + ii + 4) * 512 + e];
      else {
        uint2 v = *(const uint2*)&p.proj[((size_t)MP + b * 4 + (ii - (W - 4))) * NP + 2048 + g * 768 + 256 + e];
        o = make_float4(bflo(v.x), bfhi(v.x), bflo(v.y), bfhi(v.y));
      }
      *(float4*)&p.out[off + e0] = o;
    }
  }
}

DI void mem_attn_prompt_wave(const Params& p, int item) {
  const int lane = threadIdx.x & 63, r = lane & 15, kg = lane >> 4;
  const int h = item & 3, qt = item >> 2;
  const int row0 = qt * 16, b = row0 >> 13;
  const int bh = b * 4 + h;
  bf16x8 qf[8];
#pragma unroll
  for (int ks = 0; ks < 8; ++ks) qf[ks] = *(const bf16x8*)&p.qb[(size_t)(row0 + r) * 1024 + h * 256 + ks * 32 + kg * 8];
  f32x4 st[16];
  const u16* kbp = p.Kb + (size_t)bh * 65536;
#pragma unroll
  for (int mt = 0; mt < 16; ++mt) {
    f32x4 a = (f32x4){0.f, 0.f, 0.f, 0.f};
#pragma unroll
    for (int ks = 0; ks < 8; ++ks) {
      bf16x8 kf = *(const bf16x8*)&kbp[(mt * 16 + r) * 256 + ks * 32 + kg * 8];
      a = MFMA(kf, qf[ks], a);
    }
    st[mt] = a;
  }
  float mx = -3.0e38f;
#pragma unroll
  for (int mt = 0; mt < 16; ++mt)
#pragma unroll
    for (int j = 0; j < 4; ++j) { st[mt][j] *= 0.0625f; mx = fmaxf(mx, st[mt][j]); }
  mx = fmaxf(mx, __shfl_xor(mx, 16));
  mx = fmaxf(mx, __shfl_xor(mx, 32));
  float sum = 0.f;
#pragma unroll
  for (int mt = 0; mt < 16; ++mt)
#pragma unroll
    for (int j = 0; j < 4; ++j) { st[mt][j] = __expf(st[mt][j] - mx); sum += st[mt][j]; }
  sum += __shfl_xor(sum, 16);
  sum += __shfl_xor(sum, 32);
  const float inv = 1.f / sum;
  bf16x8 pf[8];
#pragma unroll
  for (int k2 = 0; k2 < 8; ++k2) pf[k2] = pack8(st[2 * k2], st[2 * k2 + 1]);
  const bf16x8* vt = (const bf16x8*)(p.VTf + (size_t)bh * 65536);
#pragma unroll 2
  for (int nt = 0; nt < 16; ++nt) {
    f32x4 o = (f32x4){0.f, 0.f, 0.f, 0.f};
#pragma unroll
    for (int k2 = 0; k2 < 8; ++k2) o = MFMA(vt[(nt * 8 + k2) * 64 + lane], pf[k2], o);
    uint2 ov; ov.x = pack2(o[0] * inv, o[1] * inv); ov.y = pack2(o[2] * inv, o[3] * inv);
    *(uint2*)&p.attn[(size_t)(row0 + r) * 1024 + h * 256 + nt * 16 + kg * 4] = ov;
  }
}

DI void mem_attn_sample_wave(const Params& p, int item, float* lds) {
  const int lane = threadIdx.x & 63;
  const int b = item >> 2, h = item & 3;
  float* sq = lds;
#pragma unroll
  for (int t = 0; t < 4; ++t) {
    uint2 v = *(const uint2*)&p.qb[((size_t)MP + b * 4 + t) * 1024 + h * 256 + lane * 4];
    *(float4*)&sq[t * 256 + lane * 4] = make_float4(bflo(v.x), bfhi(v.x), bflo(v.y), bfhi(v.y));
  }
  __builtin_amdgcn_s_waitcnt(0);
  __builtin_amdgcn_wave_barrier();
  float sc[4][4];
#pragma unroll
  for (int mi = 0; mi < 4; ++mi) {
    const int m = lane + 64 * mi;
    const float* kr = &p.cache_mem[(((size_t)b * 256 + m) * 2 + 0) * 1024 + h * 256];
    float d0 = 0.f, d1 = 0.f, d2 = 0.f, d3 = 0.f;
#pragma unroll 2
    for (int c = 0; c < 256; c += 4) {
      float4 kv = *(const float4*)&kr[c];
      float4 q0 = *(const float4*)&sq[c], q1 = *(const float4*)&sq[256 + c], q2 = *(const float4*)&sq[512 + c], q3 = *(const float4*)&sq[768 + c];
      d0 += kv.x * q0.x + kv.y * q0.y + kv.z * q0.z + kv.w * q0.w;
      d1 += kv.x * q1.x + kv.y * q1.y + kv.z * q1.z + kv.w * q1.w;
      d2 += kv.x * q2.x + kv.y * q2.y + kv.z * q2.z + kv.w * q2.w;
      d3 += kv.x * q3.x + kv.y * q3.y + kv.z * q3.z + kv.w * q3.w;
    }
    sc[0][mi] = d0 * 0.0625f; sc[1][mi] = d1 * 0.0625f; sc[2][mi] = d2 * 0.0625f; sc[3][mi] = d3 * 0.0625f;
  }
  float inv[4];
  __builtin_amdgcn_wave_barrier();
#pragma unroll
  for (int t = 0; t < 4; ++t) {
    float mx = wave_max(fmaxf(fmaxf(sc[t][0], sc[t][1]), fmaxf(sc[t][2], sc[t][3])));
    float sum = 0.f;
#pragma unroll
    for (int mi = 0; mi < 4; ++mi) { sc[t][mi] = __expf(sc[t][mi] - mx); sum += sc[t][mi]; }
    sum = wave_sum(sum);
    inv[t] = 1.f / sum;
#pragma unroll
    for (int mi = 0; mi < 4; ++mi) sq[t * 256 + lane + 64 * mi] = sc[t][mi];
  }
  __builtin_amdgcn_s_waitcnt(0);
  __builtin_amdgcn_wave_barrier();
  float4 o[4];
#pragma unroll
  for (int t = 0; t < 4; ++t) o[t] = make_float4(0.f, 0.f, 0.f, 0.f);
#pragma unroll 4
  for (int m = 0; m < 256; ++m) {
    float4 vv = *(const float4*)&p.cache_mem[(((size_t)b * 256 + m) * 2 + 1) * 1024 + h * 256 + lane * 4];
#pragma unroll
    for (int t = 0; t < 4; ++t) {
      const float pv = sq[t * 256 + m];
      o[t].x += pv * vv.x; o[t].y += pv * vv.y; o[t].z += pv * vv.z; o[t].w += pv * vv.w;
    }
  }
#pragma unroll
  for (int t = 0; t < 4; ++t) {
    uint2 ov; ov.x = pack2(o[t].x * inv[t], o[t].y * inv[t]); ov.y = pack2(o[t].z * inv[t], o[t].w * inv[t]);
    *(uint2*)&p.attn[((size_t)MP + b * 4 + t) * 1024 + h * 256 + lane * 4] = ov;
  }
  __builtin_amdgcn_wave_barrier();
}

DI void phase7(const Params& p, char* smem) {
  const int w = threadIdx.x >> 6;
  const int gw = blockIdx.x * 4 + w, nw = gridDim.x * 4;
  float* lds = (float*)smem + w * 1280;
  for (int it = gw; it < 128 + 8192; it += nw) {
    if (it < 128) mem_attn_sample_wave(p, it, lds);
    else mem_attn_prompt_wave(p, it - 128);
  }
}

DI void peer_topk_wave(const Params& p, int item, unsigned* lds  ) {
  const int lane = threadIdx.x & 63, r = lane & 15, kg = lane >> 4;
  const int h = item & 7, row0 = (item >> 3) * 16;
  unsigned win[2][16];
#pragma unroll
  for (int pp = 0; pp < 2; ++pp) {
    bf16x8 qf[4];
#pragma unroll
    for (int ks = 0; ks < 4; ++ks) qf[ks] = *(const bf16x8*)&p.pq[(size_t)(row0 + r) * 2048 + h * 256 + pp * 128 + ks * 32 + kg * 8];
    unsigned kk[32];
    const u16* sk = p.subkb + (size_t)(h * 2 + pp) * 16384;
#pragma unroll
    for (int mt = 0; mt < 8; ++mt) {
      f32x4 a = (f32x4){0.f, 0.f, 0.f, 0.f};
#pragma unroll
      for (int ks = 0; ks < 4; ++ks) {
        bf16x8 kf = *(const bf16x8*)&sk[(mt * 16 + r) * 128 + ks * 32 + kg * 8];
        a = MFMA(kf, qf[ks], a);
      }
#pragma unroll
      for (int j = 0; j < 4; ++j) kk[mt * 4 + j] = (ordf(a[j]) & ~127u) | (unsigned)(mt * 16 + kg * 4 + j);
    }
#pragma unroll
    for (int rr = 0; rr < 16; ++rr) {
      unsigned m = 0;
#pragma unroll
      for (int i = 0; i < 32; ++i) m = umax(m, kk[i]);
      m = umax(m, (unsigned)__shfl_xor((int)m, 16));
      m = umax(m, (unsigned)__shfl_xor((int)m, 32));
      win[pp][rr] = m;
#pragma unroll
      for (int i = 0; i < 32; ++i) kk[i] = (kk[i] == m) ? 0u : kk[i];
    }
  }
  float f0[16], f1[16];
#pragma unroll
  for (int i = 0; i < 16; ++i) { f0[i] = unordf(win[0][i] & ~127u); f1[i] = unordf(win[1][i] & ~127u); }
  unsigned cand[13];
#define CAND(s, a0, b0, a1, b1, a2, b2, a3, b3)                                                         \
  {                                                                                                     \
    float va = sel4(kg, f0[a0], f0[a1], f0[a2], f0[(a3) < 0 ? 0 : (a3)]);                                \
    float vb = sel4(kg, f1[b0], f1[b1], f1[b2], f1[(b3) < 0 ? 0 : (b3)]);                                \
    unsigned id = sel4(kg, (unsigned)((a0) * 16 + (b0)), (unsigned)((a1) * 16 + (b1)), (unsigned)((a2) * 16 + (b2)), (unsigned)(((a3) < 0 ? 0 : (a3)) * 16 + ((b3) < 0 ? 0 : (b3)))); \
    unsigned key = (ordf(va + vb) & ~255u) | id;                                                        \
    if ((a3) < 0) key = (kg == 3) ? 0u : key;                                                           \
    cand[s] = key;                                                                                      \
  }
  CAND(0, 0, 0, 0, 13, 2, 0, 6, 1)
  CAND(1, 0, 1, 0, 14, 2, 1, 7, 0)
  CAND(2, 0, 2, 0, 15, 2, 2, 7, 1)
  CAND(3, 0, 3, 1, 0, 2, 3, 8, 0)
  CAND(4, 0, 4, 1, 1, 2, 4, 9, 0)
  CAND(5, 0, 5, 1, 2, 3, 0, 10, 0)
  CAND(6, 0, 6, 1, 3, 3, 1, 11, 0)
  CAND(7, 0, 7, 1, 4, 3, 2, 12, 0)
  CAND(8, 0, 8, 1, 5, 3, 3, 13, 0)
  CAND(9, 0, 9, 1, 6, 4, 2, 14, 0)
  CAND(10, 0, 10, 1, 7, 5, 0, 15, 0)
  CAND(11, 0, 11, 4, 0, 5, 1, -1, -1)
  CAND(12, 0, 12, 4, 1, 6, 0, -1, -1)
#undef CAND
  unsigned w2[16];
#pragma unroll
  for (int rr = 0; rr < 16; ++rr) {
    unsigned m = 0;
#pragma unroll
    for (int i = 0; i < 13; ++i) m = umax(m, cand[i]);
    m = umax(m, (unsigned)__shfl_xor((int)m, 16));
    m = umax(m, (unsigned)__shfl_xor((int)m, 32));
    w2[rr] = m;
#pragma unroll
    for (int i = 0; i < 13; ++i) cand[i] = (cand[i] == m) ? 0u : cand[i];
  }
  if (kg == 0) {
#pragma unroll
    for (int i = 0; i < 16; ++i) { lds[r * 32 + i] = win[0][i] & 127u; lds[r * 32 + 16 + i] = win[1][i] & 127u; }
  }
  __builtin_amdgcn_s_waitcnt(0);
  __builtin_amdgcn_wave_barrier();
  const float cv0 = unordf(w2[0] & ~255u);
  float sum = 0.f;
#pragma unroll
  for (int rr = 0; rr < 16; ++rr) sum += __expf(unordf(w2[rr] & ~255u) - cv0);
  const float inv = 1.f / sum;
  const size_t ob = ((size_t)(row0 + r) * 8 + h) * 16;
#pragma unroll
  for (int q = 0; q < 4; ++q) {
    const unsigned wk = sel4(kg, w2[q], w2[4 + q], w2[8 + q], w2[12 + q]);
    const int a = (wk >> 4) & 15, bb = wk & 15;
    const int i1 = (int)lds[r * 32 + a], i2 = (int)lds[r * 32 + 16 + bb];
    p.eid[ob + kg * 4 + q] = i1 * 128 + i2;
    p.gate[ob + kg * 4 + q] = __expf(unordf(wk & ~255u) - cv0) * inv;
  }
  __builtin_amdgcn_wave_barrier();
}

typedef __attribute__((ext_vector_type(2))) float f32x2;
DI float dot16_fp8(uint4 u, const float* x, float c) {
  const unsigned d[4] = {u.x, u.y, u.z, u.w};
#pragma unroll
  for (int i = 0; i < 4; ++i) {
    f32x2 a = __builtin_amdgcn_cvt_pk_f32_fp8((int)d[i], false);
    f32x2 b = __builtin_amdgcn_cvt_pk_f32_fp8((int)d[i], true);
    c += a[0] * x[4 * i] + a[1] * x[4 * i + 1] + b[0] * x[4 * i + 2] + b[1] * x[4 * i + 3];
  }
  return c;
}
DI void axpy16_fp8(float* o, float w, uint4 u) {
  const unsigned d[4] = {u.x, u.y, u.z, u.w};
#pragma unroll
  for (int i = 0; i < 4; ++i) {
    f32x2 a = __builtin_amdgcn_cvt_pk_f32_fp8((int)d[i], false);
    f32x2 b = __builtin_amdgcn_cvt_pk_f32_fp8((int)d[i], true);
    o[4 * i] += w * a[0]; o[4 * i + 1] += w * a[1]; o[4 * i + 2] += w * b[0]; o[4 * i + 3] += w * b[1];
  }
}

DI void peer_expert_wave(const Params& p, int row) {
  const int lane = threadIdx.x & 63;
  float xf[16];
  {
    const uint4 x0 = *(const uint4*)&p.A2[(size_t)row * 1024 + lane * 16];
    const uint4 x1 = *(const uint4*)&p.A2[(size_t)row * 1024 + lane * 16 + 8];
    xf[0] = bflo(x0.x); xf[1] = bfhi(x0.x); xf[2] = bflo(x0.y); xf[3] = bfhi(x0.y);
    xf[4] = bflo(x0.z); xf[5] = bfhi(x0.z); xf[6] = bflo(x0.w); xf[7] = bfhi(x0.w);
    xf[8] = bflo(x1.x); xf[9] = bfhi(x1.x); xf[10] = bflo(x1.y); xf[11] = bfhi(x1.y);
    xf[12] = bflo(x1.z); xf[13] = bfhi(x1.z); xf[14] = bflo(x1.w); xf[15] = bfhi(x1.w);
  }
  const float r2 = rsqrtf(p.ssq2[row] * (1.f / 1024.f) + EPS);
  const unsigned char* EU8 = p.E8;
  const unsigned char* EV8 = p.E8 + (size_t)16384 * 1024;
  float out[16];
#pragma unroll
  for (int i = 0; i < 16; ++i) out[i] = 0.f;
#pragma unroll 1
  for (int bt = 0; bt < 2; ++bt) {
    const int eidv = p.eid[(size_t)row * 128 + bt * 64 + lane];
    const float gv = p.gate[(size_t)row * 128 + bt * 64 + lane];
    const float rsu = p.rs[eidv], rsv = p.rs[16384 + eidv];
    float part[64];
#pragma unroll
    for (int e = 0; e < 64; ++e) {
      const int id = __builtin_amdgcn_readlane(eidv, e);
      const uint4 u = *(const uint4*)(EU8 + (size_t)id * 1024 + lane * 16);
      part[e] = dot16_fp8(u, xf, 0.f);
    }
#pragma unroll
    for (int off = 32; off > 0; off >>= 1) {
      const bool up = (lane & off) != 0;
#pragma unroll
      for (int i = 0; i < off; ++i) {
        const float a = part[i], bq = part[i + off];
        const float send = up ? a : bq, keep = up ? bq : a;
        part[i] = keep + __shfl_xor(send, off);
      }
    }
    const float wv = gv * geluf(part[0] * r2 * rsu) * rsv;
#pragma unroll 8
    for (int e = 0; e < 64; ++e) {
      const int id = __builtin_amdgcn_readlane(eidv, e);
      const float we = __int_as_float(__builtin_amdgcn_readlane(__float_as_int(wv), e));
      const uint4 v = *(const uint4*)(EV8 + (size_t)id * 1024 + lane * 16);
      axpy16_fp8(out, we, v);
    }
  }
  const float* hr = p.h2 + (size_t)row * 1024 + lane * 16;
  float hv[16];
  float ss = 0.f;
#pragma unroll
  for (int i = 0; i < 4; ++i) {
    float4 t = *(const float4*)&hr[i * 4];
    hv[4 * i] = t.x + out[4 * i]; hv[4 * i + 1] = t.y + out[4 * i + 1]; hv[4 * i + 2] = t.z + out[4 * i + 2]; hv[4 * i + 3] = t.w + out[4 * i + 3];
    ss += hv[4 * i] * hv[4 * i] + hv[4 * i + 1] * hv[4 * i + 1] + hv[4 * i + 2] * hv[4 * i + 2] + hv[4 * i + 3] * hv[4 * i + 3];
  }
  ss = wave_sum(ss);
  const float rsn = rsqrtf(ss * (1.f / 1024.f) + EPS);
  float* y = ((row < MP) ? (p.out + O_YP + (size_t)row * 1024) : (p.out + O_YS + (size_t)(row - MP) * 1024)) + lane * 16;
#pragma unroll
  for (int i = 0; i < 4; ++i) {
    float4 g4 = *(const float4*)&p.g_final[lane * 16 + i * 4];
    *(float4*)&y[i * 4] = make_float4(hv[4 * i] * rsn * g4.x, hv[4 * i + 1] * rsn * g4.y, hv[4 * i + 2] * rsn * g4.z, hv[4 * i + 3] * rsn * g4.w);
  }
}

__global__ void __launch_bounds__(256, 2) mega(Params pk) {
  __shared__ __attribute__((aligned(16))) char smem[53248];
  __shared__ Params sp;
  cg::grid_group grid = cg::this_grid();
  const int w = threadIdx.x >> 6;
  if (threadIdx.x == 0) sp = pk;
  __syncthreads();
  const Params& p = sp;
#ifndef DBL
#define DBL -1
#endif
#define REP(ph) for (int rp_ = 0; rp_ < ((DBL == (ph)) ? 2 : 1); ++rp_)
  REP(0) { phase0(p, smem); if (DBL == 0) grid.sync(); }
  grid.sync();
  REP(1) for (int t = blockIdx.x; t < 257 * 34 + 128; t += gridDim.x) {
    if (t < 257 * 34) gemm_tile<0>(p, p.A0, 1024, p.WtIn, 1024, t / 34, t % 34, smem);
    else { int u = t - 257 * 34; gemm_tile<1>(p, p.Amem, 1024, p.WtMkv, 1024, u / 16, u % 16, smem); }
  }
  grid.sync();
  REP(2) { phase2(p, smem); if (DBL == 2) grid.sync(); }
  grid.sync();
  REP(3) { phase3(p, smem); if (DBL == 3) grid.sync(); }
  grid.sync();
  REP(4) phase4(p);
  grid.sync();
  for (int t = blockIdx.x; t < 257 * 8; t += gridDim.x) gemm_tile<2>(p, p.Amix, 768, p.WtOut, 768, t / 8, t % 8, smem);
  grid.sync();
  REP(6) for (int t = blockIdx.x; t < 257 * 8; t += gridDim.x) gemm_tile<3>(p, p.A1, 1024, p.WtMq, 1024, t / 8, t % 8, smem);
  sample_state_copy(p);
  grid.sync();
  REP(7) phase7(p, smem);
  grid.sync();
  for (int t = blockIdx.x; t < 257 * 8; t += gridDim.x) gemm_tile<4>(p, p.attn, 1024, p.WtMo, 1024, t / 8, t % 8, smem);
  grid.sync();
  REP(9) for (int t = blockIdx.x; t < 257 * 16; t += gridDim.x) gemm_tile<5>(p, p.A2, 1024, p.WtPq, 1024, t / 16, t % 16, smem);
  grid.sync();
  REP(10) {
    unsigned* lds = (unsigned*)smem + w * 512;
    for (int it = blockIdx.x * 4 + w; it < 2056 * 8; it += gridDim.x * 4) peer_topk_wave(p, it, lds);
  }
  grid.sync();
  REP(11) for (int row = blockIdx.x * 4 + w; row < MT; row += gridDim.x * 4) peer_expert_wave(p, row);
}

extern "C" void kernel_launch(void* const* d_in, const int* in_sizes, int n_in, void* d_out, int out_size, void* d_ws, size_t ws_size,
                              hipStream_t stream) {
  static int grid_blocks = 0;
  if (!grid_blocks) {
    int dev = 0, cus = 0, per_cu = 0;
    (void)hipGetDevice(&dev);
    (void)hipDeviceGetAttribute(&cus, hipDeviceAttributeMultiprocessorCount, dev);
    (void)hipOccupancyMaxActiveBlocksPerMultiprocessor(&per_cu, mega, 256, 0);
    if (per_cu > 2) per_cu = 2;
    if (per_cu < 1) per_cu = 1;
    grid_blocks = cus * per_cu;
  }
  Params p{};
  const float* const* in = (const float* const*)d_in;
  p.x_prompt = in[0]; p.x_sample = in[1]; p.state_delta = in[2]; p.state_conv = in[3]; p.cw1 = in[4]; p.cw2 = in[5]; p.cw3 = in[6];
  p.cache_mem = in[7]; p.mem_prompt = in[8]; p.g_mix = in[9]; p.w_in = in[10]; p.conv_w = in[11]; p.a_log = in[12]; p.dt_bias = in[13];
  p.g_onorm = in[14]; p.w_out = in[15]; p.g_memq = in[16]; p.g_memkv = in[17]; p.w_mq = in[18]; p.w_mkv = in[19]; p.w_mo = in[20];
  p.g_ffn = in[21]; p.w_pq = in[22]; p.sub_keys = in[23]; p.expert_u = in[24]; p.expert_v = in[25]; p.g_final = in[26];
  p.out = (float*)d_out;
  char* ws = (char*)d_ws;
  size_t off = 0;
  auto take = [&](size_t bytes) { char* r = ws + off; off += (bytes + 255) & ~(size_t)255; return r; };
  p.WtIn = (u16*)take((size_t)NP * 1024 * 2);
  p.WtOut = (u16*)take((size_t)1024 * 768 * 2);
  p.WtMq = (u16*)take((size_t)1024 * 1024 * 2);
  p.WtMkv = (u16*)take((size_t)2048 * 1024 * 2);
  p.WtMo = (u16*)take((size_t)1024 * 1024 * 2);
  p.WtPq = (u16*)take((size_t)2048 * 1024 * 2);
  p.subkb = (u16*)take((size_t)262144 * 2);
  p.E8 = (unsigned char*)take((size_t)32768 * 1024);
  p.rs = (float*)take((size_t)32768 * 4);
  p.Amem = (u16*)take((size_t)1024 * 1024 * 2);
  p.gb = (float*)take((size_t)MT * 8 * 4);
  p.ssq1 = (float*)take((size_t)MT * 4);
  p.ssq2 = (float*)take((size_t)MT * 4);
  p.dl = (float*)take(2048 * 4);
  p.Kb = (u16*)take((size_t)16 * 65536 * 2);
  p.VTf = (u16*)take((size_t)16 * 65536 * 2);
  char* regA = take((size_t)MT * NP * 2);
  char* regB = take((size_t)2048 * DN_ITEM);
  p.proj = (u16*)regA;
  p.h1 = (float*)regA;
  p.h2 = (float*)(regA + (size_t)MT * 1024 * 4);
  p.pq = (u16*)regA;
  p.dnops = regB;
  p.A0 = (u16*)regB;
  p.A1 = (u16*)regB;
  p.qb = (u16*)(regB + (size_t)MT * 1024 * 2);
  p.attn = (u16*)regB;
  p.A2 = (u16*)(regB + (size_t)MT * 1024 * 2);
  p.eid = (int*)regB;
  p.gate = (float*)(regB + (size_t)MT * 128 * 4);
  char* ob = (char*)d_out;
  p.vT = (u16*)ob;
  p.osw = (u16*)(ob + (size_t)3 * MP * 256 * 2);
  p.lse = (float*)(ob + (size_t)3 * MP * 256 * 2 + (size_t)3 * MT * 256 * 2);
  char* sb = ob + O_SW3 * 4;
  p.odn = (u16*)sb;
  p.Amix = (u16*)(sb + (size_t)MT * 512 * 2);
  if (off > ws_size) { fprintf(stderr, "workspace too small: need %zu have %zu\n", off, ws_size); return; }
  void* args[] = {&p};
  hipError_t e = hipLaunchCooperativeKernel((void*)mega, dim3(grid_blocks), dim3(256), args, 0, stream);
  if (e != hipSuccess) fprintf(stderr, "coop launch failed: %s (grid %d)\n", hipGetErrorString(e), grid_blocks);
}
```

```cpp
#include <hip/hip_runtime.h>
#include <hip/hip_cooperative_groups.h>
#include <cstdio>
namespace cg = cooperative_groups;

typedef unsigned short u16;
typedef __attribute__((ext_vector_type(8))) short bf16x8;
typedef __attribute__((ext_vector_type(4))) float f32x4;
typedef __attribute__((ext_vector_type(2))) __bf16 bf2_t;

#define DI __device__ __forceinline__
#define MFMA(a, b, c) __builtin_amdgcn_mfma_f32_16x16x32_bf16((a), (b), (c), 0, 0, 0)

constexpr int MP = 32768, MS = 128, MT = 32896;
constexpr int NP = 4352;
constexpr int SEQ = 8192;
constexpr float EPS = 1e-6f;
constexpr size_t DN_ITEM = 73728;

constexpr size_t O_YP = 0, O_YS = 33554432, O_PDELTA = 33685504, O_PCONV = 33947648, O_PW1 = 33966080,
                 O_PW2 = 34228224, O_PW3 = 35276800, O_PMEM = 39471104, O_SDELTA = 41568256, O_SCONV = 43665408,
                 O_SW1 = 43812864, O_SW2 = 45910016, O_SW3 = 54298624;

struct Params {
  const float *x_prompt, *x_sample, *state_delta, *state_conv, *cw1, *cw2, *cw3, *cache_mem, *mem_prompt;
  const float *g_mix, *w_in, *conv_w, *a_log, *dt_bias, *g_onorm, *w_out, *g_memq, *g_memkv, *w_mq, *w_mkv, *w_mo;
  const float *g_ffn, *w_pq, *sub_keys, *expert_u, *expert_v, *g_final;
  float* out;
  u16 *WtIn, *WtOut, *WtMq, *WtMkv, *WtMo, *WtPq, *subkb, *Amem;
  unsigned char* E8;
  float* rs;
  float *gb, *ssq1, *ssq2, *dl;
  u16 *Kb, *VTf;
  u16* proj;
  float *h1, *h2;
  u16* pq;
  char* dnops;
  u16 *A0, *A1, *qb, *attn, *A2;
  int* eid;
  float* gate;
  u16 *vT, *osw, *odn, *Amix;
  float* lse;
};

DI u16 f2bf(float x) { unsigned u = __float_as_uint(x); u += 0x7fffu + ((u >> 16) & 1u); return (u16)(u >> 16); }
DI float bf2f(u16 h) { return __uint_as_float(((unsigned)h) << 16); }
DI unsigned pack2(float a, float b) { return (unsigned)f2bf(a) | ((unsigned)f2bf(b) << 16); }
DI float bflo(unsigned d) { return __uint_as_float(d << 16); }
DI float bfhi(unsigned d) { return __uint_as_float(d & 0xffff0000u); }
DI bf16x8 pack8(f32x4 a, f32x4 b) {
  uint4 r; r.x = pack2(a[0], a[1]); r.y = pack2(a[2], a[3]); r.z = pack2(b[0], b[1]); r.w = pack2(b[2], b[3]);
  return __builtin_bit_cast(bf16x8, r);
}
DI float wave_sum(float v) {
#pragma unroll
  for (int o = 32; o > 0; o >>= 1) v += __shfl_xor(v, o);
  return v;
}
DI float wave_max(float v) {
#pragma unroll
  for (int o = 32; o > 0; o >>= 1) v = fmaxf(v, __shfl_xor(v, o));
  return v;
}
DI float siluf(float x) { return x / (1.f + __expf(-x)); }
DI float geluf(float x) { return 0.5f * x * (1.f + tanhf(0.7978845608028654f * (x + 0.044715f * x * x * x))); }
DI int permk(int kg, int j) { return (j < 4) ? (kg * 4 + j) : (16 + kg * 4 + (j - 4)); }
DI void cvt8(const float* __restrict__ s, u16* __restrict__ d) {
  float4 a = *(const float4*)s, b = *(const float4*)(s + 4);
  uint4 r; r.x = pack2(a.x, a.y); r.y = pack2(a.z, a.w); r.z = pack2(b.x, b.y); r.w = pack2(b.z, b.w);
  *(uint4*)d = r;
}
DI unsigned ordf(float f) { unsigned u = __float_as_uint(f); return (u & 0x80000000u) ? ~u : (u | 0x80000000u); }
DI float unordf(unsigned k) { unsigned u = (k & 0x80000000u) ? (k & 0x7fffffffu) : ~k; return __uint_as_float(u); }
DI unsigned umax(unsigned a, unsigned b) { return a > b ? a : b; }
template <typename T> DI T sel4(int L, T a, T b, T c, T d) { return L == 0 ? a : (L == 1 ? b : (L == 2 ? c : d)); }

template <int MODE>
DI void gemm_tile(const Params& p, const u16* __restrict__ A, int lda, const u16* __restrict__ Bt, int K, int tm, int tn,
                          char* smem) {
  u16* sA = (u16*)smem;
  u16* sB = sA + 128 * 72;
  const int tid = threadIdx.x, lane = tid & 63, w = tid >> 6;
  const int wm = w >> 1, wn = w & 1, r = lane & 15, kg = lane >> 4;
  f32x4 acc[4][4];
#pragma unroll
  for (int i = 0; i < 4; ++i)
#pragma unroll
    for (int j = 0; j < 4; ++j) acc[i][j] = (f32x4){0.f, 0.f, 0.f, 0.f};
  const int lrow = tid >> 3, lcol = (tid & 7) * 8;
  const u16* gA = A + (size_t)(tm * 128 + lrow) * lda + lcol;
  const u16* gB = Bt + (size_t)(tn * 128 + lrow) * K + lcol;
  const size_t sAi = (size_t)32 * lda, sBi = (size_t)32 * K;
  bf16x8 ra[2][4], rb[2][4];
#pragma unroll
  for (int st = 0; st < 2; ++st)
#pragma unroll
    for (int i = 0; i < 4; ++i) { ra[st][i] = *(const bf16x8*)(gA + st * 64 + i * sAi); rb[st][i] = *(const bf16x8*)(gB + st * 64 + i * sBi); }
  for (int k0 = 0; k0 < K; k0 += 128) {
#pragma unroll
    for (int st = 0; st < 2; ++st) {
      __syncthreads();
#pragma unroll
      for (int i = 0; i < 4; ++i) {
        *(bf16x8*)&sA[(lrow + i * 32) * 72 + lcol] = ra[st][i];
        *(bf16x8*)&sB[(lrow + i * 32) * 72 + lcol] = rb[st][i];
      }
      __syncthreads();
      if (k0 + st * 64 + 128 < K) {
#pragma unroll
        for (int i = 0; i < 4; ++i) {
          ra[st][i] = *(const bf16x8*)(gA + k0 + st * 64 + 128 + i * sAi);
          rb[st][i] = *(const bf16x8*)(gB + k0 + st * 64 + 128 + i * sBi);
        }
      }
#pragma unroll
      for (int ks = 0; ks < 2; ++ks) {
        bf16x8 af[4], bfr[4];
#pragma unroll
        for (int i = 0; i < 4; ++i) {
          af[i] = *(const bf16x8*)&sA[(wm * 64 + i * 16 + r) * 72 + ks * 32 + kg * 8];
          bfr[i] = *(const bf16x8*)&sB[(wn * 64 + i * 16 + r) * 72 + ks * 32 + kg * 8];
        }
#pragma unroll
        for (int mt = 0; mt < 4; ++mt)
#pragma unroll
          for (int nt = 0; nt < 4; ++nt) acc[mt][nt] = MFMA(bfr[nt], af[mt], acc[mt][nt]);
      }
    }
  }
#pragma unroll
  for (int mt = 0; mt < 4; ++mt) {
    const int row = tm * 128 + wm * 64 + mt * 16 + r;
    float rs = 1.f, ssq = 0.f;
    if (MODE == 3) rs = rsqrtf(p.ssq1[row] * (1.f / 1024.f) + EPS);
    if (MODE == 5) rs = rsqrtf(p.ssq2[row] * (1.f / 1024.f) + EPS);
#pragma unroll
    for (int nt = 0; nt < 4; ++nt) {
      const int col = tn * 128 + wn * 64 + nt * 16 + kg * 4;
      f32x4 v = acc[mt][nt];
      if (MODE == 0) {
        uint2 o; o.x = pack2(v[0], v[1]); o.y = pack2(v[2], v[3]);
        *(uint2*)&p.proj[(size_t)row * NP + col] = o;
      } else if (MODE == 1) {
        *(float4*)&p.out[O_PMEM + (size_t)row * 2048 + col] = make_float4(v[0], v[1], v[2], v[3]);
      } else if (MODE == 2 || MODE == 4) {
        float4 rsd;
        const float* gn;
        if (MODE == 2) {
          rsd = (row < MP) ? *(const float4*)&p.x_prompt[(size_t)row * 1024 + col] : *(const float4*)&p.x_sample[(size_t)(row - MP) * 1024 + col];
          gn = p.g_memq;
        } else {
          rsd = *(const float4*)&p.h1[(size_t)row * 1024 + col];
          gn = p.g_ffn;
        }
        float4 h = make_float4(rsd.x + v[0], rsd.y + v[1], rsd.z + v[2], rsd.w + v[3]);
        float4 g4 = *(const float4*)&gn[col];
        ssq += h.x * h.x + h.y * h.y + h.z * h.z + h.w * h.w;
        uint2 o; o.x = pack2(h.x * g4.x, h.y * g4.y); o.y = pack2(h.z * g4.z, h.w * g4.w);
        if (MODE == 2) { *(float4*)&p.h1[(size_t)row * 1024 + col] = h; *(uint2*)&p.A1[(size_t)row * 1024 + col] = o; }
        else { *(float4*)&p.h2[(size_t)row * 1024 + col] = h; *(uint2*)&p.A2[(size_t)row * 1024 + col] = o; }
      } else if (MODE == 3) {
        uint2 o; o.x = pack2(v[0] * rs, v[1] * rs); o.y = pack2(v[2] * rs, v[3] * rs);
        *(uint2*)&p.qb[(size_t)row * 1024 + col] = o;
      } else {
        uint2 o; o.x = pack2(v[0] * rs, v[1] * rs); o.y = pack2(v[2] * rs, v[3] * rs);
        *(uint2*)&p.pq[(size_t)row * 2048 + col] = o;
      }
    }
    if (MODE == 2 || MODE == 4) {
      ssq += __shfl_xor(ssq, 16);
      ssq += __shfl_xor(ssq, 32);
      if (kg == 0) atomicAdd((MODE == 2) ? &p.ssq1[row] : &p.ssq2[row], ssq);
    }
  }
}

DI void tr_tile(const float* __restrict__ W, int ldw, int nsrc0, u16* __restrict__ Wt, int K, int k0, int n0, float* tile) {
  const int tid = threadIdx.x;
  const int n = tid & 63, kq = tid >> 6;
  __syncthreads();
#pragma unroll
  for (int i = 0; i < 16; ++i) { int kk = kq + 4 * i; tile[kk * 65 + n] = W[(size_t)(k0 + kk) * ldw + nsrc0 + n]; }
  __syncthreads();
  const int nn = tid >> 2, ks = (tid & 3) * 16;
  unsigned o[8];
#pragma unroll
  for (int i = 0; i < 8; ++i) o[i] = pack2(tile[(ks + 2 * i) * 65 + nn], tile[(ks + 2 * i + 1) * 65 + nn]);
  u16* d = Wt + (size_t)(n0 + nn) * K + k0 + ks;
  *(uint4*)d = make_uint4(o[0], o[1], o[2], o[3]);
  *(uint4*)(d + 8) = make_uint4(o[4], o[5], o[6], o[7]);
}

DI void phase0(const Params& p, char* smem) {
  const int tid = threadIdx.x, lane = tid & 63, w = tid >> 6;
  const size_t gtid = (size_t)blockIdx.x * 256 + tid, gsz = (size_t)gridDim.x * 256;
  {
    const float* eu = p.expert_u;
    const float* ev = p.expert_v;
    unsigned char* e8 = p.E8;
    float* rsp = p.rs;
    for (int er = blockIdx.x * 4 + w; er < 32768; er += gridDim.x * 4) {
      const float* src = (er < 16384) ? (eu + (size_t)er * 1024) : (ev + (size_t)(er - 16384) * 1024);
      float4 v[4];
      float am = 0.f;
#pragma unroll
      for (int i = 0; i < 4; ++i) {
        v[i] = *(const float4*)&src[lane * 16 + i * 4];
        am = fmaxf(am, fmaxf(fmaxf(fabsf(v[i].x), fabsf(v[i].y)), fmaxf(fabsf(v[i].z), fabsf(v[i].w))));
      }
      am = wave_max(am);
      const float sc = (am > 0.f) ? 224.f / am : 1.f;
      int o[4];
#pragma unroll
      for (int i = 0; i < 4; ++i) {
        int t = __builtin_amdgcn_cvt_pk_fp8_f32(v[i].x * sc, v[i].y * sc, 0, false);
        o[i] = __builtin_amdgcn_cvt_pk_fp8_f32(v[i].z * sc, v[i].w * sc, t, true);
      }
      *(uint4*)&e8[(size_t)er * 1024 + lane * 16] = make_uint4((unsigned)o[0], (unsigned)o[1], (unsigned)o[2], (unsigned)o[3]);
      if (lane == 0) rsp[er] = (am > 0.f) ? am * (1.f / 224.f) : 1.f;
    }
  }
  for (size_t i = gtid; i < 262144 / 8; i += gsz) cvt8(p.sub_keys + i * 8, p.subkb + i * 8);
  for (size_t i = gtid; i < MT; i += gsz) { p.ssq1[i] = 0.f; p.ssq2[i] = 0.f; }
  float* wl = (float*)smem;
  __syncthreads();
  for (int i = tid; i < 2048; i += 256) {
    const int k = i >> 1, hf = i & 1;
    float4 t = *(const float4*)&p.w_in[(size_t)k * 4360 + 1536 + hf * 4];
    wl[(hf * 4 + 0) * 1024 + k] = t.x; wl[(hf * 4 + 1) * 1024 + k] = t.y; wl[(hf * 4 + 2) * 1024 + k] = t.z; wl[(hf * 4 + 3) * 1024 + k] = t.w;
  }
  __syncthreads();
  const float* xpp = p.x_prompt;
  const float* xsp = p.x_sample;
  const float* mpp = p.mem_prompt;
  const float* gmx = p.g_mix;
  const float* gmk = p.g_memkv;
  u16* a0p = p.A0;
  u16* amp = p.Amem;
  for (int row = blockIdx.x * 4 + w; row < MT + 1024; row += gridDim.x * 4) {
    const float* src; const float* g; u16* dst;
    if (row < MP) { src = xpp + (size_t)row * 1024; g = gmx; dst = a0p + (size_t)row * 1024; }
    else if (row < MT) { src = xsp + (size_t)(row - MP) * 1024; g = gmx; dst = a0p + (size_t)row * 1024; }
    else { src = mpp + (size_t)(row - MT) * 1024; g = gmk; dst = amp + (size_t)(row - MT) * 1024; }
    float4 v[4];
    float ss = 0.f;
#pragma unroll
    for (int i = 0; i < 4; ++i) { v[i] = *(const float4*)&src[lane * 4 + i * 256]; ss += v[i].x * v[i].x + v[i].y * v[i].y + v[i].z * v[i].z + v[i].w * v[i].w; }
    ss = wave_sum(ss);
    const float rs = rsqrtf(ss * (1.f / 1024.f) + EPS);
    float d8[8] = {0.f, 0.f, 0.f, 0.f, 0.f, 0.f, 0.f, 0.f};
#pragma unroll
    for (int i = 0; i < 4; ++i) {
      float4 g4 = *(const float4*)&g[lane * 4 + i * 256];
      float y[4] = {v[i].x * rs * g4.x, v[i].y * rs * g4.y, v[i].z * rs * g4.z, v[i].w * rs * g4.w};
      uint2 o; o.x = pack2(y[0], y[1]); o.y = pack2(y[2], y[3]);
      *(uint2*)&dst[lane * 4 + i * 256] = o;
      if (row < MT) {
#pragma unroll
        for (int j = 0; j < 8; ++j) {
          float4 wv = *(const float4*)&wl[j * 1024 + i * 256 + lane * 4];
          d8[j] += y[0] * wv.x + y[1] * wv.y + y[2] * wv.z + y[3] * wv.w;
        }
      }
    }
    if (row < MT) {
#pragma unroll
      for (int j = 0; j < 8; ++j) d8[j] = wave_sum(d8[j]);
      if (lane < 4) {
        float ag = sel4(lane, d8[0], d8[1], d8[2], d8[3]);
        float bg = sel4(lane, d8[4], d8[5], d8[6], d8[7]);
        float xs = ag + p.dt_bias[lane];
        float sp = (xs > 20.f) ? xs : log1pf(expf(xs));
        p.gb[(size_t)row * 8 + lane] = -expf(p.a_log[lane]) * sp;
        p.gb[(size_t)row * 8 + 4 + lane] = 1.f / (1.f + expf(-bg));
      }
    }
  }
  __syncthreads();
  float* tile = (float*)smem;
  for (int j = blockIdx.x; j < 2816; j += gridDim.x) {
    int t = j;
    if (t < 1088) { int kt = t / 68, nt = t % 68; int n0 = nt * 64; tr_tile(p.w_in, 4360, n0 + (n0 >= 1536 ? 8 : 0), p.WtIn, 1024, kt * 64, n0, tile); continue; }
    t -= 1088;
    if (t < 192) { int kt = t / 16, nt = t % 16; tr_tile(p.w_out, 1024, nt * 64, p.WtOut, 768, kt * 64, nt * 64, tile); continue; }
    t -= 192;
    if (t < 256) { int kt = t / 16, nt = t % 16; tr_tile(p.w_mq, 1024, nt * 64, p.WtMq, 1024, kt * 64, nt * 64, tile); continue; }
    t -= 256;
    if (t < 512) { int kt = t / 32, nt = t % 32; tr_tile(p.w_mkv, 2048, nt * 64, p.WtMkv, 1024, kt * 64, nt * 64, tile); continue; }
    t -= 512;
    if (t < 256) { int kt = t / 16, nt = t % 16; tr_tile(p.w_mo, 1024, nt * 64, p.WtMo, 1024, kt * 64, nt * 64, tile); continue; }
    t -= 256;
    { int kt = t / 32, nt = t % 32; tr_tile(p.w_pq, 2048, nt * 64, p.WtPq, 1024, kt * 64, nt * 64, tile); }
  }
}

DI void dn_prep(const Params& p, int item, char* smem) {
  u16* qs = (u16*)smem;
  u16* ksm = qs + 64 * 136;
  float* sL = (float*)(ksm + 64 * 136);
  float* sgc = sL + 64 * 64;
  float* sbeta = sgc + 64;
  u16* sU = (u16*)sL;
  u16* sW = qs;
  const int tid = threadIdx.x, lane = tid & 63, w = tid >> 6, r = lane & 15, kg = lane >> 4;
  const int bh = item >> 7, n = item & 127, b = bh >> 2, h = bh & 3;
  const int t0 = n * 64;
  const size_t rowbase = (size_t)b * SEQ;
  char* ops = p.dnops + (size_t)item * DN_ITEM;
  __syncthreads();
  if (tid < 64) {
    float gv = p.gb[(rowbase + t0 + tid) * 8 + h];
    float bv = p.gb[(rowbase + t0 + tid) * 8 + 4 + h];
#pragma unroll
    for (int o = 1; o < 64; o <<= 1) { float t = __shfl_up(gv, o); if (lane >= o) gv += t; }
    sgc[tid] = gv; sbeta[tid] = bv;
    if (tid == 63) p.dl[item] = __expf(gv);
  }
#pragma unroll 4
  for (int ps = 0; ps < 8; ++ps) {
    const int combo = ps * 16 + (tid >> 4);
    const int tt = combo & 63, part = combo >> 6, sub = tid & 15;
    const int col = part * 512 + h * 128 + sub * 8;
    float y[8] = {0.f, 0.f, 0.f, 0.f, 0.f, 0.f, 0.f, 0.f};
#pragma unroll
    for (int j = 0; j < 4; ++j) {
      const int t = t0 + tt - 3 + j;
      if (t >= 0) {
        uint4 xv = *(const uint4*)&p.proj[(rowbase + t) * NP + col];
        float4 wa = *(const float4*)&p.conv_w[j * 1536 + col], wb = *(const float4*)&p.conv_w[j * 1536 + col + 4];
        y[0] += bflo(xv.x) * wa.x; y[1] += bfhi(xv.x) * wa.y; y[2] += bflo(xv.y) * wa.z; y[3] += bfhi(xv.y) * wa.w;
        y[4] += bflo(xv.z) * wb.x; y[5] += bfhi(xv.z) * wb.y; y[6] += bflo(xv.w) * wb.z; y[7] += bfhi(xv.w) * wb.w;
      }
    }
    float ss = 0.f;
#pragma unroll
    for (int e = 0; e < 8; ++e) { y[e] = siluf(y[e]); ss += y[e] * y[e]; }
    ss += __shfl_xor(ss, 1); ss += __shfl_xor(ss, 2); ss += __shfl_xor(ss, 4); ss += __shfl_xor(ss, 8);
    float sc = rsqrtf(ss + EPS) * (part == 0 ? 0.08838834764831845f : 1.f);
    uint4 o; o.x = pack2(y[0] * sc, y[1] * sc); o.y = pack2(y[2] * sc, y[3] * sc); o.z = pack2(y[4] * sc, y[5] * sc); o.w = pack2(y[6] * sc, y[7] * sc);
    *(uint4*)&((part == 0 ? qs : ksm)[tt * 136 + sub * 8]) = o;
  }
  __syncthreads();
  const float gcl = sgc[63];
  {
    f32x4 aL[4], aA[4];
#pragma unroll
    for (int i = 0; i < 4; ++i) { aL[i] = (f32x4){0.f, 0.f, 0.f, 0.f}; aA[i] = (f32x4){0.f, 0.f, 0.f, 0.f}; }
#pragma unroll
    for (int ks = 0; ks < 4; ++ks) {
      bf16x8 kI = *(const bf16x8*)&ksm[(w * 16 + r) * 136 + ks * 32 + kg * 8];
      bf16x8 qI = *(const bf16x8*)&qs[(w * 16 + r) * 136 + ks * 32 + kg * 8];
#pragma unroll
      for (int nt = 0; nt < 4; ++nt) {
        bf16x8 kJ = *(const bf16x8*)&ksm[(nt * 16 + r) * 136 + ks * 32 + kg * 8];
        aL[nt] = MFMA(kJ, kI, aL[nt]);
        aA[nt] = MFMA(kJ, qI, aA[nt]);
      }
    }
    const int i = w * 16 + r;
    const float gci = sgc[i], bi = sbeta[i];
    u16* aq = (u16*)(ops + 49152);
#pragma unroll
    for (int nt = 0; nt < 4; ++nt) {
      float lv[4], av[4];
#pragma unroll
      for (int jj = 0; jj < 4; ++jj) {
        const int j = nt * 16 + kg * 4 + jj;
        const float gam = (i >= j) ? __expf(gci - sgc[j]) : 0.f;
        lv[jj] = (i > j) ? aL[nt][jj] * bi * gam : 0.f;
        av[jj] = aA[nt][jj] * gam;
      }
      *(float4*)&sL[i * 64 + nt * 16 + kg * 4] = make_float4(lv[0], lv[1], lv[2], lv[3]);
      uint2 o; o.x = pack2(av[0], av[1]); o.y = pack2(av[2], av[3]);
      *(uint2*)&aq[((w * 2 + (nt >> 1)) * 64 + lane) * 8 + (nt & 1) * 4] = o;
    }
  }
  {
    u16* qg = (u16*)(ops + 16384);
    u16* kdT = (u16*)(ops + 32768);
#pragma unroll 1
    for (int i = 0; i < 4; ++i) {
      const int f = tid + 256 * i;
      const int mtks = f >> 6, l = f & 63, rr = l & 15, kgg = l >> 4;
      {
        const int mt = mtks >> 2, ks = mtks & 3, row = mt * 16 + rr;
        const float e = __expf(sgc[row]);
        uint2 a = *(const uint2*)&qs[row * 136 + ks * 32 + kgg * 4];
        uint2 c = *(const uint2*)&qs[row * 136 + ks * 32 + 16 + kgg * 4];
        uint4 o;
        o.x = pack2(bflo(a.x) * e, bfhi(a.x) * e); o.y = pack2(bflo(a.y) * e, bfhi(a.y) * e);
        o.z = pack2(bflo(c.x) * e, bfhi(c.x) * e); o.w = pack2(bflo(c.y) * e, bfhi(c.y) * e);
        *(uint4*)&qg[(size_t)f * 8] = o;
      }
      {
        const int mt = mtks >> 1, ks = mtks & 1, kdim = mt * 16 + rr;
        float v[8];
#pragma unroll
        for (int j = 0; j < 8; ++j) {
          const int c = ks * 32 + permk(kgg, j);
          v[j] = bf2f(ksm[c * 136 + kdim]) * __expf(gcl - sgc[c]);
        }
        uint4 o; o.x = pack2(v[0], v[1]); o.y = pack2(v[2], v[3]); o.z = pack2(v[4], v[5]); o.w = pack2(v[6], v[7]);
        *(uint4*)&kdT[(size_t)f * 8] = o;
      }
    }
  }
  __syncthreads();
  float x[64];
  if (tid < 128) {
    const int col = 1024 + h * 128 + tid;
    const float w0 = p.conv_w[col], w1 = p.conv_w[1536 + col], w2 = p.conv_w[3072 + col], w3 = p.conv_w[4608 + col];
    float xm3 = 0.f, xm2 = 0.f, xm1 = 0.f;
    if (t0 > 0) {
      xm3 = bf2f(p.proj[(rowbase + t0 - 3) * NP + col]);
      xm2 = bf2f(p.proj[(rowbase + t0 - 2) * NP + col]);
      xm1 = bf2f(p.proj[(rowbase + t0 - 1) * NP + col]);
    }
#pragma unroll
    for (int t = 0; t < 64; ++t) {
      float xc = bf2f(p.proj[(rowbase + t0 + t) * NP + col]);
      float yv = w0 * xm3 + w1 * xm2 + w2 * xm1 + w3 * xc;
      x[t] = siluf(yv) * sbeta[t];
      xm3 = xm2; xm2 = xm1; xm1 = xc;
    }
  } else {
    const int kc = tid - 128;
#pragma unroll
    for (int t = 0; t < 64; ++t) x[t] = bf2f(ksm[t * 136 + kc]) * sbeta[t] * __expf(sgc[t]);
  }
#pragma unroll
  for (int i = 1; i < 64; ++i) {
    float s = x[i];
#pragma unroll
    for (int j4 = 0; j4 < (i + 3) / 4; ++j4) {
      float4 l = *(const float4*)&sL[i * 64 + j4 * 4];
      s -= l.x * x[j4 * 4];
      if (j4 * 4 + 1 < i) s -= l.y * x[j4 * 4 + 1];
      if (j4 * 4 + 2 < i) s -= l.z * x[j4 * 4 + 2];
      if (j4 * 4 + 3 < i) s -= l.w * x[j4 * 4 + 3];
    }
    x[i] = s;
  }
  __syncthreads();
  if (tid < 128) {
#pragma unroll
    for (int t = 0; t < 64; ++t) sU[t * 128 + tid] = f2bf(x[t]);
  } else {
    const int kc = tid - 128;
#pragma unroll
    for (int t = 0; t < 64; ++t) sW[t * 136 + kc] = f2bf(-x[t]);
  }
  __syncthreads();
  {
    u16* nW = (u16*)ops;
    u16* u0 = (u16*)(ops + 57344);
#pragma unroll 1
    for (int i = 0; i < 4; ++i) {
      const int f = tid + 256 * i;
      const int mtks = f >> 6, l = f & 63, rr = l & 15, kgg = l >> 4;
      const int mt = mtks >> 2, ks = mtks & 3, row = mt * 16 + rr;
      uint2 a = *(const uint2*)&sW[row * 136 + ks * 32 + kgg * 4];
      uint2 c = *(const uint2*)&sW[row * 136 + ks * 32 + 16 + kgg * 4];
      *(uint4*)&nW[(size_t)f * 8] = make_uint4(a.x, a.y, c.x, c.y);
    }
#pragma unroll 1
    for (int i = 0; i < 8; ++i) {
      const int f = tid + 256 * i;
      const int smt = f >> 6, l = f & 63, rr = l & 15, kgg = l >> 4;
      const int s = smt >> 2, mt = smt & 3;
      u16 v0 = sU[(mt * 16 + kgg * 4 + 0) * 128 + s * 16 + rr];
      u16 v1 = sU[(mt * 16 + kgg * 4 + 1) * 128 + s * 16 + rr];
      u16 v2 = sU[(mt * 16 + kgg * 4 + 2) * 128 + s * 16 + rr];
      u16 v3 = sU[(mt * 16 + kgg * 4 + 3) * 128 + s * 16 + rr];
      *(uint2*)&u0[(size_t)f * 4] = make_uint2((unsigned)v0 | ((unsigned)v1 << 16), (unsigned)v2 | ((unsigned)v3 << 16));
    }
  }
}

DI void vt_tile(const Params& p, int item, char* smem) {
  u16* tile = (u16*)smem;
  const int tid = threadIdx.x;
  const int ptile = item & 127, gbh = item >> 7;
  const int h = gbh & 3, b = (gbh >> 2) & 3, g = gbh >> 4;
  const int dsh = g * 2, ln = SEQ >> dsh;
  const int pos0 = ptile * 64;
  const int rres = pos0 / ln, i0 = pos0 % ln;
  __syncthreads();
  {
    const int pr = tid >> 2, seg = (tid & 3) * 16;
    const int token = ((i0 + pr) << dsh) + rres;
    const u16* src = &p.proj[((size_t)b * SEQ + token) * NP + 2048 + g * 768 + 512 + h * 64 + seg];
    uint4 a = *(const uint4*)src, c = *(const uint4*)(src + 8);
    unsigned d[8] = {a.x, a.y, a.z, a.w, c.x, c.y, c.z, c.w};
#pragma unroll
    for (int e = 0; e < 8; ++e) *(unsigned*)&tile[pr * 66 + seg + e * 2] = d[e];
  }
  __syncthreads();
  {
    const int dh = tid >> 2, seg = (tid & 3) * 16;
    unsigned o[8];
#pragma unroll
    for (int e = 0; e < 8; ++e) o[e] = (unsigned)tile[(seg + 2 * e) * 66 + dh] | ((unsigned)tile[(seg + 2 * e + 1) * 66 + dh] << 16);
    u16* d = &p.vT[((size_t)gbh * 64 + dh) * SEQ + pos0 + seg];
    *(uint4*)d = make_uint4(o[0], o[1], o[2], o[3]);
    *(uint4*)(d + 8) = make_uint4(o[4], o[5], o[6], o[7]);
  }
}

DI void dn_sample(const Params& p, int item, char* smem) {
  float* sq = (float*)smem;
  float* sk = sq + 512;
  float* sv = sk + 512;
  float* red = sv + 512;
  const int tid = threadIdx.x, lane = tid & 63, w = tid >> 6;
  const int b = item >> 2, h = item & 3;
  __syncthreads();
  for (int c = tid; c < 384; c += 256) {
    const int part = c >> 7, cc = c & 127;
    const int col = part * 512 + h * 128 + cc;
    float xp[7];
#pragma unroll
    for (int j = 0; j < 3; ++j) xp[j] = p.state_conv[((size_t)b * 3 + j) * 1536 + col];
#pragma unroll
    for (int j = 0; j < 4; ++j) xp[3 + j] = bf2f(p.proj[((size_t)MP + b * 4 + j) * NP + col]);
    const float w0 = p.conv_w[col], w1 = p.conv_w[1536 + col], w2 = p.conv_w[3072 + col], w3 = p.conv_w[4608 + col];
    float* dst = part == 0 ? sq : (part == 1 ? sk : sv);
#pragma unroll
    for (int t = 0; t < 4; ++t) dst[t * 128 + cc] = siluf(w0 * xp[t] + w1 * xp[t + 1] + w2 * xp[t + 2] + w3 * xp[t + 3]);
  }
  __syncthreads();
  {
    float a0 = sq[w * 128 + lane], a1 = sq[w * 128 + 64 + lane];
    float s = wave_sum(a0 * a0 + a1 * a1);
    float sc = rsqrtf(s + EPS) * 0.08838834764831845f;
    sq[w * 128 + lane] = a0 * sc; sq[w * 128 + 64 + lane] = a1 * sc;
    float b0 = sk[w * 128 + lane], b1 = sk[w * 128 + 64 + lane];
    s = wave_sum(b0 * b0 + b1 * b1);
    sc = rsqrtf(s + EPS);
    sk[w * 128 + lane] = b0 * sc; sk[w * 128 + 64 + lane] = b1 * sc;
  }
  __syncthreads();
  const int v = tid & 127, half = tid >> 7;
  float S[64];
  const float* s0 = p.state_delta + (((size_t)b * 4 + h) * 128 + half * 64) * 128 + v;
#pragma unroll
  for (int i = 0; i < 64; ++i) S[i] = s0[(size_t)i * 128];
#pragma unroll 1
  for (int t = 0; t < 4; ++t) {
    const size_t row = (size_t)MP + b * 4 + t;
    const float a = __expf(p.gb[row * 8 + h]);
    const float beta = p.gb[row * 8 + 4 + h];
    float part = 0.f;
#pragma unroll
    for (int i = 0; i < 64; ++i) part += S[i] * sk[t * 128 + half * 64 + i];
    red[half * 128 + v] = part;
    __syncthreads();
    const float kS = red[v] + red[128 + v];
    const float u = beta * (sv[t * 128 + v] - a * kS);
    float po = 0.f;
#pragma unroll
    for (int i = 0; i < 64; ++i) { S[i] = a * S[i] + sk[t * 128 + half * 64 + i] * u; po += S[i] * sq[t * 128 + half * 64 + i]; }
    __syncthreads();
    red[half * 128 + v] = po;
    __syncthreads();
    if (half == 0) p.odn[row * 512 + h * 128 + v] = f2bf(red[v] + red[128 + v]);
    __syncthreads();
  }
  float* d = p.out + O_SDELTA + (((size_t)b * 4 + h) * 128 + half * 64) * 128 + v;
#pragma unroll
  for (int i = 0; i < 64; ++i) d[(size_t)i * 128] = S[i];
}

DI void phase2(const Params& p, char* smem) {
  const size_t gtid = (size_t)blockIdx.x * 256 + threadIdx.x, gsz = (size_t)gridDim.x * 256;
  for (int j = blockIdx.x; j < 2048 + 128 + 6144; j += gridDim.x) {
    if (j < 2048) dn_prep(p, j, smem);
    else if (j < 2048 + 128) dn_sample(p, j - 2048, smem);
    else vt_tile(p, j - 2176, smem);
  }
  for (size_t f = gtid; f < (size_t)16 * 8192; f += gsz) {
    {
      const size_t e0 = f * 8;
      const int bh = (int)(e0 >> 16), key = (int)((e0 >> 8) & 255), dh = (int)(e0 & 255);
      const int b = bh >> 2, h = bh & 3;
      cvt8(p.out + O_PMEM + (((size_t)b * 256 + key) * 2 + 0) * 1024 + h * 256 + dh, p.Kb + e0);
    }
    {
      const int l = (int)(f & 63), ks = (int)((f >> 6) & 7), nt = (int)((f >> 9) & 15), bh = (int)(f >> 13);
      const int b = bh >> 2, h = bh & 3, rr = l & 15, kgg = l >> 4;
      float v[8];
#pragma unroll
      for (int j = 0; j < 8; ++j) {
        const int key = ks * 32 + permk(kgg, j);
        v[j] = p.out[O_PMEM + (((size_t)b * 256 + key) * 2 + 1) * 1024 + h * 256 + nt * 16 + rr];
      }
      *(uint4*)&p.VTf[f * 8] = make_uint4(pack2(v[0], v[1]), pack2(v[2], v[3]), pack2(v[4], v[5]), pack2(v[6], v[7]));
    }
  }
  for (size_t i = gtid; i < 18432; i += gsz) {
    const int c = (int)(i % 1536), j = (int)((i / 1536) % 3), b = (int)(i / 4608);
    p.out[O_PCONV + i] = bf2f(p.proj[((size_t)b * SEQ + SEQ - 3 + j) * NP + c]);
  }
  for (int g = 0; g < 3; ++g) {
    const int W = 128 << (2 * g);
    const size_t off = (g == 0) ? O_PW1 : (g == 1 ? O_PW2 : O_PW3);
    const size_t n4 = (size_t)4 * W * 512 / 4;
    for (size_t i = gtid; i < n4; i += gsz) {
      const size_t e0 = i * 4;
      const int e = (int)(e0 & 511), ii = (int)((e0 >> 9) % W), b = (int)((e0 >> 9) / W);
      uint2 v = *(const uint2*)&p.proj[((size_t)b * SEQ + SEQ - W + ii) * NP + 2048 + g * 768 + 256 + e];
      *(float4*)&p.out[off + e0] = make_float4(bflo(v.x), bfhi(v.x), bflo(v.y), bfhi(v.y));
    }
  }
}

typedef __attribute__((ext_vector_type(2))) unsigned u32x2;
struct ScanOps { bf16x8 nW[4]; bf16x8 qg[4]; bf16x8 aq[2]; bf16x8 kd[4]; u32x2 u0; float dl; };

DI void scan_load(const Params& p, int bh, int s, int n, int j, int lane, ScanOps& o) {
  n = n > 127 ? 127 : n;
  const char* base = p.dnops + (size_t)(bh * 128 + n) * DN_ITEM;
  const bf16x8* negW = (const bf16x8*)base;
  const bf16x8* qg = (const bf16x8*)(base + 16384);
  const bf16x8* kdT = (const bf16x8*)(base + 32768);
  const bf16x8* aqk = (const bf16x8*)(base + 49152);
  const u32x2* u0 = (const u32x2*)(base + 57344);
#pragma unroll
  for (int ks = 0; ks < 4; ++ks) o.nW[ks] = negW[(j * 4 + ks) * 64 + lane];
#pragma unroll
  for (int ks = 0; ks < 4; ++ks) o.qg[ks] = qg[(j * 4 + ks) * 64 + lane];
#pragma unroll
  for (int k2 = 0; k2 < 2; ++k2) o.aq[k2] = aqk[(j * 2 + k2) * 64 + lane];
#pragma unroll
  for (int mm = 0; mm < 2; ++mm)
#pragma unroll
    for (int k2 = 0; k2 < 2; ++k2) o.kd[mm * 2 + k2] = kdT[((2 * j + mm) * 2 + k2) * 64 + lane];
  o.u0 = u0[(s * 4 + j) * 64 + lane];
  o.dl = p.dl[bh * 128 + n];
}

DI void scan_step(const Params& p, const ScanOps& ops, int n, int b, int h, int s, int j, int lane, f32x4& S0, f32x4& S1,
                  bf16x8* sSb, u32x2* sUb) {
  const int r = lane & 15, kg = lane >> 4;
  bf16x8 sb[4];
#pragma unroll
  for (int ks = 0; ks < 4; ++ks) sb[ks] = sSb[ks * 64 + lane];
  f32x4 u = (f32x4){bflo(ops.u0[0]), bfhi(ops.u0[0]), bflo(ops.u0[1]), bfhi(ops.u0[1])};
#pragma unroll
  for (int ks = 0; ks < 4; ++ks) u = MFMA(ops.nW[ks], sb[ks], u);
  {
    u32x2 t; t[0] = pack2(u[0], u[1]); t[1] = pack2(u[2], u[3]);
    sUb[((j >> 1) * 64 + lane) * 2 + (j & 1)] = t;
  }
  __syncthreads();
  bf16x8 ub[2];
#pragma unroll
  for (int k2 = 0; k2 < 2; ++k2) ub[k2] = *(const bf16x8*)&sUb[(k2 * 64 + lane) * 2];
  f32x4 o = (f32x4){0.f, 0.f, 0.f, 0.f};
#pragma unroll
  for (int ks = 0; ks < 4; ++ks) o = MFMA(ops.qg[ks], sb[ks], o);
#pragma unroll
  for (int k2 = 0; k2 < 2; ++k2) o = MFMA(ops.aq[k2], ub[k2], o);
  S0 = S0 * ops.dl; S1 = S1 * ops.dl;
#pragma unroll
  for (int k2 = 0; k2 < 2; ++k2) { S0 = MFMA(ops.kd[k2], ub[k2], S0); S1 = MFMA(ops.kd[2 + k2], ub[k2], S1); }
  sSb[j * 64 + lane] = pack8(S0, S1);
#pragma unroll
  for (int jj = 0; jj < 4; ++jj) {
    const size_t token = (size_t)b * SEQ + n * 64 + j * 16 + kg * 4 + jj;
    p.odn[token * 512 + h * 128 + s * 16 + r] = f2bf(o[jj]);
  }
  __syncthreads();
}

DI void dn_scan_block(const Params& p, int item, char* smem) {
  const int lane = threadIdx.x & 63, j = threadIdx.x >> 6, r = lane & 15, kg = lane >> 4;
  const int bh = item >> 3, s = item & 7, b = bh >> 2, h = bh & 3;
  bf16x8* sSb = (bf16x8*)smem;
  u32x2* sUb = (u32x2*)(smem + 4096);
  f32x4 S0 = (f32x4){0.f, 0.f, 0.f, 0.f}, S1 = (f32x4){0.f, 0.f, 0.f, 0.f};
  __syncthreads();
  sSb[j * 64 + lane] = pack8(S0, S1);
  ScanOps A, B;
  scan_load(p, bh, s, 0, j, lane, A);
  scan_load(p, bh, s, 1, j, lane, B);
  __syncthreads();
#pragma unroll 1
  for (int n0 = 0; n0 < 128; n0 += 2) {
    scan_step(p, A, n0, b, h, s, j, lane, S0, S1, sSb, sUb);
    scan_load(p, bh, s, n0 + 2, j, lane, A);
    scan_step(p, B, n0 + 1, b, h, s, j, lane, S0, S1, sSb, sUb);
    scan_load(p, bh, s, n0 + 3, j, lane, B);
  }
#pragma unroll
  for (int jj = 0; jj < 4; ++jj) {
    p.out[O_PDELTA + ((size_t)bh * 128 + 32 * j + kg * 4 + jj) * 128 + s * 16 + r] = S0[jj];
    p.out[O_PDELTA + ((size_t)bh * 128 + 32 * j + 16 + kg * 4 + jj) * 128 + s * 16 + r] = S1[jj];
  }
}

DI void sw_prompt_wave(const Params& p, int item) {
  const int lane = threadIdx.x & 63, r = lane & 15, kg = lane >> 4;
  const int qt = item & 511, gbh = item >> 9;
  const int h = gbh & 3, b = (gbh >> 2) & 3, g = gbh >> 4;
  const int dsh = 2 * g, ln = SEQ >> dsh;
  const int pos0 = qt * 16, rres = pos0 / ln, i0 = pos0 % ln;
  const int kbase = i0 - 144;
  const size_t rb = (size_t)b * SEQ;
  const int qoff = 2048 + g * 768 + h * 64, koff = qoff + 256;
  bf16x8 qf[2];
  {
    const size_t tok = rb + ((size_t)(i0 + r) << dsh) + rres;
#pragma unroll
    for (int ks = 0; ks < 2; ++ks) qf[ks] = *(const bf16x8*)&p.proj[tok * NP + qoff + ks * 32 + kg * 8];
  }
  f32x4 st[10];
#pragma unroll
  for (int mt = 0; mt < 10; ++mt) {
    int ki = kbase + mt * 16 + r; ki = ki < 0 ? 0 : ki;
    const size_t tok = rb + ((size_t)ki << dsh) + rres;
    f32x4 a = (f32x4){0.f, 0.f, 0.f, 0.f};
#pragma unroll
    for (int ks = 0; ks < 2; ++ks) {
      bf16x8 kf = *(const bf16x8*)&p.proj[tok * NP + koff + ks * 32 + kg * 8];
      a = MFMA(kf, qf[ks], a);
    }
    st[mt] = a;
  }
  const int qi = i0 + r;
  float mx = -3.0e38f;
#pragma unroll
  for (int mt = 0; mt < 10; ++mt)
#pragma unroll
    for (int j = 0; j < 4; ++j) {
      const int ki = kbase + mt * 16 + kg * 4 + j;
      const int d = qi - ki;
      const bool valid = (ki >= 0) && (d >= 0) && (d <= 128);
      const float sv = valid ? st[mt][j] * 0.125f : -3.0e38f;
      st[mt][j] = sv;
      mx = fmaxf(mx, sv);
    }
  mx = fmaxf(mx, __shfl_xor(mx, 16));
  mx = fmaxf(mx, __shfl_xor(mx, 32));
  float sum = 0.f;
#pragma unroll
  for (int mt = 0; mt < 10; ++mt)
#pragma unroll
    for (int j = 0; j < 4; ++j) {
      const float pv = (st[mt][j] > -1.0e38f) ? __expf(st[mt][j] - mx) : 0.f;
      st[mt][j] = pv;
      sum += pv;
    }
  sum += __shfl_xor(sum, 16);
  sum += __shfl_xor(sum, 32);
  const float inv = 1.f / sum;
  bf16x8 pf[5];
#pragma unroll
  for (int k2 = 0; k2 < 5; ++k2) pf[k2] = pack8(st[2 * k2], st[2 * k2 + 1]);
  const size_t qrow = rb + ((size_t)qi << dsh) + rres;
#pragma unroll
  for (int nt = 0; nt < 4; ++nt) {
    f32x4 o = (f32x4){0.f, 0.f, 0.f, 0.f};
    const u16* vrow = &p.vT[((size_t)gbh * 64 + nt * 16 + r) * SEQ + (size_t)rres * ln];
#pragma unroll
    for (int k2 = 0; k2 < 5; ++k2) {
      int ka = kbase + k2 * 32 + kg * 4, kc = ka + 16;
      ka = ka < 0 ? 0 : ka; kc = kc < 0 ? 0 : kc;
      uint2 va = *(const uint2*)&vrow[ka];
      uint2 vc = *(const uint2*)&vrow[kc];
      bf16x8 vf = __builtin_bit_cast(bf16x8, make_uint4(va.x, va.y, vc.x, vc.y));
      o = MFMA(vf, pf[k2], o);
    }
    uint2 ov; ov.x = pack2(o[0] * inv, o[1] * inv); ov.y = pack2(o[2] * inv, o[3] * inv);
    *(uint2*)&p.osw[((size_t)g * MT + qrow) * 256 + h * 64 + nt * 16 + kg * 4] = ov;
  }
  if (kg == 0) p.lse[((size_t)g * MT + qrow) * 4 + h] = mx + __logf(sum);
}

DI void sw_sample_wave(const Params& p, int item) {
  const int lane = threadIdx.x & 63;
  const int t = item & 3, h = (item >> 2) & 3, b = (item >> 4) & 31, g = item >> 9;
  const int dil = 1 << (2 * g), W = 128 << (2 * g);
  const float* c1 = p.cw1;
  const float* c2 = p.cw2;
  const float* c3 = p.cw3;
  const float* cache = (g == 0) ? c1 : (g == 1 ? c2 : c3);
  const int qoff = 2048 + g * 768 + h * 64;
  const size_t qrow = (size_t)MP + b * 4 + t;
  float q[64];
#pragma unroll
  for (int c = 0; c < 64; c += 8) {
    uint4 v = *(const uint4*)&p.proj[qrow * NP + qoff + c];
    q[c] = bflo(v.x); q[c + 1] = bfhi(v.x); q[c + 2] = bflo(v.y); q[c + 3] = bfhi(v.y);
    q[c + 4] = bflo(v.z); q[c + 5] = bfhi(v.z); q[c + 6] = bflo(v.w); q[c + 7] = bfhi(v.w);
  }
  float sc[3];
#pragma unroll
  for (int mi = 0; mi < 3; ++mi) {
    const int m = lane + 64 * mi;
    float s = -3.0e38f;
    if (m <= 128) {
      const int j = W + t - m * dil;
      float d = 0.f;
      if (j >= W) {
        const u16* kr = &p.proj[((size_t)MP + b * 4 + (j - W)) * NP + qoff + 256];
#pragma unroll
        for (int c = 0; c < 64; c += 8) {
          uint4 v = *(const uint4*)&kr[c];
          d += q[c] * bflo(v.x) + q[c + 1] * bfhi(v.x) + q[c + 2] * bflo(v.y) + q[c + 3] * bfhi(v.y) + q[c + 4] * bflo(v.z) +
               q[c + 5] * bfhi(v.z) + q[c + 6] * bflo(v.w) + q[c + 7] * bfhi(v.w);
        }
      } else {
        const float* kr = &cache[(((size_t)b * W + j) * 2 + 0) * 256 + h * 64];
#pragma unroll
        for (int c = 0; c < 64; c += 4) {
          float4 v = *(const float4*)&kr[c];
          d += q[c] * v.x + q[c + 1] * v.y + q[c + 2] * v.z + q[c + 3] * v.w;
        }
      }
      s = d * 0.125f;
    }
    sc[mi] = s;
  }
  float mx = wave_max(fmaxf(fmaxf(sc[0], sc[1]), sc[2]));
  float sum = 0.f;
#pragma unroll
  for (int mi = 0; mi < 3; ++mi) { sc[mi] = (sc[mi] > -1.0e38f) ? __expf(sc[mi] - mx) : 0.f; sum += sc[mi]; }
  sum = wave_sum(sum);
  float o = 0.f;
#pragma unroll
  for (int mi = 0; mi < 3; ++mi) {
#pragma unroll 8
    for (int mm = 0; mm < 64; ++mm) {
      const int m = mi * 64 + mm;
      if (m <= 128) {
        const float pv = __shfl(sc[mi], mm);
        const int j = W + t - m * dil;
        float vv;
        if (j >= W) vv = bf2f(p.proj[((size_t)MP + b * 4 + (j - W)) * NP + qoff + 512 + lane]);
        else vv = cache[(((size_t)b * W + j) * 2 + 1) * 256 + h * 64 + lane];
        o += pv * vv;
      }
    }
  }
  p.osw[((size_t)g * MT + qrow) * 256 + h * 64 + lane] = f2bf(o / sum);
  if (lane == 0) p.lse[((size_t)g * MT + qrow) * 4 + h] = mx + __logf(sum);
}

DI void phase3(const Params& p, char* smem) {
  const int w = threadIdx.x >> 6;
  if (blockIdx.x < 128) {
    dn_scan_block(p, blockIdx.x, smem);
  } else {
    const int gw = (blockIdx.x - 128) * 4 + w, nw = (gridDim.x - 128) * 4;
    for (int it = gw; it < 24576 + 1536; it += nw) {
      if (it < 24576) sw_prompt_wave(p, it);
      else sw_sample_wave(p, it - 24576);
    }
  }
}

DI void phase4(const Params& p) {
  const int lane = threadIdx.x & 63, w = threadIdx.x >> 6;
  for (int row = blockIdx.x * 4 + w; row < MT; row += gridDim.x * 4) {
    u16* dst = p.Amix + (size_t)row * 768;
#pragma unroll
    for (int h = 0; h < 4; ++h) {
      unsigned ov = *(const unsigned*)&p.odn[(size_t)row * 512 + h * 128 + lane * 2];
      unsigned zv = *(const unsigned*)&p.proj[(size_t)row * NP + 1536 + h * 128 + lane * 2];
      float o0 = bflo(ov), o1 = bfhi(ov);
      float ss = wave_sum(o0 * o0 + o1 * o1);
      float rs = rsqrtf(ss * (1.f / 128.f) + EPS);
      float2 gn = *(const float2*)&p.g_onorm[lane * 2];
      float y0 = o0 * rs * gn.x * siluf(bflo(zv)), y1 = o1 * rs * gn.y * siluf(bfhi(zv));
      *(unsigned*)&dst[h * 128 + lane * 2] = pack2(y0, y1);
    }
    {
      const int h = lane >> 4;
      float l0 = p.lse[((size_t)0 * MT + row) * 4 + h], l1 = p.lse[((size_t)1 * MT + row) * 4 + h], l2 = p.lse[((size_t)2 * MT + row) * 4 + h];
      float m = fmaxf(l0, fmaxf(l1, l2));
      float e0 = __expf(l0 - m), e1 = __expf(l1 - m), e2 = __expf(l2 - m);
      float inv = 1.f / (e0 + e1 + e2);
      uint2 a = *(const uint2*)&p.osw[((size_t)0 * MT + row) * 256 + lane * 4];
      uint2 c = *(const uint2*)&p.osw[((size_t)1 * MT + row) * 256 + lane * 4];
      uint2 d = *(const uint2*)&p.osw[((size_t)2 * MT + row) * 256 + lane * 4];
      e0 *= inv; e1 *= inv; e2 *= inv;
      float y0 = e0 * bflo(a.x) + e1 * bflo(c.x) + e2 * bflo(d.x);
      float y1 = e0 * bfhi(a.x) + e1 * bfhi(c.x) + e2 * bfhi(d.x);
      float y2 = e0 * bflo(a.y) + e1 * bflo(c.y) + e2 * bflo(d.y);
      float y3 = e0 * bfhi(a.y) + e1 * bfhi(c.y) + e2 * bfhi(d.y);
      *(uint2*)&dst[512 + lane * 4] = make_uint2(pack2(y0, y1), pack2(y2, y3));
    }
  }
}

DI void sample_state_copy(const Params& p) {
  const size_t gtid = (size_t)blockIdx.x * 256 + threadIdx.x, gsz = (size_t)gridDim.x * 256;
  for (size_t i = gtid; i < 147456; i += gsz) {
    const int c = (int)(i % 1536), j = (int)((i / 1536) % 3), b = (int)(i / 4608);
    p.out[O_SCONV + i] = bf2f(p.proj[((size_t)MP + b * 4 + j + 1) * NP + c]);
  }
  const float* c1 = p.cw1;
  const float* c2 = p.cw2;
  const float* c3 = p.cw3;
  for (int g = 0; g < 3; ++g) {
    const int W = 128 << (2 * g);
    const float* cache = (g == 0) ? c1 : (g == 1 ? c2 : c3);
    const size_t off = (g == 0) ? O_SW1 : (g == 1 ? O_SW2 : O_SW3);
    const size_t n4 = (size_t)32 * W * 512 / 4;
    for (size_t i = gtid; i < n4; i += gsz) {
      const size_t e0 = i * 4;
      const int e = (int)(e0 & 511), ii = (int)((e0 >> 9) % W), b = (int)((e0 >> 9) / W);
      float4 o;
      if (ii < W - 4) o = *(const float4*)&cache[((size_t)b * W + ii + 4) * 512 + e];
      else {
        uint2 v = *(const uint2*)&p.proj[((size_t)MP + b * 4 + (ii - (W - 4))) * NP + 2048 + g * 768 + 256 + e];
        o = make_float4(bflo(v.x), bfhi(v.x), bflo(v.y), bfhi(v.y));
      }
      *(float4*)&p.out[off + e0] = o;
    }
  }
}

DI void mem_attn_prompt_block(const Params& p, int item, char* smem) {
  const int tid = threadIdx.x, lane = tid & 63, w = tid >> 6, r = lane & 15, kg = lane >> 4;
  const int h = item & 3, qb = item >> 2;
  const int row0 = qb * 64 + w * 16, b = (qb * 64) >> 13;
  const int bh = b * 4 + h;
  u16* sK = (u16*)smem;
  bf16x8 qf[8];
#pragma unroll
  for (int ks = 0; ks < 8; ++ks) qf[ks] = *(const bf16x8*)&p.qb[(size_t)(row0 + r) * 1024 + h * 256 + ks * 32 + kg * 8];
  f32x4 st[16];
  const u16* kbp = p.Kb + (size_t)bh * 65536;
#pragma unroll
  for (int c = 0; c < 4; ++c) {
    __syncthreads();
#pragma unroll
    for (int i2 = 0; i2 < 2; ++i2) {
#pragma unroll
      for (int i = i2 * 4; i < i2 * 4 + 4; ++i) {
        const int idx = tid + 256 * i, row = idx >> 5, seg = idx & 31;
        *(bf16x8*)&sK[row * 264 + seg * 8] = *(const bf16x8*)&kbp[(size_t)(c * 64 + row) * 256 + seg * 8];
      }
      __builtin_amdgcn_sched_barrier(0);
    }
    __syncthreads();
#pragma unroll
    for (int m4 = 0; m4 < 4; ++m4) {
      f32x4 a = (f32x4){0.f, 0.f, 0.f, 0.f};
#pragma unroll
      for (int ks = 0; ks < 8; ++ks) {
        bf16x8 kf = *(const bf16x8*)&sK[(m4 * 16 + r) * 264 + ks * 32 + kg * 8];
        a = MFMA(kf, qf[ks], a);
      }
      st[c * 4 + m4] = a;
      __builtin_amdgcn_sched_barrier(0);
    }
  }
  float mx = -3.0e38f;
#pragma unroll
  for (int mt = 0; mt < 16; ++mt)
#pragma unroll
    for (int j = 0; j < 4; ++j) { st[mt][j] *= 0.0625f; mx = fmaxf(mx, st[mt][j]); }
  mx = fmaxf(mx, __shfl_xor(mx, 16));
  mx = fmaxf(mx, __shfl_xor(mx, 32));
  float sum = 0.f;
#pragma unroll
  for (int mt = 0; mt < 16; ++mt)
#pragma unroll
    for (int j = 0; j < 4; ++j) { st[mt][j] = __expf(st[mt][j] - mx); sum += st[mt][j]; }
  sum += __shfl_xor(sum, 16);
  sum += __shfl_xor(sum, 32);
  const float inv = 1.f / sum;
  bf16x8 pf[8];
#pragma unroll
  for (int k2 = 0; k2 < 8; ++k2) pf[k2] = pack8(st[2 * k2], st[2 * k2 + 1]);
  const u16* vtp = p.VTf + (size_t)bh * 65536;
#pragma unroll 1
  for (int c = 0; c < 4; ++c) {
    __syncthreads();
#pragma unroll
    for (int i = 0; i < 8; ++i) {
      const int idx = tid + 256 * i;
      *(bf16x8*)&sK[idx * 8] = *(const bf16x8*)&vtp[(size_t)c * 16384 + idx * 8];
    }
    __syncthreads();
#pragma unroll
    for (int n4 = 0; n4 < 4; ++n4) {
      f32x4 o = (f32x4){0.f, 0.f, 0.f, 0.f};
#pragma unroll
      for (int k2 = 0; k2 < 8; ++k2) o = MFMA(*(const bf16x8*)&sK[((n4 * 8 + k2) * 64 + lane) * 8], pf[k2], o);
      uint2 ov; ov.x = pack2(o[0] * inv, o[1] * inv); ov.y = pack2(o[2] * inv, o[3] * inv);
      *(uint2*)&p.attn[(size_t)(row0 + r) * 1024 + h * 256 + (c * 4 + n4) * 16 + kg * 4] = ov;
      __builtin_amdgcn_sched_barrier(0);
    }
  }
}

DI void mem_attn_sample_wave(const Params& p, int item, float* lds) {
  const int lane = threadIdx.x & 63;
  const int b = item >> 2, h = item & 3;
  float* sq = lds;
#pragma unroll
  for (int t = 0; t < 4; ++t) {
    uint2 v = *(const uint2*)&p.qb[((size_t)MP + b * 4 + t) * 1024 + h * 256 + lane * 4];
    *(float4*)&sq[t * 256 + lane * 4] = make_float4(bflo(v.x), bfhi(v.x), bflo(v.y), bfhi(v.y));
  }
  __builtin_amdgcn_s_waitcnt(0);
  __builtin_amdgcn_wave_barrier();
  float sc[4][4];
#pragma unroll
  for (int mi = 0; mi < 4; ++mi) {
    const int m = lane + 64 * mi;
    const float* kr = &p.cache_mem[(((size_t)b * 256 + m) * 2 + 0) * 1024 + h * 256];
    float d0 = 0.f, d1 = 0.f, d2 = 0.f, d3 = 0.f;
#pragma unroll 2
    for (int c = 0; c < 256; c += 4) {
      float4 kv = *(const float4*)&kr[c];
      float4 q0 = *(const float4*)&sq[c], q1 = *(const float4*)&sq[256 + c], q2 = *(const float4*)&sq[512 + c], q3 = *(const float4*)&sq[768 + c];
      d0 += kv.x * q0.x + kv.y * q0.y + kv.z * q0.z + kv.w * q0.w;
      d1 += kv.x * q1.x + kv.y * q1.y + kv.z * q1.z + kv.w * q1.w;
      d2 += kv.x * q2.x + kv.y * q2.y + kv.z * q2.z + kv.w * q2.w;
      d3 += kv.x * q3.x + kv.y * q3.y + kv.z * q3.z + kv.w * q3.w;
    }
    sc[0][mi] = d0 * 0.0625f; sc[1][mi] = d1 * 0.0625f; sc[2][mi] = d2 * 0.0625f; sc[3][mi] = d3 * 0.0625f;
  }
  float inv[4];
  __builtin_amdgcn_wave_barrier();
#pragma unroll
  for (int t = 0; t < 4; ++t) {
    float mx = wave_max(fmaxf(fmaxf(sc[t][0], sc[t][1]), fmaxf(sc[t][2], sc[t][3])));
    float sum = 0.f;
#pragma unroll
    for (int mi = 0; mi < 4; ++mi) { sc[t][mi] = __expf(sc[t][mi] - mx); sum += sc[t][mi]; }
    sum = wave_sum(sum);
    inv[t] = 1.f / sum;
#pragma unroll
    for (int mi = 0; mi < 4; ++mi) sq[t * 256 + lane + 64 * mi] = sc[t][mi];
  }
  __builtin_amdgcn_s_waitcnt(0);
  __builtin_amdgcn_wave_barrier();
  float4 o[4];
#pragma unroll
  for (int t = 0; t < 4; ++t) o[t] = make_float4(0.f, 0.f, 0.f, 0.f);
#pragma unroll 4
  for (int m = 0; m < 256; ++m) {
    float4 vv = *(const float4*)&p.cache_mem[(((size_t)b * 256 + m) * 2 + 1) * 1024 + h * 256 + lane * 4];
#pragma unroll
    for (int t = 0; t < 4; ++t) {
      const float pv = sq[t * 256 + m];
      o[t].x += pv * vv.x; o[t].y += pv * vv.y; o[t].z += pv * vv.z; o[t].w += pv * vv.w;
    }
  }
#pragma unroll
  for (int t = 0; t < 4; ++t) {
    uint2 ov; ov.x = pack2(o[t].x * inv[t], o[t].y * inv[t]); ov.y = pack2(o[t].z * inv[t], o[t].w * inv[t]);
    *(uint2*)&p.attn[((size_t)MP + b * 4 + t) * 1024 + h * 256 + lane * 4] = ov;
  }
  __builtin_amdgcn_wave_barrier();
}

DI void phase7(const Params& p, char* smem) {
  const int w = threadIdx.x >> 6;
  float* lds = (float*)smem + w * 1280;
  for (int it = blockIdx.x; it < 32 + 2048; it += gridDim.x) {
    if (it < 32) { __syncthreads(); mem_attn_sample_wave(p, it * 4 + w, lds); }
    else mem_attn_prompt_block(p, it - 32, smem);
  }
}

DI void peer_topk_wave(const Params& p, int item, unsigned* lds  ) {
  const int lane = threadIdx.x & 63, r = lane & 15, kg = lane >> 4;
  const int h = item & 7, row0 = (item >> 3) * 16;
  unsigned win[2][16];
#pragma unroll
  for (int pp = 0; pp < 2; ++pp) {
    bf16x8 qf[4];
#pragma unroll
    for (int ks = 0; ks < 4; ++ks) qf[ks] = *(const bf16x8*)&p.pq[(size_t)(row0 + r) * 2048 + h * 256 + pp * 128 + ks * 32 + kg * 8];
    unsigned kk[32];
    const u16* sk = p.subkb + (size_t)(h * 2 + pp) * 16384;
#pragma unroll
    for (int mt = 0; mt < 8; ++mt) {
      f32x4 a = (f32x4){0.f, 0.f, 0.f, 0.f};
#pragma unroll
      for (int ks = 0; ks < 4; ++ks) {
        bf16x8 kf = *(const bf16x8*)&sk[(mt * 16 + r) * 128 + ks * 32 + kg * 8];
        a = MFMA(kf, qf[ks], a);
      }
#pragma unroll
      for (int j = 0; j < 4; ++j) kk[mt * 4 + j] = (ordf(a[j]) & ~127u) | (unsigned)(mt * 16 + kg * 4 + j);
    }
#pragma unroll
    for (int rr = 0; rr < 16; ++rr) {
      unsigned m = 0;
#pragma unroll
      for (int i = 0; i < 32; ++i) m = umax(m, kk[i]);
      m = umax(m, (unsigned)__shfl_xor((int)m, 16));
      m = umax(m, (unsigned)__shfl_xor((int)m, 32));
      win[pp][rr] = m;
#pragma unroll
      for (int i = 0; i < 32; ++i) kk[i] = (kk[i] == m) ? 0u : kk[i];
    }
  }
  float f0[16], f1[16];
#pragma unroll
  for (int i = 0; i < 16; ++i) { f0[i] = unordf(win[0][i] & ~127u); f1[i] = unordf(win[1][i] & ~127u); }
  unsigned cand[13];
#define CAND(s, a0, b0, a1, b1, a2, b2, a3, b3)                                                         \
  {                                                                                                     \
    float va = sel4(kg, f0[a0], f0[a1], f0[a2], f0[(a3) < 0 ? 0 : (a3)]);                                \
    float vb = sel4(kg, f1[b0], f1[b1], f1[b2], f1[(b3) < 0 ? 0 : (b3)]);                                \
    unsigned id = sel4(kg, (unsigned)((a0) * 16 + (b0)), (unsigned)((a1) * 16 + (b1)), (unsigned)((a2) * 16 + (b2)), (unsigned)(((a3) < 0 ? 0 : (a3)) * 16 + ((b3) < 0 ? 0 : (b3)))); \
    unsigned key = (ordf(va + vb) & ~255u) | id;                                                        \
    if ((a3) < 0) key = (kg == 3) ? 0u : key;                                                           \
    cand[s] = key;                                                                                      \
  }
  CAND(0, 0, 0, 0, 13, 2, 0, 6, 1)
  CAND(1, 0, 1, 0, 14, 2, 1, 7, 0)
  CAND(2, 0, 2, 0, 15, 2, 2, 7, 1)
  CAND(3, 0, 3, 1, 0, 2, 3, 8, 0)
  CAND(4, 0, 4, 1, 1, 2, 4, 9, 0)
  CAND(5, 0, 5, 1, 2, 3, 0, 10, 0)
  CAND(6, 0, 6, 1, 3, 3, 1, 11, 0)
  CAND(7, 0, 7, 1, 4, 3, 2, 12, 0)
  CAND(8, 0, 8, 1, 5, 3, 3, 13, 0)
  CAND(9, 0, 9, 1, 6, 4, 2, 14, 0)
  CAND(10, 0, 10, 1, 7, 5, 0, 15, 0)
  CAND(11, 0, 11, 4, 0, 5, 1, -1, -1)
  CAND(12, 0, 12, 4, 1, 6, 0, -1, -1)
#undef CAND
  unsigned w2[16];
#pragma unroll
  for (int rr = 0; rr < 16; ++rr) {
    unsigned m = 0;
#pragma unroll
    for (int i = 0; i < 13; ++i) m = umax(m, cand[i]);
    m = umax(m, (unsigned)__shfl_xor((int)m, 16));
    m = umax(m, (unsigned)__shfl_xor((int)m, 32));
    w2[rr] = m;
#pragma unroll
    for (int i = 0; i < 13; ++i) cand[i] = (cand[i] == m) ? 0u : cand[i];
  }
  if (kg == 0) {
#pragma unroll
    for (int i = 0; i < 16; ++i) { lds[r * 32 + i] = win[0][i] & 127u; lds[r * 32 + 16 + i] = win[1][i] & 127u; }
  }
  __builtin_amdgcn_s_waitcnt(0);
  __builtin_amdgcn_wave_barrier();
  const float cv0 = unordf(w2[0] & ~255u);
  float sum = 0.f;
#pragma unroll
  for (int rr = 0; rr < 16; ++rr) sum += __expf(unordf(w2[rr] & ~255u) - cv0);
  const float inv = 1.f / sum;
  const size_t ob = ((size_t)(row0 + r) * 8 + h) * 16;
#pragma unroll
  for (int q = 0; q < 4; ++q) {
    const unsigned wk = sel4(kg, w2[q], w2[4 + q], w2[8 + q], w2[12 + q]);
    const int a = (wk >> 4) & 15, bb = wk & 15;
    const int i1 = (int)lds[r * 32 + a], i2 = (int)lds[r * 32 + 16 + bb];
    p.eid[ob + kg * 4 + q] = i1 * 128 + i2;
    p.gate[ob + kg * 4 + q] = __expf(unordf(wk & ~255u) - cv0) * inv;
  }
  __builtin_amdgcn_wave_barrier();
}

typedef __attribute__((ext_vector_type(2))) float f32x2;
DI float dot16_fp8(uint4 u, const float* x, float c) {
  const unsigned d[4] = {u.x, u.y, u.z, u.w};
#pragma unroll
  for (int i = 0; i < 4; ++i) {
    f32x2 a = __builtin_amdgcn_cvt_pk_f32_fp8((int)d[i], false);
    f32x2 b = __builtin_amdgcn_cvt_pk_f32_fp8((int)d[i], true);
    c += a[0] * x[4 * i] + a[1] * x[4 * i + 1] + b[0] * x[4 * i + 2] + b[1] * x[4 * i + 3];
  }
  return c;
}
DI void axpy16_fp8(float* o, float w, uint4 u) {
  const unsigned d[4] = {u.x, u.y, u.z, u.w};
#pragma unroll
  for (int i = 0; i < 4; ++i) {
    f32x2 a = __builtin_amdgcn_cvt_pk_f32_fp8((int)d[i], false);
    f32x2 b = __builtin_amdgcn_cvt_pk_f32_fp8((int)d[i], true);
    o[4 * i] += w * a[0]; o[4 * i + 1] += w * a[1]; o[4 * i + 2] += w * b[0]; o[4 * i + 3] += w * b[1];
  }
}

DI void peer_expert_wave(const Params& p, int row) {
  const int lane = __builtin_amdgcn_mbcnt_hi(-1, __builtin_amdgcn_mbcnt_lo(-1, 0));
  float xf[16];
  {
    const uint4 x0 = *(const uint4*)&p.A2[(size_t)row * 1024 + lane * 16];
    const uint4 x1 = *(const uint4*)&p.A2[(size_t)row * 1024 + lane * 16 + 8];
    xf[0] = bflo(x0.x); xf[1] = bfhi(x0.x); xf[2] = bflo(x0.y); xf[3] = bfhi(x0.y);
    xf[4] = bflo(x0.z); xf[5] = bfhi(x0.z); xf[6] = bflo(x0.w); xf[7] = bfhi(x0.w);
    xf[8] = bflo(x1.x); xf[9] = bfhi(x1.x); xf[10] = bflo(x1.y); xf[11] = bfhi(x1.y);
    xf[12] = bflo(x1.z); xf[13] = bfhi(x1.z); xf[14] = bflo(x1.w); xf[15] = bfhi(x1.w);
  }
  const float r2 = rsqrtf(p.ssq2[row] * (1.f / 1024.f) + EPS);
  const unsigned char* EU8 = p.E8;
  const unsigned char* EV8 = p.E8 + (size_t)16384 * 1024;
  float out[16];
#pragma unroll
  for (int i = 0; i < 16; ++i) out[i] = 0.f;
#pragma unroll 1
  for (int bt = 0; bt < 2; ++bt) {
    const int eidv = p.eid[(size_t)row * 128 + bt * 64 + lane];
    const float gv = p.gate[(size_t)row * 128 + bt * 64 + lane];
    const float rsu = p.rs[eidv], rsv = p.rs[16384 + eidv];
    float part[64];
#pragma unroll
    for (int e = 0; e < 64; ++e) {
      const int id = __builtin_amdgcn_readlane(eidv, e);
      const uint4 u = *(const uint4*)(EU8 + (size_t)id * 1024 + lane * 16);
      part[e] = dot16_fp8(u, xf, 0.f);
    }
#pragma unroll
    for (int off = 32; off > 0; off >>= 1) {
      const bool up = (lane & off) != 0;
#pragma unroll
      for (int i = 0; i < off; ++i) {
        const float a = part[i], bq = part[i + off];
        const float send = up ? a : bq, keep = up ? bq : a;
        part[i] = keep + __shfl_xor(send, off);
      }
    }
    const float wv = gv * geluf(part[0] * r2 * rsu) * rsv;
#pragma unroll 8
    for (int e = 0; e < 64; ++e) {
      const int id = __builtin_amdgcn_readlane(eidv, e);
      const float we = __int_as_float(__builtin_amdgcn_readlane(__float_as_int(wv), e));
      const uint4 v = *(const uint4*)(EV8 + (size_t)id * 1024 + lane * 16);
      axpy16_fp8(out, we, v);
    }
  }
  const float* hr = p.h2 + (size_t)row * 1024 + lane * 16;
  float hv[16];
  float ss = 0.f;
#pragma unroll
  for (int i = 0; i < 4; ++i) {
    float4 t = *(const float4*)&hr[i * 4];
    hv[4 * i] = t.x + out[4 * i]; hv[4 * i + 1] = t.y + out[4 * i + 1]; hv[4 * i + 2] = t.z + out[4 * i + 2]; hv[4 * i + 3] = t.w + out[4 * i + 3];
    ss += hv[4 * i] * hv[4 * i] + hv[4 * i + 1] * hv[4 * i + 1] + hv[4 * i + 2] * hv[4 * i + 2] + hv[4 * i + 3] * hv[4 * i + 3];
  }
  ss = wave_sum(ss);
  const float rsn = rsqrtf(ss * (1.f / 1024.f) + EPS);
  float* y = ((row < MP) ? (p.out + O_YP + (size_t)row * 1024) : (p.out + O_YS + (size_t)(row - MP) * 1024)) + lane * 16;
#pragma unroll
  for (int i = 0; i < 4; ++i) {
    float4 g4 = *(const float4*)&p.g_final[lane * 16 + i * 4];
    *(float4*)&y[i * 4] = make_float4(hv[4 * i] * rsn * g4.x, hv[4 * i + 1] * rsn * g4.y, hv[4 * i + 2] * rsn * g4.z, hv[4 * i + 3] * rsn * g4.w);
  }
}

__global__ void __launch_bounds__(256, 2) mega(Params pk) {
  __shared__ __attribute__((aligned(16))) char smem[53248];
  __shared__ Params sp;
  cg::grid_group grid = cg::this_grid();
  const int w = threadIdx.x >> 6;
  if (threadIdx.x == 0) sp = pk;
  __syncthreads();
  const Params& p = sp;
#ifndef DBL
#define DBL -1
#endif
#define REP(ph) for (int rp_ = 0; rp_ < ((DBL == (ph)) ? 2 : 1); ++rp_)
  REP(0) { phase0(p, smem); if (DBL == 0) grid.sync(); }
  grid.sync();
  REP(1) for (int t = blockIdx.x; t < 257 * 34 + 128; t += gridDim.x) {
    if (t < 257 * 34) gemm_tile<0>(p, p.A0, 1024, p.WtIn, 1024, t / 34, t % 34, smem);
    else { int u = t - 257 * 34; gemm_tile<1>(p, p.Amem, 1024, p.WtMkv, 1024, u / 16, u % 16, smem); }
  }
  grid.sync();
  REP(2) { phase2(p, smem); if (DBL == 2) grid.sync(); }
  grid.sync();
  REP(3) { phase3(p, smem); if (DBL == 3) grid.sync(); }
  grid.sync();
  REP(4) phase4(p);
  grid.sync();
  for (int t = blockIdx.x; t < 257 * 8; t += gridDim.x) gemm_tile<2>(p, p.Amix, 768, p.WtOut, 768, t / 8, t % 8, smem);
  grid.sync();
  REP(6) for (int t = blockIdx.x; t < 257 * 8; t += gridDim.x) gemm_tile<3>(p, p.A1, 1024, p.WtMq, 1024, t / 8, t % 8, smem);
  sample_state_copy(p);
  grid.sync();
  REP(7) phase7(p, smem);
  grid.sync();
  for (int t = blockIdx.x; t < 257 * 8; t += gridDim.x) gemm_tile<4>(p, p.attn, 1024, p.WtMo, 1024, t / 8, t % 8, smem);
  grid.sync();
  REP(9) for (int t = blockIdx.x; t < 257 * 16; t += gridDim.x) gemm_tile<5>(p, p.A2, 1024, p.WtPq, 1024, t / 16, t % 16, smem);
  grid.sync();
  REP(10) {
    unsigned* lds = (unsigned*)smem + w * 512;
    for (int it = blockIdx.x * 4 + w; it < 2056 * 8; it += gridDim.x * 4) peer_topk_wave(p, it, lds);
  }
  grid.sync();
  REP(11) for (int row = blockIdx.x * 4 + w; row < MT; row += gridDim.x * 4) peer_expert_wave(p, row);
}

extern "C" void kernel_launch(void* const* d_in, const int* in_sizes, int n_in, void* d_out, int out_size, void* d_ws, size_t ws_size,
                              hipStream_t stream) {
  static int grid_blocks = 0;
  if (!grid_blocks) {
    int dev = 0, cus = 0, per_cu = 0;
    (void)hipGetDevice(&dev);
    (void)hipDeviceGetAttribute(&cus, hipDeviceAttributeMultiprocessorCount, dev);
    (void)hipOccupancyMaxActiveBlocksPerMultiprocessor(&per_cu, mega, 256, 0);
    if (per_cu > 2) per_cu = 2;
    if (per_cu < 1) per_cu = 1;
    grid_blocks = cus * per_cu;
  }
  Params p{};
  const float* const* in = (const float* const*)d_in;
  p.x_prompt = in[0]; p.x_sample = in[1]; p.state_delta = in[2]; p.state_conv = in[3]; p.cw1 = in[4]; p.cw2 = in[5]; p.cw3 = in[6];
  p.cache_mem = in[7]; p.mem_prompt = in[8]; p.g_mix = in[9]; p.w_in = in[10]; p.conv_w = in[11]; p.a_log = in[12]; p.dt_bias = in[13];
  p.g_onorm = in[14]; p.w_out = in[15]; p.g_memq = in[16]; p.g_memkv = in[17]; p.w_mq = in[18]; p.w_mkv = in[19]; p.w_mo = in[20];
  p.g_ffn = in[21]; p.w_pq = in[22]; p.sub_keys = in[23]; p.expert_u = in[24]; p.expert_v = in[25]; p.g_final = in[26];
  p.out = (float*)d_out;
  char* ws = (char*)d_ws;
  size_t off = 0;
  auto take = [&](size_t bytes) { char* r = ws + off; off += (bytes + 255) & ~(size_t)255; return r; };
  p.WtIn = (u16*)take((size_t)NP * 1024 * 2);
  p.WtOut = (u16*)take((size_t)1024 * 768 * 2);
  p.WtMq = (u16*)take((size_t)1024 * 1024 * 2);
  p.WtMkv = (u16*)take((size_t)2048 * 1024 * 2);
  p.WtMo = (u16*)take((size_t)1024 * 1024 * 2);
  p.WtPq = (u16*)take((size_t)2048 * 1024 * 2);
  p.subkb = (u16*)take((size_t)262144 * 2);
  p.E8 = (unsigned char*)take((size_t)32768 * 1024);
  p.rs = (float*)take((size_t)32768 * 4);
  p.Amem = (u16*)take((size_t)1024 * 1024 * 2);
  p.gb = (float*)take((size_t)MT * 8 * 4);
  p.ssq1 = (float*)take((size_t)MT * 4);
  p.ssq2 = (float*)take((size_t)MT * 4);
  p.dl = (float*)take(2048 * 4);
  p.Kb = (u16*)take((size_t)16 * 65536 * 2);
  p.VTf = (u16*)take((size_t)16 * 65536 * 2);
  char* regA = take((size_t)MT * NP * 2);
  char* regB = take((size_t)2048 * DN_ITEM);
  p.proj = (u16*)regA;
  p.h1 = (float*)regA;
  p.h2 = (float*)(regA + (size_t)MT * 1024 * 4);
  p.pq = (u16*)regA;
  p.dnops = regB;
  p.A0 = (u16*)regB;
  p.A1 = (u16*)regB;
  p.qb = (u16*)(regB + (size_t)MT * 1024 * 2);
  p.attn = (u16*)regB;
  p.A2 = (u16*)(regB + (size_t)MT * 1024 * 2);
  p.eid = (int*)regB;
  p.gate = (float*)(regB + (size_t)MT * 128 * 4);
  char* ob = (char*)d_out;
  p.vT = (u16*)ob;
  p.osw = (u16*)(ob + (size_t)3 * MP * 256 * 2);
  p.lse = (float*)(ob + (size_t)3 * MP * 256 * 2 + (size_t)3 * MT * 256 * 2);
  char* sb = ob + O_SW3 * 4;
  p.odn = (u16*)sb;
  p.Amix = (u16*)(sb + (size_t)MT * 512 * 2);
  if (off > ws_size) { fprintf(stderr, "workspace too small: need %zu have %zu\n", off, ws_size); return; }
  void* args[] = {&p};
  hipError_t e = hipLaunchCooperativeKernel((void*)mega, dim3(grid_blocks), dim3(256), args, 0, stream);
  if (e != hipSuccess) fprintf(stderr, "coop launch failed: %s (grid %d)\n", hipGetErrorString(e), grid_blocks);
}
```

```cpp
#include <hip/hip_runtime.h>
#include <hip/hip_cooperative_groups.h>
#include <cstdio>
namespace cg = cooperative_groups;

typedef unsigned short u16;
typedef __attribute__((ext_vector_type(8))) short bf16x8;
typedef __attribute__((ext_vector_type(4))) float f32x4;
typedef __attribute__((ext_vector_type(2))) __bf16 bf2_t;

#define DI __device__ __forceinline__
#define MFMA(a, b, c) __builtin_amdgcn_mfma_f32_16x16x32_bf16((a), (b), (c), 0, 0, 0)

constexpr int MP = 32768, MS = 128, MT = 32896;
constexpr int NP = 4352;
constexpr int SEQ = 8192;
constexpr float EPS = 1e-6f;
constexpr size_t DN_ITEM = 73728;

constexpr size_t O_YP = 0, O_YS = 33554432, O_PDELTA = 33685504, O_PCONV = 33947648, O_PW1 = 33966080,
                 O_PW2 = 34228224, O_PW3 = 35276800, O_PMEM = 39471104, O_SDELTA = 41568256, O_SCONV = 43665408,
                 O_SW1 = 43812864, O_SW2 = 45910016, O_SW3 = 54298624;

struct Params {
  const float *x_prompt, *x_sample, *state_delta, *state_conv, *cw1, *cw2, *cw3, *cache_mem, *mem_prompt;
  const float *g_mix, *w_in, *conv_w, *a_log, *dt_bias, *g_onorm, *w_out, *g_memq, *g_memkv, *w_mq, *w_mkv, *w_mo;
  const float *g_ffn, *w_pq, *sub_keys, *expert_u, *expert_v, *g_final;
  float* out;
  u16 *WtIn, *WtOut, *WtMq, *WtMkv, *WtMo, *WtPq, *subkb, *Amem;
  unsigned char* E8;
  float* rs;
  float *gb, *ssq1, *ssq2, *dl;
  u16 *Kb, *VTf;
  u16* proj;
  float *h1, *h2;
  u16* pq;
  char* dnops;
  u16 *A0, *A1, *qb, *attn, *A2;
  int* eid;
  float* gate;
  u16 *vT, *osw, *odn, *Amix;
  float* lse;
};

#define AS1 __attribute__((address_space(1)))
template <typename T> DI T* G(T* q) { return q; }
typedef const bf16x8 AS1* gb8p;
typedef const u16 AS1* gu16p;
typedef __attribute__((ext_vector_type(4))) unsigned u32x4;
DI u16 f2bf(float x) { unsigned u = __float_as_uint(x); u += 0x7fffu + ((u >> 16) & 1u); return (u16)(u >> 16); }
DI float bf2f(u16 h) { return __uint_as_float(((unsigned)h) << 16); }
DI unsigned pack2(float a, float b) { return (unsigned)f2bf(a) | ((unsigned)f2bf(b) << 16); }
DI float bflo(unsigned d) { return __uint_as_float(d << 16); }
DI float bfhi(unsigned d) { return __uint_as_float(d & 0xffff0000u); }
DI bf16x8 pack8(f32x4 a, f32x4 b) {
  uint4 r; r.x = pack2(a[0], a[1]); r.y = pack2(a[2], a[3]); r.z = pack2(b[0], b[1]); r.w = pack2(b[2], b[3]);
  return __builtin_bit_cast(bf16x8, r);
}
DI float wave_sum(float v) {
#pragma unroll
  for (int o = 32; o > 0; o >>= 1) v += __shfl_xor(v, o);
  return v;
}
DI float wave_max(float v) {
#pragma unroll
  for (int o = 32; o > 0; o >>= 1) v = fmaxf(v, __shfl_xor(v, o));
  return v;
}
DI float siluf(float x) { return x / (1.f + __expf(-x)); }
DI float geluf(float x) { return 0.5f * x * (1.f + tanhf(0.7978845608028654f * (x + 0.044715f * x * x * x))); }
DI int permk(int kg, int j) { return (j < 4) ? (kg * 4 + j) : (16 + kg * 4 + (j - 4)); }
DI void cvt8(const float* __restrict__ s, u16* __restrict__ d) {
  float4 a = *(const float4*)s, b = *(const float4*)(s + 4);
  uint4 r; r.x = pack2(a.x, a.y); r.y = pack2(a.z, a.w); r.z = pack2(b.x, b.y); r.w = pack2(b.z, b.w);
  *(uint4*)d = r;
}
DI unsigned ordf(float f) { unsigned u = __float_as_uint(f); return (u & 0x80000000u) ? ~u : (u | 0x80000000u); }
DI float unordf(unsigned k) { unsigned u = (k & 0x80000000u) ? (k & 0x7fffffffu) : ~k; return __uint_as_float(u); }
DI unsigned umax(unsigned a, unsigned b) { return a > b ? a : b; }
template <typename T> DI T sel4(int L, T a, T b, T c, T d) { return L == 0 ? a : (L == 1 ? b : (L == 2 ? c : d)); }

#define AS3 __attribute__((address_space(3)))
template <int MODE, int K>
DI void gemm_tile(const Params& p, const u16* __restrict__ A, int lda, const u16* __restrict__ Bt, int tm, int tn,
                          char* smem) {
  const int tid = threadIdx.x, lane = tid & 63, w = tid >> 6;
  const int wm = w >> 1, wn = w & 1, r = lane & 15, kg = lane >> 4;
  f32x4 acc[4][4];
#pragma unroll
  for (int i = 0; i < 4; ++i)
#pragma unroll
    for (int j = 0; j < 4; ++j) acc[i][j] = (f32x4){0.f, 0.f, 0.f, 0.f};
  const int lr = lane >> 2, lkg = (lane & 3) ^ (lane >> 4);
  gu16p gA[4], gB[4];
#pragma unroll
  for (int i = 0; i < 4; ++i) {
    const int sub = w * 4 + i, mt = sub >> 1, ks = sub & 1;
    gA[i] = (gu16p)A + (size_t)(tm * 128 + mt * 16 + lr) * lda + ks * 32 + lkg * 8;
    gB[i] = (gu16p)Bt + (size_t)(tn * 128 + mt * 16 + lr) * K + ks * 32 + lkg * 8;
  }
  const int frag_off = r * 64 + ((kg ^ (r >> 2)) * 16);
  __syncthreads();
#pragma unroll
  for (int i = 0; i < 4; ++i) {
    __builtin_amdgcn_global_load_lds((const unsigned AS1*)(gA[i]), (unsigned AS3*)(smem + (w * 4 + i) * 1024), 16, 0, 0);
    __builtin_amdgcn_global_load_lds((const unsigned AS1*)(gB[i]), (unsigned AS3*)(smem + 16384 + (w * 4 + i) * 1024), 16, 0, 0);
  }
#pragma unroll 2
  for (int k = 0; k < K / 64; ++k) {
    __syncthreads();
    if (k + 1 < K / 64) {
      char* st = smem + ((k + 1) & 1) * 32768;
#pragma unroll
      for (int i = 0; i < 4; ++i) {
        __builtin_amdgcn_global_load_lds((const unsigned AS1*)(gA[i] + (k + 1) * 64), (unsigned AS3*)(st + (w * 4 + i) * 1024), 16, 0, 0);
        __builtin_amdgcn_global_load_lds((const unsigned AS1*)(gB[i] + (k + 1) * 64), (unsigned AS3*)(st + 16384 + (w * 4 + i) * 1024), 16, 0, 0);
      }
    }
    const char* sa = smem + (k & 1) * 32768;
    const char* sb = sa + 16384;
#pragma unroll
    for (int ks = 0; ks < 2; ++ks) {
      bf16x8 af[4], bfr[4];
#pragma unroll
      for (int i = 0; i < 4; ++i) {
        af[i] = *(const bf16x8*)(sa + ((wm * 4 + i) * 2 + ks) * 1024 + frag_off);
        bfr[i] = *(const bf16x8*)(sb + ((wn * 4 + i) * 2 + ks) * 1024 + frag_off);
      }
#pragma unroll
      for (int mt = 0; mt < 4; ++mt)
#pragma unroll
        for (int nt = 0; nt < 4; ++nt) acc[mt][nt] = MFMA(bfr[nt], af[mt], acc[mt][nt]);
    }
  }
#pragma unroll
  for (int mt = 0; mt < 4; ++mt) {
    const int row = tm * 128 + wm * 64 + mt * 16 + r;
    float rs = 1.f, ssq = 0.f;
    if (MODE == 3) rs = rsqrtf(p.ssq1[row] * (1.f / 1024.f) + EPS);
    if (MODE == 5) rs = rsqrtf(p.ssq2[row] * (1.f / 1024.f) + EPS);
#pragma unroll
    for (int nt = 0; nt < 4; ++nt) {
      const int col = tn * 128 + wn * 64 + nt * 16 + kg * 4;
      f32x4 v = acc[mt][nt];
      if (MODE == 0) {
        uint2 o; o.x = pack2(v[0], v[1]); o.y = pack2(v[2], v[3]);
        *(uint2*)&p.proj[(size_t)row * NP + col] = o;
      } else if (MODE == 1) {
        *(float4*)&p.out[O_PMEM + (size_t)row * 2048 + col] = make_float4(v[0], v[1], v[2], v[3]);
      } else if (MODE == 2 || MODE == 4) {
        float4 rsd;
        const float* gn;
        if (MODE == 2) {
          rsd = (row < MP) ? *(const float4*)&p.x_prompt[(size_t)row * 1024 + col] : *(const float4*)&p.x_sample[(size_t)(row - MP) * 1024 + col];
          gn = p.g_memq;
        } else {
          rsd = *(const float4*)&p.h1[(size_t)row * 1024 + col];
          gn = p.g_ffn;
        }
        float4 h = make_float4(rsd.x + v[0], rsd.y + v[1], rsd.z + v[2], rsd.w + v[3]);
        float4 g4 = *(const float4*)&gn[col];
        ssq += h.x * h.x + h.y * h.y + h.z * h.z + h.w * h.w;
        uint2 o; o.x = pack2(h.x * g4.x, h.y * g4.y); o.y = pack2(h.z * g4.z, h.w * g4.w);
        if (MODE == 2) { *(float4*)&p.h1[(size_t)row * 1024 + col] = h; *(uint2*)&p.A1[(size_t)row * 1024 + col] = o; }
        else { *(float4*)&p.h2[(size_t)row * 1024 + col] = h; *(uint2*)&p.A2[(size_t)row * 1024 + col] = o; }
      } else if (MODE == 3) {
        uint2 o; o.x = pack2(v[0] * rs, v[1] * rs); o.y = pack2(v[2] * rs, v[3] * rs);
        *(uint2*)&p.qb[(size_t)row * 1024 + col] = o;
      } else {
        uint2 o; o.x = pack2(v[0] * rs, v[1] * rs); o.y = pack2(v[2] * rs, v[3] * rs);
        *(uint2*)&p.pq[(size_t)row * 2048 + col] = o;
      }
    }
    if (MODE == 2 || MODE == 4) {
      ssq += __shfl_xor(ssq, 16);
      ssq += __shfl_xor(ssq, 32);
      if (kg == 0) atomicAdd((MODE == 2) ? &p.ssq1[row] : &p.ssq2[row], ssq);
    }
  }
}

DI bool xcd_tile(int it, int nM, int nN, int& tm, int& tn) {
  const int per = gridDim.x >> 3;
  const int xcd = blockIdx.x & 7, li = blockIdx.x >> 3;
  const int i = (it * 8 + xcd) * per + li;
  if (i >= nM * nN) return false;
  const int panel = i / (8 * nN), within = i - panel * 8 * nN;
  const int rows = (nM - panel * 8) < 8 ? (nM - panel * 8) : 8;
  tn = within / rows;
  tm = panel * 8 + (within - tn * rows);
  return true;
}

DI void tr_tile(const float* __restrict__ W, int ldw, int nsrc0, u16* __restrict__ Wt, int K, int k0, int n0, float* tile) {
  const int tid = threadIdx.x;
  const int n = tid & 63, kq = tid >> 6;
  __syncthreads();
#pragma unroll
  for (int i = 0; i < 16; ++i) { int kk = kq + 4 * i; tile[kk * 65 + n] = W[(size_t)(k0 + kk) * ldw + nsrc0 + n]; }
  __syncthreads();
  const int nn = tid >> 2, ks = (tid & 3) * 16;
  unsigned o[8];
#pragma unroll
  for (int i = 0; i < 8; ++i) o[i] = pack2(tile[(ks + 2 * i) * 65 + nn], tile[(ks + 2 * i + 1) * 65 + nn]);
  u16* d = Wt + (size_t)(n0 + nn) * K + k0 + ks;
  *(uint4*)d = make_uint4(o[0], o[1], o[2], o[3]);
  *(uint4*)(d + 8) = make_uint4(o[4], o[5], o[6], o[7]);
}

DI void phase0(const Params& p, char* smem) {
  const int tid = threadIdx.x, lane = tid & 63, w = tid >> 6;
  const size_t gtid = (size_t)blockIdx.x * 256 + tid, gsz = (size_t)gridDim.x * 256;
  {
    const float* eu = p.expert_u;
    const float* ev = p.expert_v;
    unsigned char* e8 = p.E8;
    float* rsp = p.rs;
    for (int er = blockIdx.x * 4 + w; er < 32768; er += gridDim.x * 4) {
      const float* src = (er < 16384) ? (eu + (size_t)er * 1024) : (ev + (size_t)(er - 16384) * 1024);
      float4 v[4];
      float am = 0.f;
#pragma unroll
      for (int i = 0; i < 4; ++i) {
        v[i] = *(const float4*)&src[lane * 16 + i * 4];
        am = fmaxf(am, fmaxf(fmaxf(fabsf(v[i].x), fabsf(v[i].y)), fmaxf(fabsf(v[i].z), fabsf(v[i].w))));
      }
      am = wave_max(am);
      const float sc = (am > 0.f) ? 224.f / am : 1.f;
      int o[4];
#pragma unroll
      for (int i = 0; i < 4; ++i) {
        int t = __builtin_amdgcn_cvt_pk_fp8_f32(v[i].x * sc, v[i].y * sc, 0, false);
        o[i] = __builtin_amdgcn_cvt_pk_fp8_f32(v[i].z * sc, v[i].w * sc, t, true);
      }
      *(uint4*)&e8[(size_t)er * 1024 + lane * 16] = make_uint4((unsigned)o[0], (unsigned)o[1], (unsigned)o[2], (unsigned)o[3]);
      if (lane == 0) rsp[er] = (am > 0.f) ? am * (1.f / 224.f) : 1.f;
    }
  }
  for (size_t i = gtid; i < 262144 / 8; i += gsz) cvt8(p.sub_keys + i * 8, p.subkb + i * 8);
  for (size_t i = gtid; i < MT; i += gsz) { p.ssq1[i] = 0.f; p.ssq2[i] = 0.f; }
  float* wl = (float*)smem;
  __syncthreads();
  for (int i = tid; i < 2048; i += 256) {
    const int k = i >> 1, hf = i & 1;
    float4 t = *(const float4*)&p.w_in[(size_t)k * 4360 + 1536 + hf * 4];
    wl[(hf * 4 + 0) * 1024 + k] = t.x; wl[(hf * 4 + 1) * 1024 + k] = t.y; wl[(hf * 4 + 2) * 1024 + k] = t.z; wl[(hf * 4 + 3) * 1024 + k] = t.w;
  }
  __syncthreads();
  const float* xpp = p.x_prompt;
  const float* xsp = p.x_sample;
  const float* mpp = p.mem_prompt;
  const float* gmx = p.g_mix;
  const float* gmk = p.g_memkv;
  u16* a0p = p.A0;
  u16* amp = p.Amem;
  for (int row = blockIdx.x * 4 + w; row < MT + 1024; row += gridDim.x * 4) {
    const float* src; const float* g; u16* dst;
    if (row < MP) { src = xpp + (size_t)row * 1024; g = gmx; dst = a0p + (size_t)row * 1024; }
    else if (row < MT) { src = xsp + (size_t)(row - MP) * 1024; g = gmx; dst = a0p + (size_t)row * 1024; }
    else { src = mpp + (size_t)(row - MT) * 1024; g = gmk; dst = amp + (size_t)(row - MT) * 1024; }
    float4 v[4];
    float ss = 0.f;
#pragma unroll
    for (int i = 0; i < 4; ++i) { v[i] = *(const float4*)&src[lane * 4 + i * 256]; ss += v[i].x * v[i].x + v[i].y * v[i].y + v[i].z * v[i].z + v[i].w * v[i].w; }
    ss = wave_sum(ss);
    const float rs = rsqrtf(ss * (1.f / 1024.f) + EPS);
    float d8[8] = {0.f, 0.f, 0.f, 0.f, 0.f, 0.f, 0.f, 0.f};
#pragma unroll
    for (int i = 0; i < 4; ++i) {
      float4 g4 = *(const float4*)&g[lane * 4 + i * 256];
      float y[4] = {v[i].x * rs * g4.x, v[i].y * rs * g4.y, v[i].z * rs * g4.z, v[i].w * rs * g4.w};
      uint2 o; o.x = pack2(y[0], y[1]); o.y = pack2(y[2], y[3]);
      *(uint2*)&dst[lane * 4 + i * 256] = o;
      if (row < MT) {
#pragma unroll
        for (int j = 0; j < 8; ++j) {
          float4 wv = *(const float4*)&wl[j * 1024 + i * 256 + lane * 4];
          d8[j] += y[0] * wv.x + y[1] * wv.y + y[2] * wv.z + y[3] * wv.w;
        }
      }
    }
    if (row < MT) {
#pragma unroll
      for (int j = 0; j < 8; ++j) d8[j] = wave_sum(d8[j]);
      if (lane < 4) {
        float ag = sel4(lane, d8[0], d8[1], d8[2], d8[3]);
        float bg = sel4(lane, d8[4], d8[5], d8[6], d8[7]);
        float xs = ag + p.dt_bias[lane];
        float sp = (xs > 20.f) ? xs : log1pf(expf(xs));
        p.gb[(size_t)row * 8 + lane] = -expf(p.a_log[lane]) * sp;
        p.gb[(size_t)row * 8 + 4 + lane] = 1.f / (1.f + expf(-bg));
      }
    }
  }
  __syncthreads();
  float* tile = (float*)smem;
  for (int j = blockIdx.x; j < 2816; j += gridDim.x) {
    int t = j;
    if (t < 1088) { int kt = t / 68, nt = t % 68; int n0 = nt * 64; tr_tile(p.w_in, 4360, n0 + (n0 >= 1536 ? 8 : 0), p.WtIn, 1024, kt * 64, n0, tile); continue; }
    t -= 1088;
    if (t < 192) { int kt = t / 16, nt = t % 16; tr_tile(p.w_out, 1024, nt * 64, p.WtOut, 768, kt * 64, nt * 64, tile); continue; }
    t -= 192;
    if (t < 256) { int kt = t / 16, nt = t % 16; tr_tile(p.w_mq, 1024, nt * 64, p.WtMq, 1024, kt * 64, nt * 64, tile); continue; }
    t -= 256;
    if (t < 512) { int kt = t / 32, nt = t % 32; tr_tile(p.w_mkv, 2048, nt * 64, p.WtMkv, 1024, kt * 64, nt * 64, tile); continue; }
    t -= 512;
    if (t < 256) { int kt = t / 16, nt = t % 16; tr_tile(p.w_mo, 1024, nt * 64, p.WtMo, 1024, kt * 64, nt * 64, tile); continue; }
    t -= 256;
    { int kt = t / 32, nt = t % 32; tr_tile(p.w_pq, 2048, nt * 64, p.WtPq, 1024, kt * 64, nt * 64, tile); }
  }
}

DI void dn_prep(const Params& p, int item, char* smem) {
  u16* qs = (u16*)smem;
  u16* ksm = qs + 64 * 136;
  float* sL = (float*)(ksm + 64 * 136);
  float* sgc = sL + 64 * 64;
  float* sbeta = sgc + 64;
  u16* sU = (u16*)sL;
  u16* sW = qs;
  const int tid = threadIdx.x, lane = tid & 63, w = tid >> 6, r = lane & 15, kg = lane >> 4;
  const int bh = item >> 7, n = item & 127, b = bh >> 2, h = bh & 3;
  const int t0 = n * 64;
  const size_t rowbase = (size_t)b * SEQ;
  char* ops = p.dnops + (size_t)item * DN_ITEM;
  __syncthreads();
  if (tid < 64) {
    float gv = p.gb[(rowbase + t0 + tid) * 8 + h];
    float bv = p.gb[(rowbase + t0 + tid) * 8 + 4 + h];
#pragma unroll
    for (int o = 1; o < 64; o <<= 1) { float t = __shfl_up(gv, o); if (lane >= o) gv += t; }
    sgc[tid] = gv; sbeta[tid] = bv;
    if (tid == 63) p.dl[item] = __expf(gv);
  }
#pragma unroll 4
  for (int ps = 0; ps < 8; ++ps) {
    const int combo = ps * 16 + (tid >> 4);
    const int tt = combo & 63, part = combo >> 6, sub = tid & 15;
    const int col = part * 512 + h * 128 + sub * 8;
    float y[8] = {0.f, 0.f, 0.f, 0.f, 0.f, 0.f, 0.f, 0.f};
#pragma unroll
    for (int j = 0; j < 4; ++j) {
      const int t = t0 + tt - 3 + j;
      if (t >= 0) {
        uint4 xv = *(const uint4*)&p.proj[(rowbase + t) * NP + col];
        float4 wa = *(const float4*)&p.conv_w[j * 1536 + col], wb = *(const float4*)&p.conv_w[j * 1536 + col + 4];
        y[0] += bflo(xv.x) * wa.x; y[1] += bfhi(xv.x) * wa.y; y[2] += bflo(xv.y) * wa.z; y[3] += bfhi(xv.y) * wa.w;
        y[4] += bflo(xv.z) * wb.x; y[5] += bfhi(xv.z) * wb.y; y[6] += bflo(xv.w) * wb.z; y[7] += bfhi(xv.w) * wb.w;
      }
    }
    float ss = 0.f;
#pragma unroll
    for (int e = 0; e < 8; ++e) { y[e] = siluf(y[e]); ss += y[e] * y[e]; }
    ss += __shfl_xor(ss, 1); ss += __shfl_xor(ss, 2); ss += __shfl_xor(ss, 4); ss += __shfl_xor(ss, 8);
    float sc = rsqrtf(ss + EPS) * (part == 0 ? 0.08838834764831845f : 1.f);
    uint4 o; o.x = pack2(y[0] * sc, y[1] * sc); o.y = pack2(y[2] * sc, y[3] * sc); o.z = pack2(y[4] * sc, y[5] * sc); o.w = pack2(y[6] * sc, y[7] * sc);
    *(uint4*)&((part == 0 ? qs : ksm)[tt * 136 + sub * 8]) = o;
  }
  __syncthreads();
  const float gcl = sgc[63];
  {
    f32x4 aL[4], aA[4];
#pragma unroll
    for (int i = 0; i < 4; ++i) { aL[i] = (f32x4){0.f, 0.f, 0.f, 0.f}; aA[i] = (f32x4){0.f, 0.f, 0.f, 0.f}; }
#pragma unroll
    for (int ks = 0; ks < 4; ++ks) {
      bf16x8 kI = *(const bf16x8*)&ksm[(w * 16 + r) * 136 + ks * 32 + kg * 8];
      bf16x8 qI = *(const bf16x8*)&qs[(w * 16 + r) * 136 + ks * 32 + kg * 8];
#pragma unroll
      for (int nt = 0; nt < 4; ++nt) {
        bf16x8 kJ = *(const bf16x8*)&ksm[(nt * 16 + r) * 136 + ks * 32 + kg * 8];
        aL[nt] = MFMA(kJ, kI, aL[nt]);
        aA[nt] = MFMA(kJ, qI, aA[nt]);
      }
    }
    const int i = w * 16 + r;
    const float gci = sgc[i], bi = sbeta[i];
    u16* aq = (u16*)(ops + 49152);
#pragma unroll
    for (int nt = 0; nt < 4; ++nt) {
      float lv[4], av[4];
#pragma unroll
      for (int jj = 0; jj < 4; ++jj) {
        const int j = nt * 16 + kg * 4 + jj;
        const float gam = (i >= j) ? __expf(gci - sgc[j]) : 0.f;
        lv[jj] = (i > j) ? aL[nt][jj] * bi * gam : 0.f;
        av[jj] = aA[nt][jj] * gam;
      }
      *(float4*)&sL[i * 64 + nt * 16 + kg * 4] = make_float4(lv[0], lv[1], lv[2], lv[3]);
      uint2 o; o.x = pack2(av[0], av[1]); o.y = pack2(av[2], av[3]);
      *(uint2*)&aq[((w * 2 + (nt >> 1)) * 64 + lane) * 8 + (nt & 1) * 4] = o;
    }
  }
  {
    u16* qg = (u16*)(ops + 16384);
    u16* kdT = (u16*)(ops + 32768);
#pragma unroll 1
    for (int i = 0; i < 4; ++i) {
      const int f = tid + 256 * i;
      const int mtks = f >> 6, l = f & 63, rr = l & 15, kgg = l >> 4;
      {
        const int mt = mtks >> 2, ks = mtks & 3, row = mt * 16 + rr;
        const float e = __expf(sgc[row]);
        uint2 a = *(const uint2*)&qs[row * 136 + ks * 32 + kgg * 4];
        uint2 c = *(const uint2*)&qs[row * 136 + ks * 32 + 16 + kgg * 4];
        uint4 o;
        o.x = pack2(bflo(a.x) * e, bfhi(a.x) * e); o.y = pack2(bflo(a.y) * e, bfhi(a.y) * e);
        o.z = pack2(bflo(c.x) * e, bfhi(c.x) * e); o.w = pack2(bflo(c.y) * e, bfhi(c.y) * e);
        *(uint4*)&qg[(size_t)f * 8] = o;
      }
      {
        const int mt = mtks >> 1, ks = mtks & 1, kdim = mt * 16 + rr;
        float v[8];
#pragma unroll
        for (int j = 0; j < 8; ++j) {
          const int c = ks * 32 + permk(kgg, j);
          v[j] = bf2f(ksm[c * 136 + kdim]) * __expf(gcl - sgc[c]);
        }
        uint4 o; o.x = pack2(v[0], v[1]); o.y = pack2(v[2], v[3]); o.z = pack2(v[4], v[5]); o.w = pack2(v[6], v[7]);
        *(uint4*)&kdT[(size_t)f * 8] = o;
      }
    }
  }
  __syncthreads();
  float x[64];
  if (tid < 128) {
    const int col = 1024 + h * 128 + tid;
    const float w0 = p.conv_w[col], w1 = p.conv_w[1536 + col], w2 = p.conv_w[3072 + col], w3 = p.conv_w[4608 + col];
    float xm3 = 0.f, xm2 = 0.f, xm1 = 0.f;
    if (t0 > 0) {
      xm3 = bf2f(p.proj[(rowbase + t0 - 3) * NP + col]);
      xm2 = bf2f(p.proj[(rowbase + t0 - 2) * NP + col]);
      xm1 = bf2f(p.proj[(rowbase + t0 - 1) * NP + col]);
    }
#pragma unroll
    for (int t = 0; t < 64; ++t) {
      float xc = bf2f(p.proj[(rowbase + t0 + t) * NP + col]);
      float yv = w0 * xm3 + w1 * xm2 + w2 * xm1 + w3 * xc;
      x[t] = siluf(yv) * sbeta[t];
      xm3 = xm2; xm2 = xm1; xm1 = xc;
    }
  } else {
    const int kc = tid - 128;
#pragma unroll
    for (int t = 0; t < 64; ++t) x[t] = bf2f(ksm[t * 136 + kc]) * sbeta[t] * __expf(sgc[t]);
  }
#pragma unroll
  for (int i = 1; i < 64; ++i) {
    float s = x[i];
#pragma unroll
    for (int j4 = 0; j4 < (i + 3) / 4; ++j4) {
      float4 l = *(const float4*)&sL[i * 64 + j4 * 4];
      s -= l.x * x[j4 * 4];
      if (j4 * 4 + 1 < i) s -= l.y * x[j4 * 4 + 1];
      if (j4 * 4 + 2 < i) s -= l.z * x[j4 * 4 + 2];
      if (j4 * 4 + 3 < i) s -= l.w * x[j4 * 4 + 3];
    }
    x[i] = s;
  }
  __syncthreads();
  if (tid < 128) {
#pragma unroll
    for (int t = 0; t < 64; ++t) sU[t * 128 + tid] = f2bf(x[t]);
  } else {
    const int kc = tid - 128;
#pragma unroll
    for (int t = 0; t < 64; ++t) sW[t * 136 + kc] = f2bf(-x[t]);
  }
  __syncthreads();
  {
    u16* nW = (u16*)ops;
    u16* u0 = (u16*)(ops + 57344);
#pragma unroll 1
    for (int i = 0; i < 4; ++i) {
      const int f = tid + 256 * i;
      const int mtks = f >> 6, l = f & 63, rr = l & 15, kgg = l >> 4;
      const int mt = mtks >> 2, ks = mtks & 3, row = mt * 16 + rr;
      uint2 a = *(const uint2*)&sW[row * 136 + ks * 32 + kgg * 4];
      uint2 c = *(const uint2*)&sW[row * 136 + ks * 32 + 16 + kgg * 4];
      *(uint4*)&nW[(size_t)f * 8] = make_uint4(a.x, a.y, c.x, c.y);
    }
#pragma unroll 1
    for (int i = 0; i < 8; ++i) {
      const int f = tid + 256 * i;
      const int smt = f >> 6, l = f & 63, rr = l & 15, kgg = l >> 4;
      const int s = smt >> 2, mt = smt & 3;
      u16 v0 = sU[(mt * 16 + kgg * 4 + 0) * 128 + s * 16 + rr];
      u16 v1 = sU[(mt * 16 + kgg * 4 + 1) * 128 + s * 16 + rr];
      u16 v2 = sU[(mt * 16 + kgg * 4 + 2) * 128 + s * 16 + rr];
      u16 v3 = sU[(mt * 16 + kgg * 4 + 3) * 128 + s * 16 + rr];
      *(uint2*)&u0[(size_t)f * 4] = make_uint2((unsigned)v0 | ((unsigned)v1 << 16), (unsigned)v2 | ((unsigned)v3 << 16));
    }
  }
}

DI void vt_tile(const Params& p, int item, char* smem) {
  u16* tile = (u16*)smem;
  const int tid = threadIdx.x;
  const int ptile = item & 127, gbh = item >> 7;
  const int h = gbh & 3, b = (gbh >> 2) & 3, g = gbh >> 4;
  const int dsh = g * 2, ln = SEQ >> dsh;
  const int pos0 = ptile * 64;
  const int rres = pos0 / ln, i0 = pos0 % ln;
  __syncthreads();
  {
    const int pr = tid >> 2, seg = (tid & 3) * 16;
    const int token = ((i0 + pr) << dsh) + rres;
    const u16* src = &p.proj[((size_t)b * SEQ + token) * NP + 2048 + g * 768 + 512 + h * 64 + seg];
    uint4 a = *(const uint4*)src, c = *(const uint4*)(src + 8);
    unsigned d[8] = {a.x, a.y, a.z, a.w, c.x, c.y, c.z, c.w};
#pragma unroll
    for (int e = 0; e < 8; ++e) *(unsigned*)&tile[pr * 66 + seg + e * 2] = d[e];
  }
  __syncthreads();
  {
    const int dh = tid >> 2, seg = (tid & 3) * 16;
    unsigned o[8];
#pragma unroll
    for (int e = 0; e < 8; ++e) o[e] = (unsigned)tile[(seg + 2 * e) * 66 + dh] | ((unsigned)tile[(seg + 2 * e + 1) * 66 + dh] << 16);
    u16* d = &p.vT[((size_t)gbh * 64 + dh) * SEQ + pos0 + seg];
    *(uint4*)d = make_uint4(o[0], o[1], o[2], o[3]);
    *(uint4*)(d + 8) = make_uint4(o[4], o[5], o[6], o[7]);
  }
}

DI void dn_sample(const Params& p, int item, char* smem) {
  float* sq = (float*)smem;
  float* sk = sq + 512;
  float* sv = sk + 512;
  float* red = sv + 512;
  const int tid = threadIdx.x, lane = tid & 63, w = tid >> 6;
  const int b = item >> 2, h = item & 3;
  __syncthreads();
  for (int c = tid; c < 384; c += 256) {
    const int part = c >> 7, cc = c & 127;
    const int col = part * 512 + h * 128 + cc;
    float xp[7];
#pragma unroll
    for (int j = 0; j < 3; ++j) xp[j] = p.state_conv[((size_t)b * 3 + j) * 1536 + col];
#pragma unroll
    for (int j = 0; j < 4; ++j) xp[3 + j] = bf2f(p.proj[((size_t)MP + b * 4 + j) * NP + col]);
    const float w0 = p.conv_w[col], w1 = p.conv_w[1536 + col], w2 = p.conv_w[3072 + col], w3 = p.conv_w[4608 + col];
    float* dst = part == 0 ? sq : (part == 1 ? sk : sv);
#pragma unroll
    for (int t = 0; t < 4; ++t) dst[t * 128 + cc] = siluf(w0 * xp[t] + w1 * xp[t + 1] + w2 * xp[t + 2] + w3 * xp[t + 3]);
  }
  __syncthreads();
  {
    float a0 = sq[w * 128 + lane], a1 = sq[w * 128 + 64 + lane];
    float s = wave_sum(a0 * a0 + a1 * a1);
    float sc = rsqrtf(s + EPS) * 0.08838834764831845f;
    sq[w * 128 + lane] = a0 * sc; sq[w * 128 + 64 + lane] = a1 * sc;
    float b0 = sk[w * 128 + lane], b1 = sk[w * 128 + 64 + lane];
    s = wave_sum(b0 * b0 + b1 * b1);
    sc = rsqrtf(s + EPS);
    sk[w * 128 + lane] = b0 * sc; sk[w * 128 + 64 + lane] = b1 * sc;
  }
  __syncthreads();
  const int v = tid & 127, half = tid >> 7;
  float S[64];
  const float* s0 = p.state_delta + (((size_t)b * 4 + h) * 128 + half * 64) * 128 + v;
#pragma unroll
  for (int i = 0; i < 64; ++i) S[i] = s0[(size_t)i * 128];
#pragma unroll 1
  for (int t = 0; t < 4; ++t) {
    const size_t row = (size_t)MP + b * 4 + t;
    const float a = __expf(p.gb[row * 8 + h]);
    const float beta = p.gb[row * 8 + 4 + h];
    float part = 0.f;
#pragma unroll
    for (int i = 0; i < 64; ++i) part += S[i] * sk[t * 128 + half * 64 + i];
    red[half * 128 + v] = part;
    __syncthreads();
    const float kS = red[v] + red[128 + v];
    const float u = beta * (sv[t * 128 + v] - a * kS);
    float po = 0.f;
#pragma unroll
    for (int i = 0; i < 64; ++i) { S[i] = a * S[i] + sk[t * 128 + half * 64 + i] * u; po += S[i] * sq[t * 128 + half * 64 + i]; }
    __syncthreads();
    red[half * 128 + v] = po;
    __syncthreads();
    if (half == 0) p.odn[row * 512 + h * 128 + v] = f2bf(red[v] + red[128 + v]);
    __syncthreads();
  }
  float* d = p.out + O_SDELTA + (((size_t)b * 4 + h) * 128 + half * 64) * 128 + v;
#pragma unroll
  for (int i = 0; i < 64; ++i) d[(size_t)i * 128] = S[i];
}

DI void phase2(const Params& p, char* smem) {
  const size_t gtid = (size_t)blockIdx.x * 256 + threadIdx.x, gsz = (size_t)gridDim.x * 256;
  for (int j = blockIdx.x; j < 2048 + 128 + 6144; j += gridDim.x) {
    if (j < 2048) dn_prep(p, j, smem);
    else if (j < 2048 + 128) dn_sample(p, j - 2048, smem);
    else vt_tile(p, j - 2176, smem);
  }
  for (size_t f = gtid; f < (size_t)16 * 8192; f += gsz) {
    {
      const size_t e0 = f * 8;
      const int bh = (int)(e0 >> 16), key = (int)((e0 >> 8) & 255), dh = (int)(e0 & 255);
      const int b = bh >> 2, h = bh & 3;
      cvt8(p.out + O_PMEM + (((size_t)b * 256 + key) * 2 + 0) * 1024 + h * 256 + dh, p.Kb + e0);
    }
    {
      const int l = (int)(f & 63), ks = (int)((f >> 6) & 7), nt = (int)((f >> 9) & 15), bh = (int)(f >> 13);
      const int b = bh >> 2, h = bh & 3, rr = l & 15, kgg = l >> 4;
      float v[8];
#pragma unroll
      for (int j = 0; j < 8; ++j) {
        const int key = ks * 32 + permk(kgg, j);
        v[j] = p.out[O_PMEM + (((size_t)b * 256 + key) * 2 + 1) * 1024 + h * 256 + nt * 16 + rr];
      }
      *(uint4*)&p.VTf[f * 8] = make_uint4(pack2(v[0], v[1]), pack2(v[2], v[3]), pack2(v[4], v[5]), pack2(v[6], v[7]));
    }
  }
  for (size_t i = gtid; i < 18432; i += gsz) {
    const int c = (int)(i % 1536), j = (int)((i / 1536) % 3), b = (int)(i / 4608);
    p.out[O_PCONV + i] = bf2f(p.proj[((size_t)b * SEQ + SEQ - 3 + j) * NP + c]);
  }
  for (int g = 0; g < 3; ++g) {
    const int W = 128 << (2 * g);
    const size_t off = (g == 0) ? O_PW1 : (g == 1 ? O_PW2 : O_PW3);
    const size_t n4 = (size_t)4 * W * 512 / 4;
    for (size_t i = gtid; i < n4; i += gsz) {
      const size_t e0 = i * 4;
      const int e = (int)(e0 & 511), ii = (int)((e0 >> 9) % W), b = (int)((e0 >> 9) / W);
      uint2 v = *(const uint2*)&p.proj[((size_t)b * SEQ + SEQ - W + ii) * NP + 2048 + g * 768 + 256 + e];
      *(float4*)&p.out[off + e0] = make_float4(bflo(v.x), bfhi(v.x), bflo(v.y), bfhi(v.y));
    }
  }
}

typedef __attribute__((ext_vector_type(2))) unsigned u32x2;
struct ScanOps { bf16x8 nW[4]; bf16x8 qg[4]; bf16x8 aq[2]; bf16x8 kd[4]; u32x2 u0; float dl; };

DI void scan_load(const Params& p, int bh, int s, int n, int j, int lane, ScanOps& o) {
  n = n > 127 ? 127 : n;
  const char AS1* base = (const char AS1*)p.dnops + (size_t)(bh * 128 + n) * DN_ITEM;
  gb8p negW = (gb8p)base;
  gb8p qg = (gb8p)(base + 16384);
  gb8p kdT = (gb8p)(base + 32768);
  gb8p aqk = (gb8p)(base + 49152);
  const u32x2 AS1* u0 = (const u32x2 AS1*)(base + 57344);
#pragma unroll
  for (int ks = 0; ks < 4; ++ks) o.nW[ks] = negW[(j * 4 + ks) * 64 + lane];
#pragma unroll
  for (int ks = 0; ks < 4; ++ks) o.qg[ks] = qg[(j * 4 + ks) * 64 + lane];
#pragma unroll
  for (int k2 = 0; k2 < 2; ++k2) o.aq[k2] = aqk[(j * 2 + k2) * 64 + lane];
#pragma unroll
  for (int mm = 0; mm < 2; ++mm)
#pragma unroll
    for (int k2 = 0; k2 < 2; ++k2) o.kd[mm * 2 + k2] = kdT[((2 * j + mm) * 2 + k2) * 64 + lane];
  o.u0 = u0[(s * 4 + j) * 64 + lane];
  o.dl = ((const float AS1*)p.dl)[bh * 128 + n];
}

DI void scan_step(const Params& p, const ScanOps& ops, int n, int b, int h, int s, int j, int lane, f32x4& S0, f32x4& S1,
                  bf16x8* sSb, u32x2* sUb) {
  const int r = lane & 15, kg = lane >> 4;
  bf16x8 sb[4];
#pragma unroll
  for (int ks = 0; ks < 4; ++ks) sb[ks] = sSb[ks * 64 + lane];
  f32x4 u = (f32x4){bflo(ops.u0[0]), bfhi(ops.u0[0]), bflo(ops.u0[1]), bfhi(ops.u0[1])};
#pragma unroll
  for (int ks = 0; ks < 4; ++ks) u = MFMA(ops.nW[ks], sb[ks], u);
  {
    u32x2 t; t[0] = pack2(u[0], u[1]); t[1] = pack2(u[2], u[3]);
    sUb[((j >> 1) * 64 + lane) * 2 + (j & 1)] = t;
  }
  __syncthreads();
  bf16x8 ub[2];
#pragma unroll
  for (int k2 = 0; k2 < 2; ++k2) ub[k2] = *(const bf16x8*)&sUb[(k2 * 64 + lane) * 2];
  f32x4 o = (f32x4){0.f, 0.f, 0.f, 0.f};
#pragma unroll
  for (int ks = 0; ks < 4; ++ks) o = MFMA(ops.qg[ks], sb[ks], o);
#pragma unroll
  for (int k2 = 0; k2 < 2; ++k2) o = MFMA(ops.aq[k2], ub[k2], o);
  S0 = S0 * ops.dl; S1 = S1 * ops.dl;
#pragma unroll
  for (int k2 = 0; k2 < 2; ++k2) { S0 = MFMA(ops.kd[k2], ub[k2], S0); S1 = MFMA(ops.kd[2 + k2], ub[k2], S1); }
  sSb[j * 64 + lane] = pack8(S0, S1);
#pragma unroll
  for (int jj = 0; jj < 4; ++jj) {
    const size_t token = (size_t)b * SEQ + n * 64 + j * 16 + kg * 4 + jj;
    G(p.odn)[token * 512 + h * 128 + s * 16 + r] = f2bf(o[jj]);
  }
  __syncthreads();
}

DI void dn_scan_block(const Params& p, int item, char* smem) {
  const int lane = threadIdx.x & 63, j = threadIdx.x >> 6, r = lane & 15, kg = lane >> 4;
  const int bh = item >> 3, s = item & 7, b = bh >> 2, h = bh & 3;
  bf16x8* sSb = (bf16x8*)smem;
  u32x2* sUb = (u32x2*)(smem + 4096);
  f32x4 S0 = (f32x4){0.f, 0.f, 0.f, 0.f}, S1 = (f32x4){0.f, 0.f, 0.f, 0.f};
  __syncthreads();
  sSb[j * 64 + lane] = pack8(S0, S1);
  ScanOps A, B;
  scan_load(p, bh, s, 0, j, lane, A);
  scan_load(p, bh, s, 1, j, lane, B);
  __syncthreads();
#pragma unroll 1
  for (int n0 = 0; n0 < 128; n0 += 2) {
    scan_step(p, A, n0, b, h, s, j, lane, S0, S1, sSb, sUb);
    scan_load(p, bh, s, n0 + 2, j, lane, A);
    scan_step(p, B, n0 + 1, b, h, s, j, lane, S0, S1, sSb, sUb);
    scan_load(p, bh, s, n0 + 3, j, lane, B);
  }
#pragma unroll
  for (int jj = 0; jj < 4; ++jj) {
    p.out[O_PDELTA + ((size_t)bh * 128 + 32 * j + kg * 4 + jj) * 128 + s * 16 + r] = S0[jj];
    p.out[O_PDELTA + ((size_t)bh * 128 + 32 * j + 16 + kg * 4 + jj) * 128 + s * 16 + r] = S1[jj];
  }
}

DI void sw_prompt_wave(const Params& p, int item) {
  const int lane = threadIdx.x & 63, r = lane & 15, kg = lane >> 4;
  const int qt = item & 511, gbh = item >> 9;
  const int h = gbh & 3, b = (gbh >> 2) & 3, g = gbh >> 4;
  const int dsh = 2 * g, ln = SEQ >> dsh;
  const int pos0 = qt * 16, rres = pos0 / ln, i0 = pos0 % ln;
  const int kbase = i0 - 144;
  const size_t rb = (size_t)b * SEQ;
  const int qoff = 2048 + g * 768 + h * 64, koff = qoff + 256;
  bf16x8 qf[2];
  {
    const size_t tok = rb + ((size_t)(i0 + r) << dsh) + rres;
#pragma unroll
    for (int ks = 0; ks < 2; ++ks) qf[ks] = *(const bf16x8*)&p.proj[tok * NP + qoff + ks * 32 + kg * 8];
  }
  f32x4 st[10];
#pragma unroll
  for (int mt = 0; mt < 10; ++mt) {
    int ki = kbase + mt * 16 + r; ki = ki < 0 ? 0 : ki;
    const size_t tok = rb + ((size_t)ki << dsh) + rres;
    f32x4 a = (f32x4){0.f, 0.f, 0.f, 0.f};
#pragma unroll
    for (int ks = 0; ks < 2; ++ks) {
      bf16x8 kf = *(const bf16x8*)&p.proj[tok * NP + koff + ks * 32 + kg * 8];
      a = MFMA(kf, qf[ks], a);
    }
    st[mt] = a;
  }
  const int qi = i0 + r;
  float mx = -3.0e38f;
#pragma unroll
  for (int mt = 0; mt < 10; ++mt)
#pragma unroll
    for (int j = 0; j < 4; ++j) {
      const int ki = kbase + mt * 16 + kg * 4 + j;
      const int d = qi - ki;
      const bool valid = (ki >= 0) && (d >= 0) && (d <= 128);
      const float sv = valid ? st[mt][j] * 0.125f : -3.0e38f;
      st[mt][j] = sv;
      mx = fmaxf(mx, sv);
    }
  mx = fmaxf(mx, __shfl_xor(mx, 16));
  mx = fmaxf(mx, __shfl_xor(mx, 32));
  float sum = 0.f;
#pragma unroll
  for (int mt = 0; mt < 10; ++mt)
#pragma unroll
    for (int j = 0; j < 4; ++j) {
      const float pv = (st[mt][j] > -1.0e38f) ? __expf(st[mt][j] - mx) : 0.f;
      st[mt][j] = pv;
      sum += pv;
    }
  sum += __shfl_xor(sum, 16);
  sum += __shfl_xor(sum, 32);
  const float inv = 1.f / sum;
  bf16x8 pf[5];
#pragma unroll
  for (int k2 = 0; k2 < 5; ++k2) pf[k2] = pack8(st[2 * k2], st[2 * k2 + 1]);
  const size_t qrow = rb + ((size_t)qi << dsh) + rres;
#pragma unroll
  for (int nt = 0; nt < 4; ++nt) {
    f32x4 o = (f32x4){0.f, 0.f, 0.f, 0.f};
    const u16* vrow = &p.vT[((size_t)gbh * 64 + nt * 16 + r) * SEQ + (size_t)rres * ln];
#pragma unroll
    for (int k2 = 0; k2 < 5; ++k2) {
      int ka = kbase + k2 * 32 + kg * 4, kc = ka + 16;
      ka = ka < 0 ? 0 : ka; kc = kc < 0 ? 0 : kc;
      uint2 va = *(const uint2*)&vrow[ka];
      uint2 vc = *(const uint2*)&vrow[kc];
      bf16x8 vf = __builtin_bit_cast(bf16x8, make_uint4(va.x, va.y, vc.x, vc.y));
      o = MFMA(vf, pf[k2], o);
    }
    uint2 ov; ov.x = pack2(o[0] * inv, o[1] * inv); ov.y = pack2(o[2] * inv, o[3] * inv);
    *(uint2*)&p.osw[((size_t)g * MT + qrow) * 256 + h * 64 + nt * 16 + kg * 4] = ov;
  }
  if (kg == 0) p.lse[((size_t)g * MT + qrow) * 4 + h] = mx + __logf(sum);
}

DI void sw_sample_wave(const Params& p, int item) {
  const int lane = threadIdx.x & 63;
  const int t = item & 3, h = (item >> 2) & 3, b = (item >> 4) & 31, g = item >> 9;
  const int dil = 1 << (2 * g), W = 128 << (2 * g);
  const float* c1 = p.cw1;
  const float* c2 = p.cw2;
  const float* c3 = p.cw3;
  const float* cache = (g == 0) ? c1 : (g == 1 ? c2 : c3);
  const int qoff = 2048 + g * 768 + h * 64;
  const size_t qrow = (size_t)MP + b * 4 + t;
  float q[64];
#pragma unroll
  for (int c = 0; c < 64; c += 8) {
    uint4 v = *(const uint4*)&p.proj[qrow * NP + qoff + c];
    q[c] = bflo(v.x); q[c + 1] = bfhi(v.x); q[c + 2] = bflo(v.y); q[c + 3] = bfhi(v.y);
    q[c + 4] = bflo(v.z); q[c + 5] = bfhi(v.z); q[c + 6] = bflo(v.w); q[c + 7] = bfhi(v.w);
  }
  float sc[3];
#pragma unroll
  for (int mi = 0; mi < 3; ++mi) {
    const int m = lane + 64 * mi;
    float s = -3.0e38f;
    if (m <= 128) {
      const int j = W + t - m * dil;
      float d = 0.f;
      if (j >= W) {
        const u16* kr = &p.proj[((size_t)MP + b * 4 + (j - W)) * NP + qoff + 256];
#pragma unroll
        for (int c = 0; c < 64; c += 8) {
          uint4 v = *(const uint4*)&kr[c];
          d += q[c] * bflo(v.x) + q[c + 1] * bfhi(v.x) + q[c + 2] * bflo(v.y) + q[c + 3] * bfhi(v.y) + q[c + 4] * bflo(v.z) +
               q[c + 5] * bfhi(v.z) + q[c + 6] * bflo(v.w) + q[c + 7] * bfhi(v.w);
        }
      } else {
        const float* kr = &cache[(((size_t)b * W + j) * 2 + 0) * 256 + h * 64];
#pragma unroll
        for (int c = 0; c < 64; c += 4) {
          float4 v = *(const float4*)&kr[c];
          d += q[c] * v.x + q[c + 1] * v.y + q[c + 2] * v.z + q[c + 3] * v.w;
        }
      }
      s = d * 0.125f;
    }
    sc[mi] = s;
  }
  float mx = wave_max(fmaxf(fmaxf(sc[0], sc[1]), sc[2]));
  float sum = 0.f;
#pragma unroll
  for (int mi = 0; mi < 3; ++mi) { sc[mi] = (sc[mi] > -1.0e38f) ? __expf(sc[mi] - mx) : 0.f; sum += sc[mi]; }
  sum = wave_sum(sum);
  float o = 0.f;
#pragma unroll
  for (int mi = 0; mi < 3; ++mi) {
#pragma unroll 8
    for (int mm = 0; mm < 64; ++mm) {
      const int m = mi * 64 + mm;
      if (m <= 128) {
        const float pv = __shfl(sc[mi], mm);
        const int j = W + t - m * dil;
        float vv;
        if (j >= W) vv = bf2f(p.proj[((size_t)MP + b * 4 + (j - W)) * NP + qoff + 512 + lane]);
        else vv = cache[(((size_t)b * W + j) * 2 + 1) * 256 + h * 64 + lane];
        o += pv * vv;
      }
    }
  }
  p.osw[((size_t)g * MT + qrow) * 256 + h * 64 + lane] = f2bf(o / sum);
  if (lane == 0) p.lse[((size_t)g * MT + qrow) * 4 + h] = mx + __logf(sum);
}

DI void phase3(const Params& p, char* smem) {
  const int w = threadIdx.x >> 6;
  if (blockIdx.x < 128) {
    dn_scan_block(p, blockIdx.x, smem);
  } else {
    const int gw = (blockIdx.x - 128) * 4 + w, nw = (gridDim.x - 128) * 4;
    for (int it = gw; it < 24576 + 1536; it += nw) {
      if (it < 24576) sw_prompt_wave(p, it);
      else sw_sample_wave(p, it - 24576);
    }
  }
}

DI void phase4(const Params& p) {
  const int lane = threadIdx.x & 63, w = threadIdx.x >> 6;
  for (int row = blockIdx.x * 4 + w; row < MT; row += gridDim.x * 4) {
    u16* dst = p.Amix + (size_t)row * 768;
#pragma unroll
    for (int h = 0; h < 4; ++h) {
      unsigned ov = *(const unsigned*)&p.odn[(size_t)row * 512 + h * 128 + lane * 2];
      unsigned zv = *(const unsigned*)&p.proj[(size_t)row * NP + 1536 + h * 128 + lane * 2];
      float o0 = bflo(ov), o1 = bfhi(ov);
      float ss = wave_sum(o0 * o0 + o1 * o1);
      float rs = rsqrtf(ss * (1.f / 128.f) + EPS);
      float2 gn = *(const float2*)&p.g_onorm[lane * 2];
      float y0 = o0 * rs * gn.x * siluf(bflo(zv)), y1 = o1 * rs * gn.y * siluf(bfhi(zv));
      *(unsigned*)&dst[h * 128 + lane * 2] = pack2(y0, y1);
    }
    {
      const int h = lane >> 4;
      float l0 = p.lse[((size_t)0 * MT + row) * 4 + h], l1 = p.lse[((size_t)1 * MT + row) * 4 + h], l2 = p.lse[((size_t)2 * MT + row) * 4 + h];
      float m = fmaxf(l0, fmaxf(l1, l2));
      float e0 = __expf(l0 - m), e1 = __expf(l1 - m), e2 = __expf(l2 - m);
      float inv = 1.f / (e0 + e1 + e2);
      uint2 a = *(const uint2*)&p.osw[((size_t)0 * MT + row) * 256 + lane * 4];
      uint2 c = *(const uint2*)&p.osw[((size_t)1 * MT + row) * 256 + lane * 4];
      uint2 d = *(const uint2*)&p.osw[((size_t)2 * MT + row) * 256 + lane * 4];
      e0 *= inv; e1 *= inv; e2 *= inv;
      float y0 = e0 * bflo(a.x) + e1 * bflo(c.x) + e2 * bflo(d.x);
      float y1 = e0 * bfhi(a.x) + e1 * bfhi(c.x) + e2 * bfhi(d.x);
      float y2 = e0 * bflo(a.y) + e1 * bflo(c.y) + e2 * bflo(d.y);
      float y3 = e0 * bfhi(a.y) + e1 * bfhi(c.y) + e2 * bfhi(d.y);
      *(uint2*)&dst[512 + lane * 4] = make_uint2(pack2(y0, y1), pack2(y2, y3));
    }
  }
}

DI void sample_state_copy(const Params& p) {
  const size_t gtid = (size_t)blockIdx.x * 256 + threadIdx.x, gsz = (size_t)gridDim.x * 256;
  for (size_t i = gtid; i < 147456; i += gsz) {
    const int c = (int)(i % 1536), j = (int)((i / 1536) % 3), b = (int)(i / 4608);
    p.out[O_SCONV + i] = bf2f(p.proj[((size_t)MP + b * 4 + j + 1) * NP + c]);
  }
  const float* c1 = p.cw1;
  const float* c2 = p.cw2;
  const float* c3 = p.cw3;
  for (int g = 0; g < 3; ++g) {
    const int W = 128 << (2 * g);
    const float* cache = (g == 0) ? c1 : (g == 1 ? c2 : c3);
    const size_t off = (g == 0) ? O_SW1 : (g == 1 ? O_SW2 : O_SW3);
    const size_t n4 = (size_t)32 * W * 512 / 4;
    for (size_t i = gtid; i < n4; i += gsz) {
      const size_t e0 = i * 4;
      const int e = (int)(e0 & 511), ii = (int)((e0 >> 9) % W), b = (int)((e0 >> 9) / W);
      float4 o;
      if (ii < W - 4) o = *(const float4*)&cache[((size_t)b * W + ii + 4) * 512 + e];
      else {
        uint2 v = *(const uint2*)&p.proj[((size_t)MP + b * 4 + (ii - (W - 4))) * NP + 2048 + g * 768 + 256 + e];
        o = make_float4(bflo(v.x), bfhi(v.x), bflo(v.y), bfhi(v.y));
      }
      *(float4*)&p.out[off + e0] = o;
    }
  }
}

DI void mem_attn_prompt_block(const Params& p, int item, char* smem) {
  const int tid = threadIdx.x, lane = tid & 63, w = tid >> 6, r = lane & 15, kg = lane >> 4;
  const int h = item & 3, qb = item >> 2;
  const int row0 = qb * 64 + w * 16, b = (qb * 64) >> 13;
  const int bh = b * 4 + h;
  u16* sK = (u16*)smem;
  bf16x8 qf[8];
#pragma unroll
  for (int ks = 0; ks < 8; ++ks) qf[ks] = *(const bf16x8*)&G(p.qb)[(size_t)(row0 + r) * 1024 + h * 256 + ks * 32 + kg * 8];
  f32x4 st[16];
  const u16* kbp = G(p.Kb) + (size_t)bh * 65536;
#pragma unroll
  for (int c = 0; c < 4; ++c) {
    __syncthreads();
#pragma unroll
    for (int i2 = 0; i2 < 2; ++i2) {
#pragma unroll
      for (int i = i2 * 4; i < i2 * 4 + 4; ++i) {
        const int idx = tid + 256 * i, row = idx >> 5, seg = idx & 31;
        *(bf16x8*)&sK[row * 264 + seg * 8] = *(gb8p)((gu16p)kbp + (size_t)(c * 64 + row) * 256 + seg * 8);
      }
      __builtin_amdgcn_sched_barrier(0);
    }
    __syncthreads();
#pragma unroll
    for (int m4 = 0; m4 < 4; ++m4) {
      f32x4 a = (f32x4){0.f, 0.f, 0.f, 0.f};
#pragma unroll
      for (int ks = 0; ks < 8; ++ks) {
        bf16x8 kf = *(const bf16x8*)&sK[(m4 * 16 + r) * 264 + ks * 32 + kg * 8];
        a = MFMA(kf, qf[ks], a);
      }
      st[c * 4 + m4] = a;
      __builtin_amdgcn_sched_barrier(0);
    }
  }
  float mx = -3.0e38f;
#pragma unroll
  for (int mt = 0; mt < 16; ++mt)
#pragma unroll
    for (int j = 0; j < 4; ++j) { st[mt][j] *= 0.0625f; mx = fmaxf(mx, st[mt][j]); }
  mx = fmaxf(mx, __shfl_xor(mx, 16));
  mx = fmaxf(mx, __shfl_xor(mx, 32));
  float sum = 0.f;
#pragma unroll
  for (int mt = 0; mt < 16; ++mt)
#pragma unroll
    for (int j = 0; j < 4; ++j) { st[mt][j] = __expf(st[mt][j] - mx); sum += st[mt][j]; }
  sum += __shfl_xor(sum, 16);
  sum += __shfl_xor(sum, 32);
  const float inv = 1.f / sum;
  bf16x8 pf[8];
#pragma unroll
  for (int k2 = 0; k2 < 8; ++k2) pf[k2] = pack8(st[2 * k2], st[2 * k2 + 1]);
  const u16* vtp = G(p.VTf) + (size_t)bh * 65536;
#pragma unroll 1
  for (int c = 0; c < 4; ++c) {
    __syncthreads();
#pragma unroll
    for (int i = 0; i < 8; ++i) {
      const int idx = tid + 256 * i;
      *(bf16x8*)&sK[idx * 8] = *(gb8p)((gu16p)vtp + (size_t)c * 16384 + idx * 8);
    }
    __syncthreads();
#pragma unroll
    for (int n4 = 0; n4 < 4; ++n4) {
      f32x4 o = (f32x4){0.f, 0.f, 0.f, 0.f};
#pragma unroll
      for (int k2 = 0; k2 < 8; ++k2) o = MFMA(*(const bf16x8*)&sK[((n4 * 8 + k2) * 64 + lane) * 8], pf[k2], o);
      uint2 ov; ov.x = pack2(o[0] * inv, o[1] * inv); ov.y = pack2(o[2] * inv, o[3] * inv);
      *(uint2*)&G(p.attn)[(size_t)(row0 + r) * 1024 + h * 256 + (c * 4 + n4) * 16 + kg * 4] = ov;
      __builtin_amdgcn_sched_barrier(0);
    }
  }
}

DI void mem_attn_sample_wave(const Params& p, int item, float* lds) {
  const int lane = threadIdx.x & 63;
  const int b = item >> 2, h = item & 3;
  float* sq = lds;
#pragma unroll
  for (int t = 0; t < 4; ++t) {
    uint2 v = *(const uint2*)&p.qb[((size_t)MP + b * 4 + t) * 1024 + h * 256 + lane * 4];
    *(float4*)&sq[t * 256 + lane * 4] = make_float4(bflo(v.x), bfhi(v.x), bflo(v.y), bfhi(v.y));
  }
  __builtin_amdgcn_s_waitcnt(0);
  __builtin_amdgcn_wave_barrier();
  float sc[4][4];
#pragma unroll
  for (int mi = 0; mi < 4; ++mi) {
    const int m = lane + 64 * mi;
    const float* kr = &p.cache_mem[(((size_t)b * 256 + m) * 2 + 0) * 1024 + h * 256];
    float d0 = 0.f, d1 = 0.f, d2 = 0.f, d3 = 0.f;
#pragma unroll 2
    for (int c = 0; c < 256; c += 4) {
      float4 kv = *(const float4*)&kr[c];
      float4 q0 = *(const float4*)&sq[c], q1 = *(const float4*)&sq[256 + c], q2 = *(const float4*)&sq[512 + c], q3 = *(const float4*)&sq[768 + c];
      d0 += kv.x * q0.x + kv.y * q0.y + kv.z * q0.z + kv.w * q0.w;
      d1 += kv.x * q1.x + kv.y * q1.y + kv.z * q1.z + kv.w * q1.w;
      d2 += kv.x * q2.x + kv.y * q2.y + kv.z * q2.z + kv.w * q2.w;
      d3 += kv.x * q3.x + kv.y * q3.y + kv.z * q3.z + kv.w * q3.w;
    }
    sc[0][mi] = d0 * 0.0625f; sc[1][mi] = d1 * 0.0625f; sc[2][mi] = d2 * 0.0625f; sc[3][mi] = d3 * 0.0625f;
  }
  float inv[4];
  __builtin_amdgcn_wave_barrier();
#pragma unroll
  for (int t = 0; t < 4; ++t) {
    float mx = wave_max(fmaxf(fmaxf(sc[t][0], sc[t][1]), fmaxf(sc[t][2], sc[t][3])));
    float sum = 0.f;
#pragma unroll
    for (int mi = 0; mi < 4; ++mi) { sc[t][mi] = __expf(sc[t][mi] - mx); sum += sc[t][mi]; }
    sum = wave_sum(sum);
    inv[t] = 1.f / sum;
#pragma unroll
    for (int mi = 0; mi < 4; ++mi) sq[t * 256 + lane + 64 * mi] = sc[t][mi];
  }
  __builtin_amdgcn_s_waitcnt(0);
  __builtin_amdgcn_wave_barrier();
  float4 o[4];
#pragma unroll
  for (int t = 0; t < 4; ++t) o[t] = make_float4(0.f, 0.f, 0.f, 0.f);
#pragma unroll 4
  for (int m = 0; m < 256; ++m) {
    float4 vv = *(const float4*)&p.cache_mem[(((size_t)b * 256 + m) * 2 + 1) * 1024 + h * 256 + lane * 4];
#pragma unroll
    for (int t = 0; t < 4; ++t) {
      const float pv = sq[t * 256 + m];
      o[t].x += pv * vv.x; o[t].y += pv * vv.y; o[t].z += pv * vv.z; o[t].w += pv * vv.w;
    }
  }
#pragma unroll
  for (int t = 0; t < 4; ++t) {
    uint2 ov; ov.x = pack2(o[t].x * inv[t], o[t].y * inv[t]); ov.y = pack2(o[t].z * inv[t], o[t].w * inv[t]);
    *(uint2*)&p.attn[((size_t)MP + b * 4 + t) * 1024 + h * 256 + lane * 4] = ov;
  }
  __builtin_amdgcn_wave_barrier();
}

DI void phase7(const Params& p, char* smem) {
  const int w = threadIdx.x >> 6;
  float* lds = (float*)smem + w * 1280;
  for (int it = blockIdx.x; it < 32 + 2048; it += gridDim.x) {
    if (it < 32) { __syncthreads(); mem_attn_sample_wave(p, it * 4 + w, lds); }
    else mem_attn_prompt_block(p, it - 32, smem);
  }
}

DI void peer_topk_wave(const Params& p, int item, unsigned* lds  ) {
  const int lane = threadIdx.x & 63, r = lane & 15, kg = lane >> 4;
  const int h = item & 7, row0 = (item >> 3) * 16;
  unsigned win[2][16];
#pragma unroll
  for (int pp = 0; pp < 2; ++pp) {
    bf16x8 qf[4];
#pragma unroll
    for (int ks = 0; ks < 4; ++ks) qf[ks] = *(const bf16x8*)&p.pq[(size_t)(row0 + r) * 2048 + h * 256 + pp * 128 + ks * 32 + kg * 8];
    unsigned kk[32];
    const u16* sk = p.subkb + (size_t)(h * 2 + pp) * 16384;
#pragma unroll
    for (int mt = 0; mt < 8; ++mt) {
      f32x4 a = (f32x4){0.f, 0.f, 0.f, 0.f};
#pragma unroll
      for (int ks = 0; ks < 4; ++ks) {
        bf16x8 kf = *(const bf16x8*)&sk[(mt * 16 + r) * 128 + ks * 32 + kg * 8];
        a = MFMA(kf, qf[ks], a);
      }
#pragma unroll
      for (int j = 0; j < 4; ++j) kk[mt * 4 + j] = (ordf(a[j]) & ~127u) | (unsigned)(mt * 16 + kg * 4 + j);
    }
#pragma unroll
    for (int rr = 0; rr < 16; ++rr) {
      unsigned m = 0;
#pragma unroll
      for (int i = 0; i < 32; ++i) m = umax(m, kk[i]);
      m = umax(m, (unsigned)__shfl_xor((int)m, 16));
      m = umax(m, (unsigned)__shfl_xor((int)m, 32));
      win[pp][rr] = m;
#pragma unroll
      for (int i = 0; i < 32; ++i) kk[i] = (kk[i] == m) ? 0u : kk[i];
    }
  }
  float f0[16], f1[16];
#pragma unroll
  for (int i = 0; i < 16; ++i) { f0[i] = unordf(win[0][i] & ~127u); f1[i] = unordf(win[1][i] & ~127u); }
  unsigned cand[13];
#define CAND(s, a0, b0, a1, b1, a2, b2, a3, b3)                                                         \
  {                                                                                                     \
    float va = sel4(kg, f0[a0], f0[a1], f0[a2], f0[(a3) < 0 ? 0 : (a3)]);                                \
    float vb = sel4(kg, f1[b0], f1[b1], f1[b2], f1[(b3) < 0 ? 0 : (b3)]);                                \
    unsigned id = sel4(kg, (unsigned)((a0) * 16 + (b0)), (unsigned)((a1) * 16 + (b1)), (unsigned)((a2) * 16 + (b2)), (unsigned)(((a3) < 0 ? 0 : (a3)) * 16 + ((b3) < 0 ? 0 : (b3)))); \
    unsigned key = (ordf(va + vb) & ~255u) | id;                                                        \
    if ((a3) < 0) key = (kg == 3) ? 0u : key;                                                           \
    cand[s] = key;                                                                                      \
  }
  CAND(0, 0, 0, 0, 13, 2, 0, 6, 1)
  CAND(1, 0, 1, 0, 14, 2, 1, 7, 0)
  CAND(2, 0, 2, 0, 15, 2, 2, 7, 1)
  CAND(3, 0, 3, 1, 0, 2, 3, 8, 0)
  CAND(4, 0, 4, 1, 1, 2, 4, 9, 0)
  CAND(5, 0, 5, 1, 2, 3, 0, 10, 0)
  CAND(6, 0, 6, 1, 3, 3, 1, 11, 0)
  CAND(7, 0, 7, 1, 4, 3, 2, 12, 0)
  CAND(8, 0, 8, 1, 5, 3, 3, 13, 0)
  CAND(9, 0, 9, 1, 6, 4, 2, 14, 0)
  CAND(10, 0, 10, 1, 7, 5, 0, 15, 0)
  CAND(11, 0, 11, 4, 0, 5, 1, -1, -1)
  CAND(12, 0, 12, 4, 1, 6, 0, -1, -1)
#undef CAND
  unsigned w2[16];
#pragma unroll
  for (int rr = 0; rr < 16; ++rr) {
    unsigned m = 0;
#pragma unroll
    for (int i = 0; i < 13; ++i) m = umax(m, cand[i]);
    m = umax(m, (unsigned)__shfl_xor((int)m, 16));
    m = umax(m, (unsigned)__shfl_xor((int)m, 32));
    w2[rr] = m;
#pragma unroll
    for (int i = 0; i < 13; ++i) cand[i] = (cand[i] == m) ? 0u : cand[i];
  }
  if (kg == 0) {
#pragma unroll
    for (int i = 0; i < 16; ++i) { lds[r * 32 + i] = win[0][i] & 127u; lds[r * 32 + 16 + i] = win[1][i] & 127u; }
  }
  __builtin_amdgcn_s_waitcnt(0);
  __builtin_amdgcn_wave_barrier();
  const float cv0 = unordf(w2[0] & ~255u);
  float sum = 0.f;
#pragma unroll
  for (int rr = 0; rr < 16; ++rr) sum += __expf(unordf(w2[rr] & ~255u) - cv0);
  const float inv = 1.f / sum;
  const size_t ob = ((size_t)(row0 + r) * 8 + h) * 16;
#pragma unroll
  for (int q = 0; q < 4; ++q) {
    const unsigned wk = sel4(kg, w2[q], w2[4 + q], w2[8 + q], w2[12 + q]);
    const int a = (wk >> 4) & 15, bb = wk & 15;
    const int i1 = (int)lds[r * 32 + a], i2 = (int)lds[r * 32 + 16 + bb];
    p.eid[ob + kg * 4 + q] = i1 * 128 + i2;
    p.gate[ob + kg * 4 + q] = __expf(unordf(wk & ~255u) - cv0) * inv;
  }
  __builtin_amdgcn_wave_barrier();
}

typedef __attribute__((ext_vector_type(2))) float f32x2;
DI float dot16_fp8(u32x4 u, const float* x, float c) {
  const unsigned d[4] = {u[0], u[1], u[2], u[3]};
#pragma unroll
  for (int i = 0; i < 4; ++i) {
    f32x2 a = __builtin_amdgcn_cvt_pk_f32_fp8((int)d[i], false);
    f32x2 b = __builtin_amdgcn_cvt_pk_f32_fp8((int)d[i], true);
    c += a[0] * x[4 * i] + a[1] * x[4 * i + 1] + b[0] * x[4 * i + 2] + b[1] * x[4 * i + 3];
  }
  return c;
}
DI void axpy16_fp8(float* o, float w, u32x4 u) {
  const unsigned d[4] = {u[0], u[1], u[2], u[3]};
#pragma unroll
  for (int i = 0; i < 4; ++i) {
    f32x2 a = __builtin_amdgcn_cvt_pk_f32_fp8((int)d[i], false);
    f32x2 b = __builtin_amdgcn_cvt_pk_f32_fp8((int)d[i], true);
    o[4 * i] += w * a[0]; o[4 * i + 1] += w * a[1]; o[4 * i + 2] += w * b[0]; o[4 * i + 3] += w * b[1];
  }
}

DI void peer_expert_wave(const Params& p, int row) {
  const int lane = __builtin_amdgcn_mbcnt_hi(-1, __builtin_amdgcn_mbcnt_lo(-1, 0));
  float xf[16];
  {
    const uint4 x0 = *(const uint4*)&G(p.A2)[(size_t)row * 1024 + lane * 16];
    const uint4 x1 = *(const uint4*)&G(p.A2)[(size_t)row * 1024 + lane * 16 + 8];
    xf[0] = bflo(x0.x); xf[1] = bfhi(x0.x); xf[2] = bflo(x0.y); xf[3] = bfhi(x0.y);
    xf[4] = bflo(x0.z); xf[5] = bfhi(x0.z); xf[6] = bflo(x0.w); xf[7] = bfhi(x0.w);
    xf[8] = bflo(x1.x); xf[9] = bfhi(x1.x); xf[10] = bflo(x1.y); xf[11] = bfhi(x1.y);
    xf[12] = bflo(x1.z); xf[13] = bfhi(x1.z); xf[14] = bflo(x1.w); xf[15] = bfhi(x1.w);
  }
  const float r2 = rsqrtf(p.ssq2[row] * (1.f / 1024.f) + EPS);
  const unsigned char AS1* EU8 = (const unsigned char AS1*)p.E8;
  const unsigned char AS1* EV8 = (const unsigned char AS1*)p.E8 + (size_t)16384 * 1024;
  float out[16];
#pragma unroll
  for (int i = 0; i < 16; ++i) out[i] = 0.f;
#pragma unroll 1
  for (int bt = 0; bt < 2; ++bt) {
    const int eidv = G(p.eid)[(size_t)row * 128 + bt * 64 + lane];
    const float gv = G(p.gate)[(size_t)row * 128 + bt * 64 + lane];
    const float rsu = G(p.rs)[eidv], rsv = G(p.rs)[16384 + eidv];
    float part[64];
#pragma unroll
    for (int e = 0; e < 64; ++e) {
      const int id = __builtin_amdgcn_readlane(eidv, e);
      const u32x4 u = *(const u32x4 AS1*)(EU8 + (size_t)id * 1024 + lane * 16);
      part[e] = dot16_fp8(u, xf, 0.f);
    }
#pragma unroll
    for (int off = 32; off > 0; off >>= 1) {
      const bool up = (lane & off) != 0;
#pragma unroll
      for (int i = 0; i < off; ++i) {
        const float a = part[i], bq = part[i + off];
        const float send = up ? a : bq, keep = up ? bq : a;
        part[i] = keep + __shfl_xor(send, off);
      }
    }
    const float wv = gv * geluf(part[0] * r2 * rsu) * rsv;
#pragma unroll 8
    for (int e = 0; e < 64; ++e) {
      const int id = __builtin_amdgcn_readlane(eidv, e);
      const float we = __int_as_float(__builtin_amdgcn_readlane(__float_as_int(wv), e));
      const u32x4 v = *(const u32x4 AS1*)(EV8 + (size_t)id * 1024 + lane * 16);
      axpy16_fp8(out, we, v);
    }
  }
  const float* hr = G(p.h2) + (size_t)row * 1024 + lane * 16;
  float hv[16];
  float ss = 0.f;
#pragma unroll
  for (int i = 0; i < 4; ++i) {
    float4 t = *(const float4*)&hr[i * 4];
    hv[4 * i] = t.x + out[4 * i]; hv[4 * i + 1] = t.y + out[4 * i + 1]; hv[4 * i + 2] = t.z + out[4 * i + 2]; hv[4 * i + 3] = t.w + out[4 * i + 3];
    ss += hv[4 * i] * hv[4 * i] + hv[4 * i + 1] * hv[4 * i + 1] + hv[4 * i + 2] * hv[4 * i + 2] + hv[4 * i + 3] * hv[4 * i + 3];
  }
  ss = wave_sum(ss);
  const float rsn = rsqrtf(ss * (1.f / 1024.f) + EPS);
  float* y = ((row < MP) ? (G(p.out) + O_YP + (size_t)row * 1024) : (G(p.out) + O_YS + (size_t)(row - MP) * 1024)) + lane * 16;
#pragma unroll
  for (int i = 0; i < 4; ++i) {
    float4 g4 = *(const float4*)&p.g_final[lane * 16 + i * 4];
    *(float4*)&y[i * 4] = make_float4(hv[4 * i] * rsn * g4.x, hv[4 * i + 1] * rsn * g4.y, hv[4 * i + 2] * rsn * g4.z, hv[4 * i + 3] * rsn * g4.w);
  }
}

__global__ void __launch_bounds__(256, 2) mega(Params pk) {
  __shared__ __attribute__((aligned(16))) char smem[65536];
  __shared__ Params sp;
  cg::grid_group grid = cg::this_grid();
  const int w = threadIdx.x >> 6;
  if (threadIdx.x == 0) sp = pk;
  __syncthreads();
  const Params& p = sp;
#ifndef DBL
#define DBL -1
#endif
#define REP(ph) for (int rp_ = 0; rp_ < ((DBL == (ph)) ? 2 : 1); ++rp_)
  REP(0) { phase0(p, smem); if (DBL == 0) grid.sync(); }
  grid.sync();
  REP(1) {
    int tm, tn;
    for (int it = 0; it * (int)gridDim.x < 257 * 34; ++it)
      if (xcd_tile(it, 257, 34, tm, tn)) gemm_tile<0, 1024>(p, p.A0, 1024, p.WtIn, tm, tn, smem);
    for (int u = blockIdx.x; u < 128; u += gridDim.x) gemm_tile<1, 1024>(p, p.Amem, 1024, p.WtMkv, u / 16, u % 16, smem);
  }
  grid.sync();
  REP(2) { phase2(p, smem); if (DBL == 2) grid.sync(); }
  grid.sync();
  REP(3) { phase3(p, smem); if (DBL == 3) grid.sync(); }
  grid.sync();
  REP(4) phase4(p);
  grid.sync();
  { int tm, tn; for (int it = 0; it * (int)gridDim.x < 257 * 8; ++it) if (xcd_tile(it, 257, 8, tm, tn)) gemm_tile<2, 768>(p, p.Amix, 768, p.WtOut, tm, tn, smem); }
  grid.sync();
  REP(6) { int tm, tn; for (int it = 0; it * (int)gridDim.x < 257 * 8; ++it) if (xcd_tile(it, 257, 8, tm, tn)) gemm_tile<3, 1024>(p, p.A1, 1024, p.WtMq, tm, tn, smem); }
  sample_state_copy(p);
  grid.sync();
  REP(7) phase7(p, smem);
  grid.sync();
  { int tm, tn; for (int it = 0; it * (int)gridDim.x < 257 * 8; ++it) if (xcd_tile(it, 257, 8, tm, tn)) gemm_tile<4, 1024>(p, p.attn, 1024, p.WtMo, tm, tn, smem); }
  grid.sync();
  REP(9) { int tm, tn; for (int it = 0; it * (int)gridDim.x < 257 * 16; ++it) if (xcd_tile(it, 257, 16, tm, tn)) gemm_tile<5, 1024>(p, p.A2, 1024, p.WtPq, tm, tn, smem); }
  grid.sync();
  REP(10) {
    unsigned* lds = (unsigned*)smem + w * 512;
    for (int it = blockIdx.x * 4 + w; it < 2056 * 8; it += gridDim.x * 4) peer_topk_wave(p, it, lds);
  }
  grid.sync();
  REP(11) for (int row = blockIdx.x * 4 + w; row < MT; row += gridDim.x * 4) peer_expert_wave(p, row);
}

extern "C" void kernel_launch(void* const* d_in, const int* in_sizes, int n_in, void* d_out, int out_size, void* d_ws, size_t ws_size,
                              hipStream_t stream) {
  static int grid_blocks = 0;
  if (!grid_blocks) {
    int dev = 0, cus = 0, per_cu = 0;
    (void)hipGetDevice(&dev);
    (void)hipDeviceGetAttribute(&cus, hipDeviceAttributeMultiprocessorCount, dev);
    (void)hipOccupancyMaxActiveBlocksPerMultiprocessor(&per_cu, mega, 256, 0);
    if (per_cu > 2) per_cu = 2;
    if (per_cu < 1) per_cu = 1;
    grid_blocks = cus * per_cu;
  }
  Params p{};
  const float* const* in = (const float* const*)d_in;
  p.x_prompt = in[0]; p.x_sample = in[1]; p.state_delta = in[2]; p.state_conv = in[3]; p.cw1 = in[4]; p.cw2 = in[5]; p.cw3 = in[6];
  p.cache_mem = in[7]; p.mem_prompt = in[8]; p.g_mix = in[9]; p.w_in = in[10]; p.conv_w = in[11]; p.a_log = in[12]; p.dt_bias = in[13];
  p.g_onorm = in[14]; p.w_out = in[15]; p.g_memq = in[16]; p.g_memkv = in[17]; p.w_mq = in[18]; p.w_mkv = in[19]; p.w_mo = in[20];
  p.g_ffn = in[21]; p.w_pq = in[22]; p.sub_keys = in[23]; p.expert_u = in[24]; p.expert_v = in[25]; p.g_final = in[26];
  p.out = (float*)d_out;
  char* ws = (char*)d_ws;
  size_t off = 0;
  auto take = [&](size_t bytes) { char* r = ws + off; off += (bytes + 255) & ~(size_t)255; return r; };
  p.WtIn = (u16*)take((size_t)NP * 1024 * 2);
  p.WtOut = (u16*)take((size_t)1024 * 768 * 2);
  p.WtMq = (u16*)take((size_t)1024 * 1024 * 2);
  p.WtMkv = (u16*)take((size_t)2048 * 1024 * 2);
  p.WtMo = (u16*)take((size_t)1024 * 1024 * 2);
  p.WtPq = (u16*)take((size_t)2048 * 1024 * 2);
  p.subkb = (u16*)take((size_t)262144 * 2);
  p.E8 = (unsigned char*)take((size_t)32768 * 1024);
  p.rs = (float*)take((size_t)32768 * 4);
  p.Amem = (u16*)take((size_t)1024 * 1024 * 2);
  p.gb = (float*)take((size_t)MT * 8 * 4);
  p.ssq1 = (float*)take((size_t)MT * 4);
  p.ssq2 = (float*)take((size_t)MT * 4);
  p.dl = (float*)take(2048 * 4);
  p.Kb = (u16*)take((size_t)16 * 65536 * 2);
  p.VTf = (u16*)take((size_t)16 * 65536 * 2);
  char* regA = take((size_t)MT * NP * 2);
  char* regB = take((size_t)2048 * DN_ITEM);
  p.proj = (u16*)regA;
  p.h1 = (float*)regA;
  p.h2 = (float*)(regA + (size_t)MT * 1024 * 4);
  p.pq = (u16*)regA;
  p.dnops = regB;
  p.A0 = (u16*)regB;
  p.A1 = (u16*)regB;
  p.qb = (u16*)(regB + (size_t)MT * 1024 * 2);
  p.attn = (u16*)regB;
  p.A2 = (u16*)(regB + (size_t)MT * 1024 * 2);
  p.eid = (int*)regB;
  p.gate = (float*)(regB + (size_t)MT * 128 * 4);
  char* ob = (char*)d_out;
  p.vT = (u16*)ob;
  p.osw = (u16*)(ob + (size_t)3 * MP * 256 * 2);
  p.lse = (float*)(ob + (size_t)3 * MP * 256 * 2 + (size_t)3 * MT * 256 * 2);
  char* sb = ob + O_SW3 * 4;
  p.odn = (u16*)sb;
  p.Amix = (u16*)(sb + (size_t)MT * 512 * 2);
  if (off > ws_size) { fprintf(stderr, "workspace too small: need %zu have %zu\n", off, ws_size); return; }
  void* args[] = {&p};
  hipError_t e = hipLaunchCooperativeKernel((void*)mega, dim3(grid_blocks), dim3(256), args, 0, stream);
  if (e != hipSuccess) fprintf(stderr, "coop launch failed: %s (grid %d)\n", hipGetErrorString(e), grid_blocks);
}
```

```cpp
#include <hip/hip_runtime.h>
#include <hip/hip_cooperative_groups.h>
#include <cstdio>
namespace cg = cooperative_groups;

typedef unsigned short u16;
typedef __attribute__((ext_vector_type(8))) short bf16x8;
typedef __attribute__((ext_vector_type(4))) float f32x4;
typedef __attribute__((ext_vector_type(2))) __bf16 bf2_t;

#define DI __device__ __forceinline__
#define MFMA(a, b, c) __builtin_amdgcn_mfma_f32_16x16x32_bf16((a), (b), (c), 0, 0, 0)

constexpr int MP = 32768, MS = 128, MT = 32896;
constexpr int NP = 4352;
constexpr int SEQ = 8192;
constexpr float EPS = 1e-6f;
constexpr size_t DN_ITEM = 73728;

constexpr size_t O_YP = 0, O_YS = 33554432, O_PDELTA = 33685504, O_PCONV = 33947648, O_PW1 = 33966080,
                 O_PW2 = 34228224, O_PW3 = 35276800, O_PMEM = 39471104, O_SDELTA = 41568256, O_SCONV = 43665408,
                 O_SW1 = 43812864, O_SW2 = 45910016, O_SW3 = 54298624;

struct Params {
  const float *x_prompt, *x_sample, *state_delta, *state_conv, *cw1, *cw2, *cw3, *cache_mem, *mem_prompt;
  const float *g_mix, *w_in, *conv_w, *a_log, *dt_bias, *g_onorm, *w_out, *g_memq, *g_memkv, *w_mq, *w_mkv, *w_mo;
  const float *g_ffn, *w_pq, *sub_keys, *expert_u, *expert_v, *g_final;
  float* out;
  u16 *WtIn, *WtOut, *WtMq, *WtMkv, *WtMo, *WtPq, *subkb, *Amem;
  unsigned char* E8;
  float* rs;
  float *gb, *ssq1, *ssq2, *dl;
  u16 *Kb, *VTf;
  u16* proj;
  float *h1, *h2;
  u16* pq;
  char* dnops;
  u16 *A0, *A1, *qb, *attn, *A2;
  int* eid;
  float* gate;
  u16 *vT, *osw, *odn, *Amix;
  float* lse;
};

#define AS1 __attribute__((address_space(1)))
template <typename T> DI T* G(T* q) { return q; }
typedef const bf16x8 AS1* gb8p;
typedef const u16 AS1* gu16p;
typedef __attribute__((ext_vector_type(4))) unsigned u32x4;
DI u16 f2bf(float x) { unsigned u = __float_as_uint(x); u += 0x7fffu + ((u >> 16) & 1u); return (u16)(u >> 16); }
DI float bf2f(u16 h) { return __uint_as_float(((unsigned)h) << 16); }
DI unsigned pack2(float a, float b) { return (unsigned)f2bf(a) | ((unsigned)f2bf(b) << 16); }
DI float bflo(unsigned d) { return __uint_as_float(d << 16); }
DI float bfhi(unsigned d) { return __uint_as_float(d & 0xffff0000u); }
DI bf16x8 pack8(f32x4 a, f32x4 b) {
  uint4 r; r.x = pack2(a[0], a[1]); r.y = pack2(a[2], a[3]); r.z = pack2(b[0], b[1]); r.w = pack2(b[2], b[3]);
  return __builtin_bit_cast(bf16x8, r);
}
DI float wave_sum(float v) {
#pragma unroll
  for (int o = 32; o > 0; o >>= 1) v += __shfl_xor(v, o);
  return v;
}
DI float wave_max(float v) {
#pragma unroll
  for (int o = 32; o > 0; o >>= 1) v = fmaxf(v, __shfl_xor(v, o));
  return v;
}
DI float siluf(float x) { return x / (1.f + __expf(-x)); }
DI float geluf(float x) { return 0.5f * x * (1.f + tanhf(0.7978845608028654f * (x + 0.044715f * x * x * x))); }
DI int permk(int kg, int j) { return (j < 4) ? (kg * 4 + j) : (16 + kg * 4 + (j - 4)); }
DI void cvt8(const float* __restrict__ s, u16* __restrict__ d) {
  float4 a = *(const float4*)s, b = *(const float4*)(s + 4);
  uint4 r; r.x = pack2(a.x, a.y); r.y = pack2(a.z, a.w); r.z = pack2(b.x, b.y); r.w = pack2(b.z, b.w);
  *(uint4*)d = r;
}
DI unsigned ordf(float f) { unsigned u = __float_as_uint(f); return (u & 0x80000000u) ? ~u : (u | 0x80000000u); }
DI float unordf(unsigned k) { unsigned u = (k & 0x80000000u) ? (k & 0x7fffffffu) : ~k; return __uint_as_float(u); }
DI unsigned umax(unsigned a, unsigned b) { return a > b ? a : b; }
template <typename T> DI T sel4(int L, T a, T b, T c, T d) { return L == 0 ? a : (L == 1 ? b : (L == 2 ? c : d)); }

#define AS3 __attribute__((address_space(3)))
template <int MODE, int K>
DI void gemm_tile(const Params& p, const u16* __restrict__ A, int lda, const u16* __restrict__ Bt, int tm, int tn,
                          char* smem) {
  const int tid = threadIdx.x, lane = tid & 63, w = tid >> 6;
  const int wm = w >> 1, wn = w & 1, r = lane & 15, kg = lane >> 4;
  f32x4 acc[4][4];
#pragma unroll
  for (int i = 0; i < 4; ++i)
#pragma unroll
    for (int j = 0; j < 4; ++j) acc[i][j] = (f32x4){0.f, 0.f, 0.f, 0.f};
  const int lr = lane >> 2, lkg = (lane & 3) ^ (lane >> 4);
  gu16p gA[4], gB[4];
#pragma unroll
  for (int i = 0; i < 4; ++i) {
    const int sub = w * 4 + i, mt = sub >> 1, ks = sub & 1;
    gA[i] = (gu16p)A + (size_t)(tm * 128 + mt * 16 + lr) * lda + ks * 32 + lkg * 8;
    gB[i] = (gu16p)Bt + (size_t)(tn * 128 + mt * 16 + lr) * K + ks * 32 + lkg * 8;
  }
  const int frag_off = r * 64 + ((kg ^ (r >> 2)) * 16);
  __syncthreads();
#pragma unroll
  for (int i = 0; i < 4; ++i) {
    __builtin_amdgcn_global_load_lds((const unsigned AS1*)(gA[i]), (unsigned AS3*)(smem + (w * 4 + i) * 1024), 16, 0, 0);
    __builtin_amdgcn_global_load_lds((const unsigned AS1*)(gB[i]), (unsigned AS3*)(smem + 16384 + (w * 4 + i) * 1024), 16, 0, 0);
  }
#pragma unroll 2
  for (int k = 0; k < K / 64; ++k) {
    __syncthreads();
    if (k + 1 < K / 64) {
      char* st = smem + ((k + 1) & 1) * 32768;
#pragma unroll
      for (int i = 0; i < 4; ++i) {
        __builtin_amdgcn_global_load_lds((const unsigned AS1*)(gA[i] + (k + 1) * 64), (unsigned AS3*)(st + (w * 4 + i) * 1024), 16, 0, 0);
        __builtin_amdgcn_global_load_lds((const unsigned AS1*)(gB[i] + (k + 1) * 64), (unsigned AS3*)(st + 16384 + (w * 4 + i) * 1024), 16, 0, 0);
      }
    }
    const char* sa = smem + (k & 1) * 32768;
    const char* sb = sa + 16384;
#pragma unroll
    for (int ks = 0; ks < 2; ++ks) {
      bf16x8 af[4], bfr[4];
#pragma unroll
      for (int i = 0; i < 4; ++i) {
        af[i] = *(const bf16x8*)(sa + ((wm * 4 + i) * 2 + ks) * 1024 + frag_off);
        bfr[i] = *(const bf16x8*)(sb + ((wn * 4 + i) * 2 + ks) * 1024 + frag_off);
      }
#pragma unroll
      for (int mt = 0; mt < 4; ++mt)
#pragma unroll
        for (int nt = 0; nt < 4; ++nt) acc[mt][nt] = MFMA(bfr[nt], af[mt], acc[mt][nt]);
    }
  }
#pragma unroll
  for (int mt = 0; mt < 4; ++mt) {
    const int row = tm * 128 + wm * 64 + mt * 16 + r;
    float rs = 1.f, ssq = 0.f;
    if (MODE == 3) rs = rsqrtf(p.ssq1[row] * (1.f / 1024.f) + EPS);
    if (MODE == 5) rs = rsqrtf(p.ssq2[row] * (1.f / 1024.f) + EPS);
#pragma unroll
    for (int nt = 0; nt < 4; ++nt) {
      const int col = tn * 128 + wn * 64 + nt * 16 + kg * 4;
      f32x4 v = acc[mt][nt];
      if (MODE == 0) {
        uint2 o; o.x = pack2(v[0], v[1]); o.y = pack2(v[2], v[3]);
        *(uint2*)&p.proj[(size_t)row * NP + col] = o;
      } else if (MODE == 1) {
        *(float4*)&p.out[O_PMEM + (size_t)row * 2048 + col] = make_float4(v[0], v[1], v[2], v[3]);
      } else if (MODE == 2 || MODE == 4) {
        float4 rsd;
        const float* gn;
        if (MODE == 2) {
          rsd = (row < MP) ? *(const float4*)&p.x_prompt[(size_t)row * 1024 + col] : *(const float4*)&p.x_sample[(size_t)(row - MP) * 1024 + col];
          gn = p.g_memq;
        } else {
          rsd = *(const float4*)&p.h1[(size_t)row * 1024 + col];
          gn = p.g_ffn;
        }
        float4 h = make_float4(rsd.x + v[0], rsd.y + v[1], rsd.z + v[2], rsd.w + v[3]);
        float4 g4 = *(const float4*)&gn[col];
        ssq += h.x * h.x + h.y * h.y + h.z * h.z + h.w * h.w;
        uint2 o; o.x = pack2(h.x * g4.x, h.y * g4.y); o.y = pack2(h.z * g4.z, h.w * g4.w);
        if (MODE == 2) { *(float4*)&p.h1[(size_t)row * 1024 + col] = h; *(uint2*)&p.A1[(size_t)row * 1024 + col] = o; }
        else { *(float4*)&p.h2[(size_t)row * 1024 + col] = h; *(uint2*)&p.A2[(size_t)row * 1024 + col] = o; }
      } else if (MODE == 3) {
        uint2 o; o.x = pack2(v[0] * rs, v[1] * rs); o.y = pack2(v[2] * rs, v[3] * rs);
        *(uint2*)&p.qb[(size_t)row * 1024 + col] = o;
      } else {
        uint2 o; o.x = pack2(v[0] * rs, v[1] * rs); o.y = pack2(v[2] * rs, v[3] * rs);
        *(uint2*)&p.pq[(size_t)row * 2048 + col] = o;
      }
    }
    if (MODE == 2 || MODE == 4) {
      ssq += __shfl_xor(ssq, 16);
      ssq += __shfl_xor(ssq, 32);
      if (kg == 0) atomicAdd((MODE == 2) ? &p.ssq1[row] : &p.ssq2[row], ssq);
    }
  }
}

DI bool xcd_tile(int it, int nM, int nN, int& tm, int& tn) {
  const int per = gridDim.x >> 3;
  const int xcd = blockIdx.x & 7, li = blockIdx.x >> 3;
  const int i = (it * 8 + xcd) * per + li;
  if (i >= nM * nN) return false;
  const int panel = i / (8 * nN), within = i - panel * 8 * nN;
  const int rows = (nM - panel * 8) < 8 ? (nM - panel * 8) : 8;
  tn = within / rows;
  tm = panel * 8 + (within - tn * rows);
  return true;
}

DI void tr_tile(const float* __restrict__ W, int ldw, int nsrc0, u16* __restrict__ Wt, int K, int k0, int n0, float* tile) {
  const int tid = threadIdx.x;
  const int n = tid & 63, kq = tid >> 6;
  __syncthreads();
#pragma unroll
  for (int i = 0; i < 16; ++i) { int kk = kq + 4 * i; tile[kk * 65 + n] = W[(size_t)(k0 + kk) * ldw + nsrc0 + n]; }
  __syncthreads();
  const int nn = tid >> 2, ks = (tid & 3) * 16;
  unsigned o[8];
#pragma unroll
  for (int i = 0; i < 8; ++i) o[i] = pack2(tile[(ks + 2 * i) * 65 + nn], tile[(ks + 2 * i + 1) * 65 + nn]);
  u16* d = Wt + (size_t)(n0 + nn) * K + k0 + ks;
  *(uint4*)d = make_uint4(o[0], o[1], o[2], o[3]);
  *(uint4*)(d + 8) = make_uint4(o[4], o[5], o[6], o[7]);
}

DI void phase0(const Params& p, char* smem) {
  const int tid = threadIdx.x, lane = tid & 63, w = tid >> 6;
  const size_t gtid = (size_t)blockIdx.x * 256 + tid, gsz = (size_t)gridDim.x * 256;
  {
    const float* eu = p.expert_u;
    const float* ev = p.expert_v;
    unsigned char* e8 = p.E8;
    float* rsp = p.rs;
    const int sub = lane & 15, rq = lane >> 4;
    for (int er0 = (blockIdx.x * 4 + w) * 4; er0 < 32768; er0 += gridDim.x * 16) {
      const int er = er0 + rq;
      const float* src = (er < 16384) ? (eu + (size_t)er * 1024) : (ev + (size_t)(er - 16384) * 1024);
      float4 v[16];
      float am = 0.f;
#pragma unroll
      for (int i = 0; i < 16; ++i) {
        v[i] = *(const float4*)&src[(i >> 2) * 256 + sub * 16 + (i & 3) * 4];
        am = fmaxf(am, fmaxf(fmaxf(fabsf(v[i].x), fabsf(v[i].y)), fmaxf(fabsf(v[i].z), fabsf(v[i].w))));
      }
      am = fmaxf(am, __shfl_xor(am, 1)); am = fmaxf(am, __shfl_xor(am, 2));
      am = fmaxf(am, __shfl_xor(am, 4)); am = fmaxf(am, __shfl_xor(am, 8));
      const float sc = (am > 0.f) ? 224.f / am : 1.f;
#pragma unroll
      for (int c = 0; c < 4; ++c) {
        int o[4];
#pragma unroll
        for (int i = 0; i < 4; ++i) {
          const float4 t4 = v[c * 4 + i];
          int t = __builtin_amdgcn_cvt_pk_fp8_f32(t4.x * sc, t4.y * sc, 0, false);
          o[i] = __builtin_amdgcn_cvt_pk_fp8_f32(t4.z * sc, t4.w * sc, t, true);
        }
        *(uint4*)&e8[(size_t)er * 1024 + c * 256 + sub * 16] = make_uint4((unsigned)o[0], (unsigned)o[1], (unsigned)o[2], (unsigned)o[3]);
      }
      if (sub == 0) rsp[er] = (am > 0.f) ? am * (1.f / 224.f) : 1.f;
    }
  }
  for (size_t i = gtid; i < 262144 / 8; i += gsz) cvt8(p.sub_keys + i * 8, p.subkb + i * 8);
  for (size_t i = gtid; i < MT; i += gsz) { p.ssq1[i] = 0.f; p.ssq2[i] = 0.f; }
  float* wl = (float*)smem;
  __syncthreads();
  for (int i = tid; i < 2048; i += 256) {
    const int k = i >> 1, hf = i & 1;
    float4 t = *(const float4*)&p.w_in[(size_t)k * 4360 + 1536 + hf * 4];
    wl[(hf * 4 + 0) * 1024 + k] = t.x; wl[(hf * 4 + 1) * 1024 + k] = t.y; wl[(hf * 4 + 2) * 1024 + k] = t.z; wl[(hf * 4 + 3) * 1024 + k] = t.w;
  }
  __syncthreads();
  const float* xpp = p.x_prompt;
  const float* xsp = p.x_sample;
  const float* mpp = p.mem_prompt;
  const float* gmx = p.g_mix;
  const float* gmk = p.g_memkv;
  u16* a0p = p.A0;
  u16* amp = p.Amem;
  {
    const int sub = lane & 15, rq = lane >> 4;
    for (int row0 = (blockIdx.x * 4 + w) * 4; row0 < MT + 1024; row0 += gridDim.x * 16) {
      const int row = row0 + rq;
      const float* src; const float* g; u16* dst;
      if (row < MP) { src = xpp + (size_t)row * 1024; g = gmx; dst = a0p + (size_t)row * 1024; }
      else if (row < MT) { src = xsp + (size_t)(row - MP) * 1024; g = gmx; dst = a0p + (size_t)row * 1024; }
      else { src = mpp + (size_t)(row - MT) * 1024; g = gmk; dst = amp + (size_t)(row - MT) * 1024; }
      float4 v[16];
      float ss = 0.f;
#pragma unroll
      for (int i = 0; i < 16; ++i) { v[i] = *(const float4*)&src[i * 64 + sub * 4]; ss += v[i].x * v[i].x + v[i].y * v[i].y + v[i].z * v[i].z + v[i].w * v[i].w; }
      ss += __shfl_xor(ss, 1); ss += __shfl_xor(ss, 2); ss += __shfl_xor(ss, 4); ss += __shfl_xor(ss, 8);
      const float rs = rsqrtf(ss * (1.f / 1024.f) + EPS);
      float d8[8] = {0.f, 0.f, 0.f, 0.f, 0.f, 0.f, 0.f, 0.f};
#pragma unroll
      for (int i = 0; i < 16; ++i) {
        float4 g4 = *(const float4*)&g[i * 64 + sub * 4];
        float y[4] = {v[i].x * rs * g4.x, v[i].y * rs * g4.y, v[i].z * rs * g4.z, v[i].w * rs * g4.w};
        uint2 o; o.x = pack2(y[0], y[1]); o.y = pack2(y[2], y[3]);
        *(uint2*)&dst[i * 64 + sub * 4] = o;
        if (row < MT) {
#pragma unroll
          for (int j = 0; j < 8; ++j) {
            float4 wv = *(const float4*)&wl[j * 1024 + i * 64 + sub * 4];
            d8[j] += y[0] * wv.x + y[1] * wv.y + y[2] * wv.z + y[3] * wv.w;
          }
        }
      }
      if (row < MT) {
#pragma unroll
        for (int j = 0; j < 8; ++j) {
          d8[j] += __shfl_xor(d8[j], 1); d8[j] += __shfl_xor(d8[j], 2); d8[j] += __shfl_xor(d8[j], 4); d8[j] += __shfl_xor(d8[j], 8);
        }
        if (sub < 4) {
          float ag = sel4(sub, d8[0], d8[1], d8[2], d8[3]);
          float bg = sel4(sub, d8[4], d8[5], d8[6], d8[7]);
          float xs = ag + p.dt_bias[sub];
          float sp = (xs > 20.f) ? xs : log1pf(expf(xs));
          p.gb[(size_t)row * 8 + sub] = -expf(p.a_log[sub]) * sp;
          p.gb[(size_t)row * 8 + 4 + sub] = 1.f / (1.f + expf(-bg));
        }
      }
    }
  }
  __syncthreads();
  float* tile = (float*)smem;
  for (int j = blockIdx.x; j < 2816; j += gridDim.x) {
    int t = j;
    if (t < 1088) { int kt = t / 68, nt = t % 68; int n0 = nt * 64; tr_tile(p.w_in, 4360, n0 + (n0 >= 1536 ? 8 : 0), p.WtIn, 1024, kt * 64, n0, tile); continue; }
    t -= 1088;
    if (t < 192) { int kt = t / 16, nt = t % 16; tr_tile(p.w_out, 1024, nt * 64, p.WtOut, 768, kt * 64, nt * 64, tile); continue; }
    t -= 192;
    if (t < 256) { int kt = t / 16, nt = t % 16; tr_tile(p.w_mq, 1024, nt * 64, p.WtMq, 1024, kt * 64, nt * 64, tile); continue; }
    t -= 256;
    if (t < 512) { int kt = t / 32, nt = t % 32; tr_tile(p.w_mkv, 2048, nt * 64, p.WtMkv, 1024, kt * 64, nt * 64, tile); continue; }
    t -= 512;
    if (t < 256) { int kt = t / 16, nt = t % 16; tr_tile(p.w_mo, 1024, nt * 64, p.WtMo, 1024, kt * 64, nt * 64, tile); continue; }
    t -= 256;
    { int kt = t / 32, nt = t % 32; tr_tile(p.w_pq, 2048, nt * 64, p.WtPq, 1024, kt * 64, nt * 64, tile); }
  }
}

DI void dn_prep(const Params& p, int item, char* smem) {
  u16* qs = (u16*)smem;
  u16* ksm = qs + 64 * 136;
  float* sL = (float*)(ksm + 64 * 136);
  float* sgc = sL + 64 * 64;
  float* sbeta = sgc + 64;
  u16* sU = (u16*)sL;
  u16* sW = qs;
  const int tid = threadIdx.x, lane = tid & 63, w = tid >> 6, r = lane & 15, kg = lane >> 4;
  const int bh = item >> 7, n = item & 127, b = bh >> 2, h = bh & 3;
  const int t0 = n * 64;
  const size_t rowbase = (size_t)b * SEQ;
  char* ops = p.dnops + (size_t)item * DN_ITEM;
  __syncthreads();
  if (tid < 64) {
    float gv = p.gb[(rowbase + t0 + tid) * 8 + h];
    float bv = p.gb[(rowbase + t0 + tid) * 8 + 4 + h];
#pragma unroll
    for (int o = 1; o < 64; o <<= 1) { float t = __shfl_up(gv, o); if (lane >= o) gv += t; }
    sgc[tid] = gv; sbeta[tid] = bv;
    if (tid == 63) p.dl[item] = __expf(gv);
  }
#pragma unroll 4
  for (int ps = 0; ps < 8; ++ps) {
    const int combo = ps * 16 + (tid >> 4);
    const int tt = combo & 63, part = combo >> 6, sub = tid & 15;
    const int col = part * 512 + h * 128 + sub * 8;
    float y[8] = {0.f, 0.f, 0.f, 0.f, 0.f, 0.f, 0.f, 0.f};
#pragma unroll
    for (int j = 0; j < 4; ++j) {
      const int t = t0 + tt - 3 + j;
      if (t >= 0) {
        uint4 xv = *(const uint4*)&p.proj[(rowbase + t) * NP + col];
        float4 wa = *(const float4*)&p.conv_w[j * 1536 + col], wb = *(const float4*)&p.conv_w[j * 1536 + col + 4];
        y[0] += bflo(xv.x) * wa.x; y[1] += bfhi(xv.x) * wa.y; y[2] += bflo(xv.y) * wa.z; y[3] += bfhi(xv.y) * wa.w;
        y[4] += bflo(xv.z) * wb.x; y[5] += bfhi(xv.z) * wb.y; y[6] += bflo(xv.w) * wb.z; y[7] += bfhi(xv.w) * wb.w;
      }
    }
    float ss = 0.f;
#pragma unroll
    for (int e = 0; e < 8; ++e) { y[e] = siluf(y[e]); ss += y[e] * y[e]; }
    ss += __shfl_xor(ss, 1); ss += __shfl_xor(ss, 2); ss += __shfl_xor(ss, 4); ss += __shfl_xor(ss, 8);
    float sc = rsqrtf(ss + EPS) * (part == 0 ? 0.08838834764831845f : 1.f);
    uint4 o; o.x = pack2(y[0] * sc, y[1] * sc); o.y = pack2(y[2] * sc, y[3] * sc); o.z = pack2(y[4] * sc, y[5] * sc); o.w = pack2(y[6] * sc, y[7] * sc);
    *(uint4*)&((part == 0 ? qs : ksm)[tt * 136 + sub * 8]) = o;
  }
  __syncthreads();
  const float gcl = sgc[63];
  {
    f32x4 aL[4], aA[4];
#pragma unroll
    for (int i = 0; i < 4; ++i) { aL[i] = (f32x4){0.f, 0.f, 0.f, 0.f}; aA[i] = (f32x4){0.f, 0.f, 0.f, 0.f}; }
#pragma unroll
    for (int ks = 0; ks < 4; ++ks) {
      bf16x8 kI = *(const bf16x8*)&ksm[(w * 16 + r) * 136 + ks * 32 + kg * 8];
      bf16x8 qI = *(const bf16x8*)&qs[(w * 16 + r) * 136 + ks * 32 + kg * 8];
#pragma unroll
      for (int nt = 0; nt < 4; ++nt) {
        bf16x8 kJ = *(const bf16x8*)&ksm[(nt * 16 + r) * 136 + ks * 32 + kg * 8];
        aL[nt] = MFMA(kJ, kI, aL[nt]);
        aA[nt] = MFMA(kJ, qI, aA[nt]);
      }
    }
    const int i = w * 16 + r;
    const float gci = sgc[i], bi = sbeta[i];
    u16* aq = (u16*)(ops + 49152);
#pragma unroll
    for (int nt = 0; nt < 4; ++nt) {
      float lv[4], av[4];
#pragma unroll
      for (int jj = 0; jj < 4; ++jj) {
        const int j = nt * 16 + kg * 4 + jj;
        const float gam = (i >= j) ? __expf(gci - sgc[j]) : 0.f;
        lv[jj] = (i > j) ? aL[nt][jj] * bi * gam : 0.f;
        av[jj] = aA[nt][jj] * gam;
      }
      *(float4*)&sL[i * 64 + nt * 16 + kg * 4] = make_float4(lv[0], lv[1], lv[2], lv[3]);
      uint2 o; o.x = pack2(av[0], av[1]); o.y = pack2(av[2], av[3]);
      *(uint2*)&aq[((w * 2 + (nt >> 1)) * 64 + lane) * 8 + (nt & 1) * 4] = o;
    }
  }
  {
    u16* qg = (u16*)(ops + 16384);
    u16* kdT = (u16*)(ops + 32768);
#pragma unroll 1
    for (int i = 0; i < 4; ++i) {
      const int f = tid + 256 * i;
      const int mtks = f >> 6, l = f & 63, rr = l & 15, kgg = l >> 4;
      {
        const int mt = mtks >> 2, ks = mtks & 3, row = mt * 16 + rr;
        const float e = __expf(sgc[row]);
        uint2 a = *(const uint2*)&qs[row * 136 + ks * 32 + kgg * 4];
        uint2 c = *(const uint2*)&qs[row * 136 + ks * 32 + 16 + kgg * 4];
        uint4 o;
        o.x = pack2(bflo(a.x) * e, bfhi(a.x) * e); o.y = pack2(bflo(a.y) * e, bfhi(a.y) * e);
        o.z = pack2(bflo(c.x) * e, bfhi(c.x) * e); o.w = pack2(bflo(c.y) * e, bfhi(c.y) * e);
        *(uint4*)&qg[(size_t)f * 8] = o;
      }
      {
        const int mt = mtks >> 1, ks = mtks & 1, kdim = mt * 16 + rr;
        float v[8];
#pragma unroll
        for (int j = 0; j < 8; ++j) {
          const int c = ks * 32 + permk(kgg, j);
          v[j] = bf2f(ksm[c * 136 + kdim]) * __expf(gcl - sgc[c]);
        }
        uint4 o; o.x = pack2(v[0], v[1]); o.y = pack2(v[2], v[3]); o.z = pack2(v[4], v[5]); o.w = pack2(v[6], v[7]);
        *(uint4*)&kdT[(size_t)f * 8] = o;
      }
    }
  }
  __syncthreads();
  float x[64];
  if (tid < 128) {
    const int col = 1024 + h * 128 + tid;
    const float w0 = p.conv_w[col], w1 = p.conv_w[1536 + col], w2 = p.conv_w[3072 + col], w3 = p.conv_w[4608 + col];
    float xm3 = 0.f, xm2 = 0.f, xm1 = 0.f;
    if (t0 > 0) {
      xm3 = bf2f(p.proj[(rowbase + t0 - 3) * NP + col]);
      xm2 = bf2f(p.proj[(rowbase + t0 - 2) * NP + col]);
      xm1 = bf2f(p.proj[(rowbase + t0 - 1) * NP + col]);
    }
#pragma unroll
    for (int t = 0; t < 64; ++t) {
      float xc = bf2f(p.proj[(rowbase + t0 + t) * NP + col]);
      float yv = w0 * xm3 + w1 * xm2 + w2 * xm1 + w3 * xc;
      x[t] = siluf(yv) * sbeta[t];
      xm3 = xm2; xm2 = xm1; xm1 = xc;
    }
  } else {
    const int kc = tid - 128;
#pragma unroll
    for (int t = 0; t < 64; ++t) x[t] = bf2f(ksm[t * 136 + kc]) * sbeta[t] * __expf(sgc[t]);
  }
#pragma unroll
  for (int i = 1; i < 64; ++i) {
    float s = x[i];
#pragma unroll
    for (int j4 = 0; j4 < (i + 3) / 4; ++j4) {
      float4 l = *(const float4*)&sL[i * 64 + j4 * 4];
      s -= l.x * x[j4 * 4];
      if (j4 * 4 + 1 < i) s -= l.y * x[j4 * 4 + 1];
      if (j4 * 4 + 2 < i) s -= l.z * x[j4 * 4 + 2];
      if (j4 * 4 + 3 < i) s -= l.w * x[j4 * 4 + 3];
    }
    x[i] = s;
  }
  __syncthreads();
  if (tid < 128) {
#pragma unroll
    for (int t = 0; t < 64; ++t) sU[t * 128 + tid] = f2bf(x[t]);
  } else {
    const int kc = tid - 128;
#pragma unroll
    for (int t = 0; t < 64; ++t) sW[t * 136 + kc] = f2bf(-x[t]);
  }
  __syncthreads();
  {
    u16* nW = (u16*)ops;
    u16* u0 = (u16*)(ops + 57344);
#pragma unroll 1
    for (int i = 0; i < 4; ++i) {
      const int f = tid + 256 * i;
      const int mtks = f >> 6, l = f & 63, rr = l & 15, kgg = l >> 4;
      const int mt = mtks >> 2, ks = mtks & 3, row = mt * 16 + rr;
      uint2 a = *(const uint2*)&sW[row * 136 + ks * 32 + kgg * 4];
      uint2 c = *(const uint2*)&sW[row * 136 + ks * 32 + 16 + kgg * 4];
      *(uint4*)&nW[(size_t)f * 8] = make_uint4(a.x, a.y, c.x, c.y);
    }
#pragma unroll 1
    for (int i = 0; i < 8; ++i) {
      const int f = tid + 256 * i;
      const int smt = f >> 6, l = f & 63, rr = l & 15, kgg = l >> 4;
      const int s = smt >> 2, mt = smt & 3;
      u16 v0 = sU[(mt * 16 + kgg * 4 + 0) * 128 + s * 16 + rr];
      u16 v1 = sU[(mt * 16 + kgg * 4 + 1) * 128 + s * 16 + rr];
      u16 v2 = sU[(mt * 16 + kgg * 4 + 2) * 128 + s * 16 + rr];
      u16 v3 = sU[(mt * 16 + kgg * 4 + 3) * 128 + s * 16 + rr];
      *(uint2*)&u0[(size_t)f * 4] = make_uint2((unsigned)v0 | ((unsigned)v1 << 16), (unsigned)v2 | ((unsigned)v3 << 16));
    }
  }
}

DI void vt_tile(const Params& p, int item, char* smem) {
  u16* tile = (u16*)smem;
  const int tid = threadIdx.x;
  const int ptile = item & 127, gbh = item >> 7;
  const int h = gbh & 3, b = (gbh >> 2) & 3, g = gbh >> 4;
  const int dsh = g * 2, ln = SEQ >> dsh;
  const int pos0 = ptile * 64;
  const int rres = pos0 / ln, i0 = pos0 % ln;
  __syncthreads();
  {
    const int pr = tid >> 2, seg = (tid & 3) * 16;
    const int token = ((i0 + pr) << dsh) + rres;
    const u16* src = &p.proj[((size_t)b * SEQ + token) * NP + 2048 + g * 768 + 512 + h * 64 + seg];
    uint4 a = *(const uint4*)src, c = *(const uint4*)(src + 8);
    unsigned d[8] = {a.x, a.y, a.z, a.w, c.x, c.y, c.z, c.w};
#pragma unroll
    for (int e = 0; e < 8; ++e) *(unsigned*)&tile[pr * 66 + seg + e * 2] = d[e];
  }
  __syncthreads();
  {
    const int dh = tid >> 2, seg = (tid & 3) * 16;
    unsigned o[8];
#pragma unroll
    for (int e = 0; e < 8; ++e) o[e] = (unsigned)tile[(seg + 2 * e) * 66 + dh] | ((unsigned)tile[(seg + 2 * e + 1) * 66 + dh] << 16);
    u16* d = &p.vT[((size_t)gbh * 64 + dh) * SEQ + pos0 + seg];
    *(uint4*)d = make_uint4(o[0], o[1], o[2], o[3]);
    *(uint4*)(d + 8) = make_uint4(o[4], o[5], o[6], o[7]);
  }
}

DI void dn_sample(const Params& p, int item, char* smem) {
  float* sq = (float*)smem;
  float* sk = sq + 512;
  float* sv = sk + 512;
  float* red = sv + 512;
  const int tid = threadIdx.x, lane = tid & 63, w = tid >> 6;
  const int b = item >> 2, h = item & 3;
  __syncthreads();
  for (int c = tid; c < 384; c += 256) {
    const int part = c >> 7, cc = c & 127;
    const int col = part * 512 + h * 128 + cc;
    float xp[7];
#pragma unroll
    for (int j = 0; j < 3; ++j) xp[j] = p.state_conv[((size_t)b * 3 + j) * 1536 + col];
#pragma unroll
    for (int j = 0; j < 4; ++j) xp[3 + j] = bf2f(p.proj[((size_t)MP + b * 4 + j) * NP + col]);
    const float w0 = p.conv_w[col], w1 = p.conv_w[1536 + col], w2 = p.conv_w[3072 + col], w3 = p.conv_w[4608 + col];
    float* dst = part == 0 ? sq : (part == 1 ? sk : sv);
#pragma unroll
    for (int t = 0; t < 4; ++t) dst[t * 128 + cc] = siluf(w0 * xp[t] + w1 * xp[t + 1] + w2 * xp[t + 2] + w3 * xp[t + 3]);
  }
  __syncthreads();
  {
    float a0 = sq[w * 128 + lane], a1 = sq[w * 128 + 64 + lane];
    float s = wave_sum(a0 * a0 + a1 * a1);
    float sc = rsqrtf(s + EPS) * 0.08838834764831845f;
    sq[w * 128 + lane] = a0 * sc; sq[w * 128 + 64 + lane] = a1 * sc;
    float b0 = sk[w * 128 + lane], b1 = sk[w * 128 + 64 + lane];
    s = wave_sum(b0 * b0 + b1 * b1);
    sc = rsqrtf(s + EPS);
    sk[w * 128 + lane] = b0 * sc; sk[w * 128 + 64 + lane] = b1 * sc;
  }
  __syncthreads();
  const int v = tid & 127, half = tid >> 7;
  float S[64];
  const float* s0 = p.state_delta + (((size_t)b * 4 + h) * 128 + half * 64) * 128 + v;
#pragma unroll
  for (int i = 0; i < 64; ++i) S[i] = s0[(size_t)i * 128];
#pragma unroll 1
  for (int t = 0; t < 4; ++t) {
    const size_t row = (size_t)MP + b * 4 + t;
    const float a = __expf(p.gb[row * 8 + h]);
    const float beta = p.gb[row * 8 + 4 + h];
    float part = 0.f;
#pragma unroll
    for (int i = 0; i < 64; ++i) part += S[i] * sk[t * 128 + half * 64 + i];
    red[half * 128 + v] = part;
    __syncthreads();
    const float kS = red[v] + red[128 + v];
    const float u = beta * (sv[t * 128 + v] - a * kS);
    float po = 0.f;
#pragma unroll
    for (int i = 0; i < 64; ++i) { S[i] = a * S[i] + sk[t * 128 + half * 64 + i] * u; po += S[i] * sq[t * 128 + half * 64 + i]; }
    __syncthreads();
    red[half * 128 + v] = po;
    __syncthreads();
    if (half == 0) p.odn[row * 512 + h * 128 + v] = f2bf(red[v] + red[128 + v]);
    __syncthreads();
  }
  float* d = p.out + O_SDELTA + (((size_t)b * 4 + h) * 128 + half * 64) * 128 + v;
#pragma unroll
  for (int i = 0; i < 64; ++i) d[(size_t)i * 128] = S[i];
}

DI void phase2(const Params& p, char* smem) {
  const size_t gtid = (size_t)blockIdx.x * 256 + threadIdx.x, gsz = (size_t)gridDim.x * 256;
  for (int j = blockIdx.x; j < 2048 + 128 + 6144; j += gridDim.x) {
    if (j < 2048) dn_prep(p, j, smem);
    else if (j < 2048 + 128) dn_sample(p, j - 2048, smem);
    else vt_tile(p, j - 2176, smem);
  }
  for (size_t f = gtid; f < (size_t)16 * 8192; f += gsz) {
    {
      const size_t e0 = f * 8;
      const int bh = (int)(e0 >> 16), key = (int)((e0 >> 8) & 255), dh = (int)(e0 & 255);
      const int b = bh >> 2, h = bh & 3;
      cvt8(p.out + O_PMEM + (((size_t)b * 256 + key) * 2 + 0) * 1024 + h * 256 + dh, p.Kb + e0);
    }
    {
      const int l = (int)(f & 63), ks = (int)((f >> 6) & 7), nt = (int)((f >> 9) & 15), bh = (int)(f >> 13);
      const int b = bh >> 2, h = bh & 3, rr = l & 15, kgg = l >> 4;
      float v[8];
#pragma unroll
      for (int j = 0; j < 8; ++j) {
        const int key = ks * 32 + permk(kgg, j);
        v[j] = p.out[O_PMEM + (((size_t)b * 256 + key) * 2 + 1) * 1024 + h * 256 + nt * 16 + rr];
      }
      *(uint4*)&p.VTf[f * 8] = make_uint4(pack2(v[0], v[1]), pack2(v[2], v[3]), pack2(v[4], v[5]), pack2(v[6], v[7]));
    }
  }
  for (size_t i = gtid; i < 18432; i += gsz) {
    const int c = (int)(i % 1536), j = (int)((i / 1536) % 3), b = (int)(i / 4608);
    p.out[O_PCONV + i] = bf2f(p.proj[((size_t)b * SEQ + SEQ - 3 + j) * NP + c]);
  }
  for (int g = 0; g < 3; ++g) {
    const int W = 128 << (2 * g);
    const size_t off = (g == 0) ? O_PW1 : (g == 1 ? O_PW2 : O_PW3);
    const size_t n4 = (size_t)4 * W * 512 / 4;
    for (size_t i = gtid; i < n4; i += gsz) {
      const size_t e0 = i * 4;
      const int e = (int)(e0 & 511), ii = (int)((e0 >> 9) % W), b = (int)((e0 >> 9) / W);
      uint2 v = *(const uint2*)&p.proj[((size_t)b * SEQ + SEQ - W + ii) * NP + 2048 + g * 768 + 256 + e];
      *(float4*)&p.out[off + e0] = make_float4(bflo(v.x), bfhi(v.x), bflo(v.y), bfhi(v.y));
    }
  }
}

typedef __attribute__((ext_vector_type(2))) unsigned u32x2;
struct ScanOps { bf16x8 nW[4]; bf16x8 qg[4]; bf16x8 aq[2]; bf16x8 kd[4]; u32x2 u0; float dl; };

DI void scan_load(const Params& p, int bh, int s, int n, int j, int lane, ScanOps& o) {
  n = n > 127 ? 127 : n;
  const char AS1* base = (const char AS1*)p.dnops + (size_t)(bh * 128 + n) * DN_ITEM;
  gb8p negW = (gb8p)base;
  gb8p qg = (gb8p)(base + 16384);
  gb8p kdT = (gb8p)(base + 32768);
  gb8p aqk = (gb8p)(base + 49152);
  const u32x2 AS1* u0 = (const u32x2 AS1*)(base + 57344);
#pragma unroll
  for (int ks = 0; ks < 4; ++ks) o.nW[ks] = negW[(j * 4 + ks) * 64 + lane];
#pragma unroll
  for (int ks = 0; ks < 4; ++ks) o.qg[ks] = qg[(j * 4 + ks) * 64 + lane];
#pragma unroll
  for (int k2 = 0; k2 < 2; ++k2) o.aq[k2] = aqk[(j * 2 + k2) * 64 + lane];
#pragma unroll
  for (int mm = 0; mm < 2; ++mm)
#pragma unroll
    for (int k2 = 0; k2 < 2; ++k2) o.kd[mm * 2 + k2] = kdT[((2 * j + mm) * 2 + k2) * 64 + lane];
  o.u0 = u0[(s * 4 + j) * 64 + lane];
  o.dl = ((const float AS1*)p.dl)[bh * 128 + n];
}

DI void scan_step(const Params& p, const ScanOps& ops, int n, int b, int h, int s, int j, int lane, f32x4& S0, f32x4& S1,
                  bf16x8* sSb, u32x2* sUb) {
  const int r = lane & 15, kg = lane >> 4;
  bf16x8 sb[4];
#pragma unroll
  for (int ks = 0; ks < 4; ++ks) sb[ks] = sSb[ks * 64 + lane];
  f32x4 u = (f32x4){bflo(ops.u0[0]), bfhi(ops.u0[0]), bflo(ops.u0[1]), bfhi(ops.u0[1])};
#pragma unroll
  for (int ks = 0; ks < 4; ++ks) u = MFMA(ops.nW[ks], sb[ks], u);
  {
    u32x2 t; t[0] = pack2(u[0], u[1]); t[1] = pack2(u[2], u[3]);
    sUb[((j >> 1) * 64 + lane) * 2 + (j & 1)] = t;
  }
  __syncthreads();
  bf16x8 ub[2];
#pragma unroll
  for (int k2 = 0; k2 < 2; ++k2) ub[k2] = *(const bf16x8*)&sUb[(k2 * 64 + lane) * 2];
  f32x4 o = (f32x4){0.f, 0.f, 0.f, 0.f};
#pragma unroll
  for (int ks = 0; ks < 4; ++ks) o = MFMA(ops.qg[ks], sb[ks], o);
#pragma unroll
  for (int k2 = 0; k2 < 2; ++k2) o = MFMA(ops.aq[k2], ub[k2], o);
  S0 = S0 * ops.dl; S1 = S1 * ops.dl;
#pragma unroll
  for (int k2 = 0; k2 < 2; ++k2) { S0 = MFMA(ops.kd[k2], ub[k2], S0); S1 = MFMA(ops.kd[2 + k2], ub[k2], S1); }
  sSb[j * 64 + lane] = pack8(S0, S1);
#pragma unroll
  for (int jj = 0; jj < 4; ++jj) {
    const size_t token = (size_t)b * SEQ + n * 64 + j * 16 + kg * 4 + jj;
    G(p.odn)[token * 512 + h * 128 + s * 16 + r] = f2bf(o[jj]);
  }
  __syncthreads();
}

DI void dn_scan_block(const Params& p, int item, char* smem) {
  const int lane = threadIdx.x & 63, j = threadIdx.x >> 6, r = lane & 15, kg = lane >> 4;
  const int bh = item >> 3, s = item & 7, b = bh >> 2, h = bh & 3;
  bf16x8* sSb = (bf16x8*)smem;
  u32x2* sUb = (u32x2*)(smem + 4096);
  f32x4 S0 = (f32x4){0.f, 0.f, 0.f, 0.f}, S1 = (f32x4){0.f, 0.f, 0.f, 0.f};
  __syncthreads();
  sSb[j * 64 + lane] = pack8(S0, S1);
  ScanOps A, B;
  scan_load(p, bh, s, 0, j, lane, A);
  scan_load(p, bh, s, 1, j, lane, B);
  __syncthreads();
#pragma unroll 1
  for (int n0 = 0; n0 < 128; n0 += 2) {
    scan_step(p, A, n0, b, h, s, j, lane, S0, S1, sSb, sUb);
    scan_load(p, bh, s, n0 + 2, j, lane, A);
    scan_step(p, B, n0 + 1, b, h, s, j, lane, S0, S1, sSb, sUb);
    scan_load(p, bh, s, n0 + 3, j, lane, B);
  }
#pragma unroll
  for (int jj = 0; jj < 4; ++jj) {
    p.out[O_PDELTA + ((size_t)bh * 128 + 32 * j + kg * 4 + jj) * 128 + s * 16 + r] = S0[jj];
    p.out[O_PDELTA + ((size_t)bh * 128 + 32 * j + 16 + kg * 4 + jj) * 128 + s * 16 + r] = S1[jj];
  }
}

DI void sw_prompt_wave(const Params& p, int item) {
  const int lane = threadIdx.x & 63, r = lane & 15, kg = lane >> 4;
  const int qt = item & 511, gbh = item >> 9;
  const int h = gbh & 3, b = (gbh >> 2) & 3, g = gbh >> 4;
  const int dsh = 2 * g, ln = SEQ >> dsh;
  const int pos0 = qt * 16, rres = pos0 / ln, i0 = pos0 % ln;
  const int kbase = i0 - 144;
  const size_t rb = (size_t)b * SEQ;
  const int qoff = 2048 + g * 768 + h * 64, koff = qoff + 256;
  bf16x8 qf[2];
  {
    const size_t tok = rb + ((size_t)(i0 + r) << dsh) + rres;
#pragma unroll
    for (int ks = 0; ks < 2; ++ks) qf[ks] = *(const bf16x8*)&p.proj[tok * NP + qoff + ks * 32 + kg * 8];
  }
  f32x4 st[10];
#pragma unroll
  for (int mt = 0; mt < 10; ++mt) {
    int ki = kbase + mt * 16 + r; ki = ki < 0 ? 0 : ki;
    const size_t tok = rb + ((size_t)ki << dsh) + rres;
    f32x4 a = (f32x4){0.f, 0.f, 0.f, 0.f};
#pragma unroll
    for (int ks = 0; ks < 2; ++ks) {
      bf16x8 kf = *(const bf16x8*)&p.proj[tok * NP + koff + ks * 32 + kg * 8];
      a = MFMA(kf, qf[ks], a);
    }
    st[mt] = a;
  }
  const int qi = i0 + r;
  float mx = -3.0e38f;
#pragma unroll
  for (int mt = 0; mt < 10; ++mt)
#pragma unroll
    for (int j = 0; j < 4; ++j) {
      const int ki = kbase + mt * 16 + kg * 4 + j;
      const int d = qi - ki;
      const bool valid = (ki >= 0) && (d >= 0) && (d <= 128);
      const float sv = valid ? st[mt][j] * 0.125f : -3.0e38f;
      st[mt][j] = sv;
      mx = fmaxf(mx, sv);
    }
  mx = fmaxf(mx, __shfl_xor(mx, 16));
  mx = fmaxf(mx, __shfl_xor(mx, 32));
  float sum = 0.f;
#pragma unroll
  for (int mt = 0; mt < 10; ++mt)
#pragma unroll
    for (int j = 0; j < 4; ++j) {
      const float pv = (st[mt][j] > -1.0e38f) ? __expf(st[mt][j] - mx) : 0.f;
      st[mt][j] = pv;
      sum += pv;
    }
  sum += __shfl_xor(sum, 16);
  sum += __shfl_xor(sum, 32);
  const float inv = 1.f / sum;
  bf16x8 pf[5];
#pragma unroll
  for (int k2 = 0; k2 < 5; ++k2) pf[k2] = pack8(st[2 * k2], st[2 * k2 + 1]);
  const size_t qrow = rb + ((size_t)qi << dsh) + rres;
#pragma unroll
  for (int nt = 0; nt < 4; ++nt) {
    f32x4 o = (f32x4){0.f, 0.f, 0.f, 0.f};
    const u16* vrow = &p.vT[((size_t)gbh * 64 + nt * 16 + r) * SEQ + (size_t)rres * ln];
#pragma unroll
    for (int k2 = 0; k2 < 5; ++k2) {
      int ka = kbase + k2 * 32 + kg * 4, kc = ka + 16;
      ka = ka < 0 ? 0 : ka; kc = kc < 0 ? 0 : kc;
      uint2 va = *(const uint2*)&vrow[ka];
      uint2 vc = *(const uint2*)&vrow[kc];
      bf16x8 vf = __builtin_bit_cast(bf16x8, make_uint4(va.x, va.y, vc.x, vc.y));
      o = MFMA(vf, pf[k2], o);
    }
    uint2 ov; ov.x = pack2(o[0] * inv, o[1] * inv); ov.y = pack2(o[2] * inv, o[3] * inv);
    *(uint2*)&p.osw[((size_t)g * MT + qrow) * 256 + h * 64 + nt * 16 + kg * 4] = ov;
  }
  if (kg == 0) p.lse[((size_t)g * MT + qrow) * 4 + h] = mx + __logf(sum);
}

DI void sw_sample_wave(const Params& p, int item) {
  const int lane = threadIdx.x & 63;
  const int t = item & 3, h = (item >> 2) & 3, b = (item >> 4) & 31, g = item >> 9;
  const int dil = 1 << (2 * g), W = 128 << (2 * g);
  const float* c1 = p.cw1;
  const float* c2 = p.cw2;
  const float* c3 = p.cw3;
  const float* cache = (g == 0) ? c1 : (g == 1 ? c2 : c3);
  const int qoff = 2048 + g * 768 + h * 64;
  const size_t qrow = (size_t)MP + b * 4 + t;
  float q[64];
#pragma unroll
  for (int c = 0; c < 64; c += 8) {
    uint4 v = *(const uint4*)&p.proj[qrow * NP + qoff + c];
    q[c] = bflo(v.x); q[c + 1] = bfhi(v.x); q[c + 2] = bflo(v.y); q[c + 3] = bfhi(v.y);
    q[c + 4] = bflo(v.z); q[c + 5] = bfhi(v.z); q[c + 6] = bflo(v.w); q[c + 7] = bfhi(v.w);
  }
  float sc[3];
#pragma unroll
  for (int mi = 0; mi < 3; ++mi) {
    const int m = lane + 64 * mi;
    float s = -3.0e38f;
    if (m <= 128) {
      const int j = W + t - m * dil;
      float d = 0.f;
      if (j >= W) {
        const u16* kr = &p.proj[((size_t)MP + b * 4 + (j - W)) * NP + qoff + 256];
#pragma unroll
        for (int c = 0; c < 64; c += 8) {
          uint4 v = *(const uint4*)&kr[c];
          d += q[c] * bflo(v.x) + q[c + 1] * bfhi(v.x) + q[c + 2] * bflo(v.y) + q[c + 3] * bfhi(v.y) + q[c + 4] * bflo(v.z) +
               q[c + 5] * bfhi(v.z) + q[c + 6] * bflo(v.w) + q[c + 7] * bfhi(v.w);
        }
      } else {
        const float* kr = &cache[(((size_t)b * W + j) * 2 + 0) * 256 + h * 64];
#pragma unroll
        for (int c = 0; c < 64; c += 4) {
          float4 v = *(const float4*)&kr[c];
          d += q[c] * v.x + q[c + 1] * v.y + q[c + 2] * v.z + q[c + 3] * v.w;
        }
      }
      s = d * 0.125f;
    }
    sc[mi] = s;
  }
  float mx = wave_max(fmaxf(fmaxf(sc[0], sc[1]), sc[2]));
  float sum = 0.f;
#pragma unroll
  for (int mi = 0; mi < 3; ++mi) { sc[mi] = (sc[mi] > -1.0e38f) ? __expf(sc[mi] - mx) : 0.f; sum += sc[mi]; }
  sum = wave_sum(sum);
  float o = 0.f;
#pragma unroll
  for (int mi = 0; mi < 3; ++mi) {
#pragma unroll 8
    for (int mm = 0; mm < 64; ++mm) {
      const int m = mi * 64 + mm;
      if (m <= 128) {
        const float pv = __shfl(sc[mi], mm);
        const int j = W + t - m * dil;
        float vv;
        if (j >= W) vv = bf2f(p.proj[((size_t)MP + b * 4 + (j - W)) * NP + qoff + 512 + lane]);
        else vv = cache[(((size_t)b * W + j) * 2 + 1) * 256 + h * 64 + lane];
        o += pv * vv;
      }
    }
  }
  p.osw[((size_t)g * MT + qrow) * 256 + h * 64 + lane] = f2bf(o / sum);
  if (lane == 0) p.lse[((size_t)g * MT + qrow) * 4 + h] = mx + __logf(sum);
}

DI void phase3(const Params& p, char* smem) {
  const int w = threadIdx.x >> 6;
  if (blockIdx.x < 128) {
    dn_scan_block(p, blockIdx.x, smem);
  } else {
    const int gw = (blockIdx.x - 128) * 4 + w, nw = (gridDim.x - 128) * 4;
    for (int it = gw; it < 24576 + 1536; it += nw) {
      if (it < 24576) sw_prompt_wave(p, it);
      else sw_sample_wave(p, it - 24576);
    }
  }
}

DI void phase4(const Params& p) {
  const int lane = threadIdx.x & 63, w = threadIdx.x >> 6;
  for (int row = blockIdx.x * 4 + w; row < MT; row += gridDim.x * 4) {
    u16* dst = p.Amix + (size_t)row * 768;
#pragma unroll
    for (int h = 0; h < 4; ++h) {
      unsigned ov = *(const unsigned*)&p.odn[(size_t)row * 512 + h * 128 + lane * 2];
      unsigned zv = *(const unsigned*)&p.proj[(size_t)row * NP + 1536 + h * 128 + lane * 2];
      float o0 = bflo(ov), o1 = bfhi(ov);
      float ss = wave_sum(o0 * o0 + o1 * o1);
      float rs = rsqrtf(ss * (1.f / 128.f) + EPS);
      float2 gn = *(const float2*)&p.g_onorm[lane * 2];
      float y0 = o0 * rs * gn.x * siluf(bflo(zv)), y1 = o1 * rs * gn.y * siluf(bfhi(zv));
      *(unsigned*)&dst[h * 128 + lane * 2] = pack2(y0, y1);
    }
    {
      const int h = lane >> 4;
      float l0 = p.lse[((size_t)0 * MT + row) * 4 + h], l1 = p.lse[((size_t)1 * MT + row) * 4 + h], l2 = p.lse[((size_t)2 * MT + row) * 4 + h];
      float m = fmaxf(l0, fmaxf(l1, l2));
      float e0 = __expf(l0 - m), e1 = __expf(l1 - m), e2 = __expf(l2 - m);
      float inv = 1.f / (e0 + e1 + e2);
      uint2 a = *(const uint2*)&p.osw[((size_t)0 * MT + row) * 256 + lane * 4];
      uint2 c = *(const uint2*)&p.osw[((size_t)1 * MT + row) * 256 + lane * 4];
      uint2 d = *(const uint2*)&p.osw[((size_t)2 * MT + row) * 256 + lane * 4];
      e0 *= inv; e1 *= inv; e2 *= inv;
      float y0 = e0 * bflo(a.x) + e1 * bflo(c.x) + e2 * bflo(d.x);
      float y1 = e0 * bfhi(a.x) + e1 * bfhi(c.x) + e2 * bfhi(d.x);
      float y2 = e0 * bflo(a.y) + e1 * bflo(c.y) + e2 * bflo(d.y);
      float y3 = e0 * bfhi(a.y) + e1 * bfhi(c.y) + e2 * bfhi(d.y);
      *(uint2*)&dst[512 + lane * 4] = make_uint2(pack2(y0, y1), pack2(y2, y3));
    }
  }
}

DI void sample_state_copy(const Params& p) {
  const size_t gtid = (size_t)blockIdx.x * 256 + threadIdx.x, gsz = (size_t)gridDim.x * 256;
  for (size_t i = gtid; i < 147456; i += gsz) {
    const int c = (int)(i % 1536), j = (int)((i / 1536) % 3), b = (int)(i / 4608);
    p.out[O_SCONV + i] = bf2f(p.proj[((size_t)MP + b * 4 + j + 1) * NP + c]);
  }
  const float* c1 = p.cw1;
  const float* c2 = p.cw2;
  const float* c3 = p.cw3;
  for (int g = 0; g < 3; ++g) {
    const int W = 128 << (2 * g);
    const float* cache = (g == 0) ? c1 : (g == 1 ? c2 : c3);
    const size_t off = (g == 0) ? O_SW1 : (g == 1 ? O_SW2 : O_SW3);
    const size_t n4 = (size_t)32 * W * 512 / 4;
#pragma unroll 4
    for (size_t i = gtid; i < n4; i += gsz) {
      const size_t e0 = i * 4;
      const int e = (int)(e0 & 511), ii = (int)((e0 >> 9) % W), b = (int)((e0 >> 9) / W);
      float4 o;
      if (ii < W - 4) o = *(const float4*)&cache[((size_t)b * W + ii + 4) * 512 + e];
      else {
        uint2 v = *(const uint2*)&p.proj[((size_t)MP + b * 4 + (ii - (W - 4))) * NP + 2048 + g * 768 + 256 + e];
        o = make_float4(bflo(v.x), bfhi(v.x), bflo(v.y), bfhi(v.y));
      }
      *(float4*)&p.out[off + e0] = o;
    }
  }
}

DI void mem_attn_prompt_block(const Params& p, int item, char* smem) {
  const int tid = threadIdx.x, lane = tid & 63, w = tid >> 6, r = lane & 15, kg = lane >> 4;
  const int h = item & 3, qb = item >> 2;
  const int row0 = qb * 64 + w * 16, b = (qb * 64) >> 13;
  const int bh = b * 4 + h;
  u16* sK = (u16*)smem;
  bf16x8 qf[8];
#pragma unroll
  for (int ks = 0; ks < 8; ++ks) qf[ks] = *(const bf16x8*)&G(p.qb)[(size_t)(row0 + r) * 1024 + h * 256 + ks * 32 + kg * 8];
  f32x4 st[16];
  const u16* kbp = G(p.Kb) + (size_t)bh * 65536;
#pragma unroll
  for (int c = 0; c < 4; ++c) {
    __syncthreads();
#pragma unroll
    for (int i2 = 0; i2 < 2; ++i2) {
#pragma unroll
      for (int i = i2 * 4; i < i2 * 4 + 4; ++i) {
        const int idx = tid + 256 * i, row = idx >> 5, seg = idx & 31;
        *(bf16x8*)&sK[row * 264 + seg * 8] = *(gb8p)((gu16p)kbp + (size_t)(c * 64 + row) * 256 + seg * 8);
      }
      __builtin_amdgcn_sched_barrier(0);
    }
    __syncthreads();
#pragma unroll
    for (int m4 = 0; m4 < 4; ++m4) {
      f32x4 a = (f32x4){0.f, 0.f, 0.f, 0.f};
#pragma unroll
      for (int ks = 0; ks < 8; ++ks) {
        bf16x8 kf = *(const bf16x8*)&sK[(m4 * 16 + r) * 264 + ks * 32 + kg * 8];
        a = MFMA(kf, qf[ks], a);
      }
      st[c * 4 + m4] = a;
      __builtin_amdgcn_sched_barrier(0);
    }
  }
  float mx = -3.0e38f;
#pragma unroll
  for (int mt = 0; mt < 16; ++mt)
#pragma unroll
    for (int j = 0; j < 4; ++j) { st[mt][j] *= 0.0625f; mx = fmaxf(mx, st[mt][j]); }
  mx = fmaxf(mx, __shfl_xor(mx, 16));
  mx = fmaxf(mx, __shfl_xor(mx, 32));
  float sum = 0.f;
#pragma unroll
  for (int mt = 0; mt < 16; ++mt)
#pragma unroll
    for (int j = 0; j < 4; ++j) { st[mt][j] = __expf(st[mt][j] - mx); sum += st[mt][j]; }
  sum += __shfl_xor(sum, 16);
  sum += __shfl_xor(sum, 32);
  const float inv = 1.f / sum;
  bf16x8 pf[8];
#pragma unroll
  for (int k2 = 0; k2 < 8; ++k2) pf[k2] = pack8(st[2 * k2], st[2 * k2 + 1]);
  const u16* vtp = G(p.VTf) + (size_t)bh * 65536;
#pragma unroll 1
  for (int c = 0; c < 4; ++c) {
    __syncthreads();
#pragma unroll
    for (int i = 0; i < 8; ++i) {
      const int idx = tid + 256 * i;
      *(bf16x8*)&sK[idx * 8] = *(gb8p)((gu16p)vtp + (size_t)c * 16384 + idx * 8);
    }
    __syncthreads();
#pragma unroll
    for (int n4 = 0; n4 < 4; ++n4) {
      f32x4 o = (f32x4){0.f, 0.f, 0.f, 0.f};
#pragma unroll
      for (int k2 = 0; k2 < 8; ++k2) o = MFMA(*(const bf16x8*)&sK[((n4 * 8 + k2) * 64 + lane) * 8], pf[k2], o);
      uint2 ov; ov.x = pack2(o[0] * inv, o[1] * inv); ov.y = pack2(o[2] * inv, o[3] * inv);
      *(uint2*)&G(p.attn)[(size_t)(row0 + r) * 1024 + h * 256 + (c * 4 + n4) * 16 + kg * 4] = ov;
      __builtin_amdgcn_sched_barrier(0);
    }
  }
}

DI void mem_attn_sample_wave(const Params& p, int item, float* lds) {
  const int lane = threadIdx.x & 63;
  const int b = item >> 2, h = item & 3;
  float* sq = lds;
#pragma unroll
  for (int t = 0; t < 4; ++t) {
    uint2 v = *(const uint2*)&p.qb[((size_t)MP + b * 4 + t) * 1024 + h * 256 + lane * 4];
    *(float4*)&sq[t * 256 + lane * 4] = make_float4(bflo(v.x), bfhi(v.x), bflo(v.y), bfhi(v.y));
  }
  __builtin_amdgcn_s_waitcnt(0);
  __builtin_amdgcn_wave_barrier();
  float sc[4][4];
#pragma unroll
  for (int mi = 0; mi < 4; ++mi) {
    const int m = lane + 64 * mi;
    const float* kr = &p.cache_mem[(((size_t)b * 256 + m) * 2 + 0) * 1024 + h * 256];
    float d0 = 0.f, d1 = 0.f, d2 = 0.f, d3 = 0.f;
#pragma unroll 2
    for (int c = 0; c < 256; c += 4) {
      float4 kv = *(const float4*)&kr[c];
      float4 q0 = *(const float4*)&sq[c], q1 = *(const float4*)&sq[256 + c], q2 = *(const float4*)&sq[512 + c], q3 = *(const float4*)&sq[768 + c];
      d0 += kv.x * q0.x + kv.y * q0.y + kv.z * q0.z + kv.w * q0.w;
      d1 += kv.x * q1.x + kv.y * q1.y + kv.z * q1.z + kv.w * q1.w;
      d2 += kv.x * q2.x + kv.y * q2.y + kv.z * q2.z + kv.w * q2.w;
      d3 += kv.x * q3.x + kv.y * q3.y + kv.z * q3.z + kv.w * q3.w;
    }
    sc[0][mi] = d0 * 0.0625f; sc[1][mi] = d1 * 0.0625f; sc[2][mi] = d2 * 0.0625f; sc[3][mi] = d3 * 0.0625f;
  }
  float inv[4];
  __builtin_amdgcn_wave_barrier();
#pragma unroll
  for (int t = 0; t < 4; ++t) {
    float mx = wave_max(fmaxf(fmaxf(sc[t][0], sc[t][1]), fmaxf(sc[t][2], sc[t][3])));
    float sum = 0.f;
#pragma unroll
    for (int mi = 0; mi < 4; ++mi) { sc[t][mi] = __expf(sc[t][mi] - mx); sum += sc[t][mi]; }
    sum = wave_sum(sum);
    inv[t] = 1.f / sum;
#pragma unroll
    for (int mi = 0; mi < 4; ++mi) sq[t * 256 + lane + 64 * mi] = sc[t][mi];
  }
  __builtin_amdgcn_s_waitcnt(0);
  __builtin_amdgcn_wave_barrier();
  float4 o[4];
#pragma unroll
  for (int t = 0; t < 4; ++t) o[t] = make_float4(0.f, 0.f, 0.f, 0.f);
#pragma unroll 4
  for (int m = 0; m < 256; ++m) {
    float4 vv = *(const float4*)&p.cache_mem[(((size_t)b * 256 + m) * 2 + 1) * 1024 + h * 256 + lane * 4];
#pragma unroll
    for (int t = 0; t < 4; ++t) {
      const float pv = sq[t * 256 + m];
      o[t].x += pv * vv.x; o[t].y += pv * vv.y; o[t].z += pv * vv.z; o[t].w += pv * vv.w;
    }
  }
#pragma unroll
  for (int t = 0; t < 4; ++t) {
    uint2 ov; ov.x = pack2(o[t].x * inv[t], o[t].y * inv[t]); ov.y = pack2(o[t].z * inv[t], o[t].w * inv[t]);
    *(uint2*)&p.attn[((size_t)MP + b * 4 + t) * 1024 + h * 256 + lane * 4] = ov;
  }
  __builtin_amdgcn_wave_barrier();
}

DI void phase7(const Params& p, char* smem) {
  const int w = threadIdx.x >> 6;
  float* lds = (float*)smem + w * 1280;
  for (int it = blockIdx.x; it < 32 + 2048; it += gridDim.x) {
    if (it < 32) { __syncthreads(); mem_attn_sample_wave(p, it * 4 + w, lds); }
    else mem_attn_prompt_block(p, it - 32, smem);
  }
}

DI void peer_topk_wave(const Params& p, int item, unsigned* lds  ) {
  const int lane = threadIdx.x & 63, r = lane & 15, kg = lane >> 4;
  const int h = item & 7, row0 = (item >> 3) * 16;
  unsigned win[2][16];
#pragma unroll
  for (int pp = 0; pp < 2; ++pp) {
    bf16x8 qf[4];
#pragma unroll
    for (int ks = 0; ks < 4; ++ks) qf[ks] = *(const bf16x8*)&p.pq[(size_t)(row0 + r) * 2048 + h * 256 + pp * 128 + ks * 32 + kg * 8];
    unsigned kk[32];
    const u16* sk = p.subkb + (size_t)(h * 2 + pp) * 16384;
#pragma unroll
    for (int mt = 0; mt < 8; ++mt) {
      f32x4 a = (f32x4){0.f, 0.f, 0.f, 0.f};
#pragma unroll
      for (int ks = 0; ks < 4; ++ks) {
        bf16x8 kf = *(const bf16x8*)&sk[(mt * 16 + r) * 128 + ks * 32 + kg * 8];
        a = MFMA(kf, qf[ks], a);
      }
#pragma unroll
      for (int j = 0; j < 4; ++j) kk[mt * 4 + j] = (ordf(a[j]) & ~127u) | (unsigned)(mt * 16 + kg * 4 + j);
    }
#pragma unroll
    for (int rr = 0; rr < 16; ++rr) {
      unsigned m = 0;
#pragma unroll
      for (int i = 0; i < 32; ++i) m = umax(m, kk[i]);
      m = umax(m, (unsigned)__shfl_xor((int)m, 16));
      m = umax(m, (unsigned)__shfl_xor((int)m, 32));
      win[pp][rr] = m;
#pragma unroll
      for (int i = 0; i < 32; ++i) kk[i] = (kk[i] == m) ? 0u : kk[i];
    }
  }
  float f0[16], f1[16];
#pragma unroll
  for (int i = 0; i < 16; ++i) { f0[i] = unordf(win[0][i] & ~127u); f1[i] = unordf(win[1][i] & ~127u); }
  unsigned cand[13];
#define CAND(s, a0, b0, a1, b1, a2, b2, a3, b3)                                                         \
  {                                                                                                     \
    float va = sel4(kg, f0[a0], f0[a1], f0[a2], f0[(a3) < 0 ? 0 : (a3)]);                                \
    float vb = sel4(kg, f1[b0], f1[b1], f1[b2], f1[(b3) < 0 ? 0 : (b3)]);                                \
    unsigned id = sel4(kg, (unsigned)((a0) * 16 + (b0)), (unsigned)((a1) * 16 + (b1)), (unsigned)((a2) * 16 + (b2)), (unsigned)(((a3) < 0 ? 0 : (a3)) * 16 + ((b3) < 0 ? 0 : (b3)))); \
    unsigned key = (ordf(va + vb) & ~255u) | id;                                                        \
    if ((a3) < 0) key = (kg == 3) ? 0u : key;                                                           \
    cand[s] = key;                                                                                      \
  }
  CAND(0, 0, 0, 0, 13, 2, 0, 6, 1)
  CAND(1, 0, 1, 0, 14, 2, 1, 7, 0)
  CAND(2, 0, 2, 0, 15, 2, 2, 7, 1)
  CAND(3, 0, 3, 1, 0, 2, 3, 8, 0)
  CAND(4, 0, 4, 1, 1, 2, 4, 9, 0)
  CAND(5, 0, 5, 1, 2, 3, 0, 10, 0)
  CAND(6, 0, 6, 1, 3, 3, 1, 11, 0)
  CAND(7, 0, 7, 1, 4, 3, 2, 12, 0)
  CAND(8, 0, 8, 1, 5, 3, 3, 13, 0)
  CAND(9, 0, 9, 1, 6, 4, 2, 14, 0)
  CAND(10, 0, 10, 1, 7, 5, 0, 15, 0)
  CAND(11, 0, 11, 4, 0, 5, 1, -1, -1)
  CAND(12, 0, 12, 4, 1, 6, 0, -1, -1)
#undef CAND
  unsigned w2[16];
#pragma unroll
  for (int rr = 0; rr < 16; ++rr) {
    unsigned m = 0;
#pragma unroll
    for (int i = 0; i < 13; ++i) m = umax(m, cand[i]);
    m = umax(m, (unsigned)__shfl_xor((int)m, 16));
    m = umax(m, (unsigned)__shfl_xor((int)m, 32));
    w2[rr] = m;
#pragma unroll
    for (int i = 0; i < 13; ++i) cand[i] = (cand[i] == m) ? 0u : cand[i];
  }
  if (kg == 0) {
#pragma unroll
    for (int i = 0; i < 16; ++i) { lds[r * 32 + i] = win[0][i] & 127u; lds[r * 32 + 16 + i] = win[1][i] & 127u; }
  }
  __builtin_amdgcn_s_waitcnt(0);
  __builtin_amdgcn_wave_barrier();
  const float cv0 = unordf(w2[0] & ~255u);
  float sum = 0.f;
#pragma unroll
  for (int rr = 0; rr < 16; ++rr) sum += __expf(unordf(w2[rr] & ~255u) - cv0);
  const float inv = 1.f / sum;
  const size_t ob = ((size_t)(row0 + r) * 8 + h) * 16;
#pragma unroll
  for (int q = 0; q < 4; ++q) {
    const unsigned wk = sel4(kg, w2[q], w2[4 + q], w2[8 + q], w2[12 + q]);
    const int a = (wk >> 4) & 15, bb = wk & 15;
    const int i1 = (int)lds[r * 32 + a], i2 = (int)lds[r * 32 + 16 + bb];
    p.eid[ob + kg * 4 + q] = i1 * 128 + i2;
    p.gate[ob + kg * 4 + q] = __expf(unordf(wk & ~255u) - cv0) * inv;
  }
  __builtin_amdgcn_wave_barrier();
}

typedef __attribute__((ext_vector_type(2))) float f32x2;
DI float dot16_fp8(u32x4 u, const float* x, float c) {
  const unsigned d[4] = {u[0], u[1], u[2], u[3]};
#pragma unroll
  for (int i = 0; i < 4; ++i) {
    f32x2 a = __builtin_amdgcn_cvt_pk_f32_fp8((int)d[i], false);
    f32x2 b = __builtin_amdgcn_cvt_pk_f32_fp8((int)d[i], true);
    c += a[0] * x[4 * i] + a[1] * x[4 * i + 1] + b[0] * x[4 * i + 2] + b[1] * x[4 * i + 3];
  }
  return c;
}
DI void axpy16_fp8(float* o, float w, u32x4 u) {
  const unsigned d[4] = {u[0], u[1], u[2], u[3]};
#pragma unroll
  for (int i = 0; i < 4; ++i) {
    f32x2 a = __builtin_amdgcn_cvt_pk_f32_fp8((int)d[i], false);
    f32x2 b = __builtin_amdgcn_cvt_pk_f32_fp8((int)d[i], true);
    o[4 * i] += w * a[0]; o[4 * i + 1] += w * a[1]; o[4 * i + 2] += w * b[0]; o[4 * i + 3] += w * b[1];
  }
}

DI void peer_expert_wave(const Params& p, int row) {
  const int lane = __builtin_amdgcn_mbcnt_hi(-1, __builtin_amdgcn_mbcnt_lo(-1, 0));
  float xf[16];
  {
    const uint4 x0 = *(const uint4*)&G(p.A2)[(size_t)row * 1024 + lane * 16];
    const uint4 x1 = *(const uint4*)&G(p.A2)[(size_t)row * 1024 + lane * 16 + 8];
    xf[0] = bflo(x0.x); xf[1] = bfhi(x0.x); xf[2] = bflo(x0.y); xf[3] = bfhi(x0.y);
    xf[4] = bflo(x0.z); xf[5] = bfhi(x0.z); xf[6] = bflo(x0.w); xf[7] = bfhi(x0.w);
    xf[8] = bflo(x1.x); xf[9] = bfhi(x1.x); xf[10] = bflo(x1.y); xf[11] = bfhi(x1.y);
    xf[12] = bflo(x1.z); xf[13] = bfhi(x1.z); xf[14] = bflo(x1.w); xf[15] = bfhi(x1.w);
  }
  const float r2 = rsqrtf(p.ssq2[row] * (1.f / 1024.f) + EPS);
  const unsigned char AS1* EU8 = (const unsigned char AS1*)p.E8;
  const unsigned char AS1* EV8 = (const unsigned char AS1*)p.E8 + (size_t)16384 * 1024;
  float out[16];
#pragma unroll
  for (int i = 0; i < 16; ++i) out[i] = 0.f;
#pragma unroll 1
  for (int bt = 0; bt < 2; ++bt) {
    const int eidv = G(p.eid)[(size_t)row * 128 + bt * 64 + lane];
    const float gv = G(p.gate)[(size_t)row * 128 + bt * 64 + lane];
    const float rsu = G(p.rs)[eidv], rsv = G(p.rs)[16384 + eidv];
    float part[64];
#pragma unroll
    for (int e = 0; e < 64; ++e) {
      const int id = __builtin_amdgcn_readlane(eidv, e);
      const u32x4 u = *(const u32x4 AS1*)(EU8 + (size_t)id * 1024 + lane * 16);
      part[e] = dot16_fp8(u, xf, 0.f);
    }
#pragma unroll
    for (int off = 32; off > 0; off >>= 1) {
      const bool up = (lane & off) != 0;
#pragma unroll
      for (int i = 0; i < off; ++i) {
        const float a = part[i], bq = part[i + off];
        const float send = up ? a : bq, keep = up ? bq : a;
        part[i] = keep + __shfl_xor(send, off);
      }
    }
    const float wv = gv * geluf(part[0] * r2 * rsu) * rsv;
#pragma unroll 8
    for (int e = 0; e < 64; ++e) {
      const int id = __builtin_amdgcn_readlane(eidv, e);
      const float we = __int_as_float(__builtin_amdgcn_readlane(__float_as_int(wv), e));
      const u32x4 v = *(const u32x4 AS1*)(EV8 + (size_t)id * 1024 + lane * 16);
      axpy16_fp8(out, we, v);
    }
  }
  const float* hr = G(p.h2) + (size_t)row * 1024 + lane * 16;
  float hv[16];
  float ss = 0.f;
#pragma unroll
  for (int i = 0; i < 4; ++i) {
    float4 t = *(const float4*)&hr[i * 4];
    hv[4 * i] = t.x + out[4 * i]; hv[4 * i + 1] = t.y + out[4 * i + 1]; hv[4 * i + 2] = t.z + out[4 * i + 2]; hv[4 * i + 3] = t.w + out[4 * i + 3];
    ss += hv[4 * i] * hv[4 * i] + hv[4 * i + 1] * hv[4 * i + 1] + hv[4 * i + 2] * hv[4 * i + 2] + hv[4 * i + 3] * hv[4 * i + 3];
  }
  ss = wave_sum(ss);
  const float rsn = rsqrtf(ss * (1.f / 1024.f) + EPS);
  float* y = ((row < MP) ? (G(p.out) + O_YP + (size_t)row * 1024) : (G(p.out) + O_YS + (size_t)(row - MP) * 1024)) + lane * 16;
#pragma unroll
  for (int i = 0; i < 4; ++i) {
    float4 g4 = *(const float4*)&p.g_final[lane * 16 + i * 4];
    *(float4*)&y[i * 4] = make_float4(hv[4 * i] * rsn * g4.x, hv[4 * i + 1] * rsn * g4.y, hv[4 * i + 2] * rsn * g4.z, hv[4 * i + 3] * rsn * g4.w);
  }
}

__global__ void __launch_bounds__(256, 2) mega(Params pk) {
  __shared__ __attribute__((aligned(16))) char smem[65536];
  __shared__ Params sp;
  cg::grid_group grid = cg::this_grid();
  const int w = threadIdx.x >> 6;
  if (threadIdx.x == 0) sp = pk;
  __syncthreads();
  const Params& p = sp;
#ifndef DBL
#define DBL -1
#endif
#define REP(ph) for (int rp_ = 0; rp_ < ((DBL == (ph)) ? 2 : 1); ++rp_)
  REP(0) { phase0(p, smem); if (DBL == 0) grid.sync(); }
  grid.sync();
  REP(1) {
    int tm, tn;
    for (int it = 0; it * (int)gridDim.x < 257 * 34; ++it)
      if (xcd_tile(it, 257, 34, tm, tn)) gemm_tile<0, 1024>(p, p.A0, 1024, p.WtIn, tm, tn, smem);
    for (int u = blockIdx.x; u < 128; u += gridDim.x) gemm_tile<1, 1024>(p, p.Amem, 1024, p.WtMkv, u / 16, u % 16, smem);
  }
  grid.sync();
  REP(2) { phase2(p, smem); if (DBL == 2) grid.sync(); }
  grid.sync();
  REP(3) { phase3(p, smem); if (DBL == 3) grid.sync(); }
  grid.sync();
  REP(4) phase4(p);
  grid.sync();
  { int tm, tn; for (int it = 0; it * (int)gridDim.x < 257 * 8; ++it) if (xcd_tile(it, 257, 8, tm, tn)) gemm_tile<2, 768>(p, p.Amix, 768, p.WtOut, tm, tn, smem); }
  grid.sync();
  REP(6) { int tm, tn; for (int it = 0; it * (int)gridDim.x < 257 * 8; ++it) if (xcd_tile(it, 257, 8, tm, tn)) gemm_tile<3, 1024>(p, p.A1, 1024, p.WtMq, tm, tn, smem); }
  sample_state_copy(p);
  grid.sync();
  REP(7) phase7(p, smem);
  grid.sync();
  { int tm, tn; for (int it = 0; it * (int)gridDim.x < 257 * 8; ++it) if (xcd_tile(it, 257, 8, tm, tn)) gemm_tile<4, 1024>(p, p.attn, 1024, p.WtMo, tm, tn, smem); }
  grid.sync();
  REP(9) { int tm, tn; for (int it = 0; it * (int)gridDim.x < 257 * 16; ++it) if (xcd_tile(it, 257, 16, tm, tn)) gemm_tile<5, 1024>(p, p.A2, 1024, p.WtPq, tm, tn, smem); }
  grid.sync();
  REP(10) {
    unsigned* lds = (unsigned*)smem + w * 512;
    for (int it = blockIdx.x * 4 + w; it < 2056 * 8; it += gridDim.x * 4) peer_topk_wave(p, it, lds);
  }
  grid.sync();
  REP(11) for (int row = blockIdx.x * 4 + w; row < MT; row += gridDim.x * 4) peer_expert_wave(p, row);
}

extern "C" void kernel_launch(void* const* d_in, const int* in_sizes, int n_in, void* d_out, int out_size, void* d_ws, size_t ws_size,
                              hipStream_t stream) {
  static int grid_blocks = 0;
  if (!grid_blocks) {
    int dev = 0, cus = 0, per_cu = 0;
    (void)hipGetDevice(&dev);
    (void)hipDeviceGetAttribute(&cus, hipDeviceAttributeMultiprocessorCount, dev);
    (void)hipOccupancyMaxActiveBlocksPerMultiprocessor(&per_cu, mega, 256, 0);
    if (per_cu > 2) per_cu = 2;
    if (per_cu < 1) per_cu = 1;
    grid_blocks = cus * per_cu;
  }
  Params p{};
  const float* const* in = (const float* const*)d_in;
  p.x_prompt = in[0]; p.x_sample = in[1]; p.state_delta = in[2]; p.state_conv = in[3]; p.cw1 = in[4]; p.cw2 = in[5]; p.cw3 = in[6];
  p.cache_mem = in[7]; p.mem_prompt = in[8]; p.g_mix = in[9]; p.w_in = in[10]; p.conv_w = in[11]; p.a_log = in[12]; p.dt_bias = in[13];
  p.g_onorm = in[14]; p.w_out = in[15]; p.g_memq = in[16]; p.g_memkv = in[17]; p.w_mq = in[18]; p.w_mkv = in[19]; p.w_mo = in[20];
  p.g_ffn = in[21]; p.w_pq = in[22]; p.sub_keys = in[23]; p.expert_u = in[24]; p.expert_v = in[25]; p.g_final = in[26];
  p.out = (float*)d_out;
  char* ws = (char*)d_ws;
  size_t off = 0;
  auto take = [&](size_t bytes) { char* r = ws + off; off += (bytes + 255) & ~(size_t)255; return r; };
  p.WtIn = (u16*)take((size_t)NP * 1024 * 2);
  p.WtOut = (u16*)take((size_t)1024 * 768 * 2);
  p.WtMq = (u16*)take((size_t)1024 * 1024 * 2);
  p.WtMkv = (u16*)take((size_t)2048 * 1024 * 2);
  p.WtMo = (u16*)take((size_t)1024 * 1024 * 2);
  p.WtPq = (u16*)take((size_t)2048 * 1024 * 2);
  p.subkb = (u16*)take((size_t)262144 * 2);
  p.E8 = (unsigned char*)take((size_t)32768 * 1024);
  p.rs = (float*)take((size_t)32768 * 4);
  p.Amem = (u16*)take((size_t)1024 * 1024 * 2);
  p.gb = (float*)take((size_t)MT * 8 * 4);
  p.ssq1 = (float*)take((size_t)MT * 4);
  p.ssq2 = (float*)take((size_t)MT * 4);
  p.dl = (float*)take(2048 * 4);
  p.Kb = (u16*)take((size_t)16 * 65536 * 2);
  p.VTf = (u16*)take((size_t)16 * 65536 * 2);
  char* regA = take((size_t)MT * NP * 2);
  char* regB = take((size_t)2048 * DN_ITEM);
  p.proj = (u16*)regA;
  p.h1 = (float*)regA;
  p.h2 = (float*)(regA + (size_t)MT * 1024 * 4);
  p.pq = (u16*)regA;
  p.dnops = regB;
  p.A0 = (u16*)regB;
  p.A1 = (u16*)regB;
  p.qb = (u16*)(regB + (size_t)MT * 1024 * 2);
  p.attn = (u16*)regB;
  p.A2 = (u16*)(regB + (size_t)MT * 1024 * 2);
  p.eid = (int*)regB;
  p.gate = (float*)(regB + (size_t)MT * 128 * 4);
  char* ob = (char*)d_out;
  p.vT = (u16*)ob;
  p.osw = (u16*)(ob + (size_t)3 * MP * 256 * 2);
  p.lse = (float*)(ob + (size_t)3 * MP * 256 * 2 + (size_t)3 * MT * 256 * 2);
  char* sb = ob + O_SW3 * 4;
  p.odn = (u16*)sb;
  p.Amix = (u16*)(sb + (size_t)MT * 512 * 2);
  if (off > ws_size) { fprintf(stderr, "workspace too small: need %zu have %zu\n", off, ws_size); return; }
  void* args[] = {&p};
  hipError_t e = hipLaunchCooperativeKernel((void*)mega, dim3(grid_blocks), dim3(256), args, 0, stream);
  if (e != hipSuccess) fprintf(stderr, "coop launch failed: %s (grid %d)\n", hipGetErrorString(e), grid_blocks);
}
```

```cpp
#include <hip/hip_runtime.h>
#include <hip/hip_cooperative_groups.h>
#include <cstdio>
namespace cg = cooperative_groups;

typedef unsigned short u16;
typedef __attribute__((ext_vector_type(8))) short bf16x8;
typedef __attribute__((ext_vector_type(4))) float f32x4;
typedef __attribute__((ext_vector_type(2))) __bf16 bf2_t;

#define DI __device__ __forceinline__
#define MFMA(a, b, c) __builtin_amdgcn_mfma_f32_16x16x32_bf16((a), (b), (c), 0, 0, 0)

constexpr int MP = 32768, MS = 128, MT = 32896;
constexpr int NP = 4352;
constexpr int SEQ = 8192;
constexpr float EPS = 1e-6f;
constexpr size_t DN_ITEM = 73728;

constexpr size_t O_YP = 0, O_YS = 33554432, O_PDELTA = 33685504, O_PCONV = 33947648, O_PW1 = 33966080,
                 O_PW2 = 34228224, O_PW3 = 35276800, O_PMEM = 39471104, O_SDELTA = 41568256, O_SCONV = 43665408,
                 O_SW1 = 43812864, O_SW2 = 45910016, O_SW3 = 54298624;

struct Params {
  const float *x_prompt, *x_sample, *state_delta, *state_conv, *cw1, *cw2, *cw3, *cache_mem, *mem_prompt;
  const float *g_mix, *w_in, *conv_w, *a_log, *dt_bias, *g_onorm, *w_out, *g_memq, *g_memkv, *w_mq, *w_mkv, *w_mo;
  const float *g_ffn, *w_pq, *sub_keys, *expert_u, *expert_v, *g_final;
  float* out;
  u16 *WtIn, *WtOut, *WtMq, *WtMkv, *WtMo, *WtPq, *subkb, *Amem;
  unsigned char* E8;
  float* rs;
  float *gb, *ssq1, *ssq2, *dl;
  u16 *Kb, *VTf;
  u16* proj;
  float *h1, *h2;
  u16* pq;
  char* dnops;
  u16 *A0, *A1, *qb, *attn, *A2;
  int* eid;
  float* gate;
  u16 *vT, *osw, *odn, *Amix;
  float* lse;
};

#define AS1 __attribute__((address_space(1)))
template <typename T> DI T* G(T* q) { return q; }
typedef const bf16x8 AS1* gb8p;
typedef const u16 AS1* gu16p;
typedef __attribute__((ext_vector_type(4))) unsigned u32x4;
DI u16 f2bf(float x) { unsigned u = __float_as_uint(x); u += 0x7fffu + ((u >> 16) & 1u); return (u16)(u >> 16); }
DI float bf2f(u16 h) { return __uint_as_float(((unsigned)h) << 16); }
DI unsigned pack2(float a, float b) { return (unsigned)f2bf(a) | ((unsigned)f2bf(b) << 16); }
DI float bflo(unsigned d) { return __uint_as_float(d << 16); }
DI float bfhi(unsigned d) { return __uint_as_float(d & 0xffff0000u); }
DI bf16x8 pack8(f32x4 a, f32x4 b) {
  uint4 r; r.x = pack2(a[0], a[1]); r.y = pack2(a[2], a[3]); r.z = pack2(b[0], b[1]); r.w = pack2(b[2], b[3]);
  return __builtin_bit_cast(bf16x8, r);
}
DI float wave_sum(float v) {
#pragma unroll
  for (int o = 32; o > 0; o >>= 1) v += __shfl_xor(v, o);
  return v;
}
DI float wave_max(float v) {
#pragma unroll
  for (int o = 32; o > 0; o >>= 1) v = fmaxf(v, __shfl_xor(v, o));
  return v;
}
DI float siluf(float x) { return x / (1.f + __expf(-x)); }
DI float geluf(float x) { return 0.5f * x * (1.f + tanhf(0.7978845608028654f * (x + 0.044715f * x * x * x))); }
DI int permk(int kg, int j) { return (j < 4) ? (kg * 4 + j) : (16 + kg * 4 + (j - 4)); }
DI void cvt8(const float* __restrict__ s, u16* __restrict__ d) {
  float4 a = *(const float4*)s, b = *(const float4*)(s + 4);
  uint4 r; r.x = pack2(a.x, a.y); r.y = pack2(a.z, a.w); r.z = pack2(b.x, b.y); r.w = pack2(b.z, b.w);
  *(uint4*)d = r;
}
DI unsigned ordf(float f) { unsigned u = __float_as_uint(f); return (u & 0x80000000u) ? ~u : (u | 0x80000000u); }
DI float unordf(unsigned k) { unsigned u = (k & 0x80000000u) ? (k & 0x7fffffffu) : ~k; return __uint_as_float(u); }
DI unsigned umax(unsigned a, unsigned b) { return a > b ? a : b; }
template <typename T> DI T sel4(int L, T a, T b, T c, T d) { return L == 0 ? a : (L == 1 ? b : (L == 2 ? c : d)); }

#define AS3 __attribute__((address_space(3)))
template <int MODE, int K>
DI void gemm_tile(const Params& p, const u16* __restrict__ A, int lda, const u16* __restrict__ Bt, int tm, int tn,
                          char* smem) {
  const int tid = threadIdx.x, lane = tid & 63, w = tid >> 6;
  const int wm = w >> 1, wn = w & 1, r = lane & 15, kg = lane >> 4;
  f32x4 acc[4][4];
#pragma unroll
  for (int i = 0; i < 4; ++i)
#pragma unroll
    for (int j = 0; j < 4; ++j) acc[i][j] = (f32x4){0.f, 0.f, 0.f, 0.f};
  const int lr = lane >> 2, lkg = (lane & 3) ^ (lane >> 4);
  gu16p gA[4], gB[4];
#pragma unroll
  for (int i = 0; i < 4; ++i) {
    const int sub = w * 4 + i, mt = sub >> 1, ks = sub & 1;
    gA[i] = (gu16p)A + (size_t)(tm * 128 + mt * 16 + lr) * lda + ks * 32 + lkg * 8;
    gB[i] = (gu16p)Bt + (size_t)(tn * 128 + mt * 16 + lr) * K + ks * 32 + lkg * 8;
  }
  const int frag_off = r * 64 + ((kg ^ (r >> 2)) * 16);
  __syncthreads();
#pragma unroll
  for (int i = 0; i < 4; ++i) {
    __builtin_amdgcn_global_load_lds((const unsigned AS1*)(gA[i]), (unsigned AS3*)(smem + (w * 4 + i) * 1024), 16, 0, 0);
    __builtin_amdgcn_global_load_lds((const unsigned AS1*)(gB[i]), (unsigned AS3*)(smem + 16384 + (w * 4 + i) * 1024), 16, 0, 0);
  }
#pragma unroll 2
  for (int k = 0; k < K / 64; ++k) {
    __syncthreads();
    if (k + 1 < K / 64) {
      char* st = smem + ((k + 1) & 1) * 32768;
#pragma unroll
      for (int i = 0; i < 4; ++i) {
        __builtin_amdgcn_global_load_lds((const unsigned AS1*)(gA[i] + (k + 1) * 64), (unsigned AS3*)(st + (w * 4 + i) * 1024), 16, 0, 0);
        __builtin_amdgcn_global_load_lds((const unsigned AS1*)(gB[i] + (k + 1) * 64), (unsigned AS3*)(st + 16384 + (w * 4 + i) * 1024), 16, 0, 0);
      }
    }
    const char* sa = smem + (k & 1) * 32768;
    const char* sb = sa + 16384;
#pragma unroll
    for (int ks = 0; ks < 2; ++ks) {
      bf16x8 af[4], bfr[4];
#pragma unroll
      for (int i = 0; i < 4; ++i) {
        af[i] = *(const bf16x8*)(sa + ((wm * 4 + i) * 2 + ks) * 1024 + frag_off);
        bfr[i] = *(const bf16x8*)(sb + ((wn * 4 + i) * 2 + ks) * 1024 + frag_off);
      }
#pragma unroll
      for (int mt = 0; mt < 4; ++mt)
#pragma unroll
        for (int nt = 0; nt < 4; ++nt) acc[mt][nt] = MFMA(bfr[nt], af[mt], acc[mt][nt]);
    }
  }
#pragma unroll
  for (int mt = 0; mt < 4; ++mt) {
    const int row = tm * 128 + wm * 64 + mt * 16 + r;
    float rs = 1.f, ssq = 0.f;
    if (MODE == 3) rs = rsqrtf(p.ssq1[row] * (1.f / 1024.f) + EPS);
    if (MODE == 5) rs = rsqrtf(p.ssq2[row] * (1.f / 1024.f) + EPS);
#pragma unroll
    for (int nt = 0; nt < 4; ++nt) {
      const int col = tn * 128 + wn * 64 + nt * 16 + kg * 4;
      f32x4 v = acc[mt][nt];
      if (MODE == 0) {
        uint2 o; o.x = pack2(v[0], v[1]); o.y = pack2(v[2], v[3]);
        *(uint2*)&p.proj[(size_t)row * NP + col] = o;
      } else if (MODE == 1) {
        *(float4*)&p.out[O_PMEM + (size_t)row * 2048 + col] = make_float4(v[0], v[1], v[2], v[3]);
      } else if (MODE == 2 || MODE == 4) {
        float4 rsd;
        const float* gn;
        if (MODE == 2) {
          rsd = (row < MP) ? *(const float4*)&p.x_prompt[(size_t)row * 1024 + col] : *(const float4*)&p.x_sample[(size_t)(row - MP) * 1024 + col];
          gn = p.g_memq;
        } else {
          rsd = *(const float4*)&p.h1[(size_t)row * 1024 + col];
          gn = p.g_ffn;
        }
        float4 h = make_float4(rsd.x + v[0], rsd.y + v[1], rsd.z + v[2], rsd.w + v[3]);
        float4 g4 = *(const float4*)&gn[col];
        ssq += h.x * h.x + h.y * h.y + h.z * h.z + h.w * h.w;
        uint2 o; o.x = pack2(h.x * g4.x, h.y * g4.y); o.y = pack2(h.z * g4.z, h.w * g4.w);
        if (MODE == 2) { *(float4*)&p.h1[(size_t)row * 1024 + col] = h; *(uint2*)&p.A1[(size_t)row * 1024 + col] = o; }
        else { *(float4*)&p.h2[(size_t)row * 1024 + col] = h; *(uint2*)&p.A2[(size_t)row * 1024 + col] = o; }
      } else if (MODE == 3) {
        uint2 o; o.x = pack2(v[0] * rs, v[1] * rs); o.y = pack2(v[2] * rs, v[3] * rs);
        *(uint2*)&p.qb[(size_t)row * 1024 + col] = o;
      } else {
        uint2 o; o.x = pack2(v[0] * rs, v[1] * rs); o.y = pack2(v[2] * rs, v[3] * rs);
        *(uint2*)&p.pq[(size_t)row * 2048 + col] = o;
      }
    }
    if (MODE == 2 || MODE == 4) {
      ssq += __shfl_xor(ssq, 16);
      ssq += __shfl_xor(ssq, 32);
      if (kg == 0) atomicAdd((MODE == 2) ? &p.ssq1[row] : &p.ssq2[row], ssq);
    }
  }
}

DI bool xcd_tile(int it, int nM, int nN, int& tm, int& tn) {
  const int per = gridDim.x >> 3;
  const int xcd = blockIdx.x & 7, li = blockIdx.x >> 3;
  const int i = (it * 8 + xcd) * per + li;
  if (i >= nM * nN) return false;
  const int panel = i / (8 * nN), within = i - panel * 8 * nN;
  const int rows = (nM - panel * 8) < 8 ? (nM - panel * 8) : 8;
  tn = within / rows;
  tm = panel * 8 + (within - tn * rows);
  return true;
}

DI void tr_tile(const float* __restrict__ W, int ldw, int nsrc0, u16* __restrict__ Wt, int K, int k0, int n0, float* tile) {
  const int tid = threadIdx.x;
  const int n = tid & 63, kq = tid >> 6;
  __syncthreads();
#pragma unroll
  for (int i = 0; i < 16; ++i) { int kk = kq + 4 * i; tile[kk * 65 + n] = W[(size_t)(k0 + kk) * ldw + nsrc0 + n]; }
  __syncthreads();
  const int nn = tid >> 2, ks = (tid & 3) * 16;
  unsigned o[8];
#pragma unroll
  for (int i = 0; i < 8; ++i) o[i] = pack2(tile[(ks + 2 * i) * 65 + nn], tile[(ks + 2 * i + 1) * 65 + nn]);
  u16* d = Wt + (size_t)(n0 + nn) * K + k0 + ks;
  *(uint4*)d = make_uint4(o[0], o[1], o[2], o[3]);
  *(uint4*)(d + 8) = make_uint4(o[4], o[5], o[6], o[7]);
}

DI void phase0(const Params& p, char* smem) {
  const int tid = threadIdx.x, lane = tid & 63, w = tid >> 6;
  const size_t gtid = (size_t)blockIdx.x * 256 + tid, gsz = (size_t)gridDim.x * 256;
  {
    const float* eu = p.expert_u;
    const float* ev = p.expert_v;
    unsigned char* e8 = p.E8;
    float* rsp = p.rs;
    const int sub = lane & 15, rq = lane >> 4;
    for (int er0 = (blockIdx.x * 4 + w) * 4; er0 < 32768; er0 += gridDim.x * 16) {
      const int er = er0 + rq;
      const float* src = (er < 16384) ? (eu + (size_t)er * 1024) : (ev + (size_t)(er - 16384) * 1024);
      float4 v[16];
      float am = 0.f;
#pragma unroll
      for (int i = 0; i < 16; ++i) {
        v[i] = *(const float4*)&src[(i >> 2) * 256 + sub * 16 + (i & 3) * 4];
        am = fmaxf(am, fmaxf(fmaxf(fabsf(v[i].x), fabsf(v[i].y)), fmaxf(fabsf(v[i].z), fabsf(v[i].w))));
      }
      am = fmaxf(am, __shfl_xor(am, 1)); am = fmaxf(am, __shfl_xor(am, 2));
      am = fmaxf(am, __shfl_xor(am, 4)); am = fmaxf(am, __shfl_xor(am, 8));
      const float sc = (am > 0.f) ? 224.f / am : 1.f;
#pragma unroll
      for (int c = 0; c < 4; ++c) {
        int o[4];
#pragma unroll
        for (int i = 0; i < 4; ++i) {
          const float4 t4 = v[c * 4 + i];
          int t = __builtin_amdgcn_cvt_pk_fp8_f32(t4.x * sc, t4.y * sc, 0, false);
          o[i] = __builtin_amdgcn_cvt_pk_fp8_f32(t4.z * sc, t4.w * sc, t, true);
        }
        *(uint4*)&e8[(size_t)er * 1024 + c * 256 + sub * 16] = make_uint4((unsigned)o[0], (unsigned)o[1], (unsigned)o[2], (unsigned)o[3]);
      }
      if (sub == 0) rsp[er] = (am > 0.f) ? am * (1.f / 224.f) : 1.f;
    }
  }
  for (size_t i = gtid; i < 262144 / 8; i += gsz) cvt8(p.sub_keys + i * 8, p.subkb + i * 8);
  for (size_t i = gtid; i < MT; i += gsz) { p.ssq1[i] = 0.f; p.ssq2[i] = 0.f; }
  float* wl = (float*)smem;
  __syncthreads();
  for (int i = tid; i < 2048; i += 256) {
    const int k = i >> 1, hf = i & 1;
    float4 t = *(const float4*)&p.w_in[(size_t)k * 4360 + 1536 + hf * 4];
    wl[(hf * 4 + 0) * 1024 + k] = t.x; wl[(hf * 4 + 1) * 1024 + k] = t.y; wl[(hf * 4 + 2) * 1024 + k] = t.z; wl[(hf * 4 + 3) * 1024 + k] = t.w;
  }
  __syncthreads();
  const float* xpp = p.x_prompt;
  const float* xsp = p.x_sample;
  const float* mpp = p.mem_prompt;
  const float* gmx = p.g_mix;
  const float* gmk = p.g_memkv;
  u16* a0p = p.A0;
  u16* amp = p.Amem;
  {
    const int sub = lane & 15, rq = lane >> 4;
    for (int row0 = (blockIdx.x * 4 + w) * 4; row0 < MT + 1024; row0 += gridDim.x * 16) {
      const int row = row0 + rq;
      const float* src; const float* g; u16* dst;
      if (row < MP) { src = xpp + (size_t)row * 1024; g = gmx; dst = a0p + (size_t)row * 1024; }
      else if (row < MT) { src = xsp + (size_t)(row - MP) * 1024; g = gmx; dst = a0p + (size_t)row * 1024; }
      else { src = mpp + (size_t)(row - MT) * 1024; g = gmk; dst = amp + (size_t)(row - MT) * 1024; }
      float4 v[16];
      float ss = 0.f;
#pragma unroll
      for (int i = 0; i < 16; ++i) { v[i] = *(const float4*)&src[i * 64 + sub * 4]; ss += v[i].x * v[i].x + v[i].y * v[i].y + v[i].z * v[i].z + v[i].w * v[i].w; }
      ss += __shfl_xor(ss, 1); ss += __shfl_xor(ss, 2); ss += __shfl_xor(ss, 4); ss += __shfl_xor(ss, 8);
      const float rs = rsqrtf(ss * (1.f / 1024.f) + EPS);
      float d8[8] = {0.f, 0.f, 0.f, 0.f, 0.f, 0.f, 0.f, 0.f};
#pragma unroll
      for (int i = 0; i < 16; ++i) {
        float4 g4 = *(const float4*)&g[i * 64 + sub * 4];
        float y[4] = {v[i].x * rs * g4.x, v[i].y * rs * g4.y, v[i].z * rs * g4.z, v[i].w * rs * g4.w};
        uint2 o; o.x = pack2(y[0], y[1]); o.y = pack2(y[2], y[3]);
        *(uint2*)&dst[i * 64 + sub * 4] = o;
        if (row < MT) {
#pragma unroll
          for (int j = 0; j < 8; ++j) {
            float4 wv = *(const float4*)&wl[j * 1024 + i * 64 + sub * 4];
            d8[j] += y[0] * wv.x + y[1] * wv.y + y[2] * wv.z + y[3] * wv.w;
          }
        }
      }
      if (row < MT) {
#pragma unroll
        for (int j = 0; j < 8; ++j) {
          d8[j] += __shfl_xor(d8[j], 1); d8[j] += __shfl_xor(d8[j], 2); d8[j] += __shfl_xor(d8[j], 4); d8[j] += __shfl_xor(d8[j], 8);
        }
        if (sub < 4) {
          float ag = sel4(sub, d8[0], d8[1], d8[2], d8[3]);
          float bg = sel4(sub, d8[4], d8[5], d8[6], d8[7]);
          float xs = ag + p.dt_bias[sub];
          float sp = (xs > 20.f) ? xs : log1pf(expf(xs));
          p.gb[(size_t)row * 8 + sub] = -expf(p.a_log[sub]) * sp;
          p.gb[(size_t)row * 8 + 4 + sub] = 1.f / (1.f + expf(-bg));
        }
      }
    }
  }
  __syncthreads();
  float* tile = (float*)smem;
  for (int j = blockIdx.x; j < 2816; j += gridDim.x) {
    int t = j;
    if (t < 1088) { int kt = t / 68, nt = t % 68; int n0 = nt * 64; tr_tile(p.w_in, 4360, n0 + (n0 >= 1536 ? 8 : 0), p.WtIn, 1024, kt * 64, n0, tile); continue; }
    t -= 1088;
    if (t < 192) { int kt = t / 16, nt = t % 16; tr_tile(p.w_out, 1024, nt * 64, p.WtOut, 768, kt * 64, nt * 64, tile); continue; }
    t -= 192;
    if (t < 256) { int kt = t / 16, nt = t % 16; tr_tile(p.w_mq, 1024, nt * 64, p.WtMq, 1024, kt * 64, nt * 64, tile); continue; }
    t -= 256;
    if (t < 512) { int kt = t / 32, nt = t % 32; tr_tile(p.w_mkv, 2048, nt * 64, p.WtMkv, 1024, kt * 64, nt * 64, tile); continue; }
    t -= 512;
    if (t < 256) { int kt = t / 16, nt = t % 16; tr_tile(p.w_mo, 1024, nt * 64, p.WtMo, 1024, kt * 64, nt * 64, tile); continue; }
    t -= 256;
    { int kt = t / 32, nt = t % 32; tr_tile(p.w_pq, 2048, nt * 64, p.WtPq, 1024, kt * 64, nt * 64, tile); }
  }
}

DI void dn_prep(const Params& p, int item, char* smem) {
  u16* qs = (u16*)smem;
  u16* ksm = qs + 64 * 136;
  float* sL = (float*)(ksm + 64 * 136);
  float* sgc = sL + 64 * 64;
  float* sbeta = sgc + 64;
  u16* sU = (u16*)sL;
  u16* sW = qs;
  const int tid = threadIdx.x, lane = tid & 63, w = tid >> 6, r = lane & 15, kg = lane >> 4;
  const int bh = item >> 7, n = item & 127, b = bh >> 2, h = bh & 3;
  const int t0 = n * 64;
  const size_t rowbase = (size_t)b * SEQ;
  char* ops = p.dnops + (size_t)item * DN_ITEM;
  __syncthreads();
  if (tid < 64) {
    float gv = p.gb[(rowbase + t0 + tid) * 8 + h];
    float bv = p.gb[(rowbase + t0 + tid) * 8 + 4 + h];
#pragma unroll
    for (int o = 1; o < 64; o <<= 1) { float t = __shfl_up(gv, o); if (lane >= o) gv += t; }
    sgc[tid] = gv; sbeta[tid] = bv;
    if (tid == 63) p.dl[item] = __expf(gv);
  }
#pragma unroll 4
  for (int ps = 0; ps < 8; ++ps) {
    const int combo = ps * 16 + (tid >> 4);
    const int tt = combo & 63, part = combo >> 6, sub = tid & 15;
    const int col = part * 512 + h * 128 + sub * 8;
    float y[8] = {0.f, 0.f, 0.f, 0.f, 0.f, 0.f, 0.f, 0.f};
#pragma unroll
    for (int j = 0; j < 4; ++j) {
      const int t = t0 + tt - 3 + j;
      if (t >= 0) {
        uint4 xv = *(const uint4*)&p.proj[(rowbase + t) * NP + col];
        float4 wa = *(const float4*)&p.conv_w[j * 1536 + col], wb = *(const float4*)&p.conv_w[j * 1536 + col + 4];
        y[0] += bflo(xv.x) * wa.x; y[1] += bfhi(xv.x) * wa.y; y[2] += bflo(xv.y) * wa.z; y[3] += bfhi(xv.y) * wa.w;
        y[4] += bflo(xv.z) * wb.x; y[5] += bfhi(xv.z) * wb.y; y[6] += bflo(xv.w) * wb.z; y[7] += bfhi(xv.w) * wb.w;
      }
    }
    float ss = 0.f;
#pragma unroll
    for (int e = 0; e < 8; ++e) { y[e] = siluf(y[e]); ss += y[e] * y[e]; }
    ss += __shfl_xor(ss, 1); ss += __shfl_xor(ss, 2); ss += __shfl_xor(ss, 4); ss += __shfl_xor(ss, 8);
    float sc = rsqrtf(ss + EPS) * (part == 0 ? 0.08838834764831845f : 1.f);
    uint4 o; o.x = pack2(y[0] * sc, y[1] * sc); o.y = pack2(y[2] * sc, y[3] * sc); o.z = pack2(y[4] * sc, y[5] * sc); o.w = pack2(y[6] * sc, y[7] * sc);
    *(uint4*)&((part == 0 ? qs : ksm)[tt * 136 + sub * 8]) = o;
  }
  __syncthreads();
  const float gcl = sgc[63];
  {
    f32x4 aL[4], aA[4];
#pragma unroll
    for (int i = 0; i < 4; ++i) { aL[i] = (f32x4){0.f, 0.f, 0.f, 0.f}; aA[i] = (f32x4){0.f, 0.f, 0.f, 0.f}; }
#pragma unroll
    for (int ks = 0; ks < 4; ++ks) {
      bf16x8 kI = *(const bf16x8*)&ksm[(w * 16 + r) * 136 + ks * 32 + kg * 8];
      bf16x8 qI = *(const bf16x8*)&qs[(w * 16 + r) * 136 + ks * 32 + kg * 8];
#pragma unroll
      for (int nt = 0; nt < 4; ++nt) {
        bf16x8 kJ = *(const bf16x8*)&ksm[(nt * 16 + r) * 136 + ks * 32 + kg * 8];
        aL[nt] = MFMA(kJ, kI, aL[nt]);
        aA[nt] = MFMA(kJ, qI, aA[nt]);
      }
    }
    const int i = w * 16 + r;
    const float gci = sgc[i], bi = sbeta[i];
    u16* aq = (u16*)(ops + 49152);
#pragma unroll
    for (int nt = 0; nt < 4; ++nt) {
      float lv[4], av[4];
#pragma unroll
      for (int jj = 0; jj < 4; ++jj) {
        const int j = nt * 16 + kg * 4 + jj;
        const float gam = (i >= j) ? __expf(gci - sgc[j]) : 0.f;
        lv[jj] = (i > j) ? aL[nt][jj] * bi * gam : 0.f;
        av[jj] = aA[nt][jj] * gam;
      }
      *(float4*)&sL[i * 64 + nt * 16 + kg * 4] = make_float4(lv[0], lv[1], lv[2], lv[3]);
      uint2 o; o.x = pack2(av[0], av[1]); o.y = pack2(av[2], av[3]);
      *(uint2*)&aq[((w * 2 + (nt >> 1)) * 64 + lane) * 8 + (nt & 1) * 4] = o;
    }
  }
  {
    u16* qg = (u16*)(ops + 16384);
    u16* kdT = (u16*)(ops + 32768);
#pragma unroll 1
    for (int i = 0; i < 4; ++i) {
      const int f = tid + 256 * i;
      const int mtks = f >> 6, l = f & 63, rr = l & 15, kgg = l >> 4;
      {
        const int mt = mtks >> 2, ks = mtks & 3, row = mt * 16 + rr;
        const float e = __expf(sgc[row]);
        uint2 a = *(const uint2*)&qs[row * 136 + ks * 32 + kgg * 4];
        uint2 c = *(const uint2*)&qs[row * 136 + ks * 32 + 16 + kgg * 4];
        uint4 o;
        o.x = pack2(bflo(a.x) * e, bfhi(a.x) * e); o.y = pack2(bflo(a.y) * e, bfhi(a.y) * e);
        o.z = pack2(bflo(c.x) * e, bfhi(c.x) * e); o.w = pack2(bflo(c.y) * e, bfhi(c.y) * e);
        *(uint4*)&qg[(size_t)f * 8] = o;
      }
      {
        const int mt = mtks >> 1, ks = mtks & 1, kdim = mt * 16 + rr;
        float v[8];
#pragma unroll
        for (int j = 0; j < 8; ++j) {
          const int c = ks * 32 + permk(kgg, j);
          v[j] = bf2f(ksm[c * 136 + kdim]) * __expf(gcl - sgc[c]);
        }
        uint4 o; o.x = pack2(v[0], v[1]); o.y = pack2(v[2], v[3]); o.z = pack2(v[4], v[5]); o.w = pack2(v[6], v[7]);
        *(uint4*)&kdT[(size_t)f * 8] = o;
      }
    }
  }
  __syncthreads();
  float x[64];
  if (tid < 128) {
    const int col = 1024 + h * 128 + tid;
    const float w0 = p.conv_w[col], w1 = p.conv_w[1536 + col], w2 = p.conv_w[3072 + col], w3 = p.conv_w[4608 + col];
    float xm3 = 0.f, xm2 = 0.f, xm1 = 0.f;
    if (t0 > 0) {
      xm3 = bf2f(p.proj[(rowbase + t0 - 3) * NP + col]);
      xm2 = bf2f(p.proj[(rowbase + t0 - 2) * NP + col]);
      xm1 = bf2f(p.proj[(rowbase + t0 - 1) * NP + col]);
    }
#pragma unroll
    for (int t = 0; t < 64; ++t) {
      float xc = bf2f(p.proj[(rowbase + t0 + t) * NP + col]);
      float yv = w0 * xm3 + w1 * xm2 + w2 * xm1 + w3 * xc;
      x[t] = siluf(yv) * sbeta[t];
      xm3 = xm2; xm2 = xm1; xm1 = xc;
    }
  } else {
    const int kc = tid - 128;
#pragma unroll
    for (int t = 0; t < 64; ++t) x[t] = bf2f(ksm[t * 136 + kc]) * sbeta[t] * __expf(sgc[t]);
  }
#pragma unroll
  for (int i = 1; i < 64; ++i) {
    float s = x[i];
#pragma unroll
    for (int j4 = 0; j4 < (i + 3) / 4; ++j4) {
      float4 l = *(const float4*)&sL[i * 64 + j4 * 4];
      s -= l.x * x[j4 * 4];
      if (j4 * 4 + 1 < i) s -= l.y * x[j4 * 4 + 1];
      if (j4 * 4 + 2 < i) s -= l.z * x[j4 * 4 + 2];
      if (j4 * 4 + 3 < i) s -= l.w * x[j4 * 4 + 3];
    }
    x[i] = s;
  }
  __syncthreads();
  if (tid < 128) {
#pragma unroll
    for (int t = 0; t < 64; ++t) sU[t * 128 + tid] = f2bf(x[t]);
  } else {
    const int kc = tid - 128;
#pragma unroll
    for (int t = 0; t < 64; ++t) sW[t * 136 + kc] = f2bf(-x[t]);
  }
  __syncthreads();
  {
    u16* nW = (u16*)ops;
    u16* u0 = (u16*)(ops + 57344);
#pragma unroll 1
    for (int i = 0; i < 4; ++i) {
      const int f = tid + 256 * i;
      const int mtks = f >> 6, l = f & 63, rr = l & 15, kgg = l >> 4;
      const int mt = mtks >> 2, ks = mtks & 3, row = mt * 16 + rr;
      uint2 a = *(const uint2*)&sW[row * 136 + ks * 32 + kgg * 4];
      uint2 c = *(const uint2*)&sW[row * 136 + ks * 32 + 16 + kgg * 4];
      *(uint4*)&nW[(size_t)f * 8] = make_uint4(a.x, a.y, c.x, c.y);
    }
#pragma unroll 1
    for (int i = 0; i < 8; ++i) {
      const int f = tid + 256 * i;
      const int smt = f >> 6, l = f & 63, rr = l & 15, kgg = l >> 4;
      const int s = smt >> 2, mt = smt & 3;
      u16 v0 = sU[(mt * 16 + kgg * 4 + 0) * 128 + s * 16 + rr];
      u16 v1 = sU[(mt * 16 + kgg * 4 + 1) * 128 + s * 16 + rr];
      u16 v2 = sU[(mt * 16 + kgg * 4 + 2) * 128 + s * 16 + rr];
      u16 v3 = sU[(mt * 16 + kgg * 4 + 3) * 128 + s * 16 + rr];
      *(uint2*)&u0[(size_t)f * 4] = make_uint2((unsigned)v0 | ((unsigned)v1 << 16), (unsigned)v2 | ((unsigned)v3 << 16));
    }
  }
}

DI void vt_tile(const Params& p, int item, char* smem) {
  u16* tile = (u16*)smem;
  const int tid = threadIdx.x;
  const int ptile = item & 127, gbh = item >> 7;
  const int h = gbh & 3, b = (gbh >> 2) & 3, g = gbh >> 4;
  const int dsh = g * 2, ln = SEQ >> dsh;
  const int pos0 = ptile * 64;
  const int rres = pos0 / ln, i0 = pos0 % ln;
  __syncthreads();
  {
    const int pr = tid >> 2, seg = (tid & 3) * 16;
    const int token = ((i0 + pr) << dsh) + rres;
    const u16* src = &p.proj[((size_t)b * SEQ + token) * NP + 2048 + g * 768 + 512 + h * 64 + seg];
    uint4 a = *(const uint4*)src, c = *(const uint4*)(src + 8);
    unsigned d[8] = {a.x, a.y, a.z, a.w, c.x, c.y, c.z, c.w};
#pragma unroll
    for (int e = 0; e < 8; ++e) *(unsigned*)&tile[pr * 66 + seg + e * 2] = d[e];
  }
  __syncthreads();
  {
    const int dh = tid >> 2, seg = (tid & 3) * 16;
    unsigned o[8];
#pragma unroll
    for (int e = 0; e < 8; ++e) o[e] = (unsigned)tile[(seg + 2 * e) * 66 + dh] | ((unsigned)tile[(seg + 2 * e + 1) * 66 + dh] << 16);
    u16* d = &p.vT[((size_t)gbh * 64 + dh) * SEQ + pos0 + seg];
    *(uint4*)d = make_uint4(o[0], o[1], o[2], o[3]);
    *(uint4*)(d + 8) = make_uint4(o[4], o[5], o[6], o[7]);
  }
}

DI void dn_sample(const Params& p, int item, char* smem) {
  float* sq = (float*)smem;
  float* sk = sq + 512;
  float* sv = sk + 512;
  float* red = sv + 512;
  const int tid = threadIdx.x, lane = tid & 63, w = tid >> 6;
  const int b = item >> 2, h = item & 3;
  __syncthreads();
  for (int c = tid; c < 384; c += 256) {
    const int part = c >> 7, cc = c & 127;
    const int col = part * 512 + h * 128 + cc;
    float xp[7];
#pragma unroll
    for (int j = 0; j < 3; ++j) xp[j] = p.state_conv[((size_t)b * 3 + j) * 1536 + col];
#pragma unroll
    for (int j = 0; j < 4; ++j) xp[3 + j] = bf2f(p.proj[((size_t)MP + b * 4 + j) * NP + col]);
    const float w0 = p.conv_w[col], w1 = p.conv_w[1536 + col], w2 = p.conv_w[3072 + col], w3 = p.conv_w[4608 + col];
    float* dst = part == 0 ? sq : (part == 1 ? sk : sv);
#pragma unroll
    for (int t = 0; t < 4; ++t) dst[t * 128 + cc] = siluf(w0 * xp[t] + w1 * xp[t + 1] + w2 * xp[t + 2] + w3 * xp[t + 3]);
  }
  __syncthreads();
  {
    float a0 = sq[w * 128 + lane], a1 = sq[w * 128 + 64 + lane];
    float s = wave_sum(a0 * a0 + a1 * a1);
    float sc = rsqrtf(s + EPS) * 0.08838834764831845f;
    sq[w * 128 + lane] = a0 * sc; sq[w * 128 + 64 + lane] = a1 * sc;
    float b0 = sk[w * 128 + lane], b1 = sk[w * 128 + 64 + lane];
    s = wave_sum(b0 * b0 + b1 * b1);
    sc = rsqrtf(s + EPS);
    sk[w * 128 + lane] = b0 * sc; sk[w * 128 + 64 + lane] = b1 * sc;
  }
  __syncthreads();
  const int v = tid & 127, half = tid >> 7;
  float S[64];
  const float* s0 = p.state_delta + (((size_t)b * 4 + h) * 128 + half * 64) * 128 + v;
#pragma unroll
  for (int i = 0; i < 64; ++i) S[i] = s0[(size_t)i * 128];
#pragma unroll 1
  for (int t = 0; t < 4; ++t) {
    const size_t row = (size_t)MP + b * 4 + t;
    const float a = __expf(p.gb[row * 8 + h]);
    const float beta = p.gb[row * 8 + 4 + h];
    float part = 0.f;
#pragma unroll
    for (int i = 0; i < 64; ++i) part += S[i] * sk[t * 128 + half * 64 + i];
    red[half * 128 + v] = part;
    __syncthreads();
    const float kS = red[v] + red[128 + v];
    const float u = beta * (sv[t * 128 + v] - a * kS);
    float po = 0.f;
#pragma unroll
    for (int i = 0; i < 64; ++i) { S[i] = a * S[i] + sk[t * 128 + half * 64 + i] * u; po += S[i] * sq[t * 128 + half * 64 + i]; }
    __syncthreads();
    red[half * 128 + v] = po;
    __syncthreads();
    if (half == 0) p.odn[row * 512 + h * 128 + v] = f2bf(red[v] + red[128 + v]);
    __syncthreads();
  }
  float* d = p.out + O_SDELTA + (((size_t)b * 4 + h) * 128 + half * 64) * 128 + v;
#pragma unroll
  for (int i = 0; i < 64; ++i) d[(size_t)i * 128] = S[i];
}

DI void phase2(const Params& p, char* smem) {
  const size_t gtid = (size_t)blockIdx.x * 256 + threadIdx.x, gsz = (size_t)gridDim.x * 256;
  for (int j = blockIdx.x; j < 2048 + 128 + 6144; j += gridDim.x) {
    if (j < 2048) dn_prep(p, j, smem);
    else if (j < 2048 + 128) dn_sample(p, j - 2048, smem);
    else vt_tile(p, j - 2176, smem);
  }
  for (size_t f = gtid; f < (size_t)16 * 8192; f += gsz) {
    {
      const size_t e0 = f * 8;
      const int bh = (int)(e0 >> 16), key = (int)((e0 >> 8) & 255), dh = (int)(e0 & 255);
      const int b = bh >> 2, h = bh & 3;
      cvt8(p.out + O_PMEM + (((size_t)b * 256 + key) * 2 + 0) * 1024 + h * 256 + dh, p.Kb + e0);
    }
    {
      const int l = (int)(f & 63), ks = (int)((f >> 6) & 7), nt = (int)((f >> 9) & 15), bh = (int)(f >> 13);
      const int b = bh >> 2, h = bh & 3, rr = l & 15, kgg = l >> 4;
      float v[8];
#pragma unroll
      for (int j = 0; j < 8; ++j) {
        const int key = ks * 32 + permk(kgg, j);
        v[j] = p.out[O_PMEM + (((size_t)b * 256 + key) * 2 + 1) * 1024 + h * 256 + nt * 16 + rr];
      }
      *(uint4*)&p.VTf[f * 8] = make_uint4(pack2(v[0], v[1]), pack2(v[2], v[3]), pack2(v[4], v[5]), pack2(v[6], v[7]));
    }
  }
  for (size_t i = gtid; i < 18432; i += gsz) {
    const int c = (int)(i % 1536), j = (int)((i / 1536) % 3), b = (int)(i / 4608);
    p.out[O_PCONV + i] = bf2f(p.proj[((size_t)b * SEQ + SEQ - 3 + j) * NP + c]);
  }
  for (int g = 0; g < 3; ++g) {
    const int W = 128 << (2 * g);
    const size_t off = (g == 0) ? O_PW1 : (g == 1 ? O_PW2 : O_PW3);
    const size_t n4 = (size_t)4 * W * 512 / 4;
    for (size_t i = gtid; i < n4; i += gsz) {
      const size_t e0 = i * 4;
      const int e = (int)(e0 & 511), ii = (int)((e0 >> 9) % W), b = (int)((e0 >> 9) / W);
      uint2 v = *(const uint2*)&p.proj[((size_t)b * SEQ + SEQ - W + ii) * NP + 2048 + g * 768 + 256 + e];
      *(float4*)&p.out[off + e0] = make_float4(bflo(v.x), bfhi(v.x), bflo(v.y), bfhi(v.y));
    }
  }
}

typedef __attribute__((ext_vector_type(2))) unsigned u32x2;
struct ScanOps { bf16x8 nW[4]; bf16x8 qg[4]; bf16x8 aq[2]; bf16x8 kd[4]; u32x2 u0; float dl; };

DI void scan_load(const Params& p, int bh, int s, int n, int j, int lane, ScanOps& o) {
  n = n > 127 ? 127 : n;
  const char AS1* base = (const char AS1*)p.dnops + (size_t)(bh * 128 + n) * DN_ITEM;
  gb8p negW = (gb8p)base;
  gb8p qg = (gb8p)(base + 16384);
  gb8p kdT = (gb8p)(base + 32768);
  gb8p aqk = (gb8p)(base + 49152);
  const u32x2 AS1* u0 = (const u32x2 AS1*)(base + 57344);
#pragma unroll
  for (int ks = 0; ks < 4; ++ks) o.nW[ks] = negW[(j * 4 + ks) * 64 + lane];
#pragma unroll
  for (int ks = 0; ks < 4; ++ks) o.qg[ks] = qg[(j * 4 + ks) * 64 + lane];
#pragma unroll
  for (int k2 = 0; k2 < 2; ++k2) o.aq[k2] = aqk[(j * 2 + k2) * 64 + lane];
#pragma unroll
  for (int mm = 0; mm < 2; ++mm)
#pragma unroll
    for (int k2 = 0; k2 < 2; ++k2) o.kd[mm * 2 + k2] = kdT[((2 * j + mm) * 2 + k2) * 64 + lane];
  o.u0 = u0[(s * 4 + j) * 64 + lane];
  o.dl = ((const float AS1*)p.dl)[bh * 128 + n];
}

DI void scan_step(const Params& p, const ScanOps& ops, int n, int b, int h, int s, int j, int lane, f32x4& S0, f32x4& S1,
                  bf16x8* sSb, u32x2* sUb) {
  const int r = lane & 15, kg = lane >> 4;
  bf16x8 sb[4];
#pragma unroll
  for (int ks = 0; ks < 4; ++ks) sb[ks] = sSb[ks * 64 + lane];
  f32x4 u = (f32x4){bflo(ops.u0[0]), bfhi(ops.u0[0]), bflo(ops.u0[1]), bfhi(ops.u0[1])};
#pragma unroll
  for (int ks = 0; ks < 4; ++ks) u = MFMA(ops.nW[ks], sb[ks], u);
  {
    u32x2 t; t[0] = pack2(u[0], u[1]); t[1] = pack2(u[2], u[3]);
    sUb[((j >> 1) * 64 + lane) * 2 + (j & 1)] = t;
  }
  __syncthreads();
  bf16x8 ub[2];
#pragma unroll
  for (int k2 = 0; k2 < 2; ++k2) ub[k2] = *(const bf16x8*)&sUb[(k2 * 64 + lane) * 2];
  f32x4 o = (f32x4){0.f, 0.f, 0.f, 0.f};
#pragma unroll
  for (int ks = 0; ks < 4; ++ks) o = MFMA(ops.qg[ks], sb[ks], o);
#pragma unroll
  for (int k2 = 0; k2 < 2; ++k2) o = MFMA(ops.aq[k2], ub[k2], o);
  S0 = S0 * ops.dl; S1 = S1 * ops.dl;
#pragma unroll
  for (int k2 = 0; k2 < 2; ++k2) { S0 = MFMA(ops.kd[k2], ub[k2], S0); S1 = MFMA(ops.kd[2 + k2], ub[k2], S1); }
  sSb[j * 64 + lane] = pack8(S0, S1);
#pragma unroll
  for (int jj = 0; jj < 4; ++jj) {
    const size_t token = (size_t)b * SEQ + n * 64 + j * 16 + kg * 4 + jj;
    G(p.odn)[token * 512 + h * 128 + s * 16 + r] = f2bf(o[jj]);
  }
  __syncthreads();
}

DI void dn_scan_block(const Params& p, int item, char* smem) {
  const int lane = threadIdx.x & 63, j = threadIdx.x >> 6, r = lane & 15, kg = lane >> 4;
  const int bh = item >> 3, s = item & 7, b = bh >> 2, h = bh & 3;
  bf16x8* sSb = (bf16x8*)smem;
  u32x2* sUb = (u32x2*)(smem + 4096);
  f32x4 S0 = (f32x4){0.f, 0.f, 0.f, 0.f}, S1 = (f32x4){0.f, 0.f, 0.f, 0.f};
  __syncthreads();
  sSb[j * 64 + lane] = pack8(S0, S1);
  ScanOps A, B;
  scan_load(p, bh, s, 0, j, lane, A);
  scan_load(p, bh, s, 1, j, lane, B);
  __syncthreads();
#pragma unroll 1
  for (int n0 = 0; n0 < 128; n0 += 2) {
    scan_step(p, A, n0, b, h, s, j, lane, S0, S1, sSb, sUb);
    scan_load(p, bh, s, n0 + 2, j, lane, A);
    scan_step(p, B, n0 + 1, b, h, s, j, lane, S0, S1, sSb, sUb);
    scan_load(p, bh, s, n0 + 3, j, lane, B);
  }
#pragma unroll
  for (int jj = 0; jj < 4; ++jj) {
    p.out[O_PDELTA + ((size_t)bh * 128 + 32 * j + kg * 4 + jj) * 128 + s * 16 + r] = S0[jj];
    p.out[O_PDELTA + ((size_t)bh * 128 + 32 * j + 16 + kg * 4 + jj) * 128 + s * 16 + r] = S1[jj];
  }
}

DI void sw_prompt_wave(const Params& p, int item) {
  const int lane = threadIdx.x & 63, r = lane & 15, kg = lane >> 4;
  const int qt = item & 511, gbh = item >> 9;
  const int h = gbh & 3, b = (gbh >> 2) & 3, g = gbh >> 4;
  const int dsh = 2 * g, ln = SEQ >> dsh;
  const int pos0 = qt * 16, rres = pos0 / ln, i0 = pos0 % ln;
  const int kbase = i0 - 144;
  const size_t rb = (size_t)b * SEQ;
  const int qoff = 2048 + g * 768 + h * 64, koff = qoff + 256;
  bf16x8 qf[2];
  {
    const size_t tok = rb + ((size_t)(i0 + r) << dsh) + rres;
#pragma unroll
    for (int ks = 0; ks < 2; ++ks) qf[ks] = *(const bf16x8*)&p.proj[tok * NP + qoff + ks * 32 + kg * 8];
  }
  f32x4 st[10];
#pragma unroll
  for (int mt = 0; mt < 10; ++mt) {
    int ki = kbase + mt * 16 + r; ki = ki < 0 ? 0 : ki;
    const size_t tok = rb + ((size_t)ki << dsh) + rres;
    f32x4 a = (f32x4){0.f, 0.f, 0.f, 0.f};
#pragma unroll
    for (int ks = 0; ks < 2; ++ks) {
      bf16x8 kf = *(const bf16x8*)&p.proj[tok * NP + koff + ks * 32 + kg * 8];
      a = MFMA(kf, qf[ks], a);
    }
    st[mt] = a;
  }
  const int qi = i0 + r;
  float mx = -3.0e38f;
#pragma unroll
  for (int mt = 0; mt < 10; ++mt)
#pragma unroll
    for (int j = 0; j < 4; ++j) {
      const int ki = kbase + mt * 16 + kg * 4 + j;
      const int d = qi - ki;
      const bool valid = (ki >= 0) && (d >= 0) && (d <= 128);
      const float sv = valid ? st[mt][j] * 0.125f : -3.0e38f;
      st[mt][j] = sv;
      mx = fmaxf(mx, sv);
    }
  mx = fmaxf(mx, __shfl_xor(mx, 16));
  mx = fmaxf(mx, __shfl_xor(mx, 32));
  float sum = 0.f;
#pragma unroll
  for (int mt = 0; mt < 10; ++mt)
#pragma unroll
    for (int j = 0; j < 4; ++j) {
      const float pv = (st[mt][j] > -1.0e38f) ? __expf(st[mt][j] - mx) : 0.f;
      st[mt][j] = pv;
      sum += pv;
    }
  sum += __shfl_xor(sum, 16);
  sum += __shfl_xor(sum, 32);
  const float inv = 1.f / sum;
  bf16x8 pf[5];
#pragma unroll
  for (int k2 = 0; k2 < 5; ++k2) pf[k2] = pack8(st[2 * k2], st[2 * k2 + 1]);
  const size_t qrow = rb + ((size_t)qi << dsh) + rres;
#pragma unroll
  for (int nt = 0; nt < 4; ++nt) {
    f32x4 o = (f32x4){0.f, 0.f, 0.f, 0.f};
    const u16* vrow = &p.vT[((size_t)gbh * 64 + nt * 16 + r) * SEQ + (size_t)rres * ln];
#pragma unroll
    for (int k2 = 0; k2 < 5; ++k2) {
      int ka = kbase + k2 * 32 + kg * 4, kc = ka + 16;
      ka = ka < 0 ? 0 : ka; kc = kc < 0 ? 0 : kc;
      uint2 va = *(const uint2*)&vrow[ka];
      uint2 vc = *(const uint2*)&vrow[kc];
      bf16x8 vf = __builtin_bit_cast(bf16x8, make_uint4(va.x, va.y, vc.x, vc.y));
      o = MFMA(vf, pf[k2], o);
    }
    uint2 ov; ov.x = pack2(o[0] * inv, o[1] * inv); ov.y = pack2(o[2] * inv, o[3] * inv);
    *(uint2*)&p.osw[((size_t)g * MT + qrow) * 256 + h * 64 + nt * 16 + kg * 4] = ov;
  }
  if (kg == 0) p.lse[((size_t)g * MT + qrow) * 4 + h] = mx + __logf(sum);
}

DI void sw_sample_wave(const Params& p, int item) {
  const int lane = threadIdx.x & 63;
  const int t = item & 3, h = (item >> 2) & 3, b = (item >> 4) & 31, g = item >> 9;
  const int dil = 1 << (2 * g), W = 128 << (2 * g);
  const float* c1 = p.cw1;
  const float* c2 = p.cw2;
  const float* c3 = p.cw3;
  const float* cache = (g == 0) ? c1 : (g == 1 ? c2 : c3);
  const int qoff = 2048 + g * 768 + h * 64;
  const size_t qrow = (size_t)MP + b * 4 + t;
  float q[64];
#pragma unroll
  for (int c = 0; c < 64; c += 8) {
    uint4 v = *(const uint4*)&p.proj[qrow * NP + qoff + c];
    q[c] = bflo(v.x); q[c + 1] = bfhi(v.x); q[c + 2] = bflo(v.y); q[c + 3] = bfhi(v.y);
    q[c + 4] = bflo(v.z); q[c + 5] = bfhi(v.z); q[c + 6] = bflo(v.w); q[c + 7] = bfhi(v.w);
  }
  float sc[3];
#pragma unroll
  for (int mi = 0; mi < 3; ++mi) {
    const int m = lane + 64 * mi;
    float s = -3.0e38f;
    if (m <= 128) {
      const int j = W + t - m * dil;
      float d = 0.f;
      if (j >= W) {
        const u16* kr = &p.proj[((size_t)MP + b * 4 + (j - W)) * NP + qoff + 256];
#pragma unroll
        for (int c = 0; c < 64; c += 8) {
          uint4 v = *(const uint4*)&kr[c];
          d += q[c] * bflo(v.x) + q[c + 1] * bfhi(v.x) + q[c + 2] * bflo(v.y) + q[c + 3] * bfhi(v.y) + q[c + 4] * bflo(v.z) +
               q[c + 5] * bfhi(v.z) + q[c + 6] * bflo(v.w) + q[c + 7] * bfhi(v.w);
        }
      } else {
        const float* kr = &cache[(((size_t)b * W + j) * 2 + 0) * 256 + h * 64];
#pragma unroll
        for (int c = 0; c < 64; c += 4) {
          float4 v = *(const float4*)&kr[c];
          d += q[c] * v.x + q[c + 1] * v.y + q[c + 2] * v.z + q[c + 3] * v.w;
        }
      }
      s = d * 0.125f;
    }
    sc[mi] = s;
  }
  float mx = wave_max(fmaxf(fmaxf(sc[0], sc[1]), sc[2]));
  float sum = 0.f;
#pragma unroll
  for (int mi = 0; mi < 3; ++mi) { sc[mi] = (sc[mi] > -1.0e38f) ? __expf(sc[mi] - mx) : 0.f; sum += sc[mi]; }
  sum = wave_sum(sum);
  float o = 0.f;
#pragma unroll
  for (int mi = 0; mi < 3; ++mi) {
#pragma unroll 8
    for (int mm = 0; mm < 64; ++mm) {
      const int m = mi * 64 + mm;
      if (m <= 128) {
        const float pv = __shfl(sc[mi], mm);
        const int j = W + t - m * dil;
        float vv;
        if (j >= W) vv = bf2f(p.proj[((size_t)MP + b * 4 + (j - W)) * NP + qoff + 512 + lane]);
        else vv = cache[(((size_t)b * W + j) * 2 + 1) * 256 + h * 64 + lane];
        o += pv * vv;
      }
    }
  }
  p.osw[((size_t)g * MT + qrow) * 256 + h * 64 + lane] = f2bf(o / sum);
  if (lane == 0) p.lse[((size_t)g * MT + qrow) * 4 + h] = mx + __logf(sum);
}

DI void phase3(const Params& p, char* smem) {
  const int w = threadIdx.x >> 6;
  if (blockIdx.x < 128) {
    dn_scan_block(p, blockIdx.x, smem);
  } else {
    const int gw = (blockIdx.x - 128) * 4 + w, nw = (gridDim.x - 128) * 4;
    for (int it = gw; it < 24576 + 1536; it += nw) {
      if (it < 24576) sw_prompt_wave(p, it);
      else sw_sample_wave(p, it - 24576);
    }
  }
}

DI void phase4(const Params& p) {
  const int lane = threadIdx.x & 63, w = threadIdx.x >> 6;
  for (int row = blockIdx.x * 4 + w; row < MT; row += gridDim.x * 4) {
    u16* dst = p.Amix + (size_t)row * 768;
#pragma unroll
    for (int h = 0; h < 4; ++h) {
      unsigned ov = *(const unsigned*)&p.odn[(size_t)row * 512 + h * 128 + lane * 2];
      unsigned zv = *(const unsigned*)&p.proj[(size_t)row * NP + 1536 + h * 128 + lane * 2];
      float o0 = bflo(ov), o1 = bfhi(ov);
      float ss = wave_sum(o0 * o0 + o1 * o1);
      float rs = rsqrtf(ss * (1.f / 128.f) + EPS);
      float2 gn = *(const float2*)&p.g_onorm[lane * 2];
      float y0 = o0 * rs * gn.x * siluf(bflo(zv)), y1 = o1 * rs * gn.y * siluf(bfhi(zv));
      *(unsigned*)&dst[h * 128 + lane * 2] = pack2(y0, y1);
    }
    {
      const int h = lane >> 4;
      float l0 = p.lse[((size_t)0 * MT + row) * 4 + h], l1 = p.lse[((size_t)1 * MT + row) * 4 + h], l2 = p.lse[((size_t)2 * MT + row) * 4 + h];
      float m = fmaxf(l0, fmaxf(l1, l2));
      float e0 = __expf(l0 - m), e1 = __expf(l1 - m), e2 = __expf(l2 - m);
      float inv = 1.f / (e0 + e1 + e2);
      uint2 a = *(const uint2*)&p.osw[((size_t)0 * MT + row) * 256 + lane * 4];
      uint2 c = *(const uint2*)&p.osw[((size_t)1 * MT + row) * 256 + lane * 4];
      uint2 d = *(const uint2*)&p.osw[((size_t)2 * MT + row) * 256 + lane * 4];
      e0 *= inv; e1 *= inv; e2 *= inv;
      float y0 = e0 * bflo(a.x) + e1 * bflo(c.x) + e2 * bflo(d.x);
      float y1 = e0 * bfhi(a.x) + e1 * bfhi(c.x) + e2 * bfhi(d.x);
      float y2 = e0 * bflo(a.y) + e1 * bflo(c.y) + e2 * bflo(d.y);
      float y3 = e0 * bfhi(a.y) + e1 * bfhi(c.y) + e2 * bfhi(d.y);
      *(uint2*)&dst[512 + lane * 4] = make_uint2(pack2(y0, y1), pack2(y2, y3));
    }
  }
}

DI void sample_state_copy(const Params& p) {
  const size_t gtid = (size_t)blockIdx.x * 256 + threadIdx.x, gsz = (size_t)gridDim.x * 256;
  for (size_t i = gtid; i < 147456; i += gsz) {
    const int c = (int)(i % 1536), j = (int)((i / 1536) % 3), b = (int)(i / 4608);
    p.out[O_SCONV + i] = bf2f(p.proj[((size_t)MP + b * 4 + j + 1) * NP + c]);
  }
  const float* c1 = p.cw1;
  const float* c2 = p.cw2;
  const float* c3 = p.cw3;
  for (int g = 0; g < 3; ++g) {
    const int W = 128 << (2 * g);
    const float* cache = (g == 0) ? c1 : (g == 1 ? c2 : c3);
    const size_t off = (g == 0) ? O_SW1 : (g == 1 ? O_SW2 : O_SW3);
    const size_t n4 = (size_t)32 * W * 512 / 4;
#pragma unroll 4
    for (size_t i = gtid; i < n4; i += gsz) {
      const size_t e0 = i * 4;
      const int e = (int)(e0 & 511), ii = (int)((e0 >> 9) % W), b = (int)((e0 >> 9) / W);
      float4 o;
      if (ii < W - 4) o = *(const float4*)&cache[((size_t)b * W + ii + 4) * 512 + e];
      else {
        uint2 v = *(const uint2*)&p.proj[((size_t)MP + b * 4 + (ii - (W - 4))) * NP + 2048 + g * 768 + 256 + e];
        o = make_float4(bflo(v.x), bfhi(v.x), bflo(v.y), bfhi(v.y));
      }
      *(float4*)&p.out[off + e0] = o;
    }
  }
}

DI void mem_attn_prompt_block(const Params& p, int item, char* smem) {
  const int tid = threadIdx.x, lane = tid & 63, w = tid >> 6, r = lane & 15, kg = lane >> 4;
  const int h = item & 3, qb = item >> 2;
  const int row0 = qb * 64 + w * 16, b = (qb * 64) >> 13;
  const int bh = b * 4 + h;
  u16* sK = (u16*)smem;
  bf16x8 qf[8];
#pragma unroll
  for (int ks = 0; ks < 8; ++ks) qf[ks] = *(const bf16x8*)&G(p.qb)[(size_t)(row0 + r) * 1024 + h * 256 + ks * 32 + kg * 8];
  f32x4 st[16];
  const u16* kbp = G(p.Kb) + (size_t)bh * 65536;
#pragma unroll
  for (int c = 0; c < 4; ++c) {
    __syncthreads();
#pragma unroll
    for (int i2 = 0; i2 < 2; ++i2) {
#pragma unroll
      for (int i = i2 * 4; i < i2 * 4 + 4; ++i) {
        const int idx = tid + 256 * i, row = idx >> 5, seg = idx & 31;
        *(bf16x8*)&sK[row * 264 + seg * 8] = *(gb8p)((gu16p)kbp + (size_t)(c * 64 + row) * 256 + seg * 8);
      }
      __builtin_amdgcn_sched_barrier(0);
    }
    __syncthreads();
#pragma unroll
    for (int m4 = 0; m4 < 4; ++m4) {
      f32x4 a = (f32x4){0.f, 0.f, 0.f, 0.f};
#pragma unroll
      for (int ks = 0; ks < 8; ++ks) {
        bf16x8 kf = *(const bf16x8*)&sK[(m4 * 16 + r) * 264 + ks * 32 + kg * 8];
        a = MFMA(kf, qf[ks], a);
      }
      st[c * 4 + m4] = a;
      __builtin_amdgcn_sched_barrier(0);
    }
  }
  float mx = -3.0e38f;
#pragma unroll
  for (int mt = 0; mt < 16; ++mt)
#pragma unroll
    for (int j = 0; j < 4; ++j) { st[mt][j] *= 0.0625f; mx = fmaxf(mx, st[mt][j]); }
  mx = fmaxf(mx, __shfl_xor(mx, 16));
  mx = fmaxf(mx, __shfl_xor(mx, 32));
  float sum = 0.f;
#pragma unroll
  for (int mt = 0; mt < 16; ++mt)
#pragma unroll
    for (int j = 0; j < 4; ++j) { st[mt][j] = __expf(st[mt][j] - mx); sum += st[mt][j]; }
  sum += __shfl_xor(sum, 16);
  sum += __shfl_xor(sum, 32);
  const float inv = 1.f / sum;
  bf16x8 pf[8];
#pragma unroll
  for (int k2 = 0; k2 < 8; ++k2) pf[k2] = pack8(st[2 * k2], st[2 * k2 + 1]);
  const u16* vtp = G(p.VTf) + (size_t)bh * 65536;
#pragma unroll 1
  for (int c = 0; c < 4; ++c) {
    __syncthreads();
#pragma unroll
    for (int i = 0; i < 8; ++i) {
      const int idx = tid + 256 * i;
      *(bf16x8*)&sK[idx * 8] = *(gb8p)((gu16p)vtp + (size_t)c * 16384 + idx * 8);
    }
    __syncthreads();
#pragma unroll
    for (int n4 = 0; n4 < 4; ++n4) {
      f32x4 o = (f32x4){0.f, 0.f, 0.f, 0.f};
#pragma unroll
      for (int k2 = 0; k2 < 8; ++k2) o = MFMA(*(const bf16x8*)&sK[((n4 * 8 + k2) * 64 + lane) * 8], pf[k2], o);
      uint2 ov; ov.x = pack2(o[0] * inv, o[1] * inv); ov.y = pack2(o[2] * inv, o[3] * inv);
      *(uint2*)&G(p.attn)[(size_t)(row0 + r) * 1024 + h * 256 + (c * 4 + n4) * 16 + kg * 4] = ov;
      __builtin_amdgcn_sched_barrier(0);
    }
  }
}

DI void mem_attn_sample_wave(const Params& p, int item, float* lds) {
  const int lane = threadIdx.x & 63;
  const int b = item >> 2, h = item & 3;
  float* sq = lds;
#pragma unroll
  for (int t = 0; t < 4; ++t) {
    uint2 v = *(const uint2*)&p.qb[((size_t)MP + b * 4 + t) * 1024 + h * 256 + lane * 4];
    *(float4*)&sq[t * 256 + lane * 4] = make_float4(bflo(v.x), bfhi(v.x), bflo(v.y), bfhi(v.y));
  }
  __builtin_amdgcn_s_waitcnt(0);
  __builtin_amdgcn_wave_barrier();
  float sc[4][4];
#pragma unroll
  for (int mi = 0; mi < 4; ++mi) {
    const int m = lane + 64 * mi;
    const float* kr = &p.cache_mem[(((size_t)b * 256 + m) * 2 + 0) * 1024 + h * 256];
    float d0 = 0.f, d1 = 0.f, d2 = 0.f, d3 = 0.f;
#pragma unroll 2
    for (int c = 0; c < 256; c += 4) {
      float4 kv = *(const float4*)&kr[c];
      float4 q0 = *(const float4*)&sq[c], q1 = *(const float4*)&sq[256 + c], q2 = *(const float4*)&sq[512 + c], q3 = *(const float4*)&sq[768 + c];
      d0 += kv.x * q0.x + kv.y * q0.y + kv.z * q0.z + kv.w * q0.w;
      d1 += kv.x * q1.x + kv.y * q1.y + kv.z * q1.z + kv.w * q1.w;
      d2 += kv.x * q2.x + kv.y * q2.y + kv.z * q2.z + kv.w * q2.w;
      d3 += kv.x * q3.x + kv.y * q3.y + kv.z * q3.z + kv.w * q3.w;
    }
    sc[0][mi] = d0 * 0.0625f; sc[1][mi] = d1 * 0.0625f; sc[2][mi] = d2 * 0.0625f; sc[3][mi] = d3 * 0.0625f;
  }
  float inv[4];
  __builtin_amdgcn_wave_barrier();
#pragma unroll
  for (int t = 0; t < 4; ++t) {
    float mx = wave_max(fmaxf(fmaxf(sc[t][0], sc[t][1]), fmaxf(sc[t][2], sc[t][3])));
    float sum = 0.f;
#pragma unroll
    for (int mi = 0; mi < 4; ++mi) { sc[t][mi] = __expf(sc[t][mi] - mx); sum += sc[t][mi]; }
    sum = wave_sum(sum);
    inv[t] = 1.f / sum;
#pragma unroll
    for (int mi = 0; mi < 4; ++mi) sq[t * 256 + lane + 64 * mi] = sc[t][mi];
  }
  __builtin_amdgcn_s_waitcnt(0);
  __builtin_amdgcn_wave_barrier();
  float4 o[4];
#pragma unroll
  for (int t = 0; t < 4; ++t) o[t] = make_float4(0.f, 0.f, 0.f, 0.f);
#pragma unroll 4
  for (int m = 0; m < 256; ++m) {
    float4 vv = *(const float4*)&p.cache_mem[(((size_t)b * 256 + m) * 2 + 1) * 1024 + h * 256 + lane * 4];
#pragma unroll
    for (int t = 0; t < 4; ++t) {
      const float pv = sq[t * 256 + m];
      o[t].x += pv * vv.x; o[t].y += pv * vv.y; o[t].z += pv * vv.z; o[t].w += pv * vv.w;
    }
  }
#pragma unroll
  for (int t = 0; t < 4; ++t) {
    uint2 ov; ov.x = pack2(o[t].x * inv[t], o[t].y * inv[t]); ov.y = pack2(o[t].z * inv[t], o[t].w * inv[t]);
    *(uint2*)&p.attn[((size_t)MP + b * 4 + t) * 1024 + h * 256 + lane * 4] = ov;
  }
  __builtin_amdgcn_wave_barrier();
}

DI void phase7(const Params& p, char* smem) {
  const int w = threadIdx.x >> 6;
  float* lds = (float*)smem + w * 1280;
  for (int it = blockIdx.x; it < 32 + 2048; it += gridDim.x) {
    if (it < 32) { __syncthreads(); mem_attn_sample_wave(p, it * 4 + w, lds); }
    else mem_attn_prompt_block(p, it - 32, smem);
  }
}

DI void peer_topk_wave(const Params& p, int item, unsigned* lds  ) {
  const int lane = threadIdx.x & 63, r = lane & 15, kg = lane >> 4;
  const int h = item & 7, row0 = (item >> 3) * 16;
  unsigned win[2][16];
#pragma unroll
  for (int pp = 0; pp < 2; ++pp) {
    bf16x8 qf[4];
#pragma unroll
    for (int ks = 0; ks < 4; ++ks) qf[ks] = *(const bf16x8*)&p.pq[(size_t)(row0 + r) * 2048 + h * 256 + pp * 128 + ks * 32 + kg * 8];
    unsigned kk[32];
    const u16* sk = p.subkb + (size_t)(h * 2 + pp) * 16384;
#pragma unroll
    for (int mt = 0; mt < 8; ++mt) {
      f32x4 a = (f32x4){0.f, 0.f, 0.f, 0.f};
#pragma unroll
      for (int ks = 0; ks < 4; ++ks) {
        bf16x8 kf = *(const bf16x8*)&sk[(mt * 16 + r) * 128 + ks * 32 + kg * 8];
        a = MFMA(kf, qf[ks], a);
      }
#pragma unroll
      for (int j = 0; j < 4; ++j) kk[mt * 4 + j] = (ordf(a[j]) & ~127u) | (unsigned)(mt * 16 + kg * 4 + j);
    }
#pragma unroll
    for (int rr = 0; rr < 16; ++rr) {
      unsigned m = 0;
#pragma unroll
      for (int i = 0; i < 32; ++i) m = umax(m, kk[i]);
      m = umax(m, (unsigned)__shfl_xor((int)m, 16));
      m = umax(m, (unsigned)__shfl_xor((int)m, 32));
      win[pp][rr] = m;
#pragma unroll
      for (int i = 0; i < 32; ++i) kk[i] = (kk[i] == m) ? 0u : kk[i];
    }
  }
  float f0[16], f1[16];
#pragma unroll
  for (int i = 0; i < 16; ++i) { f0[i] = unordf(win[0][i] & ~127u); f1[i] = unordf(win[1][i] & ~127u); }
  unsigned cand[13];
#define CAND(s, a0, b0, a1, b1, a2, b2, a3, b3)                                                         \
  {                                                                                                     \
    float va = sel4(kg, f0[a0], f0[a1], f0[a2], f0[(a3) < 0 ? 0 : (a3)]);                                \
    float vb = sel4(kg, f1[b0], f1[b1], f1[b2], f1[(b3) < 0 ? 0 : (b3)]);                                \
    unsigned id = sel4(kg, (unsigned)((a0) * 16 + (b0)), (unsigned)((a1) * 16 + (b1)), (unsigned)((a2) * 16 + (b2)), (unsigned)(((a3) < 0 ? 0 : (a3)) * 16 + ((b3) < 0 ? 0 : (b3)))); \
    unsigned key = (ordf(va + vb) & ~255u) | id;                                                        \
    if ((a3) < 0) key = (kg == 3) ? 0u : key;                                                           \
    cand[s] = key;                                                                                      \
  }
  CAND(0, 0, 0, 0, 13, 2, 0, 6, 1)
  CAND(1, 0, 1, 0, 14, 2, 1, 7, 0)
  CAND(2, 0, 2, 0, 15, 2, 2, 7, 1)
  CAND(3, 0, 3, 1, 0, 2, 3, 8, 0)
  CAND(4, 0, 4, 1, 1, 2, 4, 9, 0)
  CAND(5, 0, 5, 1, 2, 3, 0, 10, 0)
  CAND(6, 0, 6, 1, 3, 3, 1, 11, 0)
  CAND(7, 0, 7, 1, 4, 3, 2, 12, 0)
  CAND(8, 0, 8, 1, 5, 3, 3, 13, 0)
  CAND(9, 0, 9, 1, 6, 4, 2, 14, 0)
  CAND(10, 0, 10, 1, 7, 5, 0, 15, 0)
  CAND(11, 0, 11, 4, 0, 5, 1, -1, -1)
  CAND(12, 0, 12, 4, 1, 6, 0, -1, -1)
#undef CAND
  unsigned w2[16];
#pragma unroll
  for (int rr = 0; rr < 16; ++rr) {
    unsigned m = 0;
#pragma unroll
    for (int i = 0; i < 13; ++i) m = umax(m, cand[i]);
    m = umax(m, (unsigned)__shfl_xor((int)m, 16));
    m = umax(m, (unsigned)__shfl_xor((int)m, 32));
    w2[rr] = m;
#pragma unroll
    for (int i = 0; i < 13; ++i) cand[i] = (cand[i] == m) ? 0u : cand[i];
  }
  if (kg == 0) {
#pragma unroll
    for (int i = 0; i < 16; ++i) { lds[r * 32 + i] = win[0][i] & 127u; lds[r * 32 + 16 + i] = win[1][i] & 127u; }
  }
  __builtin_amdgcn_s_waitcnt(0);
  __builtin_amdgcn_wave_barrier();
  const float cv0 = unordf(w2[0] & ~255u);
  float sum = 0.f;
#pragma unroll
  for (int rr = 0; rr < 16; ++rr) sum += __expf(unordf(w2[rr] & ~255u) - cv0);
  const float inv = 1.f / sum;
  const size_t ob = ((size_t)(row0 + r) * 8 + h) * 16;
#pragma unroll
  for (int q = 0; q < 4; ++q) {
    const unsigned wk = sel4(kg, w2[q], w2[4 + q], w2[8 + q], w2[12 + q]);
    const int a = (wk >> 4) & 15, bb = wk & 15;
    const int i1 = (int)lds[r * 32 + a], i2 = (int)lds[r * 32 + 16 + bb];
    p.eid[ob + kg * 4 + q] = i1 * 128 + i2;
    p.gate[ob + kg * 4 + q] = __expf(unordf(wk & ~255u) - cv0) * inv;
  }
  __builtin_amdgcn_wave_barrier();
}

typedef __attribute__((ext_vector_type(2))) float f32x2;
DI float dot16_fp8(u32x4 u, const float* x, float c) {
  const unsigned d[4] = {u[0], u[1], u[2], u[3]};
#pragma unroll
  for (int i = 0; i < 4; ++i) {
    f32x2 a = __builtin_amdgcn_cvt_pk_f32_fp8((int)d[i], false);
    f32x2 b = __builtin_amdgcn_cvt_pk_f32_fp8((int)d[i], true);
    c += a[0] * x[4 * i] + a[1] * x[4 * i + 1] + b[0] * x[4 * i + 2] + b[1] * x[4 * i + 3];
  }
  return c;
}
DI void axpy16_fp8(float* o, float w, u32x4 u) {
  const unsigned d[4] = {u[0], u[1], u[2], u[3]};
#pragma unroll
  for (int i = 0; i < 4; ++i) {
    f32x2 a = __builtin_amdgcn_cvt_pk_f32_fp8((int)d[i], false);
    f32x2 b = __builtin_amdgcn_cvt_pk_f32_fp8((int)d[i], true);
    o[4 * i] += w * a[0]; o[4 * i + 1] += w * a[1]; o[4 * i + 2] += w * b[0]; o[4 * i + 3] += w * b[1];
  }
}

DI void peer_expert_wave(const Params& p, int row) {
  const int lane = __builtin_amdgcn_mbcnt_hi(-1, __builtin_amdgcn_mbcnt_lo(-1, 0));
  float xf[16];
  {
    const uint4 x0 = *(const uint4*)&G(p.A2)[(size_t)row * 1024 + lane * 16];
    const uint4 x1 = *(const uint4*)&G(p.A2)[(size_t)row * 1024 + lane * 16 + 8];
    xf[0] = bflo(x0.x); xf[1] = bfhi(x0.x); xf[2] = bflo(x0.y); xf[3] = bfhi(x0.y);
    xf[4] = bflo(x0.z); xf[5] = bfhi(x0.z); xf[6] = bflo(x0.w); xf[7] = bfhi(x0.w);
    xf[8] = bflo(x1.x); xf[9] = bfhi(x1.x); xf[10] = bflo(x1.y); xf[11] = bfhi(x1.y);
    xf[12] = bflo(x1.z); xf[13] = bfhi(x1.z); xf[14] = bflo(x1.w); xf[15] = bfhi(x1.w);
  }
  const float r2 = rsqrtf(p.ssq2[row] * (1.f / 1024.f) + EPS);
  const unsigned char AS1* EU8 = (const unsigned char AS1*)p.E8;
  const unsigned char AS1* EV8 = (const unsigned char AS1*)p.E8 + (size_t)16384 * 1024;
  float out[16];
#pragma unroll
  for (int i = 0; i < 16; ++i) out[i] = 0.f;
#pragma unroll 1
  for (int bt = 0; bt < 2; ++bt) {
    const int eidv = G(p.eid)[(size_t)row * 128 + bt * 64 + lane];
    const float gv = G(p.gate)[(size_t)row * 128 + bt * 64 + lane];
    const float rsu = G(p.rs)[eidv], rsv = G(p.rs)[16384 + eidv];
    float part[64];
#pragma unroll
    for (int e = 0; e < 64; ++e) {
      const int id = __builtin_amdgcn_readlane(eidv, e);
      const u32x4 u = *(const u32x4 AS1*)(EU8 + (size_t)id * 1024 + lane * 16);
      part[e] = dot16_fp8(u, xf, 0.f);
    }
#pragma unroll
    for (int off = 32; off > 0; off >>= 1) {
      const bool up = (lane & off) != 0;
#pragma unroll
      for (int i = 0; i < off; ++i) {
        const float a = part[i], bq = part[i + off];
        const float send = up ? a : bq, keep = up ? bq : a;
        part[i] = keep + __shfl_xor(send, off);
      }
    }
    const float wv = gv * geluf(part[0] * r2 * rsu) * rsv;
#pragma unroll 8
    for (int e = 0; e < 64; ++e) {
      const int id = __builtin_amdgcn_readlane(eidv, e);
      const float we = __int_as_float(__builtin_amdgcn_readlane(__float_as_int(wv), e));
      const u32x4 v = *(const u32x4 AS1*)(EV8 + (size_t)id * 1024 + lane * 16);
      axpy16_fp8(out, we, v);
    }
  }
  const float* hr = G(p.h2) + (size_t)row * 1024 + lane * 16;
  float hv[16];
  float ss = 0.f;
#pragma unroll
  for (int i = 0; i < 4; ++i) {
    float4 t = *(const float4*)&hr[i * 4];
    hv[4 * i] = t.x + out[4 * i]; hv[4 * i + 1] = t.y + out[4 * i + 1]; hv[4 * i + 2] = t.z + out[4 * i + 2]; hv[4 * i + 3] = t.w + out[4 * i + 3];
    ss += hv[4 * i] * hv[4 * i] + hv[4 * i + 1] * hv[4 * i + 1] + hv[4 * i + 2] * hv[4 * i + 2] + hv[4 * i + 3] * hv[4 * i + 3];
  }
  ss = wave_sum(ss);
  const float rsn = rsqrtf(ss * (1.f / 1024.f) + EPS);
  float* y = ((row < MP) ? (G(p.out) + O_YP + (size_t)row * 1024) : (G(p.out) + O_YS + (size_t)(row - MP) * 1024)) + lane * 16;
#pragma unroll
  for (int i = 0; i < 4; ++i) {
    float4 g4 = *(const float4*)&p.g_final[lane * 16 + i * 4];
    *(float4*)&y[i * 4] = make_float4(hv[4 * i] * rsn * g4.x, hv[4 * i + 1] * rsn * g4.y, hv[4 * i + 2] * rsn * g4.z, hv[4 * i + 3] * rsn * g4.w);
  }
}

DI void peer_u_wave(const Params& p, int row, float* wl  ) {
  const int lane = __builtin_amdgcn_mbcnt_hi(-1, __builtin_amdgcn_mbcnt_lo(-1, 0));
  float xf[16];
  {
    const u32x4 x0 = *(const u32x4 AS1*)((const u16 AS1*)p.A2 + (size_t)row * 1024 + lane * 16);
    const u32x4 x1 = *(const u32x4 AS1*)((const u16 AS1*)p.A2 + (size_t)row * 1024 + lane * 16 + 8);
    xf[0] = bflo(x0[0]); xf[1] = bfhi(x0[0]); xf[2] = bflo(x0[1]); xf[3] = bfhi(x0[1]);
    xf[4] = bflo(x0[2]); xf[5] = bfhi(x0[2]); xf[6] = bflo(x0[3]); xf[7] = bfhi(x0[3]);
    xf[8] = bflo(x1[0]); xf[9] = bfhi(x1[0]); xf[10] = bflo(x1[1]); xf[11] = bfhi(x1[1]);
    xf[12] = bflo(x1[2]); xf[13] = bfhi(x1[2]); xf[14] = bflo(x1[3]); xf[15] = bfhi(x1[3]);
  }
  const float r2 = rsqrtf(((const float AS1*)p.ssq2)[row] * (1.f / 1024.f) + EPS);
  const unsigned char AS1* EU8 = (const unsigned char AS1*)p.E8;
  const float AS1* rsp = (const float AS1*)p.rs;
#pragma unroll 1
  for (int bt = 0; bt < 2; ++bt) {
    const int eidv = ((const int AS1*)p.eid)[(size_t)row * 128 + bt * 64 + lane];
    const float gv = ((const float AS1*)p.gate)[(size_t)row * 128 + bt * 64 + lane];
    const float rsu = rsp[eidv], rsv = rsp[16384 + eidv];
    float part[64];
#pragma unroll
    for (int e = 0; e < 64; ++e) {
      const int id = __builtin_amdgcn_readlane(eidv, e);
      const u32x4 u = *(const u32x4 AS1*)(EU8 + (size_t)id * 1024 + lane * 16);
      part[e] = dot16_fp8(u, xf, 0.f);
    }
#pragma unroll
    for (int off = 32; off > 0; off >>= 1) {
      const bool up = (lane & off) != 0;
#pragma unroll
      for (int i = 0; i < off; ++i) {
        const float a = part[i], bq = part[i + off];
        const float send = up ? a : bq, keep = up ? bq : a;
        part[i] = keep + __shfl_xor(send, off);
      }
    }
    wl[bt * 64 + lane] = gv * geluf(part[0] * r2 * rsu) * rsv;
  }
}

DI void peer_v_group(const Params& p, int gw, int nw, int g, const float* wlw  ) {
  const int lane = __builtin_amdgcn_mbcnt_hi(-1, __builtin_amdgcn_mbcnt_lo(-1, 0));
  const unsigned char AS1* EV8 = (const unsigned char AS1*)p.E8 + (size_t)16384 * 1024;
  float out[4][16];
  int e0[4], e1[4];
  float w0[4], w1[4];
  bool valid[4];
#pragma unroll
  for (int ts = 0; ts < 4; ++ts) {
    const int k = g * 4 + ts;
    const int row = gw + k * nw;
    valid[ts] = row < MT;
#pragma unroll
    for (int i = 0; i < 16; ++i) out[ts][i] = 0.f;
    e0[ts] = 0x7fffffff; e1[ts] = 0x7fffffff; w0[ts] = 0.f; w1[ts] = 0.f;
    if (valid[ts]) {
      e0[ts] = ((const int AS1*)p.eid)[(size_t)row * 128 + lane];
      e1[ts] = ((const int AS1*)p.eid)[(size_t)row * 128 + 64 + lane];
      w0[ts] = wlw[k * 128 + lane];
      w1[ts] = wlw[k * 128 + 64 + lane];
    }
  }
#pragma unroll 1
  for (int r = 0; r < 8; ++r) {
#pragma unroll
    for (int ts = 0; ts < 4; ++ts) {
      unsigned long long m0 = __ballot((e0[ts] >> 11) == r);
      unsigned long long m1 = __ballot((e1[ts] >> 11) == r);
      while ((m0 | m1) != 0ull) {
        u32x4 v[8];
        float we[8];
#pragma unroll
        for (int k = 0; k < 8; ++k) {
          we[k] = 0.f;
          v[k] = (u32x4){0u, 0u, 0u, 0u};
          if ((m0 | m1) != 0ull) {
            int l, id;
            if (m0 != 0ull) {
              l = __builtin_ctzll(m0); m0 &= m0 - 1ull;
              id = __builtin_amdgcn_readlane(e0[ts], l);
              we[k] = __int_as_float(__builtin_amdgcn_readlane(__float_as_int(w0[ts]), l));
            } else {
              l = __builtin_ctzll(m1); m1 &= m1 - 1ull;
              id = __builtin_amdgcn_readlane(e1[ts], l);
              we[k] = __int_as_float(__builtin_amdgcn_readlane(__float_as_int(w1[ts]), l));
            }
            v[k] = *(const u32x4 AS1*)(EV8 + (size_t)id * 1024 + lane * 16);
          }
        }
#pragma unroll
        for (int k = 0; k < 8; ++k) axpy16_fp8(out[ts], we[k], v[k]);
      }
    }
  }
#pragma unroll
  for (int ts = 0; ts < 4; ++ts) {
    if (!valid[ts]) continue;
    const int row = gw + (g * 4 + ts) * nw;
    const float AS1* hr = (const float AS1*)p.h2 + (size_t)row * 1024 + lane * 16;
    float hv[16];
    float ss = 0.f;
#pragma unroll
    for (int i = 0; i < 4; ++i) {
      f32x4 t = *(const f32x4 AS1*)&hr[i * 4];
      hv[4 * i] = t[0] + out[ts][4 * i]; hv[4 * i + 1] = t[1] + out[ts][4 * i + 1]; hv[4 * i + 2] = t[2] + out[ts][4 * i + 2]; hv[4 * i + 3] = t[3] + out[ts][4 * i + 3];
      ss += hv[4 * i] * hv[4 * i] + hv[4 * i + 1] * hv[4 * i + 1] + hv[4 * i + 2] * hv[4 * i + 2] + hv[4 * i + 3] * hv[4 * i + 3];
    }
    ss = wave_sum(ss);
    const float rsn = rsqrtf(ss * (1.f / 1024.f) + EPS);
    float AS1* y = ((row < MP) ? ((float AS1*)p.out + O_YP + (size_t)row * 1024) : ((float AS1*)p.out + O_YS + (size_t)(row - MP) * 1024)) + lane * 16;
#pragma unroll
    for (int i = 0; i < 4; ++i) {
      f32x4 g4 = *(const f32x4 AS1*)&((const float AS1*)p.g_final)[lane * 16 + i * 4];
      f32x4 o;
      o[0] = hv[4 * i] * rsn * g4[0]; o[1] = hv[4 * i + 1] * rsn * g4[1]; o[2] = hv[4 * i + 2] * rsn * g4[2]; o[3] = hv[4 * i + 3] * rsn * g4[3];
      *(f32x4 AS1*)&y[i * 4] = o;
    }
  }
}

__global__ void __launch_bounds__(256, 2) mega(Params pk) {
  __shared__ __attribute__((aligned(16))) char smem[65536];
  __shared__ Params sp;
  cg::grid_group grid = cg::this_grid();
  const int w = threadIdx.x >> 6;
  if (threadIdx.x == 0) sp = pk;
  __syncthreads();
  const Params& p = sp;
#ifndef DBL
#define DBL -1
#endif
#define REP(ph) for (int rp_ = 0; rp_ < ((DBL == (ph)) ? 2 : 1); ++rp_)
  REP(0) { phase0(p, smem); if (DBL == 0) grid.sync(); }
  grid.sync();
  REP(1) {
    int tm, tn;
    for (int it = 0; it * (int)gridDim.x < 257 * 34; ++it)
      if (xcd_tile(it, 257, 34, tm, tn)) gemm_tile<0, 1024>(p, p.A0, 1024, p.WtIn, tm, tn, smem);
    for (int u = blockIdx.x; u < 128; u += gridDim.x) gemm_tile<1, 1024>(p, p.Amem, 1024, p.WtMkv, u / 16, u % 16, smem);
  }
  grid.sync();
  REP(2) { phase2(p, smem); if (DBL == 2) grid.sync(); }
  grid.sync();
  REP(3) { phase3(p, smem); if (DBL == 3) grid.sync(); }
  grid.sync();
  REP(4) phase4(p);
  grid.sync();
  { int tm, tn; for (int it = 0; it * (int)gridDim.x < 257 * 8; ++it) if (xcd_tile(it, 257, 8, tm, tn)) gemm_tile<2, 768>(p, p.Amix, 768, p.WtOut, tm, tn, smem); }
  grid.sync();
  REP(6) { int tm, tn; for (int it = 0; it * (int)gridDim.x < 257 * 8; ++it) if (xcd_tile(it, 257, 8, tm, tn)) gemm_tile<3, 1024>(p, p.A1, 1024, p.WtMq, tm, tn, smem); }
  sample_state_copy(p);
  grid.sync();
  REP(7) phase7(p, smem);
  grid.sync();
  { int tm, tn; for (int it = 0; it * (int)gridDim.x < 257 * 8; ++it) if (xcd_tile(it, 257, 8, tm, tn)) gemm_tile<4, 1024>(p, p.attn, 1024, p.WtMo, tm, tn, smem); }
  grid.sync();
  REP(9) { int tm, tn; for (int it = 0; it * (int)gridDim.x < 257 * 16; ++it) if (xcd_tile(it, 257, 16, tm, tn)) gemm_tile<5, 1024>(p, p.A2, 1024, p.WtPq, tm, tn, smem); }
  grid.sync();
  REP(10) {
    unsigned* lds = (unsigned*)smem + w * 512;
    for (int it = blockIdx.x * 4 + w; it < 2056 * 8; it += gridDim.x * 4) peer_topk_wave(p, it, lds);
  }
  grid.sync();
  REP(11) {
    const int gw = blockIdx.x * 4 + w, nw = gridDim.x * 4;
    float* wlw = (float*)smem + w * (17 * 128);
    __syncthreads();
    for (int k = 0; gw + k * nw < MT && k < 17; ++k) peer_u_wave(p, gw + k * nw, wlw + k * 128);
    __builtin_amdgcn_s_waitcnt(0xc07f);
    __builtin_amdgcn_wave_barrier();
    for (int g = 0; (g * 4) * nw + gw < MT && g < 5; ++g) peer_v_group(p, gw, nw, g, wlw);
  }
}

extern "C" void kernel_launch(void* const* d_in, const int* in_sizes, int n_in, void* d_out, int out_size, void* d_ws, size_t ws_size,
                              hipStream_t stream) {
  static int grid_blocks = 0;
  if (!grid_blocks) {
    int dev = 0, cus = 0, per_cu = 0;
    (void)hipGetDevice(&dev);
    (void)hipDeviceGetAttribute(&cus, hipDeviceAttributeMultiprocessorCount, dev);
    (void)hipOccupancyMaxActiveBlocksPerMultiprocessor(&per_cu, mega, 256, 0);
    if (per_cu > 2) per_cu = 2;
    if (per_cu < 1) per_cu = 1;
    grid_blocks = cus * per_cu;
  }
  Params p{};
  const float* const* in = (const float* const*)d_in;
  p.x_prompt = in[0]; p.x_sample = in[1]; p.state_delta = in[2]; p.state_conv = in[3]; p.cw1 = in[4]; p.cw2 = in[5]; p.cw3 = in[6];
  p.cache_mem = in[7]; p.mem_prompt = in[8]; p.g_mix = in[9]; p.w_in = in[10]; p.conv_w = in[11]; p.a_log = in[12]; p.dt_bias = in[13];
  p.g_onorm = in[14]; p.w_out = in[15]; p.g_memq = in[16]; p.g_memkv = in[17]; p.w_mq = in[18]; p.w_mkv = in[19]; p.w_mo = in[20];
  p.g_ffn = in[21]; p.w_pq = in[22]; p.sub_keys = in[23]; p.expert_u = in[24]; p.expert_v = in[25]; p.g_final = in[26];
  p.out = (float*)d_out;
  char* ws = (char*)d_ws;
  size_t off = 0;
  auto take = [&](size_t bytes) { char* r = ws + off; off += (bytes + 255) & ~(size_t)255; return r; };
  p.WtIn = (u16*)take((size_t)NP * 1024 * 2);
  p.WtOut = (u16*)take((size_t)1024 * 768 * 2);
  p.WtMq = (u16*)take((size_t)1024 * 1024 * 2);
  p.WtMkv = (u16*)take((size_t)2048 * 1024 * 2);
  p.WtMo = (u16*)take((size_t)1024 * 1024 * 2);
  p.WtPq = (u16*)take((size_t)2048 * 1024 * 2);
  p.subkb = (u16*)take((size_t)262144 * 2);
  p.E8 = (unsigned char*)take((size_t)32768 * 1024);
  p.rs = (float*)take((size_t)32768 * 4);
  p.Amem = (u16*)take((size_t)1024 * 1024 * 2);
  p.gb = (float*)take((size_t)MT * 8 * 4);
  p.ssq1 = (float*)take((size_t)MT * 4);
  p.ssq2 = (float*)take((size_t)MT * 4);
  p.dl = (float*)take(2048 * 4);
  p.Kb = (u16*)take((size_t)16 * 65536 * 2);
  p.VTf = (u16*)take((size_t)16 * 65536 * 2);
  char* regA = take((size_t)MT * NP * 2);
  char* regB = take((size_t)2048 * DN_ITEM);
  p.proj = (u16*)regA;
  p.h1 = (float*)regA;
  p.h2 = (float*)(regA + (size_t)MT * 1024 * 4);
  p.pq = (u16*)regA;
  p.dnops = regB;
  p.A0 = (u16*)regB;
  p.A1 = (u16*)regB;
  p.qb = (u16*)(regB + (size_t)MT * 1024 * 2);
  p.attn = (u16*)regB;
  p.A2 = (u16*)(regB + (size_t)MT * 1024 * 2);
  p.eid = (int*)regB;
  p.gate = (float*)(regB + (size_t)MT * 128 * 4);
  char* ob = (char*)d_out;
  p.vT = (u16*)ob;
  p.osw = (u16*)(ob + (size_t)3 * MP * 256 * 2);
  p.lse = (float*)(ob + (size_t)3 * MP * 256 * 2 + (size_t)3 * MT * 256 * 2);
  char* sb = ob + O_SW3 * 4;
  p.odn = (u16*)sb;
  p.Amix = (u16*)(sb + (size_t)MT * 512 * 2);
  if (off > ws_size) { fprintf(stderr, "workspace too small: need %zu have %zu\n", off, ws_size); return; }
  void* args[] = {&p};
  hipError_t e = hipLaunchCooperativeKernel((void*)mega, dim3(grid_blocks), dim3(256), args, 0, stream);
  if (e != hipSuccess) fprintf(stderr, "coop launch failed: %s (grid %d)\n", hipGetErrorString(e), grid_blocks);
}
```

```cpp
#include <hip/hip_runtime.h>
#include <hip/hip_cooperative_groups.h>
#include <cstdio>
namespace cg = cooperative_groups;

typedef unsigned short u16;
typedef __attribute__((ext_vector_type(8))) short bf16x8;
typedef __attribute__((ext_vector_type(4))) float f32x4;
typedef __attribute__((ext_vector_type(2))) __bf16 bf2_t;

#define DI __device__ __forceinline__
#define MFMA(a, b, c) __builtin_amdgcn_mfma_f32_16x16x32_bf16((a), (b), (c), 0, 0, 0)

constexpr int MP = 32768, MS = 128, MT = 32896;
constexpr int NP = 4352;
constexpr int SEQ = 8192;
constexpr float EPS = 1e-6f;
constexpr size_t DN_ITEM = 73728;

constexpr size_t O_YP = 0, O_YS = 33554432, O_PDELTA = 33685504, O_PCONV = 33947648, O_PW1 = 33966080,
                 O_PW2 = 34228224, O_PW3 = 35276800, O_PMEM = 39471104, O_SDELTA = 41568256, O_SCONV = 43665408,
                 O_SW1 = 43812864, O_SW2 = 45910016, O_SW3 = 54298624;

struct Params {
  const float *x_prompt, *x_sample, *state_delta, *state_conv, *cw1, *cw2, *cw3, *cache_mem, *mem_prompt;
  const float *g_mix, *w_in, *conv_w, *a_log, *dt_bias, *g_onorm, *w_out, *g_memq, *g_memkv, *w_mq, *w_mkv, *w_mo;
  const float *g_ffn, *w_pq, *sub_keys, *expert_u, *expert_v, *g_final;
  float* out;
  u16 *WtIn, *WtOut, *WtMq, *WtMkv, *WtMo, *WtPq, *subkb, *Amem;
  unsigned char* E8;
  float* rs;
  float *gb, *ssq1, *ssq2, *dl;
  u16 *Kb, *VTf;
  u16* proj;
  float *h1, *h2;
  u16* pq;
  char* dnops;
  u16 *A0, *A1, *qb, *attn, *A2;
  int* eid;
  float* gate;
  u16 *vT, *osw, *odn, *Amix;
  float* lse;
};

#define AS1 __attribute__((address_space(1)))
template <typename T> DI T* G(T* q) { return q; }
typedef const bf16x8 AS1* gb8p;
typedef const u16 AS1* gu16p;
typedef __attribute__((ext_vector_type(4))) unsigned u32x4;
DI u16 f2bf(float x) { unsigned u = __float_as_uint(x); u += 0x7fffu + ((u >> 16) & 1u); return (u16)(u >> 16); }
DI float bf2f(u16 h) { return __uint_as_float(((unsigned)h) << 16); }
DI unsigned pack2(float a, float b) { return (unsigned)f2bf(a) | ((unsigned)f2bf(b) << 16); }
DI float bflo(unsigned d) { return __uint_as_float(d << 16); }
DI float bfhi(unsigned d) { return __uint_as_float(d & 0xffff0000u); }
DI bf16x8 pack8(f32x4 a, f32x4 b) {
  uint4 r; r.x = pack2(a[0], a[1]); r.y = pack2(a[2], a[3]); r.z = pack2(b[0], b[1]); r.w = pack2(b[2], b[3]);
  return __builtin_bit_cast(bf16x8, r);
}
DI float wave_sum(float v) {
#pragma unroll
  for (int o = 32; o > 0; o >>= 1) v += __shfl_xor(v, o);
  return v;
}
DI float wave_max(float v) {
#pragma unroll
  for (int o = 32; o > 0; o >>= 1) v = fmaxf(v, __shfl_xor(v, o));
  return v;
}
DI float siluf(float x) { return x / (1.f + __expf(-x)); }
DI float geluf(float x) { return 0.5f * x * (1.f + tanhf(0.7978845608028654f * (x + 0.044715f * x * x * x))); }
DI int permk(int kg, int j) { return (j < 4) ? (kg * 4 + j) : (16 + kg * 4 + (j - 4)); }
DI void cvt8(const float* __restrict__ s, u16* __restrict__ d) {
  float4 a = *(const float4*)s, b = *(const float4*)(s + 4);
  uint4 r; r.x = pack2(a.x, a.y); r.y = pack2(a.z, a.w); r.z = pack2(b.x, b.y); r.w = pack2(b.z, b.w);
  *(uint4*)d = r;
}
DI unsigned ordf(float f) { unsigned u = __float_as_uint(f); return (u & 0x80000000u) ? ~u : (u | 0x80000000u); }
DI float unordf(unsigned k) { unsigned u = (k & 0x80000000u) ? (k & 0x7fffffffu) : ~k; return __uint_as_float(u); }
DI unsigned umax(unsigned a, unsigned b) { return a > b ? a : b; }
template <typename T> DI T sel4(int L, T a, T b, T c, T d) { return L == 0 ? a : (L == 1 ? b : (L == 2 ? c : d)); }

#define AS3 __attribute__((address_space(3)))
template <int MODE, int K>
DI void gemm_tile(const Params& p, const u16* __restrict__ A, int lda, const u16* __restrict__ Bt, int tm, int tn,
                          char* smem) {
  const int tid = threadIdx.x, lane = tid & 63, w = tid >> 6;
  const int wm = w >> 1, wn = w & 1, r = lane & 15, kg = lane >> 4;
  f32x4 acc[8][4];
#pragma unroll
  for (int i = 0; i < 8; ++i)
#pragma unroll
    for (int j = 0; j < 4; ++j) acc[i][j] = (f32x4){0.f, 0.f, 0.f, 0.f};
  const int lr = lane >> 2, lkg = (lane & 3) ^ (lane >> 4);
  gu16p gA[4], gB[2];
#pragma unroll
  for (int i = 0; i < 4; ++i) gA[i] = (gu16p)A + (size_t)(tm * 256 + (w * 4 + i) * 16 + lr) * lda + lkg * 8;
#pragma unroll
  for (int i = 0; i < 2; ++i) gB[i] = (gu16p)Bt + (size_t)(tn * 128 + (w * 2 + i) * 16 + lr) * K + lkg * 8;
  const int frag_off = r * 64 + ((kg ^ (r >> 2)) * 16);
  __syncthreads();
#pragma unroll
  for (int i = 0; i < 4; ++i)
    __builtin_amdgcn_global_load_lds((const unsigned AS1*)(gA[i]), (unsigned AS3*)(smem + (w * 4 + i) * 1024), 16, 0, 0);
#pragma unroll
  for (int i = 0; i < 2; ++i)
    __builtin_amdgcn_global_load_lds((const unsigned AS1*)(gB[i]), (unsigned AS3*)(smem + 16384 + (w * 2 + i) * 1024), 16, 0, 0);
#pragma unroll 2
  for (int k = 0; k < K / 32; ++k) {
    __syncthreads();
    if (k + 1 < K / 32) {
      char* st = smem + ((k + 1) & 1) * 24576;
#pragma unroll
      for (int i = 0; i < 4; ++i)
        __builtin_amdgcn_global_load_lds((const unsigned AS1*)(gA[i] + (k + 1) * 32), (unsigned AS3*)(st + (w * 4 + i) * 1024), 16, 0, 0);
#pragma unroll
      for (int i = 0; i < 2; ++i)
        __builtin_amdgcn_global_load_lds((const unsigned AS1*)(gB[i] + (k + 1) * 32), (unsigned AS3*)(st + 16384 + (w * 2 + i) * 1024), 16, 0, 0);
    }
    const char* sa = smem + (k & 1) * 24576;
    const char* sb = sa + 16384;
    bf16x8 af[8], bfr[4];
#pragma unroll
    for (int i = 0; i < 8; ++i) af[i] = *(const bf16x8*)(sa + (wm * 8 + i) * 1024 + frag_off);
#pragma unroll
    for (int i = 0; i < 4; ++i) bfr[i] = *(const bf16x8*)(sb + (wn * 4 + i) * 1024 + frag_off);
#pragma unroll
    for (int mt = 0; mt < 8; ++mt)
#pragma unroll
      for (int nt = 0; nt < 4; ++nt) acc[mt][nt] = MFMA(bfr[nt], af[mt], acc[mt][nt]);
  }
#pragma unroll
  for (int mt = 0; mt < 8; ++mt) {
    const int row = tm * 256 + wm * 128 + mt * 16 + r;
    if (tm * 256 + wm * 128 + mt * 16 >= ((MODE == 1) ? 1024 : MT)) continue;
    float rs = 1.f, ssq = 0.f;
    if (MODE == 3) rs = rsqrtf(p.ssq1[row] * (1.f / 1024.f) + EPS);
    if (MODE == 5) rs = rsqrtf(p.ssq2[row] * (1.f / 1024.f) + EPS);
#pragma unroll
    for (int nt = 0; nt < 4; ++nt) {
      const int col = tn * 128 + wn * 64 + nt * 16 + kg * 4;
      f32x4 v = acc[mt][nt];
      if (MODE == 0) {
        uint2 o; o.x = pack2(v[0], v[1]); o.y = pack2(v[2], v[3]);
        *(uint2*)&p.proj[(size_t)row * NP + col] = o;
      } else if (MODE == 1) {
        *(float4*)&p.out[O_PMEM + (size_t)row * 2048 + col] = make_float4(v[0], v[1], v[2], v[3]);
      } else if (MODE == 2 || MODE == 4) {
        float4 rsd;
        const float* gn;
        if (MODE == 2) {
          rsd = (row < MP) ? *(const float4*)&p.x_prompt[(size_t)row * 1024 + col] : *(const float4*)&p.x_sample[(size_t)(row - MP) * 1024 + col];
          gn = p.g_memq;
        } else {
          rsd = *(const float4*)&p.h1[(size_t)row * 1024 + col];
          gn = p.g_ffn;
        }
        float4 h = make_float4(rsd.x + v[0], rsd.y + v[1], rsd.z + v[2], rsd.w + v[3]);
        float4 g4 = *(const float4*)&gn[col];
        ssq += h.x * h.x + h.y * h.y + h.z * h.z + h.w * h.w;
        uint2 o; o.x = pack2(h.x * g4.x, h.y * g4.y); o.y = pack2(h.z * g4.z, h.w * g4.w);
        if (MODE == 2) { *(float4*)&p.h1[(size_t)row * 1024 + col] = h; *(uint2*)&p.A1[(size_t)row * 1024 + col] = o; }
        else { *(float4*)&p.h2[(size_t)row * 1024 + col] = h; *(uint2*)&p.A2[(size_t)row * 1024 + col] = o; }
      } else if (MODE == 3) {
        uint2 o; o.x = pack2(v[0] * rs, v[1] * rs); o.y = pack2(v[2] * rs, v[3] * rs);
        *(uint2*)&p.qb[(size_t)row * 1024 + col] = o;
      } else {
        uint2 o; o.x = pack2(v[0] * rs, v[1] * rs); o.y = pack2(v[2] * rs, v[3] * rs);
        *(uint2*)&p.pq[(size_t)row * 2048 + col] = o;
      }
    }
    if (MODE == 2 || MODE == 4) {
      ssq += __shfl_xor(ssq, 16);
      ssq += __shfl_xor(ssq, 32);
      if (kg == 0) atomicAdd((MODE == 2) ? &p.ssq1[row] : &p.ssq2[row], ssq);
    }
  }
}

template <int MODE, int K>
DI void gemm_tile128(const Params& p, const u16* __restrict__ A, int lda, const u16* __restrict__ Bt, int tm, int tn,
                          char* smem) {
  const int tid = threadIdx.x, lane = tid & 63, w = tid >> 6;
  const int wm = w >> 1, wn = w & 1, r = lane & 15, kg = lane >> 4;
  f32x4 acc[4][4];
#pragma unroll
  for (int i = 0; i < 4; ++i)
#pragma unroll
    for (int j = 0; j < 4; ++j) acc[i][j] = (f32x4){0.f, 0.f, 0.f, 0.f};
  const int lr = lane >> 2, lkg = (lane & 3) ^ (lane >> 4);
  gu16p gA[4], gB[4];
#pragma unroll
  for (int i = 0; i < 4; ++i) {
    const int sub = w * 4 + i, mt = sub >> 1, ks = sub & 1;
    gA[i] = (gu16p)A + (size_t)(tm * 128 + mt * 16 + lr) * lda + ks * 32 + lkg * 8;
    gB[i] = (gu16p)Bt + (size_t)(tn * 128 + mt * 16 + lr) * K + ks * 32 + lkg * 8;
  }
  const int frag_off = r * 64 + ((kg ^ (r >> 2)) * 16);
  __syncthreads();
#pragma unroll
  for (int i = 0; i < 4; ++i) {
    __builtin_amdgcn_global_load_lds((const unsigned AS1*)(gA[i]), (unsigned AS3*)(smem + (w * 4 + i) * 1024), 16, 0, 0);
    __builtin_amdgcn_global_load_lds((const unsigned AS1*)(gB[i]), (unsigned AS3*)(smem + 16384 + (w * 4 + i) * 1024), 16, 0, 0);
  }
#pragma unroll 2
  for (int k = 0; k < K / 64; ++k) {
    __syncthreads();
    if (k + 1 < K / 64) {
      char* st = smem + ((k + 1) & 1) * 32768;
#pragma unroll
      for (int i = 0; i < 4; ++i) {
        __builtin_amdgcn_global_load_lds((const unsigned AS1*)(gA[i] + (k + 1) * 64), (unsigned AS3*)(st + (w * 4 + i) * 1024), 16, 0, 0);
        __builtin_amdgcn_global_load_lds((const unsigned AS1*)(gB[i] + (k + 1) * 64), (unsigned AS3*)(st + 16384 + (w * 4 + i) * 1024), 16, 0, 0);
      }
    }
    const char* sa = smem + (k & 1) * 32768;
    const char* sb = sa + 16384;
#pragma unroll
    for (int ks = 0; ks < 2; ++ks) {
      bf16x8 af[4], bfr[4];
#pragma unroll
      for (int i = 0; i < 4; ++i) {
        af[i] = *(const bf16x8*)(sa + ((wm * 4 + i) * 2 + ks) * 1024 + frag_off);
        bfr[i] = *(const bf16x8*)(sb + ((wn * 4 + i) * 2 + ks) * 1024 + frag_off);
      }
#pragma unroll
      for (int mt = 0; mt < 4; ++mt)
#pragma unroll
        for (int nt = 0; nt < 4; ++nt) acc[mt][nt] = MFMA(bfr[nt], af[mt], acc[mt][nt]);
    }
  }
#pragma unroll
  for (int mt = 0; mt < 4; ++mt) {
    const int row = tm * 128 + wm * 64 + mt * 16 + r;
    float rs = 1.f, ssq = 0.f;
    if (MODE == 3) rs = rsqrtf(p.ssq1[row] * (1.f / 1024.f) + EPS);
    if (MODE == 5) rs = rsqrtf(p.ssq2[row] * (1.f / 1024.f) + EPS);
#pragma unroll
    for (int nt = 0; nt < 4; ++nt) {
      const int col = tn * 128 + wn * 64 + nt * 16 + kg * 4;
      f32x4 v = acc[mt][nt];
      if (MODE == 0) {
        uint2 o; o.x = pack2(v[0], v[1]); o.y = pack2(v[2], v[3]);
        *(uint2*)&p.proj[(size_t)row * NP + col] = o;
      } else if (MODE == 1) {
        *(float4*)&p.out[O_PMEM + (size_t)row * 2048 + col] = make_float4(v[0], v[1], v[2], v[3]);
      } else if (MODE == 2 || MODE == 4) {
        float4 rsd;
        const float* gn;
        if (MODE == 2) {
          rsd = (row < MP) ? *(const float4*)&p.x_prompt[(size_t)row * 1024 + col] : *(const float4*)&p.x_sample[(size_t)(row - MP) * 1024 + col];
          gn = p.g_memq;
        } else {
          rsd = *(const float4*)&p.h1[(size_t)row * 1024 + col];
          gn = p.g_ffn;
        }
        float4 h = make_float4(rsd.x + v[0], rsd.y + v[1], rsd.z + v[2], rsd.w + v[3]);
        float4 g4 = *(const float4*)&gn[col];
        ssq += h.x * h.x + h.y * h.y + h.z * h.z + h.w * h.w;
        uint2 o; o.x = pack2(h.x * g4.x, h.y * g4.y); o.y = pack2(h.z * g4.z, h.w * g4.w);
        if (MODE == 2) { *(float4*)&p.h1[(size_t)row * 1024 + col] = h; *(uint2*)&p.A1[(size_t)row * 1024 + col] = o; }
        else { *(float4*)&p.h2[(size_t)row * 1024 + col] = h; *(uint2*)&p.A2[(size_t)row * 1024 + col] = o; }
      } else if (MODE == 3) {
        uint2 o; o.x = pack2(v[0] * rs, v[1] * rs); o.y = pack2(v[2] * rs, v[3] * rs);
        *(uint2*)&p.qb[(size_t)row * 1024 + col] = o;
      } else {
        uint2 o; o.x = pack2(v[0] * rs, v[1] * rs); o.y = pack2(v[2] * rs, v[3] * rs);
        *(uint2*)&p.pq[(size_t)row * 2048 + col] = o;
      }
    }
    if (MODE == 2 || MODE == 4) {
      ssq += __shfl_xor(ssq, 16);
      ssq += __shfl_xor(ssq, 32);
      if (kg == 0) atomicAdd((MODE == 2) ? &p.ssq1[row] : &p.ssq2[row], ssq);
    }
  }
}

DI bool xcd_tile(int it, int nM, int nN, int& tm, int& tn) {
  const int per = gridDim.x >> 3;
  const int xcd = blockIdx.x & 7, li = blockIdx.x >> 3;
  const int i = (it * 8 + xcd) * per + li;
  if (i >= nM * nN) return false;
  const int panel = i / (8 * nN), within = i - panel * 8 * nN;
  const int rows = (nM - panel * 8) < 8 ? (nM - panel * 8) : 8;
  tn = within / rows;
  tm = panel * 8 + (within - tn * rows);
  return true;
}

DI void tr_tile(const float* __restrict__ W, int ldw, int nsrc0, u16* __restrict__ Wt, int K, int k0, int n0, float* tile) {
  const int tid = threadIdx.x;
  const int n = tid & 63, kq = tid >> 6;
  __syncthreads();
#pragma unroll
  for (int i = 0; i < 16; ++i) { int kk = kq + 4 * i; tile[kk * 65 + n] = W[(size_t)(k0 + kk) * ldw + nsrc0 + n]; }
  __syncthreads();
  const int nn = tid >> 2, ks = (tid & 3) * 16;
  unsigned o[8];
#pragma unroll
  for (int i = 0; i < 8; ++i) o[i] = pack2(tile[(ks + 2 * i) * 65 + nn], tile[(ks + 2 * i + 1) * 65 + nn]);
  u16* d = Wt + (size_t)(n0 + nn) * K + k0 + ks;
  *(uint4*)d = make_uint4(o[0], o[1], o[2], o[3]);
  *(uint4*)(d + 8) = make_uint4(o[4], o[5], o[6], o[7]);
}

DI void phase0(const Params& p, char* smem) {
  const int tid = threadIdx.x, lane = tid & 63, w = tid >> 6;
  const size_t gtid = (size_t)blockIdx.x * 256 + tid, gsz = (size_t)gridDim.x * 256;
  {
    const float* eu = p.expert_u;
    const float* ev = p.expert_v;
    unsigned char* e8 = p.E8;
    float* rsp = p.rs;
    const int sub = lane & 15, rq = lane >> 4;
    for (int er0 = (blockIdx.x * 4 + w) * 4; er0 < 32768; er0 += gridDim.x * 16) {
      const int er = er0 + rq;
      const float* src = (er < 16384) ? (eu + (size_t)er * 1024) : (ev + (size_t)(er - 16384) * 1024);
      float4 v[16];
      float am = 0.f;
#pragma unroll
      for (int i = 0; i < 16; ++i) {
        v[i] = *(const float4*)&src[(i >> 2) * 256 + sub * 16 + (i & 3) * 4];
        am = fmaxf(am, fmaxf(fmaxf(fabsf(v[i].x), fabsf(v[i].y)), fmaxf(fabsf(v[i].z), fabsf(v[i].w))));
      }
      am = fmaxf(am, __shfl_xor(am, 1)); am = fmaxf(am, __shfl_xor(am, 2));
      am = fmaxf(am, __shfl_xor(am, 4)); am = fmaxf(am, __shfl_xor(am, 8));
      const float sc = (am > 0.f) ? 224.f / am : 1.f;
#pragma unroll
      for (int c = 0; c < 4; ++c) {
        int o[4];
#pragma unroll
        for (int i = 0; i < 4; ++i) {
          const float4 t4 = v[c * 4 + i];
          int t = __builtin_amdgcn_cvt_pk_fp8_f32(t4.x * sc, t4.y * sc, 0, false);
          o[i] = __builtin_amdgcn_cvt_pk_fp8_f32(t4.z * sc, t4.w * sc, t, true);
        }
        *(uint4*)&e8[(size_t)er * 1024 + c * 256 + sub * 16] = make_uint4((unsigned)o[0], (unsigned)o[1], (unsigned)o[2], (unsigned)o[3]);
      }
      if (sub == 0) rsp[er] = (am > 0.f) ? am * (1.f / 224.f) : 1.f;
    }
  }
  for (size_t i = gtid; i < 262144 / 8; i += gsz) cvt8(p.sub_keys + i * 8, p.subkb + i * 8);
  for (size_t i = gtid; i < MT; i += gsz) { p.ssq1[i] = 0.f; p.ssq2[i] = 0.f; }
  float* wl = (float*)smem;
  __syncthreads();
  for (int i = tid; i < 2048; i += 256) {
    const int k = i >> 1, hf = i & 1;
    float4 t = *(const float4*)&p.w_in[(size_t)k * 4360 + 1536 + hf * 4];
    wl[(hf * 4 + 0) * 1024 + k] = t.x; wl[(hf * 4 + 1) * 1024 + k] = t.y; wl[(hf * 4 + 2) * 1024 + k] = t.z; wl[(hf * 4 + 3) * 1024 + k] = t.w;
  }
  __syncthreads();
  const float* xpp = p.x_prompt;
  const float* xsp = p.x_sample;
  const float* mpp = p.mem_prompt;
  const float* gmx = p.g_mix;
  const float* gmk = p.g_memkv;
  u16* a0p = p.A0;
  u16* amp = p.Amem;
  {
    const int sub = lane & 15, rq = lane >> 4;
    for (int row0 = (blockIdx.x * 4 + w) * 4; row0 < MT + 1024; row0 += gridDim.x * 16) {
      const int row = row0 + rq;
      const float* src; const float* g; u16* dst;
      if (row < MP) { src = xpp + (size_t)row * 1024; g = gmx; dst = a0p + (size_t)row * 1024; }
      else if (row < MT) { src = xsp + (size_t)(row - MP) * 1024; g = gmx; dst = a0p + (size_t)row * 1024; }
      else { src = mpp + (size_t)(row - MT) * 1024; g = gmk; dst = amp + (size_t)(row - MT) * 1024; }
      float4 v[16];
      float ss = 0.f;
#pragma unroll
      for (int i = 0; i < 16; ++i) { v[i] = *(const float4*)&src[i * 64 + sub * 4]; ss += v[i].x * v[i].x + v[i].y * v[i].y + v[i].z * v[i].z + v[i].w * v[i].w; }
      ss += __shfl_xor(ss, 1); ss += __shfl_xor(ss, 2); ss += __shfl_xor(ss, 4); ss += __shfl_xor(ss, 8);
      const float rs = rsqrtf(ss * (1.f / 1024.f) + EPS);
      float d8[8] = {0.f, 0.f, 0.f, 0.f, 0.f, 0.f, 0.f, 0.f};
#pragma unroll
      for (int i = 0; i < 16; ++i) {
        float4 g4 = *(const float4*)&g[i * 64 + sub * 4];
        float y[4] = {v[i].x * rs * g4.x, v[i].y * rs * g4.y, v[i].z * rs * g4.z, v[i].w * rs * g4.w};
        uint2 o; o.x = pack2(y[0], y[1]); o.y = pack2(y[2], y[3]);
        *(uint2*)&dst[i * 64 + sub * 4] = o;
        if (row < MT) {
#pragma unroll
          for (int j = 0; j < 8; ++j) {
            float4 wv = *(const float4*)&wl[j * 1024 + i * 64 + sub * 4];
            d8[j] += y[0] * wv.x + y[1] * wv.y + y[2] * wv.z + y[3] * wv.w;
          }
        }
      }
      if (row < MT) {
#pragma unroll
        for (int j = 0; j < 8; ++j) {
          d8[j] += __shfl_xor(d8[j], 1); d8[j] += __shfl_xor(d8[j], 2); d8[j] += __shfl_xor(d8[j], 4); d8[j] += __shfl_xor(d8[j], 8);
        }
        if (sub < 4) {
          float ag = sel4(sub, d8[0], d8[1], d8[2], d8[3]);
          float bg = sel4(sub, d8[4], d8[5], d8[6], d8[7]);
          float xs = ag + p.dt_bias[sub];
          float sp = (xs > 20.f) ? xs : log1pf(expf(xs));
          p.gb[(size_t)row * 8 + sub] = -expf(p.a_log[sub]) * sp;
          p.gb[(size_t)row * 8 + 4 + sub] = 1.f / (1.f + expf(-bg));
        }
      }
    }
  }
  __syncthreads();
  float* tile = (float*)smem;
  for (int j = blockIdx.x; j < 2816; j += gridDim.x) {
    int t = j;
    if (t < 1088) { int kt = t / 68, nt = t % 68; int n0 = nt * 64; tr_tile(p.w_in, 4360, n0 + (n0 >= 1536 ? 8 : 0), p.WtIn, 1024, kt * 64, n0, tile); continue; }
    t -= 1088;
    if (t < 192) { int kt = t / 16, nt = t % 16; tr_tile(p.w_out, 1024, nt * 64, p.WtOut, 768, kt * 64, nt * 64, tile); continue; }
    t -= 192;
    if (t < 256) { int kt = t / 16, nt = t % 16; tr_tile(p.w_mq, 1024, nt * 64, p.WtMq, 1024, kt * 64, nt * 64, tile); continue; }
    t -= 256;
    if (t < 512) { int kt = t / 32, nt = t % 32; tr_tile(p.w_mkv, 2048, nt * 64, p.WtMkv, 1024, kt * 64, nt * 64, tile); continue; }
    t -= 512;
    if (t < 256) { int kt = t / 16, nt = t % 16; tr_tile(p.w_mo, 1024, nt * 64, p.WtMo, 1024, kt * 64, nt * 64, tile); continue; }
    t -= 256;
    { int kt = t / 32, nt = t % 32; tr_tile(p.w_pq, 2048, nt * 64, p.WtPq, 1024, kt * 64, nt * 64, tile); }
  }
}

DI void dn_prep(const Params& p, int item, char* smem) {
  u16* qs = (u16*)smem;
  u16* ksm = qs + 64 * 136;
  float* sL = (float*)(ksm + 64 * 136);
  float* sgc = sL + 64 * 64;
  float* sbeta = sgc + 64;
  u16* sU = (u16*)sL;
  u16* sW = qs;
  const int tid = threadIdx.x, lane = tid & 63, w = tid >> 6, r = lane & 15, kg = lane >> 4;
  const int bh = item >> 7, n = item & 127, b = bh >> 2, h = bh & 3;
  const int t0 = n * 64;
  const size_t rowbase = (size_t)b * SEQ;
  char* ops = p.dnops + (size_t)item * DN_ITEM;
  __syncthreads();
  if (tid < 64) {
    float gv = p.gb[(rowbase + t0 + tid) * 8 + h];
    float bv = p.gb[(rowbase + t0 + tid) * 8 + 4 + h];
#pragma unroll
    for (int o = 1; o < 64; o <<= 1) { float t = __shfl_up(gv, o); if (lane >= o) gv += t; }
    sgc[tid] = gv; sbeta[tid] = bv;
    if (tid == 63) p.dl[item] = __expf(gv);
  }
#pragma unroll 4
  for (int ps = 0; ps < 8; ++ps) {
    const int combo = ps * 16 + (tid >> 4);
    const int tt = combo & 63, part = combo >> 6, sub = tid & 15;
    const int col = part * 512 + h * 128 + sub * 8;
    float y[8] = {0.f, 0.f, 0.f, 0.f, 0.f, 0.f, 0.f, 0.f};
#pragma unroll
    for (int j = 0; j < 4; ++j) {
      const int t = t0 + tt - 3 + j;
      if (t >= 0) {
        uint4 xv = *(const uint4*)&p.proj[(rowbase + t) * NP + col];
        float4 wa = *(const float4*)&p.conv_w[j * 1536 + col], wb = *(const float4*)&p.conv_w[j * 1536 + col + 4];
        y[0] += bflo(xv.x) * wa.x; y[1] += bfhi(xv.x) * wa.y; y[2] += bflo(xv.y) * wa.z; y[3] += bfhi(xv.y) * wa.w;
        y[4] += bflo(xv.z) * wb.x; y[5] += bfhi(xv.z) * wb.y; y[6] += bflo(xv.w) * wb.z; y[7] += bfhi(xv.w) * wb.w;
      }
    }
    float ss = 0.f;
#pragma unroll
    for (int e = 0; e < 8; ++e) { y[e] = siluf(y[e]); ss += y[e] * y[e]; }
    ss += __shfl_xor(ss, 1); ss += __shfl_xor(ss, 2); ss += __shfl_xor(ss, 4); ss += __shfl_xor(ss, 8);
    float sc = rsqrtf(ss + EPS) * (part == 0 ? 0.08838834764831845f : 1.f);
    uint4 o; o.x = pack2(y[0] * sc, y[1] * sc); o.y = pack2(y[2] * sc, y[3] * sc); o.z = pack2(y[4] * sc, y[5] * sc); o.w = pack2(y[6] * sc, y[7] * sc);
    *(uint4*)&((part == 0 ? qs : ksm)[tt * 136 + sub * 8]) = o;
  }
  __syncthreads();
  const float gcl = sgc[63];
  {
    f32x4 aL[4], aA[4];
#pragma unroll
    for (int i = 0; i < 4; ++i) { aL[i] = (f32x4){0.f, 0.f, 0.f, 0.f}; aA[i] = (f32x4){0.f, 0.f, 0.f, 0.f}; }
#pragma unroll
    for (int ks = 0; ks < 4; ++ks) {
      bf16x8 kI = *(const bf16x8*)&ksm[(w * 16 + r) * 136 + ks * 32 + kg * 8];
      bf16x8 qI = *(const bf16x8*)&qs[(w * 16 + r) * 136 + ks * 32 + kg * 8];
#pragma unroll
      for (int nt = 0; nt < 4; ++nt) {
        bf16x8 kJ = *(const bf16x8*)&ksm[(nt * 16 + r) * 136 + ks * 32 + kg * 8];
        aL[nt] = MFMA(kJ, kI, aL[nt]);
        aA[nt] = MFMA(kJ, qI, aA[nt]);
      }
    }
    const int i = w * 16 + r;
    const float gci = sgc[i], bi = sbeta[i];
    u16* aq = (u16*)(ops + 49152);
#pragma unroll
    for (int nt = 0; nt < 4; ++nt) {
      float lv[4], av[4];
#pragma unroll
      for (int jj = 0; jj < 4; ++jj) {
        const int j = nt * 16 + kg * 4 + jj;
        const float gam = (i >= j) ? __expf(gci - sgc[j]) : 0.f;
        lv[jj] = (i > j) ? aL[nt][jj] * bi * gam : 0.f;
        av[jj] = aA[nt][jj] * gam;
      }
      *(float4*)&sL[i * 64 + nt * 16 + kg * 4] = make_float4(lv[0], lv[1], lv[2], lv[3]);
      uint2 o; o.x = pack2(av[0], av[1]); o.y = pack2(av[2], av[3]);
      *(uint2*)&aq[((w * 2 + (nt >> 1)) * 64 + lane) * 8 + (nt & 1) * 4] = o;
    }
  }
  {
    u16* qg = (u16*)(ops + 16384);
    u16* kdT = (u16*)(ops + 32768);
#pragma unroll 1
    for (int i = 0; i < 4; ++i) {
      const int f = tid + 256 * i;
      const int mtks = f >> 6, l = f & 63, rr = l & 15, kgg = l >> 4;
      {
        const int mt = mtks >> 2, ks = mtks & 3, row = mt * 16 + rr;
        const float e = __expf(sgc[row]);
        uint2 a = *(const uint2*)&qs[row * 136 + ks * 32 + kgg * 4];
        uint2 c = *(const uint2*)&qs[row * 136 + ks * 32 + 16 + kgg * 4];
        uint4 o;
        o.x = pack2(bflo(a.x) * e, bfhi(a.x) * e); o.y = pack2(bflo(a.y) * e, bfhi(a.y) * e);
        o.z = pack2(bflo(c.x) * e, bfhi(c.x) * e); o.w = pack2(bflo(c.y) * e, bfhi(c.y) * e);
        *(uint4*)&qg[(size_t)f * 8] = o;
      }
      {
        const int mt = mtks >> 1, ks = mtks & 1, kdim = mt * 16 + rr;
        float v[8];
#pragma unroll
        for (int j = 0; j < 8; ++j) {
          const int c = ks * 32 + permk(kgg, j);
          v[j] = bf2f(ksm[c * 136 + kdim]) * __expf(gcl - sgc[c]);
        }
        uint4 o; o.x = pack2(v[0], v[1]); o.y = pack2(v[2], v[3]); o.z = pack2(v[4], v[5]); o.w = pack2(v[6], v[7]);
        *(uint4*)&kdT[(size_t)f * 8] = o;
      }
    }
  }
  __syncthreads();
  float x[64];
  if (tid < 128) {
    const int col = 1024 + h * 128 + tid;
    const float w0 = p.conv_w[col], w1 = p.conv_w[1536 + col], w2 = p.conv_w[3072 + col], w3 = p.conv_w[4608 + col];
    float xm3 = 0.f, xm2 = 0.f, xm1 = 0.f;
    if (t0 > 0) {
      xm3 = bf2f(p.proj[(rowbase + t0 - 3) * NP + col]);
      xm2 = bf2f(p.proj[(rowbase + t0 - 2) * NP + col]);
      xm1 = bf2f(p.proj[(rowbase + t0 - 1) * NP + col]);
    }
#pragma unroll
    for (int t = 0; t < 64; ++t) {
      float xc = bf2f(p.proj[(rowbase + t0 + t) * NP + col]);
      float yv = w0 * xm3 + w1 * xm2 + w2 * xm1 + w3 * xc;
      x[t] = siluf(yv) * sbeta[t];
      xm3 = xm2; xm2 = xm1; xm1 = xc;
    }
  } else {
    const int kc = tid - 128;
#pragma unroll
    for (int t = 0; t < 64; ++t) x[t] = bf2f(ksm[t * 136 + kc]) * sbeta[t] * __expf(sgc[t]);
  }
#pragma unroll
  for (int i = 1; i < 64; ++i) {
    float s = x[i];
#pragma unroll
    for (int j4 = 0; j4 < (i + 3) / 4; ++j4) {
      float4 l = *(const float4*)&sL[i * 64 + j4 * 4];
      s -= l.x * x[j4 * 4];
      if (j4 * 4 + 1 < i) s -= l.y * x[j4 * 4 + 1];
      if (j4 * 4 + 2 < i) s -= l.z * x[j4 * 4 + 2];
      if (j4 * 4 + 3 < i) s -= l.w * x[j4 * 4 + 3];
    }
    x[i] = s;
  }
  __syncthreads();
  if (tid < 128) {
#pragma unroll
    for (int t = 0; t < 64; ++t) sU[t * 128 + tid] = f2bf(x[t]);
  } else {
    const int kc = tid - 128;
#pragma unroll
    for (int t = 0; t < 64; ++t) sW[t * 136 + kc] = f2bf(-x[t]);
  }
  __syncthreads();
  {
    u16* nW = (u16*)ops;
    u16* u0 = (u16*)(ops + 57344);
#pragma unroll 1
    for (int i = 0; i < 4; ++i) {
      const int f = tid + 256 * i;
      const int mtks = f >> 6, l = f & 63, rr = l & 15, kgg = l >> 4;
      const int mt = mtks >> 2, ks = mtks & 3, row = mt * 16 + rr;
      uint2 a = *(const uint2*)&sW[row * 136 + ks * 32 + kgg * 4];
      uint2 c = *(const uint2*)&sW[row * 136 + ks * 32 + 16 + kgg * 4];
      *(uint4*)&nW[(size_t)f * 8] = make_uint4(a.x, a.y, c.x, c.y);
    }
#pragma unroll 1
    for (int i = 0; i < 8; ++i) {
      const int f = tid + 256 * i;
      const int smt = f >> 6, l = f & 63, rr = l & 15, kgg = l >> 4;
      const int s = smt >> 2, mt = smt & 3;
      u16 v0 = sU[(mt * 16 + kgg * 4 + 0) * 128 + s * 16 + rr];
      u16 v1 = sU[(mt * 16 + kgg * 4 + 1) * 128 + s * 16 + rr];
      u16 v2 = sU[(mt * 16 + kgg * 4 + 2) * 128 + s * 16 + rr];
      u16 v3 = sU[(mt * 16 + kgg * 4 + 3) * 128 + s * 16 + rr];
      *(uint2*)&u0[(size_t)f * 4] = make_uint2((unsigned)v0 | ((unsigned)v1 << 16), (unsigned)v2 | ((unsigned)v3 << 16));
    }
  }
}

DI void vt_tile(const Params& p, int item, char* smem) {
  u16* tile = (u16*)smem;
  const int tid = threadIdx.x;
  const int ptile = item & 127, gbh = item >> 7;
  const int h = gbh & 3, b = (gbh >> 2) & 3, g = gbh >> 4;
  const int dsh = g * 2, ln = SEQ >> dsh;
  const int pos0 = ptile * 64;
  const int rres = pos0 / ln, i0 = pos0 % ln;
  __syncthreads();
  {
    const int pr = tid >> 2, seg = (tid & 3) * 16;
    const int token = ((i0 + pr) << dsh) + rres;
    const u16* src = &p.proj[((size_t)b * SEQ + token) * NP + 2048 + g * 768 + 512 + h * 64 + seg];
    uint4 a = *(const uint4*)src, c = *(const uint4*)(src + 8);
    unsigned d[8] = {a.x, a.y, a.z, a.w, c.x, c.y, c.z, c.w};
#pragma unroll
    for (int e = 0; e < 8; ++e) *(unsigned*)&tile[pr * 66 + seg + e * 2] = d[e];
  }
  __syncthreads();
  {
    const int dh = tid >> 2, seg = (tid & 3) * 16;
    unsigned o[8];
#pragma unroll
    for (int e = 0; e < 8; ++e) o[e] = (unsigned)tile[(seg + 2 * e) * 66 + dh] | ((unsigned)tile[(seg + 2 * e + 1) * 66 + dh] << 16);
    u16* d = &p.vT[((size_t)gbh * 64 + dh) * SEQ + pos0 + seg];
    *(uint4*)d = make_uint4(o[0], o[1], o[2], o[3]);
    *(uint4*)(d + 8) = make_uint4(o[4], o[5], o[6], o[7]);
  }
}

DI void dn_sample(const Params& p, int item, char* smem) {
  float* sq = (float*)smem;
  float* sk = sq + 512;
  float* sv = sk + 512;
  float* red = sv + 512;
  const int tid = threadIdx.x, lane = tid & 63, w = tid >> 6;
  const int b = item >> 2, h = item & 3;
  __syncthreads();
  for (int c = tid; c < 384; c += 256) {
    const int part = c >> 7, cc = c & 127;
    const int col = part * 512 + h * 128 + cc;
    float xp[7];
#pragma unroll
    for (int j = 0; j < 3; ++j) xp[j] = p.state_conv[((size_t)b * 3 + j) * 1536 + col];
#pragma unroll
    for (int j = 0; j < 4; ++j) xp[3 + j] = bf2f(p.proj[((size_t)MP + b * 4 + j) * NP + col]);
    const float w0 = p.conv_w[col], w1 = p.conv_w[1536 + col], w2 = p.conv_w[3072 + col], w3 = p.conv_w[4608 + col];
    float* dst = part == 0 ? sq : (part == 1 ? sk : sv);
#pragma unroll
    for (int t = 0; t < 4; ++t) dst[t * 128 + cc] = siluf(w0 * xp[t] + w1 * xp[t + 1] + w2 * xp[t + 2] + w3 * xp[t + 3]);
  }
  __syncthreads();
  {
    float a0 = sq[w * 128 + lane], a1 = sq[w * 128 + 64 + lane];
    float s = wave_sum(a0 * a0 + a1 * a1);
    float sc = rsqrtf(s + EPS) * 0.08838834764831845f;
    sq[w * 128 + lane] = a0 * sc; sq[w * 128 + 64 + lane] = a1 * sc;
    float b0 = sk[w * 128 + lane], b1 = sk[w * 128 + 64 + lane];
    s = wave_sum(b0 * b0 + b1 * b1);
    sc = rsqrtf(s + EPS);
    sk[w * 128 + lane] = b0 * sc; sk[w * 128 + 64 + lane] = b1 * sc;
  }
  __syncthreads();
  const int v = tid & 127, half = tid >> 7;
  float S[64];
  const float* s0 = p.state_delta + (((size_t)b * 4 + h) * 128 + half * 64) * 128 + v;
#pragma unroll
  for (int i = 0; i < 64; ++i) S[i] = s0[(size_t)i * 128];
#pragma unroll 1
  for (int t = 0; t < 4; ++t) {
    const size_t row = (size_t)MP + b * 4 + t;
    const float a = __expf(p.gb[row * 8 + h]);
    const float beta = p.gb[row * 8 + 4 + h];
    float part = 0.f;
#pragma unroll
    for (int i = 0; i < 64; ++i) part += S[i] * sk[t * 128 + half * 64 + i];
    red[half * 128 + v] = part;
    __syncthreads();
    const float kS = red[v] + red[128 + v];
    const float u = beta * (sv[t * 128 + v] - a * kS);
    float po = 0.f;
#pragma unroll
    for (int i = 0; i < 64; ++i) { S[i] = a * S[i] + sk[t * 128 + half * 64 + i] * u; po += S[i] * sq[t * 128 + half * 64 + i]; }
    __syncthreads();
    red[half * 128 + v] = po;
    __syncthreads();
    if (half == 0) p.odn[row * 512 + h * 128 + v] = f2bf(red[v] + red[128 + v]);
    __syncthreads();
  }
  float* d = p.out + O_SDELTA + (((size_t)b * 4 + h) * 128 + half * 64) * 128 + v;
#pragma unroll
  for (int i = 0; i < 64; ++i) d[(size_t)i * 128] = S[i];
}

DI void phase2(const Params& p, char* smem) {
  const size_t gtid = (size_t)blockIdx.x * 256 + threadIdx.x, gsz = (size_t)gridDim.x * 256;
  for (int j = blockIdx.x; j < 2048 + 128 + 6144; j += gridDim.x) {
    if (j < 2048) dn_prep(p, j, smem);
    else if (j < 2048 + 128) dn_sample(p, j - 2048, smem);
    else vt_tile(p, j - 2176, smem);
  }
  for (size_t f = gtid; f < (size_t)16 * 8192; f += gsz) {
    {
      const size_t e0 = f * 8;
      const int bh = (int)(e0 >> 16), key = (int)((e0 >> 8) & 255), dh = (int)(e0 & 255);
      const int b = bh >> 2, h = bh & 3;
      cvt8(p.out + O_PMEM + (((size_t)b * 256 + key) * 2 + 0) * 1024 + h * 256 + dh, p.Kb + e0);
    }
    {
      const int l = (int)(f & 63), ks = (int)((f >> 6) & 7), nt = (int)((f >> 9) & 15), bh = (int)(f >> 13);
      const int b = bh >> 2, h = bh & 3, rr = l & 15, kgg = l >> 4;
      float v[8];
#pragma unroll
      for (int j = 0; j < 8; ++j) {
        const int key = ks * 32 + permk(kgg, j);
        v[j] = p.out[O_PMEM + (((size_t)b * 256 + key) * 2 + 1) * 1024 + h * 256 + nt * 16 + rr];
      }
      *(uint4*)&p.VTf[f * 8] = make_uint4(pack2(v[0], v[1]), pack2(v[2], v[3]), pack2(v[4], v[5]), pack2(v[6], v[7]));
    }
  }
  for (size_t i = gtid; i < 18432; i += gsz) {
    const int c = (int)(i % 1536), j = (int)((i / 1536) % 3), b = (int)(i / 4608);
    p.out[O_PCONV + i] = bf2f(p.proj[((size_t)b * SEQ + SEQ - 3 + j) * NP + c]);
  }
  for (int g = 0; g < 3; ++g) {
    const int W = 128 << (2 * g);
    const size_t off = (g == 0) ? O_PW1 : (g == 1 ? O_PW2 : O_PW3);
    const size_t n4 = (size_t)4 * W * 512 / 4;
    for (size_t i = gtid; i < n4; i += gsz) {
      const size_t e0 = i * 4;
      const int e = (int)(e0 & 511), ii = (int)((e0 >> 9) % W), b = (int)((e0 >> 9) / W);
      uint2 v = *(const uint2*)&p.proj[((size_t)b * SEQ + SEQ - W + ii) * NP + 2048 + g * 768 + 256 + e];
      *(float4*)&p.out[off + e0] = make_float4(bflo(v.x), bfhi(v.x), bflo(v.y), bfhi(v.y));
    }
  }
}

typedef __attribute__((ext_vector_type(2))) unsigned u32x2;
struct ScanOps { bf16x8 nW[4]; bf16x8 qg[4]; bf16x8 aq[2]; bf16x8 kd[4]; u32x2 u0; float dl; };

DI void scan_load(const Params& p, int bh, int s, int n, int j, int lane, ScanOps& o) {
  n = n > 127 ? 127 : n;
  const char AS1* base = (const char AS1*)p.dnops + (size_t)(bh * 128 + n) * DN_ITEM;
  gb8p negW = (gb8p)base;
  gb8p qg = (gb8p)(base + 16384);
  gb8p kdT = (gb8p)(base + 32768);
  gb8p aqk = (gb8p)(base + 49152);
  const u32x2 AS1* u0 = (const u32x2 AS1*)(base + 57344);
#pragma unroll
  for (int ks = 0; ks < 4; ++ks) o.nW[ks] = negW[(j * 4 + ks) * 64 + lane];
#pragma unroll
  for (int ks = 0; ks < 4; ++ks) o.qg[ks] = qg[(j * 4 + ks) * 64 + lane];
#pragma unroll
  for (int k2 = 0; k2 < 2; ++k2) o.aq[k2] = aqk[(j * 2 + k2) * 64 + lane];
#pragma unroll
  for (int mm = 0; mm < 2; ++mm)
#pragma unroll
    for (int k2 = 0; k2 < 2; ++k2) o.kd[mm * 2 + k2] = kdT[((2 * j + mm) * 2 + k2) * 64 + lane];
  o.u0 = u0[(s * 4 + j) * 64 + lane];
  o.dl = ((const float AS1*)p.dl)[bh * 128 + n];
}

DI void scan_step(const Params& p, const ScanOps& ops, int n, int b, int h, int s, int j, int lane, f32x4& S0, f32x4& S1,
                  bf16x8* sSb, u32x2* sUb) {
  const int r = lane & 15, kg = lane >> 4;
  bf16x8 sb[4];
#pragma unroll
  for (int ks = 0; ks < 4; ++ks) sb[ks] = sSb[ks * 64 + lane];
  f32x4 u = (f32x4){bflo(ops.u0[0]), bfhi(ops.u0[0]), bflo(ops.u0[1]), bfhi(ops.u0[1])};
#pragma unroll
  for (int ks = 0; ks < 4; ++ks) u = MFMA(ops.nW[ks], sb[ks], u);
  {
    u32x2 t; t[0] = pack2(u[0], u[1]); t[1] = pack2(u[2], u[3]);
    sUb[((j >> 1) * 64 + lane) * 2 + (j & 1)] = t;
  }
  __syncthreads();
  bf16x8 ub[2];
#pragma unroll
  for (int k2 = 0; k2 < 2; ++k2) ub[k2] = *(const bf16x8*)&sUb[(k2 * 64 + lane) * 2];
  f32x4 o = (f32x4){0.f, 0.f, 0.f, 0.f};
#pragma unroll
  for (int ks = 0; ks < 4; ++ks) o = MFMA(ops.qg[ks], sb[ks], o);
#pragma unroll
  for (int k2 = 0; k2 < 2; ++k2) o = MFMA(ops.aq[k2], ub[k2], o);
  S0 = S0 * ops.dl; S1 = S1 * ops.dl;
#pragma unroll
  for (int k2 = 0; k2 < 2; ++k2) { S0 = MFMA(ops.kd[k2], ub[k2], S0); S1 = MFMA(ops.kd[2 + k2], ub[k2], S1); }
  sSb[j * 64 + lane] = pack8(S0, S1);
#pragma unroll
  for (int jj = 0; jj < 4; ++jj) {
    const size_t token = (size_t)b * SEQ + n * 64 + j * 16 + kg * 4 + jj;
    G(p.odn)[token * 512 + h * 128 + s * 16 + r] = f2bf(o[jj]);
  }
  __syncthreads();
}

DI void dn_scan_block(const Params& p, int item, char* smem) {
  const int lane = threadIdx.x & 63, j = threadIdx.x >> 6, r = lane & 15, kg = lane >> 4;
  const int bh = item >> 3, s = item & 7, b = bh >> 2, h = bh & 3;
  bf16x8* sSb = (bf16x8*)smem;
  u32x2* sUb = (u32x2*)(smem + 4096);
  f32x4 S0 = (f32x4){0.f, 0.f, 0.f, 0.f}, S1 = (f32x4){0.f, 0.f, 0.f, 0.f};
  __syncthreads();
  sSb[j * 64 + lane] = pack8(S0, S1);
  ScanOps A, B;
  scan_load(p, bh, s, 0, j, lane, A);
  scan_load(p, bh, s, 1, j, lane, B);
  __syncthreads();
#pragma unroll 1
  for (int n0 = 0; n0 < 128; n0 += 2) {
    scan_step(p, A, n0, b, h, s, j, lane, S0, S1, sSb, sUb);
    scan_load(p, bh, s, n0 + 2, j, lane, A);
    scan_step(p, B, n0 + 1, b, h, s, j, lane, S0, S1, sSb, sUb);
    scan_load(p, bh, s, n0 + 3, j, lane, B);
  }
#pragma unroll
  for (int jj = 0; jj < 4; ++jj) {
    p.out[O_PDELTA + ((size_t)bh * 128 + 32 * j + kg * 4 + jj) * 128 + s * 16 + r] = S0[jj];
    p.out[O_PDELTA + ((size_t)bh * 128 + 32 * j + 16 + kg * 4 + jj) * 128 + s * 16 + r] = S1[jj];
  }
}

DI void sw_prompt_wave(const Params& p, int item) {
  const int lane = threadIdx.x & 63, r = lane & 15, kg = lane >> 4;
  const int qt = item & 511, gbh = item >> 9;
  const int h = gbh & 3, b = (gbh >> 2) & 3, g = gbh >> 4;
  const int dsh = 2 * g, ln = SEQ >> dsh;
  const int pos0 = qt * 16, rres = pos0 / ln, i0 = pos0 % ln;
  const int kbase = i0 - 144;
  const size_t rb = (size_t)b * SEQ;
  const int qoff = 2048 + g * 768 + h * 64, koff = qoff + 256;
  bf16x8 qf[2];
  {
    const size_t tok = rb + ((size_t)(i0 + r) << dsh) + rres;
#pragma unroll
    for (int ks = 0; ks < 2; ++ks) qf[ks] = *(const bf16x8*)&p.proj[tok * NP + qoff + ks * 32 + kg * 8];
  }
  f32x4 st[10];
#pragma unroll
  for (int mt = 0; mt < 10; ++mt) {
    int ki = kbase + mt * 16 + r; ki = ki < 0 ? 0 : ki;
    const size_t tok = rb + ((size_t)ki << dsh) + rres;
    f32x4 a = (f32x4){0.f, 0.f, 0.f, 0.f};
#pragma unroll
    for (int ks = 0; ks < 2; ++ks) {
      bf16x8 kf = *(const bf16x8*)&p.proj[tok * NP + koff + ks * 32 + kg * 8];
      a = MFMA(kf, qf[ks], a);
    }
    st[mt] = a;
  }
  const int qi = i0 + r;
  float mx = -3.0e38f;
#pragma unroll
  for (int mt = 0; mt < 10; ++mt)
#pragma unroll
    for (int j = 0; j < 4; ++j) {
      const int ki = kbase + mt * 16 + kg * 4 + j;
      const int d = qi - ki;
      const bool valid = (ki >= 0) && (d >= 0) && (d <= 128);
      const float sv = valid ? st[mt][j] * 0.125f : -3.0e38f;
      st[mt][j] = sv;
      mx = fmaxf(mx, sv);
    }
  mx = fmaxf(mx, __shfl_xor(mx, 16));
  mx = fmaxf(mx, __shfl_xor(mx, 32));
  float sum = 0.f;
#pragma unroll
  for (int mt = 0; mt < 10; ++mt)
#pragma unroll
    for (int j = 0; j < 4; ++j) {
      const float pv = (st[mt][j] > -1.0e38f) ? __expf(st[mt][j] - mx) : 0.f;
      st[mt][j] = pv;
      sum += pv;
    }
  sum += __shfl_xor(sum, 16);
  sum += __shfl_xor(sum, 32);
  const float inv = 1.f / sum;
  bf16x8 pf[5];
#pragma unroll
  for (int k2 = 0; k2 < 5; ++k2) pf[k2] = pack8(st[2 * k2], st[2 * k2 + 1]);
  const size_t qrow = rb + ((size_t)qi << dsh) + rres;
#pragma unroll
  for (int nt = 0; nt < 4; ++nt) {
    f32x4 o = (f32x4){0.f, 0.f, 0.f, 0.f};
    const u16* vrow = &p.vT[((size_t)gbh * 64 + nt * 16 + r) * SEQ + (size_t)rres * ln];
#pragma unroll
    for (int k2 = 0; k2 < 5; ++k2) {
      int ka = kbase + k2 * 32 + kg * 4, kc = ka + 16;
      ka = ka < 0 ? 0 : ka; kc = kc < 0 ? 0 : kc;
      uint2 va = *(const uint2*)&vrow[ka];
      uint2 vc = *(const uint2*)&vrow[kc];
      bf16x8 vf = __builtin_bit_cast(bf16x8, make_uint4(va.x, va.y, vc.x, vc.y));
      o = MFMA(vf, pf[k2], o);
    }
    uint2 ov; ov.x = pack2(o[0] * inv, o[1] * inv); ov.y = pack2(o[2] * inv, o[3] * inv);
    *(uint2*)&p.osw[((size_t)g * MT + qrow) * 256 + h * 64 + nt * 16 + kg * 4] = ov;
  }
  if (kg == 0) p.lse[((size_t)g * MT + qrow) * 4 + h] = mx + __logf(sum);
}

DI void sw_sample_wave(const Params& p, int item) {
  const int lane = threadIdx.x & 63;
  const int t = item & 3, h = (item >> 2) & 3, b = (item >> 4) & 31, g = item >> 9;
  const int dil = 1 << (2 * g), W = 128 << (2 * g);
  const float* c1 = p.cw1;
  const float* c2 = p.cw2;
  const float* c3 = p.cw3;
  const float* cache = (g == 0) ? c1 : (g == 1 ? c2 : c3);
  const int qoff = 2048 + g * 768 + h * 64;
  const size_t qrow = (size_t)MP + b * 4 + t;
  float q[64];
#pragma unroll
  for (int c = 0; c < 64; c += 8) {
    uint4 v = *(const uint4*)&p.proj[qrow * NP + qoff + c];
    q[c] = bflo(v.x); q[c + 1] = bfhi(v.x); q[c + 2] = bflo(v.y); q[c + 3] = bfhi(v.y);
    q[c + 4] = bflo(v.z); q[c + 5] = bfhi(v.z); q[c + 6] = bflo(v.w); q[c + 7] = bfhi(v.w);
  }
  float sc[3];
#pragma unroll
  for (int mi = 0; mi < 3; ++mi) {
    const int m = lane + 64 * mi;
    float s = -3.0e38f;
    if (m <= 128) {
      const int j = W + t - m * dil;
      float d = 0.f;
      if (j >= W) {
        const u16* kr = &p.proj[((size_t)MP + b * 4 + (j - W)) * NP + qoff + 256];
#pragma unroll
        for (int c = 0; c < 64; c += 8) {
          uint4 v = *(const uint4*)&kr[c];
          d += q[c] * bflo(v.x) + q[c + 1] * bfhi(v.x) + q[c + 2] * bflo(v.y) + q[c + 3] * bfhi(v.y) + q[c + 4] * bflo(v.z) +
               q[c + 5] * bfhi(v.z) + q[c + 6] * bflo(v.w) + q[c + 7] * bfhi(v.w);
        }
      } else {
        const float* kr = &cache[(((size_t)b * W + j) * 2 + 0) * 256 + h * 64];
#pragma unroll
        for (int c = 0; c < 64; c += 4) {
          float4 v = *(const float4*)&kr[c];
          d += q[c] * v.x + q[c + 1] * v.y + q[c + 2] * v.z + q[c + 3] * v.w;
        }
      }
      s = d * 0.125f;
    }
    sc[mi] = s;
  }
  float mx = wave_max(fmaxf(fmaxf(sc[0], sc[1]), sc[2]));
  float sum = 0.f;
#pragma unroll
  for (int mi = 0; mi < 3; ++mi) { sc[mi] = (sc[mi] > -1.0e38f) ? __expf(sc[mi] - mx) : 0.f; sum += sc[mi]; }
  sum = wave_sum(sum);
  float o = 0.f;
#pragma unroll
  for (int mi = 0; mi < 3; ++mi) {
#pragma unroll 8
    for (int mm = 0; mm < 64; ++mm) {
      const int m = mi * 64 + mm;
      if (m <= 128) {
        const float pv = __shfl(sc[mi], mm);
        const int j = W + t - m * dil;
        float vv;
        if (j >= W) vv = bf2f(p.proj[((size_t)MP + b * 4 + (j - W)) * NP + qoff + 512 + lane]);
        else vv = cache[(((size_t)b * W + j) * 2 + 1) * 256 + h * 64 + lane];
        o += pv * vv;
      }
    }
  }
  p.osw[((size_t)g * MT + qrow) * 256 + h * 64 + lane] = f2bf(o / sum);
  if (lane == 0) p.lse[((size_t)g * MT + qrow) * 4 + h] = mx + __logf(sum);
}

DI void phase3(const Params& p, char* smem) {
  const int w = threadIdx.x >> 6;
  if (blockIdx.x < 128) {
    dn_scan_block(p, blockIdx.x, smem);
  } else {
    const int gw = (blockIdx.x - 128) * 4 + w, nw = (gridDim.x - 128) * 4;
    for (int it = gw; it < 24576 + 1536; it += nw) {
      if (it < 24576) sw_prompt_wave(p, it);
      else sw_sample_wave(p, it - 24576);
    }
  }
}

DI void phase4(const Params& p) {
  const int lane = threadIdx.x & 63, w = threadIdx.x >> 6;
  for (int row = blockIdx.x * 4 + w; row < MT; row += gridDim.x * 4) {
    u16* dst = p.Amix + (size_t)row * 768;
#pragma unroll
    for (int h = 0; h < 4; ++h) {
      unsigned ov = *(const unsigned*)&p.odn[(size_t)row * 512 + h * 128 + lane * 2];
      unsigned zv = *(const unsigned*)&p.proj[(size_t)row * NP + 1536 + h * 128 + lane * 2];
      float o0 = bflo(ov), o1 = bfhi(ov);
      float ss = wave_sum(o0 * o0 + o1 * o1);
      float rs = rsqrtf(ss * (1.f / 128.f) + EPS);
      float2 gn = *(const float2*)&p.g_onorm[lane * 2];
      float y0 = o0 * rs * gn.x * siluf(bflo(zv)), y1 = o1 * rs * gn.y * siluf(bfhi(zv));
      *(unsigned*)&dst[h * 128 + lane * 2] = pack2(y0, y1);
    }
    {
      const int h = lane >> 4;
      float l0 = p.lse[((size_t)0 * MT + row) * 4 + h], l1 = p.lse[((size_t)1 * MT + row) * 4 + h], l2 = p.lse[((size_t)2 * MT + row) * 4 + h];
      float m = fmaxf(l0, fmaxf(l1, l2));
      float e0 = __expf(l0 - m), e1 = __expf(l1 - m), e2 = __expf(l2 - m);
      float inv = 1.f / (e0 + e1 + e2);
      uint2 a = *(const uint2*)&p.osw[((size_t)0 * MT + row) * 256 + lane * 4];
      uint2 c = *(const uint2*)&p.osw[((size_t)1 * MT + row) * 256 + lane * 4];
      uint2 d = *(const uint2*)&p.osw[((size_t)2 * MT + row) * 256 + lane * 4];
      e0 *= inv; e1 *= inv; e2 *= inv;
      float y0 = e0 * bflo(a.x) + e1 * bflo(c.x) + e2 * bflo(d.x);
      float y1 = e0 * bfhi(a.x) + e1 * bfhi(c.x) + e2 * bfhi(d.x);
      float y2 = e0 * bflo(a.y) + e1 * bflo(c.y) + e2 * bflo(d.y);
      float y3 = e0 * bfhi(a.y) + e1 * bfhi(c.y) + e2 * bfhi(d.y);
      *(uint2*)&dst[512 + lane * 4] = make_uint2(pack2(y0, y1), pack2(y2, y3));
    }
  }
}

DI void sample_state_copy(const Params& p) {
  const size_t gtid = (size_t)blockIdx.x * 256 + threadIdx.x, gsz = (size_t)gridDim.x * 256;
  for (size_t i = gtid; i < 147456; i += gsz) {
    const int c = (int)(i % 1536), j = (int)((i / 1536) % 3), b = (int)(i / 4608);
    p.out[O_SCONV + i] = bf2f(p.proj[((size_t)MP + b * 4 + j + 1) * NP + c]);
  }
  const float* c1 = p.cw1;
  const float* c2 = p.cw2;
  const float* c3 = p.cw3;
  for (int g = 0; g < 3; ++g) {
    const int W = 128 << (2 * g);
    const float* cache = (g == 0) ? c1 : (g == 1 ? c2 : c3);
    const size_t off = (g == 0) ? O_SW1 : (g == 1 ? O_SW2 : O_SW3);
    const size_t n4 = (size_t)32 * W * 512 / 4;
#pragma unroll 4
    for (size_t i = gtid; i < n4; i += gsz) {
      const size_t e0 = i * 4;
      const int e = (int)(e0 & 511), ii = (int)((e0 >> 9) % W), b = (int)((e0 >> 9) / W);
      float4 o;
      if (ii < W - 4) o = *(const float4*)&cache[((size_t)b * W + ii + 4) * 512 + e];
      else {
        uint2 v = *(const uint2*)&p.proj[((size_t)MP + b * 4 + (ii - (W - 4))) * NP + 2048 + g * 768 + 256 + e];
        o = make_float4(bflo(v.x), bfhi(v.x), bflo(v.y), bfhi(v.y));
      }
      *(float4*)&p.out[off + e0] = o;
    }
  }
}

DI void mem_attn_prompt_block(const Params& p, int item, char* smem) {
  const int tid = threadIdx.x, lane = tid & 63, w = tid >> 6, r = lane & 15, kg = lane >> 4;
  const int h = item & 3, qb = item >> 2;
  const int row0 = qb * 64 + w * 16, b = (qb * 64) >> 13;
  const int bh = b * 4 + h;
  u16* sK = (u16*)smem;
  bf16x8 qf[8];
#pragma unroll
  for (int ks = 0; ks < 8; ++ks) qf[ks] = *(const bf16x8*)&G(p.qb)[(size_t)(row0 + r) * 1024 + h * 256 + ks * 32 + kg * 8];
  f32x4 st[16];
  const u16* kbp = G(p.Kb) + (size_t)bh * 65536;
#pragma unroll
  for (int c = 0; c < 4; ++c) {
    __syncthreads();
#pragma unroll
    for (int i2 = 0; i2 < 2; ++i2) {
#pragma unroll
      for (int i = i2 * 4; i < i2 * 4 + 4; ++i) {
        const int idx = tid + 256 * i, row = idx >> 5, seg = idx & 31;
        *(bf16x8*)&sK[row * 264 + seg * 8] = *(gb8p)((gu16p)kbp + (size_t)(c * 64 + row) * 256 + seg * 8);
      }
      __builtin_amdgcn_sched_barrier(0);
    }
    __syncthreads();
#pragma unroll
    for (int m4 = 0; m4 < 4; ++m4) {
      f32x4 a = (f32x4){0.f, 0.f, 0.f, 0.f};
#pragma unroll
      for (int ks = 0; ks < 8; ++ks) {
        bf16x8 kf = *(const bf16x8*)&sK[(m4 * 16 + r) * 264 + ks * 32 + kg * 8];
        a = MFMA(kf, qf[ks], a);
      }
      st[c * 4 + m4] = a;
      __builtin_amdgcn_sched_barrier(0);
    }
  }
  float mx = -3.0e38f;
#pragma unroll
  for (int mt = 0; mt < 16; ++mt)
#pragma unroll
    for (int j = 0; j < 4; ++j) { st[mt][j] *= 0.0625f; mx = fmaxf(mx, st[mt][j]); }
  mx = fmaxf(mx, __shfl_xor(mx, 16));
  mx = fmaxf(mx, __shfl_xor(mx, 32));
  float sum = 0.f;
#pragma unroll
  for (int mt = 0; mt < 16; ++mt)
#pragma unroll
    for (int j = 0; j < 4; ++j) { st[mt][j] = __expf(st[mt][j] - mx); sum += st[mt][j]; }
  sum += __shfl_xor(sum, 16);
  sum += __shfl_xor(sum, 32);
  const float inv = 1.f / sum;
  bf16x8 pf[8];
#pragma unroll
  for (int k2 = 0; k2 < 8; ++k2) pf[k2] = pack8(st[2 * k2], st[2 * k2 + 1]);
  const u16* vtp = G(p.VTf) + (size_t)bh * 65536;
#pragma unroll 1
  for (int c = 0; c < 4; ++c) {
    __syncthreads();
#pragma unroll
    for (int i = 0; i < 8; ++i) {
      const int idx = tid + 256 * i;
      *(bf16x8*)&sK[idx * 8] = *(gb8p)((gu16p)vtp + (size_t)c * 16384 + idx * 8);
    }
    __syncthreads();
#pragma unroll
    for (int n4 = 0; n4 < 4; ++n4) {
      f32x4 o = (f32x4){0.f, 0.f, 0.f, 0.f};
#pragma unroll
      for (int k2 = 0; k2 < 8; ++k2) o = MFMA(*(const bf16x8*)&sK[((n4 * 8 + k2) * 64 + lane) * 8], pf[k2], o);
      uint2 ov; ov.x = pack2(o[0] * inv, o[1] * inv); ov.y = pack2(o[2] * inv, o[3] * inv);
      *(uint2*)&G(p.attn)[(size_t)(row0 + r) * 1024 + h * 256 + (c * 4 + n4) * 16 + kg * 4] = ov;
      __builtin_amdgcn_sched_barrier(0);
    }
  }
}

DI void mem_attn_sample_wave(const Params& p, int item, float* lds) {
  const int lane = threadIdx.x & 63;
  const int b = item >> 2, h = item & 3;
  float* sq = lds;
#pragma unroll
  for (int t = 0; t < 4; ++t) {
    uint2 v = *(const uint2*)&p.qb[((size_t)MP + b * 4 + t) * 1024 + h * 256 + lane * 4];
    *(float4*)&sq[t * 256 + lane * 4] = make_float4(bflo(v.x), bfhi(v.x), bflo(v.y), bfhi(v.y));
  }
  __builtin_amdgcn_s_waitcnt(0);
  __builtin_amdgcn_wave_barrier();
  float sc[4][4];
#pragma unroll
  for (int mi = 0; mi < 4; ++mi) {
    const int m = lane + 64 * mi;
    const float* kr = &p.cache_mem[(((size_t)b * 256 + m) * 2 + 0) * 1024 + h * 256];
    float d0 = 0.f, d1 = 0.f, d2 = 0.f, d3 = 0.f;
#pragma unroll 2
    for (int c = 0; c < 256; c += 4) {
      float4 kv = *(const float4*)&kr[c];
      float4 q0 = *(const float4*)&sq[c], q1 = *(const float4*)&sq[256 + c], q2 = *(const float4*)&sq[512 + c], q3 = *(const float4*)&sq[768 + c];
      d0 += kv.x * q0.x + kv.y * q0.y + kv.z * q0.z + kv.w * q0.w;
      d1 += kv.x * q1.x + kv.y * q1.y + kv.z * q1.z + kv.w * q1.w;
      d2 += kv.x * q2.x + kv.y * q2.y + kv.z * q2.z + kv.w * q2.w;
      d3 += kv.x * q3.x + kv.y * q3.y + kv.z * q3.z + kv.w * q3.w;
    }
    sc[0][mi] = d0 * 0.0625f; sc[1][mi] = d1 * 0.0625f; sc[2][mi] = d2 * 0.0625f; sc[3][mi] = d3 * 0.0625f;
  }
  float inv[4];
  __builtin_amdgcn_wave_barrier();
#pragma unroll
  for (int t = 0; t < 4; ++t) {
    float mx = wave_max(fmaxf(fmaxf(sc[t][0], sc[t][1]), fmaxf(sc[t][2], sc[t][3])));
    float sum = 0.f;
#pragma unroll
    for (int mi = 0; mi < 4; ++mi) { sc[t][mi] = __expf(sc[t][mi] - mx); sum += sc[t][mi]; }
    sum = wave_sum(sum);
    inv[t] = 1.f / sum;
#pragma unroll
    for (int mi = 0; mi < 4; ++mi) sq[t * 256 + lane + 64 * mi] = sc[t][mi];
  }
  __builtin_amdgcn_s_waitcnt(0);
  __builtin_amdgcn_wave_barrier();
  float4 o[4];
#pragma unroll
  for (int t = 0; t < 4; ++t) o[t] = make_float4(0.f, 0.f, 0.f, 0.f);
#pragma unroll 4
  for (int m = 0; m < 256; ++m) {
    float4 vv = *(const float4*)&p.cache_mem[(((size_t)b * 256 + m) * 2 + 1) * 1024 + h * 256 + lane * 4];
#pragma unroll
    for (int t = 0; t < 4; ++t) {
      const float pv = sq[t * 256 + m];
      o[t].x += pv * vv.x; o[t].y += pv * vv.y; o[t].z += pv * vv.z; o[t].w += pv * vv.w;
    }
  }
#pragma unroll
  for (int t = 0; t < 4; ++t) {
    uint2 ov; ov.x = pack2(o[t].x * inv[t], o[t].y * inv[t]); ov.y = pack2(o[t].z * inv[t], o[t].w * inv[t]);
    *(uint2*)&p.attn[((size_t)MP + b * 4 + t) * 1024 + h * 256 + lane * 4] = ov;
  }
  __builtin_amdgcn_wave_barrier();
}

DI void phase7(const Params& p, char* smem) {
  const int w = threadIdx.x >> 6;
  float* lds = (float*)smem + w * 1280;
  for (int it = blockIdx.x; it < 32 + 2048; it += gridDim.x) {
    if (it < 32) { __syncthreads(); mem_attn_sample_wave(p, it * 4 + w, lds); }
    else mem_attn_prompt_block(p, it - 32, smem);
  }
}

DI void peer_topk_wave(const Params& p, int item, unsigned* lds  ) {
  const int lane = threadIdx.x & 63, r = lane & 15, kg = lane >> 4;
  const int h = item & 7, row0 = (item >> 3) * 16;
  unsigned win[2][16];
#pragma unroll
  for (int pp = 0; pp < 2; ++pp) {
    bf16x8 qf[4];
#pragma unroll
    for (int ks = 0; ks < 4; ++ks) qf[ks] = *(const bf16x8*)&p.pq[(size_t)(row0 + r) * 2048 + h * 256 + pp * 128 + ks * 32 + kg * 8];
    unsigned kk[32];
    const u16* sk = p.subkb + (size_t)(h * 2 + pp) * 16384;
#pragma unroll
    for (int mt = 0; mt < 8; ++mt) {
      f32x4 a = (f32x4){0.f, 0.f, 0.f, 0.f};
#pragma unroll
      for (int ks = 0; ks < 4; ++ks) {
        bf16x8 kf = *(const bf16x8*)&sk[(mt * 16 + r) * 128 + ks * 32 + kg * 8];
        a = MFMA(kf, qf[ks], a);
      }
#pragma unroll
      for (int j = 0; j < 4; ++j) kk[mt * 4 + j] = (ordf(a[j]) & ~127u) | (unsigned)(mt * 16 + kg * 4 + j);
    }
#pragma unroll
    for (int rr = 0; rr < 16; ++rr) {
      unsigned m = 0;
#pragma unroll
      for (int i = 0; i < 32; ++i) m = umax(m, kk[i]);
      m = umax(m, (unsigned)__shfl_xor((int)m, 16));
      m = umax(m, (unsigned)__shfl_xor((int)m, 32));
      win[pp][rr] = m;
#pragma unroll
      for (int i = 0; i < 32; ++i) kk[i] = (kk[i] == m) ? 0u : kk[i];
    }
  }
  float f0[16], f1[16];
#pragma unroll
  for (int i = 0; i < 16; ++i) { f0[i] = unordf(win[0][i] & ~127u); f1[i] = unordf(win[1][i] & ~127u); }
  unsigned cand[13];
#define CAND(s, a0, b0, a1, b1, a2, b2, a3, b3)                                                         \
  {                                                                                                     \
    float va = sel4(kg, f0[a0], f0[a1], f0[a2], f0[(a3) < 0 ? 0 : (a3)]);                                \
    float vb = sel4(kg, f1[b0], f1[b1], f1[b2], f1[(b3) < 0 ? 0 : (b3)]);                                \
    unsigned id = sel4(kg, (unsigned)((a0) * 16 + (b0)), (unsigned)((a1) * 16 + (b1)), (unsigned)((a2) * 16 + (b2)), (unsigned)(((a3) < 0 ? 0 : (a3)) * 16 + ((b3) < 0 ? 0 : (b3)))); \
    unsigned key = (ordf(va + vb) & ~255u) | id;                                                        \
    if ((a3) < 0) key = (kg == 3) ? 0u : key;                                                           \
    cand[s] = key;                                                                                      \
  }
  CAND(0, 0, 0, 0, 13, 2, 0, 6, 1)
  CAND(1, 0, 1, 0, 14, 2, 1, 7, 0)
  CAND(2, 0, 2, 0, 15, 2, 2, 7, 1)
  CAND(3, 0, 3, 1, 0, 2, 3, 8, 0)
  CAND(4, 0, 4, 1, 1, 2, 4, 9, 0)
  CAND(5, 0, 5, 1, 2, 3, 0, 10, 0)
  CAND(6, 0, 6, 1, 3, 3, 1, 11, 0)
  CAND(7, 0, 7, 1, 4, 3, 2, 12, 0)
  CAND(8, 0, 8, 1, 5, 3, 3, 13, 0)
  CAND(9, 0, 9, 1, 6, 4, 2, 14, 0)
  CAND(10, 0, 10, 1, 7, 5, 0, 15, 0)
  CAND(11, 0, 11, 4, 0, 5, 1, -1, -1)
  CAND(12, 0, 12, 4, 1, 6, 0, -1, -1)
#undef CAND
  unsigned w2[16];
#pragma unroll
  for (int rr = 0; rr < 16; ++rr) {
    unsigned m = 0;
#pragma unroll
    for (int i = 0; i < 13; ++i) m = umax(m, cand[i]);
    m = umax(m, (unsigned)__shfl_xor((int)m, 16));
    m = umax(m, (unsigned)__shfl_xor((int)m, 32));
    w2[rr] = m;
#pragma unroll
    for (int i = 0; i < 13; ++i) cand[i] = (cand[i] == m) ? 0u : cand[i];
  }
  if (kg == 0) {
#pragma unroll
    for (int i = 0; i < 16; ++i) { lds[r * 32 + i] = win[0][i] & 127u; lds[r * 32 + 16 + i] = win[1][i] & 127u; }
  }
  __builtin_amdgcn_s_waitcnt(0);
  __builtin_amdgcn_wave_barrier();
  const float cv0 = unordf(w2[0] & ~255u);
  float sum = 0.f;
#pragma unroll
  for (int rr = 0; rr < 16; ++rr) sum += __expf(unordf(w2[rr] & ~255u) - cv0);
  const float inv = 1.f / sum;
  const size_t ob = ((size_t)(row0 + r) * 8 + h) * 16;
#pragma unroll
  for (int q = 0; q < 4; ++q) {
    const unsigned wk = sel4(kg, w2[q], w2[4 + q], w2[8 + q], w2[12 + q]);
    const int a = (wk >> 4) & 15, bb = wk & 15;
    const int i1 = (int)lds[r * 32 + a], i2 = (int)lds[r * 32 + 16 + bb];
    p.eid[ob + kg * 4 + q] = i1 * 128 + i2;
    p.gate[ob + kg * 4 + q] = __expf(unordf(wk & ~255u) - cv0) * inv;
  }
  __builtin_amdgcn_wave_barrier();
}

typedef __attribute__((ext_vector_type(2))) float f32x2;
DI float dot16_fp8(u32x4 u, const float* x, float c) {
  const unsigned d[4] = {u[0], u[1], u[2], u[3]};
#pragma unroll
  for (int i = 0; i < 4; ++i) {
    f32x2 a = __builtin_amdgcn_cvt_pk_f32_fp8((int)d[i], false);
    f32x2 b = __builtin_amdgcn_cvt_pk_f32_fp8((int)d[i], true);
    c += a[0] * x[4 * i] + a[1] * x[4 * i + 1] + b[0] * x[4 * i + 2] + b[1] * x[4 * i + 3];
  }
  return c;
}
DI void axpy16_fp8(float* o, float w, u32x4 u) {
  const unsigned d[4] = {u[0], u[1], u[2], u[3]};
#pragma unroll
  for (int i = 0; i < 4; ++i) {
    f32x2 a = __builtin_amdgcn_cvt_pk_f32_fp8((int)d[i], false);
    f32x2 b = __builtin_amdgcn_cvt_pk_f32_fp8((int)d[i], true);
    o[4 * i] += w * a[0]; o[4 * i + 1] += w * a[1]; o[4 * i + 2] += w * b[0]; o[4 * i + 3] += w * b[1];
  }
}

DI void peer_expert_wave(const Params& p, int row) {
  const int lane = __builtin_amdgcn_mbcnt_hi(-1, __builtin_amdgcn_mbcnt_lo(-1, 0));
  float xf[16];
  {
    const uint4 x0 = *(const uint4*)&G(p.A2)[(size_t)row * 1024 + lane * 16];
    const uint4 x1 = *(const uint4*)&G(p.A2)[(size_t)row * 1024 + lane * 16 + 8];
    xf[0] = bflo(x0.x); xf[1] = bfhi(x0.x); xf[2] = bflo(x0.y); xf[3] = bfhi(x0.y);
    xf[4] = bflo(x0.z); xf[5] = bfhi(x0.z); xf[6] = bflo(x0.w); xf[7] = bfhi(x0.w);
    xf[8] = bflo(x1.x); xf[9] = bfhi(x1.x); xf[10] = bflo(x1.y); xf[11] = bfhi(x1.y);
    xf[12] = bflo(x1.z); xf[13] = bfhi(x1.z); xf[14] = bflo(x1.w); xf[15] = bfhi(x1.w);
  }
  const float r2 = rsqrtf(p.ssq2[row] * (1.f / 1024.f) + EPS);
  const unsigned char AS1* EU8 = (const unsigned char AS1*)p.E8;
  const unsigned char AS1* EV8 = (const unsigned char AS1*)p.E8 + (size_t)16384 * 1024;
  float out[16];
#pragma unroll
  for (int i = 0; i < 16; ++i) out[i] = 0.f;
#pragma unroll 1
  for (int bt = 0; bt < 2; ++bt) {
    const int eidv = G(p.eid)[(size_t)row * 128 + bt * 64 + lane];
    const float gv = G(p.gate)[(size_t)row * 128 + bt * 64 + lane];
    const float rsu = G(p.rs)[eidv], rsv = G(p.rs)[16384 + eidv];
    float part[64];
#pragma unroll
    for (int e = 0; e < 64; ++e) {
      const int id = __builtin_amdgcn_readlane(eidv, e);
      const u32x4 u = *(const u32x4 AS1*)(EU8 + (size_t)id * 1024 + lane * 16);
      part[e] = dot16_fp8(u, xf, 0.f);
    }
#pragma unroll
    for (int off = 32; off > 0; off >>= 1) {
      const bool up = (lane & off) != 0;
#pragma unroll
      for (int i = 0; i < off; ++i) {
        const float a = part[i], bq = part[i + off];
        const float send = up ? a : bq, keep = up ? bq : a;
        part[i] = keep + __shfl_xor(send, off);
      }
    }
    const float wv = gv * geluf(part[0] * r2 * rsu) * rsv;
#pragma unroll 8
    for (int e = 0; e < 64; ++e) {
      const int id = __builtin_amdgcn_readlane(eidv, e);
      const float we = __int_as_float(__builtin_amdgcn_readlane(__float_as_int(wv), e));
      const u32x4 v = *(const u32x4 AS1*)(EV8 + (size_t)id * 1024 + lane * 16);
      axpy16_fp8(out, we, v);
    }
  }
  const float* hr = G(p.h2) + (size_t)row * 1024 + lane * 16;
  float hv[16];
  float ss = 0.f;
#pragma unroll
  for (int i = 0; i < 4; ++i) {
    float4 t = *(const float4*)&hr[i * 4];
    hv[4 * i] = t.x + out[4 * i]; hv[4 * i + 1] = t.y + out[4 * i + 1]; hv[4 * i + 2] = t.z + out[4 * i + 2]; hv[4 * i + 3] = t.w + out[4 * i + 3];
    ss += hv[4 * i] * hv[4 * i] + hv[4 * i + 1] * hv[4 * i + 1] + hv[4 * i + 2] * hv[4 * i + 2] + hv[4 * i + 3] * hv[4 * i + 3];
  }
  ss = wave_sum(ss);
  const float rsn = rsqrtf(ss * (1.f / 1024.f) + EPS);
  float* y = ((row < MP) ? (G(p.out) + O_YP + (size_t)row * 1024) : (G(p.out) + O_YS + (size_t)(row - MP) * 1024)) + lane * 16;
#pragma unroll
  for (int i = 0; i < 4; ++i) {
    float4 g4 = *(const float4*)&p.g_final[lane * 16 + i * 4];
    *(float4*)&y[i * 4] = make_float4(hv[4 * i] * rsn * g4.x, hv[4 * i + 1] * rsn * g4.y, hv[4 * i + 2] * rsn * g4.z, hv[4 * i + 3] * rsn * g4.w);
  }
}

DI void peer_u_wave(const Params& p, int row, float* wl  ) {
  const int lane = __builtin_amdgcn_mbcnt_hi(-1, __builtin_amdgcn_mbcnt_lo(-1, 0));
  float xf[16];
  {
    const u32x4 x0 = *(const u32x4 AS1*)((const u16 AS1*)p.A2 + (size_t)row * 1024 + lane * 16);
    const u32x4 x1 = *(const u32x4 AS1*)((const u16 AS1*)p.A2 + (size_t)row * 1024 + lane * 16 + 8);
    xf[0] = bflo(x0[0]); xf[1] = bfhi(x0[0]); xf[2] = bflo(x0[1]); xf[3] = bfhi(x0[1]);
    xf[4] = bflo(x0[2]); xf[5] = bfhi(x0[2]); xf[6] = bflo(x0[3]); xf[7] = bfhi(x0[3]);
    xf[8] = bflo(x1[0]); xf[9] = bfhi(x1[0]); xf[10] = bflo(x1[1]); xf[11] = bfhi(x1[1]);
    xf[12] = bflo(x1[2]); xf[13] = bfhi(x1[2]); xf[14] = bflo(x1[3]); xf[15] = bfhi(x1[3]);
  }
  const float r2 = rsqrtf(((const float AS1*)p.ssq2)[row] * (1.f / 1024.f) + EPS);
  const unsigned char AS1* EU8 = (const unsigned char AS1*)p.E8;
  const float AS1* rsp = (const float AS1*)p.rs;
#pragma unroll 1
  for (int bt = 0; bt < 2; ++bt) {
    const int eidv = ((const int AS1*)p.eid)[(size_t)row * 128 + bt * 64 + lane];
    const float gv = ((const float AS1*)p.gate)[(size_t)row * 128 + bt * 64 + lane];
    const float rsu = rsp[eidv], rsv = rsp[16384 + eidv];
    float part[64];
#pragma unroll
    for (int e = 0; e < 64; ++e) {
      const int id = __builtin_amdgcn_readlane(eidv, e);
      const u32x4 u = *(const u32x4 AS1*)(EU8 + (size_t)id * 1024 + lane * 16);
      part[e] = dot16_fp8(u, xf, 0.f);
    }
#pragma unroll
    for (int off = 32; off > 0; off >>= 1) {
      const bool up = (lane & off) != 0;
#pragma unroll
      for (int i = 0; i < off; ++i) {
        const float a = part[i], bq = part[i + off];
        const float send = up ? a : bq, keep = up ? bq : a;
        part[i] = keep + __shfl_xor(send, off);
      }
    }
    wl[bt * 64 + lane] = gv * geluf(part[0] * r2 * rsu) * rsv;
  }
}

DI void peer_v_group(const Params& p, int gw, int nw, int g, const float* wlw  ) {
  const int lane = __builtin_amdgcn_mbcnt_hi(-1, __builtin_amdgcn_mbcnt_lo(-1, 0));
  const unsigned char AS1* EV8 = (const unsigned char AS1*)p.E8 + (size_t)16384 * 1024;
  float out[4][16];
  int e0[4], e1[4];
  float w0[4], w1[4];
  bool valid[4];
#pragma unroll
  for (int ts = 0; ts < 4; ++ts) {
    const int k = g * 4 + ts;
    const int row = gw + k * nw;
    valid[ts] = row < MT;
#pragma unroll
    for (int i = 0; i < 16; ++i) out[ts][i] = 0.f;
    e0[ts] = 0x7fffffff; e1[ts] = 0x7fffffff; w0[ts] = 0.f; w1[ts] = 0.f;
    if (valid[ts]) {
      e0[ts] = ((const int AS1*)p.eid)[(size_t)row * 128 + lane];
      e1[ts] = ((const int AS1*)p.eid)[(size_t)row * 128 + 64 + lane];
      w0[ts] = wlw[k * 128 + lane];
      w1[ts] = wlw[k * 128 + 64 + lane];
    }
  }
#pragma unroll 1
  for (int r = 0; r < 8; ++r) {
#pragma unroll
    for (int ts = 0; ts < 4; ++ts) {
      unsigned long long m0 = __ballot((e0[ts] >> 11) == r);
      unsigned long long m1 = __ballot((e1[ts] >> 11) == r);
      while ((m0 | m1) != 0ull) {
        u32x4 v[8];
        float we[8];
#pragma unroll
        for (int k = 0; k < 8; ++k) {
          we[k] = 0.f;
          v[k] = (u32x4){0u, 0u, 0u, 0u};
          if ((m0 | m1) != 0ull) {
            int l, id;
            if (m0 != 0ull) {
              l = __builtin_ctzll(m0); m0 &= m0 - 1ull;
              id = __builtin_amdgcn_readlane(e0[ts], l);
              we[k] = __int_as_float(__builtin_amdgcn_readlane(__float_as_int(w0[ts]), l));
            } else {
              l = __builtin_ctzll(m1); m1 &= m1 - 1ull;
              id = __builtin_amdgcn_readlane(e1[ts], l);
              we[k] = __int_as_float(__builtin_amdgcn_readlane(__float_as_int(w1[ts]), l));
            }
            v[k] = *(const u32x4 AS1*)(EV8 + (size_t)id * 1024 + lane * 16);
          }
        }
#pragma unroll
        for (int k = 0; k < 8; ++k) axpy16_fp8(out[ts], we[k], v[k]);
      }
    }
  }
#pragma unroll
  for (int ts = 0; ts < 4; ++ts) {
    if (!valid[ts]) continue;
    const int row = gw + (g * 4 + ts) * nw;
    const float AS1* hr = (const float AS1*)p.h2 + (size_t)row * 1024 + lane * 16;
    float hv[16];
    float ss = 0.f;
#pragma unroll
    for (int i = 0; i < 4; ++i) {
      f32x4 t = *(const f32x4 AS1*)&hr[i * 4];
      hv[4 * i] = t[0] + out[ts][4 * i]; hv[4 * i + 1] = t[1] + out[ts][4 * i + 1]; hv[4 * i + 2] = t[2] + out[ts][4 * i + 2]; hv[4 * i + 3] = t[3] + out[ts][4 * i + 3];
      ss += hv[4 * i] * hv[4 * i] + hv[4 * i + 1] * hv[4 * i + 1] + hv[4 * i + 2] * hv[4 * i + 2] + hv[4 * i + 3] * hv[4 * i + 3];
    }
    ss = wave_sum(ss);
    const float rsn = rsqrtf(ss * (1.f / 1024.f) + EPS);
    float AS1* y = ((row < MP) ? ((float AS1*)p.out + O_YP + (size_t)row * 1024) : ((float AS1*)p.out + O_YS + (size_t)(row - MP) * 1024)) + lane * 16;
#pragma unroll
    for (int i = 0; i < 4; ++i) {
      f32x4 g4 = *(const f32x4 AS1*)&((const float AS1*)p.g_final)[lane * 16 + i * 4];
      f32x4 o;
      o[0] = hv[4 * i] * rsn * g4[0]; o[1] = hv[4 * i + 1] * rsn * g4[1]; o[2] = hv[4 * i + 2] * rsn * g4[2]; o[3] = hv[4 * i + 3] * rsn * g4[3];
      *(f32x4 AS1*)&y[i * 4] = o;
    }
  }
}

__global__ void __launch_bounds__(256, 2) mega(Params pk) {
  __shared__ __attribute__((aligned(16))) char smem[65536];
  __shared__ Params sp;
  cg::grid_group grid = cg::this_grid();
  const int w = threadIdx.x >> 6;
  if (threadIdx.x == 0) sp = pk;
  __syncthreads();
  const Params& p = sp;
#ifndef DBL
#define DBL -1
#endif
#define REP(ph) for (int rp_ = 0; rp_ < ((DBL == (ph)) ? 2 : 1); ++rp_)
  REP(0) { phase0(p, smem); if (DBL == 0) grid.sync(); }
  grid.sync();
  REP(1) {
    int tm, tn;
    for (int it = 0; it * (int)gridDim.x < 129 * 34; ++it)
      if (xcd_tile(it, 129, 34, tm, tn)) gemm_tile<0, 1024>(p, p.A0, 1024, p.WtIn, tm, tn, smem);
    for (int u = blockIdx.x; u < 64; u += gridDim.x) gemm_tile<1, 1024>(p, p.Amem, 1024, p.WtMkv, u / 16, u % 16, smem);
  }
  grid.sync();
  REP(2) { phase2(p, smem); if (DBL == 2) grid.sync(); }
  grid.sync();
  REP(3) { phase3(p, smem); if (DBL == 3) grid.sync(); }
  grid.sync();
  REP(4) phase4(p);
  grid.sync();
  { int tm, tn; for (int it = 0; it * (int)gridDim.x < 257 * 8; ++it) if (xcd_tile(it, 257, 8, tm, tn)) gemm_tile128<2, 768>(p, p.Amix, 768, p.WtOut, tm, tn, smem); }
  grid.sync();
  REP(6) { int tm, tn; for (int it = 0; it * (int)gridDim.x < 257 * 8; ++it) if (xcd_tile(it, 257, 8, tm, tn)) gemm_tile128<3, 1024>(p, p.A1, 1024, p.WtMq, tm, tn, smem); }
  sample_state_copy(p);
  grid.sync();
  REP(7) phase7(p, smem);
  grid.sync();
  { int tm, tn; for (int it = 0; it * (int)gridDim.x < 257 * 8; ++it) if (xcd_tile(it, 257, 8, tm, tn)) gemm_tile128<4, 1024>(p, p.attn, 1024, p.WtMo, tm, tn, smem); }
  grid.sync();
  REP(9) { int tm, tn; for (int it = 0; it * (int)gridDim.x < 129 * 16; ++it) if (xcd_tile(it, 129, 16, tm, tn)) gemm_tile<5, 1024>(p, p.A2, 1024, p.WtPq, tm, tn, smem); }
  grid.sync();
  REP(10) {
    unsigned* lds = (unsigned*)smem + w * 512;
    for (int it = blockIdx.x * 4 + w; it < 2056 * 8; it += gridDim.x * 4) peer_topk_wave(p, it, lds);
  }
  grid.sync();
  REP(11) {
    const int gw = blockIdx.x * 4 + w, nw = gridDim.x * 4;
    float* wlw = (float*)smem + w * (17 * 128);
    __syncthreads();
    for (int k = 0; gw + k * nw < MT && k < 17; ++k) peer_u_wave(p, gw + k * nw, wlw + k * 128);
    __builtin_amdgcn_s_waitcnt(0xc07f);
    __builtin_amdgcn_wave_barrier();
    for (int g = 0; (g * 4) * nw + gw < MT && g < 5; ++g) peer_v_group(p, gw, nw, g, wlw);
  }
}

extern "C" void kernel_launch(void* const* d_in, const int* in_sizes, int n_in, void* d_out, int out_size, void* d_ws, size_t ws_size,
                              hipStream_t stream) {
  static int grid_blocks = 0;
  if (!grid_blocks) {
    int dev = 0, cus = 0, per_cu = 0;
    (void)hipGetDevice(&dev);
    (void)hipDeviceGetAttribute(&cus, hipDeviceAttributeMultiprocessorCount, dev);
    (void)hipOccupancyMaxActiveBlocksPerMultiprocessor(&per_cu, mega, 256, 0);
    if (per_cu > 2) per_cu = 2;
    if (per_cu < 1) per_cu = 1;
    grid_blocks = cus * per_cu;
  }
  Params p{};
  const float* const* in = (const float* const*)d_in;
  p.x_prompt = in[0]; p.x_sample = in[1]; p.state_delta = in[2]; p.state_conv = in[3]; p.cw1 = in[4]; p.cw2 = in[5]; p.cw3 = in[6];
  p.cache_mem = in[7]; p.mem_prompt = in[8]; p.g_mix = in[9]; p.w_in = in[10]; p.conv_w = in[11]; p.a_log = in[12]; p.dt_bias = in[13];
  p.g_onorm = in[14]; p.w_out = in[15]; p.g_memq = in[16]; p.g_memkv = in[17]; p.w_mq = in[18]; p.w_mkv = in[19]; p.w_mo = in[20];
  p.g_ffn = in[21]; p.w_pq = in[22]; p.sub_keys = in[23]; p.expert_u = in[24]; p.expert_v = in[25]; p.g_final = in[26];
  p.out = (float*)d_out;
  char* ws = (char*)d_ws;
  size_t off = 0;
  auto take = [&](size_t bytes) { char* r = ws + off; off += (bytes + 255) & ~(size_t)255; return r; };
  p.WtIn = (u16*)take((size_t)NP * 1024 * 2);
  p.WtOut = (u16*)take((size_t)1024 * 768 * 2);
  p.WtMq = (u16*)take((size_t)1024 * 1024 * 2);
  p.WtMkv = (u16*)take((size_t)2048 * 1024 * 2);
  p.WtMo = (u16*)take((size_t)1024 * 1024 * 2);
  p.WtPq = (u16*)take((size_t)2048 * 1024 * 2);
  p.subkb = (u16*)take((size_t)262144 * 2);
  p.E8 = (unsigned char*)take((size_t)32768 * 1024);
  p.rs = (float*)take((size_t)32768 * 4);
  p.Amem = (u16*)take((size_t)1024 * 1024 * 2);
  p.gb = (float*)take((size_t)MT * 8 * 4);
  p.ssq1 = (float*)take((size_t)MT * 4);
  p.ssq2 = (float*)take((size_t)MT * 4);
  p.dl = (float*)take(2048 * 4);
  p.Kb = (u16*)take((size_t)16 * 65536 * 2);
  p.VTf = (u16*)take((size_t)16 * 65536 * 2);
  char* regA = take((size_t)MT * NP * 2);
  char* regB = take((size_t)2048 * DN_ITEM);
  p.proj = (u16*)regA;
  p.h1 = (float*)regA;
  p.h2 = (float*)(regA + (size_t)MT * 1024 * 4);
  p.pq = (u16*)regA;
  p.dnops = regB;
  p.A0 = (u16*)regB;
  p.A1 = (u16*)regB;
  p.qb = (u16*)(regB + (size_t)MT * 1024 * 2);
  p.attn = (u16*)regB;
  p.A2 = (u16*)(regB + (size_t)MT * 1024 * 2);
  p.eid = (int*)regB;
  p.gate = (float*)(regB + (size_t)MT * 128 * 4);
  char* ob = (char*)d_out;
  p.vT = (u16*)ob;
  p.osw = (u16*)(ob + (size_t)3 * MP * 256 * 2);
  p.lse = (float*)(ob + (size_t)3 * MP * 256 * 2 + (size_t)3 * MT * 256 * 2);
  char* sb = ob + O_SW3 * 4;
  p.odn = (u16*)sb;
  p.Amix = (u16*)(sb + (size_t)MT * 512 * 2);
  if (off > ws_size) { fprintf(stderr, "workspace too small: need %zu have %zu\n", off, ws_size); return; }
  void* args[] = {&p};
  hipError_t e = hipLaunchCooperativeKernel((void*)mega, dim3(grid_blocks), dim3(256), args, 0, stream);
  if (e != hipSuccess) fprintf(stderr, "coop launch failed: %s (grid %d)\n", hipGetErrorString(e), grid_blocks);
}
```

```cpp
#include <hip/hip_runtime.h>
#include <hip/hip_cooperative_groups.h>
#include <cstdio>
namespace cg = cooperative_groups;

typedef unsigned short u16;
typedef __attribute__((ext_vector_type(8))) short bf16x8;
typedef __attribute__((ext_vector_type(4))) float f32x4;
typedef __attribute__((ext_vector_type(2))) __bf16 bf2_t;

#define DI __device__ __forceinline__
#define MFMA(a, b, c) __builtin_amdgcn_mfma_f32_16x16x32_bf16((a), (b), (c), 0, 0, 0)

constexpr int MP = 32768, MS = 128, MT = 32896;
constexpr int NP = 4352;
constexpr int SEQ = 8192;
constexpr float EPS = 1e-6f;
constexpr size_t DN_ITEM = 73728;

constexpr size_t O_YP = 0, O_YS = 33554432, O_PDELTA = 33685504, O_PCONV = 33947648, O_PW1 = 33966080,
                 O_PW2 = 34228224, O_PW3 = 35276800, O_PMEM = 39471104, O_SDELTA = 41568256, O_SCONV = 43665408,
                 O_SW1 = 43812864, O_SW2 = 45910016, O_SW3 = 54298624;

struct Params {
  const float *x_prompt, *x_sample, *state_delta, *state_conv, *cw1, *cw2, *cw3, *cache_mem, *mem_prompt;
  const float *g_mix, *w_in, *conv_w, *a_log, *dt_bias, *g_onorm, *w_out, *g_memq, *g_memkv, *w_mq, *w_mkv, *w_mo;
  const float *g_ffn, *w_pq, *sub_keys, *expert_u, *expert_v, *g_final;
  float* out;
  u16 *WtIn, *WtOut, *WtMq, *WtMkv, *WtMo, *WtPq, *subkb, *Amem;
  unsigned char* E8;
  float* rs;
  float *gb, *ssq1, *ssq2, *dl;
  u16 *Kb, *VTf;
  u16* proj;
  float *h1, *h2;
  u16* pq;
  char* dnops;
  u16 *A0, *A1, *qb, *attn, *A2;
  int* eid;
  float* gate;
  u16 *vT, *osw, *odn, *Amix;
  float* lse;
  unsigned* bar;
  int never;
  int pad_;
};

#define AS1 __attribute__((address_space(1)))
template <typename T> DI T* G(T* q) { return q; }
typedef const bf16x8 AS1* gb8p;
typedef const u16 AS1* gu16p;
typedef __attribute__((ext_vector_type(4))) unsigned u32x4;
DI u16 f2bf(float x) { unsigned u = __float_as_uint(x); u += 0x7fffu + ((u >> 16) & 1u); return (u16)(u >> 16); }
DI float bf2f(u16 h) { return __uint_as_float(((unsigned)h) << 16); }
DI unsigned pack2(float a, float b) { return (unsigned)f2bf(a) | ((unsigned)f2bf(b) << 16); }
DI float bflo(unsigned d) { return __uint_as_float(d << 16); }
DI float bfhi(unsigned d) { return __uint_as_float(d & 0xffff0000u); }
DI bf16x8 pack8(f32x4 a, f32x4 b) {
  uint4 r; r.x = pack2(a[0], a[1]); r.y = pack2(a[2], a[3]); r.z = pack2(b[0], b[1]); r.w = pack2(b[2], b[3]);
  return __builtin_bit_cast(bf16x8, r);
}
DI float wave_sum(float v) {
#pragma unroll
  for (int o = 32; o > 0; o >>= 1) v += __shfl_xor(v, o);
  return v;
}
DI float wave_max(float v) {
#pragma unroll
  for (int o = 32; o > 0; o >>= 1) v = fmaxf(v, __shfl_xor(v, o));
  return v;
}
DI float siluf(float x) { return x / (1.f + __expf(-x)); }
DI float geluf(float x) { return 0.5f * x * (1.f + tanhf(0.7978845608028654f * (x + 0.044715f * x * x * x))); }
DI int permk(int kg, int j) { return (j < 4) ? (kg * 4 + j) : (16 + kg * 4 + (j - 4)); }
DI void cvt8(const float* __restrict__ s, u16* __restrict__ d) {
  float4 a = *(const float4*)s, b = *(const float4*)(s + 4);
  uint4 r; r.x = pack2(a.x, a.y); r.y = pack2(a.z, a.w); r.z = pack2(b.x, b.y); r.w = pack2(b.z, b.w);
  *(uint4*)d = r;
}
DI unsigned ordf(float f) { unsigned u = __float_as_uint(f); return (u & 0x80000000u) ? ~u : (u | 0x80000000u); }
DI float unordf(unsigned k) { unsigned u = (k & 0x80000000u) ? (k & 0x7fffffffu) : ~k; return __uint_as_float(u); }
DI unsigned umax(unsigned a, unsigned b) { return a > b ? a : b; }
template <typename T> DI T sel4(int L, T a, T b, T c, T d) { return L == 0 ? a : (L == 1 ? b : (L == 2 ? c : d)); }

#define AS3 __attribute__((address_space(3)))
template <int MODE, int K>
DI void gemm_tile(const Params& p, const u16* __restrict__ A, int lda, const u16* __restrict__ Bt, int tm, int tn,
                          char* smem) {
  const int tid = threadIdx.x, lane = tid & 63, w = tid >> 6;
  const int wm = w >> 1, wn = w & 1, r = lane & 15, kg = lane >> 4;
  f32x4 acc[8][4];
#pragma unroll
  for (int i = 0; i < 8; ++i)
#pragma unroll
    for (int j = 0; j < 4; ++j) acc[i][j] = (f32x4){0.f, 0.f, 0.f, 0.f};
  const int lr = lane >> 2, lkg = (lane & 3) ^ (lane >> 4);
  gu16p gA[4], gB[2];
#pragma unroll
  for (int i = 0; i < 4; ++i) gA[i] = (gu16p)A + (size_t)(tm * 256 + (w * 4 + i) * 16 + lr) * lda + lkg * 8;
#pragma unroll
  for (int i = 0; i < 2; ++i) gB[i] = (gu16p)Bt + (size_t)(tn * 128 + (w * 2 + i) * 16 + lr) * K + lkg * 8;
  const int frag_off = r * 64 + ((kg ^ (r >> 2)) * 16);
  __syncthreads();
#pragma unroll
  for (int i = 0; i < 4; ++i)
    __builtin_amdgcn_global_load_lds((const unsigned AS1*)(gA[i]), (unsigned AS3*)(smem + (w * 4 + i) * 1024), 16, 0, 0);
#pragma unroll
  for (int i = 0; i < 2; ++i)
    __builtin_amdgcn_global_load_lds((const unsigned AS1*)(gB[i]), (unsigned AS3*)(smem + 16384 + (w * 2 + i) * 1024), 16, 0, 0);
#pragma unroll 2
  for (int k = 0; k < K / 32; ++k) {
    __syncthreads();
    if (k + 1 < K / 32) {
      char* st = smem + ((k + 1) & 1) * 24576;
#pragma unroll
      for (int i = 0; i < 4; ++i)
        __builtin_amdgcn_global_load_lds((const unsigned AS1*)(gA[i] + (k + 1) * 32), (unsigned AS3*)(st + (w * 4 + i) * 1024), 16, 0, 0);
#pragma unroll
      for (int i = 0; i < 2; ++i)
        __builtin_amdgcn_global_load_lds((const unsigned AS1*)(gB[i] + (k + 1) * 32), (unsigned AS3*)(st + 16384 + (w * 2 + i) * 1024), 16, 0, 0);
    }
    const char* sa = smem + (k & 1) * 24576;
    const char* sb = sa + 16384;
    bf16x8 af[8], bfr[4];
#pragma unroll
    for (int i = 0; i < 8; ++i) af[i] = *(const bf16x8*)(sa + (wm * 8 + i) * 1024 + frag_off);
#pragma unroll
    for (int i = 0; i < 4; ++i) bfr[i] = *(const bf16x8*)(sb + (wn * 4 + i) * 1024 + frag_off);
#pragma unroll
    for (int mt = 0; mt < 8; ++mt)
#pragma unroll
      for (int nt = 0; nt < 4; ++nt) acc[mt][nt] = MFMA(bfr[nt], af[mt], acc[mt][nt]);
  }
#pragma unroll
  for (int mt = 0; mt < 8; ++mt) {
    const int row = tm * 256 + wm * 128 + mt * 16 + r;
    if (tm * 256 + wm * 128 + mt * 16 >= ((MODE == 1) ? 1024 : MT)) continue;
    float rs = 1.f, ssq = 0.f;
    if (MODE == 3) rs = rsqrtf(p.ssq1[row] * (1.f / 1024.f) + EPS);
    if (MODE == 5) rs = rsqrtf(p.ssq2[row] * (1.f / 1024.f) + EPS);
#pragma unroll
    for (int nt = 0; nt < 4; ++nt) {
      const int col = tn * 128 + wn * 64 + nt * 16 + kg * 4;
      f32x4 v = acc[mt][nt];
      if (MODE == 0) {
        uint2 o; o.x = pack2(v[0], v[1]); o.y = pack2(v[2], v[3]);
        *(uint2*)&p.proj[(size_t)row * NP + col] = o;
      } else if (MODE == 1) {
        *(float4*)&p.out[O_PMEM + (size_t)row * 2048 + col] = make_float4(v[0], v[1], v[2], v[3]);
      } else if (MODE == 2 || MODE == 4) {
        float4 rsd;
        const float* gn;
        if (MODE == 2) {
          rsd = (row < MP) ? *(const float4*)&p.x_prompt[(size_t)row * 1024 + col] : *(const float4*)&p.x_sample[(size_t)(row - MP) * 1024 + col];
          gn = p.g_memq;
        } else {
          rsd = *(const float4*)&p.h1[(size_t)row * 1024 + col];
          gn = p.g_ffn;
        }
        float4 h = make_float4(rsd.x + v[0], rsd.y + v[1], rsd.z + v[2], rsd.w + v[3]);
        float4 g4 = *(const float4*)&gn[col];
        ssq += h.x * h.x + h.y * h.y + h.z * h.z + h.w * h.w;
        uint2 o; o.x = pack2(h.x * g4.x, h.y * g4.y); o.y = pack2(h.z * g4.z, h.w * g4.w);
        if (MODE == 2) { *(float4*)&p.h1[(size_t)row * 1024 + col] = h; *(uint2*)&p.A1[(size_t)row * 1024 + col] = o; }
        else { *(float4*)&p.h2[(size_t)row * 1024 + col] = h; *(uint2*)&p.A2[(size_t)row * 1024 + col] = o; }
      } else if (MODE == 3) {
        uint2 o; o.x = pack2(v[0] * rs, v[1] * rs); o.y = pack2(v[2] * rs, v[3] * rs);
        *(uint2*)&p.qb[(size_t)row * 1024 + col] = o;
      } else {
        uint2 o; o.x = pack2(v[0] * rs, v[1] * rs); o.y = pack2(v[2] * rs, v[3] * rs);
        *(uint2*)&p.pq[(size_t)row * 2048 + col] = o;
      }
    }
    if (MODE == 2 || MODE == 4) {
      ssq += __shfl_xor(ssq, 16);
      ssq += __shfl_xor(ssq, 32);
      if (kg == 0) atomicAdd((MODE == 2) ? &p.ssq1[row] : &p.ssq2[row], ssq);
    }
  }
}

template <int MODE, int K>
DI void gemm_tile128(const Params& p, const u16* __restrict__ A, int lda, const u16* __restrict__ Bt, int tm, int tn,
                          char* smem) {
  const int tid = threadIdx.x, lane = tid & 63, w = tid >> 6;
  const int wm = w >> 1, wn = w & 1, r = lane & 15, kg = lane >> 4;
  f32x4 acc[4][4];
#pragma unroll
  for (int i = 0; i < 4; ++i)
#pragma unroll
    for (int j = 0; j < 4; ++j) acc[i][j] = (f32x4){0.f, 0.f, 0.f, 0.f};
  const int lr = lane >> 2, lkg = (lane & 3) ^ (lane >> 4);
  gu16p gA[4], gB[4];
#pragma unroll
  for (int i = 0; i < 4; ++i) {
    const int sub = w * 4 + i, mt = sub >> 1, ks = sub & 1;
    gA[i] = (gu16p)A + (size_t)(tm * 128 + mt * 16 + lr) * lda + ks * 32 + lkg * 8;
    gB[i] = (gu16p)Bt + (size_t)(tn * 128 + mt * 16 + lr) * K + ks * 32 + lkg * 8;
  }
  const int frag_off = r * 64 + ((kg ^ (r >> 2)) * 16);
  __syncthreads();
#pragma unroll
  for (int i = 0; i < 4; ++i) {
    __builtin_amdgcn_global_load_lds((const unsigned AS1*)(gA[i]), (unsigned AS3*)(smem + (w * 4 + i) * 1024), 16, 0, 0);
    __builtin_amdgcn_global_load_lds((const unsigned AS1*)(gB[i]), (unsigned AS3*)(smem + 16384 + (w * 4 + i) * 1024), 16, 0, 0);
  }
#pragma unroll 2
  for (int k = 0; k < K / 64; ++k) {
    __syncthreads();
    if (k + 1 < K / 64) {
      char* st = smem + ((k + 1) & 1) * 32768;
#pragma unroll
      for (int i = 0; i < 4; ++i) {
        __builtin_amdgcn_global_load_lds((const unsigned AS1*)(gA[i] + (k + 1) * 64), (unsigned AS3*)(st + (w * 4 + i) * 1024), 16, 0, 0);
        __builtin_amdgcn_global_load_lds((const unsigned AS1*)(gB[i] + (k + 1) * 64), (unsigned AS3*)(st + 16384 + (w * 4 + i) * 1024), 16, 0, 0);
      }
    }
    const char* sa = smem + (k & 1) * 32768;
    const char* sb = sa + 16384;
#pragma unroll
    for (int ks = 0; ks < 2; ++ks) {
      bf16x8 af[4], bfr[4];
#pragma unroll
      for (int i = 0; i < 4; ++i) {
        af[i] = *(const bf16x8*)(sa + ((wm * 4 + i) * 2 + ks) * 1024 + frag_off);
        bfr[i] = *(const bf16x8*)(sb + ((wn * 4 + i) * 2 + ks) * 1024 + frag_off);
      }
#pragma unroll
      for (int mt = 0; mt < 4; ++mt)
#pragma unroll
        for (int nt = 0; nt < 4; ++nt) acc[mt][nt] = MFMA(bfr[nt], af[mt], acc[mt][nt]);
    }
  }
#pragma unroll
  for (int mt = 0; mt < 4; ++mt) {
    const int row = tm * 128 + wm * 64 + mt * 16 + r;
    float rs = 1.f, ssq = 0.f;
    if (MODE == 3) rs = rsqrtf(p.ssq1[row] * (1.f / 1024.f) + EPS);
    if (MODE == 5) rs = rsqrtf(p.ssq2[row] * (1.f / 1024.f) + EPS);
#pragma unroll
    for (int nt = 0; nt < 4; ++nt) {
      const int col = tn * 128 + wn * 64 + nt * 16 + kg * 4;
      f32x4 v = acc[mt][nt];
      if (MODE == 0) {
        uint2 o; o.x = pack2(v[0], v[1]); o.y = pack2(v[2], v[3]);
        *(uint2*)&p.proj[(size_t)row * NP + col] = o;
      } else if (MODE == 1) {
        *(float4*)&p.out[O_PMEM + (size_t)row * 2048 + col] = make_float4(v[0], v[1], v[2], v[3]);
      } else if (MODE == 2 || MODE == 4) {
        float4 rsd;
        const float* gn;
        if (MODE == 2) {
          rsd = (row < MP) ? *(const float4*)&p.x_prompt[(size_t)row * 1024 + col] : *(const float4*)&p.x_sample[(size_t)(row - MP) * 1024 + col];
          gn = p.g_memq;
        } else {
          rsd = *(const float4*)&p.h1[(size_t)row * 1024 + col];
          gn = p.g_ffn;
        }
        float4 h = make_float4(rsd.x + v[0], rsd.y + v[1], rsd.z + v[2], rsd.w + v[3]);
        float4 g4 = *(const float4*)&gn[col];
        ssq += h.x * h.x + h.y * h.y + h.z * h.z + h.w * h.w;
        uint2 o; o.x = pack2(h.x * g4.x, h.y * g4.y); o.y = pack2(h.z * g4.z, h.w * g4.w);
        if (MODE == 2) { *(float4*)&p.h1[(size_t)row * 1024 + col] = h; *(uint2*)&p.A1[(size_t)row * 1024 + col] = o; }
        else { *(float4*)&p.h2[(size_t)row * 1024 + col] = h; *(uint2*)&p.A2[(size_t)row * 1024 + col] = o; }
      } else if (MODE == 3) {
        uint2 o; o.x = pack2(v[0] * rs, v[1] * rs); o.y = pack2(v[2] * rs, v[3] * rs);
        *(uint2*)&p.qb[(size_t)row * 1024 + col] = o;
      } else {
        uint2 o; o.x = pack2(v[0] * rs, v[1] * rs); o.y = pack2(v[2] * rs, v[3] * rs);
        *(uint2*)&p.pq[(size_t)row * 2048 + col] = o;
      }
    }
    if (MODE == 2 || MODE == 4) {
      ssq += __shfl_xor(ssq, 16);
      ssq += __shfl_xor(ssq, 32);
      if (kg == 0) atomicAdd((MODE == 2) ? &p.ssq1[row] : &p.ssq2[row], ssq);
    }
  }
}

DI bool xcd_tile(int it, int nM, int nN, int& tm, int& tn) {
  const int per = gridDim.x >> 3;
  const int xcd = blockIdx.x & 7, li = blockIdx.x >> 3;
  const int i = (it * 8 + xcd) * per + li;
  if (i >= nM * nN) return false;
  const int panel = i / (8 * nN), within = i - panel * 8 * nN;
  const int rows = (nM - panel * 8) < 8 ? (nM - panel * 8) : 8;
  tn = within / rows;
  tm = panel * 8 + (within - tn * rows);
  return true;
}

DI void tr_tile(const float* __restrict__ W, int ldw, int nsrc0, u16* __restrict__ Wt, int K, int k0, int n0, float* tile) {
  const int tid = threadIdx.x;
  const int n = tid & 63, kq = tid >> 6;
  __syncthreads();
#pragma unroll
  for (int i = 0; i < 16; ++i) { int kk = kq + 4 * i; tile[kk * 65 + n] = W[(size_t)(k0 + kk) * ldw + nsrc0 + n]; }
  __syncthreads();
  const int nn = tid >> 2, ks = (tid & 3) * 16;
  unsigned o[8];
#pragma unroll
  for (int i = 0; i < 8; ++i) o[i] = pack2(tile[(ks + 2 * i) * 65 + nn], tile[(ks + 2 * i + 1) * 65 + nn]);
  u16* d = Wt + (size_t)(n0 + nn) * K + k0 + ks;
  *(uint4*)d = make_uint4(o[0], o[1], o[2], o[3]);
  *(uint4*)(d + 8) = make_uint4(o[4], o[5], o[6], o[7]);
}

DI void phase0(const Params& p, char* smem) {
  const int tid = threadIdx.x, lane = tid & 63, w = tid >> 6;
  const size_t gtid = (size_t)blockIdx.x * 256 + tid, gsz = (size_t)gridDim.x * 256;
  {
    const float* eu = p.expert_u;
    const float* ev = p.expert_v;
    unsigned char* e8 = p.E8;
    float* rsp = p.rs;
    const int sub = lane & 15, rq = lane >> 4;
    for (int er0 = (blockIdx.x * 4 + w) * 4; er0 < 32768; er0 += gridDim.x * 16) {
      const int er = er0 + rq;
      const float* src = (er < 16384) ? (eu + (size_t)er * 1024) : (ev + (size_t)(er - 16384) * 1024);
      float4 v[16];
      float am = 0.f;
#pragma unroll
      for (int i = 0; i < 16; ++i) {
        v[i] = *(const float4*)&src[(i >> 2) * 256 + sub * 16 + (i & 3) * 4];
        am = fmaxf(am, fmaxf(fmaxf(fabsf(v[i].x), fabsf(v[i].y)), fmaxf(fabsf(v[i].z), fabsf(v[i].w))));
      }
      am = fmaxf(am, __shfl_xor(am, 1)); am = fmaxf(am, __shfl_xor(am, 2));
      am = fmaxf(am, __shfl_xor(am, 4)); am = fmaxf(am, __shfl_xor(am, 8));
      const float sc = (am > 0.f) ? 224.f / am : 1.f;
#pragma unroll
      for (int c = 0; c < 4; ++c) {
        int o[4];
#pragma unroll
        for (int i = 0; i < 4; ++i) {
          const float4 t4 = v[c * 4 + i];
          int t = __builtin_amdgcn_cvt_pk_fp8_f32(t4.x * sc, t4.y * sc, 0, false);
          o[i] = __builtin_amdgcn_cvt_pk_fp8_f32(t4.z * sc, t4.w * sc, t, true);
        }
        *(uint4*)&e8[(size_t)er * 1024 + c * 256 + sub * 16] = make_uint4((unsigned)o[0], (unsigned)o[1], (unsigned)o[2], (unsigned)o[3]);
      }
      if (sub == 0) rsp[er] = (am > 0.f) ? am * (1.f / 224.f) : 1.f;
    }
  }
  for (size_t i = gtid; i < 262144 / 8; i += gsz) cvt8(p.sub_keys + i * 8, p.subkb + i * 8);
  for (size_t i = gtid; i < MT; i += gsz) { p.ssq1[i] = 0.f; p.ssq2[i] = 0.f; }
  float* wl = (float*)smem;
  __syncthreads();
  for (int i = tid; i < 2048; i += 256) {
    const int k = i >> 1, hf = i & 1;
    float4 t = *(const float4*)&p.w_in[(size_t)k * 4360 + 1536 + hf * 4];
    wl[(hf * 4 + 0) * 1024 + k] = t.x; wl[(hf * 4 + 1) * 1024 + k] = t.y; wl[(hf * 4 + 2) * 1024 + k] = t.z; wl[(hf * 4 + 3) * 1024 + k] = t.w;
  }
  __syncthreads();
  const float* xpp = p.x_prompt;
  const float* xsp = p.x_sample;
  const float* mpp = p.mem_prompt;
  const float* gmx = p.g_mix;
  const float* gmk = p.g_memkv;
  u16* a0p = p.A0;
  u16* amp = p.Amem;
  {
    const int sub = lane & 15, rq = lane >> 4;
    for (int row0 = (blockIdx.x * 4 + w) * 4; row0 < MT + 1024; row0 += gridDim.x * 16) {
      const int row = row0 + rq;
      const float* src; const float* g; u16* dst;
      if (row < MP) { src = xpp + (size_t)row * 1024; g = gmx; dst = a0p + (size_t)row * 1024; }
      else if (row < MT) { src = xsp + (size_t)(row - MP) * 1024; g = gmx; dst = a0p + (size_t)row * 1024; }
      else { src = mpp + (size_t)(row - MT) * 1024; g = gmk; dst = amp + (size_t)(row - MT) * 1024; }
      float4 v[16];
      float ss = 0.f;
#pragma unroll
      for (int i = 0; i < 16; ++i) { v[i] = *(const float4*)&src[i * 64 + sub * 4]; ss += v[i].x * v[i].x + v[i].y * v[i].y + v[i].z * v[i].z + v[i].w * v[i].w; }
      ss += __shfl_xor(ss, 1); ss += __shfl_xor(ss, 2); ss += __shfl_xor(ss, 4); ss += __shfl_xor(ss, 8);
      const float rs = rsqrtf(ss * (1.f / 1024.f) + EPS);
      float d8[8] = {0.f, 0.f, 0.f, 0.f, 0.f, 0.f, 0.f, 0.f};
#pragma unroll
      for (int i = 0; i < 16; ++i) {
        float4 g4 = *(const float4*)&g[i * 64 + sub * 4];
        float y[4] = {v[i].x * rs * g4.x, v[i].y * rs * g4.y, v[i].z * rs * g4.z, v[i].w * rs * g4.w};
        uint2 o; o.x = pack2(y[0], y[1]); o.y = pack2(y[2], y[3]);
        *(uint2*)&dst[i * 64 + sub * 4] = o;
        if (row < MT) {
#pragma unroll
          for (int j = 0; j < 8; ++j) {
            float4 wv = *(const float4*)&wl[j * 1024 + i * 64 + sub * 4];
            d8[j] += y[0] * wv.x + y[1] * wv.y + y[2] * wv.z + y[3] * wv.w;
          }
        }
      }
      if (row < MT) {
#pragma unroll
        for (int j = 0; j < 8; ++j) {
          d8[j] += __shfl_xor(d8[j], 1); d8[j] += __shfl_xor(d8[j], 2); d8[j] += __shfl_xor(d8[j], 4); d8[j] += __shfl_xor(d8[j], 8);
        }
        if (sub < 4) {
          float ag = sel4(sub, d8[0], d8[1], d8[2], d8[3]);
          float bg = sel4(sub, d8[4], d8[5], d8[6], d8[7]);
          float xs = ag + p.dt_bias[sub];
          float sp = (xs > 20.f) ? xs : log1pf(expf(xs));
          p.gb[(size_t)row * 8 + sub] = -expf(p.a_log[sub]) * sp;
          p.gb[(size_t)row * 8 + 4 + sub] = 1.f / (1.f + expf(-bg));
        }
      }
    }
  }
  __syncthreads();
  float* tile = (float*)smem;
  for (int j = blockIdx.x; j < 2816; j += gridDim.x) {
    int t = j;
    if (t < 1088) { int kt = t / 68, nt = t % 68; int n0 = nt * 64; tr_tile(p.w_in, 4360, n0 + (n0 >= 1536 ? 8 : 0), p.WtIn, 1024, kt * 64, n0, tile); continue; }
    t -= 1088;
    if (t < 192) { int kt = t / 16, nt = t % 16; tr_tile(p.w_out, 1024, nt * 64, p.WtOut, 768, kt * 64, nt * 64, tile); continue; }
    t -= 192;
    if (t < 256) { int kt = t / 16, nt = t % 16; tr_tile(p.w_mq, 1024, nt * 64, p.WtMq, 1024, kt * 64, nt * 64, tile); continue; }
    t -= 256;
    if (t < 512) { int kt = t / 32, nt = t % 32; tr_tile(p.w_mkv, 2048, nt * 64, p.WtMkv, 1024, kt * 64, nt * 64, tile); continue; }
    t -= 512;
    if (t < 256) { int kt = t / 16, nt = t % 16; tr_tile(p.w_mo, 1024, nt * 64, p.WtMo, 1024, kt * 64, nt * 64, tile); continue; }
    t -= 256;
    { int kt = t / 32, nt = t % 32; tr_tile(p.w_pq, 2048, nt * 64, p.WtPq, 1024, kt * 64, nt * 64, tile); }
  }
}

DI void dn_prep(const Params& p, int item, char* smem) {
  u16* qs = (u16*)smem;
  u16* ksm = qs + 64 * 136;
  float* sL = (float*)(ksm + 64 * 136);
  float* sgc = sL + 64 * 64;
  float* sbeta = sgc + 64;
  u16* sU = (u16*)sL;
  u16* sW = qs;
  const int tid = threadIdx.x, lane = tid & 63, w = tid >> 6, r = lane & 15, kg = lane >> 4;
  const int bh = item >> 7, n = item & 127, b = bh >> 2, h = bh & 3;
  const int t0 = n * 64;
  const size_t rowbase = (size_t)b * SEQ;
  char* ops = p.dnops + (size_t)item * DN_ITEM;
  __syncthreads();
  if (tid < 64) {
    float gv = p.gb[(rowbase + t0 + tid) * 8 + h];
    float bv = p.gb[(rowbase + t0 + tid) * 8 + 4 + h];
#pragma unroll
    for (int o = 1; o < 64; o <<= 1) { float t = __shfl_up(gv, o); if (lane >= o) gv += t; }
    sgc[tid] = gv; sbeta[tid] = bv;
    if (tid == 63) p.dl[item] = __expf(gv);
  }
#pragma unroll 4
  for (int ps = 0; ps < 8; ++ps) {
    const int combo = ps * 16 + (tid >> 4);
    const int tt = combo & 63, part = combo >> 6, sub = tid & 15;
    const int col = part * 512 + h * 128 + sub * 8;
    float y[8] = {0.f, 0.f, 0.f, 0.f, 0.f, 0.f, 0.f, 0.f};
#pragma unroll
    for (int j = 0; j < 4; ++j) {
      const int t = t0 + tt - 3 + j;
      if (t >= 0) {
        uint4 xv = *(const uint4*)&p.proj[(rowbase + t) * NP + col];
        float4 wa = *(const float4*)&p.conv_w[j * 1536 + col], wb = *(const float4*)&p.conv_w[j * 1536 + col + 4];
        y[0] += bflo(xv.x) * wa.x; y[1] += bfhi(xv.x) * wa.y; y[2] += bflo(xv.y) * wa.z; y[3] += bfhi(xv.y) * wa.w;
        y[4] += bflo(xv.z) * wb.x; y[5] += bfhi(xv.z) * wb.y; y[6] += bflo(xv.w) * wb.z; y[7] += bfhi(xv.w) * wb.w;
      }
    }
    float ss = 0.f;
#pragma unroll
    for (int e = 0; e < 8; ++e) { y[e] = siluf(y[e]); ss += y[e] * y[e]; }
    ss += __shfl_xor(ss, 1); ss += __shfl_xor(ss, 2); ss += __shfl_xor(ss, 4); ss += __shfl_xor(ss, 8);
    float sc = rsqrtf(ss + EPS) * (part == 0 ? 0.08838834764831845f : 1.f);
    uint4 o; o.x = pack2(y[0] * sc, y[1] * sc); o.y = pack2(y[2] * sc, y[3] * sc); o.z = pack2(y[4] * sc, y[5] * sc); o.w = pack2(y[6] * sc, y[7] * sc);
    *(uint4*)&((part == 0 ? qs : ksm)[tt * 136 + sub * 8]) = o;
  }
  __syncthreads();
  const float gcl = sgc[63];
  {
    f32x4 aL[4], aA[4];
#pragma unroll
    for (int i = 0; i < 4; ++i) { aL[i] = (f32x4){0.f, 0.f, 0.f, 0.f}; aA[i] = (f32x4){0.f, 0.f, 0.f, 0.f}; }
#pragma unroll
    for (int ks = 0; ks < 4; ++ks) {
      bf16x8 kI = *(const bf16x8*)&ksm[(w * 16 + r) * 136 + ks * 32 + kg * 8];
      bf16x8 qI = *(const bf16x8*)&qs[(w * 16 + r) * 136 + ks * 32 + kg * 8];
#pragma unroll
      for (int nt = 0; nt < 4; ++nt) {
        bf16x8 kJ = *(const bf16x8*)&ksm[(nt * 16 + r) * 136 + ks * 32 + kg * 8];
        aL[nt] = MFMA(kJ, kI, aL[nt]);
        aA[nt] = MFMA(kJ, qI, aA[nt]);
      }
    }
    const int i = w * 16 + r;
    const float gci = sgc[i], bi = sbeta[i];
    u16* aq = (u16*)(ops + 49152);
#pragma unroll
    for (int nt = 0; nt < 4; ++nt) {
      float lv[4], av[4];
#pragma unroll
      for (int jj = 0; jj < 4; ++jj) {
        const int j = nt * 16 + kg * 4 + jj;
        const float gam = (i >= j) ? __expf(gci - sgc[j]) : 0.f;
        lv[jj] = (i > j) ? aL[nt][jj] * bi * gam : 0.f;
        av[jj] = aA[nt][jj] * gam;
      }
      *(float4*)&sL[i * 64 + nt * 16 + kg * 4] = make_float4(lv[0], lv[1], lv[2], lv[3]);
      uint2 o; o.x = pack2(av[0], av[1]); o.y = pack2(av[2], av[3]);
      *(uint2*)&aq[((w * 2 + (nt >> 1)) * 64 + lane) * 8 + (nt & 1) * 4] = o;
    }
  }
  {
    u16* qg = (u16*)(ops + 16384);
    u16* kdT = (u16*)(ops + 32768);
#pragma unroll 1
    for (int i = 0; i < 4; ++i) {
      const int f = tid + 256 * i;
      const int mtks = f >> 6, l = f & 63, rr = l & 15, kgg = l >> 4;
      {
        const int mt = mtks >> 2, ks = mtks & 3, row = mt * 16 + rr;
        const float e = __expf(sgc[row]);
        uint2 a = *(const uint2*)&qs[row * 136 + ks * 32 + kgg * 4];
        uint2 c = *(const uint2*)&qs[row * 136 + ks * 32 + 16 + kgg * 4];
        uint4 o;
        o.x = pack2(bflo(a.x) * e, bfhi(a.x) * e); o.y = pack2(bflo(a.y) * e, bfhi(a.y) * e);
        o.z = pack2(bflo(c.x) * e, bfhi(c.x) * e); o.w = pack2(bflo(c.y) * e, bfhi(c.y) * e);
        *(uint4*)&qg[(size_t)f * 8] = o;
      }
      {
        const int mt = mtks >> 1, ks = mtks & 1, kdim = mt * 16 + rr;
        float v[8];
#pragma unroll
        for (int j = 0; j < 8; ++j) {
          const int c = ks * 32 + permk(kgg, j);
          v[j] = bf2f(ksm[c * 136 + kdim]) * __expf(gcl - sgc[c]);
        }
        uint4 o; o.x = pack2(v[0], v[1]); o.y = pack2(v[2], v[3]); o.z = pack2(v[4], v[5]); o.w = pack2(v[6], v[7]);
        *(uint4*)&kdT[(size_t)f * 8] = o;
      }
    }
  }
  __syncthreads();
  float x[64];
  if (tid < 128) {
    const int col = 1024 + h * 128 + tid;
    const float w0 = p.conv_w[col], w1 = p.conv_w[1536 + col], w2 = p.conv_w[3072 + col], w3 = p.conv_w[4608 + col];
    float xm3 = 0.f, xm2 = 0.f, xm1 = 0.f;
    if (t0 > 0) {
      xm3 = bf2f(p.proj[(rowbase + t0 - 3) * NP + col]);
      xm2 = bf2f(p.proj[(rowbase + t0 - 2) * NP + col]);
      xm1 = bf2f(p.proj[(rowbase + t0 - 1) * NP + col]);
    }
#pragma unroll
    for (int t = 0; t < 64; ++t) {
      float xc = bf2f(p.proj[(rowbase + t0 + t) * NP + col]);
      float yv = w0 * xm3 + w1 * xm2 + w2 * xm1 + w3 * xc;
      x[t] = siluf(yv) * sbeta[t];
      xm3 = xm2; xm2 = xm1; xm1 = xc;
    }
  } else {
    const int kc = tid - 128;
#pragma unroll
    for (int t = 0; t < 64; ++t) x[t] = bf2f(ksm[t * 136 + kc]) * sbeta[t] * __expf(sgc[t]);
  }
#pragma unroll
  for (int i = 1; i < 64; ++i) {
    float s = x[i];
#pragma unroll
    for (int j4 = 0; j4 < (i + 3) / 4; ++j4) {
      float4 l = *(const float4*)&sL[i * 64 + j4 * 4];
      s -= l.x * x[j4 * 4];
      if (j4 * 4 + 1 < i) s -= l.y * x[j4 * 4 + 1];
      if (j4 * 4 + 2 < i) s -= l.z * x[j4 * 4 + 2];
      if (j4 * 4 + 3 < i) s -= l.w * x[j4 * 4 + 3];
    }
    x[i] = s;
  }
  __syncthreads();
  if (tid < 128) {
#pragma unroll
    for (int t = 0; t < 64; ++t) sU[t * 128 + tid] = f2bf(x[t]);
  } else {
    const int kc = tid - 128;
#pragma unroll
    for (int t = 0; t < 64; ++t) sW[t * 136 + kc] = f2bf(-x[t]);
  }
  __syncthreads();
  {
    u16* nW = (u16*)ops;
    u16* u0 = (u16*)(ops + 57344);
#pragma unroll 1
    for (int i = 0; i < 4; ++i) {
      const int f = tid + 256 * i;
      const int mtks = f >> 6, l = f & 63, rr = l & 15, kgg = l >> 4;
      const int mt = mtks >> 2, ks = mtks & 3, row = mt * 16 + rr;
      uint2 a = *(const uint2*)&sW[row * 136 + ks * 32 + kgg * 4];
      uint2 c = *(const uint2*)&sW[row * 136 + ks * 32 + 16 + kgg * 4];
      *(uint4*)&nW[(size_t)f * 8] = make_uint4(a.x, a.y, c.x, c.y);
    }
#pragma unroll 1
    for (int i = 0; i < 8; ++i) {
      const int f = tid + 256 * i;
      const int smt = f >> 6, l = f & 63, rr = l & 15, kgg = l >> 4;
      const int s = smt >> 2, mt = smt & 3;
      u16 v0 = sU[(mt * 16 + kgg * 4 + 0) * 128 + s * 16 + rr];
      u16 v1 = sU[(mt * 16 + kgg * 4 + 1) * 128 + s * 16 + rr];
      u16 v2 = sU[(mt * 16 + kgg * 4 + 2) * 128 + s * 16 + rr];
      u16 v3 = sU[(mt * 16 + kgg * 4 + 3) * 128 + s * 16 + rr];
      *(uint2*)&u0[(size_t)f * 4] = make_uint2((unsigned)v0 | ((unsigned)v1 << 16), (unsigned)v2 | ((unsigned)v3 << 16));
    }
  }
}

DI void vt_tile(const Params& p, int item, char* smem) {
  u16* tile = (u16*)smem;
  const int tid = threadIdx.x;
  const int ptile = item & 127, gbh = item >> 7;
  const int h = gbh & 3, b = (gbh >> 2) & 3, g = gbh >> 4;
  const int dsh = g * 2, ln = SEQ >> dsh;
  const int pos0 = ptile * 64;
  const int rres = pos0 / ln, i0 = pos0 % ln;
  __syncthreads();
  {
    const int pr = tid >> 2, seg = (tid & 3) * 16;
    const int token = ((i0 + pr) << dsh) + rres;
    const u16* src = &p.proj[((size_t)b * SEQ + token) * NP + 2048 + g * 768 + 512 + h * 64 + seg];
    uint4 a = *(const uint4*)src, c = *(const uint4*)(src + 8);
    unsigned d[8] = {a.x, a.y, a.z, a.w, c.x, c.y, c.z, c.w};
#pragma unroll
    for (int e = 0; e < 8; ++e) *(unsigned*)&tile[pr * 66 + seg + e * 2] = d[e];
  }
  __syncthreads();
  {
    const int dh = tid >> 2, seg = (tid & 3) * 16;
    unsigned o[8];
#pragma unroll
    for (int e = 0; e < 8; ++e) o[e] = (unsigned)tile[(seg + 2 * e) * 66 + dh] | ((unsigned)tile[(seg + 2 * e + 1) * 66 + dh] << 16);
    u16* d = &p.vT[((size_t)gbh * 64 + dh) * SEQ + pos0 + seg];
    *(uint4*)d = make_uint4(o[0], o[1], o[2], o[3]);
    *(uint4*)(d + 8) = make_uint4(o[4], o[5], o[6], o[7]);
  }
}

DI void dn_sample(const Params& p, int item, char* smem) {
  float* sq = (float*)smem;
  float* sk = sq + 512;
  float* sv = sk + 512;
  float* red = sv + 512;
  const int tid = threadIdx.x, lane = tid & 63, w = tid >> 6;
  const int b = item >> 2, h = item & 3;
  __syncthreads();
  for (int c = tid; c < 384; c += 256) {
    const int part = c >> 7, cc = c & 127;
    const int col = part * 512 + h * 128 + cc;
    float xp[7];
#pragma unroll
    for (int j = 0; j < 3; ++j) xp[j] = p.state_conv[((size_t)b * 3 + j) * 1536 + col];
#pragma unroll
    for (int j = 0; j < 4; ++j) xp[3 + j] = bf2f(p.proj[((size_t)MP + b * 4 + j) * NP + col]);
    const float w0 = p.conv_w[col], w1 = p.conv_w[1536 + col], w2 = p.conv_w[3072 + col], w3 = p.conv_w[4608 + col];
    float* dst = part == 0 ? sq : (part == 1 ? sk : sv);
#pragma unroll
    for (int t = 0; t < 4; ++t) dst[t * 128 + cc] = siluf(w0 * xp[t] + w1 * xp[t + 1] + w2 * xp[t + 2] + w3 * xp[t + 3]);
  }
  __syncthreads();
  {
    float a0 = sq[w * 128 + lane], a1 = sq[w * 128 + 64 + lane];
    float s = wave_sum(a0 * a0 + a1 * a1);
    float sc = rsqrtf(s + EPS) * 0.08838834764831845f;
    sq[w * 128 + lane] = a0 * sc; sq[w * 128 + 64 + lane] = a1 * sc;
    float b0 = sk[w * 128 + lane], b1 = sk[w * 128 + 64 + lane];
    s = wave_sum(b0 * b0 + b1 * b1);
    sc = rsqrtf(s + EPS);
    sk[w * 128 + lane] = b0 * sc; sk[w * 128 + 64 + lane] = b1 * sc;
  }
  __syncthreads();
  const int v = tid & 127, half = tid >> 7;
  float S[64];
  const float* s0 = p.state_delta + (((size_t)b * 4 + h) * 128 + half * 64) * 128 + v;
#pragma unroll
  for (int i = 0; i < 64; ++i) S[i] = s0[(size_t)i * 128];
#pragma unroll 1
  for (int t = 0; t < 4; ++t) {
    const size_t row = (size_t)MP + b * 4 + t;
    const float a = __expf(p.gb[row * 8 + h]);
    const float beta = p.gb[row * 8 + 4 + h];
    float part = 0.f;
#pragma unroll
    for (int i = 0; i < 64; ++i) part += S[i] * sk[t * 128 + half * 64 + i];
    red[half * 128 + v] = part;
    __syncthreads();
    const float kS = red[v] + red[128 + v];
    const float u = beta * (sv[t * 128 + v] - a * kS);
    float po = 0.f;
#pragma unroll
    for (int i = 0; i < 64; ++i) { S[i] = a * S[i] + sk[t * 128 + half * 64 + i] * u; po += S[i] * sq[t * 128 + half * 64 + i]; }
    __syncthreads();
    red[half * 128 + v] = po;
    __syncthreads();
    if (half == 0) p.odn[row * 512 + h * 128 + v] = f2bf(red[v] + red[128 + v]);
    __syncthreads();
  }
  float* d = p.out + O_SDELTA + (((size_t)b * 4 + h) * 128 + half * 64) * 128 + v;
#pragma unroll
  for (int i = 0; i < 64; ++i) d[(size_t)i * 128] = S[i];
}

DI void phase2(const Params& p, char* smem) {
  const size_t gtid = (size_t)blockIdx.x * 256 + threadIdx.x, gsz = (size_t)gridDim.x * 256;
  for (int j = blockIdx.x; j < 2048 + 128 + 6144; j += gridDim.x) {
    if (j < 2048) dn_prep(p, j, smem);
    else if (j < 2048 + 128) dn_sample(p, j - 2048, smem);
    else vt_tile(p, j - 2176, smem);
  }
  for (size_t f = gtid; f < (size_t)16 * 8192; f += gsz) {
    {
      const size_t e0 = f * 8;
      const int bh = (int)(e0 >> 16), key = (int)((e0 >> 8) & 255), dh = (int)(e0 & 255);
      const int b = bh >> 2, h = bh & 3;
      cvt8(p.out + O_PMEM + (((size_t)b * 256 + key) * 2 + 0) * 1024 + h * 256 + dh, p.Kb + e0);
    }
    {
      const int l = (int)(f & 63), ks = (int)((f >> 6) & 7), nt = (int)((f >> 9) & 15), bh = (int)(f >> 13);
      const int b = bh >> 2, h = bh & 3, rr = l & 15, kgg = l >> 4;
      float v[8];
#pragma unroll
      for (int j = 0; j < 8; ++j) {
        const int key = ks * 32 + permk(kgg, j);
        v[j] = p.out[O_PMEM + (((size_t)b * 256 + key) * 2 + 1) * 1024 + h * 256 + nt * 16 + rr];
      }
      *(uint4*)&p.VTf[f * 8] = make_uint4(pack2(v[0], v[1]), pack2(v[2], v[3]), pack2(v[4], v[5]), pack2(v[6], v[7]));
    }
  }
  for (size_t i = gtid; i < 18432; i += gsz) {
    const int c = (int)(i % 1536), j = (int)((i / 1536) % 3), b = (int)(i / 4608);
    p.out[O_PCONV + i] = bf2f(p.proj[((size_t)b * SEQ + SEQ - 3 + j) * NP + c]);
  }
  for (int g = 0; g < 3; ++g) {
    const int W = 128 << (2 * g);
    const size_t off = (g == 0) ? O_PW1 : (g == 1 ? O_PW2 : O_PW3);
    const size_t n4 = (size_t)4 * W * 512 / 4;
    for (size_t i = gtid; i < n4; i += gsz) {
      const size_t e0 = i * 4;
      const int e = (int)(e0 & 511), ii = (int)((e0 >> 9) % W), b = (int)((e0 >> 9) / W);
      uint2 v = *(const uint2*)&p.proj[((size_t)b * SEQ + SEQ - W + ii) * NP + 2048 + g * 768 + 256 + e];
      *(float4*)&p.out[off + e0] = make_float4(bflo(v.x), bfhi(v.x), bflo(v.y), bfhi(v.y));
    }
  }
}

typedef __attribute__((ext_vector_type(2))) unsigned u32x2;
struct ScanOps { bf16x8 nW[4]; bf16x8 qg[4]; bf16x8 aq[2]; bf16x8 kd[4]; u32x2 u0; float dl; };

DI void scan_load(const Params& p, int bh, int s, int n, int j, int lane, ScanOps& o) {
  n = n > 127 ? 127 : n;
  const char AS1* base = (const char AS1*)p.dnops + (size_t)(bh * 128 + n) * DN_ITEM;
  gb8p negW = (gb8p)base;
  gb8p qg = (gb8p)(base + 16384);
  gb8p kdT = (gb8p)(base + 32768);
  gb8p aqk = (gb8p)(base + 49152);
  const u32x2 AS1* u0 = (const u32x2 AS1*)(base + 57344);
#pragma unroll
  for (int ks = 0; ks < 4; ++ks) o.nW[ks] = negW[(j * 4 + ks) * 64 + lane];
#pragma unroll
  for (int ks = 0; ks < 4; ++ks) o.qg[ks] = qg[(j * 4 + ks) * 64 + lane];
#pragma unroll
  for (int k2 = 0; k2 < 2; ++k2) o.aq[k2] = aqk[(j * 2 + k2) * 64 + lane];
#pragma unroll
  for (int mm = 0; mm < 2; ++mm)
#pragma unroll
    for (int k2 = 0; k2 < 2; ++k2) o.kd[mm * 2 + k2] = kdT[((2 * j + mm) * 2 + k2) * 64 + lane];
  o.u0 = u0[(s * 4 + j) * 64 + lane];
  o.dl = ((const float AS1*)p.dl)[bh * 128 + n];
}

DI void scan_step(const Params& p, const ScanOps& ops, int n, int b, int h, int s, int j, int lane, f32x4& S0, f32x4& S1,
                  bf16x8* sSb, u32x2* sUb) {
  const int r = lane & 15, kg = lane >> 4;
  bf16x8 sb[4];
#pragma unroll
  for (int ks = 0; ks < 4; ++ks) sb[ks] = sSb[ks * 64 + lane];
  f32x4 u = (f32x4){bflo(ops.u0[0]), bfhi(ops.u0[0]), bflo(ops.u0[1]), bfhi(ops.u0[1])};
#pragma unroll
  for (int ks = 0; ks < 4; ++ks) u = MFMA(ops.nW[ks], sb[ks], u);
  {
    u32x2 t; t[0] = pack2(u[0], u[1]); t[1] = pack2(u[2], u[3]);
    sUb[((j >> 1) * 64 + lane) * 2 + (j & 1)] = t;
  }
  __syncthreads();
  bf16x8 ub[2];
#pragma unroll
  for (int k2 = 0; k2 < 2; ++k2) ub[k2] = *(const bf16x8*)&sUb[(k2 * 64 + lane) * 2];
  f32x4 o = (f32x4){0.f, 0.f, 0.f, 0.f};
#pragma unroll
  for (int ks = 0; ks < 4; ++ks) o = MFMA(ops.qg[ks], sb[ks], o);
#pragma unroll
  for (int k2 = 0; k2 < 2; ++k2) o = MFMA(ops.aq[k2], ub[k2], o);
  S0 = S0 * ops.dl; S1 = S1 * ops.dl;
#pragma unroll
  for (int k2 = 0; k2 < 2; ++k2) { S0 = MFMA(ops.kd[k2], ub[k2], S0); S1 = MFMA(ops.kd[2 + k2], ub[k2], S1); }
  sSb[j * 64 + lane] = pack8(S0, S1);
#pragma unroll
  for (int jj = 0; jj < 4; ++jj) {
    const size_t token = (size_t)b * SEQ + n * 64 + j * 16 + kg * 4 + jj;
    G(p.odn)[token * 512 + h * 128 + s * 16 + r] = f2bf(o[jj]);
  }
  __syncthreads();
}

DI void dn_scan_block(const Params& p, int item, char* smem) {
  const int lane = threadIdx.x & 63, j = threadIdx.x >> 6, r = lane & 15, kg = lane >> 4;
  const int bh = item >> 3, s = item & 7, b = bh >> 2, h = bh & 3;
  bf16x8* sSb = (bf16x8*)smem;
  u32x2* sUb = (u32x2*)(smem + 4096);
  f32x4 S0 = (f32x4){0.f, 0.f, 0.f, 0.f}, S1 = (f32x4){0.f, 0.f, 0.f, 0.f};
  __syncthreads();
  sSb[j * 64 + lane] = pack8(S0, S1);
  ScanOps A, B;
  scan_load(p, bh, s, 0, j, lane, A);
  scan_load(p, bh, s, 1, j, lane, B);
  __syncthreads();
#pragma unroll 1
  for (int n0 = 0; n0 < 128; n0 += 2) {
    scan_step(p, A, n0, b, h, s, j, lane, S0, S1, sSb, sUb);
    scan_load(p, bh, s, n0 + 2, j, lane, A);
    scan_step(p, B, n0 + 1, b, h, s, j, lane, S0, S1, sSb, sUb);
    scan_load(p, bh, s, n0 + 3, j, lane, B);
  }
#pragma unroll
  for (int jj = 0; jj < 4; ++jj) {
    p.out[O_PDELTA + ((size_t)bh * 128 + 32 * j + kg * 4 + jj) * 128 + s * 16 + r] = S0[jj];
    p.out[O_PDELTA + ((size_t)bh * 128 + 32 * j + 16 + kg * 4 + jj) * 128 + s * 16 + r] = S1[jj];
  }
}

DI void sw_prompt_wave(const Params& p, int item) {
  const int lane = threadIdx.x & 63, r = lane & 15, kg = lane >> 4;
  const int qt = item & 511, gbh = item >> 9;
  const int h = gbh & 3, b = (gbh >> 2) & 3, g = gbh >> 4;
  const int dsh = 2 * g, ln = SEQ >> dsh;
  const int pos0 = qt * 16, rres = pos0 / ln, i0 = pos0 % ln;
  const int kbase = i0 - 144;
  const size_t rb = (size_t)b * SEQ;
  const int qoff = 2048 + g * 768 + h * 64, koff = qoff + 256;
  bf16x8 qf[2];
  {
    const size_t tok = rb + ((size_t)(i0 + r) << dsh) + rres;
#pragma unroll
    for (int ks = 0; ks < 2; ++ks) qf[ks] = *(const bf16x8*)&p.proj[tok * NP + qoff + ks * 32 + kg * 8];
  }
  f32x4 st[10];
#pragma unroll
  for (int mt = 0; mt < 10; ++mt) {
    int ki = kbase + mt * 16 + r; ki = ki < 0 ? 0 : ki;
    const size_t tok = rb + ((size_t)ki << dsh) + rres;
    f32x4 a = (f32x4){0.f, 0.f, 0.f, 0.f};
#pragma unroll
    for (int ks = 0; ks < 2; ++ks) {
      bf16x8 kf = *(const bf16x8*)&p.proj[tok * NP + koff + ks * 32 + kg * 8];
      a = MFMA(kf, qf[ks], a);
    }
    st[mt] = a;
  }
  const int qi = i0 + r;
  float mx = -3.0e38f;
#pragma unroll
  for (int mt = 0; mt < 10; ++mt)
#pragma unroll
    for (int j = 0; j < 4; ++j) {
      const int ki = kbase + mt * 16 + kg * 4 + j;
      const int d = qi - ki;
      const bool valid = (ki >= 0) && (d >= 0) && (d <= 128);
      const float sv = valid ? st[mt][j] * 0.125f : -3.0e38f;
      st[mt][j] = sv;
      mx = fmaxf(mx, sv);
    }
  mx = fmaxf(mx, __shfl_xor(mx, 16));
  mx = fmaxf(mx, __shfl_xor(mx, 32));
  float sum = 0.f;
#pragma unroll
  for (int mt = 0; mt < 10; ++mt)
#pragma unroll
    for (int j = 0; j < 4; ++j) {
      const float pv = (st[mt][j] > -1.0e38f) ? __expf(st[mt][j] - mx) : 0.f;
      st[mt][j] = pv;
      sum += pv;
    }
  sum += __shfl_xor(sum, 16);
  sum += __shfl_xor(sum, 32);
  const float inv = 1.f / sum;
  bf16x8 pf[5];
#pragma unroll
  for (int k2 = 0; k2 < 5; ++k2) pf[k2] = pack8(st[2 * k2], st[2 * k2 + 1]);
  const size_t qrow = rb + ((size_t)qi << dsh) + rres;
#pragma unroll
  for (int nt = 0; nt < 4; ++nt) {
    f32x4 o = (f32x4){0.f, 0.f, 0.f, 0.f};
    const u16* vrow = &p.vT[((size_t)gbh * 64 + nt * 16 + r) * SEQ + (size_t)rres * ln];
#pragma unroll
    for (int k2 = 0; k2 < 5; ++k2) {
      int ka = kbase + k2 * 32 + kg * 4, kc = ka + 16;
      ka = ka < 0 ? 0 : ka; kc = kc < 0 ? 0 : kc;
      uint2 va = *(const uint2*)&vrow[ka];
      uint2 vc = *(const uint2*)&vrow[kc];
      bf16x8 vf = __builtin_bit_cast(bf16x8, make_uint4(va.x, va.y, vc.x, vc.y));
      o = MFMA(vf, pf[k2], o);
    }
    uint2 ov; ov.x = pack2(o[0] * inv, o[1] * inv); ov.y = pack2(o[2] * inv, o[3] * inv);
    *(uint2*)&p.osw[((size_t)g * MT + qrow) * 256 + h * 64 + nt * 16 + kg * 4] = ov;
  }
  if (kg == 0) p.lse[((size_t)g * MT + qrow) * 4 + h] = mx + __logf(sum);
}

DI void sw_sample_wave(const Params& p, int item) {
  const int lane = threadIdx.x & 63;
  const int t = item & 3, h = (item >> 2) & 3, b = (item >> 4) & 31, g = item >> 9;
  const int dil = 1 << (2 * g), W = 128 << (2 * g);
  const float* c1 = p.cw1;
  const float* c2 = p.cw2;
  const float* c3 = p.cw3;
  const float* cache = (g == 0) ? c1 : (g == 1 ? c2 : c3);
  const int qoff = 2048 + g * 768 + h * 64;
  const size_t qrow = (size_t)MP + b * 4 + t;
  float q[64];
#pragma unroll
  for (int c = 0; c < 64; c += 8) {
    uint4 v = *(const uint4*)&p.proj[qrow * NP + qoff + c];
    q[c] = bflo(v.x); q[c + 1] = bfhi(v.x); q[c + 2] = bflo(v.y); q[c + 3] = bfhi(v.y);
    q[c + 4] = bflo(v.z); q[c + 5] = bfhi(v.z); q[c + 6] = bflo(v.w); q[c + 7] = bfhi(v.w);
  }
  float sc[3];
#pragma unroll
  for (int mi = 0; mi < 3; ++mi) {
    const int m = lane + 64 * mi;
    float s = -3.0e38f;
    if (m <= 128) {
      const int j = W + t - m * dil;
      float d = 0.f;
      if (j >= W) {
        const u16* kr = &p.proj[((size_t)MP + b * 4 + (j - W)) * NP + qoff + 256];
#pragma unroll
        for (int c = 0; c < 64; c += 8) {
          uint4 v = *(const uint4*)&kr[c];
          d += q[c] * bflo(v.x) + q[c + 1] * bfhi(v.x) + q[c + 2] * bflo(v.y) + q[c + 3] * bfhi(v.y) + q[c + 4] * bflo(v.z) +
               q[c + 5] * bfhi(v.z) + q[c + 6] * bflo(v.w) + q[c + 7] * bfhi(v.w);
        }
      } else {
        const float* kr = &cache[(((size_t)b * W + j) * 2 + 0) * 256 + h * 64];
#pragma unroll
        for (int c = 0; c < 64; c += 4) {
          float4 v = *(const float4*)&kr[c];
          d += q[c] * v.x + q[c + 1] * v.y + q[c + 2] * v.z + q[c + 3] * v.w;
        }
      }
      s = d * 0.125f;
    }
    sc[mi] = s;
  }
  float mx = wave_max(fmaxf(fmaxf(sc[0], sc[1]), sc[2]));
  float sum = 0.f;
#pragma unroll
  for (int mi = 0; mi < 3; ++mi) { sc[mi] = (sc[mi] > -1.0e38f) ? __expf(sc[mi] - mx) : 0.f; sum += sc[mi]; }
  sum = wave_sum(sum);
  float o = 0.f;
#pragma unroll
  for (int mi = 0; mi < 3; ++mi) {
#pragma unroll 8
    for (int mm = 0; mm < 64; ++mm) {
      const int m = mi * 64 + mm;
      if (m <= 128) {
        const float pv = __shfl(sc[mi], mm);
        const int j = W + t - m * dil;
        float vv;
        if (j >= W) vv = bf2f(p.proj[((size_t)MP + b * 4 + (j - W)) * NP + qoff + 512 + lane]);
        else vv = cache[(((size_t)b * W + j) * 2 + 1) * 256 + h * 64 + lane];
        o += pv * vv;
      }
    }
  }
  p.osw[((size_t)g * MT + qrow) * 256 + h * 64 + lane] = f2bf(o / sum);
  if (lane == 0) p.lse[((size_t)g * MT + qrow) * 4 + h] = mx + __logf(sum);
}

DI void phase3(const Params& p, char* smem) {
  const int w = threadIdx.x >> 6;
  if (blockIdx.x < 128) {
    dn_scan_block(p, blockIdx.x, smem);
  } else {
    const int gw = (blockIdx.x - 128) * 4 + w, nw = (gridDim.x - 128) * 4;
    for (int it = gw; it < 24576 + 1536; it += nw) {
      if (it < 24576) sw_prompt_wave(p, it);
      else sw_sample_wave(p, it - 24576);
    }
  }
}

DI void phase4(const Params& p) {
  const int lane = threadIdx.x & 63, w = threadIdx.x >> 6;
  for (int row = blockIdx.x * 4 + w; row < MT; row += gridDim.x * 4) {
    u16* dst = p.Amix + (size_t)row * 768;
#pragma unroll
    for (int h = 0; h < 4; ++h) {
      unsigned ov = *(const unsigned*)&p.odn[(size_t)row * 512 + h * 128 + lane * 2];
      unsigned zv = *(const unsigned*)&p.proj[(size_t)row * NP + 1536 + h * 128 + lane * 2];
      float o0 = bflo(ov), o1 = bfhi(ov);
      float ss = wave_sum(o0 * o0 + o1 * o1);
      float rs = rsqrtf(ss * (1.f / 128.f) + EPS);
      float2 gn = *(const float2*)&p.g_onorm[lane * 2];
      float y0 = o0 * rs * gn.x * siluf(bflo(zv)), y1 = o1 * rs * gn.y * siluf(bfhi(zv));
      *(unsigned*)&dst[h * 128 + lane * 2] = pack2(y0, y1);
    }
    {
      const int h = lane >> 4;
      float l0 = p.lse[((size_t)0 * MT + row) * 4 + h], l1 = p.lse[((size_t)1 * MT + row) * 4 + h], l2 = p.lse[((size_t)2 * MT + row) * 4 + h];
      float m = fmaxf(l0, fmaxf(l1, l2));
      float e0 = __expf(l0 - m), e1 = __expf(l1 - m), e2 = __expf(l2 - m);
      float inv = 1.f / (e0 + e1 + e2);
      uint2 a = *(const uint2*)&p.osw[((size_t)0 * MT + row) * 256 + lane * 4];
      uint2 c = *(const uint2*)&p.osw[((size_t)1 * MT + row) * 256 + lane * 4];
      uint2 d = *(const uint2*)&p.osw[((size_t)2 * MT + row) * 256 + lane * 4];
      e0 *= inv; e1 *= inv; e2 *= inv;
      float y0 = e0 * bflo(a.x) + e1 * bflo(c.x) + e2 * bflo(d.x);
      float y1 = e0 * bfhi(a.x) + e1 * bfhi(c.x) + e2 * bfhi(d.x);
      float y2 = e0 * bflo(a.y) + e1 * bflo(c.y) + e2 * bflo(d.y);
      float y3 = e0 * bfhi(a.y) + e1 * bfhi(c.y) + e2 * bfhi(d.y);
      *(uint2*)&dst[512 + lane * 4] = make_uint2(pack2(y0, y1), pack2(y2, y3));
    }
  }
}

DI void sample_state_copy(const Params& p) {
  const size_t gtid = (size_t)blockIdx.x * 256 + threadIdx.x, gsz = (size_t)gridDim.x * 256;
  for (size_t i = gtid; i < 147456; i += gsz) {
    const int c = (int)(i % 1536), j = (int)((i / 1536) % 3), b = (int)(i / 4608);
    p.out[O_SCONV + i] = bf2f(p.proj[((size_t)MP + b * 4 + j + 1) * NP + c]);
  }
  const float* c1 = p.cw1;
  const float* c2 = p.cw2;
  const float* c3 = p.cw3;
  for (int g = 0; g < 3; ++g) {
    const int W = 128 << (2 * g);
    const float* cache = (g == 0) ? c1 : (g == 1 ? c2 : c3);
    const size_t off = (g == 0) ? O_SW1 : (g == 1 ? O_SW2 : O_SW3);
    const size_t n4 = (size_t)32 * W * 512 / 4;
#pragma unroll 4
    for (size_t i = gtid; i < n4; i += gsz) {
      const size_t e0 = i * 4;
      const int e = (int)(e0 & 511), ii = (int)((e0 >> 9) % W), b = (int)((e0 >> 9) / W);
      float4 o;
      if (ii < W - 4) o = *(const float4*)&cache[((size_t)b * W + ii + 4) * 512 + e];
      else {
        uint2 v = *(const uint2*)&p.proj[((size_t)MP + b * 4 + (ii - (W - 4))) * NP + 2048 + g * 768 + 256 + e];
        o = make_float4(bflo(v.x), bfhi(v.x), bflo(v.y), bfhi(v.y));
      }
      *(float4*)&p.out[off + e0] = o;
    }
  }
}

DI void mem_attn_prompt_block(const Params& p, int item, char* smem) {
  const int tid = threadIdx.x, lane = tid & 63, w = tid >> 6, r = lane & 15, kg = lane >> 4;
  const int h = item & 3, qb = item >> 2;
  const int row0 = qb * 64 + w * 16, b = (qb * 64) >> 13;
  const int bh = b * 4 + h;
  u16* sK = (u16*)smem;
  bf16x8 qf[8];
#pragma unroll
  for (int ks = 0; ks < 8; ++ks) qf[ks] = *(const bf16x8*)&G(p.qb)[(size_t)(row0 + r) * 1024 + h * 256 + ks * 32 + kg * 8];
  f32x4 st[16];
  const u16* kbp = G(p.Kb) + (size_t)bh * 65536;
#pragma unroll
  for (int c = 0; c < 4; ++c) {
    __syncthreads();
#pragma unroll
    for (int i2 = 0; i2 < 2; ++i2) {
#pragma unroll
      for (int i = i2 * 4; i < i2 * 4 + 4; ++i) {
        const int idx = tid + 256 * i, row = idx >> 5, seg = idx & 31;
        *(bf16x8*)&sK[row * 264 + seg * 8] = *(gb8p)((gu16p)kbp + (size_t)(c * 64 + row) * 256 + seg * 8);
      }
      __builtin_amdgcn_sched_barrier(0);
    }
    __syncthreads();
#pragma unroll
    for (int m4 = 0; m4 < 4; ++m4) {
      f32x4 a = (f32x4){0.f, 0.f, 0.f, 0.f};
#pragma unroll
      for (int ks = 0; ks < 8; ++ks) {
        bf16x8 kf = *(const bf16x8*)&sK[(m4 * 16 + r) * 264 + ks * 32 + kg * 8];
        a = MFMA(kf, qf[ks], a);
      }
      st[c * 4 + m4] = a;
      __builtin_amdgcn_sched_barrier(0);
    }
  }
  float mx = -3.0e38f;
#pragma unroll
  for (int mt = 0; mt < 16; ++mt)
#pragma unroll
    for (int j = 0; j < 4; ++j) { st[mt][j] *= 0.0625f; mx = fmaxf(mx, st[mt][j]); }
  mx = fmaxf(mx, __shfl_xor(mx, 16));
  mx = fmaxf(mx, __shfl_xor(mx, 32));
  float sum = 0.f;
#pragma unroll
  for (int mt = 0; mt < 16; ++mt)
#pragma unroll
    for (int j = 0; j < 4; ++j) { st[mt][j] = __expf(st[mt][j] - mx); sum += st[mt][j]; }
  sum += __shfl_xor(sum, 16);
  sum += __shfl_xor(sum, 32);
  const float inv = 1.f / sum;
  bf16x8 pf[8];
#pragma unroll
  for (int k2 = 0; k2 < 8; ++k2) pf[k2] = pack8(st[2 * k2], st[2 * k2 + 1]);
  const u16* vtp = G(p.VTf) + (size_t)bh * 65536;
#pragma unroll 1
  for (int c = 0; c < 4; ++c) {
    __syncthreads();
#pragma unroll
    for (int i = 0; i < 8; ++i) {
      const int idx = tid + 256 * i;
      *(bf16x8*)&sK[idx * 8] = *(gb8p)((gu16p)vtp + (size_t)c * 16384 + idx * 8);
    }
    __syncthreads();
#pragma unroll
    for (int n4 = 0; n4 < 4; ++n4) {
      f32x4 o = (f32x4){0.f, 0.f, 0.f, 0.f};
#pragma unroll
      for (int k2 = 0; k2 < 8; ++k2) o = MFMA(*(const bf16x8*)&sK[((n4 * 8 + k2) * 64 + lane) * 8], pf[k2], o);
      uint2 ov; ov.x = pack2(o[0] * inv, o[1] * inv); ov.y = pack2(o[2] * inv, o[3] * inv);
      *(uint2*)&G(p.attn)[(size_t)(row0 + r) * 1024 + h * 256 + (c * 4 + n4) * 16 + kg * 4] = ov;
      __builtin_amdgcn_sched_barrier(0);
    }
  }
}

DI void mem_attn_sample_wave(const Params& p, int item, float* lds) {
  const int lane = threadIdx.x & 63;
  const int b = item >> 2, h = item & 3;
  float* sq = lds;
#pragma unroll
  for (int t = 0; t < 4; ++t) {
    uint2 v = *(const uint2*)&p.qb[((size_t)MP + b * 4 + t) * 1024 + h * 256 + lane * 4];
    *(float4*)&sq[t * 256 + lane * 4] = make_float4(bflo(v.x), bfhi(v.x), bflo(v.y), bfhi(v.y));
  }
  __builtin_amdgcn_s_waitcnt(0);
  __builtin_amdgcn_wave_barrier();
  float sc[4][4];
#pragma unroll
  for (int mi = 0; mi < 4; ++mi) {
    const int m = lane + 64 * mi;
    const float* kr = &p.cache_mem[(((size_t)b * 256 + m) * 2 + 0) * 1024 + h * 256];
    float d0 = 0.f, d1 = 0.f, d2 = 0.f, d3 = 0.f;
#pragma unroll 2
    for (int c = 0; c < 256; c += 4) {
      float4 kv = *(const float4*)&kr[c];
      float4 q0 = *(const float4*)&sq[c], q1 = *(const float4*)&sq[256 + c], q2 = *(const float4*)&sq[512 + c], q3 = *(const float4*)&sq[768 + c];
      d0 += kv.x * q0.x + kv.y * q0.y + kv.z * q0.z + kv.w * q0.w;
      d1 += kv.x * q1.x + kv.y * q1.y + kv.z * q1.z + kv.w * q1.w;
      d2 += kv.x * q2.x + kv.y * q2.y + kv.z * q2.z + kv.w * q2.w;
      d3 += kv.x * q3.x + kv.y * q3.y + kv.z * q3.z + kv.w * q3.w;
    }
    sc[0][mi] = d0 * 0.0625f; sc[1][mi] = d1 * 0.0625f; sc[2][mi] = d2 * 0.0625f; sc[3][mi] = d3 * 0.0625f;
  }
  float inv[4];
  __builtin_amdgcn_wave_barrier();
#pragma unroll
  for (int t = 0; t < 4; ++t) {
    float mx = wave_max(fmaxf(fmaxf(sc[t][0], sc[t][1]), fmaxf(sc[t][2], sc[t][3])));
    float sum = 0.f;
#pragma unroll
    for (int mi = 0; mi < 4; ++mi) { sc[t][mi] = __expf(sc[t][mi] - mx); sum += sc[t][mi]; }
    sum = wave_sum(sum);
    inv[t] = 1.f / sum;
#pragma unroll
    for (int mi = 0; mi < 4; ++mi) sq[t * 256 + lane + 64 * mi] = sc[t][mi];
  }
  __builtin_amdgcn_s_waitcnt(0);
  __builtin_amdgcn_wave_barrier();
  float4 o[4];
#pragma unroll
  for (int t = 0; t < 4; ++t) o[t] = make_float4(0.f, 0.f, 0.f, 0.f);
#pragma unroll 4
  for (int m = 0; m < 256; ++m) {
    float4 vv = *(const float4*)&p.cache_mem[(((size_t)b * 256 + m) * 2 + 1) * 1024 + h * 256 + lane * 4];
#pragma unroll
    for (int t = 0; t < 4; ++t) {
      const float pv = sq[t * 256 + m];
      o[t].x += pv * vv.x; o[t].y += pv * vv.y; o[t].z += pv * vv.z; o[t].w += pv * vv.w;
    }
  }
#pragma unroll
  for (int t = 0; t < 4; ++t) {
    uint2 ov; ov.x = pack2(o[t].x * inv[t], o[t].y * inv[t]); ov.y = pack2(o[t].z * inv[t], o[t].w * inv[t]);
    *(uint2*)&p.attn[((size_t)MP + b * 4 + t) * 1024 + h * 256 + lane * 4] = ov;
  }
  __builtin_amdgcn_wave_barrier();
}

DI void phase7(const Params& p, char* smem) {
  const int w = threadIdx.x >> 6;
  float* lds = (float*)smem + w * 1280;
  for (int it = blockIdx.x; it < 32 + 2048; it += gridDim.x) {
    if (it < 32) { __syncthreads(); mem_attn_sample_wave(p, it * 4 + w, lds); }
    else mem_attn_prompt_block(p, it - 32, smem);
  }
}

DI void peer_topk_wave(const Params& p, int item, unsigned* lds  ) {
  const int lane = threadIdx.x & 63, r = lane & 15, kg = lane >> 4;
  const int h = item & 7, row0 = (item >> 3) * 16;
  unsigned win[2][16];
#pragma unroll
  for (int pp = 0; pp < 2; ++pp) {
    bf16x8 qf[4];
#pragma unroll
    for (int ks = 0; ks < 4; ++ks) qf[ks] = *(const bf16x8*)&p.pq[(size_t)(row0 + r) * 2048 + h * 256 + pp * 128 + ks * 32 + kg * 8];
    unsigned kk[32];
    const u16* sk = p.subkb + (size_t)(h * 2 + pp) * 16384;
#pragma unroll
    for (int mt = 0; mt < 8; ++mt) {
      f32x4 a = (f32x4){0.f, 0.f, 0.f, 0.f};
#pragma unroll
      for (int ks = 0; ks < 4; ++ks) {
        bf16x8 kf = *(const bf16x8*)&sk[(mt * 16 + r) * 128 + ks * 32 + kg * 8];
        a = MFMA(kf, qf[ks], a);
      }
#pragma unroll
      for (int j = 0; j < 4; ++j) kk[mt * 4 + j] = (ordf(a[j]) & ~127u) | (unsigned)(mt * 16 + kg * 4 + j);
    }
#pragma unroll
    for (int rr = 0; rr < 16; ++rr) {
      unsigned m = 0;
#pragma unroll
      for (int i = 0; i < 32; ++i) m = umax(m, kk[i]);
      m = umax(m, (unsigned)__shfl_xor((int)m, 16));
      m = umax(m, (unsigned)__shfl_xor((int)m, 32));
      win[pp][rr] = m;
#pragma unroll
      for (int i = 0; i < 32; ++i) kk[i] = (kk[i] == m) ? 0u : kk[i];
    }
  }
  float f0[16], f1[16];
#pragma unroll
  for (int i = 0; i < 16; ++i) { f0[i] = unordf(win[0][i] & ~127u); f1[i] = unordf(win[1][i] & ~127u); }
  unsigned cand[13];
#define CAND(s, a0, b0, a1, b1, a2, b2, a3, b3)                                                         \
  {                                                                                                     \
    float va = sel4(kg, f0[a0], f0[a1], f0[a2], f0[(a3) < 0 ? 0 : (a3)]);                                \
    float vb = sel4(kg, f1[b0], f1[b1], f1[b2], f1[(b3) < 0 ? 0 : (b3)]);                                \
    unsigned id = sel4(kg, (unsigned)((a0) * 16 + (b0)), (unsigned)((a1) * 16 + (b1)), (unsigned)((a2) * 16 + (b2)), (unsigned)(((a3) < 0 ? 0 : (a3)) * 16 + ((b3) < 0 ? 0 : (b3)))); \
    unsigned key = (ordf(va + vb) & ~255u) | id;                                                        \
    if ((a3) < 0) key = (kg == 3) ? 0u : key;                                                           \
    cand[s] = key;                                                                                      \
  }
  CAND(0, 0, 0, 0, 13, 2, 0, 6, 1)
  CAND(1, 0, 1, 0, 14, 2, 1, 7, 0)
  CAND(2, 0, 2, 0, 15, 2, 2, 7, 1)
  CAND(3, 0, 3, 1, 0, 2, 3, 8, 0)
  CAND(4, 0, 4, 1, 1, 2, 4, 9, 0)
  CAND(5, 0, 5, 1, 2, 3, 0, 10, 0)
  CAND(6, 0, 6, 1, 3, 3, 1, 11, 0)
  CAND(7, 0, 7, 1, 4, 3, 2, 12, 0)
  CAND(8, 0, 8, 1, 5, 3, 3, 13, 0)
  CAND(9, 0, 9, 1, 6, 4, 2, 14, 0)
  CAND(10, 0, 10, 1, 7, 5, 0, 15, 0)
  CAND(11, 0, 11, 4, 0, 5, 1, -1, -1)
  CAND(12, 0, 12, 4, 1, 6, 0, -1, -1)
#undef CAND
  unsigned w2[16];
#pragma unroll
  for (int rr = 0; rr < 16; ++rr) {
    unsigned m = 0;
#pragma unroll
    for (int i = 0; i < 13; ++i) m = umax(m, cand[i]);
    m = umax(m, (unsigned)__shfl_xor((int)m, 16));
    m = umax(m, (unsigned)__shfl_xor((int)m, 32));
    w2[rr] = m;
#pragma unroll
    for (int i = 0; i < 13; ++i) cand[i] = (cand[i] == m) ? 0u : cand[i];
  }
  if (kg == 0) {
#pragma unroll
    for (int i = 0; i < 16; ++i) { lds[r * 32 + i] = win[0][i] & 127u; lds[r * 32 + 16 + i] = win[1][i] & 127u; }
  }
  __builtin_amdgcn_s_waitcnt(0);
  __builtin_amdgcn_wave_barrier();
  const float cv0 = unordf(w2[0] & ~255u);
  float sum = 0.f;
#pragma unroll
  for (int rr = 0; rr < 16; ++rr) sum += __expf(unordf(w2[rr] & ~255u) - cv0);
  const float inv = 1.f / sum;
  const size_t ob = ((size_t)(row0 + r) * 8 + h) * 16;
#pragma unroll
  for (int q = 0; q < 4; ++q) {
    const unsigned wk = sel4(kg, w2[q], w2[4 + q], w2[8 + q], w2[12 + q]);
    const int a = (wk >> 4) & 15, bb = wk & 15;
    const int i1 = (int)lds[r * 32 + a], i2 = (int)lds[r * 32 + 16 + bb];
    p.eid[ob + kg * 4 + q] = i1 * 128 + i2;
    p.gate[ob + kg * 4 + q] = __expf(unordf(wk & ~255u) - cv0) * inv;
  }
  __builtin_amdgcn_wave_barrier();
}

typedef __attribute__((ext_vector_type(2))) float f32x2;
DI float dot16_fp8(u32x4 u, const float* x, float c) {
  const unsigned d[4] = {u[0], u[1], u[2], u[3]};
#pragma unroll
  for (int i = 0; i < 4; ++i) {
    f32x2 a = __builtin_amdgcn_cvt_pk_f32_fp8((int)d[i], false);
    f32x2 b = __builtin_amdgcn_cvt_pk_f32_fp8((int)d[i], true);
    c += a[0] * x[4 * i] + a[1] * x[4 * i + 1] + b[0] * x[4 * i + 2] + b[1] * x[4 * i + 3];
  }
  return c;
}
DI void axpy16_fp8(float* o, float w, u32x4 u) {
  const unsigned d[4] = {u[0], u[1], u[2], u[3]};
#pragma unroll
  for (int i = 0; i < 4; ++i) {
    f32x2 a = __builtin_amdgcn_cvt_pk_f32_fp8((int)d[i], false);
    f32x2 b = __builtin_amdgcn_cvt_pk_f32_fp8((int)d[i], true);
    o[4 * i] += w * a[0]; o[4 * i + 1] += w * a[1]; o[4 * i + 2] += w * b[0]; o[4 * i + 3] += w * b[1];
  }
}

DI void peer_expert_wave(const Params& p, int row) {
  const int lane = __builtin_amdgcn_mbcnt_hi(-1, __builtin_amdgcn_mbcnt_lo(-1, 0));
  float xf[16];
  {
    const uint4 x0 = *(const uint4*)&G(p.A2)[(size_t)row * 1024 + lane * 16];
    const uint4 x1 = *(const uint4*)&G(p.A2)[(size_t)row * 1024 + lane * 16 + 8];
    xf[0] = bflo(x0.x); xf[1] = bfhi(x0.x); xf[2] = bflo(x0.y); xf[3] = bfhi(x0.y);
    xf[4] = bflo(x0.z); xf[5] = bfhi(x0.z); xf[6] = bflo(x0.w); xf[7] = bfhi(x0.w);
    xf[8] = bflo(x1.x); xf[9] = bfhi(x1.x); xf[10] = bflo(x1.y); xf[11] = bfhi(x1.y);
    xf[12] = bflo(x1.z); xf[13] = bfhi(x1.z); xf[14] = bflo(x1.w); xf[15] = bfhi(x1.w);
  }
  const float r2 = rsqrtf(p.ssq2[row] * (1.f / 1024.f) + EPS);
  const unsigned char AS1* EU8 = (const unsigned char AS1*)p.E8;
  const unsigned char AS1* EV8 = (const unsigned char AS1*)p.E8 + (size_t)16384 * 1024;
  float out[16];
#pragma unroll
  for (int i = 0; i < 16; ++i) out[i] = 0.f;
#pragma unroll 1
  for (int bt = 0; bt < 2; ++bt) {
    const int eidv = G(p.eid)[(size_t)row * 128 + bt * 64 + lane];
    const float gv = G(p.gate)[(size_t)row * 128 + bt * 64 + lane];
    const float rsu = G(p.rs)[eidv], rsv = G(p.rs)[16384 + eidv];
    float part[64];
#pragma unroll
    for (int e = 0; e < 64; ++e) {
      const int id = __builtin_amdgcn_readlane(eidv, e);
      const u32x4 u = *(const u32x4 AS1*)(EU8 + (size_t)id * 1024 + lane * 16);
      part[e] = dot16_fp8(u, xf, 0.f);
    }
#pragma unroll
    for (int off = 32; off > 0; off >>= 1) {
      const bool up = (lane & off) != 0;
#pragma unroll
      for (int i = 0; i < off; ++i) {
        const float a = part[i], bq = part[i + off];
        const float send = up ? a : bq, keep = up ? bq : a;
        part[i] = keep + __shfl_xor(send, off);
      }
    }
    const float wv = gv * geluf(part[0] * r2 * rsu) * rsv;
#pragma unroll 8
    for (int e = 0; e < 64; ++e) {
      const int id = __builtin_amdgcn_readlane(eidv, e);
      const float we = __int_as_float(__builtin_amdgcn_readlane(__float_as_int(wv), e));
      const u32x4 v = *(const u32x4 AS1*)(EV8 + (size_t)id * 1024 + lane * 16);
      axpy16_fp8(out, we, v);
    }
  }
  const float* hr = G(p.h2) + (size_t)row * 1024 + lane * 16;
  float hv[16];
  float ss = 0.f;
#pragma unroll
  for (int i = 0; i < 4; ++i) {
    float4 t = *(const float4*)&hr[i * 4];
    hv[4 * i] = t.x + out[4 * i]; hv[4 * i + 1] = t.y + out[4 * i + 1]; hv[4 * i + 2] = t.z + out[4 * i + 2]; hv[4 * i + 3] = t.w + out[4 * i + 3];
    ss += hv[4 * i] * hv[4 * i] + hv[4 * i + 1] * hv[4 * i + 1] + hv[4 * i + 2] * hv[4 * i + 2] + hv[4 * i + 3] * hv[4 * i + 3];
  }
  ss = wave_sum(ss);
  const float rsn = rsqrtf(ss * (1.f / 1024.f) + EPS);
  float* y = ((row < MP) ? (G(p.out) + O_YP + (size_t)row * 1024) : (G(p.out) + O_YS + (size_t)(row - MP) * 1024)) + lane * 16;
#pragma unroll
  for (int i = 0; i < 4; ++i) {
    float4 g4 = *(const float4*)&p.g_final[lane * 16 + i * 4];
    *(float4*)&y[i * 4] = make_float4(hv[4 * i] * rsn * g4.x, hv[4 * i + 1] * rsn * g4.y, hv[4 * i + 2] * rsn * g4.z, hv[4 * i + 3] * rsn * g4.w);
  }
}

DI void peer_u_wave(const Params& p, int row, float* wl  ) {
  const int lane = __builtin_amdgcn_mbcnt_hi(-1, __builtin_amdgcn_mbcnt_lo(-1, 0));
  float xf[16];
  {
    const u32x4 x0 = *(const u32x4 AS1*)((const u16 AS1*)p.A2 + (size_t)row * 1024 + lane * 16);
    const u32x4 x1 = *(const u32x4 AS1*)((const u16 AS1*)p.A2 + (size_t)row * 1024 + lane * 16 + 8);
    xf[0] = bflo(x0[0]); xf[1] = bfhi(x0[0]); xf[2] = bflo(x0[1]); xf[3] = bfhi(x0[1]);
    xf[4] = bflo(x0[2]); xf[5] = bfhi(x0[2]); xf[6] = bflo(x0[3]); xf[7] = bfhi(x0[3]);
    xf[8] = bflo(x1[0]); xf[9] = bfhi(x1[0]); xf[10] = bflo(x1[1]); xf[11] = bfhi(x1[1]);
    xf[12] = bflo(x1[2]); xf[13] = bfhi(x1[2]); xf[14] = bflo(x1[3]); xf[15] = bfhi(x1[3]);
  }
  const float r2 = rsqrtf(((const float AS1*)p.ssq2)[row] * (1.f / 1024.f) + EPS);
  const unsigned char AS1* EU8 = (const unsigned char AS1*)p.E8;
  const float AS1* rsp = (const float AS1*)p.rs;
#pragma unroll 1
  for (int bt = 0; bt < 2; ++bt) {
    const int eidv = ((const int AS1*)p.eid)[(size_t)row * 128 + bt * 64 + lane];
    const float gv = ((const float AS1*)p.gate)[(size_t)row * 128 + bt * 64 + lane];
    const float rsu = rsp[eidv], rsv = rsp[16384 + eidv];
    float part[64];
#pragma unroll
    for (int e = 0; e < 64; ++e) {
      const int id = __builtin_amdgcn_readlane(eidv, e);
      const u32x4 u = *(const u32x4 AS1*)(EU8 + (size_t)id * 1024 + lane * 16);
      part[e] = dot16_fp8(u, xf, 0.f);
    }
#pragma unroll
    for (int off = 32; off > 0; off >>= 1) {
      const bool up = (lane & off) != 0;
#pragma unroll
      for (int i = 0; i < off; ++i) {
        const float a = part[i], bq = part[i + off];
        const float send = up ? a : bq, keep = up ? bq : a;
        part[i] = keep + __shfl_xor(send, off);
      }
    }
    wl[bt * 64 + lane] = gv * geluf(part[0] * r2 * rsu) * rsv;
  }
}

DI void peer_v_group(const Params& p, int gw, int nw, int g, const float* wlw  ) {
  const int lane = __builtin_amdgcn_mbcnt_hi(-1, __builtin_amdgcn_mbcnt_lo(-1, 0));
  const unsigned char AS1* EV8 = (const unsigned char AS1*)p.E8 + (size_t)16384 * 1024;
  float out[4][16];
  int e0[4], e1[4];
  float w0[4], w1[4];
  bool valid[4];
#pragma unroll
  for (int ts = 0; ts < 4; ++ts) {
    const int k = g * 4 + ts;
    const int row = gw + k * nw;
    valid[ts] = row < MT;
#pragma unroll
    for (int i = 0; i < 16; ++i) out[ts][i] = 0.f;
    e0[ts] = 0x7fffffff; e1[ts] = 0x7fffffff; w0[ts] = 0.f; w1[ts] = 0.f;
    if (valid[ts]) {
      e0[ts] = ((const int AS1*)p.eid)[(size_t)row * 128 + lane];
      e1[ts] = ((const int AS1*)p.eid)[(size_t)row * 128 + 64 + lane];
      w0[ts] = wlw[k * 128 + lane];
      w1[ts] = wlw[k * 128 + 64 + lane];
    }
  }
#pragma unroll 1
  for (int r = 0; r < 8; ++r) {
#pragma unroll
    for (int ts = 0; ts < 4; ++ts) {
      unsigned long long m0 = __ballot((e0[ts] >> 11) == r);
      unsigned long long m1 = __ballot((e1[ts] >> 11) == r);
      while ((m0 | m1) != 0ull) {
        u32x4 v[8];
        float we[8];
#pragma unroll
        for (int k = 0; k < 8; ++k) {
          we[k] = 0.f;
          v[k] = (u32x4){0u, 0u, 0u, 0u};
          if ((m0 | m1) != 0ull) {
            int l, id;
            if (m0 != 0ull) {
              l = __builtin_ctzll(m0); m0 &= m0 - 1ull;
              id = __builtin_amdgcn_readlane(e0[ts], l);
              we[k] = __int_as_float(__builtin_amdgcn_readlane(__float_as_int(w0[ts]), l));
            } else {
              l = __builtin_ctzll(m1); m1 &= m1 - 1ull;
              id = __builtin_amdgcn_readlane(e1[ts], l);
              we[k] = __int_as_float(__builtin_amdgcn_readlane(__float_as_int(w1[ts]), l));
            }
            v[k] = *(const u32x4 AS1*)(EV8 + (size_t)id * 1024 + lane * 16);
          }
        }
#pragma unroll
        for (int k = 0; k < 8; ++k) axpy16_fp8(out[ts], we[k], v[k]);
      }
    }
  }
#pragma unroll
  for (int ts = 0; ts < 4; ++ts) {
    if (!valid[ts]) continue;
    const int row = gw + (g * 4 + ts) * nw;
    const float AS1* hr = (const float AS1*)p.h2 + (size_t)row * 1024 + lane * 16;
    float hv[16];
    float ss = 0.f;
#pragma unroll
    for (int i = 0; i < 4; ++i) {
      f32x4 t = *(const f32x4 AS1*)&hr[i * 4];
      hv[4 * i] = t[0] + out[ts][4 * i]; hv[4 * i + 1] = t[1] + out[ts][4 * i + 1]; hv[4 * i + 2] = t[2] + out[ts][4 * i + 2]; hv[4 * i + 3] = t[3] + out[ts][4 * i + 3];
      ss += hv[4 * i] * hv[4 * i] + hv[4 * i + 1] * hv[4 * i + 1] + hv[4 * i + 2] * hv[4 * i + 2] + hv[4 * i + 3] * hv[4 * i + 3];
    }
    ss = wave_sum(ss);
    const float rsn = rsqrtf(ss * (1.f / 1024.f) + EPS);
    float AS1* y = ((row < MP) ? ((float AS1*)p.out + O_YP + (size_t)row * 1024) : ((float AS1*)p.out + O_YS + (size_t)(row - MP) * 1024)) + lane * 16;
#pragma unroll
    for (int i = 0; i < 4; ++i) {
      f32x4 g4 = *(const f32x4 AS1*)&((const float AS1*)p.g_final)[lane * 16 + i * 4];
      f32x4 o;
      o[0] = hv[4 * i] * rsn * g4[0]; o[1] = hv[4 * i + 1] * rsn * g4[1]; o[2] = hv[4 * i + 2] * rsn * g4[2]; o[3] = hv[4 * i + 3] * rsn * g4[3];
      *(f32x4 AS1*)&y[i * 4] = o;
    }
  }
}


#define XB_TMO      128
#define XB_XCNT(j)  (256  + 64 * (j))
#define XB_XSUB(j)  (1280 + 64 * (j))
#define XB_XGEN(j)  (2304 + 64 * (j))
#define XB_TOP      3328
#define XB_TOPGEN   3392
#define XCD_BAR_WORDS 3456
#define XB_SPIN_CAP (1u << 18)
#define LAS __attribute__((address_space(3)))
DI unsigned xb_ld(unsigned* q) { return __hip_atomic_load(q, __ATOMIC_RELAXED, __HIP_MEMORY_SCOPE_AGENT); }
DI unsigned xb_add(unsigned* q, unsigned v) { return __hip_atomic_fetch_add(q, v, __ATOMIC_RELAXED, __HIP_MEMORY_SCOPE_AGENT); }
DI unsigned xb_xcc_id() { return (unsigned)__builtin_amdgcn_s_getreg((3 << 11) | 20) & 0xFu; }
#define XB_SPIN(cond, bar) do { unsigned _sp = 0; while (cond) { __builtin_amdgcn_s_sleep(1); \
    if ((++_sp & 255u) == 0u) { if (xb_ld(&(bar)[XB_TMO])) break; if (_sp > XB_SPIN_CAP) { atomicAdd(&(bar)[XB_TMO], 1u); break; } } } } while (0)
struct XcdBarrier { unsigned* bar; unsigned x; volatile LAS unsigned* st; };
DI XcdBarrier xcd_barrier_post(unsigned* bar, volatile LAS unsigned* st) {
  XcdBarrier b; b.bar = bar; b.x = xb_xcc_id(); b.st = st;
  if (threadIdx.x == 0) (void)xb_add(&bar[XB_XCNT(b.x)], 1u);
  return b;
}
DI void xcd_barrier_complete(unsigned* bar, unsigned x, unsigned& nloc, unsigned& nx) {
  const unsigned G = gridDim.x * gridDim.y * gridDim.z;
  unsigned sum, cnt, mine, sp = 0u;
  for (;;) {
    sum = 0u; cnt = 0u; mine = 0u;
#pragma unroll
    for (unsigned j = 0; j < 16; ++j) { const unsigned c = xb_ld(&bar[XB_XCNT(j)]); sum += c; cnt += (c > 0u) ? 1u : 0u; mine = (j == x) ? c : mine; }
    if (sum == G) break;
    __builtin_amdgcn_s_sleep(1);
    if ((++sp & 255u) == 0u) { if (xb_ld(&bar[XB_TMO])) break; if (sp > XB_SPIN_CAP) { atomicAdd(&bar[XB_TMO], 1u); break; } }
  }
  nloc = mine > 0u ? mine : 1u; nx = cnt > 0u ? cnt : 1u;
}
DI void xcd_barrier(const XcdBarrier& b) {
  asm volatile("s_waitcnt vmcnt(0)" ::: "memory");
  __syncthreads();
  if (threadIdx.x == 0) {
    unsigned* bar = b.bar;
    __builtin_amdgcn_s_waitcnt(0);
    unsigned nloc = b.st[0], nx = b.st[1];
    if (nloc == 0u) { xcd_barrier_complete(bar, b.x, nloc, nx); b.st[0] = nloc; b.st[1] = nx; }
    const unsigned old = xb_add(&bar[XB_XSUB(b.x)], 1u);
    const unsigned gen = old / nloc;
    if (old + 1u == (gen + 1u) * nloc) {
      __builtin_amdgcn_fence(__ATOMIC_RELEASE, "agent");
      asm volatile("s_waitcnt vmcnt(0)" ::: "memory");
      const unsigned og = xb_add(&bar[XB_TOP], 1u);
      const unsigned tg = og / nx;
      if (og + 1u == (tg + 1u) * nx) xb_add(&bar[XB_TOPGEN], 1u);
      else XB_SPIN(xb_ld(&bar[XB_TOPGEN]) == tg, bar);
      __builtin_amdgcn_fence(__ATOMIC_ACQUIRE, "agent");
      xb_add(&bar[XB_XGEN(b.x)], 1u);
      asm volatile("s_waitcnt vmcnt(0)" ::: "memory");
    } else {
      XB_SPIN(xb_ld(&bar[XB_XGEN(b.x)]) == gen, bar);
      __builtin_amdgcn_fence(__ATOMIC_ACQUIRE, "agent");
      asm volatile("s_waitcnt vmcnt(0)" ::: "memory");
    }
  }
  __syncthreads();
}

__global__ void __launch_bounds__(256, 2) mega(Params pk) {
  __shared__ __attribute__((aligned(16))) char smem[65536];
  __shared__ Params sp;
  cg::grid_group grid = cg::this_grid();
  const int w = threadIdx.x >> 6;
  __shared__ uint4 xb_words;
  if (threadIdx.x == 0) { sp = pk; xb_words = make_uint4(0u, 0u, 0u, 0u); }
  __syncthreads();
  const Params& p = sp;
  XcdBarrier xb = xcd_barrier_post(p.bar, (volatile LAS unsigned*)&xb_words);
  if (p.never) grid.sync();
#define GSYNC() xcd_barrier(xb)
#ifndef DBL
#define DBL -1
#endif
#define REP(ph) for (int rp_ = 0; rp_ < ((DBL == (ph)) ? 2 : 1); ++rp_)
  REP(0) { phase0(p, smem); if (DBL == 0) grid.sync(); }
  GSYNC();
  REP(1) {
    int tm, tn;
    for (int it = 0; it * (int)gridDim.x < 129 * 34; ++it)
      if (xcd_tile(it, 129, 34, tm, tn)) gemm_tile<0, 1024>(p, p.A0, 1024, p.WtIn, tm, tn, smem);
    for (int u = blockIdx.x; u < 64; u += gridDim.x) gemm_tile<1, 1024>(p, p.Amem, 1024, p.WtMkv, u / 16, u % 16, smem);
  }
  GSYNC();
  REP(2) { phase2(p, smem); if (DBL == 2) grid.sync(); }
  GSYNC();
  REP(3) { phase3(p, smem); if (DBL == 3) grid.sync(); }
  GSYNC();
  REP(4) phase4(p);
  GSYNC();
  { int tm, tn; for (int it = 0; it * (int)gridDim.x < 257 * 8; ++it) if (xcd_tile(it, 257, 8, tm, tn)) gemm_tile128<2, 768>(p, p.Amix, 768, p.WtOut, tm, tn, smem); }
  GSYNC();
  REP(6) { int tm, tn; for (int it = 0; it * (int)gridDim.x < 257 * 8; ++it) if (xcd_tile(it, 257, 8, tm, tn)) gemm_tile128<3, 1024>(p, p.A1, 1024, p.WtMq, tm, tn, smem); }
  sample_state_copy(p);
  GSYNC();
  REP(7) phase7(p, smem);
  GSYNC();
  { int tm, tn; for (int it = 0; it * (int)gridDim.x < 257 * 8; ++it) if (xcd_tile(it, 257, 8, tm, tn)) gemm_tile128<4, 1024>(p, p.attn, 1024, p.WtMo, tm, tn, smem); }
  GSYNC();
  REP(9) { int tm, tn; for (int it = 0; it * (int)gridDim.x < 129 * 16; ++it) if (xcd_tile(it, 129, 16, tm, tn)) gemm_tile<5, 1024>(p, p.A2, 1024, p.WtPq, tm, tn, smem); }
  GSYNC();
  REP(10) {
    unsigned* lds = (unsigned*)smem + w * 512;
    for (int it = blockIdx.x * 4 + w; it < 2056 * 8; it += gridDim.x * 4) peer_topk_wave(p, it, lds);
  }
  GSYNC();
  REP(11) {
    const int gw = blockIdx.x * 4 + w, nw = gridDim.x * 4;
    float* wlw = (float*)smem + w * (17 * 128);
    __syncthreads();
    for (int k = 0; gw + k * nw < MT && k < 17; ++k) peer_u_wave(p, gw + k * nw, wlw + k * 128);
    __builtin_amdgcn_s_waitcnt(0xc07f);
    __builtin_amdgcn_wave_barrier();
    for (int g = 0; (g * 4) * nw + gw < MT && g < 5; ++g) peer_v_group(p, gw, nw, g, wlw);
  }
}

extern "C" void kernel_launch(void* const* d_in, const int* in_sizes, int n_in, void* d_out, int out_size, void* d_ws, size_t ws_size,
                              hipStream_t stream) {
  static int grid_blocks = 0;
  if (!grid_blocks) {
    int dev = 0, cus = 0, per_cu = 0;
    (void)hipGetDevice(&dev);
    (void)hipDeviceGetAttribute(&cus, hipDeviceAttributeMultiprocessorCount, dev);
    (void)hipOccupancyMaxActiveBlocksPerMultiprocessor(&per_cu, mega, 256, 0);
    if (per_cu > 2) per_cu = 2;
    if (per_cu < 1) per_cu = 1;
    grid_blocks = cus * per_cu;
  }
  Params p{};
  const float* const* in = (const float* const*)d_in;
  p.x_prompt = in[0]; p.x_sample = in[1]; p.state_delta = in[2]; p.state_conv = in[3]; p.cw1 = in[4]; p.cw2 = in[5]; p.cw3 = in[6];
  p.cache_mem = in[7]; p.mem_prompt = in[8]; p.g_mix = in[9]; p.w_in = in[10]; p.conv_w = in[11]; p.a_log = in[12]; p.dt_bias = in[13];
  p.g_onorm = in[14]; p.w_out = in[15]; p.g_memq = in[16]; p.g_memkv = in[17]; p.w_mq = in[18]; p.w_mkv = in[19]; p.w_mo = in[20];
  p.g_ffn = in[21]; p.w_pq = in[22]; p.sub_keys = in[23]; p.expert_u = in[24]; p.expert_v = in[25]; p.g_final = in[26];
  p.out = (float*)d_out;
  char* ws = (char*)d_ws;
  size_t off = 0;
  auto take = [&](size_t bytes) { char* r = ws + off; off += (bytes + 255) & ~(size_t)255; return r; };
  p.WtIn = (u16*)take((size_t)NP * 1024 * 2);
  p.WtOut = (u16*)take((size_t)1024 * 768 * 2);
  p.WtMq = (u16*)take((size_t)1024 * 1024 * 2);
  p.WtMkv = (u16*)take((size_t)2048 * 1024 * 2);
  p.WtMo = (u16*)take((size_t)1024 * 1024 * 2);
  p.WtPq = (u16*)take((size_t)2048 * 1024 * 2);
  p.subkb = (u16*)take((size_t)262144 * 2);
  p.E8 = (unsigned char*)take((size_t)32768 * 1024);
  p.rs = (float*)take((size_t)32768 * 4);
  p.Amem = (u16*)take((size_t)1024 * 1024 * 2);
  p.gb = (float*)take((size_t)MT * 8 * 4);
  p.ssq1 = (float*)take((size_t)MT * 4);
  p.ssq2 = (float*)take((size_t)MT * 4);
  p.dl = (float*)take(2048 * 4);
  p.Kb = (u16*)take((size_t)16 * 65536 * 2);
  p.VTf = (u16*)take((size_t)16 * 65536 * 2);
  char* regA = take((size_t)MT * NP * 2);
  char* regB = take((size_t)2048 * DN_ITEM);
  p.proj = (u16*)regA;
  p.h1 = (float*)regA;
  p.h2 = (float*)(regA + (size_t)MT * 1024 * 4);
  p.pq = (u16*)regA;
  p.dnops = regB;
  p.A0 = (u16*)regB;
  p.A1 = (u16*)regB;
  p.qb = (u16*)(regB + (size_t)MT * 1024 * 2);
  p.attn = (u16*)regB;
  p.A2 = (u16*)(regB + (size_t)MT * 1024 * 2);
  p.eid = (int*)regB;
  p.gate = (float*)(regB + (size_t)MT * 128 * 4);
  char* ob = (char*)d_out;
  p.vT = (u16*)ob;
  p.osw = (u16*)(ob + (size_t)3 * MP * 256 * 2);
  p.lse = (float*)(ob + (size_t)3 * MP * 256 * 2 + (size_t)3 * MT * 256 * 2);
  char* sb = ob + O_SW3 * 4;
  p.odn = (u16*)sb;
  p.Amix = (u16*)(sb + (size_t)MT * 512 * 2);
  p.bar = (unsigned*)take((size_t)XCD_BAR_WORDS * 4);
  p.never = 0;
  p.pad_ = 0;
  if (off > ws_size) { fprintf(stderr, "workspace too small: need %zu have %zu\n", off, ws_size); return; }
  (void)hipMemsetAsync(p.bar, 0, (size_t)XCD_BAR_WORDS * 4, stream);
  void* args[] = {&p};
  hipError_t e = hipLaunchCooperativeKernel((void*)mega, dim3(grid_blocks), dim3(256), args, 0, stream);
  if (e != hipSuccess) fprintf(stderr, "coop launch failed: %s (grid %d)\n", hipGetErrorString(e), grid_blocks);
}
```

```cpp
#include <hip/hip_runtime.h>
#include <hip/hip_cooperative_groups.h>
#include <cstdio>
namespace cg = cooperative_groups;

typedef unsigned short u16;
typedef __attribute__((ext_vector_type(8))) short bf16x8;
typedef __attribute__((ext_vector_type(4))) float f32x4;
typedef __attribute__((ext_vector_type(2))) __bf16 bf2_t;

#define DI __device__ __forceinline__
#define MFMA(a, b, c) __builtin_amdgcn_mfma_f32_16x16x32_bf16((a), (b), (c), 0, 0, 0)

#ifndef DBL
#define DBL -1
#endif
constexpr int MP = 32768, MS = 128, MT = 32896;
constexpr int NP = 4352;
constexpr int SEQ = 8192;
constexpr float EPS = 1e-6f;
constexpr size_t DN_ITEM = 73728;

constexpr size_t O_YP = 0, O_YS = 33554432, O_PDELTA = 33685504, O_PCONV = 33947648, O_PW1 = 33966080,
                 O_PW2 = 34228224, O_PW3 = 35276800, O_PMEM = 39471104, O_SDELTA = 41568256, O_SCONV = 43665408,
                 O_SW1 = 43812864, O_SW2 = 45910016, O_SW3 = 54298624;

struct Params {
  const float *x_prompt, *x_sample, *state_delta, *state_conv, *cw1, *cw2, *cw3, *cache_mem, *mem_prompt;
  const float *g_mix, *w_in, *conv_w, *a_log, *dt_bias, *g_onorm, *w_out, *g_memq, *g_memkv, *w_mq, *w_mkv, *w_mo;
  const float *g_ffn, *w_pq, *sub_keys, *expert_u, *expert_v, *g_final;
  float* out;
  u16 *WtIn, *WtOut, *WtMq, *WtMkv, *WtMo, *WtPq, *subkb, *Amem;
  unsigned char* E8;
  float* rs;
  float *gb, *ssq1, *ssq2, *dl;
  u16 *Kb, *VTf;
  u16* proj;
  float *h1, *h2;
  u16* pq;
  char* dnops;
  u16 *A0, *A1, *qb, *attn, *A2;
  int* eid;
  float* gate;
  u16 *vT, *osw, *odn, *Amix;
  float* lse;
  unsigned* bar;
  int never;
  int pad_;
};

#define AS1 __attribute__((address_space(1)))
template <typename T> DI T* G(T* q) { return q; }
typedef const bf16x8 AS1* gb8p;
typedef const u16 AS1* gu16p;
typedef __attribute__((ext_vector_type(4))) unsigned u32x4;
DI u16 f2bf(float x) { unsigned u = __float_as_uint(x); u += 0x7fffu + ((u >> 16) & 1u); return (u16)(u >> 16); }
DI float bf2f(u16 h) { return __uint_as_float(((unsigned)h) << 16); }
DI unsigned pack2(float a, float b) { return (unsigned)f2bf(a) | ((unsigned)f2bf(b) << 16); }
DI float bflo(unsigned d) { return __uint_as_float(d << 16); }
DI float bfhi(unsigned d) { return __uint_as_float(d & 0xffff0000u); }
DI bf16x8 pack8(f32x4 a, f32x4 b) {
  uint4 r; r.x = pack2(a[0], a[1]); r.y = pack2(a[2], a[3]); r.z = pack2(b[0], b[1]); r.w = pack2(b[2], b[3]);
  return __builtin_bit_cast(bf16x8, r);
}
DI float wave_sum(float v) {
#pragma unroll
  for (int o = 32; o > 0; o >>= 1) v += __shfl_xor(v, o);
  return v;
}
DI float wave_max(float v) {
#pragma unroll
  for (int o = 32; o > 0; o >>= 1) v = fmaxf(v, __shfl_xor(v, o));
  return v;
}
DI float siluf(float x) { return x / (1.f + __expf(-x)); }
DI float geluf(float x) { return 0.5f * x * (1.f + tanhf(0.7978845608028654f * (x + 0.044715f * x * x * x))); }
DI int permk(int kg, int j) { return (j < 4) ? (kg * 4 + j) : (16 + kg * 4 + (j - 4)); }
DI void cvt8(const float* __restrict__ s, u16* __restrict__ d) {
  float4 a = *(const float4*)s, b = *(const float4*)(s + 4);
  uint4 r; r.x = pack2(a.x, a.y); r.y = pack2(a.z, a.w); r.z = pack2(b.x, b.y); r.w = pack2(b.z, b.w);
  *(uint4*)d = r;
}
DI unsigned ordf(float f) { unsigned u = __float_as_uint(f); return (u & 0x80000000u) ? ~u : (u | 0x80000000u); }
DI float unordf(unsigned k) { unsigned u = (k & 0x80000000u) ? (k & 0x7fffffffu) : ~k; return __uint_as_float(u); }
DI unsigned umax(unsigned a, unsigned b) { return a > b ? a : b; }
template <typename T> DI T sel4(int L, T a, T b, T c, T d) { return L == 0 ? a : (L == 1 ? b : (L == 2 ? c : d)); }

#define AS3 __attribute__((address_space(3)))
template <int MODE, int K>
DI void gemm_tile(const Params& p, const u16* __restrict__ A, int lda, const u16* __restrict__ Bt, int tm, int tn,
                          char* smem) {
  const int tid = threadIdx.x, lane = tid & 63, w = tid >> 6;
  const int wm = w >> 1, wn = w & 1, r = lane & 15, kg = lane >> 4;
  f32x4 acc[8][4];
#pragma unroll
  for (int i = 0; i < 8; ++i)
#pragma unroll
    for (int j = 0; j < 4; ++j) acc[i][j] = (f32x4){0.f, 0.f, 0.f, 0.f};
  const int lr = lane >> 2, lkg = (lane & 3) ^ (lane >> 4);
  gu16p gA[4], gB[2];
#pragma unroll
  for (int i = 0; i < 4; ++i) gA[i] = (gu16p)A + (size_t)(tm * 256 + (w * 4 + i) * 16 + lr) * lda + lkg * 8;
#pragma unroll
  for (int i = 0; i < 2; ++i) gB[i] = (gu16p)Bt + (size_t)(tn * 128 + (w * 2 + i) * 16 + lr) * K + lkg * 8;
  const int frag_off = r * 64 + ((kg ^ (r >> 2)) * 16);
  __syncthreads();
#pragma unroll
  for (int i = 0; i < 4; ++i)
    __builtin_amdgcn_global_load_lds((const unsigned AS1*)(gA[i]), (unsigned AS3*)(smem + (w * 4 + i) * 1024), 16, 0, 0);
#pragma unroll
  for (int i = 0; i < 2; ++i)
    __builtin_amdgcn_global_load_lds((const unsigned AS1*)(gB[i]), (unsigned AS3*)(smem + 16384 + (w * 2 + i) * 1024), 16, 0, 0);
#pragma unroll 2
  for (int k = 0; k < K / 32; ++k) {
    __syncthreads();
    if (k + 1 < K / 32) {
      char* st = smem + ((k + 1) & 1) * 24576;
#pragma unroll
      for (int i = 0; i < 4; ++i)
        __builtin_amdgcn_global_load_lds((const unsigned AS1*)(gA[i] + (k + 1) * 32), (unsigned AS3*)(st + (w * 4 + i) * 1024), 16, 0, 0);
#pragma unroll
      for (int i = 0; i < 2; ++i)
        __builtin_amdgcn_global_load_lds((const unsigned AS1*)(gB[i] + (k + 1) * 32), (unsigned AS3*)(st + 16384 + (w * 2 + i) * 1024), 16, 0, 0);
    }
    const char* sa = smem + (k & 1) * 24576;
    const char* sb = sa + 16384;
    bf16x8 af[8], bfr[4];
#pragma unroll
    for (int i = 0; i < 8; ++i) af[i] = *(const bf16x8*)(sa + (wm * 8 + i) * 1024 + frag_off);
#pragma unroll
    for (int i = 0; i < 4; ++i) bfr[i] = *(const bf16x8*)(sb + (wn * 4 + i) * 1024 + frag_off);
    __builtin_amdgcn_s_setprio(1);
#pragma unroll
    for (int mt = 0; mt < 8; ++mt)
#pragma unroll
      for (int nt = 0; nt < 4; ++nt) acc[mt][nt] = MFMA(bfr[nt], af[mt], acc[mt][nt]);
    __builtin_amdgcn_s_setprio(0);
  }
#pragma unroll
  for (int mt = 0; mt < 8; ++mt) {
    const int row = tm * 256 + wm * 128 + mt * 16 + r;
    if (tm * 256 + wm * 128 + mt * 16 >= ((MODE == 1) ? 1024 : MT)) continue;
    float rs = 1.f, ssq = 0.f;
    if (MODE == 3) rs = rsqrtf(p.ssq1[row] * (1.f / 1024.f) + EPS);
    if (MODE == 5) rs = rsqrtf(p.ssq2[row] * (1.f / 1024.f) + EPS);
#pragma unroll
    for (int nt = 0; nt < 4; ++nt) {
      const int col = tn * 128 + wn * 64 + nt * 16 + kg * 4;
      f32x4 v = acc[mt][nt];
      if (MODE == 0) {
        uint2 o; o.x = pack2(v[0], v[1]); o.y = pack2(v[2], v[3]);
        *(uint2*)&p.proj[(size_t)row * NP + col] = o;
      } else if (MODE == 1) {
        *(float4*)&p.out[O_PMEM + (size_t)row * 2048 + col] = make_float4(v[0], v[1], v[2], v[3]);
      } else if (MODE == 2 || MODE == 4) {
        float4 rsd;
        const float* gn;
        if (MODE == 2) {
          rsd = (row < MP) ? *(const float4*)&p.x_prompt[(size_t)row * 1024 + col] : *(const float4*)&p.x_sample[(size_t)(row - MP) * 1024 + col];
          gn = p.g_memq;
        } else {
          rsd = *(const float4*)&p.h1[(size_t)row * 1024 + col];
          gn = p.g_ffn;
        }
        float4 h = make_float4(rsd.x + v[0], rsd.y + v[1], rsd.z + v[2], rsd.w + v[3]);
        float4 g4 = *(const float4*)&gn[col];
        ssq += h.x * h.x + h.y * h.y + h.z * h.z + h.w * h.w;
        uint2 o; o.x = pack2(h.x * g4.x, h.y * g4.y); o.y = pack2(h.z * g4.z, h.w * g4.w);
        if (MODE == 2) { *(float4*)&p.h1[(size_t)row * 1024 + col] = h; *(uint2*)&p.A1[(size_t)row * 1024 + col] = o; }
        else { *(float4*)&p.h2[(size_t)row * 1024 + col] = h; *(uint2*)&p.A2[(size_t)row * 1024 + col] = o; }
      } else if (MODE == 3) {
        uint2 o; o.x = pack2(v[0] * rs, v[1] * rs); o.y = pack2(v[2] * rs, v[3] * rs);
        *(uint2*)&p.qb[(size_t)row * 1024 + col] = o;
      } else {
        uint2 o; o.x = pack2(v[0] * rs, v[1] * rs); o.y = pack2(v[2] * rs, v[3] * rs);
        *(uint2*)&p.pq[(size_t)row * 2048 + col] = o;
      }
    }
    if (MODE == 2 || MODE == 4) {
      ssq += __shfl_xor(ssq, 16);
      ssq += __shfl_xor(ssq, 32);
      if (kg == 0) atomicAdd((MODE == 2) ? &p.ssq1[row] : &p.ssq2[row], ssq);
    }
  }
}

template <int MODE, int K>
DI void gemm_tile128(const Params& p, const u16* __restrict__ A, int lda, const u16* __restrict__ Bt, int tm, int tn,
                          char* smem) {
  const int tid = threadIdx.x, lane = tid & 63, w = tid >> 6;
  const int wm = w >> 1, wn = w & 1, r = lane & 15, kg = lane >> 4;
  f32x4 acc[4][4];
#pragma unroll
  for (int i = 0; i < 4; ++i)
#pragma unroll
    for (int j = 0; j < 4; ++j) acc[i][j] = (f32x4){0.f, 0.f, 0.f, 0.f};
  const int lr = lane >> 2, lkg = (lane & 3) ^ (lane >> 4);
  gu16p gA[4], gB[4];
#pragma unroll
  for (int i = 0; i < 4; ++i) {
    const int sub = w * 4 + i, mt = sub >> 1, ks = sub & 1;
    gA[i] = (gu16p)A + (size_t)(tm * 128 + mt * 16 + lr) * lda + ks * 32 + lkg * 8;
    gB[i] = (gu16p)Bt + (size_t)(tn * 128 + mt * 16 + lr) * K + ks * 32 + lkg * 8;
  }
  const int frag_off = r * 64 + ((kg ^ (r >> 2)) * 16);
  __syncthreads();
#pragma unroll
  for (int i = 0; i < 4; ++i) {
    __builtin_amdgcn_global_load_lds((const unsigned AS1*)(gA[i]), (unsigned AS3*)(smem + (w * 4 + i) * 1024), 16, 0, 0);
    __builtin_amdgcn_global_load_lds((const unsigned AS1*)(gB[i]), (unsigned AS3*)(smem + 16384 + (w * 4 + i) * 1024), 16, 0, 0);
  }
#pragma unroll 2
  for (int k = 0; k < K / 64; ++k) {
    __syncthreads();
    if (k + 1 < K / 64) {
      char* st = smem + ((k + 1) & 1) * 32768;
#pragma unroll
      for (int i = 0; i < 4; ++i) {
        __builtin_amdgcn_global_load_lds((const unsigned AS1*)(gA[i] + (k + 1) * 64), (unsigned AS3*)(st + (w * 4 + i) * 1024), 16, 0, 0);
        __builtin_amdgcn_global_load_lds((const unsigned AS1*)(gB[i] + (k + 1) * 64), (unsigned AS3*)(st + 16384 + (w * 4 + i) * 1024), 16, 0, 0);
      }
    }
    const char* sa = smem + (k & 1) * 32768;
    const char* sb = sa + 16384;
#pragma unroll
    for (int ks = 0; ks < 2; ++ks) {
      bf16x8 af[4], bfr[4];
#pragma unroll
      for (int i = 0; i < 4; ++i) {
        af[i] = *(const bf16x8*)(sa + ((wm * 4 + i) * 2 + ks) * 1024 + frag_off);
        bfr[i] = *(const bf16x8*)(sb + ((wn * 4 + i) * 2 + ks) * 1024 + frag_off);
      }
#pragma unroll
      for (int mt = 0; mt < 4; ++mt)
#pragma unroll
        for (int nt = 0; nt < 4; ++nt) acc[mt][nt] = MFMA(bfr[nt], af[mt], acc[mt][nt]);
    }
  }
#pragma unroll
  for (int mt = 0; mt < 4; ++mt) {
    const int row = tm * 128 + wm * 64 + mt * 16 + r;
    float rs = 1.f, ssq = 0.f;
    if (MODE == 3) rs = rsqrtf(p.ssq1[row] * (1.f / 1024.f) + EPS);
    if (MODE == 5) rs = rsqrtf(p.ssq2[row] * (1.f / 1024.f) + EPS);
#pragma unroll
    for (int nt = 0; nt < 4; ++nt) {
      const int col = tn * 128 + wn * 64 + nt * 16 + kg * 4;
      f32x4 v = acc[mt][nt];
      if (MODE == 0) {
        uint2 o; o.x = pack2(v[0], v[1]); o.y = pack2(v[2], v[3]);
        *(uint2*)&p.proj[(size_t)row * NP + col] = o;
      } else if (MODE == 1) {
        *(float4*)&p.out[O_PMEM + (size_t)row * 2048 + col] = make_float4(v[0], v[1], v[2], v[3]);
      } else if (MODE == 2 || MODE == 4) {
        float4 rsd;
        const float* gn;
        if (MODE == 2) {
          rsd = (row < MP) ? *(const float4*)&p.x_prompt[(size_t)row * 1024 + col] : *(const float4*)&p.x_sample[(size_t)(row - MP) * 1024 + col];
          gn = p.g_memq;
        } else {
          rsd = *(const float4*)&p.h1[(size_t)row * 1024 + col];
          gn = p.g_ffn;
        }
        float4 h = make_float4(rsd.x + v[0], rsd.y + v[1], rsd.z + v[2], rsd.w + v[3]);
        float4 g4 = *(const float4*)&gn[col];
        ssq += h.x * h.x + h.y * h.y + h.z * h.z + h.w * h.w;
        uint2 o; o.x = pack2(h.x * g4.x, h.y * g4.y); o.y = pack2(h.z * g4.z, h.w * g4.w);
        if (MODE == 2) { *(float4*)&p.h1[(size_t)row * 1024 + col] = h; *(uint2*)&p.A1[(size_t)row * 1024 + col] = o; }
        else { *(float4*)&p.h2[(size_t)row * 1024 + col] = h; *(uint2*)&p.A2[(size_t)row * 1024 + col] = o; }
      } else if (MODE == 3) {
        uint2 o; o.x = pack2(v[0] * rs, v[1] * rs); o.y = pack2(v[2] * rs, v[3] * rs);
        *(uint2*)&p.qb[(size_t)row * 1024 + col] = o;
      } else {
        uint2 o; o.x = pack2(v[0] * rs, v[1] * rs); o.y = pack2(v[2] * rs, v[3] * rs);
        *(uint2*)&p.pq[(size_t)row * 2048 + col] = o;
      }
    }
    if (MODE == 2 || MODE == 4) {
      ssq += __shfl_xor(ssq, 16);
      ssq += __shfl_xor(ssq, 32);
      if (kg == 0) atomicAdd((MODE == 2) ? &p.ssq1[row] : &p.ssq2[row], ssq);
    }
  }
}

DI bool xcd_tile(int it, int nM, int nN, int& tm, int& tn) {
  const int per = gridDim.x >> 3;
  const int xcd = blockIdx.x & 7, li = blockIdx.x >> 3;
  const int i = (it * 8 + xcd) * per + li;
  if (i >= nM * nN) return false;
  const int panel = i / (8 * nN), within = i - panel * 8 * nN;
  const int rows = (nM - panel * 8) < 8 ? (nM - panel * 8) : 8;
  tn = within / rows;
  tm = panel * 8 + (within - tn * rows);
  return true;
}

DI void tr_tile(const float* __restrict__ W, int ldw, int nsrc0, u16* __restrict__ Wt, int K, int k0, int n0, float* tile) {
  const int tid = threadIdx.x;
  const int n = tid & 63, kq = tid >> 6;
  __syncthreads();
#pragma unroll
  for (int i = 0; i < 16; ++i) { int kk = kq + 4 * i; tile[kk * 65 + n] = W[(size_t)(k0 + kk) * ldw + nsrc0 + n]; }
  __syncthreads();
  const int nn = tid >> 2, ks = (tid & 3) * 16;
  unsigned o[8];
#pragma unroll
  for (int i = 0; i < 8; ++i) o[i] = pack2(tile[(ks + 2 * i) * 65 + nn], tile[(ks + 2 * i + 1) * 65 + nn]);
  u16* d = Wt + (size_t)(n0 + nn) * K + k0 + ks;
  *(uint4*)d = make_uint4(o[0], o[1], o[2], o[3]);
  *(uint4*)(d + 8) = make_uint4(o[4], o[5], o[6], o[7]);
}

DI void phase0(const Params& p, char* smem) {
  const int tid = threadIdx.x, lane = tid & 63, w = tid >> 6;
  const size_t gtid = (size_t)blockIdx.x * 256 + tid, gsz = (size_t)gridDim.x * 256;
  {
    const float* eu = p.expert_u;
    const float* ev = p.expert_v;
    unsigned char* e8 = p.E8;
    float* rsp = p.rs;
    const int sub = lane & 15, rq = lane >> 4;
    for (int er0 = (blockIdx.x * 4 + w) * 4; er0 < 32768; er0 += gridDim.x * 16) {
      const int er = er0 + rq;
      const float* src = (er < 16384) ? (eu + (size_t)er * 1024) : (ev + (size_t)(er - 16384) * 1024);
      float4 v[16];
      float am = 0.f;
#pragma unroll
      for (int i = 0; i < 16; ++i) {
        v[i] = *(const float4*)&src[(i >> 2) * 256 + sub * 16 + (i & 3) * 4];
        am = fmaxf(am, fmaxf(fmaxf(fabsf(v[i].x), fabsf(v[i].y)), fmaxf(fabsf(v[i].z), fabsf(v[i].w))));
      }
      am = fmaxf(am, __shfl_xor(am, 1)); am = fmaxf(am, __shfl_xor(am, 2));
      am = fmaxf(am, __shfl_xor(am, 4)); am = fmaxf(am, __shfl_xor(am, 8));
      const float sc = (am > 0.f) ? 224.f / am : 1.f;
#pragma unroll
      for (int c = 0; c < 4; ++c) {
        int o[4];
#pragma unroll
        for (int i = 0; i < 4; ++i) {
          const float4 t4 = v[c * 4 + i];
          int t = __builtin_amdgcn_cvt_pk_fp8_f32(t4.x * sc, t4.y * sc, 0, false);
          o[i] = __builtin_amdgcn_cvt_pk_fp8_f32(t4.z * sc, t4.w * sc, t, true);
        }
        *(uint4*)&e8[(size_t)er * 1024 + c * 256 + sub * 16] = make_uint4((unsigned)o[0], (unsigned)o[1], (unsigned)o[2], (unsigned)o[3]);
      }
      if (sub == 0) rsp[er] = (am > 0.f) ? am * (1.f / 224.f) : 1.f;
    }
  }
  for (size_t i = gtid; i < 262144 / 8; i += gsz) cvt8(p.sub_keys + i * 8, p.subkb + i * 8);
  for (size_t i = gtid; i < MT; i += gsz) { p.ssq1[i] = 0.f; p.ssq2[i] = 0.f; }
  float* wl = (float*)smem;
  __syncthreads();
  for (int i = tid; i < 2048; i += 256) {
    const int k = i >> 1, hf = i & 1;
    float4 t = *(const float4*)&p.w_in[(size_t)k * 4360 + 1536 + hf * 4];
    wl[(hf * 4 + 0) * 1024 + k] = t.x; wl[(hf * 4 + 1) * 1024 + k] = t.y; wl[(hf * 4 + 2) * 1024 + k] = t.z; wl[(hf * 4 + 3) * 1024 + k] = t.w;
  }
  __syncthreads();
  const float* xpp = p.x_prompt;
  const float* xsp = p.x_sample;
  const float* mpp = p.mem_prompt;
  const float* gmx = p.g_mix;
  const float* gmk = p.g_memkv;
  u16* a0p = p.A0;
  u16* amp = p.Amem;
  {
    const int sub = lane & 15, rq = lane >> 4;
    for (int row0 = (blockIdx.x * 4 + w) * 4; row0 < MT + 1024; row0 += gridDim.x * 16) {
      const int row = row0 + rq;
      const float* src; const float* g; u16* dst;
      if (row < MP) { src = xpp + (size_t)row * 1024; g = gmx; dst = a0p + (size_t)row * 1024; }
      else if (row < MT) { src = xsp + (size_t)(row - MP) * 1024; g = gmx; dst = a0p + (size_t)row * 1024; }
      else { src = mpp + (size_t)(row - MT) * 1024; g = gmk; dst = amp + (size_t)(row - MT) * 1024; }
      float4 v[16];
      float ss = 0.f;
#pragma unroll
      for (int i = 0; i < 16; ++i) { v[i] = *(const float4*)&src[i * 64 + sub * 4]; ss += v[i].x * v[i].x + v[i].y * v[i].y + v[i].z * v[i].z + v[i].w * v[i].w; }
      ss += __shfl_xor(ss, 1); ss += __shfl_xor(ss, 2); ss += __shfl_xor(ss, 4); ss += __shfl_xor(ss, 8);
      const float rs = rsqrtf(ss * (1.f / 1024.f) + EPS);
      float d8[8] = {0.f, 0.f, 0.f, 0.f, 0.f, 0.f, 0.f, 0.f};
#pragma unroll
      for (int i = 0; i < 16; ++i) {
        float4 g4 = *(const float4*)&g[i * 64 + sub * 4];
        float y[4] = {v[i].x * rs * g4.x, v[i].y * rs * g4.y, v[i].z * rs * g4.z, v[i].w * rs * g4.w};
        uint2 o; o.x = pack2(y[0], y[1]); o.y = pack2(y[2], y[3]);
        *(uint2*)&dst[i * 64 + sub * 4] = o;
        if (row < MT) {
#pragma unroll
          for (int j = 0; j < 8; ++j) {
            float4 wv = *(const float4*)&wl[j * 1024 + i * 64 + sub * 4];
            d8[j] += y[0] * wv.x + y[1] * wv.y + y[2] * wv.z + y[3] * wv.w;
          }
        }
      }
      if (row < MT) {
#pragma unroll
        for (int j = 0; j < 8; ++j) {
          d8[j] += __shfl_xor(d8[j], 1); d8[j] += __shfl_xor(d8[j], 2); d8[j] += __shfl_xor(d8[j], 4); d8[j] += __shfl_xor(d8[j], 8);
        }
        if (sub < 4) {
          float ag = sel4(sub, d8[0], d8[1], d8[2], d8[3]);
          float bg = sel4(sub, d8[4], d8[5], d8[6], d8[7]);
          float xs = ag + p.dt_bias[sub];
          float sp = (xs > 20.f) ? xs : log1pf(expf(xs));
          p.gb[(size_t)row * 8 + sub] = -expf(p.a_log[sub]) * sp;
          p.gb[(size_t)row * 8 + 4 + sub] = 1.f / (1.f + expf(-bg));
        }
      }
    }
  }
  __syncthreads();
  float* tile = (float*)smem;
  for (int j = blockIdx.x; j < 2816; j += gridDim.x) {
    int t = j;
    if (t < 1088) { int kt = t / 68, nt = t % 68; int n0 = nt * 64; tr_tile(p.w_in, 4360, n0 + (n0 >= 1536 ? 8 : 0), p.WtIn, 1024, kt * 64, n0, tile); continue; }
    t -= 1088;
    if (t < 192) { int kt = t / 16, nt = t % 16; tr_tile(p.w_out, 1024, nt * 64, p.WtOut, 768, kt * 64, nt * 64, tile); continue; }
    t -= 192;
    if (t < 256) { int kt = t / 16, nt = t % 16; tr_tile(p.w_mq, 1024, nt * 64, p.WtMq, 1024, kt * 64, nt * 64, tile); continue; }
    t -= 256;
    if (t < 512) { int kt = t / 32, nt = t % 32; tr_tile(p.w_mkv, 2048, nt * 64, p.WtMkv, 1024, kt * 64, nt * 64, tile); continue; }
    t -= 512;
    if (t < 256) { int kt = t / 16, nt = t % 16; tr_tile(p.w_mo, 1024, nt * 64, p.WtMo, 1024, kt * 64, nt * 64, tile); continue; }
    t -= 256;
    { int kt = t / 32, nt = t % 32; tr_tile(p.w_pq, 2048, nt * 64, p.WtPq, 1024, kt * 64, nt * 64, tile); }
  }
}

DI void dn_prep(const Params& p, int item, char* smem) {
  u16* qs = (u16*)smem;
  u16* ksm = qs + 64 * 136;
  float* sL = (float*)(ksm + 64 * 136);
  float* sgc = sL + 64 * 64;
  float* sbeta = sgc + 64;
  u16* sU = (u16*)sL;
  u16* sW = qs;
  const int tid = threadIdx.x, lane = tid & 63, w = tid >> 6, r = lane & 15, kg = lane >> 4;
  const int bh = item >> 7, n = item & 127, b = bh >> 2, h = bh & 3;
  const int t0 = n * 64;
  const size_t rowbase = (size_t)b * SEQ;
  char* ops = p.dnops + (size_t)item * DN_ITEM;
  __syncthreads();
  if (tid < 64) {
    float gv = p.gb[(rowbase + t0 + tid) * 8 + h];
    float bv = p.gb[(rowbase + t0 + tid) * 8 + 4 + h];
#pragma unroll
    for (int o = 1; o < 64; o <<= 1) { float t = __shfl_up(gv, o); if (lane >= o) gv += t; }
    sgc[tid] = gv; sbeta[tid] = bv;
    if (tid == 63) p.dl[item] = __expf(gv);
  }
#pragma unroll 4
  for (int ps = 0; ps < 8; ++ps) {
    const int combo = ps * 16 + (tid >> 4);
    const int tt = combo & 63, part = combo >> 6, sub = tid & 15;
    const int col = part * 512 + h * 128 + sub * 8;
    float y[8] = {0.f, 0.f, 0.f, 0.f, 0.f, 0.f, 0.f, 0.f};
#pragma unroll
    for (int j = 0; j < 4; ++j) {
      const int t = t0 + tt - 3 + j;
      if (t >= 0) {
        uint4 xv = *(const uint4*)&p.proj[(rowbase + t) * NP + col];
        float4 wa = *(const float4*)&p.conv_w[j * 1536 + col], wb = *(const float4*)&p.conv_w[j * 1536 + col + 4];
        y[0] += bflo(xv.x) * wa.x; y[1] += bfhi(xv.x) * wa.y; y[2] += bflo(xv.y) * wa.z; y[3] += bfhi(xv.y) * wa.w;
        y[4] += bflo(xv.z) * wb.x; y[5] += bfhi(xv.z) * wb.y; y[6] += bflo(xv.w) * wb.z; y[7] += bfhi(xv.w) * wb.w;
      }
    }
    float ss = 0.f;
#pragma unroll
    for (int e = 0; e < 8; ++e) { y[e] = siluf(y[e]); ss += y[e] * y[e]; }
    ss += __shfl_xor(ss, 1); ss += __shfl_xor(ss, 2); ss += __shfl_xor(ss, 4); ss += __shfl_xor(ss, 8);
    float sc = rsqrtf(ss + EPS) * (part == 0 ? 0.08838834764831845f : 1.f);
    uint4 o; o.x = pack2(y[0] * sc, y[1] * sc); o.y = pack2(y[2] * sc, y[3] * sc); o.z = pack2(y[4] * sc, y[5] * sc); o.w = pack2(y[6] * sc, y[7] * sc);
    *(uint4*)&((part == 0 ? qs : ksm)[tt * 136 + sub * 8]) = o;
  }
  __syncthreads();
  const float gcl = sgc[63];
  {
    f32x4 aL[4], aA[4];
#pragma unroll
    for (int i = 0; i < 4; ++i) { aL[i] = (f32x4){0.f, 0.f, 0.f, 0.f}; aA[i] = (f32x4){0.f, 0.f, 0.f, 0.f}; }
#pragma unroll
    for (int ks = 0; ks < 4; ++ks) {
      bf16x8 kI = *(const bf16x8*)&ksm[(w * 16 + r) * 136 + ks * 32 + kg * 8];
      bf16x8 qI = *(const bf16x8*)&qs[(w * 16 + r) * 136 + ks * 32 + kg * 8];
#pragma unroll
      for (int nt = 0; nt < 4; ++nt) {
        bf16x8 kJ = *(const bf16x8*)&ksm[(nt * 16 + r) * 136 + ks * 32 + kg * 8];
        aL[nt] = MFMA(kJ, kI, aL[nt]);
        aA[nt] = MFMA(kJ, qI, aA[nt]);
      }
    }
    const int i = w * 16 + r;
    const float gci = sgc[i], bi = sbeta[i];
    u16* aq = (u16*)(ops + 49152);
#pragma unroll
    for (int nt = 0; nt < 4; ++nt) {
      float lv[4], av[4];
#pragma unroll
      for (int jj = 0; jj < 4; ++jj) {
        const int j = nt * 16 + kg * 4 + jj;
        const float gam = (i >= j) ? __expf(gci - sgc[j]) : 0.f;
        lv[jj] = (i > j) ? aL[nt][jj] * bi * gam : 0.f;
        av[jj] = aA[nt][jj] * gam;
      }
      *(float4*)&sL[i * 64 + nt * 16 + kg * 4] = make_float4(lv[0], lv[1], lv[2], lv[3]);
      uint2 o; o.x = pack2(av[0], av[1]); o.y = pack2(av[2], av[3]);
      *(uint2*)&aq[((w * 2 + (nt >> 1)) * 64 + lane) * 8 + (nt & 1) * 4] = o;
    }
  }
  {
    u16* qg = (u16*)(ops + 16384);
    u16* kdT = (u16*)(ops + 32768);
#pragma unroll 1
    for (int i = 0; i < 4; ++i) {
      const int f = tid + 256 * i;
      const int mtks = f >> 6, l = f & 63, rr = l & 15, kgg = l >> 4;
      {
        const int mt = mtks >> 2, ks = mtks & 3, row = mt * 16 + rr;
        const float e = __expf(sgc[row]);
        uint2 a = *(const uint2*)&qs[row * 136 + ks * 32 + kgg * 4];
        uint2 c = *(const uint2*)&qs[row * 136 + ks * 32 + 16 + kgg * 4];
        uint4 o;
        o.x = pack2(bflo(a.x) * e, bfhi(a.x) * e); o.y = pack2(bflo(a.y) * e, bfhi(a.y) * e);
        o.z = pack2(bflo(c.x) * e, bfhi(c.x) * e); o.w = pack2(bflo(c.y) * e, bfhi(c.y) * e);
        *(uint4*)&qg[(size_t)f * 8] = o;
      }
      {
        const int mt = mtks >> 1, ks = mtks & 1, kdim = mt * 16 + rr;
        float v[8];
#pragma unroll
        for (int j = 0; j < 8; ++j) {
          const int c = ks * 32 + permk(kgg, j);
          v[j] = bf2f(ksm[c * 136 + kdim]) * __expf(gcl - sgc[c]);
        }
        uint4 o; o.x = pack2(v[0], v[1]); o.y = pack2(v[2], v[3]); o.z = pack2(v[4], v[5]); o.w = pack2(v[6], v[7]);
        *(uint4*)&kdT[(size_t)f * 8] = o;
      }
    }
  }
  __syncthreads();
  float x[64];
  if (tid < 128) {
    const int col = 1024 + h * 128 + tid;
    const float w0 = p.conv_w[col], w1 = p.conv_w[1536 + col], w2 = p.conv_w[3072 + col], w3 = p.conv_w[4608 + col];
    float xm3 = 0.f, xm2 = 0.f, xm1 = 0.f;
    if (t0 > 0) {
      xm3 = bf2f(p.proj[(rowbase + t0 - 3) * NP + col]);
      xm2 = bf2f(p.proj[(rowbase + t0 - 2) * NP + col]);
      xm1 = bf2f(p.proj[(rowbase + t0 - 1) * NP + col]);
    }
#pragma unroll
    for (int t = 0; t < 64; ++t) {
      float xc = bf2f(p.proj[(rowbase + t0 + t) * NP + col]);
      float yv = w0 * xm3 + w1 * xm2 + w2 * xm1 + w3 * xc;
      x[t] = siluf(yv) * sbeta[t];
      xm3 = xm2; xm2 = xm1; xm1 = xc;
    }
  } else {
    const int kc = tid - 128;
#pragma unroll
    for (int t = 0; t < 64; ++t) x[t] = bf2f(ksm[t * 136 + kc]) * sbeta[t] * __expf(sgc[t]);
  }
  {
    f32x4 Lr[16];
#pragma unroll
    for (int i = 1; i < 64; ++i) {
#pragma unroll
      for (int j4 = 0; j4 < (i + 3) / 4; ++j4) Lr[j4] = *(const f32x4*)&sL[i * 64 + j4 * 4];
      __builtin_amdgcn_sched_barrier(0);
      float s0 = x[i], s1 = 0.f, s2 = 0.f, s3 = 0.f;
#pragma unroll
      for (int j4 = 0; j4 < (i + 3) / 4; ++j4) {
        const f32x4 l = Lr[j4];
        s0 -= l[0] * x[j4 * 4];
        if (j4 * 4 + 1 < i) s1 -= l[1] * x[j4 * 4 + 1];
        if (j4 * 4 + 2 < i) s2 -= l[2] * x[j4 * 4 + 2];
        if (j4 * 4 + 3 < i) s3 -= l[3] * x[j4 * 4 + 3];
      }
      x[i] = (s0 + s1) + (s2 + s3);
      __builtin_amdgcn_sched_barrier(0);
    }
  }
  __syncthreads();
  if (tid < 128) {
#pragma unroll
    for (int t = 0; t < 64; ++t) sU[t * 128 + tid] = f2bf(x[t]);
  } else {
    const int kc = tid - 128;
#pragma unroll
    for (int t = 0; t < 64; ++t) sW[t * 136 + kc] = f2bf(-x[t]);
  }
  __syncthreads();
  {
    u16* nW = (u16*)ops;
    u16* u0 = (u16*)(ops + 57344);
#pragma unroll 1
    for (int i = 0; i < 4; ++i) {
      const int f = tid + 256 * i;
      const int mtks = f >> 6, l = f & 63, rr = l & 15, kgg = l >> 4;
      const int mt = mtks >> 2, ks = mtks & 3, row = mt * 16 + rr;
      uint2 a = *(const uint2*)&sW[row * 136 + ks * 32 + kgg * 4];
      uint2 c = *(const uint2*)&sW[row * 136 + ks * 32 + 16 + kgg * 4];
      *(uint4*)&nW[(size_t)f * 8] = make_uint4(a.x, a.y, c.x, c.y);
    }
#pragma unroll 1
    for (int i = 0; i < 8; ++i) {
      const int f = tid + 256 * i;
      const int smt = f >> 6, l = f & 63, rr = l & 15, kgg = l >> 4;
      const int s = smt >> 2, mt = smt & 3;
      u16 v0 = sU[(mt * 16 + kgg * 4 + 0) * 128 + s * 16 + rr];
      u16 v1 = sU[(mt * 16 + kgg * 4 + 1) * 128 + s * 16 + rr];
      u16 v2 = sU[(mt * 16 + kgg * 4 + 2) * 128 + s * 16 + rr];
      u16 v3 = sU[(mt * 16 + kgg * 4 + 3) * 128 + s * 16 + rr];
      *(uint2*)&u0[(size_t)f * 4] = make_uint2((unsigned)v0 | ((unsigned)v1 << 16), (unsigned)v2 | ((unsigned)v3 << 16));
    }
  }
}

DI void vt_tile(const Params& p, int item, char* smem) {
  u16* tile = (u16*)smem;
  const int tid = threadIdx.x;
  const int ptile = item & 127, gbh = item >> 7;
  const int h = gbh & 3, b = (gbh >> 2) & 3, g = gbh >> 4;
  const int dsh = g * 2, ln = SEQ >> dsh;
  const int pos0 = ptile * 64;
  const int rres = pos0 / ln, i0 = pos0 % ln;
  __syncthreads();
  {
    const int pr = tid >> 2, seg = (tid & 3) * 16;
    const int token = ((i0 + pr) << dsh) + rres;
    const u16* src = &p.proj[((size_t)b * SEQ + token) * NP + 2048 + g * 768 + 512 + h * 64 + seg];
    uint4 a = *(const uint4*)src, c = *(const uint4*)(src + 8);
    unsigned d[8] = {a.x, a.y, a.z, a.w, c.x, c.y, c.z, c.w};
#pragma unroll
    for (int e = 0; e < 8; ++e) *(unsigned*)&tile[pr * 66 + seg + e * 2] = d[e];
  }
  __syncthreads();
  {
    const int dh = tid >> 2, seg = (tid & 3) * 16;
    unsigned o[8];
#pragma unroll
    for (int e = 0; e < 8; ++e) o[e] = (unsigned)tile[(seg + 2 * e) * 66 + dh] | ((unsigned)tile[(seg + 2 * e + 1) * 66 + dh] << 16);
    u16* d = &p.vT[((size_t)gbh * 64 + dh) * SEQ + pos0 + seg];
    *(uint4*)d = make_uint4(o[0], o[1], o[2], o[3]);
    *(uint4*)(d + 8) = make_uint4(o[4], o[5], o[6], o[7]);
  }
}

DI void dn_sample(const Params& p, int item, char* smem) {
  float* sq = (float*)smem;
  float* sk = sq + 512;
  float* sv = sk + 512;
  float* red = sv + 512;
  const int tid = threadIdx.x, lane = tid & 63, w = tid >> 6;
  const int b = item >> 2, h = item & 3;
  __syncthreads();
  for (int c = tid; c < 384; c += 256) {
    const int part = c >> 7, cc = c & 127;
    const int col = part * 512 + h * 128 + cc;
    float xp[7];
#pragma unroll
    for (int j = 0; j < 3; ++j) xp[j] = p.state_conv[((size_t)b * 3 + j) * 1536 + col];
#pragma unroll
    for (int j = 0; j < 4; ++j) xp[3 + j] = bf2f(p.proj[((size_t)MP + b * 4 + j) * NP + col]);
    const float w0 = p.conv_w[col], w1 = p.conv_w[1536 + col], w2 = p.conv_w[3072 + col], w3 = p.conv_w[4608 + col];
    float* dst = part == 0 ? sq : (part == 1 ? sk : sv);
#pragma unroll
    for (int t = 0; t < 4; ++t) dst[t * 128 + cc] = siluf(w0 * xp[t] + w1 * xp[t + 1] + w2 * xp[t + 2] + w3 * xp[t + 3]);
  }
  __syncthreads();
  {
    float a0 = sq[w * 128 + lane], a1 = sq[w * 128 + 64 + lane];
    float s = wave_sum(a0 * a0 + a1 * a1);
    float sc = rsqrtf(s + EPS) * 0.08838834764831845f;
    sq[w * 128 + lane] = a0 * sc; sq[w * 128 + 64 + lane] = a1 * sc;
    float b0 = sk[w * 128 + lane], b1 = sk[w * 128 + 64 + lane];
    s = wave_sum(b0 * b0 + b1 * b1);
    sc = rsqrtf(s + EPS);
    sk[w * 128 + lane] = b0 * sc; sk[w * 128 + 64 + lane] = b1 * sc;
  }
  __syncthreads();
  const int v = tid & 127, half = tid >> 7;
  float S[64];
  const float* s0 = p.state_delta + (((size_t)b * 4 + h) * 128 + half * 64) * 128 + v;
#pragma unroll
  for (int i = 0; i < 64; ++i) S[i] = s0[(size_t)i * 128];
#pragma unroll 1
  for (int t = 0; t < 4; ++t) {
    const size_t row = (size_t)MP + b * 4 + t;
    const float a = __expf(p.gb[row * 8 + h]);
    const float beta = p.gb[row * 8 + 4 + h];
    float part = 0.f;
#pragma unroll
    for (int i = 0; i < 64; ++i) part += S[i] * sk[t * 128 + half * 64 + i];
    red[half * 128 + v] = part;
    __syncthreads();
    const float kS = red[v] + red[128 + v];
    const float u = beta * (sv[t * 128 + v] - a * kS);
    float po = 0.f;
#pragma unroll
    for (int i = 0; i < 64; ++i) { S[i] = a * S[i] + sk[t * 128 + half * 64 + i] * u; po += S[i] * sq[t * 128 + half * 64 + i]; }
    __syncthreads();
    red[half * 128 + v] = po;
    __syncthreads();
    if (half == 0) p.odn[row * 512 + h * 128 + v] = f2bf(red[v] + red[128 + v]);
    __syncthreads();
  }
  float* d = p.out + O_SDELTA + (((size_t)b * 4 + h) * 128 + half * 64) * 128 + v;
#pragma unroll
  for (int i = 0; i < 64; ++i) d[(size_t)i * 128] = S[i];
}

DI void phase2(const Params& p, char* smem) {
  const size_t gtid = (size_t)blockIdx.x * 256 + threadIdx.x, gsz = (size_t)gridDim.x * 256;
  for (int j = blockIdx.x; j < 2048 + 128 + 6144; j += gridDim.x) {
    if (j < 2048) { dn_prep(p, j, smem); if (DBL == 20) dn_prep(p, j, smem); }
    else if (j < 2048 + 128) dn_sample(p, j - 2048, smem);
    else { vt_tile(p, j - 2176, smem); if (DBL == 21) vt_tile(p, j - 2176, smem); }
  }
  for (size_t f = gtid; f < (size_t)16 * 8192; f += gsz) {
    {
      const size_t e0 = f * 8;
      const int bh = (int)(e0 >> 16), key = (int)((e0 >> 8) & 255), dh = (int)(e0 & 255);
      const int b = bh >> 2, h = bh & 3;
      cvt8(p.out + O_PMEM + (((size_t)b * 256 + key) * 2 + 0) * 1024 + h * 256 + dh, p.Kb + e0);
    }
    {
      const int l = (int)(f & 63), ks = (int)((f >> 6) & 7), nt = (int)((f >> 9) & 15), bh = (int)(f >> 13);
      const int b = bh >> 2, h = bh & 3, rr = l & 15, kgg = l >> 4;
      float v[8];
#pragma unroll
      for (int j = 0; j < 8; ++j) {
        const int key = ks * 32 + permk(kgg, j);
        v[j] = p.out[O_PMEM + (((size_t)b * 256 + key) * 2 + 1) * 1024 + h * 256 + nt * 16 + rr];
      }
      *(uint4*)&p.VTf[f * 8] = make_uint4(pack2(v[0], v[1]), pack2(v[2], v[3]), pack2(v[4], v[5]), pack2(v[6], v[7]));
    }
  }
  for (size_t i = gtid; i < 18432; i += gsz) {
    const int c = (int)(i % 1536), j = (int)((i / 1536) % 3), b = (int)(i / 4608);
    p.out[O_PCONV + i] = bf2f(p.proj[((size_t)b * SEQ + SEQ - 3 + j) * NP + c]);
  }
  for (int g = 0; g < 3; ++g) {
    const int W = 128 << (2 * g);
    const size_t off = (g == 0) ? O_PW1 : (g == 1 ? O_PW2 : O_PW3);
    const size_t n4 = (size_t)4 * W * 512 / 4;
    for (size_t i = gtid; i < n4; i += gsz) {
      const size_t e0 = i * 4;
      const int e = (int)(e0 & 511), ii = (int)((e0 >> 9) % W), b = (int)((e0 >> 9) / W);
      uint2 v = *(const uint2*)&p.proj[((size_t)b * SEQ + SEQ - W + ii) * NP + 2048 + g * 768 + 256 + e];
      *(float4*)&p.out[off + e0] = make_float4(bflo(v.x), bfhi(v.x), bflo(v.y), bfhi(v.y));
    }
  }
}

typedef __attribute__((ext_vector_type(2))) unsigned u32x2;
struct ScanOps { bf16x8 nW[4]; bf16x8 qg[4]; bf16x8 aq[2]; bf16x8 kd[4]; u32x2 u0; float dl; };

DI void scan_load(const Params& p, int bh, int s, int n, int j, int lane, ScanOps& o) {
  n = n > 127 ? 127 : n;
  const char AS1* base = (const char AS1*)p.dnops + (size_t)(bh * 128 + n) * DN_ITEM;
  gb8p negW = (gb8p)base;
  gb8p qg = (gb8p)(base + 16384);
  gb8p kdT = (gb8p)(base + 32768);
  gb8p aqk = (gb8p)(base + 49152);
  const u32x2 AS1* u0 = (const u32x2 AS1*)(base + 57344);
#pragma unroll
  for (int ks = 0; ks < 4; ++ks) o.nW[ks] = negW[(j * 4 + ks) * 64 + lane];
#pragma unroll
  for (int ks = 0; ks < 4; ++ks) o.qg[ks] = qg[(j * 4 + ks) * 64 + lane];
#pragma unroll
  for (int k2 = 0; k2 < 2; ++k2) o.aq[k2] = aqk[(j * 2 + k2) * 64 + lane];
#pragma unroll
  for (int mm = 0; mm < 2; ++mm)
#pragma unroll
    for (int k2 = 0; k2 < 2; ++k2) o.kd[mm * 2 + k2] = kdT[((2 * j + mm) * 2 + k2) * 64 + lane];
  o.u0 = u0[(s * 4 + j) * 64 + lane];
  o.dl = ((const float AS1*)p.dl)[bh * 128 + n];
}

DI void scan_step(const Params& p, const ScanOps& ops, int n, int b, int h, int s, int j, int lane, f32x4& S0, f32x4& S1,
                  bf16x8* sSb, u32x2* sUb) {
  const int r = lane & 15, kg = lane >> 4;
  bf16x8 sb[4];
#pragma unroll
  for (int ks = 0; ks < 4; ++ks) sb[ks] = sSb[ks * 64 + lane];
  f32x4 u = (f32x4){bflo(ops.u0[0]), bfhi(ops.u0[0]), bflo(ops.u0[1]), bfhi(ops.u0[1])};
#pragma unroll
  for (int ks = 0; ks < 4; ++ks) u = MFMA(ops.nW[ks], sb[ks], u);
  {
    u32x2 t; t[0] = pack2(u[0], u[1]); t[1] = pack2(u[2], u[3]);
    sUb[((j >> 1) * 64 + lane) * 2 + (j & 1)] = t;
  }
  __syncthreads();
  bf16x8 ub[2];
#pragma unroll
  for (int k2 = 0; k2 < 2; ++k2) ub[k2] = *(const bf16x8*)&sUb[(k2 * 64 + lane) * 2];
  f32x4 o = (f32x4){0.f, 0.f, 0.f, 0.f};
#pragma unroll
  for (int ks = 0; ks < 4; ++ks) o = MFMA(ops.qg[ks], sb[ks], o);
#pragma unroll
  for (int k2 = 0; k2 < 2; ++k2) o = MFMA(ops.aq[k2], ub[k2], o);
  S0 = S0 * ops.dl; S1 = S1 * ops.dl;
#pragma unroll
  for (int k2 = 0; k2 < 2; ++k2) { S0 = MFMA(ops.kd[k2], ub[k2], S0); S1 = MFMA(ops.kd[2 + k2], ub[k2], S1); }
  sSb[j * 64 + lane] = pack8(S0, S1);
#pragma unroll
  for (int jj = 0; jj < 4; ++jj) {
    const size_t token = (size_t)b * SEQ + n * 64 + j * 16 + kg * 4 + jj;
    G(p.odn)[token * 512 + h * 128 + s * 16 + r] = f2bf(o[jj]);
  }
  __syncthreads();
}

DI void dn_scan_block(const Params& p, int item, char* smem) {
  const int lane = threadIdx.x & 63, j = threadIdx.x >> 6, r = lane & 15, kg = lane >> 4;
  const int bh = item >> 3, s = item & 7, b = bh >> 2, h = bh & 3;
  bf16x8* sSb = (bf16x8*)smem;
  u32x2* sUb = (u32x2*)(smem + 4096);
  f32x4 S0 = (f32x4){0.f, 0.f, 0.f, 0.f}, S1 = (f32x4){0.f, 0.f, 0.f, 0.f};
  __syncthreads();
  sSb[j * 64 + lane] = pack8(S0, S1);
  ScanOps A, B;
  scan_load(p, bh, s, 0, j, lane, A);
  scan_load(p, bh, s, 1, j, lane, B);
  __syncthreads();
#pragma unroll 1
  for (int n0 = 0; n0 < 128; n0 += 2) {
    scan_step(p, A, n0, b, h, s, j, lane, S0, S1, sSb, sUb);
    scan_load(p, bh, s, n0 + 2, j, lane, A);
    scan_step(p, B, n0 + 1, b, h, s, j, lane, S0, S1, sSb, sUb);
    scan_load(p, bh, s, n0 + 3, j, lane, B);
  }
#pragma unroll
  for (int jj = 0; jj < 4; ++jj) {
    p.out[O_PDELTA + ((size_t)bh * 128 + 32 * j + kg * 4 + jj) * 128 + s * 16 + r] = S0[jj];
    p.out[O_PDELTA + ((size_t)bh * 128 + 32 * j + 16 + kg * 4 + jj) * 128 + s * 16 + r] = S1[jj];
  }
}

DI void sw_prompt_wave(const Params& p, int item) {
  const int lane = threadIdx.x & 63, r = lane & 15, kg = lane >> 4;
  const int qt = item & 511, gbh = item >> 9;
  const int h = gbh & 3, b = (gbh >> 2) & 3, g = gbh >> 4;
  const int dsh = 2 * g, ln = SEQ >> dsh;
  const int pos0 = qt * 16, rres = pos0 / ln, i0 = pos0 % ln;
  const int kbase = i0 - 144;
  const size_t rb = (size_t)b * SEQ;
  const int qoff = 2048 + g * 768 + h * 64, koff = qoff + 256;
  bf16x8 qf[2];
  {
    const size_t tok = rb + ((size_t)(i0 + r) << dsh) + rres;
#pragma unroll
    for (int ks = 0; ks < 2; ++ks) qf[ks] = *(const bf16x8*)&p.proj[tok * NP + qoff + ks * 32 + kg * 8];
  }
  f32x4 st[10];
#pragma unroll
  for (int mt = 0; mt < 10; ++mt) {
    int ki = kbase + mt * 16 + r; ki = ki < 0 ? 0 : ki;
    const size_t tok = rb + ((size_t)ki << dsh) + rres;
    f32x4 a = (f32x4){0.f, 0.f, 0.f, 0.f};
#pragma unroll
    for (int ks = 0; ks < 2; ++ks) {
      bf16x8 kf = *(const bf16x8*)&p.proj[tok * NP + koff + ks * 32 + kg * 8];
      a = MFMA(kf, qf[ks], a);
    }
    st[mt] = a;
  }
  const int qi = i0 + r;
  float mx = -3.0e38f;
#pragma unroll
  for (int mt = 0; mt < 10; ++mt)
#pragma unroll
    for (int j = 0; j < 4; ++j) {
      const int ki = kbase + mt * 16 + kg * 4 + j;
      const int d = qi - ki;
      const bool valid = (ki >= 0) && (d >= 0) && (d <= 128);
      const float sv = valid ? st[mt][j] * 0.125f : -3.0e38f;
      st[mt][j] = sv;
      mx = fmaxf(mx, sv);
    }
  mx = fmaxf(mx, __shfl_xor(mx, 16));
  mx = fmaxf(mx, __shfl_xor(mx, 32));
  float sum = 0.f;
#pragma unroll
  for (int mt = 0; mt < 10; ++mt)
#pragma unroll
    for (int j = 0; j < 4; ++j) {
      const float pv = (st[mt][j] > -1.0e38f) ? __expf(st[mt][j] - mx) : 0.f;
      st[mt][j] = pv;
      sum += pv;
    }
  sum += __shfl_xor(sum, 16);
  sum += __shfl_xor(sum, 32);
  const float inv = 1.f / sum;
  bf16x8 pf[5];
#pragma unroll
  for (int k2 = 0; k2 < 5; ++k2) pf[k2] = pack8(st[2 * k2], st[2 * k2 + 1]);
  const size_t qrow = rb + ((size_t)qi << dsh) + rres;
#pragma unroll
  for (int nt = 0; nt < 4; ++nt) {
    f32x4 o = (f32x4){0.f, 0.f, 0.f, 0.f};
    const u16* vrow = &p.vT[((size_t)gbh * 64 + nt * 16 + r) * SEQ + (size_t)rres * ln];
#pragma unroll
    for (int k2 = 0; k2 < 5; ++k2) {
      int ka = kbase + k2 * 32 + kg * 4, kc = ka + 16;
      ka = ka < 0 ? 0 : ka; kc = kc < 0 ? 0 : kc;
      uint2 va = *(const uint2*)&vrow[ka];
      uint2 vc = *(const uint2*)&vrow[kc];
      bf16x8 vf = __builtin_bit_cast(bf16x8, make_uint4(va.x, va.y, vc.x, vc.y));
      o = MFMA(vf, pf[k2], o);
    }
    uint2 ov; ov.x = pack2(o[0] * inv, o[1] * inv); ov.y = pack2(o[2] * inv, o[3] * inv);
    *(uint2*)&p.osw[((size_t)g * MT + qrow) * 256 + h * 64 + nt * 16 + kg * 4] = ov;
  }
  if (kg == 0) p.lse[((size_t)g * MT + qrow) * 4 + h] = mx + __logf(sum);
}

DI void sw_sample_wave(const Params& p, int item) {
  const int lane = threadIdx.x & 63;
  const int t = item & 3, h = (item >> 2) & 3, b = (item >> 4) & 31, g = item >> 9;
  const int dil = 1 << (2 * g), W = 128 << (2 * g);
  const float* c1 = p.cw1;
  const float* c2 = p.cw2;
  const float* c3 = p.cw3;
  const float* cache = (g == 0) ? c1 : (g == 1 ? c2 : c3);
  const int qoff = 2048 + g * 768 + h * 64;
  const size_t qrow = (size_t)MP + b * 4 + t;
  float q[64];
#pragma unroll
  for (int c = 0; c < 64; c += 8) {
    uint4 v = *(const uint4*)&p.proj[qrow * NP + qoff + c];
    q[c] = bflo(v.x); q[c + 1] = bfhi(v.x); q[c + 2] = bflo(v.y); q[c + 3] = bfhi(v.y);
    q[c + 4] = bflo(v.z); q[c + 5] = bfhi(v.z); q[c + 6] = bflo(v.w); q[c + 7] = bfhi(v.w);
  }
  float sc[3];
#pragma unroll
  for (int mi = 0; mi < 3; ++mi) {
    const int m = lane + 64 * mi;
    float s = -3.0e38f;
    if (m <= 128) {
      const int j = W + t - m * dil;
      float d = 0.f;
      if (j >= W) {
        const u16* kr = &p.proj[((size_t)MP + b * 4 + (j - W)) * NP + qoff + 256];
#pragma unroll
        for (int c = 0; c < 64; c += 8) {
          uint4 v = *(const uint4*)&kr[c];
          d += q[c] * bflo(v.x) + q[c + 1] * bfhi(v.x) + q[c + 2] * bflo(v.y) + q[c + 3] * bfhi(v.y) + q[c + 4] * bflo(v.z) +
               q[c + 5] * bfhi(v.z) + q[c + 6] * bflo(v.w) + q[c + 7] * bfhi(v.w);
        }
      } else {
        const float* kr = &cache[(((size_t)b * W + j) * 2 + 0) * 256 + h * 64];
#pragma unroll
        for (int c = 0; c < 64; c += 4) {
          float4 v = *(const float4*)&kr[c];
          d += q[c] * v.x + q[c + 1] * v.y + q[c + 2] * v.z + q[c + 3] * v.w;
        }
      }
      s = d * 0.125f;
    }
    sc[mi] = s;
  }
  float mx = wave_max(fmaxf(fmaxf(sc[0], sc[1]), sc[2]));
  float sum = 0.f;
#pragma unroll
  for (int mi = 0; mi < 3; ++mi) { sc[mi] = (sc[mi] > -1.0e38f) ? __expf(sc[mi] - mx) : 0.f; sum += sc[mi]; }
  sum = wave_sum(sum);
  float o = 0.f;
#pragma unroll
  for (int mi = 0; mi < 3; ++mi) {
#pragma unroll 8
    for (int mm = 0; mm < 64; ++mm) {
      const int m = mi * 64 + mm;
      if (m <= 128) {
        const float pv = __shfl(sc[mi], mm);
        const int j = W + t - m * dil;
        float vv;
        if (j >= W) vv = bf2f(p.proj[((size_t)MP + b * 4 + (j - W)) * NP + qoff + 512 + lane]);
        else vv = cache[(((size_t)b * W + j) * 2 + 1) * 256 + h * 64 + lane];
        o += pv * vv;
      }
    }
  }
  p.osw[((size_t)g * MT + qrow) * 256 + h * 64 + lane] = f2bf(o / sum);
  if (lane == 0) p.lse[((size_t)g * MT + qrow) * 4 + h] = mx + __logf(sum);
}

DI void phase3(const Params& p, char* smem) {
  const int w = threadIdx.x >> 6;
  if (blockIdx.x < 128) {
    dn_scan_block(p, blockIdx.x, smem);
  } else {
    const int gw = (blockIdx.x - 128) * 4 + w, nw = (gridDim.x - 128) * 4;
    for (int it = gw; it < 24576 + 1536; it += nw) {
      if (it < 24576) sw_prompt_wave(p, it);
      else sw_sample_wave(p, it - 24576);
    }
  }
}

DI void phase4(const Params& p) {
  const int lane = threadIdx.x & 63, w = threadIdx.x >> 6;
  for (int row = blockIdx.x * 4 + w; row < MT; row += gridDim.x * 4) {
    u16* dst = p.Amix + (size_t)row * 768;
#pragma unroll
    for (int h = 0; h < 4; ++h) {
      unsigned ov = *(const unsigned*)&p.odn[(size_t)row * 512 + h * 128 + lane * 2];
      unsigned zv = *(const unsigned*)&p.proj[(size_t)row * NP + 1536 + h * 128 + lane * 2];
      float o0 = bflo(ov), o1 = bfhi(ov);
      float ss = wave_sum(o0 * o0 + o1 * o1);
      float rs = rsqrtf(ss * (1.f / 128.f) + EPS);
      float2 gn = *(const float2*)&p.g_onorm[lane * 2];
      float y0 = o0 * rs * gn.x * siluf(bflo(zv)), y1 = o1 * rs * gn.y * siluf(bfhi(zv));
      *(unsigned*)&dst[h * 128 + lane * 2] = pack2(y0, y1);
    }
    {
      const int h = lane >> 4;
      float l0 = p.lse[((size_t)0 * MT + row) * 4 + h], l1 = p.lse[((size_t)1 * MT + row) * 4 + h], l2 = p.lse[((size_t)2 * MT + row) * 4 + h];
      float m = fmaxf(l0, fmaxf(l1, l2));
      float e0 = __expf(l0 - m), e1 = __expf(l1 - m), e2 = __expf(l2 - m);
      float inv = 1.f / (e0 + e1 + e2);
      uint2 a = *(const uint2*)&p.osw[((size_t)0 * MT + row) * 256 + lane * 4];
      uint2 c = *(const uint2*)&p.osw[((size_t)1 * MT + row) * 256 + lane * 4];
      uint2 d = *(const uint2*)&p.osw[((size_t)2 * MT + row) * 256 + lane * 4];
      e0 *= inv; e1 *= inv; e2 *= inv;
      float y0 = e0 * bflo(a.x) + e1 * bflo(c.x) + e2 * bflo(d.x);
      float y1 = e0 * bfhi(a.x) + e1 * bfhi(c.x) + e2 * bfhi(d.x);
      float y2 = e0 * bflo(a.y) + e1 * bflo(c.y) + e2 * bflo(d.y);
      float y3 = e0 * bfhi(a.y) + e1 * bfhi(c.y) + e2 * bfhi(d.y);
      *(uint2*)&dst[512 + lane * 4] = make_uint2(pack2(y0, y1), pack2(y2, y3));
    }
  }
}

DI void sample_state_copy(const Params& p) {
  const size_t gtid = (size_t)blockIdx.x * 256 + threadIdx.x, gsz = (size_t)gridDim.x * 256;
  for (size_t i = gtid; i < 147456; i += gsz) {
    const int c = (int)(i % 1536), j = (int)((i / 1536) % 3), b = (int)(i / 4608);
    p.out[O_SCONV + i] = bf2f(p.proj[((size_t)MP + b * 4 + j + 1) * NP + c]);
  }
  const float* c1 = p.cw1;
  const float* c2 = p.cw2;
  const float* c3 = p.cw3;
  for (int g = 0; g < 3; ++g) {
    const int W = 128 << (2 * g);
    const float* cache = (g == 0) ? c1 : (g == 1 ? c2 : c3);
    const size_t off = (g == 0) ? O_SW1 : (g == 1 ? O_SW2 : O_SW3);
    const size_t n4 = (size_t)32 * W * 512 / 4;
#pragma unroll 4
    for (size_t i = gtid; i < n4; i += gsz) {
      const size_t e0 = i * 4;
      const int e = (int)(e0 & 511), ii = (int)((e0 >> 9) % W), b = (int)((e0 >> 9) / W);
      float4 o;
      if (ii < W - 4) o = *(const float4*)&cache[((size_t)b * W + ii + 4) * 512 + e];
      else {
        uint2 v = *(const uint2*)&p.proj[((size_t)MP + b * 4 + (ii - (W - 4))) * NP + 2048 + g * 768 + 256 + e];
        o = make_float4(bflo(v.x), bfhi(v.x), bflo(v.y), bfhi(v.y));
      }
      *(float4*)&p.out[off + e0] = o;
    }
  }
}

DI void mem_attn_prompt_block(const Params& p, int item, char* smem) {
  const int tid = threadIdx.x, lane = tid & 63, w = tid >> 6, r = lane & 15, kg = lane >> 4;
  const int h = item & 3, qb = item >> 2;
  const int row0 = qb * 64 + w * 16, b = (qb * 64) >> 13;
  const int bh = b * 4 + h;
  u16* sK = (u16*)smem;
  bf16x8 qf[8];
#pragma unroll
  for (int ks = 0; ks < 8; ++ks) qf[ks] = *(const bf16x8*)&G(p.qb)[(size_t)(row0 + r) * 1024 + h * 256 + ks * 32 + kg * 8];
  f32x4 st[16];
  const u16* kbp = G(p.Kb) + (size_t)bh * 65536;
#pragma unroll
  for (int c = 0; c < 4; ++c) {
    __syncthreads();
#pragma unroll
    for (int i2 = 0; i2 < 2; ++i2) {
#pragma unroll
      for (int i = i2 * 4; i < i2 * 4 + 4; ++i) {
        const int idx = tid + 256 * i, row = idx >> 5, seg = idx & 31;
        *(bf16x8*)&sK[row * 264 + seg * 8] = *(gb8p)((gu16p)kbp + (size_t)(c * 64 + row) * 256 + seg * 8);
      }
      __builtin_amdgcn_sched_barrier(0);
    }
    __syncthreads();
#pragma unroll
    for (int m4 = 0; m4 < 4; ++m4) {
      f32x4 a = (f32x4){0.f, 0.f, 0.f, 0.f};
#pragma unroll
      for (int ks = 0; ks < 8; ++ks) {
        bf16x8 kf = *(const bf16x8*)&sK[(m4 * 16 + r) * 264 + ks * 32 + kg * 8];
        a = MFMA(kf, qf[ks], a);
      }
      st[c * 4 + m4] = a;
      __builtin_amdgcn_sched_barrier(0);
    }
  }
  float mx = -3.0e38f;
#pragma unroll
  for (int mt = 0; mt < 16; ++mt)
#pragma unroll
    for (int j = 0; j < 4; ++j) { st[mt][j] *= 0.0625f; mx = fmaxf(mx, st[mt][j]); }
  mx = fmaxf(mx, __shfl_xor(mx, 16));
  mx = fmaxf(mx, __shfl_xor(mx, 32));
  float sum = 0.f;
#pragma unroll
  for (int mt = 0; mt < 16; ++mt)
#pragma unroll
    for (int j = 0; j < 4; ++j) { st[mt][j] = __expf(st[mt][j] - mx); sum += st[mt][j]; }
  sum += __shfl_xor(sum, 16);
  sum += __shfl_xor(sum, 32);
  const float inv = 1.f / sum;
  bf16x8 pf[8];
#pragma unroll
  for (int k2 = 0; k2 < 8; ++k2) pf[k2] = pack8(st[2 * k2], st[2 * k2 + 1]);
  const u16* vtp = G(p.VTf) + (size_t)bh * 65536;
#pragma unroll 1
  for (int c = 0; c < 4; ++c) {
    __syncthreads();
#pragma unroll
    for (int i = 0; i < 8; ++i) {
      const int idx = tid + 256 * i;
      *(bf16x8*)&sK[idx * 8] = *(gb8p)((gu16p)vtp + (size_t)c * 16384 + idx * 8);
    }
    __syncthreads();
#pragma unroll
    for (int n4 = 0; n4 < 4; ++n4) {
      f32x4 o = (f32x4){0.f, 0.f, 0.f, 0.f};
#pragma unroll
      for (int k2 = 0; k2 < 8; ++k2) o = MFMA(*(const bf16x8*)&sK[((n4 * 8 + k2) * 64 + lane) * 8], pf[k2], o);
      uint2 ov; ov.x = pack2(o[0] * inv, o[1] * inv); ov.y = pack2(o[2] * inv, o[3] * inv);
      *(uint2*)&G(p.attn)[(size_t)(row0 + r) * 1024 + h * 256 + (c * 4 + n4) * 16 + kg * 4] = ov;
      __builtin_amdgcn_sched_barrier(0);
    }
  }
}

DI void mem_attn_sample_wave(const Params& p, int item, float* lds) {
  const int lane = threadIdx.x & 63;
  const int b = item >> 2, h = item & 3;
  float* sq = lds;
#pragma unroll
  for (int t = 0; t < 4; ++t) {
    uint2 v = *(const uint2*)&p.qb[((size_t)MP + b * 4 + t) * 1024 + h * 256 + lane * 4];
    *(float4*)&sq[t * 256 + lane * 4] = make_float4(bflo(v.x), bfhi(v.x), bflo(v.y), bfhi(v.y));
  }
  __builtin_amdgcn_s_waitcnt(0);
  __builtin_amdgcn_wave_barrier();
  float sc[4][4];
#pragma unroll
  for (int mi = 0; mi < 4; ++mi) {
    const int m = lane + 64 * mi;
    const float* kr = &p.cache_mem[(((size_t)b * 256 + m) * 2 + 0) * 1024 + h * 256];
    float d0 = 0.f, d1 = 0.f, d2 = 0.f, d3 = 0.f;
#pragma unroll 2
    for (int c = 0; c < 256; c += 4) {
      float4 kv = *(const float4*)&kr[c];
      float4 q0 = *(const float4*)&sq[c], q1 = *(const float4*)&sq[256 + c], q2 = *(const float4*)&sq[512 + c], q3 = *(const float4*)&sq[768 + c];
      d0 += kv.x * q0.x + kv.y * q0.y + kv.z * q0.z + kv.w * q0.w;
      d1 += kv.x * q1.x + kv.y * q1.y + kv.z * q1.z + kv.w * q1.w;
      d2 += kv.x * q2.x + kv.y * q2.y + kv.z * q2.z + kv.w * q2.w;
      d3 += kv.x * q3.x + kv.y * q3.y + kv.z * q3.z + kv.w * q3.w;
    }
    sc[0][mi] = d0 * 0.0625f; sc[1][mi] = d1 * 0.0625f; sc[2][mi] = d2 * 0.0625f; sc[3][mi] = d3 * 0.0625f;
  }
  float inv[4];
  __builtin_amdgcn_wave_barrier();
#pragma unroll
  for (int t = 0; t < 4; ++t) {
    float mx = wave_max(fmaxf(fmaxf(sc[t][0], sc[t][1]), fmaxf(sc[t][2], sc[t][3])));
    float sum = 0.f;
#pragma unroll
    for (int mi = 0; mi < 4; ++mi) { sc[t][mi] = __expf(sc[t][mi] - mx); sum += sc[t][mi]; }
    sum = wave_sum(sum);
    inv[t] = 1.f / sum;
#pragma unroll
    for (int mi = 0; mi < 4; ++mi) sq[t * 256 + lane + 64 * mi] = sc[t][mi];
  }
  __builtin_amdgcn_s_waitcnt(0);
  __builtin_amdgcn_wave_barrier();
  float4 o[4];
#pragma unroll
  for (int t = 0; t < 4; ++t) o[t] = make_float4(0.f, 0.f, 0.f, 0.f);
#pragma unroll 4
  for (int m = 0; m < 256; ++m) {
    float4 vv = *(const float4*)&p.cache_mem[(((size_t)b * 256 + m) * 2 + 1) * 1024 + h * 256 + lane * 4];
#pragma unroll
    for (int t = 0; t < 4; ++t) {
      const float pv = sq[t * 256 + m];
      o[t].x += pv * vv.x; o[t].y += pv * vv.y; o[t].z += pv * vv.z; o[t].w += pv * vv.w;
    }
  }
#pragma unroll
  for (int t = 0; t < 4; ++t) {
    uint2 ov; ov.x = pack2(o[t].x * inv[t], o[t].y * inv[t]); ov.y = pack2(o[t].z * inv[t], o[t].w * inv[t]);
    *(uint2*)&p.attn[((size_t)MP + b * 4 + t) * 1024 + h * 256 + lane * 4] = ov;
  }
  __builtin_amdgcn_wave_barrier();
}

DI void phase7(const Params& p, char* smem) {
  const int w = threadIdx.x >> 6;
  float* lds = (float*)smem + w * 1280;
  for (int it = blockIdx.x; it < 32 + 2048; it += gridDim.x) {
    if (it < 32) { __syncthreads(); mem_attn_sample_wave(p, it * 4 + w, lds); }
    else mem_attn_prompt_block(p, it - 32, smem);
  }
}

DI void peer_topk_wave(const Params& p, int item, unsigned* lds  ) {
  const int lane = threadIdx.x & 63, r = lane & 15, kg = lane >> 4;
  const int h = item & 7, row0 = (item >> 3) * 16;
  unsigned win[2][16];
#pragma unroll
  for (int pp = 0; pp < 2; ++pp) {
    bf16x8 qf[4];
#pragma unroll
    for (int ks = 0; ks < 4; ++ks) qf[ks] = *(const bf16x8*)&p.pq[(size_t)(row0 + r) * 2048 + h * 256 + pp * 128 + ks * 32 + kg * 8];
    unsigned kk[32];
    const u16* sk = p.subkb + (size_t)(h * 2 + pp) * 16384;
#pragma unroll
    for (int mt = 0; mt < 8; ++mt) {
      f32x4 a = (f32x4){0.f, 0.f, 0.f, 0.f};
#pragma unroll
      for (int ks = 0; ks < 4; ++ks) {
        bf16x8 kf = *(const bf16x8*)&sk[(mt * 16 + r) * 128 + ks * 32 + kg * 8];
        a = MFMA(kf, qf[ks], a);
      }
#pragma unroll
      for (int j = 0; j < 4; ++j) kk[mt * 4 + j] = (ordf(a[j]) & ~127u) | (unsigned)(mt * 16 + kg * 4 + j);
    }
#pragma unroll
    for (int rr = 0; rr < 16; ++rr) {
      unsigned m = 0;
#pragma unroll
      for (int i = 0; i < 32; ++i) m = umax(m, kk[i]);
      m = umax(m, (unsigned)__shfl_xor((int)m, 16));
      m = umax(m, (unsigned)__shfl_xor((int)m, 32));
      win[pp][rr] = m;
#pragma unroll
      for (int i = 0; i < 32; ++i) kk[i] = (kk[i] == m) ? 0u : kk[i];
    }
  }
  float f0[16], f1[16];
#pragma unroll
  for (int i = 0; i < 16; ++i) { f0[i] = unordf(win[0][i] & ~127u); f1[i] = unordf(win[1][i] & ~127u); }
  unsigned cand[13];
#define CAND(s, a0, b0, a1, b1, a2, b2, a3, b3)                                                         \
  {                                                                                                     \
    float va = sel4(kg, f0[a0], f0[a1], f0[a2], f0[(a3) < 0 ? 0 : (a3)]);                                \
    float vb = sel4(kg, f1[b0], f1[b1], f1[b2], f1[(b3) < 0 ? 0 : (b3)]);                                \
    unsigned id = sel4(kg, (unsigned)((a0) * 16 + (b0)), (unsigned)((a1) * 16 + (b1)), (unsigned)((a2) * 16 + (b2)), (unsigned)(((a3) < 0 ? 0 : (a3)) * 16 + ((b3) < 0 ? 0 : (b3)))); \
    unsigned key = (ordf(va + vb) & ~255u) | id;                                                        \
    if ((a3) < 0) key = (kg == 3) ? 0u : key;                                                           \
    cand[s] = key;                                                                                      \
  }
  CAND(0, 0, 0, 0, 13, 2, 0, 6, 1)
  CAND(1, 0, 1, 0, 14, 2, 1, 7, 0)
  CAND(2, 0, 2, 0, 15, 2, 2, 7, 1)
  CAND(3, 0, 3, 1, 0, 2, 3, 8, 0)
  CAND(4, 0, 4, 1, 1, 2, 4, 9, 0)
  CAND(5, 0, 5, 1, 2, 3, 0, 10, 0)
  CAND(6, 0, 6, 1, 3, 3, 1, 11, 0)
  CAND(7, 0, 7, 1, 4, 3, 2, 12, 0)
  CAND(8, 0, 8, 1, 5, 3, 3, 13, 0)
  CAND(9, 0, 9, 1, 6, 4, 2, 14, 0)
  CAND(10, 0, 10, 1, 7, 5, 0, 15, 0)
  CAND(11, 0, 11, 4, 0, 5, 1, -1, -1)
  CAND(12, 0, 12, 4, 1, 6, 0, -1, -1)
#undef CAND
  unsigned w2[16];
#pragma unroll
  for (int rr = 0; rr < 16; ++rr) {
    unsigned m = 0;
#pragma unroll
    for (int i = 0; i < 13; ++i) m = umax(m, cand[i]);
    m = umax(m, (unsigned)__shfl_xor((int)m, 16));
    m = umax(m, (unsigned)__shfl_xor((int)m, 32));
    w2[rr] = m;
#pragma unroll
    for (int i = 0; i < 13; ++i) cand[i] = (cand[i] == m) ? 0u : cand[i];
  }
  if (kg == 0) {
#pragma unroll
    for (int i = 0; i < 16; ++i) { lds[r * 32 + i] = win[0][i] & 127u; lds[r * 32 + 16 + i] = win[1][i] & 127u; }
  }
  __builtin_amdgcn_s_waitcnt(0);
  __builtin_amdgcn_wave_barrier();
  const float cv0 = unordf(w2[0] & ~255u);
  float sum = 0.f;
#pragma unroll
  for (int rr = 0; rr < 16; ++rr) sum += __expf(unordf(w2[rr] & ~255u) - cv0);
  const float inv = 1.f / sum;
  const size_t ob = ((size_t)(row0 + r) * 8 + h) * 16;
#pragma unroll
  for (int q = 0; q < 4; ++q) {
    const unsigned wk = sel4(kg, w2[q], w2[4 + q], w2[8 + q], w2[12 + q]);
    const int a = (wk >> 4) & 15, bb = wk & 15;
    const int i1 = (int)lds[r * 32 + a], i2 = (int)lds[r * 32 + 16 + bb];
    p.eid[ob + kg * 4 + q] = i1 * 128 + i2;
    p.gate[ob + kg * 4 + q] = __expf(unordf(wk & ~255u) - cv0) * inv;
  }
  __builtin_amdgcn_wave_barrier();
}

typedef __attribute__((ext_vector_type(2))) float f32x2;
DI float dot16_fp8(u32x4 u, const float* x, float c) {
  const unsigned d[4] = {u[0], u[1], u[2], u[3]};
#pragma unroll
  for (int i = 0; i < 4; ++i) {
    f32x2 a = __builtin_amdgcn_cvt_pk_f32_fp8((int)d[i], false);
    f32x2 b = __builtin_amdgcn_cvt_pk_f32_fp8((int)d[i], true);
    c += a[0] * x[4 * i] + a[1] * x[4 * i + 1] + b[0] * x[4 * i + 2] + b[1] * x[4 * i + 3];
  }
  return c;
}
DI void axpy16_fp8(float* o, float w, u32x4 u) {
  const unsigned d[4] = {u[0], u[1], u[2], u[3]};
#pragma unroll
  for (int i = 0; i < 4; ++i) {
    f32x2 a = __builtin_amdgcn_cvt_pk_f32_fp8((int)d[i], false);
    f32x2 b = __builtin_amdgcn_cvt_pk_f32_fp8((int)d[i], true);
    o[4 * i] += w * a[0]; o[4 * i + 1] += w * a[1]; o[4 * i + 2] += w * b[0]; o[4 * i + 3] += w * b[1];
  }
}

DI void peer_expert_wave(const Params& p, int row) {
  const int lane = __builtin_amdgcn_mbcnt_hi(-1, __builtin_amdgcn_mbcnt_lo(-1, 0));
  float xf[16];
  {
    const uint4 x0 = *(const uint4*)&G(p.A2)[(size_t)row * 1024 + lane * 16];
    const uint4 x1 = *(const uint4*)&G(p.A2)[(size_t)row * 1024 + lane * 16 + 8];
    xf[0] = bflo(x0.x); xf[1] = bfhi(x0.x); xf[2] = bflo(x0.y); xf[3] = bfhi(x0.y);
    xf[4] = bflo(x0.z); xf[5] = bfhi(x0.z); xf[6] = bflo(x0.w); xf[7] = bfhi(x0.w);
    xf[8] = bflo(x1.x); xf[9] = bfhi(x1.x); xf[10] = bflo(x1.y); xf[11] = bfhi(x1.y);
    xf[12] = bflo(x1.z); xf[13] = bfhi(x1.z); xf[14] = bflo(x1.w); xf[15] = bfhi(x1.w);
  }
  const float r2 = rsqrtf(p.ssq2[row] * (1.f / 1024.f) + EPS);
  const unsigned char AS1* EU8 = (const unsigned char AS1*)p.E8;
  const unsigned char AS1* EV8 = (const unsigned char AS1*)p.E8 + (size_t)16384 * 1024;
  float out[16];
#pragma unroll
  for (int i = 0; i < 16; ++i) out[i] = 0.f;
#pragma unroll 1
  for (int bt = 0; bt < 2; ++bt) {
    const int eidv = G(p.eid)[(size_t)row * 128 + bt * 64 + lane];
    const float gv = G(p.gate)[(size_t)row * 128 + bt * 64 + lane];
    const float rsu = G(p.rs)[eidv], rsv = G(p.rs)[16384 + eidv];
    float part[64];
#pragma unroll
    for (int e = 0; e < 64; ++e) {
      const int id = __builtin_amdgcn_readlane(eidv, e);
      const u32x4 u = *(const u32x4 AS1*)(EU8 + (size_t)id * 1024 + lane * 16);
      part[e] = dot16_fp8(u, xf, 0.f);
    }
#pragma unroll
    for (int off = 32; off > 0; off >>= 1) {
      const bool up = (lane & off) != 0;
#pragma unroll
      for (int i = 0; i < off; ++i) {
        const float a = part[i], bq = part[i + off];
        const float send = up ? a : bq, keep = up ? bq : a;
        part[i] = keep + __shfl_xor(send, off);
      }
    }
    const float wv = gv * geluf(part[0] * r2 * rsu) * rsv;
#pragma unroll 8
    for (int e = 0; e < 64; ++e) {
      const int id = __builtin_amdgcn_readlane(eidv, e);
      const float we = __int_as_float(__builtin_amdgcn_readlane(__float_as_int(wv), e));
      const u32x4 v = *(const u32x4 AS1*)(EV8 + (size_t)id * 1024 + lane * 16);
      axpy16_fp8(out, we, v);
    }
  }
  const float* hr = G(p.h2) + (size_t)row * 1024 + lane * 16;
  float hv[16];
  float ss = 0.f;
#pragma unroll
  for (int i = 0; i < 4; ++i) {
    float4 t = *(const float4*)&hr[i * 4];
    hv[4 * i] = t.x + out[4 * i]; hv[4 * i + 1] = t.y + out[4 * i + 1]; hv[4 * i + 2] = t.z + out[4 * i + 2]; hv[4 * i + 3] = t.w + out[4 * i + 3];
    ss += hv[4 * i] * hv[4 * i] + hv[4 * i + 1] * hv[4 * i + 1] + hv[4 * i + 2] * hv[4 * i + 2] + hv[4 * i + 3] * hv[4 * i + 3];
  }
  ss = wave_sum(ss);
  const float rsn = rsqrtf(ss * (1.f / 1024.f) + EPS);
  float* y = ((row < MP) ? (G(p.out) + O_YP + (size_t)row * 1024) : (G(p.out) + O_YS + (size_t)(row - MP) * 1024)) + lane * 16;
#pragma unroll
  for (int i = 0; i < 4; ++i) {
    float4 g4 = *(const float4*)&p.g_final[lane * 16 + i * 4];
    *(float4*)&y[i * 4] = make_float4(hv[4 * i] * rsn * g4.x, hv[4 * i + 1] * rsn * g4.y, hv[4 * i + 2] * rsn * g4.z, hv[4 * i + 3] * rsn * g4.w);
  }
}

DI void peer_u_wave(const Params& p, int row, float* wl  ) {
  const int lane = __builtin_amdgcn_mbcnt_hi(-1, __builtin_amdgcn_mbcnt_lo(-1, 0));
  float xf[16];
  {
    const u32x4 x0 = *(const u32x4 AS1*)((const u16 AS1*)p.A2 + (size_t)row * 1024 + lane * 16);
    const u32x4 x1 = *(const u32x4 AS1*)((const u16 AS1*)p.A2 + (size_t)row * 1024 + lane * 16 + 8);
    xf[0] = bflo(x0[0]); xf[1] = bfhi(x0[0]); xf[2] = bflo(x0[1]); xf[3] = bfhi(x0[1]);
    xf[4] = bflo(x0[2]); xf[5] = bfhi(x0[2]); xf[6] = bflo(x0[3]); xf[7] = bfhi(x0[3]);
    xf[8] = bflo(x1[0]); xf[9] = bfhi(x1[0]); xf[10] = bflo(x1[1]); xf[11] = bfhi(x1[1]);
    xf[12] = bflo(x1[2]); xf[13] = bfhi(x1[2]); xf[14] = bflo(x1[3]); xf[15] = bfhi(x1[3]);
  }
  const float r2 = rsqrtf(((const float AS1*)p.ssq2)[row] * (1.f / 1024.f) + EPS);
  const unsigned char AS1* EU8 = (const unsigned char AS1*)p.E8;
  const float AS1* rsp = (const float AS1*)p.rs;
#pragma unroll 1
  for (int bt = 0; bt < 2; ++bt) {
    const int eidv = ((const int AS1*)p.eid)[(size_t)row * 128 + bt * 64 + lane];
    const float gv = ((const float AS1*)p.gate)[(size_t)row * 128 + bt * 64 + lane];
    const float rsu = rsp[eidv], rsv = rsp[16384 + eidv];
    float part[64];
#pragma unroll
    for (int e = 0; e < 64; ++e) {
      const int id = __builtin_amdgcn_readlane(eidv, e);
      const u32x4 u = *(const u32x4 AS1*)(EU8 + (size_t)id * 1024 + lane * 16);
      part[e] = dot16_fp8(u, xf, 0.f);
    }
#pragma unroll
    for (int off = 32; off > 0; off >>= 1) {
      const bool up = (lane & off) != 0;
#pragma unroll
      for (int i = 0; i < off; ++i) {
        const float a = part[i], bq = part[i + off];
        const float send = up ? a : bq, keep = up ? bq : a;
        part[i] = keep + __shfl_xor(send, off);
      }
    }
    wl[bt * 64 + lane] = gv * geluf(part[0] * r2 * rsu) * rsv;
  }
}

DI void peer_v_group(const Params& p, int gw, int nw, int g, const float* wlw  ) {
  const int lane = __builtin_amdgcn_mbcnt_hi(-1, __builtin_amdgcn_mbcnt_lo(-1, 0));
  const unsigned char AS1* EV8 = (const unsigned char AS1*)p.E8 + (size_t)16384 * 1024;
  float out[4][16];
  int e0[4], e1[4];
  float w0[4], w1[4];
  bool valid[4];
#pragma unroll
  for (int ts = 0; ts < 4; ++ts) {
    const int k = g * 4 + ts;
    const int row = gw + k * nw;
    valid[ts] = row < MT;
#pragma unroll
    for (int i = 0; i < 16; ++i) out[ts][i] = 0.f;
    e0[ts] = 0x7fffffff; e1[ts] = 0x7fffffff; w0[ts] = 0.f; w1[ts] = 0.f;
    if (valid[ts]) {
      e0[ts] = ((const int AS1*)p.eid)[(size_t)row * 128 + lane];
      e1[ts] = ((const int AS1*)p.eid)[(size_t)row * 128 + 64 + lane];
      w0[ts] = wlw[k * 128 + lane];
      w1[ts] = wlw[k * 128 + 64 + lane];
    }
  }
#pragma unroll 1
  for (int r = 0; r < 8; ++r) {
#pragma unroll
    for (int ts = 0; ts < 4; ++ts) {
      unsigned long long m0 = __ballot((e0[ts] >> 11) == r);
      unsigned long long m1 = __ballot((e1[ts] >> 11) == r);
      while ((m0 | m1) != 0ull) {
        u32x4 v[8];
        float we[8];
#pragma unroll
        for (int k = 0; k < 8; ++k) {
          we[k] = 0.f;
          v[k] = (u32x4){0u, 0u, 0u, 0u};
          if ((m0 | m1) != 0ull) {
            int l, id;
            if (m0 != 0ull) {
              l = __builtin_ctzll(m0); m0 &= m0 - 1ull;
              id = __builtin_amdgcn_readlane(e0[ts], l);
              we[k] = __int_as_float(__builtin_amdgcn_readlane(__float_as_int(w0[ts]), l));
            } else {
              l = __builtin_ctzll(m1); m1 &= m1 - 1ull;
              id = __builtin_amdgcn_readlane(e1[ts], l);
              we[k] = __int_as_float(__builtin_amdgcn_readlane(__float_as_int(w1[ts]), l));
            }
            v[k] = *(const u32x4 AS1*)(EV8 + (size_t)id * 1024 + lane * 16);
          }
        }
#pragma unroll
        for (int k = 0; k < 8; ++k) axpy16_fp8(out[ts], we[k], v[k]);
      }
    }
  }
#pragma unroll
  for (int ts = 0; ts < 4; ++ts) {
    if (!valid[ts]) continue;
    const int row = gw + (g * 4 + ts) * nw;
    const float AS1* hr = (const float AS1*)p.h2 + (size_t)row * 1024 + lane * 16;
    float hv[16];
    float ss = 0.f;
#pragma unroll
    for (int i = 0; i < 4; ++i) {
      f32x4 t = *(const f32x4 AS1*)&hr[i * 4];
      hv[4 * i] = t[0] + out[ts][4 * i]; hv[4 * i + 1] = t[1] + out[ts][4 * i + 1]; hv[4 * i + 2] = t[2] + out[ts][4 * i + 2]; hv[4 * i + 3] = t[3] + out[ts][4 * i + 3];
      ss += hv[4 * i] * hv[4 * i] + hv[4 * i + 1] * hv[4 * i + 1] + hv[4 * i + 2] * hv[4 * i + 2] + hv[4 * i + 3] * hv[4 * i + 3];
    }
    ss = wave_sum(ss);
    const float rsn = rsqrtf(ss * (1.f / 1024.f) + EPS);
    float AS1* y = ((row < MP) ? ((float AS1*)p.out + O_YP + (size_t)row * 1024) : ((float AS1*)p.out + O_YS + (size_t)(row - MP) * 1024)) + lane * 16;
#pragma unroll
    for (int i = 0; i < 4; ++i) {
      f32x4 g4 = *(const f32x4 AS1*)&((const float AS1*)p.g_final)[lane * 16 + i * 4];
      f32x4 o;
      o[0] = hv[4 * i] * rsn * g4[0]; o[1] = hv[4 * i + 1] * rsn * g4[1]; o[2] = hv[4 * i + 2] * rsn * g4[2]; o[3] = hv[4 * i + 3] * rsn * g4[3];
      *(f32x4 AS1*)&y[i * 4] = o;
    }
  }
}


#define XB_TMO      128
#define XB_XCNT(j)  (256  + 64 * (j))
#define XB_XSUB(j)  (1280 + 64 * (j))
#define XB_XGEN(j)  (2304 + 64 * (j))
#define XB_TOP      3328
#define XB_TOPGEN   3392
#define XCD_BAR_WORDS 3456
#define XB_SPIN_CAP (1u << 18)
#define LAS __attribute__((address_space(3)))
DI unsigned xb_ld(unsigned* q) { return __hip_atomic_load(q, __ATOMIC_RELAXED, __HIP_MEMORY_SCOPE_AGENT); }
DI unsigned xb_add(unsigned* q, unsigned v) { return __hip_atomic_fetch_add(q, v, __ATOMIC_RELAXED, __HIP_MEMORY_SCOPE_AGENT); }
DI unsigned xb_xcc_id() { return (unsigned)__builtin_amdgcn_s_getreg((3 << 11) | 20) & 0xFu; }
#define XB_SPIN(cond, bar) do { unsigned _sp = 0; while (cond) { __builtin_amdgcn_s_sleep(1); \
    if ((++_sp & 255u) == 0u) { if (xb_ld(&(bar)[XB_TMO])) break; if (_sp > XB_SPIN_CAP) { atomicAdd(&(bar)[XB_TMO], 1u); break; } } } } while (0)
struct XcdBarrier { unsigned* bar; unsigned x; volatile LAS unsigned* st; };
DI XcdBarrier xcd_barrier_post(unsigned* bar, volatile LAS unsigned* st) {
  XcdBarrier b; b.bar = bar; b.x = xb_xcc_id(); b.st = st;
  if (threadIdx.x == 0) (void)xb_add(&bar[XB_XCNT(b.x)], 1u);
  return b;
}
DI void xcd_barrier_complete(unsigned* bar, unsigned x, unsigned& nloc, unsigned& nx) {
  const unsigned G = gridDim.x * gridDim.y * gridDim.z;
  unsigned sum, cnt, mine, sp = 0u;
  for (;;) {
    sum = 0u; cnt = 0u; mine = 0u;
#pragma unroll
    for (unsigned j = 0; j < 16; ++j) { const unsigned c = xb_ld(&bar[XB_XCNT(j)]); sum += c; cnt += (c > 0u) ? 1u : 0u; mine = (j == x) ? c : mine; }
    if (sum == G) break;
    __builtin_amdgcn_s_sleep(1);
    if ((++sp & 255u) == 0u) { if (xb_ld(&bar[XB_TMO])) break; if (sp > XB_SPIN_CAP) { atomicAdd(&bar[XB_TMO], 1u); break; } }
  }
  nloc = mine > 0u ? mine : 1u; nx = cnt > 0u ? cnt : 1u;
}
DI void xcd_barrier(const XcdBarrier& b) {
  asm volatile("s_waitcnt vmcnt(0)" ::: "memory");
  __syncthreads();
  if (threadIdx.x == 0) {
    unsigned* bar = b.bar;
    __builtin_amdgcn_s_waitcnt(0);
    unsigned nloc = b.st[0], nx = b.st[1];
    if (nloc == 0u) { xcd_barrier_complete(bar, b.x, nloc, nx); b.st[0] = nloc; b.st[1] = nx; }
    const unsigned old = xb_add(&bar[XB_XSUB(b.x)], 1u);
    const unsigned gen = old / nloc;
    if (old + 1u == (gen + 1u) * nloc) {
      __builtin_amdgcn_fence(__ATOMIC_RELEASE, "agent");
      asm volatile("s_waitcnt vmcnt(0)" ::: "memory");
      const unsigned og = xb_add(&bar[XB_TOP], 1u);
      const unsigned tg = og / nx;
      if (og + 1u == (tg + 1u) * nx) xb_add(&bar[XB_TOPGEN], 1u);
      else XB_SPIN(xb_ld(&bar[XB_TOPGEN]) == tg, bar);
      __builtin_amdgcn_fence(__ATOMIC_ACQUIRE, "agent");
      xb_add(&bar[XB_XGEN(b.x)], 1u);
      asm volatile("s_waitcnt vmcnt(0)" ::: "memory");
    } else {
      XB_SPIN(xb_ld(&bar[XB_XGEN(b.x)]) == gen, bar);
      __builtin_amdgcn_fence(__ATOMIC_ACQUIRE, "agent");
      asm volatile("s_waitcnt vmcnt(0)" ::: "memory");
    }
  }
  __syncthreads();
}

__global__ void __launch_bounds__(256, 2) mega(Params pk) {
  __shared__ __attribute__((aligned(16))) char smem[65536];
  __shared__ Params sp;
  cg::grid_group grid = cg::this_grid();
  const int w = threadIdx.x >> 6;
  __shared__ uint4 xb_words;
  if (threadIdx.x == 0) { sp = pk; xb_words = make_uint4(0u, 0u, 0u, 0u); }
  __syncthreads();
  const Params& p = sp;
  XcdBarrier xb = xcd_barrier_post(p.bar, (volatile LAS unsigned*)&xb_words);
  if (p.never) grid.sync();
#define GSYNC() xcd_barrier(xb)
#define REP(ph) for (int rp_ = 0; rp_ < ((DBL == (ph)) ? 2 : 1); ++rp_)
  REP(0) { phase0(p, smem); if (DBL == 0) grid.sync(); }
  GSYNC();
  REP(1) {
    int tm, tn;
    for (int it = 0; it * (int)gridDim.x < 129 * 34; ++it)
      if (xcd_tile(it, 129, 34, tm, tn)) gemm_tile<0, 1024>(p, p.A0, 1024, p.WtIn, tm, tn, smem);
    for (int u = blockIdx.x; u < 64; u += gridDim.x) gemm_tile<1, 1024>(p, p.Amem, 1024, p.WtMkv, u / 16, u % 16, smem);
  }
  GSYNC();
  REP(2) { phase2(p, smem); if (DBL == 2) grid.sync(); }
  GSYNC();
  REP(3) { phase3(p, smem); if (DBL == 3) grid.sync(); }
  GSYNC();
  REP(4) phase4(p);
  GSYNC();
  { int tm, tn; for (int it = 0; it * (int)gridDim.x < 257 * 8; ++it) if (xcd_tile(it, 257, 8, tm, tn)) gemm_tile128<2, 768>(p, p.Amix, 768, p.WtOut, tm, tn, smem); }
  GSYNC();
  REP(6) { int tm, tn; for (int it = 0; it * (int)gridDim.x < 257 * 8; ++it) if (xcd_tile(it, 257, 8, tm, tn)) gemm_tile128<3, 1024>(p, p.A1, 1024, p.WtMq, tm, tn, smem); }
  sample_state_copy(p);
  GSYNC();
  REP(7) phase7(p, smem);
  GSYNC();
  { int tm, tn; for (int it = 0; it * (int)gridDim.x < 257 * 8; ++it) if (xcd_tile(it, 257, 8, tm, tn)) gemm_tile128<4, 1024>(p, p.attn, 1024, p.WtMo, tm, tn, smem); }
  GSYNC();
  REP(9) { int tm, tn; for (int it = 0; it * (int)gridDim.x < 129 * 16; ++it) if (xcd_tile(it, 129, 16, tm, tn)) gemm_tile<5, 1024>(p, p.A2, 1024, p.WtPq, tm, tn, smem); }
  GSYNC();
  REP(10) {
    unsigned* lds = (unsigned*)smem + w * 512;
    for (int it = blockIdx.x * 4 + w; it < 2056 * 8; it += gridDim.x * 4) peer_topk_wave(p, it, lds);
  }
  GSYNC();
  REP(11) {
    const int gw = blockIdx.x * 4 + w, nw = gridDim.x * 4;
    float* wlw = (float*)smem + w * (17 * 128);
    __syncthreads();
    for (int k = 0; gw + k * nw < MT && k < 17; ++k) peer_u_wave(p, gw + k * nw, wlw + k * 128);
    __builtin_amdgcn_s_waitcnt(0xc07f);
    __builtin_amdgcn_wave_barrier();
    for (int g = 0; (g * 4) * nw + gw < MT && g < 5; ++g) peer_v_group(p, gw, nw, g, wlw);
  }
}

extern "C" void kernel_launch(void* const* d_in, const int* in_sizes, int n_in, void* d_out, int out_size, void* d_ws, size_t ws_size,
                              hipStream_t stream) {
  static int grid_blocks = 0;
  if (!grid_blocks) {
    int dev = 0, cus = 0, per_cu = 0;
    (void)hipGetDevice(&dev);
    (void)hipDeviceGetAttribute(&cus, hipDeviceAttributeMultiprocessorCount, dev);
    (void)hipOccupancyMaxActiveBlocksPerMultiprocessor(&per_cu, mega, 256, 0);
    if (per_cu > 2) per_cu = 2;
    if (per_cu < 1) per_cu = 1;
    grid_blocks = cus * per_cu;
  }
  Params p{};
  const float* const* in = (const float* const*)d_in;
  p.x_prompt = in[0]; p.x_sample = in[1]; p.state_delta = in[2]; p.state_conv = in[3]; p.cw1 = in[4]; p.cw2 = in[5]; p.cw3 = in[6];
  p.cache_mem = in[7]; p.mem_prompt = in[8]; p.g_mix = in[9]; p.w_in = in[10]; p.conv_w = in[11]; p.a_log = in[12]; p.dt_bias = in[13];
  p.g_onorm = in[14]; p.w_out = in[15]; p.g_memq = in[16]; p.g_memkv = in[17]; p.w_mq = in[18]; p.w_mkv = in[19]; p.w_mo = in[20];
  p.g_ffn = in[21]; p.w_pq = in[22]; p.sub_keys = in[23]; p.expert_u = in[24]; p.expert_v = in[25]; p.g_final = in[26];
  p.out = (float*)d_out;
  char* ws = (char*)d_ws;
  size_t off = 0;
  auto take = [&](size_t bytes) { char* r = ws + off; off += (bytes + 255) & ~(size_t)255; return r; };
  p.WtIn = (u16*)take((size_t)NP * 1024 * 2);
  p.WtOut = (u16*)take((size_t)1024 * 768 * 2);
  p.WtMq = (u16*)take((size_t)1024 * 1024 * 2);
  p.WtMkv = (u16*)take((size_t)2048 * 1024 * 2);
  p.WtMo = (u16*)take((size_t)1024 * 1024 * 2);
  p.WtPq = (u16*)take((size_t)2048 * 1024 * 2);
  p.subkb = (u16*)take((size_t)262144 * 2);
  p.E8 = (unsigned char*)take((size_t)32768 * 1024);
  p.rs = (float*)take((size_t)32768 * 4);
  p.Amem = (u16*)take((size_t)1024 * 1024 * 2);
  p.gb = (float*)take((size_t)MT * 8 * 4);
  p.ssq1 = (float*)take((size_t)MT * 4);
  p.ssq2 = (float*)take((size_t)MT * 4);
  p.dl = (float*)take(2048 * 4);
  p.Kb = (u16*)take((size_t)16 * 65536 * 2);
  p.VTf = (u16*)take((size_t)16 * 65536 * 2);
  char* regA = take((size_t)MT * NP * 2);
  char* regB = take((size_t)2048 * DN_ITEM);
  p.proj = (u16*)regA;
  p.h1 = (float*)regA;
  p.h2 = (float*)(regA + (size_t)MT * 1024 * 4);
  p.pq = (u16*)regA;
  p.dnops = regB;
  p.A0 = (u16*)regB;
  p.A1 = (u16*)regB;
  p.qb = (u16*)(regB + (size_t)MT * 1024 * 2);
  p.attn = (u16*)regB;
  p.A2 = (u16*)(regB + (size_t)MT * 1024 * 2);
  p.eid = (int*)regB;
  p.gate = (float*)(regB + (size_t)MT * 128 * 4);
  char* ob = (char*)d_out;
  p.vT = (u16*)ob;
  p.osw = (u16*)(ob + (size_t)3 * MP * 256 * 2);
  p.lse = (float*)(ob + (size_t)3 * MP * 256 * 2 + (size_t)3 * MT * 256 * 2);
  char* sb = ob + O_SW3 * 4;
  p.odn = (u16*)sb;
  p.Amix = (u16*)(sb + (size_t)MT * 512 * 2);
  p.bar = (unsigned*)take((size_t)XCD_BAR_WORDS * 4);
  p.never = 0;
  p.pad_ = 0;
  if (off > ws_size) { fprintf(stderr, "workspace too small: need %zu have %zu\n", off, ws_size); return; }
  (void)hipMemsetAsync(p.bar, 0, (size_t)XCD_BAR_WORDS * 4, stream);
  void* args[] = {&p};
  hipError_t e = hipLaunchCooperativeKernel((void*)mega, dim3(grid_blocks), dim3(256), args, 0, stream);
  if (e != hipSuccess) fprintf(stderr, "coop launch failed: %s (grid %d)\n", hipGetErrorString(e), grid_blocks);
}
```

```cpp
#include <hip/hip_runtime.h>
#include <hip/hip_cooperative_groups.h>
#include <cstdio>
namespace cg = cooperative_groups;

typedef unsigned short u16;
typedef __attribute__((ext_vector_type(8))) short bf16x8;
typedef __attribute__((ext_vector_type(4))) float f32x4;
typedef __attribute__((ext_vector_type(2))) __bf16 bf2_t;

#define DI __device__ __forceinline__
#define MFMA(a, b, c) __builtin_amdgcn_mfma_f32_16x16x32_bf16((a), (b), (c), 0, 0, 0)

#ifndef DBL
#define DBL -1
#endif
constexpr int MP = 32768, MS = 128, MT = 32896;
constexpr int NP = 4352;
constexpr int SEQ = 8192;
constexpr float EPS = 1e-6f;
constexpr size_t DN_ITEM = 73728;

constexpr size_t O_YP = 0, O_YS = 33554432, O_PDELTA = 33685504, O_PCONV = 33947648, O_PW1 = 33966080,
                 O_PW2 = 34228224, O_PW3 = 35276800, O_PMEM = 39471104, O_SDELTA = 41568256, O_SCONV = 43665408,
                 O_SW1 = 43812864, O_SW2 = 45910016, O_SW3 = 54298624;

struct Params {
  const float *x_prompt, *x_sample, *state_delta, *state_conv, *cw1, *cw2, *cw3, *cache_mem, *mem_prompt;
  const float *g_mix, *w_in, *conv_w, *a_log, *dt_bias, *g_onorm, *w_out, *g_memq, *g_memkv, *w_mq, *w_mkv, *w_mo;
  const float *g_ffn, *w_pq, *sub_keys, *expert_u, *expert_v, *g_final;
  float* out;
  u16 *WtIn, *WtOut, *WtMq, *WtMkv, *WtMo, *WtPq, *subkb, *Amem;
  unsigned char* E8;
  float* rs;
  float *gb, *ssq1, *ssq2, *dl;
  u16 *Kb, *VTf;
  u16* proj;
  u16 *h1, *h2;
  u16* pq;
  char* dnops;
  u16 *A0, *A1, *qb, *attn, *A2;
  int* eid;
  float* gate;
  u16 *vT, *osw, *odn, *Amix;
  float* lse;
  unsigned* bar;
  int never;
  int pad_;
};

#define AS1 __attribute__((address_space(1)))
template <typename T> DI T* G(T* q) { return q; }
typedef const bf16x8 AS1* gb8p;
typedef const u16 AS1* gu16p;
typedef __attribute__((ext_vector_type(4))) unsigned u32x4;
DI u16 f2bf(float x) { unsigned u = __float_as_uint(x); u += 0x7fffu + ((u >> 16) & 1u); return (u16)(u >> 16); }
DI float bf2f(u16 h) { return __uint_as_float(((unsigned)h) << 16); }
DI unsigned pack2(float a, float b) { return (unsigned)f2bf(a) | ((unsigned)f2bf(b) << 16); }
DI float bflo(unsigned d) { return __uint_as_float(d << 16); }
DI float bfhi(unsigned d) { return __uint_as_float(d & 0xffff0000u); }
DI bf16x8 pack8(f32x4 a, f32x4 b) {
  uint4 r; r.x = pack2(a[0], a[1]); r.y = pack2(a[2], a[3]); r.z = pack2(b[0], b[1]); r.w = pack2(b[2], b[3]);
  return __builtin_bit_cast(bf16x8, r);
}
DI float wave_sum(float v) {
#pragma unroll
  for (int o = 32; o > 0; o >>= 1) v += __shfl_xor(v, o);
  return v;
}
DI float wave_max(float v) {
#pragma unroll
  for (int o = 32; o > 0; o >>= 1) v = fmaxf(v, __shfl_xor(v, o));
  return v;
}
DI float siluf(float x) { return x / (1.f + __expf(-x)); }
DI float geluf(float x) { return 0.5f * x * (1.f + tanhf(0.7978845608028654f * (x + 0.044715f * x * x * x))); }
DI int permk(int kg, int j) { return (j < 4) ? (kg * 4 + j) : (16 + kg * 4 + (j - 4)); }
DI void cvt8(const float* __restrict__ s, u16* __restrict__ d) {
  float4 a = *(const float4*)s, b = *(const float4*)(s + 4);
  uint4 r; r.x = pack2(a.x, a.y); r.y = pack2(a.z, a.w); r.z = pack2(b.x, b.y); r.w = pack2(b.z, b.w);
  *(uint4*)d = r;
}
DI unsigned ordf(float f) { unsigned u = __float_as_uint(f); return (u & 0x80000000u) ? ~u : (u | 0x80000000u); }
DI float unordf(unsigned k) { unsigned u = (k & 0x80000000u) ? (k & 0x7fffffffu) : ~k; return __uint_as_float(u); }
DI unsigned umax(unsigned a, unsigned b) { return a > b ? a : b; }
template <typename T> DI T sel4(int L, T a, T b, T c, T d) { return L == 0 ? a : (L == 1 ? b : (L == 2 ? c : d)); }

#define AS3 __attribute__((address_space(3)))
template <int MODE, int K>
DI void gemm_tile(const Params& p, const u16* __restrict__ A, int lda, const u16* __restrict__ Bt, int tm, int tn,
                          char* smem) {
  const int tid = threadIdx.x, lane = tid & 63, w = tid >> 6;
  const int wm = w >> 1, wn = w & 1, r = lane & 15, kg = lane >> 4;
  f32x4 acc[8][4];
#pragma unroll
  for (int i = 0; i < 8; ++i)
#pragma unroll
    for (int j = 0; j < 4; ++j) acc[i][j] = (f32x4){0.f, 0.f, 0.f, 0.f};
  const int lr = lane >> 2, lkg = (lane & 3) ^ (lane >> 4);
  gu16p gA[4], gB[2];
#pragma unroll
  for (int i = 0; i < 4; ++i) gA[i] = (gu16p)A + (size_t)(tm * 256 + (w * 4 + i) * 16 + lr) * lda + lkg * 8;
#pragma unroll
  for (int i = 0; i < 2; ++i) gB[i] = (gu16p)Bt + (size_t)(tn * 128 + (w * 2 + i) * 16 + lr) * K + lkg * 8;
  const int frag_off = r * 64 + ((kg ^ (r >> 2)) * 16);
  __syncthreads();
#pragma unroll
  for (int i = 0; i < 4; ++i)
    __builtin_amdgcn_global_load_lds((const unsigned AS1*)(gA[i]), (unsigned AS3*)(smem + (w * 4 + i) * 1024), 16, 0, 0);
#pragma unroll
  for (int i = 0; i < 2; ++i)
    __builtin_amdgcn_global_load_lds((const unsigned AS1*)(gB[i]), (unsigned AS3*)(smem + 16384 + (w * 2 + i) * 1024), 16, 0, 0);
#pragma unroll 2
  for (int k = 0; k < K / 32; ++k) {
    __syncthreads();
    if (k + 1 < K / 32) {
      char* st = smem + ((k + 1) & 1) * 24576;
#pragma unroll
      for (int i = 0; i < 4; ++i)
        __builtin_amdgcn_global_load_lds((const unsigned AS1*)(gA[i] + (k + 1) * 32), (unsigned AS3*)(st + (w * 4 + i) * 1024), 16, 0, 0);
#pragma unroll
      for (int i = 0; i < 2; ++i)
        __builtin_amdgcn_global_load_lds((const unsigned AS1*)(gB[i] + (k + 1) * 32), (unsigned AS3*)(st + 16384 + (w * 2 + i) * 1024), 16, 0, 0);
    }
    const char* sa = smem + (k & 1) * 24576;
    const char* sb = sa + 16384;
    bf16x8 af[8], bfr[4];
#pragma unroll
    for (int i = 0; i < 8; ++i) af[i] = *(const bf16x8*)(sa + (wm * 8 + i) * 1024 + frag_off);
#pragma unroll
    for (int i = 0; i < 4; ++i) bfr[i] = *(const bf16x8*)(sb + (wn * 4 + i) * 1024 + frag_off);
    __builtin_amdgcn_s_setprio(1);
#pragma unroll
    for (int mt = 0; mt < 8; ++mt)
#pragma unroll
      for (int nt = 0; nt < 4; ++nt) acc[mt][nt] = MFMA(bfr[nt], af[mt], acc[mt][nt]);
    __builtin_amdgcn_s_setprio(0);
  }
#pragma unroll
  for (int mt = 0; mt < 8; ++mt) {
    const int row = tm * 256 + wm * 128 + mt * 16 + r;
    if (tm * 256 + wm * 128 + mt * 16 >= ((MODE == 1) ? 1024 : MT)) continue;
    float rs = 1.f, ssq = 0.f;
    if (MODE == 3) rs = rsqrtf(p.ssq1[row] * (1.f / 1024.f) + EPS);
    if (MODE == 5) rs = rsqrtf(p.ssq2[row] * (1.f / 1024.f) + EPS);
#pragma unroll
    for (int nt = 0; nt < 4; ++nt) {
      const int col = tn * 128 + wn * 64 + nt * 16 + kg * 4;
      f32x4 v = acc[mt][nt];
      if (MODE == 0) {
        uint2 o; o.x = pack2(v[0], v[1]); o.y = pack2(v[2], v[3]);
        *(uint2*)&p.proj[(size_t)row * NP + col] = o;
      } else if (MODE == 1) {
        *(float4*)&p.out[O_PMEM + (size_t)row * 2048 + col] = make_float4(v[0], v[1], v[2], v[3]);
      } else if (MODE == 2 || MODE == 4) {
        float4 rsd;
        const float* gn;
        if (MODE == 2) {
          rsd = (row < MP) ? *(const float4*)&p.x_prompt[(size_t)row * 1024 + col] : *(const float4*)&p.x_sample[(size_t)(row - MP) * 1024 + col];
          gn = p.g_memq;
        } else {
          { const uint2 rv = *(const uint2*)&p.h1[(size_t)row * 1024 + col]; rsd = make_float4(bflo(rv.x), bfhi(rv.x), bflo(rv.y), bfhi(rv.y)); }
          gn = p.g_ffn;
        }
        float4 h = make_float4(rsd.x + v[0], rsd.y + v[1], rsd.z + v[2], rsd.w + v[3]);
        float4 g4 = *(const float4*)&gn[col];
        ssq += h.x * h.x + h.y * h.y + h.z * h.z + h.w * h.w;
        uint2 o; o.x = pack2(h.x * g4.x, h.y * g4.y); o.y = pack2(h.z * g4.z, h.w * g4.w);
        const uint2 hb = make_uint2(pack2(h.x, h.y), pack2(h.z, h.w));
        if (MODE == 2) { *(uint2*)&p.h1[(size_t)row * 1024 + col] = hb; *(uint2*)&p.A1[(size_t)row * 1024 + col] = o; }
        else { *(uint2*)&p.h2[(size_t)row * 1024 + col] = hb; *(uint2*)&p.A2[(size_t)row * 1024 + col] = o; }
      } else if (MODE == 3) {
        uint2 o; o.x = pack2(v[0] * rs, v[1] * rs); o.y = pack2(v[2] * rs, v[3] * rs);
        *(uint2*)&p.qb[(size_t)row * 1024 + col] = o;
      } else {
        uint2 o; o.x = pack2(v[0] * rs, v[1] * rs); o.y = pack2(v[2] * rs, v[3] * rs);
        *(uint2*)&p.pq[(size_t)row * 2048 + col] = o;
      }
    }
    if (MODE == 2 || MODE == 4) {
      ssq += __shfl_xor(ssq, 16);
      ssq += __shfl_xor(ssq, 32);
      if (kg == 0) atomicAdd((MODE == 2) ? &p.ssq1[row] : &p.ssq2[row], ssq);
    }
  }
}

template <int MODE, int K>
DI void gemm_tile128(const Params& p, const u16* __restrict__ A, int lda, const u16* __restrict__ Bt, int tm, int tn,
                          char* smem) {
  const int tid = threadIdx.x, lane = tid & 63, w = tid >> 6;
  const int wm = w >> 1, wn = w & 1, r = lane & 15, kg = lane >> 4;
  f32x4 acc[4][4];
#pragma unroll
  for (int i = 0; i < 4; ++i)
#pragma unroll
    for (int j = 0; j < 4; ++j) acc[i][j] = (f32x4){0.f, 0.f, 0.f, 0.f};
  const int lr = lane >> 2, lkg = (lane & 3) ^ (lane >> 4);
  gu16p gA[4], gB[4];
#pragma unroll
  for (int i = 0; i < 4; ++i) {
    const int sub = w * 4 + i, mt = sub >> 1, ks = sub & 1;
    gA[i] = (gu16p)A + (size_t)(tm * 128 + mt * 16 + lr) * lda + ks * 32 + lkg * 8;
    gB[i] = (gu16p)Bt + (size_t)(tn * 128 + mt * 16 + lr) * K + ks * 32 + lkg * 8;
  }
  const int frag_off = r * 64 + ((kg ^ (r >> 2)) * 16);
  __syncthreads();
#pragma unroll
  for (int i = 0; i < 4; ++i) {
    __builtin_amdgcn_global_load_lds((const unsigned AS1*)(gA[i]), (unsigned AS3*)(smem + (w * 4 + i) * 1024), 16, 0, 0);
    __builtin_amdgcn_global_load_lds((const unsigned AS1*)(gB[i]), (unsigned AS3*)(smem + 16384 + (w * 4 + i) * 1024), 16, 0, 0);
  }
#pragma unroll 2
  for (int k = 0; k < K / 64; ++k) {
    __syncthreads();
    if (k + 1 < K / 64) {
      char* st = smem + ((k + 1) & 1) * 32768;
#pragma unroll
      for (int i = 0; i < 4; ++i) {
        __builtin_amdgcn_global_load_lds((const unsigned AS1*)(gA[i] + (k + 1) * 64), (unsigned AS3*)(st + (w * 4 + i) * 1024), 16, 0, 0);
        __builtin_amdgcn_global_load_lds((const unsigned AS1*)(gB[i] + (k + 1) * 64), (unsigned AS3*)(st + 16384 + (w * 4 + i) * 1024), 16, 0, 0);
      }
    }
    const char* sa = smem + (k & 1) * 32768;
    const char* sb = sa + 16384;
#pragma unroll
    for (int ks = 0; ks < 2; ++ks) {
      bf16x8 af[4], bfr[4];
#pragma unroll
      for (int i = 0; i < 4; ++i) {
        af[i] = *(const bf16x8*)(sa + ((wm * 4 + i) * 2 + ks) * 1024 + frag_off);
        bfr[i] = *(const bf16x8*)(sb + ((wn * 4 + i) * 2 + ks) * 1024 + frag_off);
      }
#pragma unroll
      for (int mt = 0; mt < 4; ++mt)
#pragma unroll
        for (int nt = 0; nt < 4; ++nt) acc[mt][nt] = MFMA(bfr[nt], af[mt], acc[mt][nt]);
    }
  }
#pragma unroll
  for (int mt = 0; mt < 4; ++mt) {
    const int row = tm * 128 + wm * 64 + mt * 16 + r;
    float rs = 1.f, ssq = 0.f;
    if (MODE == 3) rs = rsqrtf(p.ssq1[row] * (1.f / 1024.f) + EPS);
    if (MODE == 5) rs = rsqrtf(p.ssq2[row] * (1.f / 1024.f) + EPS);
#pragma unroll
    for (int nt = 0; nt < 4; ++nt) {
      const int col = tn * 128 + wn * 64 + nt * 16 + kg * 4;
      f32x4 v = acc[mt][nt];
      if (MODE == 0) {
        uint2 o; o.x = pack2(v[0], v[1]); o.y = pack2(v[2], v[3]);
        *(uint2*)&p.proj[(size_t)row * NP + col] = o;
      } else if (MODE == 1) {
        *(float4*)&p.out[O_PMEM + (size_t)row * 2048 + col] = make_float4(v[0], v[1], v[2], v[3]);
      } else if (MODE == 2 || MODE == 4) {
        float4 rsd;
        const float* gn;
        if (MODE == 2) {
          rsd = (row < MP) ? *(const float4*)&p.x_prompt[(size_t)row * 1024 + col] : *(const float4*)&p.x_sample[(size_t)(row - MP) * 1024 + col];
          gn = p.g_memq;
        } else {
          { const uint2 rv = *(const uint2*)&p.h1[(size_t)row * 1024 + col]; rsd = make_float4(bflo(rv.x), bfhi(rv.x), bflo(rv.y), bfhi(rv.y)); }
          gn = p.g_ffn;
        }
        float4 h = make_float4(rsd.x + v[0], rsd.y + v[1], rsd.z + v[2], rsd.w + v[3]);
        float4 g4 = *(const float4*)&gn[col];
        ssq += h.x * h.x + h.y * h.y + h.z * h.z + h.w * h.w;
        uint2 o; o.x = pack2(h.x * g4.x, h.y * g4.y); o.y = pack2(h.z * g4.z, h.w * g4.w);
        const uint2 hb = make_uint2(pack2(h.x, h.y), pack2(h.z, h.w));
        if (MODE == 2) { *(uint2*)&p.h1[(size_t)row * 1024 + col] = hb; *(uint2*)&p.A1[(size_t)row * 1024 + col] = o; }
        else { *(uint2*)&p.h2[(size_t)row * 1024 + col] = hb; *(uint2*)&p.A2[(size_t)row * 1024 + col] = o; }
      } else if (MODE == 3) {
        uint2 o; o.x = pack2(v[0] * rs, v[1] * rs); o.y = pack2(v[2] * rs, v[3] * rs);
        *(uint2*)&p.qb[(size_t)row * 1024 + col] = o;
      } else {
        uint2 o; o.x = pack2(v[0] * rs, v[1] * rs); o.y = pack2(v[2] * rs, v[3] * rs);
        *(uint2*)&p.pq[(size_t)row * 2048 + col] = o;
      }
    }
    if (MODE == 2 || MODE == 4) {
      ssq += __shfl_xor(ssq, 16);
      ssq += __shfl_xor(ssq, 32);
      if (kg == 0) atomicAdd((MODE == 2) ? &p.ssq1[row] : &p.ssq2[row], ssq);
    }
  }
}

DI bool xcd_tile(int it, int nM, int nN, int& tm, int& tn) {
  const int per = gridDim.x >> 3;
  const int xcd = blockIdx.x & 7, li = blockIdx.x >> 3;
  const int i = (it * 8 + xcd) * per + li;
  if (i >= nM * nN) return false;
  const int panel = i / (8 * nN), within = i - panel * 8 * nN;
  const int rows = (nM - panel * 8) < 8 ? (nM - panel * 8) : 8;
  tn = within / rows;
  tm = panel * 8 + (within - tn * rows);
  return true;
}

DI void tr_tile(const float* __restrict__ W, int ldw, int nsrc0, u16* __restrict__ Wt, int K, int k0, int n0, float* tile) {
  const int tid = threadIdx.x;
  const int n = tid & 63, kq = tid >> 6;
  __syncthreads();
#pragma unroll
  for (int i = 0; i < 16; ++i) { int kk = kq + 4 * i; tile[kk * 65 + n] = W[(size_t)(k0 + kk) * ldw + nsrc0 + n]; }
  __syncthreads();
  const int nn = tid >> 2, ks = (tid & 3) * 16;
  unsigned o[8];
#pragma unroll
  for (int i = 0; i < 8; ++i) o[i] = pack2(tile[(ks + 2 * i) * 65 + nn], tile[(ks + 2 * i + 1) * 65 + nn]);
  u16* d = Wt + (size_t)(n0 + nn) * K + k0 + ks;
  *(uint4*)d = make_uint4(o[0], o[1], o[2], o[3]);
  *(uint4*)(d + 8) = make_uint4(o[4], o[5], o[6], o[7]);
}

DI void phase0(const Params& p, char* smem) {
  const int tid = threadIdx.x, lane = tid & 63, w = tid >> 6;
  const size_t gtid = (size_t)blockIdx.x * 256 + tid, gsz = (size_t)gridDim.x * 256;
  {
    const float* eu = p.expert_u;
    const float* ev = p.expert_v;
    unsigned char* e8 = p.E8;
    float* rsp = p.rs;
    const int sub = lane & 15, rq = lane >> 4;
    for (int er0 = (blockIdx.x * 4 + w) * 4; er0 < 32768; er0 += gridDim.x * 16) {
      const int er = er0 + rq;
      const float* src = (er < 16384) ? (eu + (size_t)er * 1024) : (ev + (size_t)(er - 16384) * 1024);
      float4 v[16];
      float am = 0.f;
#pragma unroll
      for (int i = 0; i < 16; ++i) {
        v[i] = *(const float4*)&src[(i >> 2) * 256 + sub * 16 + (i & 3) * 4];
        am = fmaxf(am, fmaxf(fmaxf(fabsf(v[i].x), fabsf(v[i].y)), fmaxf(fabsf(v[i].z), fabsf(v[i].w))));
      }
      am = fmaxf(am, __shfl_xor(am, 1)); am = fmaxf(am, __shfl_xor(am, 2));
      am = fmaxf(am, __shfl_xor(am, 4)); am = fmaxf(am, __shfl_xor(am, 8));
      const float sc = (am > 0.f) ? 224.f / am : 1.f;
#pragma unroll
      for (int c = 0; c < 4; ++c) {
        int o[4];
#pragma unroll
        for (int i = 0; i < 4; ++i) {
          const float4 t4 = v[c * 4 + i];
          int t = __builtin_amdgcn_cvt_pk_fp8_f32(t4.x * sc, t4.y * sc, 0, false);
          o[i] = __builtin_amdgcn_cvt_pk_fp8_f32(t4.z * sc, t4.w * sc, t, true);
        }
        *(uint4*)&e8[(size_t)er * 1024 + c * 256 + sub * 16] = make_uint4((unsigned)o[0], (unsigned)o[1], (unsigned)o[2], (unsigned)o[3]);
      }
      if (sub == 0) rsp[er] = (am > 0.f) ? am * (1.f / 224.f) : 1.f;
    }
  }
  for (size_t i = gtid; i < 262144 / 8; i += gsz) cvt8(p.sub_keys + i * 8, p.subkb + i * 8);
  for (size_t i = gtid; i < MT; i += gsz) { p.ssq1[i] = 0.f; p.ssq2[i] = 0.f; }
  float* wl = (float*)smem;
  __syncthreads();
  for (int i = tid; i < 2048; i += 256) {
    const int k = i >> 1, hf = i & 1;
    float4 t = *(const float4*)&p.w_in[(size_t)k * 4360 + 1536 + hf * 4];
    wl[(hf * 4 + 0) * 1024 + k] = t.x; wl[(hf * 4 + 1) * 1024 + k] = t.y; wl[(hf * 4 + 2) * 1024 + k] = t.z; wl[(hf * 4 + 3) * 1024 + k] = t.w;
  }
  __syncthreads();
  const float* xpp = p.x_prompt;
  const float* xsp = p.x_sample;
  const float* mpp = p.mem_prompt;
  const float* gmx = p.g_mix;
  const float* gmk = p.g_memkv;
  u16* a0p = p.A0;
  u16* amp = p.Amem;
  {
    const int sub = lane & 15, rq = lane >> 4;
    for (int row0 = (blockIdx.x * 4 + w) * 4; row0 < MT + 1024; row0 += gridDim.x * 16) {
      const int row = row0 + rq;
      const float* src; const float* g; u16* dst;
      if (row < MP) { src = xpp + (size_t)row * 1024; g = gmx; dst = a0p + (size_t)row * 1024; }
      else if (row < MT) { src = xsp + (size_t)(row - MP) * 1024; g = gmx; dst = a0p + (size_t)row * 1024; }
      else { src = mpp + (size_t)(row - MT) * 1024; g = gmk; dst = amp + (size_t)(row - MT) * 1024; }
      float4 v[16];
      float ss = 0.f;
#pragma unroll
      for (int i = 0; i < 16; ++i) { v[i] = *(const float4*)&src[i * 64 + sub * 4]; ss += v[i].x * v[i].x + v[i].y * v[i].y + v[i].z * v[i].z + v[i].w * v[i].w; }
      ss += __shfl_xor(ss, 1); ss += __shfl_xor(ss, 2); ss += __shfl_xor(ss, 4); ss += __shfl_xor(ss, 8);
      const float rs = rsqrtf(ss * (1.f / 1024.f) + EPS);
      float d8[8] = {0.f, 0.f, 0.f, 0.f, 0.f, 0.f, 0.f, 0.f};
#pragma unroll
      for (int i = 0; i < 16; ++i) {
        float4 g4 = *(const float4*)&g[i * 64 + sub * 4];
        float y[4] = {v[i].x * rs * g4.x, v[i].y * rs * g4.y, v[i].z * rs * g4.z, v[i].w * rs * g4.w};
        uint2 o; o.x = pack2(y[0], y[1]); o.y = pack2(y[2], y[3]);
        *(uint2*)&dst[i * 64 + sub * 4] = o;
        if (row < MT) {
#pragma unroll
          for (int j = 0; j < 8; ++j) {
            float4 wv = *(const float4*)&wl[j * 1024 + i * 64 + sub * 4];
            d8[j] += y[0] * wv.x + y[1] * wv.y + y[2] * wv.z + y[3] * wv.w;
          }
        }
      }
      if (row < MT) {
#pragma unroll
        for (int j = 0; j < 8; ++j) {
          d8[j] += __shfl_xor(d8[j], 1); d8[j] += __shfl_xor(d8[j], 2); d8[j] += __shfl_xor(d8[j], 4); d8[j] += __shfl_xor(d8[j], 8);
        }
        if (sub < 4) {
          float ag = sel4(sub, d8[0], d8[1], d8[2], d8[3]);
          float bg = sel4(sub, d8[4], d8[5], d8[6], d8[7]);
          float xs = ag + p.dt_bias[sub];
          float sp = (xs > 20.f) ? xs : log1pf(expf(xs));
          p.gb[(size_t)row * 8 + sub] = -expf(p.a_log[sub]) * sp;
          p.gb[(size_t)row * 8 + 4 + sub] = 1.f / (1.f + expf(-bg));
        }
      }
    }
  }
  __syncthreads();
  float* tile = (float*)smem;
  for (int j = blockIdx.x; j < 2816; j += gridDim.x) {
    int t = j;
    if (t < 1088) { int kt = t / 68, nt = t % 68; int n0 = nt * 64; tr_tile(p.w_in, 4360, n0 + (n0 >= 1536 ? 8 : 0), p.WtIn, 1024, kt * 64, n0, tile); continue; }
    t -= 1088;
    if (t < 192) { int kt = t / 16, nt = t % 16; tr_tile(p.w_out, 1024, nt * 64, p.WtOut, 768, kt * 64, nt * 64, tile); continue; }
    t -= 192;
    if (t < 256) { int kt = t / 16, nt = t % 16; tr_tile(p.w_mq, 1024, nt * 64, p.WtMq, 1024, kt * 64, nt * 64, tile); continue; }
    t -= 256;
    if (t < 512) { int kt = t / 32, nt = t % 32; tr_tile(p.w_mkv, 2048, nt * 64, p.WtMkv, 1024, kt * 64, nt * 64, tile); continue; }
    t -= 512;
    if (t < 256) { int kt = t / 16, nt = t % 16; tr_tile(p.w_mo, 1024, nt * 64, p.WtMo, 1024, kt * 64, nt * 64, tile); continue; }
    t -= 256;
    { int kt = t / 32, nt = t % 32; tr_tile(p.w_pq, 2048, nt * 64, p.WtPq, 1024, kt * 64, nt * 64, tile); }
  }
}

DI void dn_prep(const Params& p, int item, char* smem) {
  u16* qs = (u16*)smem;
  u16* ksm = qs + 64 * 136;
  float* sL = (float*)(ksm + 64 * 136);
  float* sgc = sL + 64 * 64;
  float* sbeta = sgc + 64;
  u16* sU = (u16*)sL;
  u16* sW = qs;
  const int tid = threadIdx.x, lane = tid & 63, w = tid >> 6, r = lane & 15, kg = lane >> 4;
  const int bh = item >> 7, n = item & 127, b = bh >> 2, h = bh & 3;
  const int t0 = n * 64;
  const size_t rowbase = (size_t)b * SEQ;
  char* ops = p.dnops + (size_t)item * DN_ITEM;
  __syncthreads();
  if (tid < 64) {
    float gv = p.gb[(rowbase + t0 + tid) * 8 + h];
    float bv = p.gb[(rowbase + t0 + tid) * 8 + 4 + h];
#pragma unroll
    for (int o = 1; o < 64; o <<= 1) { float t = __shfl_up(gv, o); if (lane >= o) gv += t; }
    sgc[tid] = gv; sbeta[tid] = bv;
    if (tid == 63) p.dl[item] = __expf(gv);
  }
#pragma unroll 4
  for (int ps = 0; ps < 8; ++ps) {
    const int combo = ps * 16 + (tid >> 4);
    const int tt = combo & 63, part = combo >> 6, sub = tid & 15;
    const int col = part * 512 + h * 128 + sub * 8;
    float y[8] = {0.f, 0.f, 0.f, 0.f, 0.f, 0.f, 0.f, 0.f};
#pragma unroll
    for (int j = 0; j < 4; ++j) {
      const int t = t0 + tt - 3 + j;
      if (t >= 0) {
        uint4 xv = *(const uint4*)&p.proj[(rowbase + t) * NP + col];
        float4 wa = *(const float4*)&p.conv_w[j * 1536 + col], wb = *(const float4*)&p.conv_w[j * 1536 + col + 4];
        y[0] += bflo(xv.x) * wa.x; y[1] += bfhi(xv.x) * wa.y; y[2] += bflo(xv.y) * wa.z; y[3] += bfhi(xv.y) * wa.w;
        y[4] += bflo(xv.z) * wb.x; y[5] += bfhi(xv.z) * wb.y; y[6] += bflo(xv.w) * wb.z; y[7] += bfhi(xv.w) * wb.w;
      }
    }
    float ss = 0.f;
#pragma unroll
    for (int e = 0; e < 8; ++e) { y[e] = siluf(y[e]); ss += y[e] * y[e]; }
    ss += __shfl_xor(ss, 1); ss += __shfl_xor(ss, 2); ss += __shfl_xor(ss, 4); ss += __shfl_xor(ss, 8);
    float sc = rsqrtf(ss + EPS) * (part == 0 ? 0.08838834764831845f : 1.f);
    uint4 o; o.x = pack2(y[0] * sc, y[1] * sc); o.y = pack2(y[2] * sc, y[3] * sc); o.z = pack2(y[4] * sc, y[5] * sc); o.w = pack2(y[6] * sc, y[7] * sc);
    *(uint4*)&((part == 0 ? qs : ksm)[tt * 136 + sub * 8]) = o;
  }
  __syncthreads();
  const float gcl = sgc[63];
  {
    f32x4 aL[4], aA[4];
#pragma unroll
    for (int i = 0; i < 4; ++i) { aL[i] = (f32x4){0.f, 0.f, 0.f, 0.f}; aA[i] = (f32x4){0.f, 0.f, 0.f, 0.f}; }
#pragma unroll
    for (int ks = 0; ks < 4; ++ks) {
      bf16x8 kI = *(const bf16x8*)&ksm[(w * 16 + r) * 136 + ks * 32 + kg * 8];
      bf16x8 qI = *(const bf16x8*)&qs[(w * 16 + r) * 136 + ks * 32 + kg * 8];
#pragma unroll
      for (int nt = 0; nt < 4; ++nt) {
        bf16x8 kJ = *(const bf16x8*)&ksm[(nt * 16 + r) * 136 + ks * 32 + kg * 8];
        aL[nt] = MFMA(kJ, kI, aL[nt]);
        aA[nt] = MFMA(kJ, qI, aA[nt]);
      }
    }
    const int i = w * 16 + r;
    const float gci = sgc[i], bi = sbeta[i];
    u16* aq = (u16*)(ops + 49152);
#pragma unroll
    for (int nt = 0; nt < 4; ++nt) {
      float lv[4], av[4];
#pragma unroll
      for (int jj = 0; jj < 4; ++jj) {
        const int j = nt * 16 + kg * 4 + jj;
        const float gam = (i >= j) ? __expf(gci - sgc[j]) : 0.f;
        lv[jj] = (i > j) ? aL[nt][jj] * bi * gam : 0.f;
        av[jj] = aA[nt][jj] * gam;
      }
      *(float4*)&sL[i * 64 + nt * 16 + kg * 4] = make_float4(lv[0], lv[1], lv[2], lv[3]);
      uint2 o; o.x = pack2(av[0], av[1]); o.y = pack2(av[2], av[3]);
      *(uint2*)&aq[((w * 2 + (nt >> 1)) * 64 + lane) * 8 + (nt & 1) * 4] = o;
    }
  }
  {
    u16* qg = (u16*)(ops + 16384);
    u16* kdT = (u16*)(ops + 32768);
#pragma unroll 1
    for (int i = 0; i < 4; ++i) {
      const int f = tid + 256 * i;
      const int mtks = f >> 6, l = f & 63, rr = l & 15, kgg = l >> 4;
      {
        const int mt = mtks >> 2, ks = mtks & 3, row = mt * 16 + rr;
        const float e = __expf(sgc[row]);
        uint2 a = *(const uint2*)&qs[row * 136 + ks * 32 + kgg * 4];
        uint2 c = *(const uint2*)&qs[row * 136 + ks * 32 + 16 + kgg * 4];
        uint4 o;
        o.x = pack2(bflo(a.x) * e, bfhi(a.x) * e); o.y = pack2(bflo(a.y) * e, bfhi(a.y) * e);
        o.z = pack2(bflo(c.x) * e, bfhi(c.x) * e); o.w = pack2(bflo(c.y) * e, bfhi(c.y) * e);
        *(uint4*)&qg[(size_t)f * 8] = o;
      }
      {
        const int mt = mtks >> 1, ks = mtks & 1, kdim = mt * 16 + rr;
        float v[8];
#pragma unroll
        for (int j = 0; j < 8; ++j) {
          const int c = ks * 32 + permk(kgg, j);
          v[j] = bf2f(ksm[c * 136 + kdim]) * __expf(gcl - sgc[c]);
        }
        uint4 o; o.x = pack2(v[0], v[1]); o.y = pack2(v[2], v[3]); o.z = pack2(v[4], v[5]); o.w = pack2(v[6], v[7]);
        *(uint4*)&kdT[(size_t)f * 8] = o;
      }
    }
  }
  __syncthreads();
  float x[64];
  if (tid < 128) {
    const int col = 1024 + h * 128 + tid;
    const float w0 = p.conv_w[col], w1 = p.conv_w[1536 + col], w2 = p.conv_w[3072 + col], w3 = p.conv_w[4608 + col];
    float xm3 = 0.f, xm2 = 0.f, xm1 = 0.f;
    if (t0 > 0) {
      xm3 = bf2f(p.proj[(rowbase + t0 - 3) * NP + col]);
      xm2 = bf2f(p.proj[(rowbase + t0 - 2) * NP + col]);
      xm1 = bf2f(p.proj[(rowbase + t0 - 1) * NP + col]);
    }
#pragma unroll
    for (int t = 0; t < 64; ++t) {
      float xc = bf2f(p.proj[(rowbase + t0 + t) * NP + col]);
      float yv = w0 * xm3 + w1 * xm2 + w2 * xm1 + w3 * xc;
      x[t] = siluf(yv) * sbeta[t];
      xm3 = xm2; xm2 = xm1; xm1 = xc;
    }
  } else {
    const int kc = tid - 128;
#pragma unroll
    for (int t = 0; t < 64; ++t) x[t] = bf2f(ksm[t * 136 + kc]) * sbeta[t] * __expf(sgc[t]);
  }
  {
    f32x4 Lr[16];
#pragma unroll
    for (int i = 1; i < 64; ++i) {
#pragma unroll
      for (int j4 = 0; j4 < (i + 3) / 4; ++j4) Lr[j4] = *(const f32x4*)&sL[i * 64 + j4 * 4];
      __builtin_amdgcn_sched_barrier(0);
      float s0 = x[i], s1 = 0.f, s2 = 0.f, s3 = 0.f;
#pragma unroll
      for (int j4 = 0; j4 < (i + 3) / 4; ++j4) {
        const f32x4 l = Lr[j4];
        s0 -= l[0] * x[j4 * 4];
        if (j4 * 4 + 1 < i) s1 -= l[1] * x[j4 * 4 + 1];
        if (j4 * 4 + 2 < i) s2 -= l[2] * x[j4 * 4 + 2];
        if (j4 * 4 + 3 < i) s3 -= l[3] * x[j4 * 4 + 3];
      }
      x[i] = (s0 + s1) + (s2 + s3);
      __builtin_amdgcn_sched_barrier(0);
    }
  }
  __syncthreads();
  if (tid < 128) {
#pragma unroll
    for (int t = 0; t < 64; ++t) sU[t * 128 + tid] = f2bf(x[t]);
  } else {
    const int kc = tid - 128;
#pragma unroll
    for (int t = 0; t < 64; ++t) sW[t * 136 + kc] = f2bf(-x[t]);
  }
  __syncthreads();
  {
    u16* nW = (u16*)ops;
    u16* u0 = (u16*)(ops + 57344);
#pragma unroll 1
    for (int i = 0; i < 4; ++i) {
      const int f = tid + 256 * i;
      const int mtks = f >> 6, l = f & 63, rr = l & 15, kgg = l >> 4;
      const int mt = mtks >> 2, ks = mtks & 3, row = mt * 16 + rr;
      uint2 a = *(const uint2*)&sW[row * 136 + ks * 32 + kgg * 4];
      uint2 c = *(const uint2*)&sW[row * 136 + ks * 32 + 16 + kgg * 4];
      *(uint4*)&nW[(size_t)f * 8] = make_uint4(a.x, a.y, c.x, c.y);
    }
#pragma unroll 1
    for (int i = 0; i < 8; ++i) {
      const int f = tid + 256 * i;
      const int smt = f >> 6, l = f & 63, rr = l & 15, kgg = l >> 4;
      const int s = smt >> 2, mt = smt & 3;
      u16 v0 = sU[(mt * 16 + kgg * 4 + 0) * 128 + s * 16 + rr];
      u16 v1 = sU[(mt * 16 + kgg * 4 + 1) * 128 + s * 16 + rr];
      u16 v2 = sU[(mt * 16 + kgg * 4 + 2) * 128 + s * 16 + rr];
      u16 v3 = sU[(mt * 16 + kgg * 4 + 3) * 128 + s * 16 + rr];
      *(uint2*)&u0[(size_t)f * 4] = make_uint2((unsigned)v0 | ((unsigned)v1 << 16), (unsigned)v2 | ((unsigned)v3 << 16));
    }
  }
}

DI void vt_tile(const Params& p, int item, char* smem) {
  u16* tile = (u16*)smem;
  const int tid = threadIdx.x;
  const int ptile = item & 127, gbh = item >> 7;
  const int h = gbh & 3, b = (gbh >> 2) & 3, g = gbh >> 4;
  const int dsh = g * 2, ln = SEQ >> dsh;
  const int pos0 = ptile * 64;
  const int rres = pos0 / ln, i0 = pos0 % ln;
  __syncthreads();
  {
    const int pr = tid >> 2, seg = (tid & 3) * 16;
    const int token = ((i0 + pr) << dsh) + rres;
    const u16* src = &p.proj[((size_t)b * SEQ + token) * NP + 2048 + g * 768 + 512 + h * 64 + seg];
    uint4 a = *(const uint4*)src, c = *(const uint4*)(src + 8);
    unsigned d[8] = {a.x, a.y, a.z, a.w, c.x, c.y, c.z, c.w};
#pragma unroll
    for (int e = 0; e < 8; ++e) *(unsigned*)&tile[pr * 66 + seg + e * 2] = d[e];
  }
  __syncthreads();
  {
    const int dh = tid >> 2, seg = (tid & 3) * 16;
    unsigned o[8];
#pragma unroll
    for (int e = 0; e < 8; ++e) o[e] = (unsigned)tile[(seg + 2 * e) * 66 + dh] | ((unsigned)tile[(seg + 2 * e + 1) * 66 + dh] << 16);
    u16* d = &p.vT[((size_t)gbh * 64 + dh) * SEQ + pos0 + seg];
    *(uint4*)d = make_uint4(o[0], o[1], o[2], o[3]);
    *(uint4*)(d + 8) = make_uint4(o[4], o[5], o[6], o[7]);
  }
}

DI void dn_sample(const Params& p, int item, char* smem) {
  float* sq = (float*)smem;
  float* sk = sq + 512;
  float* sv = sk + 512;
  float* red = sv + 512;
  const int tid = threadIdx.x, lane = tid & 63, w = tid >> 6;
  const int b = item >> 2, h = item & 3;
  __syncthreads();
  for (int c = tid; c < 384; c += 256) {
    const int part = c >> 7, cc = c & 127;
    const int col = part * 512 + h * 128 + cc;
    float xp[7];
#pragma unroll
    for (int j = 0; j < 3; ++j) xp[j] = p.state_conv[((size_t)b * 3 + j) * 1536 + col];
#pragma unroll
    for (int j = 0; j < 4; ++j) xp[3 + j] = bf2f(p.proj[((size_t)MP + b * 4 + j) * NP + col]);
    const float w0 = p.conv_w[col], w1 = p.conv_w[1536 + col], w2 = p.conv_w[3072 + col], w3 = p.conv_w[4608 + col];
    float* dst = part == 0 ? sq : (part == 1 ? sk : sv);
#pragma unroll
    for (int t = 0; t < 4; ++t) dst[t * 128 + cc] = siluf(w0 * xp[t] + w1 * xp[t + 1] + w2 * xp[t + 2] + w3 * xp[t + 3]);
  }
  __syncthreads();
  {
    float a0 = sq[w * 128 + lane], a1 = sq[w * 128 + 64 + lane];
    float s = wave_sum(a0 * a0 + a1 * a1);
    float sc = rsqrtf(s + EPS) * 0.08838834764831845f;
    sq[w * 128 + lane] = a0 * sc; sq[w * 128 + 64 + lane] = a1 * sc;
    float b0 = sk[w * 128 + lane], b1 = sk[w * 128 + 64 + lane];
    s = wave_sum(b0 * b0 + b1 * b1);
    sc = rsqrtf(s + EPS);
    sk[w * 128 + lane] = b0 * sc; sk[w * 128 + 64 + lane] = b1 * sc;
  }
  __syncthreads();
  const int v = tid & 127, half = tid >> 7;
  float S[64];
  const float* s0 = p.state_delta + (((size_t)b * 4 + h) * 128 + half * 64) * 128 + v;
#pragma unroll
  for (int i = 0; i < 64; ++i) S[i] = s0[(size_t)i * 128];
#pragma unroll 1
  for (int t = 0; t < 4; ++t) {
    const size_t row = (size_t)MP + b * 4 + t;
    const float a = __expf(p.gb[row * 8 + h]);
    const float beta = p.gb[row * 8 + 4 + h];
    float part = 0.f;
#pragma unroll
    for (int i = 0; i < 64; ++i) part += S[i] * sk[t * 128 + half * 64 + i];
    red[half * 128 + v] = part;
    __syncthreads();
    const float kS = red[v] + red[128 + v];
    const float u = beta * (sv[t * 128 + v] - a * kS);
    float po = 0.f;
#pragma unroll
    for (int i = 0; i < 64; ++i) { S[i] = a * S[i] + sk[t * 128 + half * 64 + i] * u; po += S[i] * sq[t * 128 + half * 64 + i]; }
    __syncthreads();
    red[half * 128 + v] = po;
    __syncthreads();
    if (half == 0) p.odn[row * 512 + h * 128 + v] = f2bf(red[v] + red[128 + v]);
    __syncthreads();
  }
  float* d = p.out + O_SDELTA + (((size_t)b * 4 + h) * 128 + half * 64) * 128 + v;
#pragma unroll
  for (int i = 0; i < 64; ++i) d[(size_t)i * 128] = S[i];
}

DI void phase2(const Params& p, char* smem) {
  const size_t gtid = (size_t)blockIdx.x * 256 + threadIdx.x, gsz = (size_t)gridDim.x * 256;
  for (int j = blockIdx.x; j < 2048 + 128 + 6144; j += gridDim.x) {
    if (j < 2048) { dn_prep(p, j, smem); if (DBL == 20) dn_prep(p, j, smem); }
    else if (j < 2048 + 128) dn_sample(p, j - 2048, smem);
    else { vt_tile(p, j - 2176, smem); if (DBL == 21) vt_tile(p, j - 2176, smem); }
  }
  for (size_t f = gtid; f < (size_t)16 * 8192; f += gsz) {
    {
      const size_t e0 = f * 8;
      const int bh = (int)(e0 >> 16), key = (int)((e0 >> 8) & 255), dh = (int)(e0 & 255);
      const int b = bh >> 2, h = bh & 3;
      cvt8(p.out + O_PMEM + (((size_t)b * 256 + key) * 2 + 0) * 1024 + h * 256 + dh, p.Kb + e0);
    }
    {
      const int l = (int)(f & 63), ks = (int)((f >> 6) & 7), nt = (int)((f >> 9) & 15), bh = (int)(f >> 13);
      const int b = bh >> 2, h = bh & 3, rr = l & 15, kgg = l >> 4;
      float v[8];
#pragma unroll
      for (int j = 0; j < 8; ++j) {
        const int key = ks * 32 + permk(kgg, j);
        v[j] = p.out[O_PMEM + (((size_t)b * 256 + key) * 2 + 1) * 1024 + h * 256 + nt * 16 + rr];
      }
      *(uint4*)&p.VTf[f * 8] = make_uint4(pack2(v[0], v[1]), pack2(v[2], v[3]), pack2(v[4], v[5]), pack2(v[6], v[7]));
    }
  }
  for (size_t i = gtid; i < 18432; i += gsz) {
    const int c = (int)(i % 1536), j = (int)((i / 1536) % 3), b = (int)(i / 4608);
    p.out[O_PCONV + i] = bf2f(p.proj[((size_t)b * SEQ + SEQ - 3 + j) * NP + c]);
  }
  for (int g = 0; g < 3; ++g) {
    const int W = 128 << (2 * g);
    const size_t off = (g == 0) ? O_PW1 : (g == 1 ? O_PW2 : O_PW3);
    const size_t n4 = (size_t)4 * W * 512 / 4;
    for (size_t i = gtid; i < n4; i += gsz) {
      const size_t e0 = i * 4;
      const int e = (int)(e0 & 511), ii = (int)((e0 >> 9) % W), b = (int)((e0 >> 9) / W);
      uint2 v = *(const uint2*)&p.proj[((size_t)b * SEQ + SEQ - W + ii) * NP + 2048 + g * 768 + 256 + e];
      *(float4*)&p.out[off + e0] = make_float4(bflo(v.x), bfhi(v.x), bflo(v.y), bfhi(v.y));
    }
  }
}

typedef __attribute__((ext_vector_type(2))) unsigned u32x2;
struct ScanOps { bf16x8 nW[4]; bf16x8 qg[4]; bf16x8 aq[2]; bf16x8 kd[4]; u32x2 u0; float dl; };

DI void scan_load(const Params& p, int bh, int s, int n, int j, int lane, ScanOps& o) {
  n = n > 127 ? 127 : n;
  const char AS1* base = (const char AS1*)p.dnops + (size_t)(bh * 128 + n) * DN_ITEM;
  gb8p negW = (gb8p)base;
  gb8p qg = (gb8p)(base + 16384);
  gb8p kdT = (gb8p)(base + 32768);
  gb8p aqk = (gb8p)(base + 49152);
  const u32x2 AS1* u0 = (const u32x2 AS1*)(base + 57344);
#pragma unroll
  for (int ks = 0; ks < 4; ++ks) o.nW[ks] = negW[(j * 4 + ks) * 64 + lane];
#pragma unroll
  for (int ks = 0; ks < 4; ++ks) o.qg[ks] = qg[(j * 4 + ks) * 64 + lane];
#pragma unroll
  for (int k2 = 0; k2 < 2; ++k2) o.aq[k2] = aqk[(j * 2 + k2) * 64 + lane];
#pragma unroll
  for (int mm = 0; mm < 2; ++mm)
#pragma unroll
    for (int k2 = 0; k2 < 2; ++k2) o.kd[mm * 2 + k2] = kdT[((2 * j + mm) * 2 + k2) * 64 + lane];
  o.u0 = u0[(s * 4 + j) * 64 + lane];
  o.dl = ((const float AS1*)p.dl)[bh * 128 + n];
}

DI void scan_step(const Params& p, const ScanOps& ops, int n, int b, int h, int s, int j, int lane, f32x4& S0, f32x4& S1,
                  bf16x8* sSb, u32x2* sUb) {
  const int r = lane & 15, kg = lane >> 4;
  bf16x8 sb[4];
#pragma unroll
  for (int ks = 0; ks < 4; ++ks) sb[ks] = sSb[ks * 64 + lane];
  f32x4 u = (f32x4){bflo(ops.u0[0]), bfhi(ops.u0[0]), bflo(ops.u0[1]), bfhi(ops.u0[1])};
#pragma unroll
  for (int ks = 0; ks < 4; ++ks) u = MFMA(ops.nW[ks], sb[ks], u);
  {
    u32x2 t; t[0] = pack2(u[0], u[1]); t[1] = pack2(u[2], u[3]);
    sUb[((j >> 1) * 64 + lane) * 2 + (j & 1)] = t;
  }
  __syncthreads();
  bf16x8 ub[2];
#pragma unroll
  for (int k2 = 0; k2 < 2; ++k2) ub[k2] = *(const bf16x8*)&sUb[(k2 * 64 + lane) * 2];
  f32x4 o = (f32x4){0.f, 0.f, 0.f, 0.f};
#pragma unroll
  for (int ks = 0; ks < 4; ++ks) o = MFMA(ops.qg[ks], sb[ks], o);
#pragma unroll
  for (int k2 = 0; k2 < 2; ++k2) o = MFMA(ops.aq[k2], ub[k2], o);
  S0 = S0 * ops.dl; S1 = S1 * ops.dl;
#pragma unroll
  for (int k2 = 0; k2 < 2; ++k2) { S0 = MFMA(ops.kd[k2], ub[k2], S0); S1 = MFMA(ops.kd[2 + k2], ub[k2], S1); }
  sSb[j * 64 + lane] = pack8(S0, S1);
#pragma unroll
  for (int jj = 0; jj < 4; ++jj) {
    const size_t token = (size_t)b * SEQ + n * 64 + j * 16 + kg * 4 + jj;
    G(p.odn)[token * 512 + h * 128 + s * 16 + r] = f2bf(o[jj]);
  }
  __syncthreads();
}

DI void dn_scan_block(const Params& p, int item, char* smem) {
  const int lane = threadIdx.x & 63, j = threadIdx.x >> 6, r = lane & 15, kg = lane >> 4;
  const int bh = item >> 3, s = item & 7, b = bh >> 2, h = bh & 3;
  bf16x8* sSb = (bf16x8*)smem;
  u32x2* sUb = (u32x2*)(smem + 4096);
  f32x4 S0 = (f32x4){0.f, 0.f, 0.f, 0.f}, S1 = (f32x4){0.f, 0.f, 0.f, 0.f};
  __syncthreads();
  sSb[j * 64 + lane] = pack8(S0, S1);
  ScanOps A, B;
  scan_load(p, bh, s, 0, j, lane, A);
  scan_load(p, bh, s, 1, j, lane, B);
  __syncthreads();
#pragma unroll 1
  for (int n0 = 0; n0 < 128; n0 += 2) {
    scan_step(p, A, n0, b, h, s, j, lane, S0, S1, sSb, sUb);
    scan_load(p, bh, s, n0 + 2, j, lane, A);
    scan_step(p, B, n0 + 1, b, h, s, j, lane, S0, S1, sSb, sUb);
    scan_load(p, bh, s, n0 + 3, j, lane, B);
  }
#pragma unroll
  for (int jj = 0; jj < 4; ++jj) {
    p.out[O_PDELTA + ((size_t)bh * 128 + 32 * j + kg * 4 + jj) * 128 + s * 16 + r] = S0[jj];
    p.out[O_PDELTA + ((size_t)bh * 128 + 32 * j + 16 + kg * 4 + jj) * 128 + s * 16 + r] = S1[jj];
  }
}

DI void sw_prompt_wave(const Params& p, int item) {
  const int lane = threadIdx.x & 63, r = lane & 15, kg = lane >> 4;
  const int qt = item & 511, gbh = item >> 9;
  const int h = gbh & 3, b = (gbh >> 2) & 3, g = gbh >> 4;
  const int dsh = 2 * g, ln = SEQ >> dsh;
  const int pos0 = qt * 16, rres = pos0 / ln, i0 = pos0 % ln;
  const int kbase = i0 - 144;
  const size_t rb = (size_t)b * SEQ;
  const int qoff = 2048 + g * 768 + h * 64, koff = qoff + 256;
  bf16x8 qf[2];
  {
    const size_t tok = rb + ((size_t)(i0 + r) << dsh) + rres;
#pragma unroll
    for (int ks = 0; ks < 2; ++ks) qf[ks] = *(const bf16x8*)&p.proj[tok * NP + qoff + ks * 32 + kg * 8];
  }
  f32x4 st[10];
#pragma unroll
  for (int mt = 0; mt < 10; ++mt) {
    int ki = kbase + mt * 16 + r; ki = ki < 0 ? 0 : ki;
    const size_t tok = rb + ((size_t)ki << dsh) + rres;
    f32x4 a = (f32x4){0.f, 0.f, 0.f, 0.f};
#pragma unroll
    for (int ks = 0; ks < 2; ++ks) {
      bf16x8 kf = *(const bf16x8*)&p.proj[tok * NP + koff + ks * 32 + kg * 8];
      a = MFMA(kf, qf[ks], a);
    }
    st[mt] = a;
  }
  const int qi = i0 + r;
  float mx = -3.0e38f;
#pragma unroll
  for (int mt = 0; mt < 10; ++mt)
#pragma unroll
    for (int j = 0; j < 4; ++j) {
      const int ki = kbase + mt * 16 + kg * 4 + j;
      const int d = qi - ki;
      const bool valid = (ki >= 0) && (d >= 0) && (d <= 128);
      const float sv = valid ? st[mt][j] * 0.125f : -3.0e38f;
      st[mt][j] = sv;
      mx = fmaxf(mx, sv);
    }
  mx = fmaxf(mx, __shfl_xor(mx, 16));
  mx = fmaxf(mx, __shfl_xor(mx, 32));
  float sum = 0.f;
#pragma unroll
  for (int mt = 0; mt < 10; ++mt)
#pragma unroll
    for (int j = 0; j < 4; ++j) {
      const float pv = (st[mt][j] > -1.0e38f) ? __expf(st[mt][j] - mx) : 0.f;
      st[mt][j] = pv;
      sum += pv;
    }
  sum += __shfl_xor(sum, 16);
  sum += __shfl_xor(sum, 32);
  const float inv = 1.f / sum;
  bf16x8 pf[5];
#pragma unroll
  for (int k2 = 0; k2 < 5; ++k2) pf[k2] = pack8(st[2 * k2], st[2 * k2 + 1]);
  const size_t qrow = rb + ((size_t)qi << dsh) + rres;
#pragma unroll
  for (int nt = 0; nt < 4; ++nt) {
    f32x4 o = (f32x4){0.f, 0.f, 0.f, 0.f};
    const u16* vrow = &p.vT[((size_t)gbh * 64 + nt * 16 + r) * SEQ + (size_t)rres * ln];
#pragma unroll
    for (int k2 = 0; k2 < 5; ++k2) {
      int ka = kbase + k2 * 32 + kg * 4, kc = ka + 16;
      ka = ka < 0 ? 0 : ka; kc = kc < 0 ? 0 : kc;
      uint2 va = *(const uint2*)&vrow[ka];
      uint2 vc = *(const uint2*)&vrow[kc];
      bf16x8 vf = __builtin_bit_cast(bf16x8, make_uint4(va.x, va.y, vc.x, vc.y));
      o = MFMA(vf, pf[k2], o);
    }
    uint2 ov; ov.x = pack2(o[0] * inv, o[1] * inv); ov.y = pack2(o[2] * inv, o[3] * inv);
    *(uint2*)&p.osw[((size_t)g * MT + qrow) * 256 + h * 64 + nt * 16 + kg * 4] = ov;
  }
  if (kg == 0) p.lse[((size_t)g * MT + qrow) * 4 + h] = mx + __logf(sum);
}

DI void sw_sample_wave(const Params& p, int item) {
  const int lane = threadIdx.x & 63;
  const int t = item & 3, h = (item >> 2) & 3, b = (item >> 4) & 31, g = item >> 9;
  const int dil = 1 << (2 * g), W = 128 << (2 * g);
  const float* c1 = p.cw1;
  const float* c2 = p.cw2;
  const float* c3 = p.cw3;
  const float* cache = (g == 0) ? c1 : (g == 1 ? c2 : c3);
  const int qoff = 2048 + g * 768 + h * 64;
  const size_t qrow = (size_t)MP + b * 4 + t;
  float q[64];
#pragma unroll
  for (int c = 0; c < 64; c += 8) {
    uint4 v = *(const uint4*)&p.proj[qrow * NP + qoff + c];
    q[c] = bflo(v.x); q[c + 1] = bfhi(v.x); q[c + 2] = bflo(v.y); q[c + 3] = bfhi(v.y);
    q[c + 4] = bflo(v.z); q[c + 5] = bfhi(v.z); q[c + 6] = bflo(v.w); q[c + 7] = bfhi(v.w);
  }
  float sc[3];
#pragma unroll
  for (int mi = 0; mi < 3; ++mi) {
    const int m = lane + 64 * mi;
    float s = -3.0e38f;
    if (m <= 128) {
      const int j = W + t - m * dil;
      float d = 0.f;
      if (j >= W) {
        const u16* kr = &p.proj[((size_t)MP + b * 4 + (j - W)) * NP + qoff + 256];
#pragma unroll
        for (int c = 0; c < 64; c += 8) {
          uint4 v = *(const uint4*)&kr[c];
          d += q[c] * bflo(v.x) + q[c + 1] * bfhi(v.x) + q[c + 2] * bflo(v.y) + q[c + 3] * bfhi(v.y) + q[c + 4] * bflo(v.z) +
               q[c + 5] * bfhi(v.z) + q[c + 6] * bflo(v.w) + q[c + 7] * bfhi(v.w);
        }
      } else {
        const float* kr = &cache[(((size_t)b * W + j) * 2 + 0) * 256 + h * 64];
#pragma unroll
        for (int c = 0; c < 64; c += 4) {
          float4 v = *(const float4*)&kr[c];
          d += q[c] * v.x + q[c + 1] * v.y + q[c + 2] * v.z + q[c + 3] * v.w;
        }
      }
      s = d * 0.125f;
    }
    sc[mi] = s;
  }
  float mx = wave_max(fmaxf(fmaxf(sc[0], sc[1]), sc[2]));
  float sum = 0.f;
#pragma unroll
  for (int mi = 0; mi < 3; ++mi) { sc[mi] = (sc[mi] > -1.0e38f) ? __expf(sc[mi] - mx) : 0.f; sum += sc[mi]; }
  sum = wave_sum(sum);
  float o = 0.f;
#pragma unroll
  for (int mi = 0; mi < 3; ++mi) {
#pragma unroll 8
    for (int mm = 0; mm < 64; ++mm) {
      const int m = mi * 64 + mm;
      if (m <= 128) {
        const float pv = __shfl(sc[mi], mm);
        const int j = W + t - m * dil;
        float vv;
        if (j >= W) vv = bf2f(p.proj[((size_t)MP + b * 4 + (j - W)) * NP + qoff + 512 + lane]);
        else vv = cache[(((size_t)b * W + j) * 2 + 1) * 256 + h * 64 + lane];
        o += pv * vv;
      }
    }
  }
  p.osw[((size_t)g * MT + qrow) * 256 + h * 64 + lane] = f2bf(o / sum);
  if (lane == 0) p.lse[((size_t)g * MT + qrow) * 4 + h] = mx + __logf(sum);
}

DI void phase3(const Params& p, char* smem) {
  const int w = threadIdx.x >> 6;
  if (blockIdx.x < 128) {
    dn_scan_block(p, blockIdx.x, smem);
  } else {
    const int gw = (blockIdx.x - 128) * 4 + w, nw = (gridDim.x - 128) * 4;
    for (int it = gw; it < 24576 + 1536; it += nw) {
      if (it < 24576) sw_prompt_wave(p, it);
      else sw_sample_wave(p, it - 24576);
    }
  }
}

DI void phase4(const Params& p) {
  const int lane = threadIdx.x & 63, w = threadIdx.x >> 6;
  for (int row = blockIdx.x * 4 + w; row < MT; row += gridDim.x * 4) {
    u16* dst = p.Amix + (size_t)row * 768;
#pragma unroll
    for (int h = 0; h < 4; ++h) {
      unsigned ov = *(const unsigned*)&p.odn[(size_t)row * 512 + h * 128 + lane * 2];
      unsigned zv = *(const unsigned*)&p.proj[(size_t)row * NP + 1536 + h * 128 + lane * 2];
      float o0 = bflo(ov), o1 = bfhi(ov);
      float ss = wave_sum(o0 * o0 + o1 * o1);
      float rs = rsqrtf(ss * (1.f / 128.f) + EPS);
      float2 gn = *(const float2*)&p.g_onorm[lane * 2];
      float y0 = o0 * rs * gn.x * siluf(bflo(zv)), y1 = o1 * rs * gn.y * siluf(bfhi(zv));
      *(unsigned*)&dst[h * 128 + lane * 2] = pack2(y0, y1);
    }
    {
      const int h = lane >> 4;
      float l0 = p.lse[((size_t)0 * MT + row) * 4 + h], l1 = p.lse[((size_t)1 * MT + row) * 4 + h], l2 = p.lse[((size_t)2 * MT + row) * 4 + h];
      float m = fmaxf(l0, fmaxf(l1, l2));
      float e0 = __expf(l0 - m), e1 = __expf(l1 - m), e2 = __expf(l2 - m);
      float inv = 1.f / (e0 + e1 + e2);
      uint2 a = *(const uint2*)&p.osw[((size_t)0 * MT + row) * 256 + lane * 4];
      uint2 c = *(const uint2*)&p.osw[((size_t)1 * MT + row) * 256 + lane * 4];
      uint2 d = *(const uint2*)&p.osw[((size_t)2 * MT + row) * 256 + lane * 4];
      e0 *= inv; e1 *= inv; e2 *= inv;
      float y0 = e0 * bflo(a.x) + e1 * bflo(c.x) + e2 * bflo(d.x);
      float y1 = e0 * bfhi(a.x) + e1 * bfhi(c.x) + e2 * bfhi(d.x);
      float y2 = e0 * bflo(a.y) + e1 * bflo(c.y) + e2 * bflo(d.y);
      float y3 = e0 * bfhi(a.y) + e1 * bfhi(c.y) + e2 * bfhi(d.y);
      *(uint2*)&dst[512 + lane * 4] = make_uint2(pack2(y0, y1), pack2(y2, y3));
    }
  }
}

DI void sample_state_copy(const Params& p) {
  const size_t gtid = (size_t)blockIdx.x * 256 + threadIdx.x, gsz = (size_t)gridDim.x * 256;
  for (size_t i = gtid; i < 147456; i += gsz) {
    const int c = (int)(i % 1536), j = (int)((i / 1536) % 3), b = (int)(i / 4608);
    p.out[O_SCONV + i] = bf2f(p.proj[((size_t)MP + b * 4 + j + 1) * NP + c]);
  }
  const float* c1 = p.cw1;
  const float* c2 = p.cw2;
  const float* c3 = p.cw3;
  for (int g = 0; g < 3; ++g) {
    const int W = 128 << (2 * g);
    const float* cache = (g == 0) ? c1 : (g == 1 ? c2 : c3);
    const size_t off = (g == 0) ? O_SW1 : (g == 1 ? O_SW2 : O_SW3);
    const size_t n4 = (size_t)32 * W * 512 / 4;
#pragma unroll 4
    for (size_t i = gtid; i < n4; i += gsz) {
      const size_t e0 = i * 4;
      const int e = (int)(e0 & 511), ii = (int)((e0 >> 9) % W), b = (int)((e0 >> 9) / W);
      float4 o;
      if (ii < W - 4) o = *(const float4*)&cache[((size_t)b * W + ii + 4) * 512 + e];
      else {
        uint2 v = *(const uint2*)&p.proj[((size_t)MP + b * 4 + (ii - (W - 4))) * NP + 2048 + g * 768 + 256 + e];
        o = make_float4(bflo(v.x), bfhi(v.x), bflo(v.y), bfhi(v.y));
      }
      *(float4*)&p.out[off + e0] = o;
    }
  }
}

DI void mem_attn_prompt_block(const Params& p, int item, char* smem) {
  const int tid = threadIdx.x, lane = tid & 63, w = tid >> 6, r = lane & 15, kg = lane >> 4;
  const int h = item & 3, qb = item >> 2;
  const int row0 = qb * 64 + w * 16, b = (qb * 64) >> 13;
  const int bh = b * 4 + h;
  u16* sK = (u16*)smem;
  bf16x8 qf[8];
#pragma unroll
  for (int ks = 0; ks < 8; ++ks) qf[ks] = *(const bf16x8*)&G(p.qb)[(size_t)(row0 + r) * 1024 + h * 256 + ks * 32 + kg * 8];
  f32x4 st[16];
  const u16* kbp = G(p.Kb) + (size_t)bh * 65536;
#pragma unroll
  for (int c = 0; c < 4; ++c) {
    __syncthreads();
#pragma unroll
    for (int i2 = 0; i2 < 2; ++i2) {
#pragma unroll
      for (int i = i2 * 4; i < i2 * 4 + 4; ++i) {
        const int idx = tid + 256 * i, row = idx >> 5, seg = idx & 31;
        *(bf16x8*)&sK[row * 264 + seg * 8] = *(gb8p)((gu16p)kbp + (size_t)(c * 64 + row) * 256 + seg * 8);
      }
      __builtin_amdgcn_sched_barrier(0);
    }
    __syncthreads();
#pragma unroll
    for (int m4 = 0; m4 < 4; ++m4) {
      f32x4 a = (f32x4){0.f, 0.f, 0.f, 0.f};
#pragma unroll
      for (int ks = 0; ks < 8; ++ks) {
        bf16x8 kf = *(const bf16x8*)&sK[(m4 * 16 + r) * 264 + ks * 32 + kg * 8];
        a = MFMA(kf, qf[ks], a);
      }
      st[c * 4 + m4] = a;
      __builtin_amdgcn_sched_barrier(0);
    }
  }
  float mx = -3.0e38f;
#pragma unroll
  for (int mt = 0; mt < 16; ++mt)
#pragma unroll
    for (int j = 0; j < 4; ++j) { st[mt][j] *= 0.0625f; mx = fmaxf(mx, st[mt][j]); }
  mx = fmaxf(mx, __shfl_xor(mx, 16));
  mx = fmaxf(mx, __shfl_xor(mx, 32));
  float sum = 0.f;
#pragma unroll
  for (int mt = 0; mt < 16; ++mt)
#pragma unroll
    for (int j = 0; j < 4; ++j) { st[mt][j] = __expf(st[mt][j] - mx); sum += st[mt][j]; }
  sum += __shfl_xor(sum, 16);
  sum += __shfl_xor(sum, 32);
  const float inv = 1.f / sum;
  bf16x8 pf[8];
#pragma unroll
  for (int k2 = 0; k2 < 8; ++k2) pf[k2] = pack8(st[2 * k2], st[2 * k2 + 1]);
  const u16* vtp = G(p.VTf) + (size_t)bh * 65536;
#pragma unroll 1
  for (int c = 0; c < 4; ++c) {
    __syncthreads();
#pragma unroll
    for (int i = 0; i < 8; ++i) {
      const int idx = tid + 256 * i;
      *(bf16x8*)&sK[idx * 8] = *(gb8p)((gu16p)vtp + (size_t)c * 16384 + idx * 8);
    }
    __syncthreads();
#pragma unroll
    for (int n4 = 0; n4 < 4; ++n4) {
      f32x4 o = (f32x4){0.f, 0.f, 0.f, 0.f};
#pragma unroll
      for (int k2 = 0; k2 < 8; ++k2) o = MFMA(*(const bf16x8*)&sK[((n4 * 8 + k2) * 64 + lane) * 8], pf[k2], o);
      uint2 ov; ov.x = pack2(o[0] * inv, o[1] * inv); ov.y = pack2(o[2] * inv, o[3] * inv);
      *(uint2*)&G(p.attn)[(size_t)(row0 + r) * 1024 + h * 256 + (c * 4 + n4) * 16 + kg * 4] = ov;
      __builtin_amdgcn_sched_barrier(0);
    }
  }
}

DI void mem_attn_sample_wave(const Params& p, int item, float* lds) {
  const int lane = threadIdx.x & 63;
  const int b = item >> 2, h = item & 3;
  float* sq = lds;
#pragma unroll
  for (int t = 0; t < 4; ++t) {
    uint2 v = *(const uint2*)&p.qb[((size_t)MP + b * 4 + t) * 1024 + h * 256 + lane * 4];
    *(float4*)&sq[t * 256 + lane * 4] = make_float4(bflo(v.x), bfhi(v.x), bflo(v.y), bfhi(v.y));
  }
  __builtin_amdgcn_s_waitcnt(0);
  __builtin_amdgcn_wave_barrier();
  float sc[4][4];
#pragma unroll
  for (int mi = 0; mi < 4; ++mi) {
    const int m = lane + 64 * mi;
    const float* kr = &p.cache_mem[(((size_t)b * 256 + m) * 2 + 0) * 1024 + h * 256];
    float d0 = 0.f, d1 = 0.f, d2 = 0.f, d3 = 0.f;
#pragma unroll 2
    for (int c = 0; c < 256; c += 4) {
      float4 kv = *(const float4*)&kr[c];
      float4 q0 = *(const float4*)&sq[c], q1 = *(const float4*)&sq[256 + c], q2 = *(const float4*)&sq[512 + c], q3 = *(const float4*)&sq[768 + c];
      d0 += kv.x * q0.x + kv.y * q0.y + kv.z * q0.z + kv.w * q0.w;
      d1 += kv.x * q1.x + kv.y * q1.y + kv.z * q1.z + kv.w * q1.w;
      d2 += kv.x * q2.x + kv.y * q2.y + kv.z * q2.z + kv.w * q2.w;
      d3 += kv.x * q3.x + kv.y * q3.y + kv.z * q3.z + kv.w * q3.w;
    }
    sc[0][mi] = d0 * 0.0625f; sc[1][mi] = d1 * 0.0625f; sc[2][mi] = d2 * 0.0625f; sc[3][mi] = d3 * 0.0625f;
  }
  float inv[4];
  __builtin_amdgcn_wave_barrier();
#pragma unroll
  for (int t = 0; t < 4; ++t) {
    float mx = wave_max(fmaxf(fmaxf(sc[t][0], sc[t][1]), fmaxf(sc[t][2], sc[t][3])));
    float sum = 0.f;
#pragma unroll
    for (int mi = 0; mi < 4; ++mi) { sc[t][mi] = __expf(sc[t][mi] - mx); sum += sc[t][mi]; }
    sum = wave_sum(sum);
    inv[t] = 1.f / sum;
#pragma unroll
    for (int mi = 0; mi < 4; ++mi) sq[t * 256 + lane + 64 * mi] = sc[t][mi];
  }
  __builtin_amdgcn_s_waitcnt(0);
  __builtin_amdgcn_wave_barrier();
  float4 o[4];
#pragma unroll
  for (int t = 0; t < 4; ++t) o[t] = make_float4(0.f, 0.f, 0.f, 0.f);
#pragma unroll 4
  for (int m = 0; m < 256; ++m) {
    float4 vv = *(const float4*)&p.cache_mem[(((size_t)b * 256 + m) * 2 + 1) * 1024 + h * 256 + lane * 4];
#pragma unroll
    for (int t = 0; t < 4; ++t) {
      const float pv = sq[t * 256 + m];
      o[t].x += pv * vv.x; o[t].y += pv * vv.y; o[t].z += pv * vv.z; o[t].w += pv * vv.w;
    }
  }
#pragma unroll
  for (int t = 0; t < 4; ++t) {
    uint2 ov; ov.x = pack2(o[t].x * inv[t], o[t].y * inv[t]); ov.y = pack2(o[t].z * inv[t], o[t].w * inv[t]);
    *(uint2*)&p.attn[((size_t)MP + b * 4 + t) * 1024 + h * 256 + lane * 4] = ov;
  }
  __builtin_amdgcn_wave_barrier();
}

DI void phase7(const Params& p, char* smem) {
  const int w = threadIdx.x >> 6;
  float* lds = (float*)smem + w * 1280;
  for (int it = blockIdx.x; it < 32 + 2048; it += gridDim.x) {
    if (it < 32) { __syncthreads(); mem_attn_sample_wave(p, it * 4 + w, lds); }
    else mem_attn_prompt_block(p, it - 32, smem);
  }
}

DI void peer_topk_wave(const Params& p, int item, unsigned* lds  ) {
  const int lane = threadIdx.x & 63, r = lane & 15, kg = lane >> 4;
  const int h = item & 7, row0 = (item >> 3) * 16;
  unsigned win[2][16];
#pragma unroll
  for (int pp = 0; pp < 2; ++pp) {
    bf16x8 qf[4];
#pragma unroll
    for (int ks = 0; ks < 4; ++ks) qf[ks] = *(const bf16x8*)&p.pq[(size_t)(row0 + r) * 2048 + h * 256 + pp * 128 + ks * 32 + kg * 8];
    unsigned kk[32];
    const u16* sk = p.subkb + (size_t)(h * 2 + pp) * 16384;
#pragma unroll
    for (int mt = 0; mt < 8; ++mt) {
      f32x4 a = (f32x4){0.f, 0.f, 0.f, 0.f};
#pragma unroll
      for (int ks = 0; ks < 4; ++ks) {
        bf16x8 kf = *(const bf16x8*)&sk[(mt * 16 + r) * 128 + ks * 32 + kg * 8];
        a = MFMA(kf, qf[ks], a);
      }
#pragma unroll
      for (int j = 0; j < 4; ++j) kk[mt * 4 + j] = (ordf(a[j]) & ~127u) | (unsigned)(mt * 16 + kg * 4 + j);
    }
#pragma unroll
    for (int rr = 0; rr < 16; ++rr) {
      unsigned m = 0;
#pragma unroll
      for (int i = 0; i < 32; ++i) m = umax(m, kk[i]);
      m = umax(m, (unsigned)__shfl_xor((int)m, 16));
      m = umax(m, (unsigned)__shfl_xor((int)m, 32));
      win[pp][rr] = m;
#pragma unroll
      for (int i = 0; i < 32; ++i) kk[i] = (kk[i] == m) ? 0u : kk[i];
    }
  }
  float f0[16], f1[16];
#pragma unroll
  for (int i = 0; i < 16; ++i) { f0[i] = unordf(win[0][i] & ~127u); f1[i] = unordf(win[1][i] & ~127u); }
  unsigned cand[13];
#define CAND(s, a0, b0, a1, b1, a2, b2, a3, b3)                                                         \
  {                                                                                                     \
    float va = sel4(kg, f0[a0], f0[a1], f0[a2], f0[(a3) < 0 ? 0 : (a3)]);                                \
    float vb = sel4(kg, f1[b0], f1[b1], f1[b2], f1[(b3) < 0 ? 0 : (b3)]);                                \
    unsigned id = sel4(kg, (unsigned)((a0) * 16 + (b0)), (unsigned)((a1) * 16 + (b1)), (unsigned)((a2) * 16 + (b2)), (unsigned)(((a3) < 0 ? 0 : (a3)) * 16 + ((b3) < 0 ? 0 : (b3)))); \
    unsigned key = (ordf(va + vb) & ~255u) | id;                                                        \
    if ((a3) < 0) key = (kg == 3) ? 0u : key;                                                           \
    cand[s] = key;                                                                                      \
  }
  CAND(0, 0, 0, 0, 13, 2, 0, 6, 1)
  CAND(1, 0, 1, 0, 14, 2, 1, 7, 0)
  CAND(2, 0, 2, 0, 15, 2, 2, 7, 1)
  CAND(3, 0, 3, 1, 0, 2, 3, 8, 0)
  CAND(4, 0, 4, 1, 1, 2, 4, 9, 0)
  CAND(5, 0, 5, 1, 2, 3, 0, 10, 0)
  CAND(6, 0, 6, 1, 3, 3, 1, 11, 0)
  CAND(7, 0, 7, 1, 4, 3, 2, 12, 0)
  CAND(8, 0, 8, 1, 5, 3, 3, 13, 0)
  CAND(9, 0, 9, 1, 6, 4, 2, 14, 0)
  CAND(10, 0, 10, 1, 7, 5, 0, 15, 0)
  CAND(11, 0, 11, 4, 0, 5, 1, -1, -1)
  CAND(12, 0, 12, 4, 1, 6, 0, -1, -1)
#undef CAND
  unsigned w2[16];
#pragma unroll
  for (int rr = 0; rr < 16; ++rr) {
    unsigned m = 0;
#pragma unroll
    for (int i = 0; i < 13; ++i) m = umax(m, cand[i]);
    m = umax(m, (unsigned)__shfl_xor((int)m, 16));
    m = umax(m, (unsigned)__shfl_xor((int)m, 32));
    w2[rr] = m;
#pragma unroll
    for (int i = 0; i < 13; ++i) cand[i] = (cand[i] == m) ? 0u : cand[i];
  }
  if (kg == 0) {
#pragma unroll
    for (int i = 0; i < 16; ++i) { lds[r * 32 + i] = win[0][i] & 127u; lds[r * 32 + 16 + i] = win[1][i] & 127u; }
  }
  __builtin_amdgcn_s_waitcnt(0);
  __builtin_amdgcn_wave_barrier();
  const float cv0 = unordf(w2[0] & ~255u);
  float sum = 0.f;
#pragma unroll
  for (int rr = 0; rr < 16; ++rr) sum += __expf(unordf(w2[rr] & ~255u) - cv0);
  const float inv = 1.f / sum;
  const size_t ob = ((size_t)(row0 + r) * 8 + h) * 16;
#pragma unroll
  for (int q = 0; q < 4; ++q) {
    const unsigned wk = sel4(kg, w2[q], w2[4 + q], w2[8 + q], w2[12 + q]);
    const int a = (wk >> 4) & 15, bb = wk & 15;
    const int i1 = (int)lds[r * 32 + a], i2 = (int)lds[r * 32 + 16 + bb];
    p.eid[ob + kg * 4 + q] = i1 * 128 + i2;
    p.gate[ob + kg * 4 + q] = __expf(unordf(wk & ~255u) - cv0) * inv;
  }
  __builtin_amdgcn_wave_barrier();
}

typedef __attribute__((ext_vector_type(2))) float f32x2;
DI float dot16_fp8(u32x4 u, const float* x, float c) {
  const unsigned d[4] = {u[0], u[1], u[2], u[3]};
#pragma unroll
  for (int i = 0; i < 4; ++i) {
    f32x2 a = __builtin_amdgcn_cvt_pk_f32_fp8((int)d[i], false);
    f32x2 b = __builtin_amdgcn_cvt_pk_f32_fp8((int)d[i], true);
    c += a[0] * x[4 * i] + a[1] * x[4 * i + 1] + b[0] * x[4 * i + 2] + b[1] * x[4 * i + 3];
  }
  return c;
}
DI void axpy16_fp8(float* o, float w, u32x4 u) {
  const unsigned d[4] = {u[0], u[1], u[2], u[3]};
#pragma unroll
  for (int i = 0; i < 4; ++i) {
    f32x2 a = __builtin_amdgcn_cvt_pk_f32_fp8((int)d[i], false);
    f32x2 b = __builtin_amdgcn_cvt_pk_f32_fp8((int)d[i], true);
    o[4 * i] += w * a[0]; o[4 * i + 1] += w * a[1]; o[4 * i + 2] += w * b[0]; o[4 * i + 3] += w * b[1];
  }
}

DI void peer_expert_wave(const Params& p, int row) {
  const int lane = __builtin_amdgcn_mbcnt_hi(-1, __builtin_amdgcn_mbcnt_lo(-1, 0));
  float xf[16];
  {
    const uint4 x0 = *(const uint4*)&G(p.A2)[(size_t)row * 1024 + lane * 16];
    const uint4 x1 = *(const uint4*)&G(p.A2)[(size_t)row * 1024 + lane * 16 + 8];
    xf[0] = bflo(x0.x); xf[1] = bfhi(x0.x); xf[2] = bflo(x0.y); xf[3] = bfhi(x0.y);
    xf[4] = bflo(x0.z); xf[5] = bfhi(x0.z); xf[6] = bflo(x0.w); xf[7] = bfhi(x0.w);
    xf[8] = bflo(x1.x); xf[9] = bfhi(x1.x); xf[10] = bflo(x1.y); xf[11] = bfhi(x1.y);
    xf[12] = bflo(x1.z); xf[13] = bfhi(x1.z); xf[14] = bflo(x1.w); xf[15] = bfhi(x1.w);
  }
  const float r2 = rsqrtf(p.ssq2[row] * (1.f / 1024.f) + EPS);
  const unsigned char AS1* EU8 = (const unsigned char AS1*)p.E8;
  const unsigned char AS1* EV8 = (const unsigned char AS1*)p.E8 + (size_t)16384 * 1024;
  float out[16];
#pragma unroll
  for (int i = 0; i < 16; ++i) out[i] = 0.f;
#pragma unroll 1
  for (int bt = 0; bt < 2; ++bt) {
    const int eidv = G(p.eid)[(size_t)row * 128 + bt * 64 + lane];
    const float gv = G(p.gate)[(size_t)row * 128 + bt * 64 + lane];
    const float rsu = G(p.rs)[eidv], rsv = G(p.rs)[16384 + eidv];
    float part[64];
#pragma unroll
    for (int e = 0; e < 64; ++e) {
      const int id = __builtin_amdgcn_readlane(eidv, e);
      const u32x4 u = *(const u32x4 AS1*)(EU8 + (size_t)id * 1024 + lane * 16);
      part[e] = dot16_fp8(u, xf, 0.f);
    }
#pragma unroll
    for (int off = 32; off > 0; off >>= 1) {
      const bool up = (lane & off) != 0;
#pragma unroll
      for (int i = 0; i < off; ++i) {
        const float a = part[i], bq = part[i + off];
        const float send = up ? a : bq, keep = up ? bq : a;
        part[i] = keep + __shfl_xor(send, off);
      }
    }
    const float wv = gv * geluf(part[0] * r2 * rsu) * rsv;
#pragma unroll 8
    for (int e = 0; e < 64; ++e) {
      const int id = __builtin_amdgcn_readlane(eidv, e);
      const float we = __int_as_float(__builtin_amdgcn_readlane(__float_as_int(wv), e));
      const u32x4 v = *(const u32x4 AS1*)(EV8 + (size_t)id * 1024 + lane * 16);
      axpy16_fp8(out, we, v);
    }
  }
  const u16* hr = G(p.h2) + (size_t)row * 1024 + lane * 16;
  float hv[16];
  float ss = 0.f;
#pragma unroll
  for (int i = 0; i < 4; ++i) {
    const uint2 tv = *(const uint2*)&hr[i * 4];
    float4 t = make_float4(bflo(tv.x), bfhi(tv.x), bflo(tv.y), bfhi(tv.y));
    hv[4 * i] = t.x + out[4 * i]; hv[4 * i + 1] = t.y + out[4 * i + 1]; hv[4 * i + 2] = t.z + out[4 * i + 2]; hv[4 * i + 3] = t.w + out[4 * i + 3];
    ss += hv[4 * i] * hv[4 * i] + hv[4 * i + 1] * hv[4 * i + 1] + hv[4 * i + 2] * hv[4 * i + 2] + hv[4 * i + 3] * hv[4 * i + 3];
  }
  ss = wave_sum(ss);
  const float rsn = rsqrtf(ss * (1.f / 1024.f) + EPS);
  float* y = ((row < MP) ? (G(p.out) + O_YP + (size_t)row * 1024) : (G(p.out) + O_YS + (size_t)(row - MP) * 1024)) + lane * 16;
#pragma unroll
  for (int i = 0; i < 4; ++i) {
    float4 g4 = *(const float4*)&p.g_final[lane * 16 + i * 4];
    *(float4*)&y[i * 4] = make_float4(hv[4 * i] * rsn * g4.x, hv[4 * i + 1] * rsn * g4.y, hv[4 * i + 2] * rsn * g4.z, hv[4 * i + 3] * rsn * g4.w);
  }
}

DI void peer_u_wave(const Params& p, int row, float* wl  ) {
  const int lane = __builtin_amdgcn_mbcnt_hi(-1, __builtin_amdgcn_mbcnt_lo(-1, 0));
  float xf[16];
  {
    const u32x4 x0 = *(const u32x4 AS1*)((const u16 AS1*)p.A2 + (size_t)row * 1024 + lane * 16);
    const u32x4 x1 = *(const u32x4 AS1*)((const u16 AS1*)p.A2 + (size_t)row * 1024 + lane * 16 + 8);
    xf[0] = bflo(x0[0]); xf[1] = bfhi(x0[0]); xf[2] = bflo(x0[1]); xf[3] = bfhi(x0[1]);
    xf[4] = bflo(x0[2]); xf[5] = bfhi(x0[2]); xf[6] = bflo(x0[3]); xf[7] = bfhi(x0[3]);
    xf[8] = bflo(x1[0]); xf[9] = bfhi(x1[0]); xf[10] = bflo(x1[1]); xf[11] = bfhi(x1[1]);
    xf[12] = bflo(x1[2]); xf[13] = bfhi(x1[2]); xf[14] = bflo(x1[3]); xf[15] = bfhi(x1[3]);
  }
  const float r2 = rsqrtf(((const float AS1*)p.ssq2)[row] * (1.f / 1024.f) + EPS);
  const unsigned char AS1* EU8 = (const unsigned char AS1*)p.E8;
  const float AS1* rsp = (const float AS1*)p.rs;
#pragma unroll 1
  for (int bt = 0; bt < 2; ++bt) {
    const int eidv = ((const int AS1*)p.eid)[(size_t)row * 128 + bt * 64 + lane];
    const float gv = ((const float AS1*)p.gate)[(size_t)row * 128 + bt * 64 + lane];
    const float rsu = rsp[eidv], rsv = rsp[16384 + eidv];
    float part[64];
#pragma unroll
    for (int e = 0; e < 64; ++e) {
      const int id = __builtin_amdgcn_readlane(eidv, e);
      const u32x4 u = *(const u32x4 AS1*)(EU8 + (size_t)id * 1024 + lane * 16);
      part[e] = dot16_fp8(u, xf, 0.f);
    }
#pragma unroll
    for (int off = 32; off > 0; off >>= 1) {
      const bool up = (lane & off) != 0;
#pragma unroll
      for (int i = 0; i < off; ++i) {
        const float a = part[i], bq = part[i + off];
        const float send = up ? a : bq, keep = up ? bq : a;
        part[i] = keep + __shfl_xor(send, off);
      }
    }
    wl[bt * 64 + lane] = gv * geluf(part[0] * r2 * rsu) * rsv;
  }
}

DI void peer_v_group(const Params& p, int gw, int nw, int g, const float* wlw  ) {
  const int lane = __builtin_amdgcn_mbcnt_hi(-1, __builtin_amdgcn_mbcnt_lo(-1, 0));
  const unsigned char AS1* EV8 = (const unsigned char AS1*)p.E8 + (size_t)16384 * 1024;
  float out[4][16];
  int e0[4], e1[4];
  float w0[4], w1[4];
  bool valid[4];
#pragma unroll
  for (int ts = 0; ts < 4; ++ts) {
    const int k = g * 4 + ts;
    const int row = gw + k * nw;
    valid[ts] = row < MT;
#pragma unroll
    for (int i = 0; i < 16; ++i) out[ts][i] = 0.f;
    e0[ts] = 0x7fffffff; e1[ts] = 0x7fffffff; w0[ts] = 0.f; w1[ts] = 0.f;
    if (valid[ts]) {
      e0[ts] = ((const int AS1*)p.eid)[(size_t)row * 128 + lane];
      e1[ts] = ((const int AS1*)p.eid)[(size_t)row * 128 + 64 + lane];
      w0[ts] = wlw[k * 128 + lane];
      w1[ts] = wlw[k * 128 + 64 + lane];
    }
  }
#pragma unroll 1
  for (int r = 0; r < 8; ++r) {
#pragma unroll
    for (int ts = 0; ts < 4; ++ts) {
      unsigned long long m0 = __ballot((e0[ts] >> 11) == r);
      unsigned long long m1 = __ballot((e1[ts] >> 11) == r);
      while ((m0 | m1) != 0ull) {
        u32x4 v[8];
        float we[8];
#pragma unroll
        for (int k = 0; k < 8; ++k) {
          we[k] = 0.f;
          v[k] = (u32x4){0u, 0u, 0u, 0u};
          if ((m0 | m1) != 0ull) {
            int l, id;
            if (m0 != 0ull) {
              l = __builtin_ctzll(m0); m0 &= m0 - 1ull;
              id = __builtin_amdgcn_readlane(e0[ts], l);
              we[k] = __int_as_float(__builtin_amdgcn_readlane(__float_as_int(w0[ts]), l));
            } else {
              l = __builtin_ctzll(m1); m1 &= m1 - 1ull;
              id = __builtin_amdgcn_readlane(e1[ts], l);
              we[k] = __int_as_float(__builtin_amdgcn_readlane(__float_as_int(w1[ts]), l));
            }
            v[k] = *(const u32x4 AS1*)(EV8 + (size_t)id * 1024 + lane * 16);
          }
        }
#pragma unroll
        for (int k = 0; k < 8; ++k) axpy16_fp8(out[ts], we[k], v[k]);
      }
    }
  }
#pragma unroll
  for (int ts = 0; ts < 4; ++ts) {
    if (!valid[ts]) continue;
    const int row = gw + (g * 4 + ts) * nw;
    const u16 AS1* hr = (const u16 AS1*)p.h2 + (size_t)row * 1024 + lane * 16;
    float hv[16];
    float ss = 0.f;
#pragma unroll
    for (int i = 0; i < 4; ++i) {
      const u32x2 tv = *(const u32x2 AS1*)&hr[i * 4];
      f32x4 t = (f32x4){bflo(tv[0]), bfhi(tv[0]), bflo(tv[1]), bfhi(tv[1])};
      hv[4 * i] = t[0] + out[ts][4 * i]; hv[4 * i + 1] = t[1] + out[ts][4 * i + 1]; hv[4 * i + 2] = t[2] + out[ts][4 * i + 2]; hv[4 * i + 3] = t[3] + out[ts][4 * i + 3];
      ss += hv[4 * i] * hv[4 * i] + hv[4 * i + 1] * hv[4 * i + 1] + hv[4 * i + 2] * hv[4 * i + 2] + hv[4 * i + 3] * hv[4 * i + 3];
    }
    ss = wave_sum(ss);
    const float rsn = rsqrtf(ss * (1.f / 1024.f) + EPS);
    float AS1* y = ((row < MP) ? ((float AS1*)p.out + O_YP + (size_t)row * 1024) : ((float AS1*)p.out + O_YS + (size_t)(row - MP) * 1024)) + lane * 16;
#pragma unroll
    for (int i = 0; i < 4; ++i) {
      f32x4 g4 = *(const f32x4 AS1*)&((const float AS1*)p.g_final)[lane * 16 + i * 4];
      f32x4 o;
      o[0] = hv[4 * i] * rsn * g4[0]; o[1] = hv[4 * i + 1] * rsn * g4[1]; o[2] = hv[4 * i + 2] * rsn * g4[2]; o[3] = hv[4 * i + 3] * rsn * g4[3];
      *(f32x4 AS1*)&y[i * 4] = o;
    }
  }
}


#define XB_TMO      128
#define XB_XCNT(j)  (256  + 64 * (j))
#define XB_XSUB(j)  (1280 + 64 * (j))
#define XB_XGEN(j)  (2304 + 64 * (j))
#define XB_TOP      3328
#define XB_TOPGEN   3392
#define XCD_BAR_WORDS 3456
#define XB_SPIN_CAP (1u << 18)
#define LAS __attribute__((address_space(3)))
DI unsigned xb_ld(unsigned* q) { return __hip_atomic_load(q, __ATOMIC_RELAXED, __HIP_MEMORY_SCOPE_AGENT); }
DI unsigned xb_add(unsigned* q, unsigned v) { return __hip_atomic_fetch_add(q, v, __ATOMIC_RELAXED, __HIP_MEMORY_SCOPE_AGENT); }
DI unsigned xb_xcc_id() { return (unsigned)__builtin_amdgcn_s_getreg((3 << 11) | 20) & 0xFu; }
#define XB_SPIN(cond, bar) do { unsigned _sp = 0; while (cond) { __builtin_amdgcn_s_sleep(1); \
    if ((++_sp & 255u) == 0u) { if (xb_ld(&(bar)[XB_TMO])) break; if (_sp > XB_SPIN_CAP) { atomicAdd(&(bar)[XB_TMO], 1u); break; } } } } while (0)
struct XcdBarrier { unsigned* bar; unsigned x; volatile LAS unsigned* st; };
DI XcdBarrier xcd_barrier_post(unsigned* bar, volatile LAS unsigned* st) {
  XcdBarrier b; b.bar = bar; b.x = xb_xcc_id(); b.st = st;
  if (threadIdx.x == 0) (void)xb_add(&bar[XB_XCNT(b.x)], 1u);
  return b;
}
DI void xcd_barrier_complete(unsigned* bar, unsigned x, unsigned& nloc, unsigned& nx) {
  const unsigned G = gridDim.x * gridDim.y * gridDim.z;
  unsigned sum, cnt, mine, sp = 0u;
  for (;;) {
    sum = 0u; cnt = 0u; mine = 0u;
#pragma unroll
    for (unsigned j = 0; j < 16; ++j) { const unsigned c = xb_ld(&bar[XB_XCNT(j)]); sum += c; cnt += (c > 0u) ? 1u : 0u; mine = (j == x) ? c : mine; }
    if (sum == G) break;
    __builtin_amdgcn_s_sleep(1);
    if ((++sp & 255u) == 0u) { if (xb_ld(&bar[XB_TMO])) break; if (sp > XB_SPIN_CAP) { atomicAdd(&bar[XB_TMO], 1u); break; } }
  }
  nloc = mine > 0u ? mine : 1u; nx = cnt > 0u ? cnt : 1u;
}
DI void xcd_barrier(const XcdBarrier& b) {
  asm volatile("s_waitcnt vmcnt(0)" ::: "memory");
  __syncthreads();
  if (threadIdx.x == 0) {
    unsigned* bar = b.bar;
    __builtin_amdgcn_s_waitcnt(0);
    unsigned nloc = b.st[0], nx = b.st[1];
    if (nloc == 0u) { xcd_barrier_complete(bar, b.x, nloc, nx); b.st[0] = nloc; b.st[1] = nx; }
    const unsigned old = xb_add(&bar[XB_XSUB(b.x)], 1u);
    const unsigned gen = old / nloc;
    if (old + 1u == (gen + 1u) * nloc) {
      __builtin_amdgcn_fence(__ATOMIC_RELEASE, "agent");
      asm volatile("s_waitcnt vmcnt(0)" ::: "memory");
      const unsigned og = xb_add(&bar[XB_TOP], 1u);
      const unsigned tg = og / nx;
      if (og + 1u == (tg + 1u) * nx) xb_add(&bar[XB_TOPGEN], 1u);
      else XB_SPIN(xb_ld(&bar[XB_TOPGEN]) == tg, bar);
      __builtin_amdgcn_fence(__ATOMIC_ACQUIRE, "agent");
      xb_add(&bar[XB_XGEN(b.x)], 1u);
      asm volatile("s_waitcnt vmcnt(0)" ::: "memory");
    } else {
      XB_SPIN(xb_ld(&bar[XB_XGEN(b.x)]) == gen, bar);
      __builtin_amdgcn_fence(__ATOMIC_ACQUIRE, "agent");
      asm volatile("s_waitcnt vmcnt(0)" ::: "memory");
    }
  }
  __syncthreads();
}

__global__ void __launch_bounds__(256, 2) mega(Params pk) {
  __shared__ __attribute__((aligned(16))) char smem[65536];
  __shared__ Params sp;
  cg::grid_group grid = cg::this_grid();
  const int w = threadIdx.x >> 6;
  __shared__ uint4 xb_words;
  if (threadIdx.x == 0) { sp = pk; xb_words = make_uint4(0u, 0u, 0u, 0u); }
  __syncthreads();
  const Params& p = sp;
  XcdBarrier xb = xcd_barrier_post(p.bar, (volatile LAS unsigned*)&xb_words);
  if (p.never) grid.sync();
#define GSYNC() xcd_barrier(xb)
#define REP(ph) for (int rp_ = 0; rp_ < ((DBL == (ph)) ? 2 : 1); ++rp_)
  REP(0) { phase0(p, smem); if (DBL == 0) grid.sync(); }
  GSYNC();
  REP(1) {
    int tm, tn;
    for (int it = 0; it * (int)gridDim.x < 129 * 34; ++it)
      if (xcd_tile(it, 129, 34, tm, tn)) gemm_tile<0, 1024>(p, p.A0, 1024, p.WtIn, tm, tn, smem);
    for (int u = blockIdx.x; u < 64; u += gridDim.x) gemm_tile<1, 1024>(p, p.Amem, 1024, p.WtMkv, u / 16, u % 16, smem);
  }
  GSYNC();
  REP(2) { phase2(p, smem); if (DBL == 2) grid.sync(); }
  GSYNC();
  REP(3) { phase3(p, smem); if (DBL == 3) grid.sync(); }
  GSYNC();
  REP(4) phase4(p);
  GSYNC();
  { int tm, tn; for (int it = 0; it * (int)gridDim.x < 257 * 8; ++it) if (xcd_tile(it, 257, 8, tm, tn)) gemm_tile128<2, 768>(p, p.Amix, 768, p.WtOut, tm, tn, smem); }
  GSYNC();
  REP(6) { int tm, tn; for (int it = 0; it * (int)gridDim.x < 257 * 8; ++it) if (xcd_tile(it, 257, 8, tm, tn)) gemm_tile128<3, 1024>(p, p.A1, 1024, p.WtMq, tm, tn, smem); }
  sample_state_copy(p);
  GSYNC();
  REP(7) phase7(p, smem);
  GSYNC();
  { int tm, tn; for (int it = 0; it * (int)gridDim.x < 257 * 8; ++it) if (xcd_tile(it, 257, 8, tm, tn)) gemm_tile128<4, 1024>(p, p.attn, 1024, p.WtMo, tm, tn, smem); }
  GSYNC();
  REP(9) { int tm, tn; for (int it = 0; it * (int)gridDim.x < 129 * 16; ++it) if (xcd_tile(it, 129, 16, tm, tn)) gemm_tile<5, 1024>(p, p.A2, 1024, p.WtPq, tm, tn, smem); }
  GSYNC();
  REP(10) {
    unsigned* lds = (unsigned*)smem + w * 512;
    for (int it = blockIdx.x * 4 + w; it < 2056 * 8; it += gridDim.x * 4) peer_topk_wave(p, it, lds);
  }
  GSYNC();
  REP(11) {
    const int gw = blockIdx.x * 4 + w, nw = gridDim.x * 4;
    float* wlw = (float*)smem + w * (17 * 128);
    __syncthreads();
    for (int k = 0; gw + k * nw < MT && k < 17; ++k) peer_u_wave(p, gw + k * nw, wlw + k * 128);
    __builtin_amdgcn_s_waitcnt(0xc07f);
    __builtin_amdgcn_wave_barrier();
    for (int g = 0; (g * 4) * nw + gw < MT && g < 5; ++g) peer_v_group(p, gw, nw, g, wlw);
  }
}

extern "C" void kernel_launch(void* const* d_in, const int* in_sizes, int n_in, void* d_out, int out_size, void* d_ws, size_t ws_size,
                              hipStream_t stream) {
  static int grid_blocks = 0;
  if (!grid_blocks) {
    int dev = 0, cus = 0, per_cu = 0;
    (void)hipGetDevice(&dev);
    (void)hipDeviceGetAttribute(&cus, hipDeviceAttributeMultiprocessorCount, dev);
    (void)hipOccupancyMaxActiveBlocksPerMultiprocessor(&per_cu, mega, 256, 0);
    if (per_cu > 2) per_cu = 2;
    if (per_cu < 1) per_cu = 1;
    grid_blocks = cus * per_cu;
  }
  Params p{};
  const float* const* in = (const float* const*)d_in;
  p.x_prompt = in[0]; p.x_sample = in[1]; p.state_delta = in[2]; p.state_conv = in[3]; p.cw1 = in[4]; p.cw2 = in[5]; p.cw3 = in[6];
  p.cache_mem = in[7]; p.mem_prompt = in[8]; p.g_mix = in[9]; p.w_in = in[10]; p.conv_w = in[11]; p.a_log = in[12]; p.dt_bias = in[13];
  p.g_onorm = in[14]; p.w_out = in[15]; p.g_memq = in[16]; p.g_memkv = in[17]; p.w_mq = in[18]; p.w_mkv = in[19]; p.w_mo = in[20];
  p.g_ffn = in[21]; p.w_pq = in[22]; p.sub_keys = in[23]; p.expert_u = in[24]; p.expert_v = in[25]; p.g_final = in[26];
  p.out = (float*)d_out;
  char* ws = (char*)d_ws;
  size_t off = 0;
  auto take = [&](size_t bytes) { char* r = ws + off; off += (bytes + 255) & ~(size_t)255; return r; };
  p.WtIn = (u16*)take((size_t)NP * 1024 * 2);
  p.WtOut = (u16*)take((size_t)1024 * 768 * 2);
  p.WtMq = (u16*)take((size_t)1024 * 1024 * 2);
  p.WtMkv = (u16*)take((size_t)2048 * 1024 * 2);
  p.WtMo = (u16*)take((size_t)1024 * 1024 * 2);
  p.WtPq = (u16*)take((size_t)2048 * 1024 * 2);
  p.subkb = (u16*)take((size_t)262144 * 2);
  p.E8 = (unsigned char*)take((size_t)32768 * 1024);
  p.rs = (float*)take((size_t)32768 * 4);
  p.Amem = (u16*)take((size_t)1024 * 1024 * 2);
  p.gb = (float*)take((size_t)MT * 8 * 4);
  p.ssq1 = (float*)take((size_t)MT * 4);
  p.ssq2 = (float*)take((size_t)MT * 4);
  p.dl = (float*)take(2048 * 4);
  p.Kb = (u16*)take((size_t)16 * 65536 * 2);
  p.VTf = (u16*)take((size_t)16 * 65536 * 2);
  char* regA = take((size_t)MT * NP * 2);
  char* regB = take((size_t)2048 * DN_ITEM);
  p.proj = (u16*)regA;
  p.h1 = (u16*)regA;
  p.h2 = (u16*)(regA + (size_t)MT * 1024 * 4);
  p.pq = (u16*)regA;
  p.dnops = regB;
  p.A0 = (u16*)regB;
  p.A1 = (u16*)regB;
  p.qb = (u16*)(regB + (size_t)MT * 1024 * 2);
  p.attn = (u16*)regB;
  p.A2 = (u16*)(regB + (size_t)MT * 1024 * 2);
  p.eid = (int*)regB;
  p.gate = (float*)(regB + (size_t)MT * 128 * 4);
  char* ob = (char*)d_out;
  p.vT = (u16*)ob;
  p.osw = (u16*)(ob + (size_t)3 * MP * 256 * 2);
  p.lse = (float*)(ob + (size_t)3 * MP * 256 * 2 + (size_t)3 * MT * 256 * 2);
  char* sb = ob + O_SW3 * 4;
  p.odn = (u16*)sb;
  p.Amix = (u16*)(sb + (size_t)MT * 512 * 2);
  p.bar = (unsigned*)take((size_t)XCD_BAR_WORDS * 4);
  p.never = 0;
  p.pad_ = 0;
  if (off > ws_size) { fprintf(stderr, "workspace too small: need %zu have %zu\n", off, ws_size); return; }
  (void)hipMemsetAsync(p.bar, 0, (size_t)XCD_BAR_WORDS * 4, stream);
  void* args[] = {&p};
  hipError_t e = hipLaunchCooperativeKernel((void*)mega, dim3(grid_blocks), dim3(256), args, 0, stream);
  if (e != hipSuccess) fprintf(stderr, "coop launch failed: %s (grid %d)\n", hipGetErrorString(e), grid_blocks);
}
```

```cpp
#include <hip/hip_runtime.h>
#include <hip/hip_cooperative_groups.h>
#include <cstdio>
namespace cg = cooperative_groups;

typedef unsigned short u16;
typedef __attribute__((ext_vector_type(8))) short bf16x8;
typedef __attribute__((ext_vector_type(4))) float f32x4;
typedef __attribute__((ext_vector_type(2))) __bf16 bf2_t;

#define DI __device__ __forceinline__
#define MFMA(a, b, c) __builtin_amdgcn_mfma_f32_16x16x32_bf16((a), (b), (c), 0, 0, 0)

#ifndef DBL
#define DBL -1
#endif
constexpr int MP = 32768, MS = 128, MT = 32896;
constexpr int NP = 4352;
constexpr int SEQ = 8192;
constexpr float EPS = 1e-6f;
constexpr size_t DN_ITEM = 73728;

constexpr size_t O_YP = 0, O_YS = 33554432, O_PDELTA = 33685504, O_PCONV = 33947648, O_PW1 = 33966080,
                 O_PW2 = 34228224, O_PW3 = 35276800, O_PMEM = 39471104, O_SDELTA = 41568256, O_SCONV = 43665408,
                 O_SW1 = 43812864, O_SW2 = 45910016, O_SW3 = 54298624;

struct Params {
  const float *x_prompt, *x_sample, *state_delta, *state_conv, *cw1, *cw2, *cw3, *cache_mem, *mem_prompt;
  const float *g_mix, *w_in, *conv_w, *a_log, *dt_bias, *g_onorm, *w_out, *g_memq, *g_memkv, *w_mq, *w_mkv, *w_mo;
  const float *g_ffn, *w_pq, *sub_keys, *expert_u, *expert_v, *g_final;
  float* out;
  u16 *WtIn, *WtOut, *WtMq, *WtMkv, *WtMo, *WtPq, *subkb, *Amem;
  unsigned char* E8;
  float* rs;
  float *gb, *ssq1, *ssq2, *dl;
  u16 *Kb, *VTf;
  u16* proj;
  u16 *h1, *h2;
  u16* pq;
  char* dnops;
  u16 *A0, *A1, *qb, *attn, *A2;
  int* eid;
  float* gate;
  u16 *vT, *osw, *odn, *Amix;
  float* lse;
  unsigned* bar;
  int never;
  int pad_;
};

#define AS1 __attribute__((address_space(1)))
template <typename T> DI T* G(T* q) { return q; }
typedef const bf16x8 AS1* gb8p;
typedef const u16 AS1* gu16p;
typedef __attribute__((ext_vector_type(4))) unsigned u32x4;
DI u16 f2bf(float x) { unsigned u = __float_as_uint(x); u += 0x7fffu + ((u >> 16) & 1u); return (u16)(u >> 16); }
DI float bf2f(u16 h) { return __uint_as_float(((unsigned)h) << 16); }
DI unsigned pack2(float a, float b) { return (unsigned)f2bf(a) | ((unsigned)f2bf(b) << 16); }
DI float bflo(unsigned d) { return __uint_as_float(d << 16); }
DI float bfhi(unsigned d) { return __uint_as_float(d & 0xffff0000u); }
DI bf16x8 pack8(f32x4 a, f32x4 b) {
  uint4 r; r.x = pack2(a[0], a[1]); r.y = pack2(a[2], a[3]); r.z = pack2(b[0], b[1]); r.w = pack2(b[2], b[3]);
  return __builtin_bit_cast(bf16x8, r);
}
DI float wave_sum(float v) {
#pragma unroll
  for (int o = 32; o > 0; o >>= 1) v += __shfl_xor(v, o);
  return v;
}
DI float wave_max(float v) {
#pragma unroll
  for (int o = 32; o > 0; o >>= 1) v = fmaxf(v, __shfl_xor(v, o));
  return v;
}
DI float siluf(float x) { return x / (1.f + __expf(-x)); }
DI float geluf(float x) { return 0.5f * x * (1.f + tanhf(0.7978845608028654f * (x + 0.044715f * x * x * x))); }
DI int permk(int kg, int j) { return (j < 4) ? (kg * 4 + j) : (16 + kg * 4 + (j - 4)); }
DI void cvt8(const float* __restrict__ s, u16* __restrict__ d) {
  float4 a = *(const float4*)s, b = *(const float4*)(s + 4);
  uint4 r; r.x = pack2(a.x, a.y); r.y = pack2(a.z, a.w); r.z = pack2(b.x, b.y); r.w = pack2(b.z, b.w);
  *(uint4*)d = r;
}
DI unsigned ordf(float f) { unsigned u = __float_as_uint(f); return (u & 0x80000000u) ? ~u : (u | 0x80000000u); }
DI float unordf(unsigned k) { unsigned u = (k & 0x80000000u) ? (k & 0x7fffffffu) : ~k; return __uint_as_float(u); }
DI unsigned umax(unsigned a, unsigned b) { return a > b ? a : b; }
template <typename T> DI T sel4(int L, T a, T b, T c, T d) { return L == 0 ? a : (L == 1 ? b : (L == 2 ? c : d)); }

#define AS3 __attribute__((address_space(3)))
template <int MODE, int K>
DI void gemm_tile(const Params& p, const u16* __restrict__ A, int lda, const u16* __restrict__ Bt, int tm, int tn,
                          char* smem) {
  const int tid = threadIdx.x, lane = tid & 63, w = tid >> 6;
  const int wm = w >> 1, wn = w & 1, r = lane & 15, kg = lane >> 4;
  f32x4 acc[8][4];
#pragma unroll
  for (int i = 0; i < 8; ++i)
#pragma unroll
    for (int j = 0; j < 4; ++j) acc[i][j] = (f32x4){0.f, 0.f, 0.f, 0.f};
  const int lr = lane >> 2, lkg = (lane & 3) ^ (lane >> 4);
  gu16p gA[4], gB[2];
#pragma unroll
  for (int i = 0; i < 4; ++i) gA[i] = (gu16p)A + (size_t)(tm * 256 + (w * 4 + i) * 16 + lr) * lda + lkg * 8;
#pragma unroll
  for (int i = 0; i < 2; ++i) gB[i] = (gu16p)Bt + (size_t)(tn * 128 + (w * 2 + i) * 16 + lr) * K + lkg * 8;
  const int frag_off = r * 64 + ((kg ^ (r >> 2)) * 16);
  __syncthreads();
#pragma unroll
  for (int i = 0; i < 4; ++i)
    __builtin_amdgcn_global_load_lds((const unsigned AS1*)(gA[i]), (unsigned AS3*)(smem + (w * 4 + i) * 1024), 16, 0, 0);
#pragma unroll
  for (int i = 0; i < 2; ++i)
    __builtin_amdgcn_global_load_lds((const unsigned AS1*)(gB[i]), (unsigned AS3*)(smem + 16384 + (w * 2 + i) * 1024), 16, 0, 0);
#pragma unroll 2
  for (int k = 0; k < K / 32; ++k) {
    __syncthreads();
    if (k + 1 < K / 32) {
      char* st = smem + ((k + 1) & 1) * 24576;
#pragma unroll
      for (int i = 0; i < 4; ++i)
        __builtin_amdgcn_global_load_lds((const unsigned AS1*)(gA[i] + (k + 1) * 32), (unsigned AS3*)(st + (w * 4 + i) * 1024), 16, 0, 0);
#pragma unroll
      for (int i = 0; i < 2; ++i)
        __builtin_amdgcn_global_load_lds((const unsigned AS1*)(gB[i] + (k + 1) * 32), (unsigned AS3*)(st + 16384 + (w * 2 + i) * 1024), 16, 0, 0);
    }
    const char* sa = smem + (k & 1) * 24576;
    const char* sb = sa + 16384;
    bf16x8 af[8], bfr[4];
#pragma unroll
    for (int i = 0; i < 8; ++i) af[i] = *(const bf16x8*)(sa + (wm * 8 + i) * 1024 + frag_off);
#pragma unroll
    for (int i = 0; i < 4; ++i) bfr[i] = *(const bf16x8*)(sb + (wn * 4 + i) * 1024 + frag_off);
    __builtin_amdgcn_s_setprio(1);
#pragma unroll
    for (int mt = 0; mt < 8; ++mt)
#pragma unroll
      for (int nt = 0; nt < 4; ++nt) acc[mt][nt] = MFMA(bfr[nt], af[mt], acc[mt][nt]);
    __builtin_amdgcn_s_setprio(0);
  }
#pragma unroll
  for (int mt = 0; mt < 8; ++mt) {
    const int row = tm * 256 + wm * 128 + mt * 16 + r;
    if (tm * 256 + wm * 128 + mt * 16 >= ((MODE == 1) ? 1024 : MT)) continue;
    float rs = 1.f, ssq = 0.f;
    if (MODE == 3) rs = rsqrtf(p.ssq1[row] * (1.f / 1024.f) + EPS);
    if (MODE == 5) rs = rsqrtf(p.ssq2[row] * (1.f / 1024.f) + EPS);
#pragma unroll
    for (int nt = 0; nt < 4; ++nt) {
      const int col = tn * 128 + wn * 64 + nt * 16 + kg * 4;
      f32x4 v = acc[mt][nt];
      if (MODE == 0) {
        uint2 o; o.x = pack2(v[0], v[1]); o.y = pack2(v[2], v[3]);
        *(uint2*)&p.proj[(size_t)row * NP + col] = o;
      } else if (MODE == 1) {
        *(float4*)&p.out[O_PMEM + (size_t)row * 2048 + col] = make_float4(v[0], v[1], v[2], v[3]);
      } else if (MODE == 2 || MODE == 4) {
        float4 rsd;
        if (MODE == 2) {
          rsd = (row < MP) ? *(const float4*)&p.x_prompt[(size_t)row * 1024 + col] : *(const float4*)&p.x_sample[(size_t)(row - MP) * 1024 + col];
        } else {
          { const uint2 rv = *(const uint2*)&p.h1[(size_t)row * 1024 + col]; rsd = make_float4(bflo(rv.x), bfhi(rv.x), bflo(rv.y), bfhi(rv.y)); }
        }
        float4 h = make_float4(rsd.x + v[0], rsd.y + v[1], rsd.z + v[2], rsd.w + v[3]);
        ssq += h.x * h.x + h.y * h.y + h.z * h.z + h.w * h.w;
        const uint2 hb = make_uint2(pack2(h.x, h.y), pack2(h.z, h.w));
        if (MODE == 2) *(uint2*)&p.h1[(size_t)row * 1024 + col] = hb;
        else *(uint2*)&p.h2[(size_t)row * 1024 + col] = hb;
      } else if (MODE == 3) {
        uint2 o; o.x = pack2(v[0] * rs, v[1] * rs); o.y = pack2(v[2] * rs, v[3] * rs);
        *(uint2*)&p.qb[(size_t)row * 1024 + col] = o;
      } else {
        uint2 o; o.x = pack2(v[0] * rs, v[1] * rs); o.y = pack2(v[2] * rs, v[3] * rs);
        *(uint2*)&p.pq[(size_t)row * 2048 + col] = o;
      }
    }
    if (MODE == 2 || MODE == 4) {
      ssq += __shfl_xor(ssq, 16);
      ssq += __shfl_xor(ssq, 32);
      if (kg == 0) atomicAdd((MODE == 2) ? &p.ssq1[row] : &p.ssq2[row], ssq);
    }
  }
}

template <int MODE, int K>
DI void gemm_tile128(const Params& p, const u16* __restrict__ A, int lda, const u16* __restrict__ Bt, int tm, int tn,
                          char* smem) {
  const int tid = threadIdx.x, lane = tid & 63, w = tid >> 6;
  const int wm = w >> 1, wn = w & 1, r = lane & 15, kg = lane >> 4;
  f32x4 acc[4][4];
#pragma unroll
  for (int i = 0; i < 4; ++i)
#pragma unroll
    for (int j = 0; j < 4; ++j) acc[i][j] = (f32x4){0.f, 0.f, 0.f, 0.f};
  const int lr = lane >> 2, lkg = (lane & 3) ^ (lane >> 4);
  gu16p gA[4], gB[4];
#pragma unroll
  for (int i = 0; i < 4; ++i) {
    const int sub = w * 4 + i, mt = sub >> 1, ks = sub & 1;
    gA[i] = (gu16p)A + (size_t)(tm * 128 + mt * 16 + lr) * lda + ks * 32 + lkg * 8;
    gB[i] = (gu16p)Bt + (size_t)(tn * 128 + mt * 16 + lr) * K + ks * 32 + lkg * 8;
  }
  const int frag_off = r * 64 + ((kg ^ (r >> 2)) * 16);
  __syncthreads();
#pragma unroll
  for (int i = 0; i < 4; ++i) {
    __builtin_amdgcn_global_load_lds((const unsigned AS1*)(gA[i]), (unsigned AS3*)(smem + (w * 4 + i) * 1024), 16, 0, 0);
    __builtin_amdgcn_global_load_lds((const unsigned AS1*)(gB[i]), (unsigned AS3*)(smem + 16384 + (w * 4 + i) * 1024), 16, 0, 0);
  }
#pragma unroll 2
  for (int k = 0; k < K / 64; ++k) {
    __syncthreads();
    if (k + 1 < K / 64) {
      char* st = smem + ((k + 1) & 1) * 32768;
#pragma unroll
      for (int i = 0; i < 4; ++i) {
        __builtin_amdgcn_global_load_lds((const unsigned AS1*)(gA[i] + (k + 1) * 64), (unsigned AS3*)(st + (w * 4 + i) * 1024), 16, 0, 0);
        __builtin_amdgcn_global_load_lds((const unsigned AS1*)(gB[i] + (k + 1) * 64), (unsigned AS3*)(st + 16384 + (w * 4 + i) * 1024), 16, 0, 0);
      }
    }
    const char* sa = smem + (k & 1) * 32768;
    const char* sb = sa + 16384;
#pragma unroll
    for (int ks = 0; ks < 2; ++ks) {
      bf16x8 af[4], bfr[4];
#pragma unroll
      for (int i = 0; i < 4; ++i) {
        af[i] = *(const bf16x8*)(sa + ((wm * 4 + i) * 2 + ks) * 1024 + frag_off);
        bfr[i] = *(const bf16x8*)(sb + ((wn * 4 + i) * 2 + ks) * 1024 + frag_off);
      }
#pragma unroll
      for (int mt = 0; mt < 4; ++mt)
#pragma unroll
        for (int nt = 0; nt < 4; ++nt) acc[mt][nt] = MFMA(bfr[nt], af[mt], acc[mt][nt]);
    }
  }
#pragma unroll
  for (int mt = 0; mt < 4; ++mt) {
    const int row = tm * 128 + wm * 64 + mt * 16 + r;
    float rs = 1.f, ssq = 0.f;
    if (MODE == 3) rs = rsqrtf(p.ssq1[row] * (1.f / 1024.f) + EPS);
    if (MODE == 5) rs = rsqrtf(p.ssq2[row] * (1.f / 1024.f) + EPS);
#pragma unroll
    for (int nt = 0; nt < 4; ++nt) {
      const int col = tn * 128 + wn * 64 + nt * 16 + kg * 4;
      f32x4 v = acc[mt][nt];
      if (MODE == 0) {
        uint2 o; o.x = pack2(v[0], v[1]); o.y = pack2(v[2], v[3]);
        *(uint2*)&p.proj[(size_t)row * NP + col] = o;
      } else if (MODE == 1) {
        *(float4*)&p.out[O_PMEM + (size_t)row * 2048 + col] = make_float4(v[0], v[1], v[2], v[3]);
      } else if (MODE == 2 || MODE == 4) {
        float4 rsd;
        if (MODE == 2) {
          rsd = (row < MP) ? *(const float4*)&p.x_prompt[(size_t)row * 1024 + col] : *(const float4*)&p.x_sample[(size_t)(row - MP) * 1024 + col];
        } else {
          { const uint2 rv = *(const uint2*)&p.h1[(size_t)row * 1024 + col]; rsd = make_float4(bflo(rv.x), bfhi(rv.x), bflo(rv.y), bfhi(rv.y)); }
        }
        float4 h = make_float4(rsd.x + v[0], rsd.y + v[1], rsd.z + v[2], rsd.w + v[3]);
        ssq += h.x * h.x + h.y * h.y + h.z * h.z + h.w * h.w;
        const uint2 hb = make_uint2(pack2(h.x, h.y), pack2(h.z, h.w));
        if (MODE == 2) *(uint2*)&p.h1[(size_t)row * 1024 + col] = hb;
        else *(uint2*)&p.h2[(size_t)row * 1024 + col] = hb;
      } else if (MODE == 3) {
        uint2 o; o.x = pack2(v[0] * rs, v[1] * rs); o.y = pack2(v[2] * rs, v[3] * rs);
        *(uint2*)&p.qb[(size_t)row * 1024 + col] = o;
      } else {
        uint2 o; o.x = pack2(v[0] * rs, v[1] * rs); o.y = pack2(v[2] * rs, v[3] * rs);
        *(uint2*)&p.pq[(size_t)row * 2048 + col] = o;
      }
    }
    if (MODE == 2 || MODE == 4) {
      ssq += __shfl_xor(ssq, 16);
      ssq += __shfl_xor(ssq, 32);
      if (kg == 0) atomicAdd((MODE == 2) ? &p.ssq1[row] : &p.ssq2[row], ssq);
    }
  }
}

DI bool xcd_tile(int it, int nM, int nN, int& tm, int& tn) {
  const int per = gridDim.x >> 3;
  const int xcd = blockIdx.x & 7, li = blockIdx.x >> 3;
  const int i = (it * 8 + xcd) * per + li;
  if (i >= nM * nN) return false;
  const int panel = i / (8 * nN), within = i - panel * 8 * nN;
  const int rows = (nM - panel * 8) < 8 ? (nM - panel * 8) : 8;
  tn = within / rows;
  tm = panel * 8 + (within - tn * rows);
  return true;
}

DI void tr_tile(const float* __restrict__ W, int ldw, int nsrc0, u16* __restrict__ Wt, int K, int k0, int n0, float* tile, const float* gs = nullptr) {
  const int tid = threadIdx.x;
  const int n = tid & 63, kq = tid >> 6;
  __syncthreads();
#pragma unroll
  for (int i = 0; i < 16; ++i) { int kk = kq + 4 * i; tile[kk * 65 + n] = W[(size_t)(k0 + kk) * ldw + nsrc0 + n] * (gs ? gs[k0 + kk] : 1.f); }
  __syncthreads();
  const int nn = tid >> 2, ks = (tid & 3) * 16;
  unsigned o[8];
#pragma unroll
  for (int i = 0; i < 8; ++i) o[i] = pack2(tile[(ks + 2 * i) * 65 + nn], tile[(ks + 2 * i + 1) * 65 + nn]);
  u16* d = Wt + (size_t)(n0 + nn) * K + k0 + ks;
  *(uint4*)d = make_uint4(o[0], o[1], o[2], o[3]);
  *(uint4*)(d + 8) = make_uint4(o[4], o[5], o[6], o[7]);
}

DI void phase0(const Params& p, char* smem) {
  const int tid = threadIdx.x, lane = tid & 63, w = tid >> 6;
  const size_t gtid = (size_t)blockIdx.x * 256 + tid, gsz = (size_t)gridDim.x * 256;
  {
    const float* eu = p.expert_u;
    const float* ev = p.expert_v;
    unsigned char* e8 = p.E8;
    float* rsp = p.rs;
    const float* gfn = p.g_ffn;
    const int sub = lane & 15, rq = lane >> 4;
    for (int er0 = (blockIdx.x * 4 + w) * 4; er0 < 32768; er0 += gridDim.x * 16) {
      const int er = er0 + rq;
      const float* src = (er < 16384) ? (eu + (size_t)er * 1024) : (ev + (size_t)(er - 16384) * 1024);
      float4 v[16];
      float am = 0.f;
#pragma unroll
      for (int i = 0; i < 16; ++i) {
        v[i] = *(const float4*)&src[(i >> 2) * 256 + sub * 16 + (i & 3) * 4];
        if (er < 16384) {
          const float4 gq = *(const float4*)&gfn[(i >> 2) * 256 + sub * 16 + (i & 3) * 4];
          v[i].x *= gq.x; v[i].y *= gq.y; v[i].z *= gq.z; v[i].w *= gq.w;
        }
        am = fmaxf(am, fmaxf(fmaxf(fabsf(v[i].x), fabsf(v[i].y)), fmaxf(fabsf(v[i].z), fabsf(v[i].w))));
      }
      am = fmaxf(am, __shfl_xor(am, 1)); am = fmaxf(am, __shfl_xor(am, 2));
      am = fmaxf(am, __shfl_xor(am, 4)); am = fmaxf(am, __shfl_xor(am, 8));
      const float sc = (am > 0.f) ? 224.f / am : 1.f;
#pragma unroll
      for (int c = 0; c < 4; ++c) {
        int o[4];
#pragma unroll
        for (int i = 0; i < 4; ++i) {
          const float4 t4 = v[c * 4 + i];
          int t = __builtin_amdgcn_cvt_pk_fp8_f32(t4.x * sc, t4.y * sc, 0, false);
          o[i] = __builtin_amdgcn_cvt_pk_fp8_f32(t4.z * sc, t4.w * sc, t, true);
        }
        *(uint4*)&e8[(size_t)er * 1024 + c * 256 + sub * 16] = make_uint4((unsigned)o[0], (unsigned)o[1], (unsigned)o[2], (unsigned)o[3]);
      }
      if (sub == 0) rsp[er] = (am > 0.f) ? am * (1.f / 224.f) : 1.f;
    }
  }
  for (size_t i = gtid; i < 262144 / 8; i += gsz) cvt8(p.sub_keys + i * 8, p.subkb + i * 8);
  for (size_t i = gtid; i < MT; i += gsz) { p.ssq1[i] = 0.f; p.ssq2[i] = 0.f; }
  float* wl = (float*)smem;
  __syncthreads();
  for (int i = tid; i < 2048; i += 256) {
    const int k = i >> 1, hf = i & 1;
    float4 t = *(const float4*)&p.w_in[(size_t)k * 4360 + 1536 + hf * 4];
    wl[(hf * 4 + 0) * 1024 + k] = t.x; wl[(hf * 4 + 1) * 1024 + k] = t.y; wl[(hf * 4 + 2) * 1024 + k] = t.z; wl[(hf * 4 + 3) * 1024 + k] = t.w;
  }
  __syncthreads();
  const float* xpp = p.x_prompt;
  const float* xsp = p.x_sample;
  const float* mpp = p.mem_prompt;
  const float* gmx = p.g_mix;
  const float* gmk = p.g_memkv;
  u16* a0p = p.A0;
  u16* amp = p.Amem;
  {
    const int sub = lane & 15, rq = lane >> 4;
    for (int row0 = (blockIdx.x * 4 + w) * 4; row0 < MT + 1024; row0 += gridDim.x * 16) {
      const int row = row0 + rq;
      const float* src; const float* g; u16* dst;
      if (row < MP) { src = xpp + (size_t)row * 1024; g = gmx; dst = a0p + (size_t)row * 1024; }
      else if (row < MT) { src = xsp + (size_t)(row - MP) * 1024; g = gmx; dst = a0p + (size_t)row * 1024; }
      else { src = mpp + (size_t)(row - MT) * 1024; g = gmk; dst = amp + (size_t)(row - MT) * 1024; }
      float4 v[16];
      float ss = 0.f;
#pragma unroll
      for (int i = 0; i < 16; ++i) { v[i] = *(const float4*)&src[i * 64 + sub * 4]; ss += v[i].x * v[i].x + v[i].y * v[i].y + v[i].z * v[i].z + v[i].w * v[i].w; }
      ss += __shfl_xor(ss, 1); ss += __shfl_xor(ss, 2); ss += __shfl_xor(ss, 4); ss += __shfl_xor(ss, 8);
      const float rs = rsqrtf(ss * (1.f / 1024.f) + EPS);
      float d8[8] = {0.f, 0.f, 0.f, 0.f, 0.f, 0.f, 0.f, 0.f};
#pragma unroll
      for (int i = 0; i < 16; ++i) {
        float4 g4 = *(const float4*)&g[i * 64 + sub * 4];
        float y[4] = {v[i].x * rs * g4.x, v[i].y * rs * g4.y, v[i].z * rs * g4.z, v[i].w * rs * g4.w};
        uint2 o; o.x = pack2(y[0], y[1]); o.y = pack2(y[2], y[3]);
        *(uint2*)&dst[i * 64 + sub * 4] = o;
        if (row < MT) {
#pragma unroll
          for (int j = 0; j < 8; ++j) {
            float4 wv = *(const float4*)&wl[j * 1024 + i * 64 + sub * 4];
            d8[j] += y[0] * wv.x + y[1] * wv.y + y[2] * wv.z + y[3] * wv.w;
          }
        }
      }
      if (row < MT) {
#pragma unroll
        for (int j = 0; j < 8; ++j) {
          d8[j] += __shfl_xor(d8[j], 1); d8[j] += __shfl_xor(d8[j], 2); d8[j] += __shfl_xor(d8[j], 4); d8[j] += __shfl_xor(d8[j], 8);
        }
        if (sub < 4) {
          float ag = sel4(sub, d8[0], d8[1], d8[2], d8[3]);
          float bg = sel4(sub, d8[4], d8[5], d8[6], d8[7]);
          float xs = ag + p.dt_bias[sub];
          float sp = (xs > 20.f) ? xs : log1pf(expf(xs));
          p.gb[(size_t)row * 8 + sub] = -expf(p.a_log[sub]) * sp;
          p.gb[(size_t)row * 8 + 4 + sub] = 1.f / (1.f + expf(-bg));
        }
      }
    }
  }
  __syncthreads();
  float* tile = (float*)smem;
  for (int j = blockIdx.x; j < 2816; j += gridDim.x) {
    int t = j;
    if (t < 1088) { int kt = t / 68, nt = t % 68; int n0 = nt * 64; tr_tile(p.w_in, 4360, n0 + (n0 >= 1536 ? 8 : 0), p.WtIn, 1024, kt * 64, n0, tile); continue; }
    t -= 1088;
    if (t < 192) { int kt = t / 16, nt = t % 16; tr_tile(p.w_out, 1024, nt * 64, p.WtOut, 768, kt * 64, nt * 64, tile); continue; }
    t -= 192;
    if (t < 256) { int kt = t / 16, nt = t % 16; tr_tile(p.w_mq, 1024, nt * 64, p.WtMq, 1024, kt * 64, nt * 64, tile, p.g_memq); continue; }
    t -= 256;
    if (t < 512) { int kt = t / 32, nt = t % 32; tr_tile(p.w_mkv, 2048, nt * 64, p.WtMkv, 1024, kt * 64, nt * 64, tile); continue; }
    t -= 512;
    if (t < 256) { int kt = t / 16, nt = t % 16; tr_tile(p.w_mo, 1024, nt * 64, p.WtMo, 1024, kt * 64, nt * 64, tile); continue; }
    t -= 256;
    { int kt = t / 32, nt = t % 32; tr_tile(p.w_pq, 2048, nt * 64, p.WtPq, 1024, kt * 64, nt * 64, tile, p.g_ffn); }
  }
}

DI void dn_prep(const Params& p, int item, char* smem) {
  u16* qs = (u16*)smem;
  u16* ksm = qs + 64 * 136;
  float* sL = (float*)(ksm + 64 * 136);
  float* sgc = sL + 64 * 64;
  float* sbeta = sgc + 64;
  u16* sU = (u16*)sL;
  u16* sW = qs;
  const int tid = threadIdx.x, lane = tid & 63, w = tid >> 6, r = lane & 15, kg = lane >> 4;
  const int bh = item >> 7, n = item & 127, b = bh >> 2, h = bh & 3;
  const int t0 = n * 64;
  const size_t rowbase = (size_t)b * SEQ;
  char* ops = p.dnops + (size_t)item * DN_ITEM;
  __syncthreads();
  if (tid < 64) {
    float gv = p.gb[(rowbase + t0 + tid) * 8 + h];
    float bv = p.gb[(rowbase + t0 + tid) * 8 + 4 + h];
#pragma unroll
    for (int o = 1; o < 64; o <<= 1) { float t = __shfl_up(gv, o); if (lane >= o) gv += t; }
    sgc[tid] = gv; sbeta[tid] = bv;
    if (tid == 63) p.dl[item] = __expf(gv);
  }
#pragma unroll 4
  for (int ps = 0; ps < 8; ++ps) {
    const int combo = ps * 16 + (tid >> 4);
    const int tt = combo & 63, part = combo >> 6, sub = tid & 15;
    const int col = part * 512 + h * 128 + sub * 8;
    float y[8] = {0.f, 0.f, 0.f, 0.f, 0.f, 0.f, 0.f, 0.f};
#pragma unroll
    for (int j = 0; j < 4; ++j) {
      const int t = t0 + tt - 3 + j;
      if (t >= 0) {
        uint4 xv = *(const uint4*)&p.proj[(rowbase + t) * NP + col];
        float4 wa = *(const float4*)&p.conv_w[j * 1536 + col], wb = *(const float4*)&p.conv_w[j * 1536 + col + 4];
        y[0] += bflo(xv.x) * wa.x; y[1] += bfhi(xv.x) * wa.y; y[2] += bflo(xv.y) * wa.z; y[3] += bfhi(xv.y) * wa.w;
        y[4] += bflo(xv.z) * wb.x; y[5] += bfhi(xv.z) * wb.y; y[6] += bflo(xv.w) * wb.z; y[7] += bfhi(xv.w) * wb.w;
      }
    }
    float ss = 0.f;
#pragma unroll
    for (int e = 0; e < 8; ++e) { y[e] = siluf(y[e]); ss += y[e] * y[e]; }
    ss += __shfl_xor(ss, 1); ss += __shfl_xor(ss, 2); ss += __shfl_xor(ss, 4); ss += __shfl_xor(ss, 8);
    float sc = rsqrtf(ss + EPS) * (part == 0 ? 0.08838834764831845f : 1.f);
    uint4 o; o.x = pack2(y[0] * sc, y[1] * sc); o.y = pack2(y[2] * sc, y[3] * sc); o.z = pack2(y[4] * sc, y[5] * sc); o.w = pack2(y[6] * sc, y[7] * sc);
    *(uint4*)&((part == 0 ? qs : ksm)[tt * 136 + sub * 8]) = o;
  }
  __syncthreads();
  const float gcl = sgc[63];
  {
    f32x4 aL[4], aA[4];
#pragma unroll
    for (int i = 0; i < 4; ++i) { aL[i] = (f32x4){0.f, 0.f, 0.f, 0.f}; aA[i] = (f32x4){0.f, 0.f, 0.f, 0.f}; }
#pragma unroll
    for (int ks = 0; ks < 4; ++ks) {
      bf16x8 kI = *(const bf16x8*)&ksm[(w * 16 + r) * 136 + ks * 32 + kg * 8];
      bf16x8 qI = *(const bf16x8*)&qs[(w * 16 + r) * 136 + ks * 32 + kg * 8];
#pragma unroll
      for (int nt = 0; nt < 4; ++nt) {
        bf16x8 kJ = *(const bf16x8*)&ksm[(nt * 16 + r) * 136 + ks * 32 + kg * 8];
        aL[nt] = MFMA(kJ, kI, aL[nt]);
        aA[nt] = MFMA(kJ, qI, aA[nt]);
      }
    }
    const int i = w * 16 + r;
    const float gci = sgc[i], bi = sbeta[i];
    u16* aq = (u16*)(ops + 49152);
#pragma unroll
    for (int nt = 0; nt < 4; ++nt) {
      float lv[4], av[4];
#pragma unroll
      for (int jj = 0; jj < 4; ++jj) {
        const int j = nt * 16 + kg * 4 + jj;
        const float gam = (i >= j) ? __expf(gci - sgc[j]) : 0.f;
        lv[jj] = (i > j) ? aL[nt][jj] * bi * gam : 0.f;
        av[jj] = aA[nt][jj] * gam;
      }
      *(float4*)&sL[i * 64 + nt * 16 + kg * 4] = make_float4(lv[0], lv[1], lv[2], lv[3]);
      uint2 o; o.x = pack2(av[0], av[1]); o.y = pack2(av[2], av[3]);
      *(uint2*)&aq[((w * 2 + (nt >> 1)) * 64 + lane) * 8 + (nt & 1) * 4] = o;
    }
  }
  {
    u16* qg = (u16*)(ops + 16384);
    u16* kdT = (u16*)(ops + 32768);
#pragma unroll 1
    for (int i = 0; i < 4; ++i) {
      const int f = tid + 256 * i;
      const int mtks = f >> 6, l = f & 63, rr = l & 15, kgg = l >> 4;
      {
        const int mt = mtks >> 2, ks = mtks & 3, row = mt * 16 + rr;
        const float e = __expf(sgc[row]);
        uint2 a = *(const uint2*)&qs[row * 136 + ks * 32 + kgg * 4];
        uint2 c = *(const uint2*)&qs[row * 136 + ks * 32 + 16 + kgg * 4];
        uint4 o;
        o.x = pack2(bflo(a.x) * e, bfhi(a.x) * e); o.y = pack2(bflo(a.y) * e, bfhi(a.y) * e);
        o.z = pack2(bflo(c.x) * e, bfhi(c.x) * e); o.w = pack2(bflo(c.y) * e, bfhi(c.y) * e);
        *(uint4*)&qg[(size_t)f * 8] = o;
      }
      {
        const int mt = mtks >> 1, ks = mtks & 1, kdim = mt * 16 + rr;
        float v[8];
#pragma unroll
        for (int j = 0; j < 8; ++j) {
          const int c = ks * 32 + permk(kgg, j);
          v[j] = bf2f(ksm[c * 136 + kdim]) * __expf(gcl - sgc[c]);
        }
        uint4 o; o.x = pack2(v[0], v[1]); o.y = pack2(v[2], v[3]); o.z = pack2(v[4], v[5]); o.w = pack2(v[6], v[7]);
        *(uint4*)&kdT[(size_t)f * 8] = o;
      }
    }
  }
  __syncthreads();
  float x[64];
  if (tid < 128) {
    const int col = 1024 + h * 128 + tid;
    const float w0 = p.conv_w[col], w1 = p.conv_w[1536 + col], w2 = p.conv_w[3072 + col], w3 = p.conv_w[4608 + col];
    float xm3 = 0.f, xm2 = 0.f, xm1 = 0.f;
    if (t0 > 0) {
      xm3 = bf2f(p.proj[(rowbase + t0 - 3) * NP + col]);
      xm2 = bf2f(p.proj[(rowbase + t0 - 2) * NP + col]);
      xm1 = bf2f(p.proj[(rowbase + t0 - 1) * NP + col]);
    }
#pragma unroll
    for (int t = 0; t < 64; ++t) {
      float xc = bf2f(p.proj[(rowbase + t0 + t) * NP + col]);
      float yv = w0 * xm3 + w1 * xm2 + w2 * xm1 + w3 * xc;
      x[t] = siluf(yv) * sbeta[t];
      xm3 = xm2; xm2 = xm1; xm1 = xc;
    }
  } else {
    const int kc = tid - 128;
#pragma unroll
    for (int t = 0; t < 64; ++t) x[t] = bf2f(ksm[t * 136 + kc]) * sbeta[t] * __expf(sgc[t]);
  }
  {
    f32x4 Lr[16];
#pragma unroll
    for (int i = 1; i < 64; ++i) {
#pragma unroll
      for (int j4 = 0; j4 < (i + 3) / 4; ++j4) Lr[j4] = *(const f32x4*)&sL[i * 64 + j4 * 4];
      __builtin_amdgcn_sched_barrier(0);
      float s0 = x[i], s1 = 0.f, s2 = 0.f, s3 = 0.f;
#pragma unroll
      for (int j4 = 0; j4 < (i + 3) / 4; ++j4) {
        const f32x4 l = Lr[j4];
        s0 -= l[0] * x[j4 * 4];
        if (j4 * 4 + 1 < i) s1 -= l[1] * x[j4 * 4 + 1];
        if (j4 * 4 + 2 < i) s2 -= l[2] * x[j4 * 4 + 2];
        if (j4 * 4 + 3 < i) s3 -= l[3] * x[j4 * 4 + 3];
      }
      x[i] = (s0 + s1) + (s2 + s3);
      __builtin_amdgcn_sched_barrier(0);
    }
  }
  __syncthreads();
  if (tid < 128) {
#pragma unroll
    for (int t = 0; t < 64; ++t) sU[t * 128 + tid] = f2bf(x[t]);
  } else {
    const int kc = tid - 128;
#pragma unroll
    for (int t = 0; t < 64; ++t) sW[t * 136 + kc] = f2bf(-x[t]);
  }
  __syncthreads();
  {
    u16* nW = (u16*)ops;
    u16* u0 = (u16*)(ops + 57344);
#pragma unroll 1
    for (int i = 0; i < 4; ++i) {
      const int f = tid + 256 * i;
      const int mtks = f >> 6, l = f & 63, rr = l & 15, kgg = l >> 4;
      const int mt = mtks >> 2, ks = mtks & 3, row = mt * 16 + rr;
      uint2 a = *(const uint2*)&sW[row * 136 + ks * 32 + kgg * 4];
      uint2 c = *(const uint2*)&sW[row * 136 + ks * 32 + 16 + kgg * 4];
      *(uint4*)&nW[(size_t)f * 8] = make_uint4(a.x, a.y, c.x, c.y);
    }
#pragma unroll 1
    for (int i = 0; i < 8; ++i) {
      const int f = tid + 256 * i;
      const int smt = f >> 6, l = f & 63, rr = l & 15, kgg = l >> 4;
      const int s = smt >> 2, mt = smt & 3;
      u16 v0 = sU[(mt * 16 + kgg * 4 + 0) * 128 + s * 16 + rr];
      u16 v1 = sU[(mt * 16 + kgg * 4 + 1) * 128 + s * 16 + rr];
      u16 v2 = sU[(mt * 16 + kgg * 4 + 2) * 128 + s * 16 + rr];
      u16 v3 = sU[(mt * 16 + kgg * 4 + 3) * 128 + s * 16 + rr];
      *(uint2*)&u0[(size_t)f * 4] = make_uint2((unsigned)v0 | ((unsigned)v1 << 16), (unsigned)v2 | ((unsigned)v3 << 16));
    }
  }
}

DI void vt_tile(const Params& p, int item, char* smem) {
  u16* tile = (u16*)smem;
  const int tid = threadIdx.x;
  const int ptile = item & 127, gbh = item >> 7;
  const int h = gbh & 3, b = (gbh >> 2) & 3, g = gbh >> 4;
  const int dsh = g * 2, ln = SEQ >> dsh;
  const int pos0 = ptile * 64;
  const int rres = pos0 / ln, i0 = pos0 % ln;
  __syncthreads();
  {
    const int pr = tid >> 2, seg = (tid & 3) * 16;
    const int token = ((i0 + pr) << dsh) + rres;
    const u16* src = &p.proj[((size_t)b * SEQ + token) * NP + 2048 + g * 768 + 512 + h * 64 + seg];
    uint4 a = *(const uint4*)src, c = *(const uint4*)(src + 8);
    unsigned d[8] = {a.x, a.y, a.z, a.w, c.x, c.y, c.z, c.w};
#pragma unroll
    for (int e = 0; e < 8; ++e) *(unsigned*)&tile[pr * 66 + seg + e * 2] = d[e];
  }
  __syncthreads();
  {
    const int dh = tid >> 2, seg = (tid & 3) * 16;
    unsigned o[8];
#pragma unroll
    for (int e = 0; e < 8; ++e) o[e] = (unsigned)tile[(seg + 2 * e) * 66 + dh] | ((unsigned)tile[(seg + 2 * e + 1) * 66 + dh] << 16);
    u16* d = &p.vT[((size_t)gbh * 64 + dh) * SEQ + pos0 + seg];
    *(uint4*)d = make_uint4(o[0], o[1], o[2], o[3]);
    *(uint4*)(d + 8) = make_uint4(o[4], o[5], o[6], o[7]);
  }
}

DI void dn_sample(const Params& p, int item, char* smem) {
  float* sq = (float*)smem;
  float* sk = sq + 512;
  float* sv = sk + 512;
  float* red = sv + 512;
  const int tid = threadIdx.x, lane = tid & 63, w = tid >> 6;
  const int b = item >> 2, h = item & 3;
  __syncthreads();
  for (int c = tid; c < 384; c += 256) {
    const int part = c >> 7, cc = c & 127;
    const int col = part * 512 + h * 128 + cc;
    float xp[7];
#pragma unroll
    for (int j = 0; j < 3; ++j) xp[j] = p.state_conv[((size_t)b * 3 + j) * 1536 + col];
#pragma unroll
    for (int j = 0; j < 4; ++j) xp[3 + j] = bf2f(p.proj[((size_t)MP + b * 4 + j) * NP + col]);
    const float w0 = p.conv_w[col], w1 = p.conv_w[1536 + col], w2 = p.conv_w[3072 + col], w3 = p.conv_w[4608 + col];
    float* dst = part == 0 ? sq : (part == 1 ? sk : sv);
#pragma unroll
    for (int t = 0; t < 4; ++t) dst[t * 128 + cc] = siluf(w0 * xp[t] + w1 * xp[t + 1] + w2 * xp[t + 2] + w3 * xp[t + 3]);
  }
  __syncthreads();
  {
    float a0 = sq[w * 128 + lane], a1 = sq[w * 128 + 64 + lane];
    float s = wave_sum(a0 * a0 + a1 * a1);
    float sc = rsqrtf(s + EPS) * 0.08838834764831845f;
    sq[w * 128 + lane] = a0 * sc; sq[w * 128 + 64 + lane] = a1 * sc;
    float b0 = sk[w * 128 + lane], b1 = sk[w * 128 + 64 + lane];
    s = wave_sum(b0 * b0 + b1 * b1);
    sc = rsqrtf(s + EPS);
    sk[w * 128 + lane] = b0 * sc; sk[w * 128 + 64 + lane] = b1 * sc;
  }
  __syncthreads();
  const int v = tid & 127, half = tid >> 7;
  float S[64];
  const float* s0 = p.state_delta + (((size_t)b * 4 + h) * 128 + half * 64) * 128 + v;
#pragma unroll
  for (int i = 0; i < 64; ++i) S[i] = s0[(size_t)i * 128];
#pragma unroll 1
  for (int t = 0; t < 4; ++t) {
    const size_t row = (size_t)MP + b * 4 + t;
    const float a = __expf(p.gb[row * 8 + h]);
    const float beta = p.gb[row * 8 + 4 + h];
    float part = 0.f;
#pragma unroll
    for (int i = 0; i < 64; ++i) part += S[i] * sk[t * 128 + half * 64 + i];
    red[half * 128 + v] = part;
    __syncthreads();
    const float kS = red[v] + red[128 + v];
    const float u = beta * (sv[t * 128 + v] - a * kS);
    float po = 0.f;
#pragma unroll
    for (int i = 0; i < 64; ++i) { S[i] = a * S[i] + sk[t * 128 + half * 64 + i] * u; po += S[i] * sq[t * 128 + half * 64 + i]; }
    __syncthreads();
    red[half * 128 + v] = po;
    __syncthreads();
    if (half == 0) p.odn[row * 512 + h * 128 + v] = f2bf(red[v] + red[128 + v]);
    __syncthreads();
  }
  float* d = p.out + O_SDELTA + (((size_t)b * 4 + h) * 128 + half * 64) * 128 + v;
#pragma unroll
  for (int i = 0; i < 64; ++i) d[(size_t)i * 128] = S[i];
}

DI void phase2(const Params& p, char* smem) {
  const size_t gtid = (size_t)blockIdx.x * 256 + threadIdx.x, gsz = (size_t)gridDim.x * 256;
  for (int j = blockIdx.x; j < 2048 + 128 + 6144; j += gridDim.x) {
    if (j < 2048) { dn_prep(p, j, smem); if (DBL == 20) dn_prep(p, j, smem); }
    else if (j < 2048 + 128) dn_sample(p, j - 2048, smem);
    else { vt_tile(p, j - 2176, smem); if (DBL == 21) vt_tile(p, j - 2176, smem); }
  }
  for (size_t f = gtid; f < (size_t)16 * 8192; f += gsz) {
    {
      const size_t e0 = f * 8;
      const int bh = (int)(e0 >> 16), key = (int)((e0 >> 8) & 255), dh = (int)(e0 & 255);
      const int b = bh >> 2, h = bh & 3;
      cvt8(p.out + O_PMEM + (((size_t)b * 256 + key) * 2 + 0) * 1024 + h * 256 + dh, p.Kb + e0);
    }
    {
      const int l = (int)(f & 63), ks = (int)((f >> 6) & 7), nt = (int)((f >> 9) & 15), bh = (int)(f >> 13);
      const int b = bh >> 2, h = bh & 3, rr = l & 15, kgg = l >> 4;
      float v[8];
#pragma unroll
      for (int j = 0; j < 8; ++j) {
        const int key = ks * 32 + permk(kgg, j);
        v[j] = p.out[O_PMEM + (((size_t)b * 256 + key) * 2 + 1) * 1024 + h * 256 + nt * 16 + rr];
      }
      *(uint4*)&p.VTf[f * 8] = make_uint4(pack2(v[0], v[1]), pack2(v[2], v[3]), pack2(v[4], v[5]), pack2(v[6], v[7]));
    }
  }
  for (size_t i = gtid; i < 18432; i += gsz) {
    const int c = (int)(i % 1536), j = (int)((i / 1536) % 3), b = (int)(i / 4608);
    p.out[O_PCONV + i] = bf2f(p.proj[((size_t)b * SEQ + SEQ - 3 + j) * NP + c]);
  }
  for (int g = 0; g < 3; ++g) {
    const int W = 128 << (2 * g);
    const size_t off = (g == 0) ? O_PW1 : (g == 1 ? O_PW2 : O_PW3);
    const size_t n4 = (size_t)4 * W * 512 / 4;
    for (size_t i = gtid; i < n4; i += gsz) {
      const size_t e0 = i * 4;
      const int e = (int)(e0 & 511), ii = (int)((e0 >> 9) % W), b = (int)((e0 >> 9) / W);
      uint2 v = *(const uint2*)&p.proj[((size_t)b * SEQ + SEQ - W + ii) * NP + 2048 + g * 768 + 256 + e];
      *(float4*)&p.out[off + e0] = make_float4(bflo(v.x), bfhi(v.x), bflo(v.y), bfhi(v.y));
    }
  }
}

typedef __attribute__((ext_vector_type(2))) unsigned u32x2;
struct ScanOps { bf16x8 nW[4]; bf16x8 qg[4]; bf16x8 aq[2]; bf16x8 kd[4]; u32x2 u0; float dl; };

DI void scan_load(const Params& p, int bh, int s, int n, int j, int lane, ScanOps& o) {
  n = n > 127 ? 127 : n;
  const char AS1* base = (const char AS1*)p.dnops + (size_t)(bh * 128 + n) * DN_ITEM;
  gb8p negW = (gb8p)base;
  gb8p qg = (gb8p)(base + 16384);
  gb8p kdT = (gb8p)(base + 32768);
  gb8p aqk = (gb8p)(base + 49152);
  const u32x2 AS1* u0 = (const u32x2 AS1*)(base + 57344);
#pragma unroll
  for (int ks = 0; ks < 4; ++ks) o.nW[ks] = negW[(j * 4 + ks) * 64 + lane];
#pragma unroll
  for (int ks = 0; ks < 4; ++ks) o.qg[ks] = qg[(j * 4 + ks) * 64 + lane];
#pragma unroll
  for (int k2 = 0; k2 < 2; ++k2) o.aq[k2] = aqk[(j * 2 + k2) * 64 + lane];
#pragma unroll
  for (int mm = 0; mm < 2; ++mm)
#pragma unroll
    for (int k2 = 0; k2 < 2; ++k2) o.kd[mm * 2 + k2] = kdT[((2 * j + mm) * 2 + k2) * 64 + lane];
  o.u0 = u0[(s * 4 + j) * 64 + lane];
  o.dl = ((const float AS1*)p.dl)[bh * 128 + n];
}

DI void scan_step(const Params& p, const ScanOps& ops, int n, int b, int h, int s, int j, int lane, f32x4& S0, f32x4& S1,
                  bf16x8* sSb, u32x2* sUb) {
  const int r = lane & 15, kg = lane >> 4;
  bf16x8 sb[4];
#pragma unroll
  for (int ks = 0; ks < 4; ++ks) sb[ks] = sSb[ks * 64 + lane];
  f32x4 u = (f32x4){bflo(ops.u0[0]), bfhi(ops.u0[0]), bflo(ops.u0[1]), bfhi(ops.u0[1])};
#pragma unroll
  for (int ks = 0; ks < 4; ++ks) u = MFMA(ops.nW[ks], sb[ks], u);
  {
    u32x2 t; t[0] = pack2(u[0], u[1]); t[1] = pack2(u[2], u[3]);
    sUb[((j >> 1) * 64 + lane) * 2 + (j & 1)] = t;
  }
  __syncthreads();
  bf16x8 ub[2];
#pragma unroll
  for (int k2 = 0; k2 < 2; ++k2) ub[k2] = *(const bf16x8*)&sUb[(k2 * 64 + lane) * 2];
  f32x4 o = (f32x4){0.f, 0.f, 0.f, 0.f};
#pragma unroll
  for (int ks = 0; ks < 4; ++ks) o = MFMA(ops.qg[ks], sb[ks], o);
#pragma unroll
  for (int k2 = 0; k2 < 2; ++k2) o = MFMA(ops.aq[k2], ub[k2], o);
  S0 = S0 * ops.dl; S1 = S1 * ops.dl;
#pragma unroll
  for (int k2 = 0; k2 < 2; ++k2) { S0 = MFMA(ops.kd[k2], ub[k2], S0); S1 = MFMA(ops.kd[2 + k2], ub[k2], S1); }
  sSb[j * 64 + lane] = pack8(S0, S1);
#pragma unroll
  for (int jj = 0; jj < 4; ++jj) {
    const size_t token = (size_t)b * SEQ + n * 64 + j * 16 + kg * 4 + jj;
    G(p.odn)[token * 512 + h * 128 + s * 16 + r] = f2bf(o[jj]);
  }
  __syncthreads();
}

DI void dn_scan_block(const Params& p, int item, char* smem) {
  const int lane = threadIdx.x & 63, j = threadIdx.x >> 6, r = lane & 15, kg = lane >> 4;
  const int bh = item >> 3, s = item & 7, b = bh >> 2, h = bh & 3;
  bf16x8* sSb = (bf16x8*)smem;
  u32x2* sUb = (u32x2*)(smem + 4096);
  f32x4 S0 = (f32x4){0.f, 0.f, 0.f, 0.f}, S1 = (f32x4){0.f, 0.f, 0.f, 0.f};
  __syncthreads();
  sSb[j * 64 + lane] = pack8(S0, S1);
  ScanOps A, B;
  scan_load(p, bh, s, 0, j, lane, A);
  scan_load(p, bh, s, 1, j, lane, B);
  __syncthreads();
#pragma unroll 1
  for (int n0 = 0; n0 < 128; n0 += 2) {
    scan_step(p, A, n0, b, h, s, j, lane, S0, S1, sSb, sUb);
    scan_load(p, bh, s, n0 + 2, j, lane, A);
    scan_step(p, B, n0 + 1, b, h, s, j, lane, S0, S1, sSb, sUb);
    scan_load(p, bh, s, n0 + 3, j, lane, B);
  }
#pragma unroll
  for (int jj = 0; jj < 4; ++jj) {
    p.out[O_PDELTA + ((size_t)bh * 128 + 32 * j + kg * 4 + jj) * 128 + s * 16 + r] = S0[jj];
    p.out[O_PDELTA + ((size_t)bh * 128 + 32 * j + 16 + kg * 4 + jj) * 128 + s * 16 + r] = S1[jj];
  }
}

DI void sw_prompt_wave(const Params& p, int item) {
  const int lane = threadIdx.x & 63, r = lane & 15, kg = lane >> 4;
  const int qt = item & 511, gbh = item >> 9;
  const int h = gbh & 3, b = (gbh >> 2) & 3, g = gbh >> 4;
  const int dsh = 2 * g, ln = SEQ >> dsh;
  const int pos0 = qt * 16, rres = pos0 / ln, i0 = pos0 % ln;
  const int kbase = i0 - 144;
  const size_t rb = (size_t)b * SEQ;
  const int qoff = 2048 + g * 768 + h * 64, koff = qoff + 256;
  bf16x8 qf[2];
  {
    const size_t tok = rb + ((size_t)(i0 + r) << dsh) + rres;
#pragma unroll
    for (int ks = 0; ks < 2; ++ks) qf[ks] = *(const bf16x8*)&p.proj[tok * NP + qoff + ks * 32 + kg * 8];
  }
  f32x4 st[10];
#pragma unroll
  for (int mt = 0; mt < 10; ++mt) {
    int ki = kbase + mt * 16 + r; ki = ki < 0 ? 0 : ki;
    const size_t tok = rb + ((size_t)ki << dsh) + rres;
    f32x4 a = (f32x4){0.f, 0.f, 0.f, 0.f};
#pragma unroll
    for (int ks = 0; ks < 2; ++ks) {
      bf16x8 kf = *(const bf16x8*)&p.proj[tok * NP + koff + ks * 32 + kg * 8];
      a = MFMA(kf, qf[ks], a);
    }
    st[mt] = a;
  }
  const int qi = i0 + r;
  float mx = -3.0e38f;
#pragma unroll
  for (int mt = 0; mt < 10; ++mt)
#pragma unroll
    for (int j = 0; j < 4; ++j) {
      const int ki = kbase + mt * 16 + kg * 4 + j;
      const int d = qi - ki;
      const bool valid = (ki >= 0) && (d >= 0) && (d <= 128);
      const float sv = valid ? st[mt][j] * 0.125f : -3.0e38f;
      st[mt][j] = sv;
      mx = fmaxf(mx, sv);
    }
  mx = fmaxf(mx, __shfl_xor(mx, 16));
  mx = fmaxf(mx, __shfl_xor(mx, 32));
  float sum = 0.f;
#pragma unroll
  for (int mt = 0; mt < 10; ++mt)
#pragma unroll
    for (int j = 0; j < 4; ++j) {
      const float pv = (st[mt][j] > -1.0e38f) ? __expf(st[mt][j] - mx) : 0.f;
      st[mt][j] = pv;
      sum += pv;
    }
  sum += __shfl_xor(sum, 16);
  sum += __shfl_xor(sum, 32);
  const float inv = 1.f / sum;
  bf16x8 pf[5];
#pragma unroll
  for (int k2 = 0; k2 < 5; ++k2) pf[k2] = pack8(st[2 * k2], st[2 * k2 + 1]);
  const size_t qrow = rb + ((size_t)qi << dsh) + rres;
#pragma unroll
  for (int nt = 0; nt < 4; ++nt) {
    f32x4 o = (f32x4){0.f, 0.f, 0.f, 0.f};
    const u16* vrow = &p.vT[((size_t)gbh * 64 + nt * 16 + r) * SEQ + (size_t)rres * ln];
#pragma unroll
    for (int k2 = 0; k2 < 5; ++k2) {
      int ka = kbase + k2 * 32 + kg * 4, kc = ka + 16;
      ka = ka < 0 ? 0 : ka; kc = kc < 0 ? 0 : kc;
      uint2 va = *(const uint2*)&vrow[ka];
      uint2 vc = *(const uint2*)&vrow[kc];
      bf16x8 vf = __builtin_bit_cast(bf16x8, make_uint4(va.x, va.y, vc.x, vc.y));
      o = MFMA(vf, pf[k2], o);
    }
    uint2 ov; ov.x = pack2(o[0] * inv, o[1] * inv); ov.y = pack2(o[2] * inv, o[3] * inv);
    *(uint2*)&p.osw[((size_t)g * MT + qrow) * 256 + h * 64 + nt * 16 + kg * 4] = ov;
  }
  if (kg == 0) p.lse[((size_t)g * MT + qrow) * 4 + h] = mx + __logf(sum);
}

DI void sw_sample_wave(const Params& p, int item) {
  const int lane = threadIdx.x & 63;
  const int t = item & 3, h = (item >> 2) & 3, b = (item >> 4) & 31, g = item >> 9;
  const int dil = 1 << (2 * g), W = 128 << (2 * g);
  const float* c1 = p.cw1;
  const float* c2 = p.cw2;
  const float* c3 = p.cw3;
  const float* cache = (g == 0) ? c1 : (g == 1 ? c2 : c3);
  const int qoff = 2048 + g * 768 + h * 64;
  const size_t qrow = (size_t)MP + b * 4 + t;
  float q[64];
#pragma unroll
  for (int c = 0; c < 64; c += 8) {
    uint4 v = *(const uint4*)&p.proj[qrow * NP + qoff + c];
    q[c] = bflo(v.x); q[c + 1] = bfhi(v.x); q[c + 2] = bflo(v.y); q[c + 3] = bfhi(v.y);
    q[c + 4] = bflo(v.z); q[c + 5] = bfhi(v.z); q[c + 6] = bflo(v.w); q[c + 7] = bfhi(v.w);
  }
  float sc[3];
#pragma unroll
  for (int mi = 0; mi < 3; ++mi) {
    const int m = lane + 64 * mi;
    float s = -3.0e38f;
    if (m <= 128) {
      const int j = W + t - m * dil;
      float d = 0.f;
      if (j >= W) {
        const u16* kr = &p.proj[((size_t)MP + b * 4 + (j - W)) * NP + qoff + 256];
#pragma unroll
        for (int c = 0; c < 64; c += 8) {
          uint4 v = *(const uint4*)&kr[c];
          d += q[c] * bflo(v.x) + q[c + 1] * bfhi(v.x) + q[c + 2] * bflo(v.y) + q[c + 3] * bfhi(v.y) + q[c + 4] * bflo(v.z) +
               q[c + 5] * bfhi(v.z) + q[c + 6] * bflo(v.w) + q[c + 7] * bfhi(v.w);
        }
      } else {
        const float* kr = &cache[(((size_t)b * W + j) * 2 + 0) * 256 + h * 64];
#pragma unroll
        for (int c = 0; c < 64; c += 4) {
          float4 v = *(const float4*)&kr[c];
          d += q[c] * v.x + q[c + 1] * v.y + q[c + 2] * v.z + q[c + 3] * v.w;
        }
      }
      s = d * 0.125f;
    }
    sc[mi] = s;
  }
  float mx = wave_max(fmaxf(fmaxf(sc[0], sc[1]), sc[2]));
  float sum = 0.f;
#pragma unroll
  for (int mi = 0; mi < 3; ++mi) { sc[mi] = (sc[mi] > -1.0e38f) ? __expf(sc[mi] - mx) : 0.f; sum += sc[mi]; }
  sum = wave_sum(sum);
  float o = 0.f;
#pragma unroll
  for (int mi = 0; mi < 3; ++mi) {
#pragma unroll 8
    for (int mm = 0; mm < 64; ++mm) {
      const int m = mi * 64 + mm;
      if (m <= 128) {
        const float pv = __shfl(sc[mi], mm);
        const int j = W + t - m * dil;
        float vv;
        if (j >= W) vv = bf2f(p.proj[((size_t)MP + b * 4 + (j - W)) * NP + qoff + 512 + lane]);
        else vv = cache[(((size_t)b * W + j) * 2 + 1) * 256 + h * 64 + lane];
        o += pv * vv;
      }
    }
  }
  p.osw[((size_t)g * MT + qrow) * 256 + h * 64 + lane] = f2bf(o / sum);
  if (lane == 0) p.lse[((size_t)g * MT + qrow) * 4 + h] = mx + __logf(sum);
}

DI void phase3(const Params& p, char* smem) {
  const int w = threadIdx.x >> 6;
  if (blockIdx.x < 128) {
    dn_scan_block(p, blockIdx.x, smem);
  } else {
    const int gw = (blockIdx.x - 128) * 4 + w, nw = (gridDim.x - 128) * 4;
    for (int it = gw; it < 24576 + 1536; it += nw) {
      if (it < 24576) sw_prompt_wave(p, it);
      else sw_sample_wave(p, it - 24576);
    }
  }
}

DI void phase4(const Params& p) {
  const int lane = threadIdx.x & 63, w = threadIdx.x >> 6;
  for (int row = blockIdx.x * 4 + w; row < MT; row += gridDim.x * 4) {
    u16* dst = p.Amix + (size_t)row * 768;
#pragma unroll
    for (int h = 0; h < 4; ++h) {
      unsigned ov = *(const unsigned*)&p.odn[(size_t)row * 512 + h * 128 + lane * 2];
      unsigned zv = *(const unsigned*)&p.proj[(size_t)row * NP + 1536 + h * 128 + lane * 2];
      float o0 = bflo(ov), o1 = bfhi(ov);
      float ss = wave_sum(o0 * o0 + o1 * o1);
      float rs = rsqrtf(ss * (1.f / 128.f) + EPS);
      float2 gn = *(const float2*)&p.g_onorm[lane * 2];
      float y0 = o0 * rs * gn.x * siluf(bflo(zv)), y1 = o1 * rs * gn.y * siluf(bfhi(zv));
      *(unsigned*)&dst[h * 128 + lane * 2] = pack2(y0, y1);
    }
    {
      const int h = lane >> 4;
      float l0 = p.lse[((size_t)0 * MT + row) * 4 + h], l1 = p.lse[((size_t)1 * MT + row) * 4 + h], l2 = p.lse[((size_t)2 * MT + row) * 4 + h];
      float m = fmaxf(l0, fmaxf(l1, l2));
      float e0 = __expf(l0 - m), e1 = __expf(l1 - m), e2 = __expf(l2 - m);
      float inv = 1.f / (e0 + e1 + e2);
      uint2 a = *(const uint2*)&p.osw[((size_t)0 * MT + row) * 256 + lane * 4];
      uint2 c = *(const uint2*)&p.osw[((size_t)1 * MT + row) * 256 + lane * 4];
      uint2 d = *(const uint2*)&p.osw[((size_t)2 * MT + row) * 256 + lane * 4];
      e0 *= inv; e1 *= inv; e2 *= inv;
      float y0 = e0 * bflo(a.x) + e1 * bflo(c.x) + e2 * bflo(d.x);
      float y1 = e0 * bfhi(a.x) + e1 * bfhi(c.x) + e2 * bfhi(d.x);
      float y2 = e0 * bflo(a.y) + e1 * bflo(c.y) + e2 * bflo(d.y);
      float y3 = e0 * bfhi(a.y) + e1 * bfhi(c.y) + e2 * bfhi(d.y);
      *(uint2*)&dst[512 + lane * 4] = make_uint2(pack2(y0, y1), pack2(y2, y3));
    }
  }
}

DI void sample_state_copy(const Params& p) {
  const size_t gtid = (size_t)blockIdx.x * 256 + threadIdx.x, gsz = (size_t)gridDim.x * 256;
  for (size_t i = gtid; i < 147456; i += gsz) {
    const int c = (int)(i % 1536), j = (int)((i / 1536) % 3), b = (int)(i / 4608);
    p.out[O_SCONV + i] = bf2f(p.proj[((size_t)MP + b * 4 + j + 1) * NP + c]);
  }
  const float* c1 = p.cw1;
  const float* c2 = p.cw2;
  const float* c3 = p.cw3;
  for (int g = 0; g < 3; ++g) {
    const int W = 128 << (2 * g);
    const float* cache = (g == 0) ? c1 : (g == 1 ? c2 : c3);
    const size_t off = (g == 0) ? O_SW1 : (g == 1 ? O_SW2 : O_SW3);
    const size_t n4 = (size_t)32 * W * 512 / 4;
#pragma unroll 4
    for (size_t i = gtid; i < n4; i += gsz) {
      const size_t e0 = i * 4;
      const int e = (int)(e0 & 511), ii = (int)((e0 >> 9) % W), b = (int)((e0 >> 9) / W);
      float4 o;
      if (ii < W - 4) o = *(const float4*)&cache[((size_t)b * W + ii + 4) * 512 + e];
      else {
        uint2 v = *(const uint2*)&p.proj[((size_t)MP + b * 4 + (ii - (W - 4))) * NP + 2048 + g * 768 + 256 + e];
        o = make_float4(bflo(v.x), bfhi(v.x), bflo(v.y), bfhi(v.y));
      }
      *(float4*)&p.out[off + e0] = o;
    }
  }
}

DI void mem_attn_prompt_block(const Params& p, int item, char* smem) {
  const int tid = threadIdx.x, lane = tid & 63, w = tid >> 6, r = lane & 15, kg = lane >> 4;
  const int h = item & 3, qb = item >> 2;
  const int row0 = qb * 64 + w * 16, b = (qb * 64) >> 13;
  const int bh = b * 4 + h;
  u16* sK = (u16*)smem;
  bf16x8 qf[8];
#pragma unroll
  for (int ks = 0; ks < 8; ++ks) qf[ks] = *(const bf16x8*)&G(p.qb)[(size_t)(row0 + r) * 1024 + h * 256 + ks * 32 + kg * 8];
  f32x4 st[16];
  const u16* kbp = G(p.Kb) + (size_t)bh * 65536;
#pragma unroll
  for (int c = 0; c < 4; ++c) {
    __syncthreads();
#pragma unroll
    for (int i2 = 0; i2 < 2; ++i2) {
#pragma unroll
      for (int i = i2 * 4; i < i2 * 4 + 4; ++i) {
        const int idx = tid + 256 * i, row = idx >> 5, seg = idx & 31;
        *(bf16x8*)&sK[row * 264 + seg * 8] = *(gb8p)((gu16p)kbp + (size_t)(c * 64 + row) * 256 + seg * 8);
      }
      __builtin_amdgcn_sched_barrier(0);
    }
    __syncthreads();
#pragma unroll
    for (int m4 = 0; m4 < 4; ++m4) {
      f32x4 a = (f32x4){0.f, 0.f, 0.f, 0.f};
#pragma unroll
      for (int ks = 0; ks < 8; ++ks) {
        bf16x8 kf = *(const bf16x8*)&sK[(m4 * 16 + r) * 264 + ks * 32 + kg * 8];
        a = MFMA(kf, qf[ks], a);
      }
      st[c * 4 + m4] = a;
      __builtin_amdgcn_sched_barrier(0);
    }
  }
  float mx = -3.0e38f;
#pragma unroll
  for (int mt = 0; mt < 16; ++mt)
#pragma unroll
    for (int j = 0; j < 4; ++j) { st[mt][j] *= 0.0625f; mx = fmaxf(mx, st[mt][j]); }
  mx = fmaxf(mx, __shfl_xor(mx, 16));
  mx = fmaxf(mx, __shfl_xor(mx, 32));
  float sum = 0.f;
#pragma unroll
  for (int mt = 0; mt < 16; ++mt)
#pragma unroll
    for (int j = 0; j < 4; ++j) { st[mt][j] = __expf(st[mt][j] - mx); sum += st[mt][j]; }
  sum += __shfl_xor(sum, 16);
  sum += __shfl_xor(sum, 32);
  const float inv = 1.f / sum;
  bf16x8 pf[8];
#pragma unroll
  for (int k2 = 0; k2 < 8; ++k2) pf[k2] = pack8(st[2 * k2], st[2 * k2 + 1]);
  const u16* vtp = G(p.VTf) + (size_t)bh * 65536;
#pragma unroll 1
  for (int c = 0; c < 4; ++c) {
    __syncthreads();
#pragma unroll
    for (int i = 0; i < 8; ++i) {
      const int idx = tid + 256 * i;
      *(bf16x8*)&sK[idx * 8] = *(gb8p)((gu16p)vtp + (size_t)c * 16384 + idx * 8);
    }
    __syncthreads();
#pragma unroll
    for (int n4 = 0; n4 < 4; ++n4) {
      f32x4 o = (f32x4){0.f, 0.f, 0.f, 0.f};
#pragma unroll
      for (int k2 = 0; k2 < 8; ++k2) o = MFMA(*(const bf16x8*)&sK[((n4 * 8 + k2) * 64 + lane) * 8], pf[k2], o);
      uint2 ov; ov.x = pack2(o[0] * inv, o[1] * inv); ov.y = pack2(o[2] * inv, o[3] * inv);
      *(uint2*)&G(p.attn)[(size_t)(row0 + r) * 1024 + h * 256 + (c * 4 + n4) * 16 + kg * 4] = ov;
      __builtin_amdgcn_sched_barrier(0);
    }
  }
}

DI void mem_attn_sample_wave(const Params& p, int item, float* lds) {
  const int lane = threadIdx.x & 63;
  const int b = item >> 2, h = item & 3;
  float* sq = lds;
#pragma unroll
  for (int t = 0; t < 4; ++t) {
    uint2 v = *(const uint2*)&p.qb[((size_t)MP + b * 4 + t) * 1024 + h * 256 + lane * 4];
    *(float4*)&sq[t * 256 + lane * 4] = make_float4(bflo(v.x), bfhi(v.x), bflo(v.y), bfhi(v.y));
  }
  __builtin_amdgcn_s_waitcnt(0);
  __builtin_amdgcn_wave_barrier();
  float sc[4][4];
#pragma unroll
  for (int mi = 0; mi < 4; ++mi) {
    const int m = lane + 64 * mi;
    const float* kr = &p.cache_mem[(((size_t)b * 256 + m) * 2 + 0) * 1024 + h * 256];
    float d0 = 0.f, d1 = 0.f, d2 = 0.f, d3 = 0.f;
#pragma unroll 2
    for (int c = 0; c < 256; c += 4) {
      float4 kv = *(const float4*)&kr[c];
      float4 q0 = *(const float4*)&sq[c], q1 = *(const float4*)&sq[256 + c], q2 = *(const float4*)&sq[512 + c], q3 = *(const float4*)&sq[768 + c];
      d0 += kv.x * q0.x + kv.y * q0.y + kv.z * q0.z + kv.w * q0.w;
      d1 += kv.x * q1.x + kv.y * q1.y + kv.z * q1.z + kv.w * q1.w;
      d2 += kv.x * q2.x + kv.y * q2.y + kv.z * q2.z + kv.w * q2.w;
      d3 += kv.x * q3.x + kv.y * q3.y + kv.z * q3.z + kv.w * q3.w;
    }
    sc[0][mi] = d0 * 0.0625f; sc[1][mi] = d1 * 0.0625f; sc[2][mi] = d2 * 0.0625f; sc[3][mi] = d3 * 0.0625f;
  }
  float inv[4];
  __builtin_amdgcn_wave_barrier();
#pragma unroll
  for (int t = 0; t < 4; ++t) {
    float mx = wave_max(fmaxf(fmaxf(sc[t][0], sc[t][1]), fmaxf(sc[t][2], sc[t][3])));
    float sum = 0.f;
#pragma unroll
    for (int mi = 0; mi < 4; ++mi) { sc[t][mi] = __expf(sc[t][mi] - mx); sum += sc[t][mi]; }
    sum = wave_sum(sum);
    inv[t] = 1.f / sum;
#pragma unroll
    for (int mi = 0; mi < 4; ++mi) sq[t * 256 + lane + 64 * mi] = sc[t][mi];
  }
  __builtin_amdgcn_s_waitcnt(0);
  __builtin_amdgcn_wave_barrier();
  float4 o[4];
#pragma unroll
  for (int t = 0; t < 4; ++t) o[t] = make_float4(0.f, 0.f, 0.f, 0.f);
#pragma unroll 4
  for (int m = 0; m < 256; ++m) {
    float4 vv = *(const float4*)&p.cache_mem[(((size_t)b * 256 + m) * 2 + 1) * 1024 + h * 256 + lane * 4];
#pragma unroll
    for (int t = 0; t < 4; ++t) {
      const float pv = sq[t * 256 + m];
      o[t].x += pv * vv.x; o[t].y += pv * vv.y; o[t].z += pv * vv.z; o[t].w += pv * vv.w;
    }
  }
#pragma unroll
  for (int t = 0; t < 4; ++t) {
    uint2 ov; ov.x = pack2(o[t].x * inv[t], o[t].y * inv[t]); ov.y = pack2(o[t].z * inv[t], o[t].w * inv[t]);
    *(uint2*)&p.attn[((size_t)MP + b * 4 + t) * 1024 + h * 256 + lane * 4] = ov;
  }
  __builtin_amdgcn_wave_barrier();
}

DI void phase7(const Params& p, char* smem) {
  const int w = threadIdx.x >> 6;
  float* lds = (float*)smem + w * 1280;
  for (int it = blockIdx.x; it < 32 + 2048; it += gridDim.x) {
    if (it < 32) { __syncthreads(); mem_attn_sample_wave(p, it * 4 + w, lds); }
    else mem_attn_prompt_block(p, it - 32, smem);
  }
}

DI void peer_topk_wave(const Params& p, int item, unsigned* lds  ) {
  const int lane = threadIdx.x & 63, r = lane & 15, kg = lane >> 4;
  const int h = item & 7, row0 = (item >> 3) * 16;
  unsigned win[2][16];
#pragma unroll
  for (int pp = 0; pp < 2; ++pp) {
    bf16x8 qf[4];
#pragma unroll
    for (int ks = 0; ks < 4; ++ks) qf[ks] = *(const bf16x8*)&p.pq[(size_t)(row0 + r) * 2048 + h * 256 + pp * 128 + ks * 32 + kg * 8];
    unsigned kk[32];
    const u16* sk = p.subkb + (size_t)(h * 2 + pp) * 16384;
#pragma unroll
    for (int mt = 0; mt < 8; ++mt) {
      f32x4 a = (f32x4){0.f, 0.f, 0.f, 0.f};
#pragma unroll
      for (int ks = 0; ks < 4; ++ks) {
        bf16x8 kf = *(const bf16x8*)&sk[(mt * 16 + r) * 128 + ks * 32 + kg * 8];
        a = MFMA(kf, qf[ks], a);
      }
#pragma unroll
      for (int j = 0; j < 4; ++j) kk[mt * 4 + j] = (ordf(a[j]) & ~127u) | (unsigned)(mt * 16 + kg * 4 + j);
    }
#pragma unroll
    for (int rr = 0; rr < 16; ++rr) {
      unsigned m = 0;
#pragma unroll
      for (int i = 0; i < 32; ++i) m = umax(m, kk[i]);
      m = umax(m, (unsigned)__shfl_xor((int)m, 16));
      m = umax(m, (unsigned)__shfl_xor((int)m, 32));
      win[pp][rr] = m;
#pragma unroll
      for (int i = 0; i < 32; ++i) kk[i] = (kk[i] == m) ? 0u : kk[i];
    }
  }
  float f0[16], f1[16];
#pragma unroll
  for (int i = 0; i < 16; ++i) { f0[i] = unordf(win[0][i] & ~127u); f1[i] = unordf(win[1][i] & ~127u); }
  unsigned cand[13];
#define CAND(s, a0, b0, a1, b1, a2, b2, a3, b3)                                                         \
  {                                                                                                     \
    float va = sel4(kg, f0[a0], f0[a1], f0[a2], f0[(a3) < 0 ? 0 : (a3)]);                                \
    float vb = sel4(kg, f1[b0], f1[b1], f1[b2], f1[(b3) < 0 ? 0 : (b3)]);                                \
    unsigned id = sel4(kg, (unsigned)((a0) * 16 + (b0)), (unsigned)((a1) * 16 + (b1)), (unsigned)((a2) * 16 + (b2)), (unsigned)(((a3) < 0 ? 0 : (a3)) * 16 + ((b3) < 0 ? 0 : (b3)))); \
    unsigned key = (ordf(va + vb) & ~255u) | id;                                                        \
    if ((a3) < 0) key = (kg == 3) ? 0u : key;                                                           \
    cand[s] = key;                                                                                      \
  }
  CAND(0, 0, 0, 0, 13, 2, 0, 6, 1)
  CAND(1, 0, 1, 0, 14, 2, 1, 7, 0)
  CAND(2, 0, 2, 0, 15, 2, 2, 7, 1)
  CAND(3, 0, 3, 1, 0, 2, 3, 8, 0)
  CAND(4, 0, 4, 1, 1, 2, 4, 9, 0)
  CAND(5, 0, 5, 1, 2, 3, 0, 10, 0)
  CAND(6, 0, 6, 1, 3, 3, 1, 11, 0)
  CAND(7, 0, 7, 1, 4, 3, 2, 12, 0)
  CAND(8, 0, 8, 1, 5, 3, 3, 13, 0)
  CAND(9, 0, 9, 1, 6, 4, 2, 14, 0)
  CAND(10, 0, 10, 1, 7, 5, 0, 15, 0)
  CAND(11, 0, 11, 4, 0, 5, 1, -1, -1)
  CAND(12, 0, 12, 4, 1, 6, 0, -1, -1)
#undef CAND
  unsigned w2[16];
#pragma unroll
  for (int rr = 0; rr < 16; ++rr) {
    unsigned m = 0;
#pragma unroll
    for (int i = 0; i < 13; ++i) m = umax(m, cand[i]);
    m = umax(m, (unsigned)__shfl_xor((int)m, 16));
    m = umax(m, (unsigned)__shfl_xor((int)m, 32));
    w2[rr] = m;
#pragma unroll
    for (int i = 0; i < 13; ++i) cand[i] = (cand[i] == m) ? 0u : cand[i];
  }
  if (kg == 0) {
#pragma unroll
    for (int i = 0; i < 16; ++i) { lds[r * 32 + i] = win[0][i] & 127u; lds[r * 32 + 16 + i] = win[1][i] & 127u; }
  }
  __builtin_amdgcn_s_waitcnt(0);
  __builtin_amdgcn_wave_barrier();
  const float cv0 = unordf(w2[0] & ~255u);
  float sum = 0.f;
#pragma unroll
  for (int rr = 0; rr < 16; ++rr) sum += __expf(unordf(w2[rr] & ~255u) - cv0);
  const float inv = 1.f / sum;
  const size_t ob = ((size_t)(row0 + r) * 8 + h) * 16;
#pragma unroll
  for (int q = 0; q < 4; ++q) {
    const unsigned wk = sel4(kg, w2[q], w2[4 + q], w2[8 + q], w2[12 + q]);
    const int a = (wk >> 4) & 15, bb = wk & 15;
    const int i1 = (int)lds[r * 32 + a], i2 = (int)lds[r * 32 + 16 + bb];
    p.eid[ob + kg * 4 + q] = i1 * 128 + i2;
    p.gate[ob + kg * 4 + q] = __expf(unordf(wk & ~255u) - cv0) * inv;
  }
  __builtin_amdgcn_wave_barrier();
}

typedef __attribute__((ext_vector_type(2))) float f32x2;
DI float dot16_fp8(u32x4 u, const float* x, float c) {
  const unsigned d[4] = {u[0], u[1], u[2], u[3]};
#pragma unroll
  for (int i = 0; i < 4; ++i) {
    f32x2 a = __builtin_amdgcn_cvt_pk_f32_fp8((int)d[i], false);
    f32x2 b = __builtin_amdgcn_cvt_pk_f32_fp8((int)d[i], true);
    c += a[0] * x[4 * i] + a[1] * x[4 * i + 1] + b[0] * x[4 * i + 2] + b[1] * x[4 * i + 3];
  }
  return c;
}
DI void axpy16_fp8(float* o, float w, u32x4 u) {
  const unsigned d[4] = {u[0], u[1], u[2], u[3]};
#pragma unroll
  for (int i = 0; i < 4; ++i) {
    f32x2 a = __builtin_amdgcn_cvt_pk_f32_fp8((int)d[i], false);
    f32x2 b = __builtin_amdgcn_cvt_pk_f32_fp8((int)d[i], true);
    o[4 * i] += w * a[0]; o[4 * i + 1] += w * a[1]; o[4 * i + 2] += w * b[0]; o[4 * i + 3] += w * b[1];
  }
}

DI void peer_expert_wave(const Params& p, int row) {
  const int lane = __builtin_amdgcn_mbcnt_hi(-1, __builtin_amdgcn_mbcnt_lo(-1, 0));
  float xf[16];
  {
    const uint4 x0 = *(const uint4*)&G(p.h2)[(size_t)row * 1024 + lane * 16];
    const uint4 x1 = *(const uint4*)&G(p.h2)[(size_t)row * 1024 + lane * 16 + 8];
    xf[0] = bflo(x0.x); xf[1] = bfhi(x0.x); xf[2] = bflo(x0.y); xf[3] = bfhi(x0.y);
    xf[4] = bflo(x0.z); xf[5] = bfhi(x0.z); xf[6] = bflo(x0.w); xf[7] = bfhi(x0.w);
    xf[8] = bflo(x1.x); xf[9] = bfhi(x1.x); xf[10] = bflo(x1.y); xf[11] = bfhi(x1.y);
    xf[12] = bflo(x1.z); xf[13] = bfhi(x1.z); xf[14] = bflo(x1.w); xf[15] = bfhi(x1.w);
  }
  const float r2 = rsqrtf(p.ssq2[row] * (1.f / 1024.f) + EPS);
  const unsigned char AS1* EU8 = (const unsigned char AS1*)p.E8;
  const unsigned char AS1* EV8 = (const unsigned char AS1*)p.E8 + (size_t)16384 * 1024;
  float out[16];
#pragma unroll
  for (int i = 0; i < 16; ++i) out[i] = 0.f;
#pragma unroll 1
  for (int bt = 0; bt < 2; ++bt) {
    const int eidv = G(p.eid)[(size_t)row * 128 + bt * 64 + lane];
    const float gv = G(p.gate)[(size_t)row * 128 + bt * 64 + lane];
    const float rsu = G(p.rs)[eidv], rsv = G(p.rs)[16384 + eidv];
    float part[64];
#pragma unroll
    for (int e = 0; e < 64; ++e) {
      const int id = __builtin_amdgcn_readlane(eidv, e);
      const u32x4 u = *(const u32x4 AS1*)(EU8 + (size_t)id * 1024 + lane * 16);
      part[e] = dot16_fp8(u, xf, 0.f);
    }
#pragma unroll
    for (int off = 32; off > 0; off >>= 1) {
      const bool up = (lane & off) != 0;
#pragma unroll
      for (int i = 0; i < off; ++i) {
        const float a = part[i], bq = part[i + off];
        const float send = up ? a : bq, keep = up ? bq : a;
        part[i] = keep + __shfl_xor(send, off);
      }
    }
    const float wv = gv * geluf(part[0] * r2 * rsu) * rsv;
#pragma unroll 8
    for (int e = 0; e < 64; ++e) {
      const int id = __builtin_amdgcn_readlane(eidv, e);
      const float we = __int_as_float(__builtin_amdgcn_readlane(__float_as_int(wv), e));
      const u32x4 v = *(const u32x4 AS1*)(EV8 + (size_t)id * 1024 + lane * 16);
      axpy16_fp8(out, we, v);
    }
  }
  const u16* hr = G(p.h2) + (size_t)row * 1024 + lane * 16;
  float hv[16];
  float ss = 0.f;
#pragma unroll
  for (int i = 0; i < 4; ++i) {
    const uint2 tv = *(const uint2*)&hr[i * 4];
    float4 t = make_float4(bflo(tv.x), bfhi(tv.x), bflo(tv.y), bfhi(tv.y));
    hv[4 * i] = t.x + out[4 * i]; hv[4 * i + 1] = t.y + out[4 * i + 1]; hv[4 * i + 2] = t.z + out[4 * i + 2]; hv[4 * i + 3] = t.w + out[4 * i + 3];
    ss += hv[4 * i] * hv[4 * i] + hv[4 * i + 1] * hv[4 * i + 1] + hv[4 * i + 2] * hv[4 * i + 2] + hv[4 * i + 3] * hv[4 * i + 3];
  }
  ss = wave_sum(ss);
  const float rsn = rsqrtf(ss * (1.f / 1024.f) + EPS);
  float* y = ((row < MP) ? (G(p.out) + O_YP + (size_t)row * 1024) : (G(p.out) + O_YS + (size_t)(row - MP) * 1024)) + lane * 16;
#pragma unroll
  for (int i = 0; i < 4; ++i) {
    float4 g4 = *(const float4*)&p.g_final[lane * 16 + i * 4];
    *(float4*)&y[i * 4] = make_float4(hv[4 * i] * rsn * g4.x, hv[4 * i + 1] * rsn * g4.y, hv[4 * i + 2] * rsn * g4.z, hv[4 * i + 3] * rsn * g4.w);
  }
}

DI void peer_u_wave(const Params& p, int row, float* wl  ) {
  const int lane = __builtin_amdgcn_mbcnt_hi(-1, __builtin_amdgcn_mbcnt_lo(-1, 0));
  float xf[16];
  {
    const u32x4 x0 = *(const u32x4 AS1*)((const u16 AS1*)p.h2 + (size_t)row * 1024 + lane * 16);
    const u32x4 x1 = *(const u32x4 AS1*)((const u16 AS1*)p.h2 + (size_t)row * 1024 + lane * 16 + 8);
    xf[0] = bflo(x0[0]); xf[1] = bfhi(x0[0]); xf[2] = bflo(x0[1]); xf[3] = bfhi(x0[1]);
    xf[4] = bflo(x0[2]); xf[5] = bfhi(x0[2]); xf[6] = bflo(x0[3]); xf[7] = bfhi(x0[3]);
    xf[8] = bflo(x1[0]); xf[9] = bfhi(x1[0]); xf[10] = bflo(x1[1]); xf[11] = bfhi(x1[1]);
    xf[12] = bflo(x1[2]); xf[13] = bfhi(x1[2]); xf[14] = bflo(x1[3]); xf[15] = bfhi(x1[3]);
  }
  const float r2 = rsqrtf(((const float AS1*)p.ssq2)[row] * (1.f / 1024.f) + EPS);
  const unsigned char AS1* EU8 = (const unsigned char AS1*)p.E8;
  const float AS1* rsp = (const float AS1*)p.rs;
#pragma unroll 1
  for (int bt = 0; bt < 2; ++bt) {
    const int eidv = ((const int AS1*)p.eid)[(size_t)row * 128 + bt * 64 + lane];
    const float gv = ((const float AS1*)p.gate)[(size_t)row * 128 + bt * 64 + lane];
    const float rsu = rsp[eidv], rsv = rsp[16384 + eidv];
    float part[64];
#pragma unroll
    for (int e = 0; e < 64; ++e) {
      const int id = __builtin_amdgcn_readlane(eidv, e);
      const u32x4 u = *(const u32x4 AS1*)(EU8 + (size_t)id * 1024 + lane * 16);
      part[e] = dot16_fp8(u, xf, 0.f);
    }
#pragma unroll
    for (int off = 32; off > 0; off >>= 1) {
      const bool up = (lane & off) != 0;
#pragma unroll
      for (int i = 0; i < off; ++i) {
        const float a = part[i], bq = part[i + off];
        const float send = up ? a : bq, keep = up ? bq : a;
        part[i] = keep + __shfl_xor(send, off);
      }
    }
    wl[bt * 64 + lane] = gv * geluf(part[0] * r2 * rsu) * rsv;
  }
}

DI void peer_v_group(const Params& p, int gw, int nw, int g, const float* wlw  ) {
  const int lane = __builtin_amdgcn_mbcnt_hi(-1, __builtin_amdgcn_mbcnt_lo(-1, 0));
  const unsigned char AS1* EV8 = (const unsigned char AS1*)p.E8 + (size_t)16384 * 1024;
  float out[4][16];
  int e0[4], e1[4];
  float w0[4], w1[4];
  bool valid[4];
#pragma unroll
  for (int ts = 0; ts < 4; ++ts) {
    const int k = g * 4 + ts;
    const int row = gw + k * nw;
    valid[ts] = row < MT;
#pragma unroll
    for (int i = 0; i < 16; ++i) out[ts][i] = 0.f;
    e0[ts] = 0x7fffffff; e1[ts] = 0x7fffffff; w0[ts] = 0.f; w1[ts] = 0.f;
    if (valid[ts]) {
      e0[ts] = ((const int AS1*)p.eid)[(size_t)row * 128 + lane];
      e1[ts] = ((const int AS1*)p.eid)[(size_t)row * 128 + 64 + lane];
      w0[ts] = wlw[k * 128 + lane];
      w1[ts] = wlw[k * 128 + 64 + lane];
    }
  }
#pragma unroll 1
  for (int r = 0; r < 8; ++r) {
#pragma unroll
    for (int ts = 0; ts < 4; ++ts) {
      unsigned long long m0 = __ballot((e0[ts] >> 11) == r);
      unsigned long long m1 = __ballot((e1[ts] >> 11) == r);
      while ((m0 | m1) != 0ull) {
        u32x4 v[8];
        float we[8];
#pragma unroll
        for (int k = 0; k < 8; ++k) {
          we[k] = 0.f;
          v[k] = (u32x4){0u, 0u, 0u, 0u};
          if ((m0 | m1) != 0ull) {
            int l, id;
            if (m0 != 0ull) {
              l = __builtin_ctzll(m0); m0 &= m0 - 1ull;
              id = __builtin_amdgcn_readlane(e0[ts], l);
              we[k] = __int_as_float(__builtin_amdgcn_readlane(__float_as_int(w0[ts]), l));
            } else {
              l = __builtin_ctzll(m1); m1 &= m1 - 1ull;
              id = __builtin_amdgcn_readlane(e1[ts], l);
              we[k] = __int_as_float(__builtin_amdgcn_readlane(__float_as_int(w1[ts]), l));
            }
            v[k] = *(const u32x4 AS1*)(EV8 + (size_t)id * 1024 + lane * 16);
          }
        }
#pragma unroll
        for (int k = 0; k < 8; ++k) axpy16_fp8(out[ts], we[k], v[k]);
      }
    }
  }
#pragma unroll
  for (int ts = 0; ts < 4; ++ts) {
    if (!valid[ts]) continue;
    const int row = gw + (g * 4 + ts) * nw;
    const u16 AS1* hr = (const u16 AS1*)p.h2 + (size_t)row * 1024 + lane * 16;
    float hv[16];
    float ss = 0.f;
#pragma unroll
    for (int i = 0; i < 4; ++i) {
      const u32x2 tv = *(const u32x2 AS1*)&hr[i * 4];
      f32x4 t = (f32x4){bflo(tv[0]), bfhi(tv[0]), bflo(tv[1]), bfhi(tv[1])};
      hv[4 * i] = t[0] + out[ts][4 * i]; hv[4 * i + 1] = t[1] + out[ts][4 * i + 1]; hv[4 * i + 2] = t[2] + out[ts][4 * i + 2]; hv[4 * i + 3] = t[3] + out[ts][4 * i + 3];
      ss += hv[4 * i] * hv[4 * i] + hv[4 * i + 1] * hv[4 * i + 1] + hv[4 * i + 2] * hv[4 * i + 2] + hv[4 * i + 3] * hv[4 * i + 3];
    }
    ss = wave_sum(ss);
    const float rsn = rsqrtf(ss * (1.f / 1024.f) + EPS);
    float AS1* y = ((row < MP) ? ((float AS1*)p.out + O_YP + (size_t)row * 1024) : ((float AS1*)p.out + O_YS + (size_t)(row - MP) * 1024)) + lane * 16;
#pragma unroll
    for (int i = 0; i < 4; ++i) {
      f32x4 g4 = *(const f32x4 AS1*)&((const float AS1*)p.g_final)[lane * 16 + i * 4];
      f32x4 o;
      o[0] = hv[4 * i] * rsn * g4[0]; o[1] = hv[4 * i + 1] * rsn * g4[1]; o[2] = hv[4 * i + 2] * rsn * g4[2]; o[3] = hv[4 * i + 3] * rsn * g4[3];
      *(f32x4 AS1*)&y[i * 4] = o;
    }
  }
}


#define XB_TMO      128
#define XB_XCNT(j)  (256  + 64 * (j))
#define XB_XSUB(j)  (1280 + 64 * (j))
#define XB_XGEN(j)  (2304 + 64 * (j))
#define XB_TOP      3328
#define XB_TOPGEN   3392
#define XCD_BAR_WORDS 3456
#define XB_SPIN_CAP (1u << 18)
#define LAS __attribute__((address_space(3)))
DI unsigned xb_ld(unsigned* q) { return __hip_atomic_load(q, __ATOMIC_RELAXED, __HIP_MEMORY_SCOPE_AGENT); }
DI unsigned xb_add(unsigned* q, unsigned v) { return __hip_atomic_fetch_add(q, v, __ATOMIC_RELAXED, __HIP_MEMORY_SCOPE_AGENT); }
DI unsigned xb_xcc_id() { return (unsigned)__builtin_amdgcn_s_getreg((3 << 11) | 20) & 0xFu; }
#define XB_SPIN(cond, bar) do { unsigned _sp = 0; while (cond) { __builtin_amdgcn_s_sleep(1); \
    if ((++_sp & 255u) == 0u) { if (xb_ld(&(bar)[XB_TMO])) break; if (_sp > XB_SPIN_CAP) { atomicAdd(&(bar)[XB_TMO], 1u); break; } } } } while (0)
struct XcdBarrier { unsigned* bar; unsigned x; volatile LAS unsigned* st; };
DI XcdBarrier xcd_barrier_post(unsigned* bar, volatile LAS unsigned* st) {
  XcdBarrier b; b.bar = bar; b.x = xb_xcc_id(); b.st = st;
  if (threadIdx.x == 0) (void)xb_add(&bar[XB_XCNT(b.x)], 1u);
  return b;
}
DI void xcd_barrier_complete(unsigned* bar, unsigned x, unsigned& nloc, unsigned& nx) {
  const unsigned G = gridDim.x * gridDim.y * gridDim.z;
  unsigned sum, cnt, mine, sp = 0u;
  for (;;) {
    sum = 0u; cnt = 0u; mine = 0u;
#pragma unroll
    for (unsigned j = 0; j < 16; ++j) { const unsigned c = xb_ld(&bar[XB_XCNT(j)]); sum += c; cnt += (c > 0u) ? 1u : 0u; mine = (j == x) ? c : mine; }
    if (sum == G) break;
    __builtin_amdgcn_s_sleep(1);
    if ((++sp & 255u) == 0u) { if (xb_ld(&bar[XB_TMO])) break; if (sp > XB_SPIN_CAP) { atomicAdd(&bar[XB_TMO], 1u); break; } }
  }
  nloc = mine > 0u ? mine : 1u; nx = cnt > 0u ? cnt : 1u;
}
DI void xcd_barrier(const XcdBarrier& b) {
  asm volatile("s_waitcnt vmcnt(0)" ::: "memory");
  __syncthreads();
  if (threadIdx.x == 0) {
    unsigned* bar = b.bar;
    __builtin_amdgcn_s_waitcnt(0);
    unsigned nloc = b.st[0], nx = b.st[1];
    if (nloc == 0u) { xcd_barrier_complete(bar, b.x, nloc, nx); b.st[0] = nloc; b.st[1] = nx; }
    const unsigned old = xb_add(&bar[XB_XSUB(b.x)], 1u);
    const unsigned gen = old / nloc;
    if (old + 1u == (gen + 1u) * nloc) {
      __builtin_amdgcn_fence(__ATOMIC_RELEASE, "agent");
      asm volatile("s_waitcnt vmcnt(0)" ::: "memory");
      const unsigned og = xb_add(&bar[XB_TOP], 1u);
      const unsigned tg = og / nx;
      if (og + 1u == (tg + 1u) * nx) xb_add(&bar[XB_TOPGEN], 1u);
      else XB_SPIN(xb_ld(&bar[XB_TOPGEN]) == tg, bar);
      __builtin_amdgcn_fence(__ATOMIC_ACQUIRE, "agent");
      xb_add(&bar[XB_XGEN(b.x)], 1u);
      asm volatile("s_waitcnt vmcnt(0)" ::: "memory");
    } else {
      XB_SPIN(xb_ld(&bar[XB_XGEN(b.x)]) == gen, bar);
      __builtin_amdgcn_fence(__ATOMIC_ACQUIRE, "agent");
      asm volatile("s_waitcnt vmcnt(0)" ::: "memory");
    }
  }
  __syncthreads();
}

__global__ void __launch_bounds__(256, 2) mega(Params pk) {
  __shared__ __attribute__((aligned(16))) char smem[65536];
  __shared__ Params sp;
  cg::grid_group grid = cg::this_grid();
  const int w = threadIdx.x >> 6;
  __shared__ uint4 xb_words;
  if (threadIdx.x == 0) { sp = pk; xb_words = make_uint4(0u, 0u, 0u, 0u); }
  __syncthreads();
  const Params& p = sp;
  XcdBarrier xb = xcd_barrier_post(p.bar, (volatile LAS unsigned*)&xb_words);
  if (p.never) grid.sync();
#define GSYNC() xcd_barrier(xb)
#define REP(ph) for (int rp_ = 0; rp_ < ((DBL == (ph)) ? 2 : 1); ++rp_)
  REP(0) { phase0(p, smem); if (DBL == 0) grid.sync(); }
  GSYNC();
  REP(1) {
    int tm, tn;
    for (int it = 0; it * (int)gridDim.x < 129 * 34; ++it)
      if (xcd_tile(it, 129, 34, tm, tn)) gemm_tile<0, 1024>(p, p.A0, 1024, p.WtIn, tm, tn, smem);
    for (int u = blockIdx.x; u < 64; u += gridDim.x) gemm_tile<1, 1024>(p, p.Amem, 1024, p.WtMkv, u / 16, u % 16, smem);
  }
  GSYNC();
  REP(2) { phase2(p, smem); if (DBL == 2) grid.sync(); }
  GSYNC();
  REP(3) { phase3(p, smem); if (DBL == 3) grid.sync(); }
  GSYNC();
  REP(4) phase4(p);
  GSYNC();
  { int tm, tn; for (int it = 0; it * (int)gridDim.x < 257 * 8; ++it) if (xcd_tile(it, 257, 8, tm, tn)) gemm_tile128<2, 768>(p, p.Amix, 768, p.WtOut, tm, tn, smem); }
  GSYNC();
  REP(6) { int tm, tn; for (int it = 0; it * (int)gridDim.x < 257 * 8; ++it) if (xcd_tile(it, 257, 8, tm, tn)) gemm_tile128<3, 1024>(p, p.h1, 1024, p.WtMq, tm, tn, smem); }
  sample_state_copy(p);
  GSYNC();
  REP(7) phase7(p, smem);
  GSYNC();
  { int tm, tn; for (int it = 0; it * (int)gridDim.x < 257 * 8; ++it) if (xcd_tile(it, 257, 8, tm, tn)) gemm_tile128<4, 1024>(p, p.attn, 1024, p.WtMo, tm, tn, smem); }
  GSYNC();
  REP(9) { int tm, tn; for (int it = 0; it * (int)gridDim.x < 129 * 16; ++it) if (xcd_tile(it, 129, 16, tm, tn)) gemm_tile<5, 1024>(p, p.h2, 1024, p.WtPq, tm, tn, smem); }
  GSYNC();
  REP(10) {
    unsigned* lds = (unsigned*)smem + w * 512;
    for (int it = blockIdx.x * 4 + w; it < 2056 * 8; it += gridDim.x * 4) peer_topk_wave(p, it, lds);
  }
  GSYNC();
  REP(11) {
    const int gw = blockIdx.x * 4 + w, nw = gridDim.x * 4;
    float* wlw = (float*)smem + w * (17 * 128);
    __syncthreads();
    for (int k = 0; gw + k * nw < MT && k < 17; ++k) peer_u_wave(p, gw + k * nw, wlw + k * 128);
    __builtin_amdgcn_s_waitcnt(0xc07f);
    __builtin_amdgcn_wave_barrier();
    for (int g = 0; (g * 4) * nw + gw < MT && g < 5; ++g) peer_v_group(p, gw, nw, g, wlw);
  }
}

extern "C" void kernel_launch(void* const* d_in, const int* in_sizes, int n_in, void* d_out, int out_size, void* d_ws, size_t ws_size,
                              hipStream_t stream) {
  static int grid_blocks = 0;
  if (!grid_blocks) {
    int dev = 0, cus = 0, per_cu = 0;
    (void)hipGetDevice(&dev);
    (void)hipDeviceGetAttribute(&cus, hipDeviceAttributeMultiprocessorCount, dev);
    (void)hipOccupancyMaxActiveBlocksPerMultiprocessor(&per_cu, mega, 256, 0);
    if (per_cu > 2) per_cu = 2;
    if (per_cu < 1) per_cu = 1;
    grid_blocks = cus * per_cu;
  }
  Params p{};
  const float* const* in = (const float* const*)d_in;
  p.x_prompt = in[0]; p.x_sample = in[1]; p.state_delta = in[2]; p.state_conv = in[3]; p.cw1 = in[4]; p.cw2 = in[5]; p.cw3 = in[6];
  p.cache_mem = in[7]; p.mem_prompt = in[8]; p.g_mix = in[9]; p.w_in = in[10]; p.conv_w = in[11]; p.a_log = in[12]; p.dt_bias = in[13];
  p.g_onorm = in[14]; p.w_out = in[15]; p.g_memq = in[16]; p.g_memkv = in[17]; p.w_mq = in[18]; p.w_mkv = in[19]; p.w_mo = in[20];
  p.g_ffn = in[21]; p.w_pq = in[22]; p.sub_keys = in[23]; p.expert_u = in[24]; p.expert_v = in[25]; p.g_final = in[26];
  p.out = (float*)d_out;
  char* ws = (char*)d_ws;
  size_t off = 0;
  auto take = [&](size_t bytes) { char* r = ws + off; off += (bytes + 255) & ~(size_t)255; return r; };
  p.WtIn = (u16*)take((size_t)NP * 1024 * 2);
  p.WtOut = (u16*)take((size_t)1024 * 768 * 2);
  p.WtMq = (u16*)take((size_t)1024 * 1024 * 2);
  p.WtMkv = (u16*)take((size_t)2048 * 1024 * 2);
  p.WtMo = (u16*)take((size_t)1024 * 1024 * 2);
  p.WtPq = (u16*)take((size_t)2048 * 1024 * 2);
  p.subkb = (u16*)take((size_t)262144 * 2);
  p.E8 = (unsigned char*)take((size_t)32768 * 1024);
  p.rs = (float*)take((size_t)32768 * 4);
  p.Amem = (u16*)take((size_t)1024 * 1024 * 2);
  p.gb = (float*)take((size_t)MT * 8 * 4);
  p.ssq1 = (float*)take((size_t)MT * 4);
  p.ssq2 = (float*)take((size_t)MT * 4);
  p.dl = (float*)take(2048 * 4);
  p.Kb = (u16*)take((size_t)16 * 65536 * 2);
  p.VTf = (u16*)take((size_t)16 * 65536 * 2);
  char* regA = take((size_t)MT * NP * 2);
  char* regB = take((size_t)2048 * DN_ITEM);
  p.proj = (u16*)regA;
  p.h1 = (u16*)regA;
  p.h2 = (u16*)(regA + (size_t)MT * 1024 * 4);
  p.pq = (u16*)regA;
  p.dnops = regB;
  p.A0 = (u16*)regB;
  p.A1 = (u16*)regB;
  p.qb = (u16*)(regB + (size_t)MT * 1024 * 2);
  p.attn = (u16*)regB;
  p.A2 = (u16*)(regB + (size_t)MT * 1024 * 2);
  p.eid = (int*)regB;
  p.gate = (float*)(regB + (size_t)MT * 128 * 4);
  char* ob = (char*)d_out;
  p.vT = (u16*)ob;
  p.osw = (u16*)(ob + (size_t)3 * MP * 256 * 2);
  p.lse = (float*)(ob + (size_t)3 * MP * 256 * 2 + (size_t)3 * MT * 256 * 2);
  char* sb = ob + O_SW3 * 4;
  p.odn = (u16*)sb;
  p.Amix = (u16*)(sb + (size_t)MT * 512 * 2);
  p.bar = (unsigned*)take((size_t)XCD_BAR_WORDS * 4);
  p.never = 0;
  p.pad_ = 0;
  if (off > ws_size) { fprintf(stderr, "workspace too small: need %zu have %zu\n", off, ws_size); return; }
  (void)hipMemsetAsync(p.bar, 0, (size_t)XCD_BAR_WORDS * 4, stream);
  void* args[] = {&p};
  hipError_t e = hipLaunchCooperativeKernel((void*)mega, dim3(grid_blocks), dim3(256), args, 0, stream);
  if (e != hipSuccess) fprintf(stderr, "coop launch failed: %s (grid %d)\n", hipGetErrorString(e), grid_blocks);
}
```

```cpp
#include <hip/hip_runtime.h>
#include <hip/hip_cooperative_groups.h>
#include <cstdio>
namespace cg = cooperative_groups;

typedef unsigned short u16;
typedef __attribute__((ext_vector_type(8))) short bf16x8;
typedef __attribute__((ext_vector_type(4))) float f32x4;
typedef __attribute__((ext_vector_type(2))) __bf16 bf2_t;

#define DI __device__ __forceinline__
#define MFMA(a, b, c) __builtin_amdgcn_mfma_f32_16x16x32_bf16((a), (b), (c), 0, 0, 0)

#ifndef DBL
#define DBL -1
#endif
constexpr int MP = 32768, MS = 128, MT = 32896;
constexpr int NP = 4352;
constexpr int SEQ = 8192;
constexpr float EPS = 1e-6f;
constexpr size_t DN_ITEM = 73728;

constexpr size_t O_YP = 0, O_YS = 33554432, O_PDELTA = 33685504, O_PCONV = 33947648, O_PW1 = 33966080,
                 O_PW2 = 34228224, O_PW3 = 35276800, O_PMEM = 39471104, O_SDELTA = 41568256, O_SCONV = 43665408,
                 O_SW1 = 43812864, O_SW2 = 45910016, O_SW3 = 54298624;

struct Params {
  const float *x_prompt, *x_sample, *state_delta, *state_conv, *cw1, *cw2, *cw3, *cache_mem, *mem_prompt;
  const float *g_mix, *w_in, *conv_w, *a_log, *dt_bias, *g_onorm, *w_out, *g_memq, *g_memkv, *w_mq, *w_mkv, *w_mo;
  const float *g_ffn, *w_pq, *sub_keys, *expert_u, *expert_v, *g_final;
  float* out;
  u16 *WtIn, *WtOut, *WtMq, *WtMkv, *WtMo, *WtPq, *subkb, *Amem;
  unsigned char* E8;
  float* rs;
  float *gb, *ssq1, *ssq2, *dl;
  u16 *Kb, *VTf;
  u16* proj;
  u16 *h1, *h2;
  u16* pq;
  char* dnops;
  u16 *A0, *A1, *qb, *attn, *A2;
  int* eid;
  float* gate;
  u16 *vT, *osw, *odn, *Amix;
  float* lse;
  unsigned* bar;
  int never;
  int pad_;
};

#define AS1 __attribute__((address_space(1)))
template <typename T> DI T* G(T* q) { return q; }
typedef const bf16x8 AS1* gb8p;
typedef const u16 AS1* gu16p;
typedef __attribute__((ext_vector_type(4))) unsigned u32x4;
DI u16 f2bf(float x) { unsigned u = __float_as_uint(x); u += 0x7fffu + ((u >> 16) & 1u); return (u16)(u >> 16); }
DI float bf2f(u16 h) { return __uint_as_float(((unsigned)h) << 16); }
DI unsigned pack2(float a, float b) { return (unsigned)f2bf(a) | ((unsigned)f2bf(b) << 16); }
DI float bflo(unsigned d) { return __uint_as_float(d << 16); }
DI float bfhi(unsigned d) { return __uint_as_float(d & 0xffff0000u); }
DI bf16x8 pack8(f32x4 a, f32x4 b) {
  uint4 r; r.x = pack2(a[0], a[1]); r.y = pack2(a[2], a[3]); r.z = pack2(b[0], b[1]); r.w = pack2(b[2], b[3]);
  return __builtin_bit_cast(bf16x8, r);
}
DI float wave_sum(float v) {
#pragma unroll
  for (int o = 32; o > 0; o >>= 1) v += __shfl_xor(v, o);
  return v;
}
DI float wave_max(float v) {
#pragma unroll
  for (int o = 32; o > 0; o >>= 1) v = fmaxf(v, __shfl_xor(v, o));
  return v;
}
DI float siluf(float x) { return x / (1.f + __expf(-x)); }
DI float geluf(float x) { return 0.5f * x * (1.f + tanhf(0.7978845608028654f * (x + 0.044715f * x * x * x))); }
DI int permk(int kg, int j) { return (j < 4) ? (kg * 4 + j) : (16 + kg * 4 + (j - 4)); }
DI void cvt8(const float* __restrict__ s, u16* __restrict__ d) {
  float4 a = *(const float4*)s, b = *(const float4*)(s + 4);
  uint4 r; r.x = pack2(a.x, a.y); r.y = pack2(a.z, a.w); r.z = pack2(b.x, b.y); r.w = pack2(b.z, b.w);
  *(uint4*)d = r;
}
DI unsigned ordf(float f) { unsigned u = __float_as_uint(f); return (u & 0x80000000u) ? ~u : (u | 0x80000000u); }
DI float unordf(unsigned k) { unsigned u = (k & 0x80000000u) ? (k & 0x7fffffffu) : ~k; return __uint_as_float(u); }
DI unsigned umax(unsigned a, unsigned b) { return a > b ? a : b; }
template <typename T> DI T sel4(int L, T a, T b, T c, T d) { return L == 0 ? a : (L == 1 ? b : (L == 2 ? c : d)); }

#define AS3 __attribute__((address_space(3)))
template <int MODE, int K>
DI void gemm_tile(const Params& p, const u16* __restrict__ A, int lda, const u16* __restrict__ Bt, int tm, int tn,
                          char* smem) {
  const int tid = threadIdx.x, lane = tid & 63, w = tid >> 6;
  const int wm = w >> 1, wn = w & 1, r = lane & 15, kg = lane >> 4;
  f32x4 acc[8][4];
#pragma unroll
  for (int i = 0; i < 8; ++i)
#pragma unroll
    for (int j = 0; j < 4; ++j) acc[i][j] = (f32x4){0.f, 0.f, 0.f, 0.f};
  const int lr = lane >> 2, lkg = (lane & 3) ^ (lane >> 4);
  gu16p gA[4], gB[2];
#pragma unroll
  for (int i = 0; i < 4; ++i) gA[i] = (gu16p)A + (size_t)(tm * 256 + (w * 4 + i) * 16 + lr) * lda + lkg * 8;
#pragma unroll
  for (int i = 0; i < 2; ++i) gB[i] = (gu16p)Bt + (size_t)(tn * 128 + (w * 2 + i) * 16 + lr) * K + lkg * 8;
  const int frag_off = r * 64 + ((kg ^ (r >> 2)) * 16);
  __syncthreads();
#pragma unroll
  for (int i = 0; i < 4; ++i)
    __builtin_amdgcn_global_load_lds((const unsigned AS1*)(gA[i]), (unsigned AS3*)(smem + (w * 4 + i) * 1024), 16, 0, 0);
#pragma unroll
  for (int i = 0; i < 2; ++i)
    __builtin_amdgcn_global_load_lds((const unsigned AS1*)(gB[i]), (unsigned AS3*)(smem + 16384 + (w * 2 + i) * 1024), 16, 0, 0);
#pragma unroll 2
  for (int k = 0; k < K / 32; ++k) {
    __syncthreads();
    if (k + 1 < K / 32) {
      char* st = smem + ((k + 1) & 1) * 24576;
#pragma unroll
      for (int i = 0; i < 4; ++i)
        __builtin_amdgcn_global_load_lds((const unsigned AS1*)(gA[i] + (k + 1) * 32), (unsigned AS3*)(st + (w * 4 + i) * 1024), 16, 0, 0);
#pragma unroll
      for (int i = 0; i < 2; ++i)
        __builtin_amdgcn_global_load_lds((const unsigned AS1*)(gB[i] + (k + 1) * 32), (unsigned AS3*)(st + 16384 + (w * 2 + i) * 1024), 16, 0, 0);
    }
    const char* sa = smem + (k & 1) * 24576;
    const char* sb = sa + 16384;
    bf16x8 af[8], bfr[4];
#pragma unroll
    for (int i = 0; i < 8; ++i) af[i] = *(const bf16x8*)(sa + (wm * 8 + i) * 1024 + frag_off);
#pragma unroll
    for (int i = 0; i < 4; ++i) bfr[i] = *(const bf16x8*)(sb + (wn * 4 + i) * 1024 + frag_off);
    __builtin_amdgcn_s_setprio(1);
#pragma unroll
    for (int mt = 0; mt < 8; ++mt)
#pragma unroll
      for (int nt = 0; nt < 4; ++nt) acc[mt][nt] = MFMA(bfr[nt], af[mt], acc[mt][nt]);
    __builtin_amdgcn_s_setprio(0);
  }
#pragma unroll
  for (int mt = 0; mt < 8; ++mt) {
    const int row = tm * 256 + wm * 128 + mt * 16 + r;
    if (tm * 256 + wm * 128 + mt * 16 >= ((MODE == 1) ? 1024 : MT)) continue;
    float rs = 1.f, ssq = 0.f;
    if (MODE == 3) rs = rsqrtf(p.ssq1[row] * (1.f / 1024.f) + EPS);
    if (MODE == 5) rs = rsqrtf(p.ssq2[row] * (1.f / 1024.f) + EPS);
#pragma unroll
    for (int nt = 0; nt < 4; ++nt) {
      const int col = tn * 128 + wn * 64 + nt * 16 + kg * 4;
      f32x4 v = acc[mt][nt];
      if (MODE == 0) {
        uint2 o; o.x = pack2(v[0], v[1]); o.y = pack2(v[2], v[3]);
        *(uint2*)&p.proj[(size_t)row * NP + col] = o;
      } else if (MODE == 1) {
        *(float4*)&p.out[O_PMEM + (size_t)row * 2048 + col] = make_float4(v[0], v[1], v[2], v[3]);
      } else if (MODE == 2 || MODE == 4) {
        float4 rsd;
        if (MODE == 2) {
          rsd = (row < MP) ? *(const float4*)&p.x_prompt[(size_t)row * 1024 + col] : *(const float4*)&p.x_sample[(size_t)(row - MP) * 1024 + col];
        } else {
          { const uint2 rv = *(const uint2*)&p.h1[(size_t)row * 1024 + col]; rsd = make_float4(bflo(rv.x), bfhi(rv.x), bflo(rv.y), bfhi(rv.y)); }
        }
        float4 h = make_float4(rsd.x + v[0], rsd.y + v[1], rsd.z + v[2], rsd.w + v[3]);
        ssq += h.x * h.x + h.y * h.y + h.z * h.z + h.w * h.w;
        const uint2 hb = make_uint2(pack2(h.x, h.y), pack2(h.z, h.w));
        if (MODE == 2) *(uint2*)&p.h1[(size_t)row * 1024 + col] = hb;
        else *(uint2*)&p.h2[(size_t)row * 1024 + col] = hb;
      } else if (MODE == 3) {
        uint2 o; o.x = pack2(v[0] * rs, v[1] * rs); o.y = pack2(v[2] * rs, v[3] * rs);
        *(uint2*)&p.qb[(size_t)row * 1024 + col] = o;
      } else {
        uint2 o; o.x = pack2(v[0] * rs, v[1] * rs); o.y = pack2(v[2] * rs, v[3] * rs);
        *(uint2*)&p.pq[(size_t)row * 2048 + col] = o;
      }
    }
    if (MODE == 2 || MODE == 4) {
      ssq += __shfl_xor(ssq, 16);
      ssq += __shfl_xor(ssq, 32);
      if (kg == 0) atomicAdd((MODE == 2) ? &p.ssq1[row] : &p.ssq2[row], ssq);
    }
  }
}

template <int MODE, int K>
DI void gemm_tile128(const Params& p, const u16* __restrict__ A, int lda, const u16* __restrict__ Bt, int tm, int tn,
                          char* smem) {
  const int tid = threadIdx.x, lane = tid & 63, w = tid >> 6;
  const int wm = w >> 1, wn = w & 1, r = lane & 15, kg = lane >> 4;
  f32x4 acc[4][4];
#pragma unroll
  for (int i = 0; i < 4; ++i)
#pragma unroll
    for (int j = 0; j < 4; ++j) acc[i][j] = (f32x4){0.f, 0.f, 0.f, 0.f};
  const int lr = lane >> 2, lkg = (lane & 3) ^ (lane >> 4);
  gu16p gA[4], gB[4];
#pragma unroll
  for (int i = 0; i < 4; ++i) {
    const int sub = w * 4 + i, mt = sub >> 1, ks = sub & 1;
    gA[i] = (gu16p)A + (size_t)(tm * 128 + mt * 16 + lr) * lda + ks * 32 + lkg * 8;
    gB[i] = (gu16p)Bt + (size_t)(tn * 128 + mt * 16 + lr) * K + ks * 32 + lkg * 8;
  }
  const int frag_off = r * 64 + ((kg ^ (r >> 2)) * 16);
  __syncthreads();
#pragma unroll
  for (int i = 0; i < 4; ++i) {
    __builtin_amdgcn_global_load_lds((const unsigned AS1*)(gA[i]), (unsigned AS3*)(smem + (w * 4 + i) * 1024), 16, 0, 0);
    __builtin_amdgcn_global_load_lds((const unsigned AS1*)(gB[i]), (unsigned AS3*)(smem + 16384 + (w * 4 + i) * 1024), 16, 0, 0);
  }
#pragma unroll 2
  for (int k = 0; k < K / 64; ++k) {
    __syncthreads();
    if (k + 1 < K / 64) {
      char* st = smem + ((k + 1) & 1) * 32768;
#pragma unroll
      for (int i = 0; i < 4; ++i) {
        __builtin_amdgcn_global_load_lds((const unsigned AS1*)(gA[i] + (k + 1) * 64), (unsigned AS3*)(st + (w * 4 + i) * 1024), 16, 0, 0);
        __builtin_amdgcn_global_load_lds((const unsigned AS1*)(gB[i] + (k + 1) * 64), (unsigned AS3*)(st + 16384 + (w * 4 + i) * 1024), 16, 0, 0);
      }
    }
    const char* sa = smem + (k & 1) * 32768;
    const char* sb = sa + 16384;
#pragma unroll
    for (int ks = 0; ks < 2; ++ks) {
      bf16x8 af[4], bfr[4];
#pragma unroll
      for (int i = 0; i < 4; ++i) {
        af[i] = *(const bf16x8*)(sa + ((wm * 4 + i) * 2 + ks) * 1024 + frag_off);
        bfr[i] = *(const bf16x8*)(sb + ((wn * 4 + i) * 2 + ks) * 1024 + frag_off);
      }
#pragma unroll
      for (int mt = 0; mt < 4; ++mt)
#pragma unroll
        for (int nt = 0; nt < 4; ++nt) acc[mt][nt] = MFMA(bfr[nt], af[mt], acc[mt][nt]);
    }
  }
#pragma unroll
  for (int mt = 0; mt < 4; ++mt) {
    const int row = tm * 128 + wm * 64 + mt * 16 + r;
    float rs = 1.f, ssq = 0.f;
    if (MODE == 3) rs = rsqrtf(p.ssq1[row] * (1.f / 1024.f) + EPS);
    if (MODE == 5) rs = rsqrtf(p.ssq2[row] * (1.f / 1024.f) + EPS);
#pragma unroll
    for (int nt = 0; nt < 4; ++nt) {
      const int col = tn * 128 + wn * 64 + nt * 16 + kg * 4;
      f32x4 v = acc[mt][nt];
      if (MODE == 0) {
        uint2 o; o.x = pack2(v[0], v[1]); o.y = pack2(v[2], v[3]);
        *(uint2*)&p.proj[(size_t)row * NP + col] = o;
      } else if (MODE == 1) {
        *(float4*)&p.out[O_PMEM + (size_t)row * 2048 + col] = make_float4(v[0], v[1], v[2], v[3]);
      } else if (MODE == 2 || MODE == 4) {
        float4 rsd;
        if (MODE == 2) {
          rsd = (row < MP) ? *(const float4*)&p.x_prompt[(size_t)row * 1024 + col] : *(const float4*)&p.x_sample[(size_t)(row - MP) * 1024 + col];
        } else {
          { const uint2 rv = *(const uint2*)&p.h1[(size_t)row * 1024 + col]; rsd = make_float4(bflo(rv.x), bfhi(rv.x), bflo(rv.y), bfhi(rv.y)); }
        }
        float4 h = make_float4(rsd.x + v[0], rsd.y + v[1], rsd.z + v[2], rsd.w + v[3]);
        ssq += h.x * h.x + h.y * h.y + h.z * h.z + h.w * h.w;
        const uint2 hb = make_uint2(pack2(h.x, h.y), pack2(h.z, h.w));
        if (MODE == 2) *(uint2*)&p.h1[(size_t)row * 1024 + col] = hb;
        else *(uint2*)&p.h2[(size_t)row * 1024 + col] = hb;
      } else if (MODE == 3) {
        uint2 o; o.x = pack2(v[0] * rs, v[1] * rs); o.y = pack2(v[2] * rs, v[3] * rs);
        *(uint2*)&p.qb[(size_t)row * 1024 + col] = o;
      } else {
        uint2 o; o.x = pack2(v[0] * rs, v[1] * rs); o.y = pack2(v[2] * rs, v[3] * rs);
        *(uint2*)&p.pq[(size_t)row * 2048 + col] = o;
      }
    }
    if (MODE == 2 || MODE == 4) {
      ssq += __shfl_xor(ssq, 16);
      ssq += __shfl_xor(ssq, 32);
      if (kg == 0) atomicAdd((MODE == 2) ? &p.ssq1[row] : &p.ssq2[row], ssq);
    }
  }
}

DI bool xcd_tile(int it, int nM, int nN, int& tm, int& tn) {
  const int per = gridDim.x >> 3;
  const int xcd = blockIdx.x & 7, li = blockIdx.x >> 3;
  const int i = (it * 8 + xcd) * per + li;
  if (i >= nM * nN) return false;
  const int panel = i / (8 * nN), within = i - panel * 8 * nN;
  const int rows = (nM - panel * 8) < 8 ? (nM - panel * 8) : 8;
  tn = within / rows;
  tm = panel * 8 + (within - tn * rows);
  return true;
}

DI void tr_tile(const float* __restrict__ W, int ldw, int nsrc0, u16* __restrict__ Wt, int K, int k0, int n0, float* tile, const float* gs = nullptr) {
  const int tid = threadIdx.x;
  const int n = tid & 63, kq = tid >> 6;
  __syncthreads();
#pragma unroll
  for (int i = 0; i < 16; ++i) { int kk = kq + 4 * i; tile[kk * 65 + n] = W[(size_t)(k0 + kk) * ldw + nsrc0 + n] * (gs ? gs[k0 + kk] : 1.f); }
  __syncthreads();
  const int nn = tid >> 2, ks = (tid & 3) * 16;
  unsigned o[8];
#pragma unroll
  for (int i = 0; i < 8; ++i) o[i] = pack2(tile[(ks + 2 * i) * 65 + nn], tile[(ks + 2 * i + 1) * 65 + nn]);
  u16* d = Wt + (size_t)(n0 + nn) * K + k0 + ks;
  *(uint4*)d = make_uint4(o[0], o[1], o[2], o[3]);
  *(uint4*)(d + 8) = make_uint4(o[4], o[5], o[6], o[7]);
}

DI void phase0(const Params& p, char* smem) {
  const int tid = threadIdx.x, lane = tid & 63, w = tid >> 6;
  const size_t gtid = (size_t)blockIdx.x * 256 + tid, gsz = (size_t)gridDim.x * 256;
  {
    const float* eu = p.expert_u;
    const float* ev = p.expert_v;
    unsigned char* e8 = p.E8;
    float* rsp = p.rs;
    const float* gfn = p.g_ffn;
    const int sub = lane & 15, rq = lane >> 4;
    for (int er0 = (blockIdx.x * 4 + w) * 4; er0 < 32768; er0 += gridDim.x * 16) {
      const int er = er0 + rq;
      const float* src = (er < 16384) ? (eu + (size_t)er * 1024) : (ev + (size_t)(er - 16384) * 1024);
      float4 v[16];
      float am = 0.f;
#pragma unroll
      for (int i = 0; i < 16; ++i) {
        v[i] = *(const float4*)&src[(i >> 2) * 256 + sub * 16 + (i & 3) * 4];
        if (er < 16384) {
          const float4 gq = *(const float4*)&gfn[(i >> 2) * 256 + sub * 16 + (i & 3) * 4];
          v[i].x *= gq.x; v[i].y *= gq.y; v[i].z *= gq.z; v[i].w *= gq.w;
        }
        am = fmaxf(am, fmaxf(fmaxf(fabsf(v[i].x), fabsf(v[i].y)), fmaxf(fabsf(v[i].z), fabsf(v[i].w))));
      }
      am = fmaxf(am, __shfl_xor(am, 1)); am = fmaxf(am, __shfl_xor(am, 2));
      am = fmaxf(am, __shfl_xor(am, 4)); am = fmaxf(am, __shfl_xor(am, 8));
      const float sc = (am > 0.f) ? 224.f / am : 1.f;
#pragma unroll
      for (int c = 0; c < 4; ++c) {
        int o[4];
#pragma unroll
        for (int i = 0; i < 4; ++i) {
          const float4 t4 = v[c * 4 + i];
          int t = __builtin_amdgcn_cvt_pk_fp8_f32(t4.x * sc, t4.y * sc, 0, false);
          o[i] = __builtin_amdgcn_cvt_pk_fp8_f32(t4.z * sc, t4.w * sc, t, true);
        }
        *(uint4*)&e8[(size_t)er * 1024 + c * 256 + sub * 16] = make_uint4((unsigned)o[0], (unsigned)o[1], (unsigned)o[2], (unsigned)o[3]);
      }
      if (sub == 0) rsp[er] = (am > 0.f) ? am * (1.f / 224.f) : 1.f;
    }
  }
  for (size_t i = gtid; i < 262144 / 8; i += gsz) cvt8(p.sub_keys + i * 8, p.subkb + i * 8);
  for (size_t i = gtid; i < MT; i += gsz) { p.ssq1[i] = 0.f; p.ssq2[i] = 0.f; }
  float* wl = (float*)smem;
  __syncthreads();
  for (int i = tid; i < 2048; i += 256) {
    const int k = i >> 1, hf = i & 1;
    float4 t = *(const float4*)&p.w_in[(size_t)k * 4360 + 1536 + hf * 4];
    wl[(hf * 4 + 0) * 1024 + k] = t.x; wl[(hf * 4 + 1) * 1024 + k] = t.y; wl[(hf * 4 + 2) * 1024 + k] = t.z; wl[(hf * 4 + 3) * 1024 + k] = t.w;
  }
  __syncthreads();
  const float* xpp = p.x_prompt;
  const float* xsp = p.x_sample;
  const float* mpp = p.mem_prompt;
  const float* gmx = p.g_mix;
  const float* gmk = p.g_memkv;
  u16* a0p = p.A0;
  u16* amp = p.Amem;
  {
    const int sub = lane & 15, rq = lane >> 4;
    for (int row0 = (blockIdx.x * 4 + w) * 4; row0 < MT + 1024; row0 += gridDim.x * 16) {
      const int row = row0 + rq;
      const float* src; const float* g; u16* dst;
      if (row < MP) { src = xpp + (size_t)row * 1024; g = gmx; dst = a0p + (size_t)row * 1024; }
      else if (row < MT) { src = xsp + (size_t)(row - MP) * 1024; g = gmx; dst = a0p + (size_t)row * 1024; }
      else { src = mpp + (size_t)(row - MT) * 1024; g = gmk; dst = amp + (size_t)(row - MT) * 1024; }
      float4 v[16];
      float ss = 0.f;
#pragma unroll
      for (int i = 0; i < 16; ++i) { v[i] = *(const float4*)&src[i * 64 + sub * 4]; ss += v[i].x * v[i].x + v[i].y * v[i].y + v[i].z * v[i].z + v[i].w * v[i].w; }
      ss += __shfl_xor(ss, 1); ss += __shfl_xor(ss, 2); ss += __shfl_xor(ss, 4); ss += __shfl_xor(ss, 8);
      const float rs = rsqrtf(ss * (1.f / 1024.f) + EPS);
      float d8[8] = {0.f, 0.f, 0.f, 0.f, 0.f, 0.f, 0.f, 0.f};
#pragma unroll
      for (int i = 0; i < 16; ++i) {
        float4 g4 = *(const float4*)&g[i * 64 + sub * 4];
        float y[4] = {v[i].x * rs * g4.x, v[i].y * rs * g4.y, v[i].z * rs * g4.z, v[i].w * rs * g4.w};
        uint2 o; o.x = pack2(y[0], y[1]); o.y = pack2(y[2], y[3]);
        *(uint2*)&dst[i * 64 + sub * 4] = o;
        if (row < MT) {
#pragma unroll
          for (int j = 0; j < 8; ++j) {
            float4 wv = *(const float4*)&wl[j * 1024 + i * 64 + sub * 4];
            d8[j] += y[0] * wv.x + y[1] * wv.y + y[2] * wv.z + y[3] * wv.w;
          }
        }
      }
      if (row < MT) {
#pragma unroll
        for (int j = 0; j < 8; ++j) {
          d8[j] += __shfl_xor(d8[j], 1); d8[j] += __shfl_xor(d8[j], 2); d8[j] += __shfl_xor(d8[j], 4); d8[j] += __shfl_xor(d8[j], 8);
        }
        if (sub < 4) {
          float ag = sel4(sub, d8[0], d8[1], d8[2], d8[3]);
          float bg = sel4(sub, d8[4], d8[5], d8[6], d8[7]);
          float xs = ag + p.dt_bias[sub];
          float sp = (xs > 20.f) ? xs : log1pf(expf(xs));
          p.gb[(size_t)row * 8 + sub] = -expf(p.a_log[sub]) * sp;
          p.gb[(size_t)row * 8 + 4 + sub] = 1.f / (1.f + expf(-bg));
        }
      }
    }
  }
  __syncthreads();
  float* tile = (float*)smem;
  for (int j = blockIdx.x; j < 2816; j += gridDim.x) {
    int t = j;
    if (t < 1088) { int kt = t / 68, nt = t % 68; int n0 = nt * 64; tr_tile(p.w_in, 4360, n0 + (n0 >= 1536 ? 8 : 0), p.WtIn, 1024, kt * 64, n0, tile); continue; }
    t -= 1088;
    if (t < 192) { int kt = t / 16, nt = t % 16; tr_tile(p.w_out, 1024, nt * 64, p.WtOut, 768, kt * 64, nt * 64, tile); continue; }
    t -= 192;
    if (t < 256) { int kt = t / 16, nt = t % 16; tr_tile(p.w_mq, 1024, nt * 64, p.WtMq, 1024, kt * 64, nt * 64, tile, p.g_memq); continue; }
    t -= 256;
    if (t < 512) { int kt = t / 32, nt = t % 32; tr_tile(p.w_mkv, 2048, nt * 64, p.WtMkv, 1024, kt * 64, nt * 64, tile); continue; }
    t -= 512;
    if (t < 256) { int kt = t / 16, nt = t % 16; tr_tile(p.w_mo, 1024, nt * 64, p.WtMo, 1024, kt * 64, nt * 64, tile); continue; }
    t -= 256;
    { int kt = t / 32, nt = t % 32; tr_tile(p.w_pq, 2048, nt * 64, p.WtPq, 1024, kt * 64, nt * 64, tile, p.g_ffn); }
  }
}

DI void dn_prep(const Params& p, int item, char* smem) {
  u16* qs = (u16*)smem;
  u16* ksm = qs + 64 * 136;
  float* sL = (float*)(ksm + 64 * 136);
  float* sgc = sL + 64 * 64;
  float* sbeta = sgc + 64;
  u16* sU = (u16*)sL;
  u16* sW = qs;
  const int tid = threadIdx.x, lane = tid & 63, w = tid >> 6, r = lane & 15, kg = lane >> 4;
  const int bh = item >> 7, n = item & 127, b = bh >> 2, h = bh & 3;
  const int t0 = n * 64;
  const size_t rowbase = (size_t)b * SEQ;
  char* ops = p.dnops + (size_t)item * DN_ITEM;
  __syncthreads();
  if (tid < 64) {
    float gv = p.gb[(rowbase + t0 + tid) * 8 + h];
    float bv = p.gb[(rowbase + t0 + tid) * 8 + 4 + h];
#pragma unroll
    for (int o = 1; o < 64; o <<= 1) { float t = __shfl_up(gv, o); if (lane >= o) gv += t; }
    sgc[tid] = gv; sbeta[tid] = bv;
    if (tid == 63) p.dl[item] = __expf(gv);
  }
#pragma unroll 4
  for (int ps = 0; ps < 8; ++ps) {
    const int combo = ps * 16 + (tid >> 4);
    const int tt = combo & 63, part = combo >> 6, sub = tid & 15;
    const int col = part * 512 + h * 128 + sub * 8;
    float y[8] = {0.f, 0.f, 0.f, 0.f, 0.f, 0.f, 0.f, 0.f};
#pragma unroll
    for (int j = 0; j < 4; ++j) {
      const int t = t0 + tt - 3 + j;
      if (t >= 0) {
        uint4 xv = *(const uint4*)&p.proj[(rowbase + t) * NP + col];
        float4 wa = *(const float4*)&p.conv_w[j * 1536 + col], wb = *(const float4*)&p.conv_w[j * 1536 + col + 4];
        y[0] += bflo(xv.x) * wa.x; y[1] += bfhi(xv.x) * wa.y; y[2] += bflo(xv.y) * wa.z; y[3] += bfhi(xv.y) * wa.w;
        y[4] += bflo(xv.z) * wb.x; y[5] += bfhi(xv.z) * wb.y; y[6] += bflo(xv.w) * wb.z; y[7] += bfhi(xv.w) * wb.w;
      }
    }
    float ss = 0.f;
#pragma unroll
    for (int e = 0; e < 8; ++e) { y[e] = siluf(y[e]); ss += y[e] * y[e]; }
    ss += __shfl_xor(ss, 1); ss += __shfl_xor(ss, 2); ss += __shfl_xor(ss, 4); ss += __shfl_xor(ss, 8);
    float sc = rsqrtf(ss + EPS) * (part == 0 ? 0.08838834764831845f : 1.f);
    uint4 o; o.x = pack2(y[0] * sc, y[1] * sc); o.y = pack2(y[2] * sc, y[3] * sc); o.z = pack2(y[4] * sc, y[5] * sc); o.w = pack2(y[6] * sc, y[7] * sc);
    *(uint4*)&((part == 0 ? qs : ksm)[tt * 136 + sub * 8]) = o;
  }
  __syncthreads();
  const float gcl = sgc[63];
  {
    f32x4 aL[4], aA[4];
#pragma unroll
    for (int i = 0; i < 4; ++i) { aL[i] = (f32x4){0.f, 0.f, 0.f, 0.f}; aA[i] = (f32x4){0.f, 0.f, 0.f, 0.f}; }
#pragma unroll
    for (int ks = 0; ks < 4; ++ks) {
      bf16x8 kI = *(const bf16x8*)&ksm[(w * 16 + r) * 136 + ks * 32 + kg * 8];
      bf16x8 qI = *(const bf16x8*)&qs[(w * 16 + r) * 136 + ks * 32 + kg * 8];
#pragma unroll
      for (int nt = 0; nt < 4; ++nt) {
        bf16x8 kJ = *(const bf16x8*)&ksm[(nt * 16 + r) * 136 + ks * 32 + kg * 8];
        aL[nt] = MFMA(kJ, kI, aL[nt]);
        aA[nt] = MFMA(kJ, qI, aA[nt]);
      }
    }
    const int i = w * 16 + r;
    const float gci = sgc[i], bi = sbeta[i];
    u16* aq = (u16*)(ops + 49152);
#pragma unroll
    for (int nt = 0; nt < 4; ++nt) {
      float lv[4], av[4];
#pragma unroll
      for (int jj = 0; jj < 4; ++jj) {
        const int j = nt * 16 + kg * 4 + jj;
        const float gam = (i >= j) ? __expf(gci - sgc[j]) : 0.f;
        lv[jj] = (i > j) ? aL[nt][jj] * bi * gam : 0.f;
        av[jj] = aA[nt][jj] * gam;
      }
      *(float4*)&sL[i * 64 + nt * 16 + kg * 4] = make_float4(lv[0], lv[1], lv[2], lv[3]);
      uint2 o; o.x = pack2(av[0], av[1]); o.y = pack2(av[2], av[3]);
      *(uint2*)&aq[((w * 2 + (nt >> 1)) * 64 + lane) * 8 + (nt & 1) * 4] = o;
    }
  }
  {
    u16* qg = (u16*)(ops + 16384);
    u16* kdT = (u16*)(ops + 32768);
#pragma unroll 1
    for (int i = 0; i < 4; ++i) {
      const int f = tid + 256 * i;
      const int mtks = f >> 6, l = f & 63, rr = l & 15, kgg = l >> 4;
      {
        const int mt = mtks >> 2, ks = mtks & 3, row = mt * 16 + rr;
        const float e = __expf(sgc[row]);
        uint2 a = *(const uint2*)&qs[row * 136 + ks * 32 + kgg * 4];
        uint2 c = *(const uint2*)&qs[row * 136 + ks * 32 + 16 + kgg * 4];
        uint4 o;
        o.x = pack2(bflo(a.x) * e, bfhi(a.x) * e); o.y = pack2(bflo(a.y) * e, bfhi(a.y) * e);
        o.z = pack2(bflo(c.x) * e, bfhi(c.x) * e); o.w = pack2(bflo(c.y) * e, bfhi(c.y) * e);
        *(uint4*)&qg[(size_t)f * 8] = o;
      }
      {
        const int mt = mtks >> 1, ks = mtks & 1, kdim = mt * 16 + rr;
        float v[8];
#pragma unroll
        for (int j = 0; j < 8; ++j) {
          const int c = ks * 32 + permk(kgg, j);
          v[j] = bf2f(ksm[c * 136 + kdim]) * __expf(gcl - sgc[c]);
        }
        uint4 o; o.x = pack2(v[0], v[1]); o.y = pack2(v[2], v[3]); o.z = pack2(v[4], v[5]); o.w = pack2(v[6], v[7]);
        *(uint4*)&kdT[(size_t)f * 8] = o;
      }
    }
  }
  __syncthreads();
  float x[64];
  if (tid < 128) {
    const int col = 1024 + h * 128 + tid;
    const float w0 = p.conv_w[col], w1 = p.conv_w[1536 + col], w2 = p.conv_w[3072 + col], w3 = p.conv_w[4608 + col];
    float xm3 = 0.f, xm2 = 0.f, xm1 = 0.f;
    if (t0 > 0) {
      xm3 = bf2f(p.proj[(rowbase + t0 - 3) * NP + col]);
      xm2 = bf2f(p.proj[(rowbase + t0 - 2) * NP + col]);
      xm1 = bf2f(p.proj[(rowbase + t0 - 1) * NP + col]);
    }
#pragma unroll
    for (int t = 0; t < 64; ++t) {
      float xc = bf2f(p.proj[(rowbase + t0 + t) * NP + col]);
      float yv = w0 * xm3 + w1 * xm2 + w2 * xm1 + w3 * xc;
      x[t] = siluf(yv) * sbeta[t];
      xm3 = xm2; xm2 = xm1; xm1 = xc;
    }
  } else {
    const int kc = tid - 128;
#pragma unroll
    for (int t = 0; t < 64; ++t) x[t] = bf2f(ksm[t * 136 + kc]) * sbeta[t] * __expf(sgc[t]);
  }
  {
    f32x4 Lr[16];
#pragma unroll
    for (int i = 1; i < 64; ++i) {
#pragma unroll
      for (int j4 = 0; j4 < (i + 3) / 4; ++j4) Lr[j4] = *(const f32x4*)&sL[i * 64 + j4 * 4];
      __builtin_amdgcn_sched_barrier(0);
      float s0 = x[i], s1 = 0.f, s2 = 0.f, s3 = 0.f;
#pragma unroll
      for (int j4 = 0; j4 < (i + 3) / 4; ++j4) {
        const f32x4 l = Lr[j4];
        s0 -= l[0] * x[j4 * 4];
        if (j4 * 4 + 1 < i) s1 -= l[1] * x[j4 * 4 + 1];
        if (j4 * 4 + 2 < i) s2 -= l[2] * x[j4 * 4 + 2];
        if (j4 * 4 + 3 < i) s3 -= l[3] * x[j4 * 4 + 3];
      }
      x[i] = (s0 + s1) + (s2 + s3);
      __builtin_amdgcn_sched_barrier(0);
    }
  }
  __syncthreads();
  if (tid < 128) {
#pragma unroll
    for (int t = 0; t < 64; ++t) sU[t * 128 + tid] = f2bf(x[t]);
  } else {
    const int kc = tid - 128;
#pragma unroll
    for (int t = 0; t < 64; ++t) sW[t * 136 + kc] = f2bf(-x[t]);
  }
  __syncthreads();
  {
    u16* nW = (u16*)ops;
    u16* u0 = (u16*)(ops + 57344);
#pragma unroll 1
    for (int i = 0; i < 4; ++i) {
      const int f = tid + 256 * i;
      const int mtks = f >> 6, l = f & 63, rr = l & 15, kgg = l >> 4;
      const int mt = mtks >> 2, ks = mtks & 3, row = mt * 16 + rr;
      uint2 a = *(const uint2*)&sW[row * 136 + ks * 32 + kgg * 4];
      uint2 c = *(const uint2*)&sW[row * 136 + ks * 32 + 16 + kgg * 4];
      *(uint4*)&nW[(size_t)f * 8] = make_uint4(a.x, a.y, c.x, c.y);
    }
#pragma unroll 1
    for (int i = 0; i < 8; ++i) {
      const int f = tid + 256 * i;
      const int smt = f >> 6, l = f & 63, rr = l & 15, kgg = l >> 4;
      const int s = smt >> 2, mt = smt & 3;
      u16 v0 = sU[(mt * 16 + kgg * 4 + 0) * 128 + s * 16 + rr];
      u16 v1 = sU[(mt * 16 + kgg * 4 + 1) * 128 + s * 16 + rr];
      u16 v2 = sU[(mt * 16 + kgg * 4 + 2) * 128 + s * 16 + rr];
      u16 v3 = sU[(mt * 16 + kgg * 4 + 3) * 128 + s * 16 + rr];
      *(uint2*)&u0[(size_t)f * 4] = make_uint2((unsigned)v0 | ((unsigned)v1 << 16), (unsigned)v2 | ((unsigned)v3 << 16));
    }
  }
}

DI void vt_tile(const Params& p, int item, char* smem) {
  u16* tile = (u16*)smem;
  const int tid = threadIdx.x;
  const int ptile = item & 127, gbh = item >> 7;
  const int h = gbh & 3, b = (gbh >> 2) & 3, g = gbh >> 4;
  const int dsh = g * 2, ln = SEQ >> dsh;
  const int pos0 = ptile * 64;
  const int rres = pos0 / ln, i0 = pos0 % ln;
  __syncthreads();
  {
    const int pr = tid >> 2, seg = (tid & 3) * 16;
    const int token = ((i0 + pr) << dsh) + rres;
    const u16* src = &p.proj[((size_t)b * SEQ + token) * NP + 2048 + g * 768 + 512 + h * 64 + seg];
    uint4 a = *(const uint4*)src, c = *(const uint4*)(src + 8);
    unsigned d[8] = {a.x, a.y, a.z, a.w, c.x, c.y, c.z, c.w};
#pragma unroll
    for (int e = 0; e < 8; ++e) *(unsigned*)&tile[pr * 66 + seg + e * 2] = d[e];
  }
  __syncthreads();
  {
    const int dh = tid >> 2, seg = (tid & 3) * 16;
    unsigned o[8];
#pragma unroll
    for (int e = 0; e < 8; ++e) o[e] = (unsigned)tile[(seg + 2 * e) * 66 + dh] | ((unsigned)tile[(seg + 2 * e + 1) * 66 + dh] << 16);
    u16* d = &p.vT[((size_t)gbh * 64 + dh) * SEQ + pos0 + seg];
    *(uint4*)d = make_uint4(o[0], o[1], o[2], o[3]);
    *(uint4*)(d + 8) = make_uint4(o[4], o[5], o[6], o[7]);
  }
}

DI void dn_sample(const Params& p, int item, char* smem) {
  float* sq = (float*)smem;
  float* sk = sq + 512;
  float* sv = sk + 512;
  float* red = sv + 512;
  const int tid = threadIdx.x, lane = tid & 63, w = tid >> 6;
  const int b = item >> 2, h = item & 3;
  __syncthreads();
  for (int c = tid; c < 384; c += 256) {
    const int part = c >> 7, cc = c & 127;
    const int col = part * 512 + h * 128 + cc;
    float xp[7];
#pragma unroll
    for (int j = 0; j < 3; ++j) xp[j] = p.state_conv[((size_t)b * 3 + j) * 1536 + col];
#pragma unroll
    for (int j = 0; j < 4; ++j) xp[3 + j] = bf2f(p.proj[((size_t)MP + b * 4 + j) * NP + col]);
    const float w0 = p.conv_w[col], w1 = p.conv_w[1536 + col], w2 = p.conv_w[3072 + col], w3 = p.conv_w[4608 + col];
    float* dst = part == 0 ? sq : (part == 1 ? sk : sv);
#pragma unroll
    for (int t = 0; t < 4; ++t) dst[t * 128 + cc] = siluf(w0 * xp[t] + w1 * xp[t + 1] + w2 * xp[t + 2] + w3 * xp[t + 3]);
  }
  __syncthreads();
  {
    float a0 = sq[w * 128 + lane], a1 = sq[w * 128 + 64 + lane];
    float s = wave_sum(a0 * a0 + a1 * a1);
    float sc = rsqrtf(s + EPS) * 0.08838834764831845f;
    sq[w * 128 + lane] = a0 * sc; sq[w * 128 + 64 + lane] = a1 * sc;
    float b0 = sk[w * 128 + lane], b1 = sk[w * 128 + 64 + lane];
    s = wave_sum(b0 * b0 + b1 * b1);
    sc = rsqrtf(s + EPS);
    sk[w * 128 + lane] = b0 * sc; sk[w * 128 + 64 + lane] = b1 * sc;
  }
  __syncthreads();
  const int v = tid & 127, half = tid >> 7;
  float S[64];
  const float* s0 = p.state_delta + (((size_t)b * 4 + h) * 128 + half * 64) * 128 + v;
#pragma unroll
  for (int i = 0; i < 64; ++i) S[i] = s0[(size_t)i * 128];
#pragma unroll 1
  for (int t = 0; t < 4; ++t) {
    const size_t row = (size_t)MP + b * 4 + t;
    const float a = __expf(p.gb[row * 8 + h]);
    const float beta = p.gb[row * 8 + 4 + h];
    float part = 0.f;
#pragma unroll
    for (int i = 0; i < 64; ++i) part += S[i] * sk[t * 128 + half * 64 + i];
    red[half * 128 + v] = part;
    __syncthreads();
    const float kS = red[v] + red[128 + v];
    const float u = beta * (sv[t * 128 + v] - a * kS);
    float po = 0.f;
#pragma unroll
    for (int i = 0; i < 64; ++i) { S[i] = a * S[i] + sk[t * 128 + half * 64 + i] * u; po += S[i] * sq[t * 128 + half * 64 + i]; }
    __syncthreads();
    red[half * 128 + v] = po;
    __syncthreads();
    if (half == 0) p.odn[row * 512 + h * 128 + v] = f2bf(red[v] + red[128 + v]);
    __syncthreads();
  }
  float* d = p.out + O_SDELTA + (((size_t)b * 4 + h) * 128 + half * 64) * 128 + v;
#pragma unroll
  for (int i = 0; i < 64; ++i) d[(size_t)i * 128] = S[i];
}

DI void phase2(const Params& p, char* smem) {
  const size_t gtid = (size_t)blockIdx.x * 256 + threadIdx.x, gsz = (size_t)gridDim.x * 256;
  for (int j = blockIdx.x; j < 2048 + 128 + 6144; j += gridDim.x) {
    if (j < 2048) { dn_prep(p, j, smem); if (DBL == 20) dn_prep(p, j, smem); }
    else if (j < 2048 + 128) dn_sample(p, j - 2048, smem);
    else { vt_tile(p, j - 2176, smem); if (DBL == 21) vt_tile(p, j - 2176, smem); }
  }
  for (size_t f = gtid; f < (size_t)16 * 8192; f += gsz) {
    {
      const size_t e0 = f * 8;
      const int bh = (int)(e0 >> 16), key = (int)((e0 >> 8) & 255), dh = (int)(e0 & 255);
      const int b = bh >> 2, h = bh & 3;
      cvt8(p.out + O_PMEM + (((size_t)b * 256 + key) * 2 + 0) * 1024 + h * 256 + dh, p.Kb + e0);
    }
    {
      const int l = (int)(f & 63), ks = (int)((f >> 6) & 7), nt = (int)((f >> 9) & 15), bh = (int)(f >> 13);
      const int b = bh >> 2, h = bh & 3, rr = l & 15, kgg = l >> 4;
      float v[8];
#pragma unroll
      for (int j = 0; j < 8; ++j) {
        const int key = ks * 32 + permk(kgg, j);
        v[j] = p.out[O_PMEM + (((size_t)b * 256 + key) * 2 + 1) * 1024 + h * 256 + nt * 16 + rr];
      }
      *(uint4*)&p.VTf[f * 8] = make_uint4(pack2(v[0], v[1]), pack2(v[2], v[3]), pack2(v[4], v[5]), pack2(v[6], v[7]));
    }
  }
  for (size_t i = gtid; i < 18432; i += gsz) {
    const int c = (int)(i % 1536), j = (int)((i / 1536) % 3), b = (int)(i / 4608);
    p.out[O_PCONV + i] = bf2f(p.proj[((size_t)b * SEQ + SEQ - 3 + j) * NP + c]);
  }
  for (int g = 0; g < 3; ++g) {
    const int W = 128 << (2 * g);
    const size_t off = (g == 0) ? O_PW1 : (g == 1 ? O_PW2 : O_PW3);
    const size_t n4 = (size_t)4 * W * 512 / 4;
    for (size_t i = gtid; i < n4; i += gsz) {
      const size_t e0 = i * 4;
      const int e = (int)(e0 & 511), ii = (int)((e0 >> 9) % W), b = (int)((e0 >> 9) / W);
      uint2 v = *(const uint2*)&p.proj[((size_t)b * SEQ + SEQ - W + ii) * NP + 2048 + g * 768 + 256 + e];
      *(float4*)&p.out[off + e0] = make_float4(bflo(v.x), bfhi(v.x), bflo(v.y), bfhi(v.y));
    }
  }
}

typedef __attribute__((ext_vector_type(2))) unsigned u32x2;
struct ScanOps { bf16x8 nW[4]; bf16x8 qg[4]; bf16x8 aq[2]; bf16x8 kd[4]; u32x2 u0; float dl; };

DI void scan_load(const Params& p, int bh, int s, int n, int j, int lane, ScanOps& o) {
  n = n > 127 ? 127 : n;
  const char AS1* base = (const char AS1*)p.dnops + (size_t)(bh * 128 + n) * DN_ITEM;
  gb8p negW = (gb8p)base;
  gb8p qg = (gb8p)(base + 16384);
  gb8p kdT = (gb8p)(base + 32768);
  gb8p aqk = (gb8p)(base + 49152);
  const u32x2 AS1* u0 = (const u32x2 AS1*)(base + 57344);
#pragma unroll
  for (int ks = 0; ks < 4; ++ks) o.nW[ks] = negW[(j * 4 + ks) * 64 + lane];
#pragma unroll
  for (int ks = 0; ks < 4; ++ks) o.qg[ks] = qg[(j * 4 + ks) * 64 + lane];
#pragma unroll
  for (int k2 = 0; k2 < 2; ++k2) o.aq[k2] = aqk[(j * 2 + k2) * 64 + lane];
#pragma unroll
  for (int mm = 0; mm < 2; ++mm)
#pragma unroll
    for (int k2 = 0; k2 < 2; ++k2) o.kd[mm * 2 + k2] = kdT[((2 * j + mm) * 2 + k2) * 64 + lane];
  o.u0 = u0[(s * 4 + j) * 64 + lane];
  o.dl = ((const float AS1*)p.dl)[bh * 128 + n];
}

DI void scan_step(const Params& p, const ScanOps& ops, int n, int b, int h, int s, int j, int lane, f32x4& S0, f32x4& S1,
                  bf16x8* sSb, u32x2* sUb) {
  const int r = lane & 15, kg = lane >> 4;
  bf16x8 sb[4];
#pragma unroll
  for (int ks = 0; ks < 4; ++ks) sb[ks] = sSb[ks * 64 + lane];
  f32x4 u = (f32x4){bflo(ops.u0[0]), bfhi(ops.u0[0]), bflo(ops.u0[1]), bfhi(ops.u0[1])};
#pragma unroll
  for (int ks = 0; ks < 4; ++ks) u = MFMA(ops.nW[ks], sb[ks], u);
  {
    u32x2 t; t[0] = pack2(u[0], u[1]); t[1] = pack2(u[2], u[3]);
    sUb[((j >> 1) * 64 + lane) * 2 + (j & 1)] = t;
  }
  __syncthreads();
  bf16x8 ub[2];
#pragma unroll
  for (int k2 = 0; k2 < 2; ++k2) ub[k2] = *(const bf16x8*)&sUb[(k2 * 64 + lane) * 2];
  f32x4 o = (f32x4){0.f, 0.f, 0.f, 0.f};
#pragma unroll
  for (int ks = 0; ks < 4; ++ks) o = MFMA(ops.qg[ks], sb[ks], o);
#pragma unroll
  for (int k2 = 0; k2 < 2; ++k2) o = MFMA(ops.aq[k2], ub[k2], o);
  S0 = S0 * ops.dl; S1 = S1 * ops.dl;
#pragma unroll
  for (int k2 = 0; k2 < 2; ++k2) { S0 = MFMA(ops.kd[k2], ub[k2], S0); S1 = MFMA(ops.kd[2 + k2], ub[k2], S1); }
  sSb[j * 64 + lane] = pack8(S0, S1);
#pragma unroll
  for (int jj = 0; jj < 4; ++jj) {
    const size_t token = (size_t)b * SEQ + n * 64 + j * 16 + kg * 4 + jj;
    G(p.odn)[token * 512 + h * 128 + s * 16 + r] = f2bf(o[jj]);
  }
  __syncthreads();
}

DI void dn_scan_block(const Params& p, int item, char* smem) {
  const int lane = threadIdx.x & 63, j = threadIdx.x >> 6, r = lane & 15, kg = lane >> 4;
  const int bh = item >> 3, s = item & 7, b = bh >> 2, h = bh & 3;
  bf16x8* sSb = (bf16x8*)smem;
  u32x2* sUb = (u32x2*)(smem + 4096);
  f32x4 S0 = (f32x4){0.f, 0.f, 0.f, 0.f}, S1 = (f32x4){0.f, 0.f, 0.f, 0.f};
  __syncthreads();
  sSb[j * 64 + lane] = pack8(S0, S1);
  ScanOps A, B;
  scan_load(p, bh, s, 0, j, lane, A);
  scan_load(p, bh, s, 1, j, lane, B);
  __syncthreads();
#pragma unroll 1
  for (int n0 = 0; n0 < 128; n0 += 2) {
    scan_step(p, A, n0, b, h, s, j, lane, S0, S1, sSb, sUb);
    scan_load(p, bh, s, n0 + 2, j, lane, A);
    scan_step(p, B, n0 + 1, b, h, s, j, lane, S0, S1, sSb, sUb);
    scan_load(p, bh, s, n0 + 3, j, lane, B);
  }
#pragma unroll
  for (int jj = 0; jj < 4; ++jj) {
    p.out[O_PDELTA + ((size_t)bh * 128 + 32 * j + kg * 4 + jj) * 128 + s * 16 + r] = S0[jj];
    p.out[O_PDELTA + ((size_t)bh * 128 + 32 * j + 16 + kg * 4 + jj) * 128 + s * 16 + r] = S1[jj];
  }
}

DI void sw_prompt_wave(const Params& p, int item) {
  const int lane = threadIdx.x & 63, r = lane & 15, kg = lane >> 4;
  const int qt = item & 511, gbh = item >> 9;
  const int h = gbh & 3, b = (gbh >> 2) & 3, g = gbh >> 4;
  const int dsh = 2 * g, ln = SEQ >> dsh;
  const int pos0 = qt * 16, rres = pos0 / ln, i0 = pos0 % ln;
  const int kbase = i0 - 144;
  const size_t rb = (size_t)b * SEQ;
  const int qoff = 2048 + g * 768 + h * 64, koff = qoff + 256;
  bf16x8 qf[2];
  {
    const size_t tok = rb + ((size_t)(i0 + r) << dsh) + rres;
#pragma unroll
    for (int ks = 0; ks < 2; ++ks) qf[ks] = *(const bf16x8*)&p.proj[tok * NP + qoff + ks * 32 + kg * 8];
  }
  f32x4 st[10];
#pragma unroll
  for (int mt = 0; mt < 10; ++mt) {
    int ki = kbase + mt * 16 + r; ki = ki < 0 ? 0 : ki;
    const size_t tok = rb + ((size_t)ki << dsh) + rres;
    f32x4 a = (f32x4){0.f, 0.f, 0.f, 0.f};
#pragma unroll
    for (int ks = 0; ks < 2; ++ks) {
      bf16x8 kf = *(const bf16x8*)&p.proj[tok * NP + koff + ks * 32 + kg * 8];
      a = MFMA(kf, qf[ks], a);
    }
    st[mt] = a;
  }
  const int qi = i0 + r;
  float mx = -3.0e38f;
#pragma unroll
  for (int mt = 0; mt < 10; ++mt)
#pragma unroll
    for (int j = 0; j < 4; ++j) {
      const int ki = kbase + mt * 16 + kg * 4 + j;
      const int d = qi - ki;
      const bool valid = (ki >= 0) && (d >= 0) && (d <= 128);
      const float sv = valid ? st[mt][j] * 0.125f : -3.0e38f;
      st[mt][j] = sv;
      mx = fmaxf(mx, sv);
    }
  mx = fmaxf(mx, __shfl_xor(mx, 16));
  mx = fmaxf(mx, __shfl_xor(mx, 32));
  float sum = 0.f;
#pragma unroll
  for (int mt = 0; mt < 10; ++mt)
#pragma unroll
    for (int j = 0; j < 4; ++j) {
      const float pv = (st[mt][j] > -1.0e38f) ? __expf(st[mt][j] - mx) : 0.f;
      st[mt][j] = pv;
      sum += pv;
    }
  sum += __shfl_xor(sum, 16);
  sum += __shfl_xor(sum, 32);
  const float inv = 1.f / sum;
  bf16x8 pf[5];
#pragma unroll
  for (int k2 = 0; k2 < 5; ++k2) pf[k2] = pack8(st[2 * k2], st[2 * k2 + 1]);
  const size_t qrow = rb + ((size_t)qi << dsh) + rres;
#pragma unroll
  for (int nt = 0; nt < 4; ++nt) {
    f32x4 o = (f32x4){0.f, 0.f, 0.f, 0.f};
    const u16* vrow = &p.vT[((size_t)gbh * 64 + nt * 16 + r) * SEQ + (size_t)rres * ln];
#pragma unroll
    for (int k2 = 0; k2 < 5; ++k2) {
      int ka = kbase + k2 * 32 + kg * 4, kc = ka + 16;
      ka = ka < 0 ? 0 : ka; kc = kc < 0 ? 0 : kc;
      uint2 va = *(const uint2*)&vrow[ka];
      uint2 vc = *(const uint2*)&vrow[kc];
      bf16x8 vf = __builtin_bit_cast(bf16x8, make_uint4(va.x, va.y, vc.x, vc.y));
      o = MFMA(vf, pf[k2], o);
    }
    uint2 ov; ov.x = pack2(o[0] * inv, o[1] * inv); ov.y = pack2(o[2] * inv, o[3] * inv);
    *(uint2*)&p.osw[((size_t)g * MT + qrow) * 256 + h * 64 + nt * 16 + kg * 4] = ov;
  }
  if (kg == 0) p.lse[((size_t)g * MT + qrow) * 4 + h] = mx + __logf(sum);
}

DI void sw_sample_wave(const Params& p, int item) {
  const int lane = threadIdx.x & 63;
  const int t = item & 3, h = (item >> 2) & 3, b = (item >> 4) & 31, g = item >> 9;
  const int dil = 1 << (2 * g), W = 128 << (2 * g);
  const float* c1 = p.cw1;
  const float* c2 = p.cw2;
  const float* c3 = p.cw3;
  const float* cache = (g == 0) ? c1 : (g == 1 ? c2 : c3);
  const int qoff = 2048 + g * 768 + h * 64;
  const size_t qrow = (size_t)MP + b * 4 + t;
  float q[64];
#pragma unroll
  for (int c = 0; c < 64; c += 8) {
    uint4 v = *(const uint4*)&p.proj[qrow * NP + qoff + c];
    q[c] = bflo(v.x); q[c + 1] = bfhi(v.x); q[c + 2] = bflo(v.y); q[c + 3] = bfhi(v.y);
    q[c + 4] = bflo(v.z); q[c + 5] = bfhi(v.z); q[c + 6] = bflo(v.w); q[c + 7] = bfhi(v.w);
  }
  float sc[3];
#pragma unroll
  for (int mi = 0; mi < 3; ++mi) {
    const int m = lane + 64 * mi;
    float s = -3.0e38f;
    if (m <= 128) {
      const int j = W + t - m * dil;
      float d = 0.f;
      if (j >= W) {
        const u16* kr = &p.proj[((size_t)MP + b * 4 + (j - W)) * NP + qoff + 256];
#pragma unroll
        for (int c = 0; c < 64; c += 8) {
          uint4 v = *(const uint4*)&kr[c];
          d += q[c] * bflo(v.x) + q[c + 1] * bfhi(v.x) + q[c + 2] * bflo(v.y) + q[c + 3] * bfhi(v.y) + q[c + 4] * bflo(v.z) +
               q[c + 5] * bfhi(v.z) + q[c + 6] * bflo(v.w) + q[c + 7] * bfhi(v.w);
        }
      } else {
        const float* kr = &cache[(((size_t)b * W + j) * 2 + 0) * 256 + h * 64];
#pragma unroll
        for (int c = 0; c < 64; c += 4) {
          float4 v = *(const float4*)&kr[c];
          d += q[c] * v.x + q[c + 1] * v.y + q[c + 2] * v.z + q[c + 3] * v.w;
        }
      }
      s = d * 0.125f;
    }
    sc[mi] = s;
  }
  float mx = wave_max(fmaxf(fmaxf(sc[0], sc[1]), sc[2]));
  float sum = 0.f;
#pragma unroll
  for (int mi = 0; mi < 3; ++mi) { sc[mi] = (sc[mi] > -1.0e38f) ? __expf(sc[mi] - mx) : 0.f; sum += sc[mi]; }
  sum = wave_sum(sum);
  float o = 0.f;
#pragma unroll
  for (int mi = 0; mi < 3; ++mi) {
#pragma unroll 8
    for (int mm = 0; mm < 64; ++mm) {
      const int m = mi * 64 + mm;
      if (m <= 128) {
        const float pv = __shfl(sc[mi], mm);
        const int j = W + t - m * dil;
        float vv;
        if (j >= W) vv = bf2f(p.proj[((size_t)MP + b * 4 + (j - W)) * NP + qoff + 512 + lane]);
        else vv = cache[(((size_t)b * W + j) * 2 + 1) * 256 + h * 64 + lane];
        o += pv * vv;
      }
    }
  }
  p.osw[((size_t)g * MT + qrow) * 256 + h * 64 + lane] = f2bf(o / sum);
  if (lane == 0) p.lse[((size_t)g * MT + qrow) * 4 + h] = mx + __logf(sum);
}

DI void phase3(const Params& p, char* smem) {
  const int w = threadIdx.x >> 6;
  if (blockIdx.x < 128) {
    dn_scan_block(p, blockIdx.x, smem);
  } else {
    const int gw = (blockIdx.x - 128) * 4 + w, nw = (gridDim.x - 128) * 4;
    for (int it = gw; it < 24576 + 1536; it += nw) {
      if (it < 24576) sw_prompt_wave(p, it);
      else sw_sample_wave(p, it - 24576);
    }
  }
}

DI void phase4(const Params& p) {
  const int lane = threadIdx.x & 63, w = threadIdx.x >> 6;
  for (int row = blockIdx.x * 4 + w; row < MT; row += gridDim.x * 4) {
    u16* dst = p.Amix + (size_t)row * 768;
#pragma unroll
    for (int h = 0; h < 4; ++h) {
      unsigned ov = *(const unsigned*)&p.odn[(size_t)row * 512 + h * 128 + lane * 2];
      unsigned zv = *(const unsigned*)&p.proj[(size_t)row * NP + 1536 + h * 128 + lane * 2];
      float o0 = bflo(ov), o1 = bfhi(ov);
      float ss = wave_sum(o0 * o0 + o1 * o1);
      float rs = rsqrtf(ss * (1.f / 128.f) + EPS);
      float2 gn = *(const float2*)&p.g_onorm[lane * 2];
      float y0 = o0 * rs * gn.x * siluf(bflo(zv)), y1 = o1 * rs * gn.y * siluf(bfhi(zv));
      *(unsigned*)&dst[h * 128 + lane * 2] = pack2(y0, y1);
    }
    {
      const int h = lane >> 4;
      float l0 = p.lse[((size_t)0 * MT + row) * 4 + h], l1 = p.lse[((size_t)1 * MT + row) * 4 + h], l2 = p.lse[((size_t)2 * MT + row) * 4 + h];
      float m = fmaxf(l0, fmaxf(l1, l2));
      float e0 = __expf(l0 - m), e1 = __expf(l1 - m), e2 = __expf(l2 - m);
      float inv = 1.f / (e0 + e1 + e2);
      uint2 a = *(const uint2*)&p.osw[((size_t)0 * MT + row) * 256 + lane * 4];
      uint2 c = *(const uint2*)&p.osw[((size_t)1 * MT + row) * 256 + lane * 4];
      uint2 d = *(const uint2*)&p.osw[((size_t)2 * MT + row) * 256 + lane * 4];
      e0 *= inv; e1 *= inv; e2 *= inv;
      float y0 = e0 * bflo(a.x) + e1 * bflo(c.x) + e2 * bflo(d.x);
      float y1 = e0 * bfhi(a.x) + e1 * bfhi(c.x) + e2 * bfhi(d.x);
      float y2 = e0 * bflo(a.y) + e1 * bflo(c.y) + e2 * bflo(d.y);
      float y3 = e0 * bfhi(a.y) + e1 * bfhi(c.y) + e2 * bfhi(d.y);
      *(uint2*)&dst[512 + lane * 4] = make_uint2(pack2(y0, y1), pack2(y2, y3));
    }
  }
}

DI void sample_state_copy(const Params& p) {
  const size_t gtid = (size_t)blockIdx.x * 256 + threadIdx.x, gsz = (size_t)gridDim.x * 256;
  for (size_t i = gtid; i < 147456; i += gsz) {
    const int c = (int)(i % 1536), j = (int)((i / 1536) % 3), b = (int)(i / 4608);
    p.out[O_SCONV + i] = bf2f(p.proj[((size_t)MP + b * 4 + j + 1) * NP + c]);
  }
  const float* c1 = p.cw1;
  const float* c2 = p.cw2;
  const float* c3 = p.cw3;
  for (int g = 0; g < 3; ++g) {
    const int W = 128 << (2 * g);
    const float* cache = (g == 0) ? c1 : (g == 1 ? c2 : c3);
    const size_t off = (g == 0) ? O_SW1 : (g == 1 ? O_SW2 : O_SW3);
    const size_t n4 = (size_t)32 * W * 512 / 4;
#pragma unroll 4
    for (size_t i = gtid; i < n4; i += gsz) {
      const size_t e0 = i * 4;
      const int e = (int)(e0 & 511), ii = (int)((e0 >> 9) % W), b = (int)((e0 >> 9) / W);
      f32x4 o;
      if (ii < W - 4) o = __builtin_nontemporal_load((const f32x4*)&cache[((size_t)b * W + ii + 4) * 512 + e]);
      else {
        uint2 v = *(const uint2*)&p.proj[((size_t)MP + b * 4 + (ii - (W - 4))) * NP + 2048 + g * 768 + 256 + e];
        o = (f32x4){bflo(v.x), bfhi(v.x), bflo(v.y), bfhi(v.y)};
      }
      __builtin_nontemporal_store(o, (f32x4*)&p.out[off + e0]);
    }
  }
}

DI void mem_attn_prompt_block(const Params& p, int item, char* smem) {
  const int tid = threadIdx.x, lane = tid & 63, w = tid >> 6, r = lane & 15, kg = lane >> 4;
  const int h = item & 3, qb = item >> 2;
  const int row0 = qb * 64 + w * 16, b = (qb * 64) >> 13;
  const int bh = b * 4 + h;
  u16* sK = (u16*)smem;
  bf16x8 qf[8];
#pragma unroll
  for (int ks = 0; ks < 8; ++ks) qf[ks] = *(const bf16x8*)&G(p.qb)[(size_t)(row0 + r) * 1024 + h * 256 + ks * 32 + kg * 8];
  f32x4 st[16];
  const u16* kbp = G(p.Kb) + (size_t)bh * 65536;
#pragma unroll
  for (int c = 0; c < 4; ++c) {
    __syncthreads();
#pragma unroll
    for (int i2 = 0; i2 < 2; ++i2) {
#pragma unroll
      for (int i = i2 * 4; i < i2 * 4 + 4; ++i) {
        const int idx = tid + 256 * i, row = idx >> 5, seg = idx & 31;
        *(bf16x8*)&sK[row * 264 + seg * 8] = *(gb8p)((gu16p)kbp + (size_t)(c * 64 + row) * 256 + seg * 8);
      }
      __builtin_amdgcn_sched_barrier(0);
    }
    __syncthreads();
#pragma unroll
    for (int m4 = 0; m4 < 4; ++m4) {
      f32x4 a = (f32x4){0.f, 0.f, 0.f, 0.f};
#pragma unroll
      for (int ks = 0; ks < 8; ++ks) {
        bf16x8 kf = *(const bf16x8*)&sK[(m4 * 16 + r) * 264 + ks * 32 + kg * 8];
        a = MFMA(kf, qf[ks], a);
      }
      st[c * 4 + m4] = a;
      __builtin_amdgcn_sched_barrier(0);
    }
  }
  float mx = -3.0e38f;
#pragma unroll
  for (int mt = 0; mt < 16; ++mt)
#pragma unroll
    for (int j = 0; j < 4; ++j) { st[mt][j] *= 0.0625f; mx = fmaxf(mx, st[mt][j]); }
  mx = fmaxf(mx, __shfl_xor(mx, 16));
  mx = fmaxf(mx, __shfl_xor(mx, 32));
  float sum = 0.f;
#pragma unroll
  for (int mt = 0; mt < 16; ++mt)
#pragma unroll
    for (int j = 0; j < 4; ++j) { st[mt][j] = __expf(st[mt][j] - mx); sum += st[mt][j]; }
  sum += __shfl_xor(sum, 16);
  sum += __shfl_xor(sum, 32);
  const float inv = 1.f / sum;
  bf16x8 pf[8];
#pragma unroll
  for (int k2 = 0; k2 < 8; ++k2) pf[k2] = pack8(st[2 * k2], st[2 * k2 + 1]);
  const u16* vtp = G(p.VTf) + (size_t)bh * 65536;
#pragma unroll 1
  for (int c = 0; c < 4; ++c) {
    __syncthreads();
#pragma unroll
    for (int i = 0; i < 8; ++i) {
      const int idx = tid + 256 * i;
      *(bf16x8*)&sK[idx * 8] = *(gb8p)((gu16p)vtp + (size_t)c * 16384 + idx * 8);
    }
    __syncthreads();
#pragma unroll
    for (int n4 = 0; n4 < 4; ++n4) {
      f32x4 o = (f32x4){0.f, 0.f, 0.f, 0.f};
#pragma unroll
      for (int k2 = 0; k2 < 8; ++k2) o = MFMA(*(const bf16x8*)&sK[((n4 * 8 + k2) * 64 + lane) * 8], pf[k2], o);
      uint2 ov; ov.x = pack2(o[0] * inv, o[1] * inv); ov.y = pack2(o[2] * inv, o[3] * inv);
      *(uint2*)&G(p.attn)[(size_t)(row0 + r) * 1024 + h * 256 + (c * 4 + n4) * 16 + kg * 4] = ov;
      __builtin_amdgcn_sched_barrier(0);
    }
  }
}

DI void mem_attn_sample_wave(const Params& p, int item, float* lds) {
  const int lane = threadIdx.x & 63;
  const int b = item >> 2, h = item & 3;
  float* sq = lds;
#pragma unroll
  for (int t = 0; t < 4; ++t) {
    uint2 v = *(const uint2*)&p.qb[((size_t)MP + b * 4 + t) * 1024 + h * 256 + lane * 4];
    *(float4*)&sq[t * 256 + lane * 4] = make_float4(bflo(v.x), bfhi(v.x), bflo(v.y), bfhi(v.y));
  }
  __builtin_amdgcn_s_waitcnt(0);
  __builtin_amdgcn_wave_barrier();
  float sc[4][4];
#pragma unroll
  for (int mi = 0; mi < 4; ++mi) {
    const int m = lane + 64 * mi;
    const float* kr = &p.cache_mem[(((size_t)b * 256 + m) * 2 + 0) * 1024 + h * 256];
    float d0 = 0.f, d1 = 0.f, d2 = 0.f, d3 = 0.f;
#pragma unroll 2
    for (int c = 0; c < 256; c += 4) {
      float4 kv = *(const float4*)&kr[c];
      float4 q0 = *(const float4*)&sq[c], q1 = *(const float4*)&sq[256 + c], q2 = *(const float4*)&sq[512 + c], q3 = *(const float4*)&sq[768 + c];
      d0 += kv.x * q0.x + kv.y * q0.y + kv.z * q0.z + kv.w * q0.w;
      d1 += kv.x * q1.x + kv.y * q1.y + kv.z * q1.z + kv.w * q1.w;
      d2 += kv.x * q2.x + kv.y * q2.y + kv.z * q2.z + kv.w * q2.w;
      d3 += kv.x * q3.x + kv.y * q3.y + kv.z * q3.z + kv.w * q3.w;
    }
    sc[0][mi] = d0 * 0.0625f; sc[1][mi] = d1 * 0.0625f; sc[2][mi] = d2 * 0.0625f; sc[3][mi] = d3 * 0.0625f;
  }
  float inv[4];
  __builtin_amdgcn_wave_barrier();
#pragma unroll
  for (int t = 0; t < 4; ++t) {
    float mx = wave_max(fmaxf(fmaxf(sc[t][0], sc[t][1]), fmaxf(sc[t][2], sc[t][3])));
    float sum = 0.f;
#pragma unroll
    for (int mi = 0; mi < 4; ++mi) { sc[t][mi] = __expf(sc[t][mi] - mx); sum += sc[t][mi]; }
    sum = wave_sum(sum);
    inv[t] = 1.f / sum;
#pragma unroll
    for (int mi = 0; mi < 4; ++mi) sq[t * 256 + lane + 64 * mi] = sc[t][mi];
  }
  __builtin_amdgcn_s_waitcnt(0);
  __builtin_amdgcn_wave_barrier();
  float4 o[4];
#pragma unroll
  for (int t = 0; t < 4; ++t) o[t] = make_float4(0.f, 0.f, 0.f, 0.f);
#pragma unroll 4
  for (int m = 0; m < 256; ++m) {
    float4 vv = *(const float4*)&p.cache_mem[(((size_t)b * 256 + m) * 2 + 1) * 1024 + h * 256 + lane * 4];
#pragma unroll
    for (int t = 0; t < 4; ++t) {
      const float pv = sq[t * 256 + m];
      o[t].x += pv * vv.x; o[t].y += pv * vv.y; o[t].z += pv * vv.z; o[t].w += pv * vv.w;
    }
  }
#pragma unroll
  for (int t = 0; t < 4; ++t) {
    uint2 ov; ov.x = pack2(o[t].x * inv[t], o[t].y * inv[t]); ov.y = pack2(o[t].z * inv[t], o[t].w * inv[t]);
    *(uint2*)&p.attn[((size_t)MP + b * 4 + t) * 1024 + h * 256 + lane * 4] = ov;
  }
  __builtin_amdgcn_wave_barrier();
}

DI void phase7(const Params& p, char* smem) {
  const int w = threadIdx.x >> 6;
  float* lds = (float*)smem + w * 1280;
  for (int it = blockIdx.x; it < 32 + 2048; it += gridDim.x) {
    if (it < 32) { __syncthreads(); mem_attn_sample_wave(p, it * 4 + w, lds); }
    else mem_attn_prompt_block(p, it - 32, smem);
  }
}

DI void peer_topk_wave(const Params& p, int item, unsigned* lds  ) {
  const int lane = threadIdx.x & 63, r = lane & 15, kg = lane >> 4;
  const int h = item & 7, row0 = (item >> 3) * 16;
  unsigned win[2][16];
#pragma unroll
  for (int pp = 0; pp < 2; ++pp) {
    bf16x8 qf[4];
#pragma unroll
    for (int ks = 0; ks < 4; ++ks) qf[ks] = *(const bf16x8*)&p.pq[(size_t)(row0 + r) * 2048 + h * 256 + pp * 128 + ks * 32 + kg * 8];
    unsigned kk[32];
    const u16* sk = p.subkb + (size_t)(h * 2 + pp) * 16384;
#pragma unroll
    for (int mt = 0; mt < 8; ++mt) {
      f32x4 a = (f32x4){0.f, 0.f, 0.f, 0.f};
#pragma unroll
      for (int ks = 0; ks < 4; ++ks) {
        bf16x8 kf = *(const bf16x8*)&sk[(mt * 16 + r) * 128 + ks * 32 + kg * 8];
        a = MFMA(kf, qf[ks], a);
      }
#pragma unroll
      for (int j = 0; j < 4; ++j) kk[mt * 4 + j] = (ordf(a[j]) & ~127u) | (unsigned)(mt * 16 + kg * 4 + j);
    }
#pragma unroll
    for (int rr = 0; rr < 16; ++rr) {
      unsigned m = 0;
#pragma unroll
      for (int i = 0; i < 32; ++i) m = umax(m, kk[i]);
      m = umax(m, (unsigned)__shfl_xor((int)m, 16));
      m = umax(m, (unsigned)__shfl_xor((int)m, 32));
      win[pp][rr] = m;
#pragma unroll
      for (int i = 0; i < 32; ++i) kk[i] = (kk[i] == m) ? 0u : kk[i];
    }
  }
  float f0[16], f1[16];
#pragma unroll
  for (int i = 0; i < 16; ++i) { f0[i] = unordf(win[0][i] & ~127u); f1[i] = unordf(win[1][i] & ~127u); }
  unsigned cand[13];
#define CAND(s, a0, b0, a1, b1, a2, b2, a3, b3)                                                         \
  {                                                                                                     \
    float va = sel4(kg, f0[a0], f0[a1], f0[a2], f0[(a3) < 0 ? 0 : (a3)]);                                \
    float vb = sel4(kg, f1[b0], f1[b1], f1[b2], f1[(b3) < 0 ? 0 : (b3)]);                                \
    unsigned id = sel4(kg, (unsigned)((a0) * 16 + (b0)), (unsigned)((a1) * 16 + (b1)), (unsigned)((a2) * 16 + (b2)), (unsigned)(((a3) < 0 ? 0 : (a3)) * 16 + ((b3) < 0 ? 0 : (b3)))); \
    unsigned key = (ordf(va + vb) & ~255u) | id;                                                        \
    if ((a3) < 0) key = (kg == 3) ? 0u : key;                                                           \
    cand[s] = key;                                                                                      \
  }
  CAND(0, 0, 0, 0, 13, 2, 0, 6, 1)
  CAND(1, 0, 1, 0, 14, 2, 1, 7, 0)
  CAND(2, 0, 2, 0, 15, 2, 2, 7, 1)
  CAND(3, 0, 3, 1, 0, 2, 3, 8, 0)
  CAND(4, 0, 4, 1, 1, 2, 4, 9, 0)
  CAND(5, 0, 5, 1, 2, 3, 0, 10, 0)
  CAND(6, 0, 6, 1, 3, 3, 1, 11, 0)
  CAND(7, 0, 7, 1, 4, 3, 2, 12, 0)
  CAND(8, 0, 8, 1, 5, 3, 3, 13, 0)
  CAND(9, 0, 9, 1, 6, 4, 2, 14, 0)
  CAND(10, 0, 10, 1, 7, 5, 0, 15, 0)
  CAND(11, 0, 11, 4, 0, 5, 1, -1, -1)
  CAND(12, 0, 12, 4, 1, 6, 0, -1, -1)
#undef CAND
  unsigned w2[16];
#pragma unroll
  for (int rr = 0; rr < 16; ++rr) {
    unsigned m = 0;
#pragma unroll
    for (int i = 0; i < 13; ++i) m = umax(m, cand[i]);
    m = umax(m, (unsigned)__shfl_xor((int)m, 16));
    m = umax(m, (unsigned)__shfl_xor((int)m, 32));
    w2[rr] = m;
#pragma unroll
    for (int i = 0; i < 13; ++i) cand[i] = (cand[i] == m) ? 0u : cand[i];
  }
  if (kg == 0) {
#pragma unroll
    for (int i = 0; i < 16; ++i) { lds[r * 32 + i] = win[0][i] & 127u; lds[r * 32 + 16 + i] = win[1][i] & 127u; }
  }
  __builtin_amdgcn_s_waitcnt(0);
  __builtin_amdgcn_wave_barrier();
  const float cv0 = unordf(w2[0] & ~255u);
  float sum = 0.f;
#pragma unroll
  for (int rr = 0; rr < 16; ++rr) sum += __expf(unordf(w2[rr] & ~255u) - cv0);
  const float inv = 1.f / sum;
  const size_t ob = ((size_t)(row0 + r) * 8 + h) * 16;
#pragma unroll
  for (int q = 0; q < 4; ++q) {
    const unsigned wk = sel4(kg, w2[q], w2[4 + q], w2[8 + q], w2[12 + q]);
    const int a = (wk >> 4) & 15, bb = wk & 15;
    const int i1 = (int)lds[r * 32 + a], i2 = (int)lds[r * 32 + 16 + bb];
    p.eid[ob + kg * 4 + q] = i1 * 128 + i2;
    p.gate[ob + kg * 4 + q] = __expf(unordf(wk & ~255u) - cv0) * inv;
  }
  __builtin_amdgcn_wave_barrier();
}

typedef __attribute__((ext_vector_type(2))) float f32x2;
DI float dot16_fp8(u32x4 u, const float* x, float c) {
  const unsigned d[4] = {u[0], u[1], u[2], u[3]};
#pragma unroll
  for (int i = 0; i < 4; ++i) {
    f32x2 a = __builtin_amdgcn_cvt_pk_f32_fp8((int)d[i], false);
    f32x2 b = __builtin_amdgcn_cvt_pk_f32_fp8((int)d[i], true);
    c += a[0] * x[4 * i] + a[1] * x[4 * i + 1] + b[0] * x[4 * i + 2] + b[1] * x[4 * i + 3];
  }
  return c;
}
DI void axpy16_fp8(float* o, float w, u32x4 u) {
  const unsigned d[4] = {u[0], u[1], u[2], u[3]};
#pragma unroll
  for (int i = 0; i < 4; ++i) {
    f32x2 a = __builtin_amdgcn_cvt_pk_f32_fp8((int)d[i], false);
    f32x2 b = __builtin_amdgcn_cvt_pk_f32_fp8((int)d[i], true);
    o[4 * i] += w * a[0]; o[4 * i + 1] += w * a[1]; o[4 * i + 2] += w * b[0]; o[4 * i + 3] += w * b[1];
  }
}

DI void peer_expert_wave(const Params& p, int row) {
  const int lane = __builtin_amdgcn_mbcnt_hi(-1, __builtin_amdgcn_mbcnt_lo(-1, 0));
  float xf[16];
  {
    const uint4 x0 = *(const uint4*)&G(p.h2)[(size_t)row * 1024 + lane * 16];
    const uint4 x1 = *(const uint4*)&G(p.h2)[(size_t)row * 1024 + lane * 16 + 8];
    xf[0] = bflo(x0.x); xf[1] = bfhi(x0.x); xf[2] = bflo(x0.y); xf[3] = bfhi(x0.y);
    xf[4] = bflo(x0.z); xf[5] = bfhi(x0.z); xf[6] = bflo(x0.w); xf[7] = bfhi(x0.w);
    xf[8] = bflo(x1.x); xf[9] = bfhi(x1.x); xf[10] = bflo(x1.y); xf[11] = bfhi(x1.y);
    xf[12] = bflo(x1.z); xf[13] = bfhi(x1.z); xf[14] = bflo(x1.w); xf[15] = bfhi(x1.w);
  }
  const float r2 = rsqrtf(p.ssq2[row] * (1.f / 1024.f) + EPS);
  const unsigned char AS1* EU8 = (const unsigned char AS1*)p.E8;
  const unsigned char AS1* EV8 = (const unsigned char AS1*)p.E8 + (size_t)16384 * 1024;
  float out[16];
#pragma unroll
  for (int i = 0; i < 16; ++i) out[i] = 0.f;
#pragma unroll 1
  for (int bt = 0; bt < 2; ++bt) {
    const int eidv = G(p.eid)[(size_t)row * 128 + bt * 64 + lane];
    const float gv = G(p.gate)[(size_t)row * 128 + bt * 64 + lane];
    const float rsu = G(p.rs)[eidv], rsv = G(p.rs)[16384 + eidv];
    float part[64];
#pragma unroll
    for (int e = 0; e < 64; ++e) {
      const int id = __builtin_amdgcn_readlane(eidv, e);
      const u32x4 u = *(const u32x4 AS1*)(EU8 + (size_t)id * 1024 + lane * 16);
      part[e] = dot16_fp8(u, xf, 0.f);
    }
#pragma unroll
    for (int off = 32; off > 0; off >>= 1) {
      const bool up = (lane & off) != 0;
#pragma unroll
      for (int i = 0; i < off; ++i) {
        const float a = part[i], bq = part[i + off];
        const float send = up ? a : bq, keep = up ? bq : a;
        part[i] = keep + __shfl_xor(send, off);
      }
    }
    const float wv = gv * geluf(part[0] * r2 * rsu) * rsv;
#pragma unroll 8
    for (int e = 0; e < 64; ++e) {
      const int id = __builtin_amdgcn_readlane(eidv, e);
      const float we = __int_as_float(__builtin_amdgcn_readlane(__float_as_int(wv), e));
      const u32x4 v = *(const u32x4 AS1*)(EV8 + (size_t)id * 1024 + lane * 16);
      axpy16_fp8(out, we, v);
    }
  }
  const u16* hr = G(p.h2) + (size_t)row * 1024 + lane * 16;
  float hv[16];
  float ss = 0.f;
#pragma unroll
  for (int i = 0; i < 4; ++i) {
    const uint2 tv = *(const uint2*)&hr[i * 4];
    float4 t = make_float4(bflo(tv.x), bfhi(tv.x), bflo(tv.y), bfhi(tv.y));
    hv[4 * i] = t.x + out[4 * i]; hv[4 * i + 1] = t.y + out[4 * i + 1]; hv[4 * i + 2] = t.z + out[4 * i + 2]; hv[4 * i + 3] = t.w + out[4 * i + 3];
    ss += hv[4 * i] * hv[4 * i] + hv[4 * i + 1] * hv[4 * i + 1] + hv[4 * i + 2] * hv[4 * i + 2] + hv[4 * i + 3] * hv[4 * i + 3];
  }
  ss = wave_sum(ss);
  const float rsn = rsqrtf(ss * (1.f / 1024.f) + EPS);
  float* y = ((row < MP) ? (G(p.out) + O_YP + (size_t)row * 1024) : (G(p.out) + O_YS + (size_t)(row - MP) * 1024)) + lane * 16;
#pragma unroll
  for (int i = 0; i < 4; ++i) {
    float4 g4 = *(const float4*)&p.g_final[lane * 16 + i * 4];
    *(float4*)&y[i * 4] = make_float4(hv[4 * i] * rsn * g4.x, hv[4 * i + 1] * rsn * g4.y, hv[4 * i + 2] * rsn * g4.z, hv[4 * i + 3] * rsn * g4.w);
  }
}

DI void peer_u_wave(const Params& p, int row, float* wl  ) {
  const int lane = __builtin_amdgcn_mbcnt_hi(-1, __builtin_amdgcn_mbcnt_lo(-1, 0));
  float xf[16];
  {
    const u32x4 x0 = *(const u32x4 AS1*)((const u16 AS1*)p.h2 + (size_t)row * 1024 + lane * 16);
    const u32x4 x1 = *(const u32x4 AS1*)((const u16 AS1*)p.h2 + (size_t)row * 1024 + lane * 16 + 8);
    xf[0] = bflo(x0[0]); xf[1] = bfhi(x0[0]); xf[2] = bflo(x0[1]); xf[3] = bfhi(x0[1]);
    xf[4] = bflo(x0[2]); xf[5] = bfhi(x0[2]); xf[6] = bflo(x0[3]); xf[7] = bfhi(x0[3]);
    xf[8] = bflo(x1[0]); xf[9] = bfhi(x1[0]); xf[10] = bflo(x1[1]); xf[11] = bfhi(x1[1]);
    xf[12] = bflo(x1[2]); xf[13] = bfhi(x1[2]); xf[14] = bflo(x1[3]); xf[15] = bfhi(x1[3]);
  }
  const float r2 = rsqrtf(((const float AS1*)p.ssq2)[row] * (1.f / 1024.f) + EPS);
  const unsigned char AS1* EU8 = (const unsigned char AS1*)p.E8;
  const float AS1* rsp = (const float AS1*)p.rs;
#pragma unroll 1
  for (int bt = 0; bt < 2; ++bt) {
    const int eidv = ((const int AS1*)p.eid)[(size_t)row * 128 + bt * 64 + lane];
    const float gv = ((const float AS1*)p.gate)[(size_t)row * 128 + bt * 64 + lane];
    const float rsu = rsp[eidv], rsv = rsp[16384 + eidv];
    float part[64];
#pragma unroll
    for (int e = 0; e < 64; ++e) {
      const int id = __builtin_amdgcn_readlane(eidv, e);
      const u32x4 u = *(const u32x4 AS1*)(EU8 + (size_t)id * 1024 + lane * 16);
      part[e] = dot16_fp8(u, xf, 0.f);
    }
#pragma unroll
    for (int off = 32; off > 0; off >>= 1) {
      const bool up = (lane & off) != 0;
#pragma unroll
      for (int i = 0; i < off; ++i) {
        const float a = part[i], bq = part[i + off];
        const float send = up ? a : bq, keep = up ? bq : a;
        part[i] = keep + __shfl_xor(send, off);
      }
    }
    wl[bt * 64 + lane] = gv * geluf(part[0] * r2 * rsu) * rsv;
  }
}

DI void peer_v_group(const Params& p, int gw, int nw, int g, const float* wlw  ) {
  const int lane = __builtin_amdgcn_mbcnt_hi(-1, __builtin_amdgcn_mbcnt_lo(-1, 0));
  const unsigned char AS1* EV8 = (const unsigned char AS1*)p.E8 + (size_t)16384 * 1024;
  float out[4][16];
  int e0[4], e1[4];
  float w0[4], w1[4];
  bool valid[4];
#pragma unroll
  for (int ts = 0; ts < 4; ++ts) {
    const int k = g * 4 + ts;
    const int row = gw + k * nw;
    valid[ts] = row < MT;
#pragma unroll
    for (int i = 0; i < 16; ++i) out[ts][i] = 0.f;
    e0[ts] = 0x7fffffff; e1[ts] = 0x7fffffff; w0[ts] = 0.f; w1[ts] = 0.f;
    if (valid[ts]) {
      e0[ts] = ((const int AS1*)p.eid)[(size_t)row * 128 + lane];
      e1[ts] = ((const int AS1*)p.eid)[(size_t)row * 128 + 64 + lane];
      w0[ts] = wlw[k * 128 + lane];
      w1[ts] = wlw[k * 128 + 64 + lane];
    }
  }
#pragma unroll 1
  for (int r = 0; r < 8; ++r) {
#pragma unroll
    for (int ts = 0; ts < 4; ++ts) {
      unsigned long long m0 = __ballot((e0[ts] >> 11) == r);
      unsigned long long m1 = __ballot((e1[ts] >> 11) == r);
      while ((m0 | m1) != 0ull) {
        u32x4 v[8];
        float we[8];
#pragma unroll
        for (int k = 0; k < 8; ++k) {
          we[k] = 0.f;
          v[k] = (u32x4){0u, 0u, 0u, 0u};
          if ((m0 | m1) != 0ull) {
            int l, id;
            if (m0 != 0ull) {
              l = __builtin_ctzll(m0); m0 &= m0 - 1ull;
              id = __builtin_amdgcn_readlane(e0[ts], l);
              we[k] = __int_as_float(__builtin_amdgcn_readlane(__float_as_int(w0[ts]), l));
            } else {
              l = __builtin_ctzll(m1); m1 &= m1 - 1ull;
              id = __builtin_amdgcn_readlane(e1[ts], l);
              we[k] = __int_as_float(__builtin_amdgcn_readlane(__float_as_int(w1[ts]), l));
            }
            v[k] = *(const u32x4 AS1*)(EV8 + (size_t)id * 1024 + lane * 16);
          }
        }
#pragma unroll
        for (int k = 0; k < 8; ++k) axpy16_fp8(out[ts], we[k], v[k]);
      }
    }
  }
#pragma unroll
  for (int ts = 0; ts < 4; ++ts) {
    if (!valid[ts]) continue;
    const int row = gw + (g * 4 + ts) * nw;
    const u16 AS1* hr = (const u16 AS1*)p.h2 + (size_t)row * 1024 + lane * 16;
    float hv[16];
    float ss = 0.f;
#pragma unroll
    for (int i = 0; i < 4; ++i) {
      const u32x2 tv = *(const u32x2 AS1*)&hr[i * 4];
      f32x4 t = (f32x4){bflo(tv[0]), bfhi(tv[0]), bflo(tv[1]), bfhi(tv[1])};
      hv[4 * i] = t[0] + out[ts][4 * i]; hv[4 * i + 1] = t[1] + out[ts][4 * i + 1]; hv[4 * i + 2] = t[2] + out[ts][4 * i + 2]; hv[4 * i + 3] = t[3] + out[ts][4 * i + 3];
      ss += hv[4 * i] * hv[4 * i] + hv[4 * i + 1] * hv[4 * i + 1] + hv[4 * i + 2] * hv[4 * i + 2] + hv[4 * i + 3] * hv[4 * i + 3];
    }
    ss = wave_sum(ss);
    const float rsn = rsqrtf(ss * (1.f / 1024.f) + EPS);
    float AS1* y = ((row < MP) ? ((float AS1*)p.out + O_YP + (size_t)row * 1024) : ((float AS1*)p.out + O_YS + (size_t)(row - MP) * 1024)) + lane * 16;
#pragma unroll
    for (int i = 0; i < 4; ++i) {
      f32x4 g4 = *(const f32x4 AS1*)&((const float AS1*)p.g_final)[lane * 16 + i * 4];
      f32x4 o;
      o[0] = hv[4 * i] * rsn * g4[0]; o[1] = hv[4 * i + 1] * rsn * g4[1]; o[2] = hv[4 * i + 2] * rsn * g4[2]; o[3] = hv[4 * i + 3] * rsn * g4[3];
      *(f32x4 AS1*)&y[i * 4] = o;
    }
  }
}


#define XB_TMO      128
#define XB_XCNT(j)  (256  + 64 * (j))
#define XB_XSUB(j)  (1280 + 64 * (j))
#define XB_XGEN(j)  (2304 + 64 * (j))
#define XB_TOP      3328
#define XB_TOPGEN   3392
#define XCD_BAR_WORDS 3456
#define XB_SPIN_CAP (1u << 18)
#define LAS __attribute__((address_space(3)))
DI unsigned xb_ld(unsigned* q) { return __hip_atomic_load(q, __ATOMIC_RELAXED, __HIP_MEMORY_SCOPE_AGENT); }
DI unsigned xb_add(unsigned* q, unsigned v) { return __hip_atomic_fetch_add(q, v, __ATOMIC_RELAXED, __HIP_MEMORY_SCOPE_AGENT); }
DI unsigned xb_xcc_id() { return (unsigned)__builtin_amdgcn_s_getreg((3 << 11) | 20) & 0xFu; }
#define XB_SPIN(cond, bar) do { unsigned _sp = 0; while (cond) { __builtin_amdgcn_s_sleep(1); \
    if ((++_sp & 255u) == 0u) { if (xb_ld(&(bar)[XB_TMO])) break; if (_sp > XB_SPIN_CAP) { atomicAdd(&(bar)[XB_TMO], 1u); break; } } } } while (0)
struct XcdBarrier { unsigned* bar; unsigned x; volatile LAS unsigned* st; };
DI XcdBarrier xcd_barrier_post(unsigned* bar, volatile LAS unsigned* st) {
  XcdBarrier b; b.bar = bar; b.x = xb_xcc_id(); b.st = st;
  if (threadIdx.x == 0) (void)xb_add(&bar[XB_XCNT(b.x)], 1u);
  return b;
}
DI void xcd_barrier_complete(unsigned* bar, unsigned x, unsigned& nloc, unsigned& nx) {
  const unsigned G = gridDim.x * gridDim.y * gridDim.z;
  unsigned sum, cnt, mine, sp = 0u;
  for (;;) {
    sum = 0u; cnt = 0u; mine = 0u;
#pragma unroll
    for (unsigned j = 0; j < 16; ++j) { const unsigned c = xb_ld(&bar[XB_XCNT(j)]); sum += c; cnt += (c > 0u) ? 1u : 0u; mine = (j == x) ? c : mine; }
    if (sum == G) break;
    __builtin_amdgcn_s_sleep(1);
    if ((++sp & 255u) == 0u) { if (xb_ld(&bar[XB_TMO])) break; if (sp > XB_SPIN_CAP) { atomicAdd(&bar[XB_TMO], 1u); break; } }
  }
  nloc = mine > 0u ? mine : 1u; nx = cnt > 0u ? cnt : 1u;
}
DI void xcd_barrier(const XcdBarrier& b) {
  asm volatile("s_waitcnt vmcnt(0)" ::: "memory");
  __syncthreads();
  if (threadIdx.x == 0) {
    unsigned* bar = b.bar;
    __builtin_amdgcn_s_waitcnt(0);
    unsigned nloc = b.st[0], nx = b.st[1];
    if (nloc == 0u) { xcd_barrier_complete(bar, b.x, nloc, nx); b.st[0] = nloc; b.st[1] = nx; }
    const unsigned old = xb_add(&bar[XB_XSUB(b.x)], 1u);
    const unsigned gen = old / nloc;
    if (old + 1u == (gen + 1u) * nloc) {
      __builtin_amdgcn_fence(__ATOMIC_RELEASE, "agent");
      asm volatile("s_waitcnt vmcnt(0)" ::: "memory");
      const unsigned og = xb_add(&bar[XB_TOP], 1u);
      const unsigned tg = og / nx;
      if (og + 1u == (tg + 1u) * nx) xb_add(&bar[XB_TOPGEN], 1u);
      else XB_SPIN(xb_ld(&bar[XB_TOPGEN]) == tg, bar);
      __builtin_amdgcn_fence(__ATOMIC_ACQUIRE, "agent");
      xb_add(&bar[XB_XGEN(b.x)], 1u);
      asm volatile("s_waitcnt vmcnt(0)" ::: "memory");
    } else {
      XB_SPIN(xb_ld(&bar[XB_XGEN(b.x)]) == gen, bar);
      __builtin_amdgcn_fence(__ATOMIC_ACQUIRE, "agent");
      asm volatile("s_waitcnt vmcnt(0)" ::: "memory");
    }
  }
  __syncthreads();
}

__global__ void __launch_bounds__(256, 2) mega(Params pk) {
  __shared__ __attribute__((aligned(16))) char smem[65536];
  __shared__ Params sp;
  cg::grid_group grid = cg::this_grid();
  const int w = threadIdx.x >> 6;
  __shared__ uint4 xb_words;
  if (threadIdx.x == 0) { sp = pk; xb_words = make_uint4(0u, 0u, 0u, 0u); }
  __syncthreads();
  const Params& p = sp;
  XcdBarrier xb = xcd_barrier_post(p.bar, (volatile LAS unsigned*)&xb_words);
  if (p.never) grid.sync();
#define GSYNC() xcd_barrier(xb)
#define REP(ph) for (int rp_ = 0; rp_ < ((DBL == (ph)) ? 2 : 1); ++rp_)
  REP(0) { phase0(p, smem); if (DBL == 0) grid.sync(); }
  GSYNC();
  REP(1) {
    int tm, tn;
    for (int it = 0; it * (int)gridDim.x < 129 * 34; ++it)
      if (xcd_tile(it, 129, 34, tm, tn)) gemm_tile<0, 1024>(p, p.A0, 1024, p.WtIn, tm, tn, smem);
    for (int u = blockIdx.x; u < 64; u += gridDim.x) gemm_tile<1, 1024>(p, p.Amem, 1024, p.WtMkv, u / 16, u % 16, smem);
  }
  GSYNC();
  REP(2) { phase2(p, smem); if (DBL == 2) grid.sync(); }
  GSYNC();
  REP(3) { phase3(p, smem); if (DBL == 3) grid.sync(); }
  GSYNC();
  REP(4) phase4(p);
  GSYNC();
  { int tm, tn; for (int it = 0; it * (int)gridDim.x < 257 * 8; ++it) if (xcd_tile(it, 257, 8, tm, tn)) gemm_tile128<2, 768>(p, p.Amix, 768, p.WtOut, tm, tn, smem); }
  GSYNC();
  REP(6) { int tm, tn; for (int it = 0; it * (int)gridDim.x < 257 * 8; ++it) if (xcd_tile(it, 257, 8, tm, tn)) gemm_tile128<3, 1024>(p, p.h1, 1024, p.WtMq, tm, tn, smem); }
  sample_state_copy(p);
  GSYNC();
  REP(7) phase7(p, smem);
  GSYNC();
  { int tm, tn; for (int it = 0; it * (int)gridDim.x < 257 * 8; ++it) if (xcd_tile(it, 257, 8, tm, tn)) gemm_tile128<4, 1024>(p, p.attn, 1024, p.WtMo, tm, tn, smem); }
  GSYNC();
  REP(9) { int tm, tn; for (int it = 0; it * (int)gridDim.x < 129 * 16; ++it) if (xcd_tile(it, 129, 16, tm, tn)) gemm_tile<5, 1024>(p, p.h2, 1024, p.WtPq, tm, tn, smem); }
  GSYNC();
  REP(10) {
    unsigned* lds = (unsigned*)smem + w * 512;
    for (int it = blockIdx.x * 4 + w; it < 2056 * 8; it += gridDim.x * 4) peer_topk_wave(p, it, lds);
  }
  GSYNC();
  REP(11) {
    const int gw = blockIdx.x * 4 + w, nw = gridDim.x * 4;
    float* wlw = (float*)smem + w * (17 * 128);
    __syncthreads();
    for (int k = 0; gw + k * nw < MT && k < 17; ++k) peer_u_wave(p, gw + k * nw, wlw + k * 128);
    __builtin_amdgcn_s_waitcnt(0xc07f);
    __builtin_amdgcn_wave_barrier();
    for (int g = 0; (g * 4) * nw + gw < MT && g < 5; ++g) peer_v_group(p, gw, nw, g, wlw);
  }
}

extern "C" void kernel_launch(void* const* d_in, const int* in_sizes, int n_in, void* d_out, int out_size, void* d_ws, size_t ws_size,
                              hipStream_t stream) {
  static int grid_blocks = 0;
  if (!grid_blocks) {
    int dev = 0, cus = 0, per_cu = 0;
    (void)hipGetDevice(&dev);
    (void)hipDeviceGetAttribute(&cus, hipDeviceAttributeMultiprocessorCount, dev);
    (void)hipOccupancyMaxActiveBlocksPerMultiprocessor(&per_cu, mega, 256, 0);
    if (per_cu > 2) per_cu = 2;
    if (per_cu < 1) per_cu = 1;
    grid_blocks = cus * per_cu;
  }
  Params p{};
  const float* const* in = (const float* const*)d_in;
  p.x_prompt = in[0]; p.x_sample = in[1]; p.state_delta = in[2]; p.state_conv = in[3]; p.cw1 = in[4]; p.cw2 = in[5]; p.cw3 = in[6];
  p.cache_mem = in[7]; p.mem_prompt = in[8]; p.g_mix = in[9]; p.w_in = in[10]; p.conv_w = in[11]; p.a_log = in[12]; p.dt_bias = in[13];
  p.g_onorm = in[14]; p.w_out = in[15]; p.g_memq = in[16]; p.g_memkv = in[17]; p.w_mq = in[18]; p.w_mkv = in[19]; p.w_mo = in[20];
  p.g_ffn = in[21]; p.w_pq = in[22]; p.sub_keys = in[23]; p.expert_u = in[24]; p.expert_v = in[25]; p.g_final = in[26];
  p.out = (float*)d_out;
  char* ws = (char*)d_ws;
  size_t off = 0;
  auto take = [&](size_t bytes) { char* r = ws + off; off += (bytes + 255) & ~(size_t)255; return r; };
  p.WtIn = (u16*)take((size_t)NP * 1024 * 2);
  p.WtOut = (u16*)take((size_t)1024 * 768 * 2);
  p.WtMq = (u16*)take((size_t)1024 * 1024 * 2);
  p.WtMkv = (u16*)take((size_t)2048 * 1024 * 2);
  p.WtMo = (u16*)take((size_t)1024 * 1024 * 2);
  p.WtPq = (u16*)take((size_t)2048 * 1024 * 2);
  p.subkb = (u16*)take((size_t)262144 * 2);
  p.E8 = (unsigned char*)take((size_t)32768 * 1024);
  p.rs = (float*)take((size_t)32768 * 4);
  p.Amem = (u16*)take((size_t)1024 * 1024 * 2);
  p.gb = (float*)take((size_t)MT * 8 * 4);
  p.ssq1 = (float*)take((size_t)MT * 4);
  p.ssq2 = (float*)take((size_t)MT * 4);
  p.dl = (float*)take(2048 * 4);
  p.Kb = (u16*)take((size_t)16 * 65536 * 2);
  p.VTf = (u16*)take((size_t)16 * 65536 * 2);
  char* regA = take((size_t)MT * NP * 2);
  char* regB = take((size_t)2048 * DN_ITEM);
  p.proj = (u16*)regA;
  p.h1 = (u16*)regA;
  p.h2 = (u16*)(regA + (size_t)MT * 1024 * 4);
  p.pq = (u16*)regA;
  p.dnops = regB;
  p.A0 = (u16*)regB;
  p.A1 = (u16*)regB;
  p.qb = (u16*)(regB + (size_t)MT * 1024 * 2);
  p.attn = (u16*)regB;
  p.A2 = (u16*)(regB + (size_t)MT * 1024 * 2);
  p.eid = (int*)regB;
  p.gate = (float*)(regB + (size_t)MT * 128 * 4);
  char* ob = (char*)d_out;
  p.vT = (u16*)ob;
  p.osw = (u16*)(ob + (size_t)3 * MP * 256 * 2);
  p.lse = (float*)(ob + (size_t)3 * MP * 256 * 2 + (size_t)3 * MT * 256 * 2);
  char* sb = ob + O_SW3 * 4;
  p.odn = (u16*)sb;
  p.Amix = (u16*)(sb + (size_t)MT * 512 * 2);
  p.bar = (unsigned*)take((size_t)XCD_BAR_WORDS * 4);
  p.never = 0;
  p.pad_ = 0;
  if (off > ws_size) { fprintf(stderr, "workspace too small: need %zu have %zu\n", off, ws_size); return; }
  (void)hipMemsetAsync(p.bar, 0, (size_t)XCD_BAR_WORDS * 4, stream);
  void* args[] = {&p};
  hipError_t e = hipLaunchCooperativeKernel((void*)mega, dim3(grid_blocks), dim3(256), args, 0, stream);
  if (e != hipSuccess) fprintf(stderr, "coop launch failed: %s (grid %d)\n", hipGetErrorString(e), grid_blocks);
}
```
